# Optimizing an MI355X kernel written in HIP

```python
import math
import jax, jax.numpy as jnp
from jax import lax
import numpy as np

D_MODEL = 1024
BATCH = 16
SEQ = 256
DEPTH = 2
DEC_BATCH = 2
DEC_SEQ = 1024
PAST_LEN = 512

GRID_W = 64
HEAD_DIM = 64
MIX_A = D_MODEL // 2
MIX_B = D_MODEL // 4
MIX_C = D_MODEL - MIX_A - MIX_B
N_HEADS_A = MIX_A // (2 * HEAD_DIM)
KEY_DIM_B = HEAD_DIM
VAL_DIM_B = HEAD_DIM
N_HEADS_B = MIX_B // VAL_DIM_B
N_HEADS_C = MIX_C // HEAD_DIM
N_KV_C = N_HEADS_C // 2
GQA_GROUP = N_HEADS_C // N_KV_C
D_FF = 4 * D_MODEL
Q_BLOCK = 128
CHUNK = 64
ROPE_THETA = 10000.0
ROPE_AXIS_PAIRS = HEAD_DIM // 4
ALPHA = (2 * DEPTH) ** 0.25
BETA = (8 * DEPTH) ** -0.25
LN_EPS = 1e-6
RMS_EPS = 1e-6
F_MIN = 1e-6
PROJ_SIZES = (MIX_A, MIX_A, MIX_A,
              N_HEADS_B * KEY_DIM_B, N_HEADS_B * KEY_DIM_B,
              N_HEADS_B * KEY_DIM_B,
              N_HEADS_B * VAL_DIM_B, N_HEADS_B * VAL_DIM_B,
              MIX_C, N_KV_C * HEAD_DIM, N_KV_C * HEAD_DIM)
N_IN = sum(PROJ_SIZES)

kernel_name = 'hybrid_diffusion_diffattn_hgrn2_gqa_step'


def _layernorm(x, g, b):
    xf = x.astype(jnp.float32)
    mu = jnp.mean(xf, axis=-1, keepdims=True)
    var = jnp.mean(jnp.square(xf - mu), axis=-1, keepdims=True)
    return ((xf - mu) * lax.rsqrt(var + LN_EPS)).astype(x.dtype) * g + b


def _rmsnorm(x, g):
    xf = x.astype(jnp.float32)
    y = xf * lax.rsqrt(jnp.mean(jnp.square(xf), axis=-1, keepdims=True) + RMS_EPS)
    return y.astype(x.dtype) * g


def _axial_rope_tables(n_tokens):
    rows = n_tokens // GRID_W
    row = jnp.repeat(jnp.arange(rows, dtype=jnp.float32), GRID_W)
    col = (jnp.arange(rows * GRID_W) % GRID_W).astype(jnp.float32)
    inv = ROPE_THETA ** (-jnp.arange(ROPE_AXIS_PAIRS, dtype=jnp.float32) / ROPE_AXIS_PAIRS)
    ang = jnp.concatenate([row[:, None] * inv, col[:, None] * inv], axis=-1)
    return jnp.cos(ang), jnp.sin(ang)


def _apply_rope(x, cos, sin):
    shp = x.shape
    bshape = (1, cos.shape[0]) + (1,) * (x.ndim - 3) + (cos.shape[1],)
    c, s = cos.reshape(bshape), sin.reshape(bshape)
    xf = x.astype(jnp.float32).reshape(shp[:-1] + (HEAD_DIM // 2, 2))
    x1, x2 = xf[..., 0], xf[..., 1]
    out = jnp.stack([x1 * c - x2 * s, x1 * s + x2 * c], axis=-1)
    return out.reshape(shp).astype(x.dtype)


def _query_block_sweep(fn, q):
    B, T = q.shape[:2]
    nb = T // Q_BLOCK
    qb = jnp.moveaxis(q.reshape((B, nb, Q_BLOCK) + q.shape[2:]), 1, 0)
    out = jnp.moveaxis(lax.map(fn, qb), 0, 1)
    return out.reshape((B, T) + out.shape[3:])


def _diff_attn_block(qb, k, v, lam):
    s = jnp.einsum('bqhmd,bkhmd->bhmqk', qb, k).astype(jnp.float32) * HEAD_DIM ** -0.5
    p = jax.nn.softmax(s, axis=-1)
    w = p[:, :, 0] - lam * p[:, :, 1]
    return jnp.einsum('bhqk,bkhe->bqhe', w.astype(v.dtype), v)


def _gqa_block(qb, k, v):
    s = jnp.einsum('bqngd,bknd->bngqk', qb, k).astype(jnp.float32) * HEAD_DIM ** -0.5
    p = jax.nn.softmax(s, axis=-1).astype(v.dtype)
    return jnp.einsum('bngqk,bknd->bqngd', p, v)


def _log_forget(x, lb):
    lb = lb.astype(jnp.float32)
    f = lb + (1.0 - lb) * jax.nn.sigmoid(x.astype(jnp.float32))
    return jnp.log(jnp.maximum(f, F_MIN))


def _hgrn2_scan(q, k, v, g, s0):
    B, T, H, DK = q.shape
    DV = v.shape[-1]
    nc = T // CHUNK

    def chunks(a):
        a = a.astype(jnp.float32).reshape((B, nc, CHUNK) + a.shape[2:])
        return jnp.moveaxis(a, 1, 0)

    causal = jnp.tril(jnp.ones((CHUNK, CHUNK), dtype=bool))[None, :, :, None, None]

    def step(S, xs):
        qc, kc, vc, gc = xs
        b = jnp.cumsum(gc, axis=1)
        o_inter = jnp.einsum('bthk,bhkv->bthv', qc * jnp.exp(b), S)
        diff = b[:, :, None] - b[:, None, :]
        decay = jnp.where(causal, jnp.exp(jnp.where(causal, diff, 0.0)), 0.0)
        attn = jnp.einsum('bthk,bshk,btshk->bths', qc, kc, decay)
        o_intra = jnp.einsum('bths,bshv->bthv', attn, vc)
        b_end = b[:, -1]
        S = jnp.exp(b_end)[..., None] * S + jnp.einsum(
            'bshk,bshv->bhkv', kc * jnp.exp(b_end[:, None] - b), vc)
        return S, o_inter + o_intra

    s_fin, o = lax.scan(step, s0.astype(jnp.float32), (chunks(q), chunks(k), chunks(v), chunks(g)))
    return jnp.moveaxis(o, 0, 1).reshape(B, T, H, DV), s_fin


def _token_mixer(h, lp, li, rope, ctx):
    B, T, _ = h.shape
    z = h @ lp['w_in']
    qa, ka, va, qb, fb_f, fb_b, ib, gb, qc, kc, vc = jnp.split(
        z, np.cumsum(PROJ_SIZES)[:-1].tolist(), axis=-1)
    qa = qa.reshape(B, T, N_HEADS_A, 2, HEAD_DIM)
    ka = ka.reshape(B, T, N_HEADS_A, 2, HEAD_DIM)
    va = va.reshape(B, T, N_HEADS_A, 2 * HEAD_DIM)
    qc = _rmsnorm(qc.reshape(B, T, N_HEADS_C, HEAD_DIM), lp['qnorm_g'])
    kc = _rmsnorm(kc.reshape(B, T, N_KV_C, HEAD_DIM), lp['knorm_g'])
    vc = vc.reshape(B, T, N_KV_C, HEAD_DIM)
    if ctx is None:
        ka_all, va_all, kc_all, vc_all = ka, va, kc, vc
        s0_f = s0_b = jnp.zeros((B, N_HEADS_B, KEY_DIM_B, VAL_DIM_B), jnp.float32)
    else:
        cos, sin = rope
        qa = _apply_rope(qa, cos, sin)
        qc = _apply_rope(qc, cos, sin)
        ka_all = jnp.concatenate([_apply_rope(ka, cos, sin), ctx[0]], axis=1)
        va_all = jnp.concatenate([va, ctx[1]], axis=1)
        kc_all = jnp.concatenate([_apply_rope(kc, cos, sin), ctx[2]], axis=1)
        vc_all = jnp.concatenate([vc, ctx[3]], axis=1)
        s0_f, s0_b = ctx[4], ctx[5]

    lam_init = 0.8 - 0.6 * math.exp(-0.3 * li)
    lam = (jnp.exp(jnp.sum(lp['lam_q1'].astype(jnp.float32) * lp['lam_k1'].astype(jnp.float32)))
           - jnp.exp(jnp.sum(lp['lam_q2'].astype(jnp.float32) * lp['lam_k2'].astype(jnp.float32)))
           + lam_init)
    oa = _query_block_sweep(lambda q: _diff_attn_block(q, ka_all, va_all, lam), qa)
    oa = _rmsnorm(oa, lp['subln_g']) * (1.0 - lam_init)

    g_f = _log_forget(fb_f, lp['lb_fwd']).reshape(B, T, N_HEADS_B, KEY_DIM_B)
    g_b = _log_forget(fb_b, lp['lb_bwd']).reshape(B, T, N_HEADS_B, KEY_DIM_B)
    qb = jax.nn.silu(qb).reshape(B, T, N_HEADS_B, KEY_DIM_B)
    vb = ib.reshape(B, T, N_HEADS_B, VAL_DIM_B)
    flip = lambda a: jnp.flip(a, axis=1)
    o_f, s_f = _hgrn2_scan(qb, -jnp.expm1(g_f), vb, g_f, s0_f)
    o_b, s_b = _hgrn2_scan(flip(qb), -jnp.expm1(flip(g_b)), flip(vb), flip(g_b), s0_b)
    ob = (o_f + flip(o_b)).astype(h.dtype)
    ob = _rmsnorm(ob, lp['gnorm_g']) * jax.nn.silu(gb.reshape(B, T, N_HEADS_B, VAL_DIM_B))

    oc = _query_block_sweep(lambda q: _gqa_block(q, kc_all, vc_all),
                            qc.reshape(B, T, N_KV_C, GQA_GROUP, HEAD_DIM))

    mixed = jnp.concatenate([oa.reshape(B, T, MIX_A), ob.reshape(B, T, MIX_B),
                             oc.reshape(B, T, MIX_C)], axis=-1)
    own = (ka, va, kc, vc, s_f.astype(h.dtype), s_b.astype(h.dtype))
    return mixed @ lp['w_out'], own


def _layer(x, mod, lp, li, rope, ctx):
    sh1, sc1, g1, sh2, sc2, g2 = jnp.split(mod, 6, axis=-1)
    m, own = _token_mixer(x * (1.0 + sc1) + sh1, lp, li, rope, ctx)
    x = _layernorm(ALPHA * x + g1 * m, lp['ln1_g'], lp['ln1_b'])
    hid = jnp.square(jax.nn.relu((x * (1.0 + sc2) + sh2) @ lp['w_ff1']))
    x = _layernorm(ALPHA * x + g2 * (hid @ lp['w_ff2']), lp['ln2_g'], lp['ln2_b'])
    return x, own


def setup_inputs(seed: int = 0) -> dict:
    key = jax.random.key(seed)
    ks = jax.random.split(key, 32)
    f32 = jnp.float32
    nrm = lambda k, shape, s=1.0: s * jax.random.normal(k, shape, f32)
    return {
        'x_prompt': nrm(ks[0], (BATCH, SEQ, D_MODEL)),
        'x_sample': nrm(ks[1], (DEC_BATCH, DEC_SEQ, D_MODEL)),
        'cache_a_k': nrm(ks[2], (DEC_BATCH, DEPTH, PAST_LEN, N_HEADS_A, 2, HEAD_DIM)),
        'cache_a_v': nrm(ks[3], (DEC_BATCH, DEPTH, PAST_LEN, N_HEADS_A, 2 * HEAD_DIM)),
        'cache_c_k': nrm(ks[4], (DEC_BATCH, DEPTH, PAST_LEN, N_KV_C, HEAD_DIM)),
        'cache_c_v': nrm(ks[5], (DEC_BATCH, DEPTH, PAST_LEN, N_KV_C, HEAD_DIM)),
        'state_b_fwd': nrm(ks[6], (DEC_BATCH, DEPTH, N_HEADS_B, KEY_DIM_B, VAL_DIM_B)),
        'state_b_bwd': nrm(ks[7], (DEC_BATCH, DEPTH, N_HEADS_B, KEY_DIM_B, VAL_DIM_B)),
        'c': nrm(ks[8], (DEC_BATCH, D_MODEL)),
        'c_ctx': nrm(ks[9], (D_MODEL,)),
        'w_ada': nrm(ks[10], (DEPTH, D_MODEL, 6 * D_MODEL), 0.5 * D_MODEL ** -0.5),
        'b_ada': nrm(ks[11], (DEPTH, 6 * D_MODEL), 0.02),
        'w_in': nrm(ks[12], (DEPTH, D_MODEL, N_IN), D_MODEL ** -0.5),
        'w_out': nrm(ks[13], (DEPTH, MIX_A + MIX_B + MIX_C, D_MODEL), BETA * (MIX_A + MIX_B + MIX_C) ** -0.5),
        'lam_q1': nrm(ks[14], (DEPTH, HEAD_DIM), 0.1),
        'lam_k1': nrm(ks[15], (DEPTH, HEAD_DIM), 0.1),
        'lam_q2': nrm(ks[16], (DEPTH, HEAD_DIM), 0.1),
        'lam_k2': nrm(ks[17], (DEPTH, HEAD_DIM), 0.1),
        'subln_g': 1.0 + nrm(ks[18], (DEPTH, 2 * HEAD_DIM), 0.02),
        'lb_logits_fwd': nrm(ks[19], (DEPTH, N_HEADS_B * KEY_DIM_B), 0.5),
        'lb_logits_bwd': nrm(ks[20], (DEPTH, N_HEADS_B * KEY_DIM_B), 0.5),
        'gnorm_g': 1.0 + nrm(ks[21], (DEPTH, VAL_DIM_B), 0.02),
        'qnorm_g': 1.0 + nrm(ks[22], (DEPTH, HEAD_DIM), 0.02),
        'knorm_g': 1.0 + nrm(ks[23], (DEPTH, HEAD_DIM), 0.02),
        'ln1_g': 1.0 + nrm(ks[24], (DEPTH, D_MODEL), 0.02),
        'ln1_b': nrm(ks[25], (DEPTH, D_MODEL), 0.02),
        'ln2_g': 1.0 + nrm(ks[26], (DEPTH, D_MODEL), 0.02),
        'ln2_b': nrm(ks[27], (DEPTH, D_MODEL), 0.02),
        'w_ff1': nrm(ks[28], (DEPTH, D_MODEL, D_FF), D_MODEL ** -0.5),
        'w_ff2': nrm(ks[29], (DEPTH, D_FF, D_MODEL), BETA * D_FF ** -0.5),
    }


def reference(x_prompt, x_sample, cache_a_k, cache_a_v, cache_c_k, cache_c_v, state_b_fwd,
              state_b_bwd, c, c_ctx, w_ada, b_ada, w_in, w_out, lam_q1, lam_k1, lam_q2, lam_k2,
              subln_g, lb_logits_fwd, lb_logits_bwd, gnorm_g, qnorm_g, knorm_g, ln1_g, ln1_b,
              ln2_g, ln2_b, w_ff1, w_ff2):
    sm_f = jax.nn.softmax(lb_logits_fwd.astype(jnp.float32), axis=0)
    sm_b = jax.nn.softmax(lb_logits_bwd.astype(jnp.float32), axis=0)
    lb_f = jnp.cumsum(sm_f, axis=0) - sm_f[0]
    lb_b = jnp.cumsum(sm_b, axis=0) - sm_b[0]
    rope = _axial_rope_tables(x_sample.shape[1])

    y_prompt, y_sample = x_prompt, x_sample
    ctx_layers = []
    for li in range(DEPTH):
        lp = {'w_in': w_in[li], 'w_out': w_out[li], 'lam_q1': lam_q1[li], 'lam_k1': lam_k1[li],
              'lam_q2': lam_q2[li], 'lam_k2': lam_k2[li], 'subln_g': subln_g[li],
              'lb_fwd': lb_f[li], 'lb_bwd': lb_b[li], 'gnorm_g': gnorm_g[li],
              'qnorm_g': qnorm_g[li], 'knorm_g': knorm_g[li], 'ln1_g': ln1_g[li],
              'ln1_b': ln1_b[li], 'ln2_g': ln2_g[li], 'ln2_b': ln2_b[li],
              'w_ff1': w_ff1[li], 'w_ff2': w_ff2[li]}
        mod_ctx = (jax.nn.silu(c_ctx) @ w_ada[li] + b_ada[li])[None, None, :]
        y_prompt, own = _layer(y_prompt, mod_ctx, lp, li, None, None)
        ctx_layers.append(own)
        mod_lat = (jax.nn.silu(c) @ w_ada[li] + b_ada[li])[:, None, :]
        cache = (cache_a_k[:, li], cache_a_v[:, li], cache_c_k[:, li], cache_c_v[:, li],
                 state_b_fwd[:, li], state_b_bwd[:, li])
        y_sample, _ = _layer(y_sample, mod_lat, lp, li, rope, cache)

    new_a_k = jnp.stack([t[0] for t in ctx_layers], axis=1)
    new_a_v = jnp.stack([t[1] for t in ctx_layers], axis=1)
    new_c_k = jnp.stack([t[2] for t in ctx_layers], axis=1)
    new_c_v = jnp.stack([t[3] for t in ctx_layers], axis=1)
    new_state_fwd = jnp.stack([t[4] for t in ctx_layers], axis=1)
    new_state_bwd = jnp.stack([t[5] for t in ctx_layers], axis=1)
    return (y_prompt, y_sample, new_a_k, new_a_v, new_c_k, new_c_v, new_state_fwd, new_state_bwd)
```

```cpp
#include <hip/hip_runtime.h>
#include <hip/hip_cooperative_groups.h>
#include <stdint.h>
#include <stdio.h>
namespace cg = cooperative_groups;

#ifndef MULTI_LAUNCH
#define MULTI_LAUNCH 0
#endif

#define DI __device__ __forceinline__
typedef unsigned short u16;
using bf16x8 = __attribute__((ext_vector_type(8))) short;
using f32x4 = __attribute__((ext_vector_type(4))) float;
typedef __bf16 bf2_t __attribute__((ext_vector_type(2)));
typedef float f2_t __attribute__((ext_vector_type(2)));

constexpr int D = 1024, NTOK = 6144, NCTX = 4096, NIN = 3328, DFF = 4096;
constexpr float ALPHA = 1.41421356237309515f;
constexpr float LOG2E = 1.44269504088896341f;
constexpr int LDS_BYTES = 71680;
constexpr int NPHASE = 14;

constexpr size_t O_WTIN = 0;
constexpr size_t O_WTOUT = O_WTIN + (size_t)2 * NIN * D * 2;
constexpr size_t O_WTFF1 = O_WTOUT + (size_t)2 * D * D * 2;
constexpr size_t O_WTFF2 = O_WTFF1 + (size_t)2 * DFF * D * 2;
constexpr size_t O_MODS = O_WTFF2 + (size_t)2 * D * DFF * 2;
constexpr size_t O_ROPE = O_MODS + (size_t)2 * 3 * 6144 * 4;
constexpr size_t O_QA = O_ROPE + (size_t)1024 * 32 * 2 * 4;
constexpr size_t O_KACTX = O_QA + (size_t)NTOK * 512 * 2;
constexpr size_t O_KALAT = O_KACTX + (size_t)NCTX * 512 * 2;
constexpr size_t O_VTACTX = O_KALAT + (size_t)2 * 2 * 1536 * 512 * 2;
constexpr size_t O_VTALAT = O_VTACTX + (size_t)16 * 4 * 128 * 256 * 2;
constexpr size_t O_QC = O_VTALAT + (size_t)2 * 2 * 4 * 128 * 1536 * 2;
constexpr size_t O_KCCTX = O_QC + (size_t)NTOK * 256 * 2;
constexpr size_t O_KCLAT = O_KCCTX + (size_t)NCTX * 128 * 2;
constexpr size_t O_VTCCTX = O_KCLAT + (size_t)2 * 2 * 1536 * 128 * 2;
constexpr size_t O_VTCLAT = O_VTCCTX + (size_t)16 * 2 * 64 * 256 * 2;
constexpr size_t O_KV = O_VTCLAT + (size_t)2 * 2 * 2 * 64 * 1536 * 2;
constexpr size_t O_DEC = O_KV + (size_t)768 * 4096 * 4;
constexpr size_t O_MIXED = O_DEC + (size_t)768 * 64 * 4;
constexpr size_t O_XPRE1 = O_MIXED + (size_t)NTOK * 1024 * 2;
constexpr size_t O_ST1 = O_XPRE1 + (size_t)NTOK * 1024 * 4;
constexpr size_t O_XPRE2 = O_ST1 + (size_t)NTOK * 32 * 4;
constexpr size_t O_ST2 = O_XPRE2 + (size_t)NTOK * 1024 * 4;
constexpr size_t O_HQ = O_ST2 + (size_t)NTOK * 32 * 4;
constexpr size_t O_HGF = O_HQ + (size_t)NTOK * 256 * 4;
constexpr size_t O_HGB = O_HGF + (size_t)NTOK * 256 * 4;
constexpr size_t O_HI = O_HGB + (size_t)NTOK * 256 * 4;
constexpr size_t O_HSG = O_HI + (size_t)NTOK * 256 * 4;
constexpr size_t O_OI = O_HSG + (size_t)NTOK * 256 * 4;
constexpr size_t O_QE = O_OI + (size_t)2 * NTOK * 256 * 4;
constexpr size_t O_END1 = O_QE + (size_t)2 * NTOK * 256 * 4;
constexpr size_t O_HID = O_HQ;
constexpr size_t O_END2 = O_HID + (size_t)NTOK * 4096 * 2;
static_assert(O_END2 <= O_END1, "HID alias must fit");
static_assert(O_END1 <= (size_t)256 * 1024 * 1024, "workspace too big");

constexpr size_t OUT_YP = 0, OUT_YS = 4194304, OUT_AK = 6291456, OUT_AV = 10485760, OUT_CK = 14680064,
                 OUT_CV = 15728640, OUT_SF = 16777216, OUT_SB = 17301504;

struct P {
  const float* in[30];
  float* out;
  char* ws;
};

DI unsigned pack2(float a, float b) {
  f2_t v = {a, b};
  bf2_t r = __builtin_convertvector(v, bf2_t);
  return __builtin_bit_cast(unsigned, r);
}
DI u16 f2bf(float x) { return (u16)(pack2(x, 0.f) & 0xffffu); }
DI float ex2(float x) { return __builtin_amdgcn_exp2f(x); }
DI float siluf(float x) { return x / (1.f + expf(-x)); }
DI float shx(float v, int m) { return __shfl_xor(v, m, 64); }
#define MFMA16(a, b, c) __builtin_amdgcn_mfma_f32_16x16x32_bf16((a), (b), (c), 0, 0, 0)

DI void p0_mod(const P& p, int item, char* smem) {
  float* ssilu = (float*)smem;
  float* red = ssilu + 3072;
  const int tid = threadIdx.x;
  __syncthreads();
  for (int i = tid; i < 3072; i += 256) {
    int w = i >> 10, k = i & 1023;
    float v = (w == 0) ? p.in[9][k] : p.in[8][(w - 1) * 1024 + k];
    ssilu[i] = siluf(v);
  }
  __syncthreads();
  const int li = item / 96, j0 = (item % 96) * 64;
  const int c4 = tid & 15, kp = tid >> 4;
  const float* W = p.in[10] + (size_t)li * 1024 * 6144 + j0 + c4 * 4;
  float4 a0 = {0, 0, 0, 0}, a1 = a0, a2 = a0;
#pragma unroll 4
  for (int kk = 0; kk < 64; ++kk) {
    int k = kp * 64 + kk;
    float4 w4 = *(const float4*)(W + (size_t)k * 6144);
    float s0 = ssilu[k], s1 = ssilu[1024 + k], s2 = ssilu[2048 + k];
    a0.x += s0 * w4.x; a0.y += s0 * w4.y; a0.z += s0 * w4.z; a0.w += s0 * w4.w;
    a1.x += s1 * w4.x; a1.y += s1 * w4.y; a1.z += s1 * w4.z; a1.w += s1 * w4.w;
    a2.x += s2 * w4.x; a2.y += s2 * w4.y; a2.z += s2 * w4.z; a2.w += s2 * w4.w;
  }
  *(float4*)(red + (kp * 3 + 0) * 64 + c4 * 4) = a0;
  *(float4*)(red + (kp * 3 + 1) * 64 + c4 * 4) = a1;
  *(float4*)(red + (kp * 3 + 2) * 64 + c4 * 4) = a2;
  __syncthreads();
  if (tid < 192) {
    int w = tid >> 6, c = tid & 63;
    float s = p.in[11][li * 6144 + j0 + c];
    for (int q = 0; q < 16; ++q) s += red[(q * 3 + w) * 64 + c];
    ((float*)(p.ws + O_MODS))[(li * 3 + w) * 6144 + j0 + c] = s;
  }
}

DI void p0_rope(const P& p, int item) {
  float* R = (float*)(p.ws + O_ROPE);
  for (int i = threadIdx.x; i < 4096; i += 256) {
    int idx = item * 4096 + i;
    int t = idx >> 5, pp = idx & 31;
    float inv = powf(10000.f, -(float)(pp & 15) / 16.f);
    float pos = (pp < 16) ? (float)(t >> 6) : (float)(t & 63);
    float ang = pos * inv;
    R[idx * 2] = cosf(ang);
    R[idx * 2 + 1] = sinf(ang);
  }
}

DI void p0_copyk(const P& p, int item, bool isA) {
  const int W = isA ? 512 : 128;
  const float* src = isA ? p.in[2] : p.in[4];
  u16* dst = (u16*)(p.ws + (isA ? O_KALAT : O_KCLAT));
  for (int i = 0; i < 4; ++i) {
    size_t e = (size_t)item * 4096 + (size_t)(threadIdx.x + 256 * i) * 4;
    float4 v = *(const float4*)(src + e);
    int c = (int)(e % W);
    size_t r = e / W;
    int pp = (int)(r % 512);
    int bl = (int)(r / 512);
    int b = bl >> 1, li = bl & 1;
    uint2 o;
    o.x = pack2(v.x, v.y);
    o.y = pack2(v.z, v.w);
    *(uint2*)(dst + ((size_t)((li * 2 + b) * 1536 + 1024 + pp)) * W + c) = o;
  }
}

DI void transpose_tile(const float* src, int sstride, u16* dst, int dstride, char* smem) {
  float* t = (float*)smem;
  const int tid = threadIdx.x;
  __syncthreads();
#pragma unroll
  for (int i = 0; i < 4; ++i) {
    int idx = tid + 256 * i;
    int r = idx >> 4, c4 = idx & 15;
    float4 v = *(const float4*)(src + (size_t)r * sstride + c4 * 4);
    float* q = t + r * 65 + c4 * 4;
    q[0] = v.x; q[1] = v.y; q[2] = v.z; q[3] = v.w;
  }
  __syncthreads();
  const int c = tid >> 2, rs = tid & 3;
  unsigned o[8];
#pragma unroll
  for (int e = 0; e < 8; ++e) {
    float a = t[(rs * 16 + 2 * e) * 65 + c], b = t[(rs * 16 + 2 * e + 1) * 65 + c];
    o[e] = pack2(a, b);
  }
  uint4* dp = (uint4*)(dst + (size_t)c * dstride + rs * 16);
  dp[0] = make_uint4(o[0], o[1], o[2], o[3]);
  dp[1] = make_uint4(o[4], o[5], o[6], o[7]);
}

DI void phase0(const P& p, char* smem) {
  constexpr int N_MOD = 192, N_ROPE = 8, N_AK = 256, N_CK = 64;
  constexpr int T_IN = 1664, T_OUT = 512, T_FF1 = 2048, T_FF2 = 2048, T_AV = 256, T_CV = 64;
  constexpr int B_ROPE = N_MOD, B_AK = B_ROPE + N_ROPE, B_CK = B_AK + N_AK, B_T = B_CK + N_CK;
  constexpr int TOTAL = B_T + T_IN + T_OUT + T_FF1 + T_FF2 + T_AV + T_CV;
  for (int it = blockIdx.x; it < TOTAL; it += gridDim.x) {
    if (it < B_ROPE) p0_mod(p, it, smem);
    else if (it < B_AK) p0_rope(p, it - B_ROPE);
    else if (it < B_CK) p0_copyk(p, it - B_AK, true);
    else if (it < B_T) p0_copyk(p, it - B_CK, false);
    else {
      int t = it - B_T;
      if (t < T_IN) {
        int li = t / 832, r = t % 832, kt = r / 52, nt = r % 52;
        transpose_tile(p.in[12] + (size_t)li * 1024 * NIN + (size_t)(kt * 64) * NIN + nt * 64, NIN,
                       (u16*)(p.ws + O_WTIN) + (size_t)li * NIN * 1024 + (size_t)(nt * 64) * 1024 + kt * 64, 1024, smem);
      } else if ((t -= T_IN) < T_OUT) {
        int li = t / 256, r = t % 256, kt = r / 16, nt = r % 16;
        transpose_tile(p.in[13] + (size_t)li * 1024 * 1024 + (size_t)(kt * 64) * 1024 + nt * 64, 1024,
                       (u16*)(p.ws + O_WTOUT) + (size_t)li * 1024 * 1024 + (size_t)(nt * 64) * 1024 + kt * 64, 1024, smem);
      } else if ((t -= T_OUT) < T_FF1) {
        int li = t / 1024, r = t % 1024, kt = r / 64, nt = r % 64;
        transpose_tile(p.in[28] + (size_t)li * 1024 * DFF + (size_t)(kt * 64) * DFF + nt * 64, DFF,
                       (u16*)(p.ws + O_WTFF1) + (size_t)li * DFF * 1024 + (size_t)(nt * 64) * 1024 + kt * 64, 1024, smem);
      } else if ((t -= T_FF1) < T_FF2) {
        int li = t / 1024, r = t % 1024, kt = r / 16, nt = r % 16;
        transpose_tile(p.in[29] + (size_t)li * DFF * 1024 + (size_t)(kt * 64) * 1024 + nt * 64, 1024,
                       (u16*)(p.ws + O_WTFF2) + (size_t)li * 1024 * DFF + (size_t)(nt * 64) * DFF + kt * 64, DFF, smem);
      } else if ((t -= T_FF2) < T_AV) {
        int bl = t / 64, r = t % 64, pt = r / 8, ct = r % 8;
        int b = bl >> 1, li = bl & 1;
        transpose_tile(p.in[3] + ((size_t)bl * 512 + pt * 64) * 512 + ct * 64, 512,
                       (u16*)(p.ws + O_VTALAT) + ((size_t)(li * 2 + b) * 512 + ct * 64) * 1536 + 1024 + pt * 64, 1536, smem);
      } else {
        t -= T_AV;
        int bl = t / 16, r = t % 16, pt = r / 2, ct = r % 2;
        int b = bl >> 1, li = bl & 1;
        transpose_tile(p.in[5] + ((size_t)bl * 512 + pt * 64) * 128 + ct * 64, 128,
                       (u16*)(p.ws + O_VTCLAT) + ((size_t)(li * 2 + b) * 128 + ct * 64) * 1536 + 1024 + pt * 64, 1536, smem);
      }
    }
  }
}

struct GA {
  const float* alo;
  const float* ahi;
  const float* stats;
  const float* lng;
  const float* lnb;
  const float* mods;
  int sc_off, sh_off;
  const u16* a16;
  const u16* bt;
  int K, N;
  float* xout;
  float* sout;
  u16* hid;
};

DI void epi_inproj(const P& p, int li, f32x4 (&acc)[4][4], int R0, int C0);

typedef unsigned u32x4 __attribute__((ext_vector_type(4)));
typedef unsigned u32x2 __attribute__((ext_vector_type(2)));

template <int AMODE>
DI void g_load(const GA& g, const float* fsrc, const float* modv, int m0, int n0, int K, int k0, int tid, u32x4 (&breg)[4],
               u32x4 (&areg)[4], f32x4 (&freg)[8], f32x4& cG, f32x4& cB) {
  const unsigned boff = (unsigned)(tid >> 3) * (unsigned)K + (unsigned)(tid & 7) * 8u;
#pragma unroll
  for (int i = 0; i < 4; ++i) {
    const u16* bb = g.bt + (size_t)(n0 + 32 * i) * K + k0;
    breg[i] = *(const u32x4*)(bb + boff);
  }
  if constexpr (AMODE == 0) {
#pragma unroll
    for (int i = 0; i < 4; ++i) {
      const u16* ab = g.a16 + (size_t)(m0 + 32 * i) * K + k0;
      areg[i] = *(const u32x4*)(ab + boff);
    }
  } else {
    const int col = k0 + (tid & 15) * 4;
    const unsigned aoff = (unsigned)(tid >> 4) * 1024u + (unsigned)(tid & 15) * 4u;
#pragma unroll
    for (int i = 0; i < 8; ++i) {
      const float* ab = fsrc + (size_t)(16 * i) * 1024 + k0;
      freg[i] = *(const f32x4*)(ab + aoff);
    }
    f32x4 sc = *(const f32x4*)(modv + g.sc_off + col);
    f32x4 sh = *(const f32x4*)(modv + g.sh_off + col);
    sc = sc + 1.f;
    if (g.stats != nullptr) {
      f32x4 gg = *(const f32x4*)(g.lng + col);
      f32x4 bb = *(const f32x4*)(g.lnb + col);
      cG = gg * sc;
      cB = bb * sc + sh;
    } else {
      cG = sc;
      cB = sh;
    }
  }
}

template <int AMODE>
DI void g_store(bool hasStats, u16* sA, u16* sB, const float2* sStat, int tid, const u32x4 (&breg)[4], const u32x4 (&areg)[4],
                const f32x4 (&freg)[8], const f32x4& cG, const f32x4& cB) {
#pragma unroll
  for (int i = 0; i < 4; ++i) {
    int idx = tid + 256 * i;
    int row = idx >> 3, c8 = idx & 7;
    *(u32x4*)(sB + row * 72 + c8 * 8) = breg[i];
  }
  if constexpr (AMODE == 0) {
#pragma unroll
    for (int i = 0; i < 4; ++i) {
      int idx = tid + 256 * i;
      int row = idx >> 3, c8 = idx & 7;
      *(u32x4*)(sA + row * 72 + c8 * 8) = areg[i];
    }
  } else {
#pragma unroll
    for (int i = 0; i < 8; ++i) {
      int row = (tid >> 4) + 16 * i;
      float mu = 0.f, rs = 1.f;
      if (hasStats) {
        float2 st = sStat[row];
        mu = st.x;
        rs = st.y;
      }
      f32x4 hv = (freg[i] - mu) * rs * cG + cB;
      u32x2 o;
      o.x = pack2(hv.x, hv.y);
      o.y = pack2(hv.z, hv.w);
      *(u32x2*)(sA + row * 72 + (tid & 15) * 4) = o;
    }
  }
}

template <int AMODE, int EPI>
DI void gemm_tile(const P& p, const GA& g, int li, int m0, int n0, char* smem) {
  const int tid = threadIdx.x, lane = tid & 63, wid = tid >> 6, wr = wid >> 1, wc = wid & 1;
  const int l16 = lane & 15, q4 = lane >> 4;
  u16* sA = (u16*)smem;
  u16* sB = sA + 128 * 72;
  float2* sStat = (float2*)(smem + 36864);
  const int K = g.K;
  const int rtype = (m0 < NCTX) ? 0 : 1 + ((m0 - NCTX) >> 10);
  const float* modv = g.mods + rtype * 6144;
  const float* fsrc = (m0 < NCTX) ? g.alo + (size_t)m0 * 1024 : g.ahi + (size_t)(m0 - NCTX) * 1024;

  __syncthreads();
  if (g.stats != nullptr && tid < 128) {
    const float4* sp = (const float4*)(g.stats + (size_t)(m0 + tid) * 32);
    float s1 = 0.f, s2 = 0.f;
#pragma unroll
    for (int i = 0; i < 8; ++i) {
      float4 v = sp[i];
      s1 += v.x + v.z;
      s2 += v.y + v.w;
    }
    float mu = s1 * (1.f / 1024.f);
    float var = s2 * (1.f / 1024.f) - mu * mu;
    sStat[tid] = make_float2(mu, rsqrtf(fmaxf(var, 0.f) + 1e-6f));
  }

  f32x4 acc[4][4];
#pragma unroll
  for (int i = 0; i < 4; ++i)
#pragma unroll
    for (int j = 0; j < 4; ++j) acc[i][j] = f32x4{0.f, 0.f, 0.f, 0.f};

  u32x4 breg[4];
  u32x4 areg[4];
  f32x4 freg[8];
  f32x4 cG = {1.f, 1.f, 1.f, 1.f}, cB = {0.f, 0.f, 0.f, 0.f};
  const int nk = K >> 6;
  g_load<AMODE>(g, fsrc, modv, m0, n0, K, 0, tid, breg, areg, freg, cG, cB);
  for (int kt = 0; kt < nk; ++kt) {
    __syncthreads();
    g_store<AMODE>(g.stats != nullptr, sA, sB, sStat, tid, breg, areg, freg, cG, cB);
    __syncthreads();
    if (kt + 1 < nk) g_load<AMODE>(g, fsrc, modv, m0, n0, K, (kt + 1) << 6, tid, breg, areg, freg, cG, cB);
#pragma unroll
    for (int s = 0; s < 2; ++s) {
      bf16x8 af[4], bfr[4];
#pragma unroll
      for (int i = 0; i < 4; ++i) {
        af[i] = *(const bf16x8*)(sA + (wr * 64 + i * 16 + l16) * 72 + s * 32 + q4 * 8);
        bfr[i] = *(const bf16x8*)(sB + (wc * 64 + i * 16 + l16) * 72 + s * 32 + q4 * 8);
      }
#pragma unroll
      for (int i = 0; i < 4; ++i)
#pragma unroll
        for (int j = 0; j < 4; ++j) acc[i][j] = MFMA16(af[i], bfr[j], acc[i][j]);
    }
  }

  const int R0 = m0 + wr * 64, C0 = n0 + wc * 64;
  if constexpr (EPI == 0) {
    epi_inproj(p, li, acc, R0, C0);
  } else if constexpr (EPI == 1) {
    float gate[4], lg[4], lb[4];
#pragma unroll
    for (int j = 0; j < 4; ++j) {
      int col = C0 + j * 16 + l16;
      gate[j] = modv[g.sc_off + col];
      lg[j] = g.stats ? g.lng[col] : 1.f;
      lb[j] = g.stats ? g.lnb[col] : 0.f;
    }
#pragma unroll
    for (int i = 0; i < 4; ++i) {
#pragma unroll
      for (int r = 0; r < 4; ++r) {
        int lrow = wr * 64 + i * 16 + q4 * 4 + r;
        float mu = 0.f, rs = 1.f;
        if (g.stats != nullptr) {
          float2 st = sStat[lrow];
          mu = st.x;
          rs = st.y;
        }
        float s1 = 0.f, s2 = 0.f;
#pragma unroll
        for (int j = 0; j < 4; ++j) {
          int col = C0 + j * 16 + l16;
          float x = fsrc[(size_t)lrow * 1024 + col];
          x = (x - mu) * rs * lg[j] + lb[j];
          float v = ALPHA * x + gate[j] * acc[i][j][r];
          g.xout[(size_t)(m0 + lrow) * 1024 + col] = v;
          s1 += v;
          s2 += v * v;
        }
        s1 += shx(s1, 1); s2 += shx(s2, 1);
        s1 += shx(s1, 2); s2 += shx(s2, 2);
        s1 += shx(s1, 4); s2 += shx(s2, 4);
        s1 += shx(s1, 8); s2 += shx(s2, 8);
        if (l16 == 0) *(float2*)(g.sout + (size_t)(m0 + lrow) * 32 + (C0 >> 6) * 2) = make_float2(s1, s2);
      }
    }
  } else {
#pragma unroll
    for (int i = 0; i < 4; ++i)
#pragma unroll
      for (int r = 0; r < 4; ++r) {
        int row = R0 + i * 16 + q4 * 4 + r;
#pragma unroll
        for (int j = 0; j < 4; ++j) {
          float v = fmaxf(acc[i][j][r], 0.f);
          g.hid[(size_t)row * DFF + C0 + j * 16 + l16] = f2bf(v * v);
        }
      }
  }
}

DI void epi_inproj(const P& p, int li, f32x4 (&acc)[4][4], int R0, int C0) {
  const int lane = threadIdx.x & 63, l16 = lane & 15, q4 = lane >> 4;
  const int seg = C0 >> 6;
  const bool lat = R0 >= NCTX;
  const float2* rope = (const float2*)(p.ws + O_ROPE);
  int b, tb;
  if (!lat) { b = R0 >> 8; tb = R0 & 255; } else { b = (R0 - NCTX) >> 10; tb = (R0 - NCTX) & 1023; }

  enum { T_QA, T_KA, T_VA, T_QB, T_FF, T_FB, T_IB, T_GB, T_QC, T_KC, T_VC };
  int type, cbase;
  if (seg < 8) { type = T_QA; cbase = seg * 64; }
  else if (seg < 16) { type = T_KA; cbase = (seg - 8) * 64; }
  else if (seg < 24) { type = T_VA; cbase = (seg - 16) * 64; }
  else if (seg < 28) { type = T_QB; cbase = (seg - 24) * 64; }
  else if (seg < 32) { type = T_FF; cbase = (seg - 28) * 64; }
  else if (seg < 36) { type = T_FB; cbase = (seg - 32) * 64; }
  else if (seg < 40) { type = T_IB; cbase = (seg - 36) * 64; }
  else if (seg < 44) { type = T_GB; cbase = (seg - 40) * 64; }
  else if (seg < 48) { type = T_QC; cbase = (seg - 44) * 64; }
  else if (seg < 50) { type = T_KC; cbase = (seg - 48) * 64; }
  else { type = T_VC; cbase = (seg - 50) * 64; }

  if (type == T_QC || type == T_KC) {
    const float* gv = (type == T_QC ? p.in[22] : p.in[23]) + li * 64;
    float gj[4];
#pragma unroll
    for (int j = 0; j < 4; ++j) gj[j] = gv[j * 16 + l16];
#pragma unroll
    for (int i = 0; i < 4; ++i)
#pragma unroll
      for (int r = 0; r < 4; ++r) {
        float ss = 0.f;
#pragma unroll
        for (int j = 0; j < 4; ++j) ss += acc[i][j][r] * acc[i][j][r];
        ss += shx(ss, 1); ss += shx(ss, 2); ss += shx(ss, 4); ss += shx(ss, 8);
        float rs = rsqrtf(ss * (1.f / 64.f) + 1e-6f);
#pragma unroll
        for (int j = 0; j < 4; ++j) acc[i][j][r] = acc[i][j][r] * rs * gj[j];
      }
  }
  if (!lat && (type == T_KA || type == T_VA || type == T_KC || type == T_VC)) {
    float* o;
    int W;
    if (type == T_KA) { o = p.out + OUT_AK; W = 512; }
    else if (type == T_VA) { o = p.out + OUT_AV; W = 512; }
    else if (type == T_KC) { o = p.out + OUT_CK; W = 128; }
    else { o = p.out + OUT_CV; W = 128; }
#pragma unroll
    for (int i = 0; i < 4; ++i)
#pragma unroll
      for (int r = 0; r < 4; ++r) {
        int t = tb + i * 16 + q4 * 4 + r;
        size_t base = ((size_t)(b * 2 + li) * 256 + t) * W + cbase;
#pragma unroll
        for (int j = 0; j < 4; ++j) o[base + j * 16 + l16] = acc[i][j][r];
      }
  }
  if (lat && (type == T_QA || type == T_KA || type == T_QC || type == T_KC)) {
#pragma unroll
    for (int i = 0; i < 4; ++i)
#pragma unroll
      for (int r = 0; r < 4; ++r) {
        int t = tb + i * 16 + q4 * 4 + r;
#pragma unroll
        for (int j = 0; j < 4; ++j) {
          float v = acc[i][j][r];
          float pv = shx(v, 1);
          float2 cs = rope[t * 32 + j * 8 + (l16 >> 1)];
          acc[i][j][r] = (l16 & 1) ? (pv * cs.y + v * cs.x) : (v * cs.x - pv * cs.y);
        }
      }
  }

  if (type == T_QA || type == T_KA || type == T_QC || type == T_KC) {
    u16* dst;
    int W;
    size_t rowbase;
    if (type == T_QA) { dst = (u16*)(p.ws + O_QA); W = 512; rowbase = (size_t)R0 * 512; }
    else if (type == T_QC) { dst = (u16*)(p.ws + O_QC); W = 256; rowbase = (size_t)R0 * 256; }
    else if (type == T_KA) {
      W = 512;
      if (!lat) { dst = (u16*)(p.ws + O_KACTX); rowbase = (size_t)R0 * 512; }
      else { dst = (u16*)(p.ws + O_KALAT); rowbase = ((size_t)(li * 2 + b) * 1536 + tb) * 512; }
    } else {
      W = 128;
      if (!lat) { dst = (u16*)(p.ws + O_KCCTX); rowbase = (size_t)R0 * 128; }
      else { dst = (u16*)(p.ws + O_KCLAT); rowbase = ((size_t)(li * 2 + b) * 1536 + tb) * 128; }
    }
#pragma unroll
    for (int i = 0; i < 4; ++i)
#pragma unroll
      for (int r = 0; r < 4; ++r) {
        size_t base = rowbase + (size_t)(i * 16 + q4 * 4 + r) * W + cbase;
#pragma unroll
        for (int j = 0; j < 4; ++j) dst[base + j * 16 + l16] = f2bf(acc[i][j][r]);
      }
  } else if (type == T_VA || type == T_VC) {
    u16* dst;
    int L;
    size_t hb;
    if (type == T_VA) {
      int h = cbase >> 7, dv0 = cbase & 127;
      if (!lat) { dst = (u16*)(p.ws + O_VTACTX); L = 256; hb = ((size_t)(b * 4 + h) * 128 + dv0) * 256; }
      else { dst = (u16*)(p.ws + O_VTALAT); L = 1536; hb = ((size_t)((li * 2 + b) * 4 + h) * 128 + dv0) * 1536; }
    } else {
      int n = cbase >> 6;
      if (!lat) { dst = (u16*)(p.ws + O_VTCCTX); L = 256; hb = ((size_t)(b * 2 + n) * 64) * 256; }
      else { dst = (u16*)(p.ws + O_VTCLAT); L = 1536; hb = ((size_t)((li * 2 + b) * 2 + n) * 64) * 1536; }
    }
#pragma unroll
    for (int i = 0; i < 4; ++i)
#pragma unroll
      for (int j = 0; j < 4; ++j) {
        uint2 o;
        o.x = pack2(acc[i][j][0], acc[i][j][1]);
        o.y = pack2(acc[i][j][2], acc[i][j][3]);
        *(uint2*)(dst + hb + (size_t)(j * 16 + l16) * L + tb + i * 16 + q4 * 4) = o;
      }
  } else {
    float* dst;
    if (type == T_QB) dst = (float*)(p.ws + O_HQ);
    else if (type == T_FF) dst = (float*)(p.ws + O_HGF);
    else if (type == T_FB) dst = (float*)(p.ws + O_HGB);
    else if (type == T_IB) dst = (float*)(p.ws + O_HI);
    else dst = (float*)(p.ws + O_HSG);
    float lbv[4] = {0.f, 0.f, 0.f, 0.f};
    if ((type == T_FF || type == T_FB) && li == 1) {
      const float* lg = (type == T_FF) ? p.in[19] : p.in[20];
#pragma unroll
      for (int j = 0; j < 4; ++j) {
        int c = cbase + j * 16 + l16;
        lbv[j] = 1.f / (1.f + expf(lg[c] - lg[256 + c]));
      }
    }
#pragma unroll
    for (int i = 0; i < 4; ++i)
#pragma unroll
      for (int r = 0; r < 4; ++r) {
        size_t base = (size_t)(R0 + i * 16 + q4 * 4 + r) * 256 + cbase;
#pragma unroll
        for (int j = 0; j < 4; ++j) {
          float v = acc[i][j][r];
          float o;
          if (type == T_QB || type == T_GB) o = siluf(v);
          else if (type == T_IB) o = v;
          else {
            float sg = 1.f / (1.f + expf(-v));
            float f = lbv[j] + (1.f - lbv[j]) * sg;
            o = logf(fmaxf(f, 1e-6f));
          }
          dst[base + j * 16 + l16] = o;
        }
      }
  }
}

template <int AMODE, int EPI>
DI void gemm_phase(const P& p, const GA& g, int li, char* smem) {
  const int NT = g.N >> 7;
  const int xcd = blockIdx.x & 7, lb = blockIdx.x >> 3, nlb = gridDim.x >> 3;
  if (lb >= nlb) return;
  for (int t = lb; t < 6 * NT; t += nlb) {
    int mt = xcd * 6 + t / NT, nt = t % NT;
    gemm_tile<AMODE, EPI>(p, g, li, mt * 128, nt * 128, smem);
  }
}


template <int KW, int DV>
DI void attn_gload(const u16* Kb, int kstride, const u16* VT, int L, int kb, int tid, u32x4 (&kr)[KW / 32], u32x4 (&vr)[DV / 32]) {
  constexpr int KPR = 256 / (KW / 8);
  const unsigned koff = (unsigned)(tid / (KW / 8)) * (unsigned)kstride + (unsigned)(tid % (KW / 8)) * 8u;
  const unsigned voff = (unsigned)(tid >> 3) * (unsigned)L + (unsigned)(tid & 7) * 8u;
#pragma unroll
  for (int i = 0; i < KW / 32; ++i) {
    const u16* kbp = Kb + (size_t)(kb * 64 + KPR * i) * kstride;
    kr[i] = *(const u32x4*)(kbp + koff);
  }
#pragma unroll
  for (int i = 0; i < DV / 32; ++i) {
    const u16* vbp = VT + (size_t)(32 * i) * L + kb * 64;
    vr[i] = *(const u32x4*)(vbp + voff);
  }
}
template <int KW, int DV, bool DIFF>
DI void attn_item(const u16* Q, int qstride, int qcol, int qrow0, const u16* Kb, int kstride, const u16* VT, int L,
                          int nkeys, u16* mixed, int mixcol, float lam, float postscale, const float* subg, char* smem) {
  const int tid = threadIdx.x, lane = tid & 63, wid = tid >> 6, l16 = lane & 15, q4 = lane >> 4;
  const int qsub = wid & 1, var = wid >> 1;
  constexpr int KS = KW + 8;
  u16* sK = (u16*)smem;
  u16* sV = sK + 64 * KS;
  constexpr int KPT = KW / 32, VPT = DV / 32, NDT = DV / 16;
  const int kfo = DIFF ? var * 64 : 0;
  const float c = 0.125f * LOG2E;

  const u16* qp = Q + (size_t)(qrow0 + qsub * 16 + l16) * qstride + qcol + var * 64 + q4 * 8;
  const bf16x8 qf0 = *(const bf16x8*)qp;
  const bf16x8 qf1 = *(const bf16x8*)(qp + 32);

  u32x4 kr[KPT], vr[VPT];
  f32x4 o[NDT];
#pragma unroll
  for (int d = 0; d < NDT; ++d) o[d] = f32x4{0.f, 0.f, 0.f, 0.f};
  float m = -INFINITY, l = 0.f;
  const int nkb = nkeys >> 6;
  attn_gload<KW, DV>(Kb, kstride, VT, L, 0, tid, kr, vr);
  for (int kb = 0; kb < nkb; ++kb) {
    __syncthreads();
#pragma unroll
    for (int i = 0; i < KPT; ++i) {
      int idx = tid + 256 * i;
      int key = idx / (KW / 8), cc = idx % (KW / 8);
      *(u32x4*)(sK + key * KS + cc * 8) = kr[i];
    }
#pragma unroll
    for (int i = 0; i < VPT; ++i) {
      int idx = tid + 256 * i;
      int row = idx >> 3, cc = idx & 7;
      *(u32x4*)(sV + row * 72 + cc * 8) = vr[i];
    }
    __syncthreads();
    if (kb + 1 < nkb) attn_gload<KW, DV>(Kb, kstride, VT, L, kb + 1, tid, kr, vr);

    f32x4 st[4];
#pragma unroll
    for (int kt = 0; kt < 4; ++kt) {
      const u16* kp = sK + (kt * 16 + l16) * KS + kfo + q4 * 8;
      bf16x8 k0 = *(const bf16x8*)kp;
      bf16x8 k1 = *(const bf16x8*)(kp + 32);
      f32x4 z = {0.f, 0.f, 0.f, 0.f};
      z = MFMA16(k0, qf0, z);
      st[kt] = MFMA16(k1, qf1, z);
    }
    float bm = st[0][0];
#pragma unroll
    for (int kt = 0; kt < 4; ++kt)
#pragma unroll
      for (int r = 0; r < 4; ++r) bm = fmaxf(bm, st[kt][r]);
    bm = fmaxf(bm, shx(bm, 16));
    bm = fmaxf(bm, shx(bm, 32));
    const float mn = fmaxf(m, bm);
    const float alpha = ex2((m - mn) * c);
    m = mn;
    float ps = 0.f;
#pragma unroll
    for (int kt = 0; kt < 4; ++kt)
#pragma unroll
      for (int r = 0; r < 4; ++r) {
        float pv = ex2((st[kt][r] - mn) * c);
        st[kt][r] = pv;
        ps += pv;
      }
    l = l * alpha + ps;
#pragma unroll
    for (int d = 0; d < NDT; ++d) {
      o[d][0] *= alpha; o[d][1] *= alpha; o[d][2] *= alpha; o[d][3] *= alpha;
    }
#pragma unroll
    for (int ks = 0; ks < 2; ++ks) {
      unsigned pk[4];
      pk[0] = pack2(st[2 * ks][0], st[2 * ks][1]);
      pk[1] = pack2(st[2 * ks][2], st[2 * ks][3]);
      pk[2] = pack2(st[2 * ks + 1][0], st[2 * ks + 1][1]);
      pk[3] = pack2(st[2 * ks + 1][2], st[2 * ks + 1][3]);
      uint4 pu = make_uint4(pk[0], pk[1], pk[2], pk[3]);
      bf16x8 pf = __builtin_bit_cast(bf16x8, pu);
#pragma unroll
      for (int d = 0; d < NDT; ++d) {
        const u16* vp = sV + (d * 16 + l16) * 72 + ks * 32 + q4 * 4;
        uint2 v0 = *(const uint2*)vp;
        uint2 v1 = *(const uint2*)(vp + 16);
        uint4 vu = make_uint4(v0.x, v0.y, v1.x, v1.y);
        bf16x8 vf = __builtin_bit_cast(bf16x8, vu);
        o[d] = MFMA16(vf, pf, o[d]);
      }
    }
  }
  l += shx(l, 16);
  l += shx(l, 32);
  const float inv = 1.f / l;
  const int row = qrow0 + qsub * 16 + l16;
  if constexpr (DIFF) {
    __syncthreads();
    float* sO = (float*)smem;
    if (var == 1) {
#pragma unroll
      for (int d = 0; d < NDT; ++d)
        *(float4*)(sO + (qsub * 16 + l16) * 132 + d * 16 + q4 * 4) =
            make_float4(o[d][0] * inv, o[d][1] * inv, o[d][2] * inv, o[d][3] * inv);
    }
    __syncthreads();
    if (var == 0) {
      float ss = 0.f;
#pragma unroll
      for (int d = 0; d < NDT; ++d) {
        float4 o1 = *(const float4*)(sO + (qsub * 16 + l16) * 132 + d * 16 + q4 * 4);
        o[d][0] = o[d][0] * inv - lam * o1.x;
        o[d][1] = o[d][1] * inv - lam * o1.y;
        o[d][2] = o[d][2] * inv - lam * o1.z;
        o[d][3] = o[d][3] * inv - lam * o1.w;
        ss += o[d][0] * o[d][0] + o[d][1] * o[d][1] + o[d][2] * o[d][2] + o[d][3] * o[d][3];
      }
      ss += shx(ss, 16);
      ss += shx(ss, 32);
      const float rs = rsqrtf(ss * (1.f / 128.f) + 1e-6f) * postscale;
#pragma unroll
      for (int d = 0; d < NDT; ++d) {
        float4 gg = *(const float4*)(subg + d * 16 + q4 * 4);
        uint2 ov;
        ov.x = pack2(o[d][0] * rs * gg.x, o[d][1] * rs * gg.y);
        ov.y = pack2(o[d][2] * rs * gg.z, o[d][3] * rs * gg.w);
        *(uint2*)(mixed + (size_t)row * 1024 + mixcol + d * 16 + q4 * 4) = ov;
      }
    }
  } else {
#pragma unroll
    for (int d = 0; d < NDT; ++d) {
      uint2 ov;
      ov.x = pack2(o[d][0] * inv, o[d][1] * inv);
      ov.y = pack2(o[d][2] * inv, o[d][3] * inv);
      *(uint2*)(mixed + (size_t)row * 1024 + mixcol + var * 64 + d * 16 + q4 * 4) = ov;
    }
  }
}

DI void attnA_item(const P& p, int li, int it, char* smem) {
  const int lane = threadIdx.x & 63;
  float d1 = p.in[14][li * 64 + lane] * p.in[15][li * 64 + lane];
  float d2 = p.in[16][li * 64 + lane] * p.in[17][li * 64 + lane];
#pragma unroll
  for (int s = 1; s < 64; s <<= 1) { d1 += shx(d1, s); d2 += shx(d2, s); }
  const float lam_init = 0.8f - 0.6f * expf(-0.3f * (float)li);
  const float lam = expf(d1) - expf(d2) + lam_init;
  const u16* QA = (const u16*)(p.ws + O_QA);
  u16* mixed = (u16*)(p.ws + O_MIXED);
  const float* subg = p.in[18] + li * 128;
  int qrow0, L;
  const u16 *Kb, *VT;
  int h;
  if (it < 256) {
    int b = it >> 7, qb = it & 31;
    h = (it >> 5) & 3;
    Kb = (const u16*)(p.ws + O_KALAT) + (size_t)(li * 2 + b) * 1536 * 512 + h * 128;
    VT = (const u16*)(p.ws + O_VTALAT) + (size_t)((li * 2 + b) * 4 + h) * 128 * 1536;
    qrow0 = NCTX + b * 1024 + qb * 32;
    L = 1536;
  } else {
    it -= 256;
    int b = it >> 5, qb = it & 7;
    h = (it >> 3) & 3;
    Kb = (const u16*)(p.ws + O_KACTX) + (size_t)b * 256 * 512 + h * 128;
    VT = (const u16*)(p.ws + O_VTACTX) + (size_t)(b * 4 + h) * 128 * 256;
    qrow0 = b * 256 + qb * 32;
    L = 256;
  }
  attn_item<128, 128, true>(QA, 512, h * 128, qrow0, Kb, 512, VT, L, L, mixed, h * 128, lam, 1.f - lam_init, subg, smem);
}
DI void attnC_item(const P& p, int li, int it, char* smem) {
  const u16* QC = (const u16*)(p.ws + O_QC);
  u16* mixed = (u16*)(p.ws + O_MIXED);
  int qrow0, L, n;
  const u16 *Kb, *VT;
  if (it < 128) {
    int b = it >> 6, qb = it & 31;
    n = (it >> 5) & 1;
    Kb = (const u16*)(p.ws + O_KCLAT) + (size_t)(li * 2 + b) * 1536 * 128 + n * 64;
    VT = (const u16*)(p.ws + O_VTCLAT) + (size_t)((li * 2 + b) * 2 + n) * 64 * 1536;
    qrow0 = NCTX + b * 1024 + qb * 32;
    L = 1536;
  } else {
    it -= 128;
    int b = it >> 4, qb = it & 7;
    n = (it >> 3) & 1;
    Kb = (const u16*)(p.ws + O_KCCTX) + (size_t)b * 256 * 128 + n * 64;
    VT = (const u16*)(p.ws + O_VTCCTX) + (size_t)(b * 2 + n) * 64 * 256;
    qrow0 = b * 256 + qb * 32;
    L = 256;
  }
  attn_item<64, 64, false>(QC, 256, n * 128, qrow0, Kb, 128, VT, L, L, mixed, 768 + n * 128, 0.f, 1.f, nullptr, smem);
}

DI void h1_item(const P& p, int item, char* smem) {
  const int tid = threadIdx.x;
  const int dir = item & 1, h = (item >> 1) & 3, tc = item >> 3;
  const int row0 = tc * 64;
  float* sQ = (float*)smem;
  float* sB = sQ + 64 * 68;
  float* sK = sB + 64 * 68;
  float* sV = sK + 64 * 68;
  float* sTot = sV + 64 * 64;
  const float* HQ = (const float*)(p.ws + O_HQ);
  const float* HG = (const float*)(p.ws + (dir ? O_HGB : O_HGF));
  const float* HI = (const float*)(p.ws + O_HI);
  float* OI = (float*)(p.ws + O_OI) + (size_t)dir * NTOK * 256;
  float* QE = (float*)(p.ws + O_QE) + (size_t)dir * NTOK * 256;
  float* KV = (float*)(p.ws + O_KV) + (size_t)item * 4096;
  float* DEC = (float*)(p.ws + O_DEC) + (size_t)item * 64;

  __syncthreads();
#pragma unroll
  for (int i = 0; i < 4; ++i) {
    int idx = tid + 256 * i;
    int lo = idx >> 4, c4 = idx & 15;
    int row = dir ? row0 + 63 - lo : row0 + lo;
    size_t off = (size_t)row * 256 + h * 64 + c4 * 4;
    *(float4*)(sQ + lo * 68 + c4 * 4) = *(const float4*)(HQ + off);
    *(float4*)(sB + lo * 68 + c4 * 4) = *(const float4*)(HG + off);
    *(float4*)(sV + lo * 64 + c4 * 4) = *(const float4*)(HI + off);
  }
  __syncthreads();
  {
    const int k = tid & 63, part = tid >> 6;
    float run = 0.f;
#pragma unroll 4
    for (int e = 0; e < 16; ++e) {
      int i = part * 16 + e;
      float g = sB[i * 68 + k];
      sK[i * 68 + k] = -expm1f(g);
      run += g * LOG2E;
      sB[i * 68 + k] = run;
    }
    sTot[part * 64 + k] = run;
    __syncthreads();
    float add = 0.f;
    for (int pp = 0; pp < part; ++pp) add += sTot[pp * 64 + k];
    if (part > 0)
      for (int e = 0; e < 16; ++e) sB[(part * 16 + e) * 68 + k] += add;
  }
  __syncthreads();
#pragma unroll
  for (int i = 0; i < 4; ++i) {
    int idx = tid + 256 * i;
    int lo = idx >> 4, c4 = idx & 15;
    int row = dir ? row0 + 63 - lo : row0 + lo;
    float4 q = *(const float4*)(sQ + lo * 68 + c4 * 4);
    float4 bb = *(const float4*)(sB + lo * 68 + c4 * 4);
    *(float4*)(QE + (size_t)row * 256 + h * 64 + c4 * 4) = make_float4(q.x * ex2(bb.x), q.y * ex2(bb.y), q.z * ex2(bb.z), q.w * ex2(bb.w));
  }
  const int ty = tid >> 4, tx = tid & 15;
  float at[4][4];
#pragma unroll
  for (int a = 0; a < 4; ++a)
#pragma unroll
    for (int cc = 0; cc < 4; ++cc) at[a][cc] = 0.f;
#pragma unroll 1
  for (int k = 0; k < 64; k += 4) {
    float4 qt[4], bt[4], ks[4], bs[4];
#pragma unroll
    for (int a = 0; a < 4; ++a) {
      qt[a] = *(const float4*)(sQ + (ty + 16 * a) * 68 + k);
      bt[a] = *(const float4*)(sB + (ty + 16 * a) * 68 + k);
      ks[a] = *(const float4*)(sK + (tx + 16 * a) * 68 + k);
      bs[a] = *(const float4*)(sB + (tx + 16 * a) * 68 + k);
    }
#pragma unroll
    for (int a = 0; a < 4; ++a)
#pragma unroll
      for (int cc = 0; cc <= a; ++cc) {
        float s = at[a][cc];
        s += qt[a].x * ks[cc].x * ex2(bt[a].x - bs[cc].x);
        s += qt[a].y * ks[cc].y * ex2(bt[a].y - bs[cc].y);
        s += qt[a].z * ks[cc].z * ex2(bt[a].z - bs[cc].z);
        s += qt[a].w * ks[cc].w * ex2(bt[a].w - bs[cc].w);
        at[a][cc] = s;
      }
  }
  __syncthreads();
  float* sA = sQ;
#pragma unroll
  for (int a = 0; a < 4; ++a)
#pragma unroll
    for (int cc = 0; cc < 4; ++cc) {
      float v = (cc < a) ? at[a][cc] : ((cc == a && tx <= ty) ? at[a][cc] : 0.f);
      sA[(ty + 16 * a) * 68 + tx + 16 * cc] = v;
    }
  __syncthreads();
  {
    float4 oa[4];
#pragma unroll
    for (int a = 0; a < 4; ++a) oa[a] = make_float4(0.f, 0.f, 0.f, 0.f);
#pragma unroll 1
    for (int s = 0; s < 64; s += 4) {
      float4 v0 = *(const float4*)(sV + (s + 0) * 64 + tx * 4);
      float4 v1 = *(const float4*)(sV + (s + 1) * 64 + tx * 4);
      float4 v2 = *(const float4*)(sV + (s + 2) * 64 + tx * 4);
      float4 v3 = *(const float4*)(sV + (s + 3) * 64 + tx * 4);
#pragma unroll
      for (int a = 0; a < 4; ++a) {
        float4 w = *(const float4*)(sA + (ty + 16 * a) * 68 + s);
        oa[a].x += w.x * v0.x + w.y * v1.x + w.z * v2.x + w.w * v3.x;
        oa[a].y += w.x * v0.y + w.y * v1.y + w.z * v2.y + w.w * v3.y;
        oa[a].z += w.x * v0.z + w.y * v1.z + w.z * v2.z + w.w * v3.z;
        oa[a].w += w.x * v0.w + w.y * v1.w + w.z * v2.w + w.w * v3.w;
      }
    }
#pragma unroll
    for (int a = 0; a < 4; ++a) {
      int t = ty + 16 * a;
      int row = dir ? row0 + 63 - t : row0 + t;
      *(float4*)(OI + (size_t)row * 256 + h * 64 + tx * 4) = oa[a];
    }
  }
  {
    float bend[4];
    float4 kva[4];
#pragma unroll
    for (int a = 0; a < 4; ++a) {
      bend[a] = sB[63 * 68 + ty + 16 * a];
      kva[a] = make_float4(0.f, 0.f, 0.f, 0.f);
    }
#pragma unroll 2
    for (int s = 0; s < 64; ++s) {
      float4 v = *(const float4*)(sV + s * 64 + tx * 4);
#pragma unroll
      for (int a = 0; a < 4; ++a) {
        int k = ty + 16 * a;
        float kd = sK[s * 68 + k] * ex2(bend[a] - sB[s * 68 + k]);
        kva[a].x += kd * v.x; kva[a].y += kd * v.y; kva[a].z += kd * v.z; kva[a].w += kd * v.w;
      }
    }
#pragma unroll
    for (int a = 0; a < 4; ++a) {
      int k = ty + 16 * a;
      *(float4*)(KV + k * 64 + tx * 4) = kva[a];
      if (tx == 0) DEC[k] = ex2(bend[a]);
    }
  }
}

DI void h2_item(const P& p, int li, int item, char* smem) {
  const int tid = threadIdx.x, ty = tid >> 4, tx = tid & 15;
  const int h = item & 3, tc = item >> 2, row0 = tc * 64;
  const bool lat = tc >= 64;
  int seq, cl, nc;
  if (!lat) { seq = tc >> 2; cl = tc & 3; nc = 4; } else { seq = (tc - 64) >> 4; cl = (tc - 64) & 15; nc = 16; }
  const int tcbase = tc - cl;
  float* sS = (float*)smem;
  float* sQE = sS + 4096;
  const float* KVb = (const float*)(p.ws + O_KV);
  const float* DECb = (const float*)(p.ws + O_DEC);
  float4 oa[4];
#pragma unroll
  for (int a = 0; a < 4; ++a) {
    size_t off = (size_t)(row0 + ty + 16 * a) * 256 + h * 64 + tx * 4;
    float4 x = *(const float4*)((const float*)(p.ws + O_OI) + off);
    float4 y = *(const float4*)((const float*)(p.ws + O_OI) + (size_t)NTOK * 256 + off);
    oa[a] = make_float4(x.x + y.x, x.y + y.y, x.z + y.z, x.w + y.w);
  }
#pragma unroll 1
  for (int dir = 0; dir < 2; ++dir) {
    float4 S[4];
#pragma unroll
    for (int a = 0; a < 4; ++a) {
      if (lat) S[a] = *(const float4*)(p.in[6 + dir] + ((size_t)((seq * 2 + li) * 4 + h) * 64 + ty + 16 * a) * 64 + tx * 4);
      else S[a] = make_float4(0.f, 0.f, 0.f, 0.f);
    }
    const int nprev = dir == 0 ? cl : nc - 1 - cl;
#pragma unroll 1
    for (int j = 0; j < nprev; ++j) {
      int tcj = tcbase + (dir == 0 ? j : nc - 1 - j);
      size_t itj = (size_t)((tcj * 4 + h) * 2 + dir);
#pragma unroll
      for (int a = 0; a < 4; ++a) {
        int k = ty + 16 * a;
        float dcy = DECb[itj * 64 + k];
        float4 kv = *(const float4*)(KVb + itj * 4096 + k * 64 + tx * 4);
        S[a].x = dcy * S[a].x + kv.x; S[a].y = dcy * S[a].y + kv.y; S[a].z = dcy * S[a].z + kv.z; S[a].w = dcy * S[a].w + kv.w;
      }
    }
    if (!lat && nprev == nc - 1) {
      size_t itj = (size_t)((tc * 4 + h) * 2 + dir);
      float* so = p.out + (dir == 0 ? OUT_SF : OUT_SB) + (size_t)((seq * 2 + li) * 4 + h) * 4096;
#pragma unroll
      for (int a = 0; a < 4; ++a) {
        int k = ty + 16 * a;
        float dcy = DECb[itj * 64 + k];
        float4 kv = *(const float4*)(KVb + itj * 4096 + k * 64 + tx * 4);
        *(float4*)(so + k * 64 + tx * 4) = make_float4(dcy * S[a].x + kv.x, dcy * S[a].y + kv.y, dcy * S[a].z + kv.z, dcy * S[a].w + kv.w);
      }
    }
    __syncthreads();
#pragma unroll
    for (int a = 0; a < 4; ++a) *(float4*)(sS + (ty + 16 * a) * 64 + tx * 4) = S[a];
    const float* QE = (const float*)(p.ws + O_QE) + (size_t)dir * NTOK * 256;
#pragma unroll
    for (int i = 0; i < 4; ++i) {
      int idx = tid + 256 * i;
      int t = idx >> 4, c4 = idx & 15;
      *(float4*)(sQE + t * 68 + c4 * 4) = *(const float4*)(QE + (size_t)(row0 + t) * 256 + h * 64 + c4 * 4);
    }
    __syncthreads();
#pragma unroll 1
    for (int k = 0; k < 64; k += 4) {
      float4 s0 = *(const float4*)(sS + (k + 0) * 64 + tx * 4);
      float4 s1 = *(const float4*)(sS + (k + 1) * 64 + tx * 4);
      float4 s2 = *(const float4*)(sS + (k + 2) * 64 + tx * 4);
      float4 s3 = *(const float4*)(sS + (k + 3) * 64 + tx * 4);
#pragma unroll
      for (int a = 0; a < 4; ++a) {
        float4 w = *(const float4*)(sQE + (ty + 16 * a) * 68 + k);
        oa[a].x += w.x * s0.x + w.y * s1.x + w.z * s2.x + w.w * s3.x;
        oa[a].y += w.x * s0.y + w.y * s1.y + w.z * s2.y + w.w * s3.y;
        oa[a].z += w.x * s0.z + w.y * s1.z + w.z * s2.z + w.w * s3.z;
        oa[a].w += w.x * s0.w + w.y * s1.w + w.z * s2.w + w.w * s3.w;
      }
    }
  }
  const float4 gn = *(const float4*)(p.in[21] + li * 64 + tx * 4);
  u16* mixed = (u16*)(p.ws + O_MIXED);
#pragma unroll
  for (int a = 0; a < 4; ++a) {
    float ss = oa[a].x * oa[a].x + oa[a].y * oa[a].y + oa[a].z * oa[a].z + oa[a].w * oa[a].w;
    ss += shx(ss, 1); ss += shx(ss, 2); ss += shx(ss, 4); ss += shx(ss, 8);
    float rs = rsqrtf(ss * (1.f / 64.f) + 1e-6f);
    int row = row0 + ty + 16 * a;
    float4 sg = *(const float4*)((const float*)(p.ws + O_HSG) + (size_t)row * 256 + h * 64 + tx * 4);
    uint2 ov;
    ov.x = pack2(oa[a].x * rs * gn.x * sg.x, oa[a].y * rs * gn.y * sg.y);
    ov.y = pack2(oa[a].z * rs * gn.z * sg.z, oa[a].w * rs * gn.w * sg.w);
    *(uint2*)(mixed + (size_t)row * 1024 + 512 + h * 64 + tx * 4) = ov;
  }
}

DI void final_ln(const P& p) {
  const int lane = threadIdx.x & 63, wid = threadIdx.x >> 6;
  const float* X = (const float*)(p.ws + O_XPRE2);
  const float* ST = (const float*)(p.ws + O_ST2);
  const float* g = p.in[26] + 1024;
  const float* bb = p.in[27] + 1024;
  for (int it = blockIdx.x; it < NTOK / 4; it += gridDim.x) {
    int row = it * 4 + wid;
    float s1 = 0.f, s2 = 0.f;
    if (lane < 16) {
      float2 v = *(const float2*)(ST + (size_t)row * 32 + lane * 2);
      s1 = v.x;
      s2 = v.y;
    }
#pragma unroll
    for (int s = 1; s < 16; s <<= 1) { s1 += shx(s1, s); s2 += shx(s2, s); }
    s1 = __shfl(s1, 0, 64);
    s2 = __shfl(s2, 0, 64);
    float mu = s1 * (1.f / 1024.f);
    float rs = rsqrtf(fmaxf(s2 * (1.f / 1024.f) - mu * mu, 0.f) + 1e-6f);
    float* out = p.out + (row < NCTX ? OUT_YP + (size_t)row * 1024 : OUT_YS + (size_t)(row - NCTX) * 1024);
#pragma unroll
    for (int i = 0; i < 4; ++i) {
      int c = (lane + 64 * i) * 4;
      float4 x = *(const float4*)(X + (size_t)row * 1024 + c);
      float4 gg = *(const float4*)(g + c);
      float4 b4 = *(const float4*)(bb + c);
      *(float4*)(out + c) = make_float4((x.x - mu) * rs * gg.x + b4.x, (x.y - mu) * rs * gg.y + b4.y,
                                         (x.z - mu) * rs * gg.z + b4.z, (x.w - mu) * rs * gg.w + b4.w);
    }
  }
}

DI void run_phase(const P& p, int ph, char* smem) {
  if (ph == 0) { phase0(p, smem); return; }
  if (ph == NPHASE - 1) { final_ln(p); return; }
  const int li = (ph - 1) / 6, s = (ph - 1) % 6;
  float* XPRE1 = (float*)(p.ws + O_XPRE1);
  float* XPRE2 = (float*)(p.ws + O_XPRE2);
  float* ST1 = (float*)(p.ws + O_ST1);
  float* ST2 = (float*)(p.ws + O_ST2);
  GA g;
  g.mods = (const float*)(p.ws + O_MODS) + li * 3 * 6144;
  g.a16 = nullptr; g.xout = nullptr; g.sout = nullptr; g.hid = nullptr;
  const float* xin_lo = li == 0 ? p.in[0] : XPRE2;
  const float* xin_hi = li == 0 ? p.in[1] : XPRE2 + (size_t)NCTX * 1024;
  const float* xin_st = li == 0 ? nullptr : ST2;
  const float* xin_g = p.in[26] + (li == 0 ? 0 : (li - 1) * 1024);
  const float* xin_b = p.in[27] + (li == 0 ? 0 : (li - 1) * 1024);
  if (s == 0) {
    g.alo = xin_lo; g.ahi = xin_hi; g.stats = xin_st; g.lng = xin_g; g.lnb = xin_b;
    g.sc_off = 1024; g.sh_off = 0;
    g.bt = (const u16*)(p.ws + O_WTIN) + (size_t)li * NIN * D; g.K = D; g.N = NIN;
    gemm_phase<1, 0>(p, g, li, smem);
  } else if (s == 1) {
    for (int it = blockIdx.x; it < 768 + 768; it += gridDim.x) {
      if (it >= 256 && it < 1024) h1_item(p, it - 256, smem);
      else attnA_item(p, li, it < 256 ? it : it - 768, smem);
    }
  } else if (s == 2) {
    for (int it = blockIdx.x; it < 384 + 384; it += gridDim.x) {
      if (it >= 128 && it < 512) h2_item(p, li, it - 128, smem);
      else attnC_item(p, li, it < 128 ? it : it - 384, smem);
    }
  } else if (s == 3) {
    g.alo = xin_lo; g.ahi = xin_hi; g.stats = xin_st; g.lng = xin_g; g.lnb = xin_b;
    g.sc_off = 2048; g.sh_off = 0;
    g.a16 = (const u16*)(p.ws + O_MIXED);
    g.bt = (const u16*)(p.ws + O_WTOUT) + (size_t)li * D * D; g.K = D; g.N = D;
    g.xout = XPRE1; g.sout = ST1;
    gemm_phase<0, 1>(p, g, li, smem);
  } else if (s == 4) {
    g.alo = XPRE1; g.ahi = XPRE1 + (size_t)NCTX * 1024; g.stats = ST1; g.lng = p.in[24] + li * 1024; g.lnb = p.in[25] + li * 1024;
    g.sc_off = 4096; g.sh_off = 3072;
    g.bt = (const u16*)(p.ws + O_WTFF1) + (size_t)li * DFF * D; g.K = D; g.N = DFF;
    g.hid = (u16*)(p.ws + O_HID);
    gemm_phase<1, 2>(p, g, li, smem);
  } else {
    g.alo = XPRE1; g.ahi = XPRE1 + (size_t)NCTX * 1024; g.stats = ST1; g.lng = p.in[24] + li * 1024; g.lnb = p.in[25] + li * 1024;
    g.sc_off = 5120; g.sh_off = 0;
    g.a16 = (const u16*)(p.ws + O_HID);
    g.bt = (const u16*)(p.ws + O_WTFF2) + (size_t)li * D * DFF; g.K = DFF; g.N = D;
    g.xout = XPRE2; g.sout = ST2;
    gemm_phase<0, 1>(p, g, li, smem);
  }
}

#if !MULTI_LAUNCH
__global__ void __launch_bounds__(256, 2) mega_kernel(P p) {
  extern __shared__ __attribute__((aligned(16))) char smem[];
  cg::grid_group grid = cg::this_grid();
  run_phase(p, 0, smem); grid.sync();
  run_phase(p, 1, smem); grid.sync();
  run_phase(p, 2, smem); grid.sync();
  run_phase(p, 3, smem); grid.sync();
  run_phase(p, 4, smem); grid.sync();
  run_phase(p, 5, smem); grid.sync();
  run_phase(p, 6, smem); grid.sync();
  run_phase(p, 7, smem); grid.sync();
  run_phase(p, 8, smem); grid.sync();
  run_phase(p, 9, smem); grid.sync();
  run_phase(p, 10, smem); grid.sync();
  run_phase(p, 11, smem); grid.sync();
  run_phase(p, 12, smem); grid.sync();
  run_phase(p, 13, smem);
}
#define MAIN_KERNEL mega_kernel
#else
__global__ void __launch_bounds__(256, 2) phase_kernel(P p, int ph) {
  extern __shared__ __attribute__((aligned(16))) char smem[];
  run_phase(p, ph, smem);
}
#define MAIN_KERNEL phase_kernel
#endif

extern "C" void kernel_launch(void* const* d_in, const int* in_sizes, int n_in, void* d_out, int out_size, void* d_ws,
                              size_t ws_size, hipStream_t stream) {
  static int grid_blocks = 0;
  if (!grid_blocks) {
    int dev = 0, cus = 0, per_cu = 0;
    (void)hipGetDevice(&dev);
    (void)hipDeviceGetAttribute(&cus, hipDeviceAttributeMultiprocessorCount, dev);
    (void)hipFuncSetAttribute((const void*)MAIN_KERNEL, hipFuncAttributeMaxDynamicSharedMemorySize, LDS_BYTES);
    (void)hipOccupancyMaxActiveBlocksPerMultiprocessor(&per_cu, MAIN_KERNEL, 256, LDS_BYTES);
    if (per_cu > 2) per_cu = 2;
    if (per_cu < 1) per_cu = 1;
    grid_blocks = cus * per_cu;
  }
  P p{};
  for (int i = 0; i < 30; ++i) p.in[i] = (const float*)d_in[i];
  p.out = (float*)d_out;
  p.ws = (char*)d_ws;
#if MULTI_LAUNCH
  for (int ph = 0; ph < NPHASE; ++ph) phase_kernel<<<dim3(grid_blocks), dim3(256), LDS_BYTES, stream>>>(p, ph);
#else
  void* args[] = {&p};
  hipError_t e = hipLaunchCooperativeKernel((void*)mega_kernel, dim3(grid_blocks), dim3(256), args, LDS_BYTES, stream);
  if (e != hipSuccess) fprintf(stderr, "cooperative launch failed: %s (grid %d)\n", hipGetErrorString(e), grid_blocks);
#endif
}
```

```cpp
#include <hip/hip_runtime.h>
#include <hip/hip_cooperative_groups.h>
#include <stdint.h>
#include <stdio.h>
namespace cg = cooperative_groups;

#ifndef MULTI_LAUNCH
#define MULTI_LAUNCH 0
#endif

#define DI __device__ __forceinline__
typedef unsigned short u16;
using bf16x8 = __attribute__((ext_vector_type(8))) short;
using f32x4 = __attribute__((ext_vector_type(4))) float;
typedef __bf16 bf2_t __attribute__((ext_vector_type(2)));
typedef float f2_t __attribute__((ext_vector_type(2)));

constexpr int D = 1024, NTOK = 6144, NCTX = 4096, NIN = 3328, DFF = 4096;
constexpr float ALPHA = 1.41421356237309515f;
constexpr float LOG2E = 1.44269504088896341f;
constexpr int LDS_BYTES = 71680;
constexpr int NPHASE = 14;

constexpr size_t O_WTIN = 0;
constexpr size_t O_WTOUT = O_WTIN + (size_t)2 * NIN * D * 2;
constexpr size_t O_WTFF1 = O_WTOUT + (size_t)2 * D * D * 2;
constexpr size_t O_WTFF2 = O_WTFF1 + (size_t)2 * DFF * D * 2;
constexpr size_t O_MODS = O_WTFF2 + (size_t)2 * D * DFF * 2;
constexpr size_t O_ROPE = O_MODS + (size_t)2 * 3 * 6144 * 4;
constexpr size_t O_QA = O_ROPE + (size_t)1024 * 32 * 2 * 4;
constexpr size_t O_KACTX = O_QA + (size_t)NTOK * 512 * 2;
constexpr size_t O_KALAT = O_KACTX + (size_t)NCTX * 512 * 2;
constexpr size_t O_VTACTX = O_KALAT + (size_t)2 * 2 * 1536 * 512 * 2;
constexpr size_t O_VTALAT = O_VTACTX + (size_t)16 * 4 * 128 * 256 * 2;
constexpr size_t O_QC = O_VTALAT + (size_t)2 * 2 * 4 * 128 * 1536 * 2;
constexpr size_t O_KCCTX = O_QC + (size_t)NTOK * 256 * 2;
constexpr size_t O_KCLAT = O_KCCTX + (size_t)NCTX * 128 * 2;
constexpr size_t O_VTCCTX = O_KCLAT + (size_t)2 * 2 * 1536 * 128 * 2;
constexpr size_t O_VTCLAT = O_VTCCTX + (size_t)16 * 2 * 64 * 256 * 2;
constexpr size_t O_KV = O_VTCLAT + (size_t)2 * 2 * 2 * 64 * 1536 * 2;
constexpr size_t O_DEC = O_KV + (size_t)768 * 4096 * 4;
constexpr size_t O_MIXED = O_DEC + (size_t)768 * 64 * 4;
constexpr size_t O_XPRE1 = O_MIXED + (size_t)NTOK * 1024 * 2;
constexpr size_t O_ST1 = O_XPRE1 + (size_t)NTOK * 1024 * 4;
constexpr size_t O_XPRE2 = O_ST1 + (size_t)NTOK * 32 * 4;
constexpr size_t O_ST2 = O_XPRE2 + (size_t)NTOK * 1024 * 4;
constexpr size_t O_HQ = O_ST2 + (size_t)NTOK * 32 * 4;
constexpr size_t O_HGF = O_HQ + (size_t)NTOK * 256 * 4;
constexpr size_t O_HGB = O_HGF + (size_t)NTOK * 256 * 4;
constexpr size_t O_HI = O_HGB + (size_t)NTOK * 256 * 4;
constexpr size_t O_HSG = O_HI + (size_t)NTOK * 256 * 4;
constexpr size_t O_OI = O_HSG + (size_t)NTOK * 256 * 4;
constexpr size_t O_QE = O_OI + (size_t)2 * NTOK * 256 * 4;
constexpr size_t O_END1 = O_QE + (size_t)2 * NTOK * 256 * 4;
constexpr size_t O_HID = O_HQ;
constexpr size_t O_END2 = O_HID + (size_t)NTOK * 4096 * 2;
static_assert(O_END2 <= O_END1, "HID alias must fit");
static_assert(O_END1 <= (size_t)256 * 1024 * 1024, "workspace too big");

constexpr size_t OUT_YP = 0, OUT_YS = 4194304, OUT_AK = 6291456, OUT_AV = 10485760, OUT_CK = 14680064,
                 OUT_CV = 15728640, OUT_SF = 16777216, OUT_SB = 17301504;

struct P {
  const float* in[30];
  float* out;
  char* ws;
};

DI unsigned pack2(float a, float b) {
  f2_t v = {a, b};
  bf2_t r = __builtin_convertvector(v, bf2_t);
  return __builtin_bit_cast(unsigned, r);
}
DI u16 f2bf(float x) { return (u16)(pack2(x, 0.f) & 0xffffu); }
DI float ex2(float x) { return __builtin_amdgcn_exp2f(x); }
DI float siluf(float x) { return x / (1.f + expf(-x)); }
DI float shx(float v, int m) { return __shfl_xor(v, m, 64); }
#define MFMA16(a, b, c) __builtin_amdgcn_mfma_f32_16x16x32_bf16((a), (b), (c), 0, 0, 0)

DI void p0_mod(const P& p, int item, char* smem) {
  float* ssilu = (float*)smem;
  float* red = ssilu + 3072;
  const int tid = threadIdx.x;
  __syncthreads();
  for (int i = tid; i < 3072; i += 256) {
    int w = i >> 10, k = i & 1023;
    float v = (w == 0) ? p.in[9][k] : p.in[8][(w - 1) * 1024 + k];
    ssilu[i] = siluf(v);
  }
  __syncthreads();
  const int li = item / 96, j0 = (item % 96) * 64;
  const int c4 = tid & 15, kp = tid >> 4;
  const float* W = p.in[10] + (size_t)li * 1024 * 6144 + j0 + c4 * 4;
  float4 a0 = {0, 0, 0, 0}, a1 = a0, a2 = a0;
#pragma unroll 4
  for (int kk = 0; kk < 64; ++kk) {
    int k = kp * 64 + kk;
    float4 w4 = *(const float4*)(W + (size_t)k * 6144);
    float s0 = ssilu[k], s1 = ssilu[1024 + k], s2 = ssilu[2048 + k];
    a0.x += s0 * w4.x; a0.y += s0 * w4.y; a0.z += s0 * w4.z; a0.w += s0 * w4.w;
    a1.x += s1 * w4.x; a1.y += s1 * w4.y; a1.z += s1 * w4.z; a1.w += s1 * w4.w;
    a2.x += s2 * w4.x; a2.y += s2 * w4.y; a2.z += s2 * w4.z; a2.w += s2 * w4.w;
  }
  *(float4*)(red + (kp * 3 + 0) * 64 + c4 * 4) = a0;
  *(float4*)(red + (kp * 3 + 1) * 64 + c4 * 4) = a1;
  *(float4*)(red + (kp * 3 + 2) * 64 + c4 * 4) = a2;
  __syncthreads();
  if (tid < 192) {
    int w = tid >> 6, c = tid & 63;
    float s = p.in[11][li * 6144 + j0 + c];
    for (int q = 0; q < 16; ++q) s += red[(q * 3 + w) * 64 + c];
    ((float*)(p.ws + O_MODS))[(li * 3 + w) * 6144 + j0 + c] = s;
  }
}

DI void p0_rope(const P& p, int item) {
  float* R = (float*)(p.ws + O_ROPE);
  for (int i = threadIdx.x; i < 4096; i += 256) {
    int idx = item * 4096 + i;
    int t = idx >> 5, pp = idx & 31;
    float inv = powf(10000.f, -(float)(pp & 15) / 16.f);
    float pos = (pp < 16) ? (float)(t >> 6) : (float)(t & 63);
    float ang = pos * inv;
    R[idx * 2] = cosf(ang);
    R[idx * 2 + 1] = sinf(ang);
  }
}

DI void p0_copyk(const P& p, int item, bool isA) {
  const int W = isA ? 512 : 128;
  const float* src = isA ? p.in[2] : p.in[4];
  u16* dst = (u16*)(p.ws + (isA ? O_KALAT : O_KCLAT));
  for (int i = 0; i < 4; ++i) {
    size_t e = (size_t)item * 4096 + (size_t)(threadIdx.x + 256 * i) * 4;
    float4 v = *(const float4*)(src + e);
    int c = (int)(e % W);
    size_t r = e / W;
    int pp = (int)(r % 512);
    int bl = (int)(r / 512);
    int b = bl >> 1, li = bl & 1;
    uint2 o;
    o.x = pack2(v.x, v.y);
    o.y = pack2(v.z, v.w);
    *(uint2*)(dst + ((size_t)((li * 2 + b) * 1536 + 1024 + pp)) * W + c) = o;
  }
}

DI void transpose_tile(const float* src, int sstride, u16* dst, int dstride, char* smem) {
  float* t = (float*)smem;
  const int tid = threadIdx.x;
  __syncthreads();
#pragma unroll
  for (int i = 0; i < 4; ++i) {
    int idx = tid + 256 * i;
    int r = idx >> 4, c4 = idx & 15;
    float4 v = *(const float4*)(src + (size_t)r * sstride + c4 * 4);
    float* q = t + r * 65 + c4 * 4;
    q[0] = v.x; q[1] = v.y; q[2] = v.z; q[3] = v.w;
  }
  __syncthreads();
  const int c = tid >> 2, rs = tid & 3;
  unsigned o[8];
#pragma unroll
  for (int e = 0; e < 8; ++e) {
    float a = t[(rs * 16 + 2 * e) * 65 + c], b = t[(rs * 16 + 2 * e + 1) * 65 + c];
    o[e] = pack2(a, b);
  }
  uint4* dp = (uint4*)(dst + (size_t)c * dstride + rs * 16);
  dp[0] = make_uint4(o[0], o[1], o[2], o[3]);
  dp[1] = make_uint4(o[4], o[5], o[6], o[7]);
}

DI void phase0(const P& p, char* smem) {
  constexpr int N_MOD = 192, N_ROPE = 8, N_AK = 256, N_CK = 64;
  constexpr int T_IN = 1664, T_OUT = 512, T_FF1 = 2048, T_FF2 = 2048, T_AV = 256, T_CV = 64;
  constexpr int B_ROPE = N_MOD, B_AK = B_ROPE + N_ROPE, B_CK = B_AK + N_AK, B_T = B_CK + N_CK;
  constexpr int TOTAL = B_T + T_IN + T_OUT + T_FF1 + T_FF2 + T_AV + T_CV;
  for (int it = blockIdx.x; it < TOTAL; it += gridDim.x) {
    if (it < B_ROPE) p0_mod(p, it, smem);
    else if (it < B_AK) p0_rope(p, it - B_ROPE);
    else if (it < B_CK) p0_copyk(p, it - B_AK, true);
    else if (it < B_T) p0_copyk(p, it - B_CK, false);
    else {
      int t = it - B_T;
      if (t < T_IN) {
        int li = t / 832, r = t % 832, kt = r / 52, nt = r % 52;
        transpose_tile(p.in[12] + (size_t)li * 1024 * NIN + (size_t)(kt * 64) * NIN + nt * 64, NIN,
                       (u16*)(p.ws + O_WTIN) + (size_t)li * NIN * 1024 + (size_t)(nt * 64) * 1024 + kt * 64, 1024, smem);
      } else if ((t -= T_IN) < T_OUT) {
        int li = t / 256, r = t % 256, kt = r / 16, nt = r % 16;
        transpose_tile(p.in[13] + (size_t)li * 1024 * 1024 + (size_t)(kt * 64) * 1024 + nt * 64, 1024,
                       (u16*)(p.ws + O_WTOUT) + (size_t)li * 1024 * 1024 + (size_t)(nt * 64) * 1024 + kt * 64, 1024, smem);
      } else if ((t -= T_OUT) < T_FF1) {
        int li = t / 1024, r = t % 1024, kt = r / 64, nt = r % 64;
        transpose_tile(p.in[28] + (size_t)li * 1024 * DFF + (size_t)(kt * 64) * DFF + nt * 64, DFF,
                       (u16*)(p.ws + O_WTFF1) + (size_t)li * DFF * 1024 + (size_t)(nt * 64) * 1024 + kt * 64, 1024, smem);
      } else if ((t -= T_FF1) < T_FF2) {
        int li = t / 1024, r = t % 1024, kt = r / 16, nt = r % 16;
        transpose_tile(p.in[29] + (size_t)li * DFF * 1024 + (size_t)(kt * 64) * 1024 + nt * 64, 1024,
                       (u16*)(p.ws + O_WTFF2) + (size_t)li * 1024 * DFF + (size_t)(nt * 64) * DFF + kt * 64, DFF, smem);
      } else if ((t -= T_FF2) < T_AV) {
        int bl = t / 64, r = t % 64, pt = r / 8, ct = r % 8;
        int b = bl >> 1, li = bl & 1;
        transpose_tile(p.in[3] + ((size_t)bl * 512 + pt * 64) * 512 + ct * 64, 512,
                       (u16*)(p.ws + O_VTALAT) + ((size_t)(li * 2 + b) * 512 + ct * 64) * 1536 + 1024 + pt * 64, 1536, smem);
      } else {
        t -= T_AV;
        int bl = t / 16, r = t % 16, pt = r / 2, ct = r % 2;
        int b = bl >> 1, li = bl & 1;
        transpose_tile(p.in[5] + ((size_t)bl * 512 + pt * 64) * 128 + ct * 64, 128,
                       (u16*)(p.ws + O_VTCLAT) + ((size_t)(li * 2 + b) * 128 + ct * 64) * 1536 + 1024 + pt * 64, 1536, smem);
      }
    }
  }
}

struct GA {
  const float* alo;
  const float* ahi;
  const float* stats;
  const float* lng;
  const float* lnb;
  const float* mods;
  int sc_off, sh_off;
  const u16* a16;
  const u16* bt;
  int K, N;
  float* xout;
  float* sout;
  u16* hid;
};

DI void epi_inproj(const P& p, int li, f32x4 (&acc)[4][4], int R0, int C0);

typedef unsigned u32x4 __attribute__((ext_vector_type(4)));
typedef unsigned u32x2 __attribute__((ext_vector_type(2)));

template <int AMODE>
DI void g_load(const GA& g, const float* fsrc, const float* modv, int m0, int n0, int K, int k0, int tid, u32x4 (&breg)[4],
               u32x4 (&areg)[4], f32x4 (&freg)[8], f32x4& cG, f32x4& cB) {
  const unsigned boff = (unsigned)(tid >> 3) * (unsigned)K + (unsigned)(tid & 7) * 8u;
#pragma unroll
  for (int i = 0; i < 4; ++i) {
    const u16* bb = g.bt + (size_t)(n0 + 32 * i) * K + k0;
    breg[i] = *(const u32x4*)(bb + boff);
  }
  if constexpr (AMODE == 0) {
#pragma unroll
    for (int i = 0; i < 4; ++i) {
      const u16* ab = g.a16 + (size_t)(m0 + 32 * i) * K + k0;
      areg[i] = *(const u32x4*)(ab + boff);
    }
  } else {
    const int col = k0 + (tid & 15) * 4;
    const unsigned aoff = (unsigned)(tid >> 4) * 1024u + (unsigned)(tid & 15) * 4u;
#pragma unroll
    for (int i = 0; i < 8; ++i) {
      const float* ab = fsrc + (size_t)(16 * i) * 1024 + k0;
      freg[i] = *(const f32x4*)(ab + aoff);
    }
    f32x4 sc = *(const f32x4*)(modv + g.sc_off + col);
    f32x4 sh = *(const f32x4*)(modv + g.sh_off + col);
    sc = sc + 1.f;
    if (g.stats != nullptr) {
      f32x4 gg = *(const f32x4*)(g.lng + col);
      f32x4 bb = *(const f32x4*)(g.lnb + col);
      cG = gg * sc;
      cB = bb * sc + sh;
    } else {
      cG = sc;
      cB = sh;
    }
  }
}

template <int AMODE>
DI void g_store(bool hasStats, u16* sA, u16* sB, const float2* sStat, int tid, const u32x4 (&breg)[4], const u32x4 (&areg)[4],
                const f32x4 (&freg)[8], const f32x4& cG, const f32x4& cB) {
#pragma unroll
  for (int i = 0; i < 4; ++i) {
    int idx = tid + 256 * i;
    int row = idx >> 3, c8 = idx & 7;
    *(u32x4*)(sB + row * 72 + c8 * 8) = breg[i];
  }
  if constexpr (AMODE == 0) {
#pragma unroll
    for (int i = 0; i < 4; ++i) {
      int idx = tid + 256 * i;
      int row = idx >> 3, c8 = idx & 7;
      *(u32x4*)(sA + row * 72 + c8 * 8) = areg[i];
    }
  } else {
#pragma unroll
    for (int i = 0; i < 8; ++i) {
      int row = (tid >> 4) + 16 * i;
      float mu = 0.f, rs = 1.f;
      if (hasStats) {
        float2 st = sStat[row];
        mu = st.x;
        rs = st.y;
      }
      f32x4 hv = (freg[i] - mu) * rs * cG + cB;
      u32x2 o;
      o.x = pack2(hv.x, hv.y);
      o.y = pack2(hv.z, hv.w);
      *(u32x2*)(sA + row * 72 + (tid & 15) * 4) = o;
    }
  }
}

template <int AMODE, int EPI>
DI void gemm_tile(const P& p, const GA& g, int li, int m0, int n0, char* smem) {
  const int tid = threadIdx.x, lane = tid & 63, wid = tid >> 6, wr = wid >> 1, wc = wid & 1;
  const int l16 = lane & 15, q4 = lane >> 4;
  u16* sA = (u16*)smem;
  u16* sB = sA + 128 * 72;
  float2* sStat = (float2*)(smem + 36864);
  const int K = g.K;
  const int rtype = (m0 < NCTX) ? 0 : 1 + ((m0 - NCTX) >> 10);
  const float* modv = g.mods + rtype * 6144;
  const float* fsrc = (m0 < NCTX) ? g.alo + (size_t)m0 * 1024 : g.ahi + (size_t)(m0 - NCTX) * 1024;

  __syncthreads();
  if (g.stats != nullptr && tid < 128) {
    const float4* sp = (const float4*)(g.stats + (size_t)(m0 + tid) * 32);
    float s1 = 0.f, s2 = 0.f;
#pragma unroll
    for (int i = 0; i < 8; ++i) {
      float4 v = sp[i];
      s1 += v.x + v.z;
      s2 += v.y + v.w;
    }
    float mu = s1 * (1.f / 1024.f);
    float var = s2 * (1.f / 1024.f) - mu * mu;
    sStat[tid] = make_float2(mu, rsqrtf(fmaxf(var, 0.f) + 1e-6f));
  }

  f32x4 acc[4][4];
#pragma unroll
  for (int i = 0; i < 4; ++i)
#pragma unroll
    for (int j = 0; j < 4; ++j) acc[i][j] = f32x4{0.f, 0.f, 0.f, 0.f};

  u32x4 breg[4];
  u32x4 areg[4];
  f32x4 freg[8];
  f32x4 cG = {1.f, 1.f, 1.f, 1.f}, cB = {0.f, 0.f, 0.f, 0.f};
  const int nk = K >> 6;
  g_load<AMODE>(g, fsrc, modv, m0, n0, K, 0, tid, breg, areg, freg, cG, cB);
  for (int kt = 0; kt < nk; ++kt) {
    __syncthreads();
    g_store<AMODE>(g.stats != nullptr, sA, sB, sStat, tid, breg, areg, freg, cG, cB);
    __syncthreads();
    if (kt + 1 < nk) g_load<AMODE>(g, fsrc, modv, m0, n0, K, (kt + 1) << 6, tid, breg, areg, freg, cG, cB);
#pragma unroll
    for (int s = 0; s < 2; ++s) {
      bf16x8 af[4], bfr[4];
#pragma unroll
      for (int i = 0; i < 4; ++i) {
        af[i] = *(const bf16x8*)(sA + (wr * 64 + i * 16 + l16) * 72 + s * 32 + q4 * 8);
        bfr[i] = *(const bf16x8*)(sB + (wc * 64 + i * 16 + l16) * 72 + s * 32 + q4 * 8);
      }
#pragma unroll
      for (int i = 0; i < 4; ++i)
#pragma unroll
        for (int j = 0; j < 4; ++j) acc[i][j] = MFMA16(af[i], bfr[j], acc[i][j]);
    }
  }

  const int R0 = m0 + wr * 64, C0 = n0 + wc * 64;
  if constexpr (EPI == 0) {
    epi_inproj(p, li, acc, R0, C0);
  } else if constexpr (EPI == 1) {
    float gate[4], lg[4], lb[4];
#pragma unroll
    for (int j = 0; j < 4; ++j) {
      int col = C0 + j * 16 + l16;
      gate[j] = modv[g.sc_off + col];
      lg[j] = g.stats ? g.lng[col] : 1.f;
      lb[j] = g.stats ? g.lnb[col] : 0.f;
    }
#pragma unroll
    for (int i = 0; i < 4; ++i) {
#pragma unroll
      for (int r = 0; r < 4; ++r) {
        int lrow = wr * 64 + i * 16 + q4 * 4 + r;
        float mu = 0.f, rs = 1.f;
        if (g.stats != nullptr) {
          float2 st = sStat[lrow];
          mu = st.x;
          rs = st.y;
        }
        float s1 = 0.f, s2 = 0.f;
#pragma unroll
        for (int j = 0; j < 4; ++j) {
          int col = C0 + j * 16 + l16;
          float x = fsrc[(size_t)lrow * 1024 + col];
          x = (x - mu) * rs * lg[j] + lb[j];
          float v = ALPHA * x + gate[j] * acc[i][j][r];
          g.xout[(size_t)(m0 + lrow) * 1024 + col] = v;
          s1 += v;
          s2 += v * v;
        }
        s1 += shx(s1, 1); s2 += shx(s2, 1);
        s1 += shx(s1, 2); s2 += shx(s2, 2);
        s1 += shx(s1, 4); s2 += shx(s2, 4);
        s1 += shx(s1, 8); s2 += shx(s2, 8);
        if (l16 == 0) *(float2*)(g.sout + (size_t)(m0 + lrow) * 32 + (C0 >> 6) * 2) = make_float2(s1, s2);
      }
    }
  } else {
#pragma unroll
    for (int i = 0; i < 4; ++i)
#pragma unroll
      for (int r = 0; r < 4; ++r) {
        int row = R0 + i * 16 + q4 * 4 + r;
#pragma unroll
        for (int j = 0; j < 4; ++j) {
          float v = fmaxf(acc[i][j][r], 0.f);
          g.hid[(size_t)row * DFF + C0 + j * 16 + l16] = f2bf(v * v);
        }
      }
  }
}

DI void epi_inproj(const P& p, int li, f32x4 (&acc)[4][4], int R0, int C0) {
  const int lane = threadIdx.x & 63, l16 = lane & 15, q4 = lane >> 4;
  const int seg = C0 >> 6;
  const bool lat = R0 >= NCTX;
  const float2* rope = (const float2*)(p.ws + O_ROPE);
  int b, tb;
  if (!lat) { b = R0 >> 8; tb = R0 & 255; } else { b = (R0 - NCTX) >> 10; tb = (R0 - NCTX) & 1023; }

  enum { T_QA, T_KA, T_VA, T_QB, T_FF, T_FB, T_IB, T_GB, T_QC, T_KC, T_VC };
  int type, cbase;
  if (seg < 8) { type = T_QA; cbase = seg * 64; }
  else if (seg < 16) { type = T_KA; cbase = (seg - 8) * 64; }
  else if (seg < 24) { type = T_VA; cbase = (seg - 16) * 64; }
  else if (seg < 28) { type = T_QB; cbase = (seg - 24) * 64; }
  else if (seg < 32) { type = T_FF; cbase = (seg - 28) * 64; }
  else if (seg < 36) { type = T_FB; cbase = (seg - 32) * 64; }
  else if (seg < 40) { type = T_IB; cbase = (seg - 36) * 64; }
  else if (seg < 44) { type = T_GB; cbase = (seg - 40) * 64; }
  else if (seg < 48) { type = T_QC; cbase = (seg - 44) * 64; }
  else if (seg < 50) { type = T_KC; cbase = (seg - 48) * 64; }
  else { type = T_VC; cbase = (seg - 50) * 64; }

  if (type == T_QC || type == T_KC) {
    const float* gv = (type == T_QC ? p.in[22] : p.in[23]) + li * 64;
    float gj[4];
#pragma unroll
    for (int j = 0; j < 4; ++j) gj[j] = gv[j * 16 + l16];
#pragma unroll
    for (int i = 0; i < 4; ++i)
#pragma unroll
      for (int r = 0; r < 4; ++r) {
        float ss = 0.f;
#pragma unroll
        for (int j = 0; j < 4; ++j) ss += acc[i][j][r] * acc[i][j][r];
        ss += shx(ss, 1); ss += shx(ss, 2); ss += shx(ss, 4); ss += shx(ss, 8);
        float rs = rsqrtf(ss * (1.f / 64.f) + 1e-6f);
#pragma unroll
        for (int j = 0; j < 4; ++j) acc[i][j][r] = acc[i][j][r] * rs * gj[j];
      }
  }
  if (!lat && (type == T_KA || type == T_VA || type == T_KC || type == T_VC)) {
    float* o;
    int W;
    if (type == T_KA) { o = p.out + OUT_AK; W = 512; }
    else if (type == T_VA) { o = p.out + OUT_AV; W = 512; }
    else if (type == T_KC) { o = p.out + OUT_CK; W = 128; }
    else { o = p.out + OUT_CV; W = 128; }
#pragma unroll
    for (int i = 0; i < 4; ++i)
#pragma unroll
      for (int r = 0; r < 4; ++r) {
        int t = tb + i * 16 + q4 * 4 + r;
        size_t base = ((size_t)(b * 2 + li) * 256 + t) * W + cbase;
#pragma unroll
        for (int j = 0; j < 4; ++j) o[base + j * 16 + l16] = acc[i][j][r];
      }
  }
  if (lat && (type == T_QA || type == T_KA || type == T_QC || type == T_KC)) {
#pragma unroll
    for (int i = 0; i < 4; ++i)
#pragma unroll
      for (int r = 0; r < 4; ++r) {
        int t = tb + i * 16 + q4 * 4 + r;
#pragma unroll
        for (int j = 0; j < 4; ++j) {
          float v = acc[i][j][r];
          float pv = shx(v, 1);
          float2 cs = rope[t * 32 + j * 8 + (l16 >> 1)];
          acc[i][j][r] = (l16 & 1) ? (pv * cs.y + v * cs.x) : (v * cs.x - pv * cs.y);
        }
      }
  }

  if (type == T_QA || type == T_KA || type == T_QC || type == T_KC) {
    u16* dst;
    int W;
    size_t rowbase;
    if (type == T_QA) { dst = (u16*)(p.ws + O_QA); W = 512; rowbase = (size_t)R0 * 512; }
    else if (type == T_QC) { dst = (u16*)(p.ws + O_QC); W = 256; rowbase = (size_t)R0 * 256; }
    else if (type == T_KA) {
      W = 512;
      if (!lat) { dst = (u16*)(p.ws + O_KACTX); rowbase = (size_t)R0 * 512; }
      else { dst = (u16*)(p.ws + O_KALAT); rowbase = ((size_t)(li * 2 + b) * 1536 + tb) * 512; }
    } else {
      W = 128;
      if (!lat) { dst = (u16*)(p.ws + O_KCCTX); rowbase = (size_t)R0 * 128; }
      else { dst = (u16*)(p.ws + O_KCLAT); rowbase = ((size_t)(li * 2 + b) * 1536 + tb) * 128; }
    }
#pragma unroll
    for (int i = 0; i < 4; ++i)
#pragma unroll
      for (int r = 0; r < 4; ++r) {
        size_t base = rowbase + (size_t)(i * 16 + q4 * 4 + r) * W + cbase;
#pragma unroll
        for (int j = 0; j < 4; ++j) dst[base + j * 16 + l16] = f2bf(acc[i][j][r]);
      }
  } else if (type == T_VA || type == T_VC) {
    u16* dst;
    int L;
    size_t hb;
    if (type == T_VA) {
      int h = cbase >> 7, dv0 = cbase & 127;
      if (!lat) { dst = (u16*)(p.ws + O_VTACTX); L = 256; hb = ((size_t)(b * 4 + h) * 128 + dv0) * 256; }
      else { dst = (u16*)(p.ws + O_VTALAT); L = 1536; hb = ((size_t)((li * 2 + b) * 4 + h) * 128 + dv0) * 1536; }
    } else {
      int n = cbase >> 6;
      if (!lat) { dst = (u16*)(p.ws + O_VTCCTX); L = 256; hb = ((size_t)(b * 2 + n) * 64) * 256; }
      else { dst = (u16*)(p.ws + O_VTCLAT); L = 1536; hb = ((size_t)((li * 2 + b) * 2 + n) * 64) * 1536; }
    }
#pragma unroll
    for (int i = 0; i < 4; ++i)
#pragma unroll
      for (int j = 0; j < 4; ++j) {
        uint2 o;
        o.x = pack2(acc[i][j][0], acc[i][j][1]);
        o.y = pack2(acc[i][j][2], acc[i][j][3]);
        *(uint2*)(dst + hb + (size_t)(j * 16 + l16) * L + tb + i * 16 + q4 * 4) = o;
      }
  } else {
    float* dst;
    if (type == T_QB) dst = (float*)(p.ws + O_HQ);
    else if (type == T_FF) dst = (float*)(p.ws + O_HGF);
    else if (type == T_FB) dst = (float*)(p.ws + O_HGB);
    else if (type == T_IB) dst = (float*)(p.ws + O_HI);
    else dst = (float*)(p.ws + O_HSG);
    float lbv[4] = {0.f, 0.f, 0.f, 0.f};
    if ((type == T_FF || type == T_FB) && li == 1) {
      const float* lg = (type == T_FF) ? p.in[19] : p.in[20];
#pragma unroll
      for (int j = 0; j < 4; ++j) {
        int c = cbase + j * 16 + l16;
        lbv[j] = 1.f / (1.f + expf(lg[c] - lg[256 + c]));
      }
    }
#pragma unroll
    for (int i = 0; i < 4; ++i)
#pragma unroll
      for (int r = 0; r < 4; ++r) {
        size_t base = (size_t)(R0 + i * 16 + q4 * 4 + r) * 256 + cbase;
#pragma unroll
        for (int j = 0; j < 4; ++j) {
          float v = acc[i][j][r];
          float o;
          if (type == T_QB || type == T_GB) o = siluf(v);
          else if (type == T_IB) o = v;
          else {
            float sg = 1.f / (1.f + expf(-v));
            float f = lbv[j] + (1.f - lbv[j]) * sg;
            o = logf(fmaxf(f, 1e-6f));
          }
          dst[base + j * 16 + l16] = o;
        }
      }
  }
}

template <int AMODE, int EPI>
DI void gemm_phase(const P& p, const GA& g, int li, char* smem) {
  const int NT = g.N >> 7;
  const int xcd = blockIdx.x & 7, lb = blockIdx.x >> 3, nlb = gridDim.x >> 3;
  if (lb >= nlb) return;
  for (int t = lb; t < 6 * NT; t += nlb) {
    int mt = xcd * 6 + t / NT, nt = t % NT;
    gemm_tile<AMODE, EPI>(p, g, li, mt * 128, nt * 128, smem);
  }
}


template <int KW, int DV>
DI void attn_gload(const u16* Kb, int kstride, const u16* VT, int L, int kb, int tid, u32x4 (&kr)[KW / 32], u32x4 (&vr)[DV / 32]) {
  constexpr int KPR = 256 / (KW / 8);
  const unsigned koff = (unsigned)(tid / (KW / 8)) * (unsigned)kstride + (unsigned)(tid % (KW / 8)) * 8u;
  const unsigned voff = (unsigned)(tid >> 3) * (unsigned)L + (unsigned)(tid & 7) * 8u;
#pragma unroll
  for (int i = 0; i < KW / 32; ++i) {
    const u16* kbp = Kb + (size_t)(kb * 64 + KPR * i) * kstride;
    kr[i] = *(const u32x4*)(kbp + koff);
  }
#pragma unroll
  for (int i = 0; i < DV / 32; ++i) {
    const u16* vbp = VT + (size_t)(32 * i) * L + kb * 64;
    vr[i] = *(const u32x4*)(vbp + voff);
  }
}
template <int KW, int DV, bool DIFF>
DI void attn_item(const u16* Q, int qstride, int qcol, int qrow0, const u16* Kb, int kstride, const u16* VT, int L,
                          int nkeys, u16* mixed, int mixcol, float lam, float postscale, const float* subg, char* smem) {
  const int tid = threadIdx.x, lane = tid & 63, wid = tid >> 6, l16 = lane & 15, q4 = lane >> 4;
  const int qsub = wid & 1, var = wid >> 1;
  constexpr int KS = KW + 8;
  u16* sK = (u16*)smem;
  u16* sV = sK + 64 * KS;
  constexpr int KPT = KW / 32, VPT = DV / 32, NDT = DV / 16;
  const int kfo = DIFF ? var * 64 : 0;
  const float c = 0.125f * LOG2E;

  const u16* qp = Q + (size_t)(qrow0 + qsub * 16 + l16) * qstride + qcol + var * 64 + q4 * 8;
  const bf16x8 qf0 = *(const bf16x8*)qp;
  const bf16x8 qf1 = *(const bf16x8*)(qp + 32);

  u32x4 kr[KPT], vr[VPT];
  f32x4 o[NDT];
#pragma unroll
  for (int d = 0; d < NDT; ++d) o[d] = f32x4{0.f, 0.f, 0.f, 0.f};
  float m = -INFINITY, l = 0.f;
  const int nkb = nkeys >> 6;
  attn_gload<KW, DV>(Kb, kstride, VT, L, 0, tid, kr, vr);
  for (int kb = 0; kb < nkb; ++kb) {
    __syncthreads();
#pragma unroll
    for (int i = 0; i < KPT; ++i) {
      int idx = tid + 256 * i;
      int key = idx / (KW / 8), cc = idx % (KW / 8);
      *(u32x4*)(sK + key * KS + cc * 8) = kr[i];
    }
#pragma unroll
    for (int i = 0; i < VPT; ++i) {
      int idx = tid + 256 * i;
      int row = idx >> 3, cc = idx & 7;
      *(u32x4*)(sV + row * 72 + cc * 8) = vr[i];
    }
    __syncthreads();
    if (kb + 1 < nkb) attn_gload<KW, DV>(Kb, kstride, VT, L, kb + 1, tid, kr, vr);

    f32x4 st[4];
#pragma unroll
    for (int kt = 0; kt < 4; ++kt) {
      const u16* kp = sK + (kt * 16 + l16) * KS + kfo + q4 * 8;
      bf16x8 k0 = *(const bf16x8*)kp;
      bf16x8 k1 = *(const bf16x8*)(kp + 32);
      f32x4 z = {0.f, 0.f, 0.f, 0.f};
      z = MFMA16(k0, qf0, z);
      st[kt] = MFMA16(k1, qf1, z);
    }
    float bm = st[0][0];
#pragma unroll
    for (int kt = 0; kt < 4; ++kt)
#pragma unroll
      for (int r = 0; r < 4; ++r) bm = fmaxf(bm, st[kt][r]);
    bm = fmaxf(bm, shx(bm, 16));
    bm = fmaxf(bm, shx(bm, 32));
    const float mn = fmaxf(m, bm);
    const float alpha = ex2((m - mn) * c);
    m = mn;
    float ps = 0.f;
#pragma unroll
    for (int kt = 0; kt < 4; ++kt)
#pragma unroll
      for (int r = 0; r < 4; ++r) {
        float pv = ex2((st[kt][r] - mn) * c);
        st[kt][r] = pv;
        ps += pv;
      }
    l = l * alpha + ps;
#pragma unroll
    for (int d = 0; d < NDT; ++d) {
      o[d][0] *= alpha; o[d][1] *= alpha; o[d][2] *= alpha; o[d][3] *= alpha;
    }
#pragma unroll
    for (int ks = 0; ks < 2; ++ks) {
      unsigned pk[4];
      pk[0] = pack2(st[2 * ks][0], st[2 * ks][1]);
      pk[1] = pack2(st[2 * ks][2], st[2 * ks][3]);
      pk[2] = pack2(st[2 * ks + 1][0], st[2 * ks + 1][1]);
      pk[3] = pack2(st[2 * ks + 1][2], st[2 * ks + 1][3]);
      uint4 pu = make_uint4(pk[0], pk[1], pk[2], pk[3]);
      bf16x8 pf = __builtin_bit_cast(bf16x8, pu);
#pragma unroll
      for (int d = 0; d < NDT; ++d) {
        const u16* vp = sV + (d * 16 + l16) * 72 + ks * 32 + q4 * 4;
        uint2 v0 = *(const uint2*)vp;
        uint2 v1 = *(const uint2*)(vp + 16);
        uint4 vu = make_uint4(v0.x, v0.y, v1.x, v1.y);
        bf16x8 vf = __builtin_bit_cast(bf16x8, vu);
        o[d] = MFMA16(vf, pf, o[d]);
      }
    }
  }
  l += shx(l, 16);
  l += shx(l, 32);
  const float inv = 1.f / l;
  const int row = qrow0 + qsub * 16 + l16;
  if constexpr (DIFF) {
    __syncthreads();
    float* sO = (float*)smem;
    if (var == 1) {
#pragma unroll
      for (int d = 0; d < NDT; ++d)
        *(float4*)(sO + (qsub * 16 + l16) * 132 + d * 16 + q4 * 4) =
            make_float4(o[d][0] * inv, o[d][1] * inv, o[d][2] * inv, o[d][3] * inv);
    }
    __syncthreads();
    if (var == 0) {
      float ss = 0.f;
#pragma unroll
      for (int d = 0; d < NDT; ++d) {
        float4 o1 = *(const float4*)(sO + (qsub * 16 + l16) * 132 + d * 16 + q4 * 4);
        o[d][0] = o[d][0] * inv - lam * o1.x;
        o[d][1] = o[d][1] * inv - lam * o1.y;
        o[d][2] = o[d][2] * inv - lam * o1.z;
        o[d][3] = o[d][3] * inv - lam * o1.w;
        ss += o[d][0] * o[d][0] + o[d][1] * o[d][1] + o[d][2] * o[d][2] + o[d][3] * o[d][3];
      }
      ss += shx(ss, 16);
      ss += shx(ss, 32);
      const float rs = rsqrtf(ss * (1.f / 128.f) + 1e-6f) * postscale;
#pragma unroll
      for (int d = 0; d < NDT; ++d) {
        float4 gg = *(const float4*)(subg + d * 16 + q4 * 4);
        uint2 ov;
        ov.x = pack2(o[d][0] * rs * gg.x, o[d][1] * rs * gg.y);
        ov.y = pack2(o[d][2] * rs * gg.z, o[d][3] * rs * gg.w);
        *(uint2*)(mixed + (size_t)row * 1024 + mixcol + d * 16 + q4 * 4) = ov;
      }
    }
  } else {
#pragma unroll
    for (int d = 0; d < NDT; ++d) {
      uint2 ov;
      ov.x = pack2(o[d][0] * inv, o[d][1] * inv);
      ov.y = pack2(o[d][2] * inv, o[d][3] * inv);
      *(uint2*)(mixed + (size_t)row * 1024 + mixcol + var * 64 + d * 16 + q4 * 4) = ov;
    }
  }
}

DI void attnA_item(const P& p, int li, int it, char* smem) {
  const int lane = threadIdx.x & 63;
  float d1 = p.in[14][li * 64 + lane] * p.in[15][li * 64 + lane];
  float d2 = p.in[16][li * 64 + lane] * p.in[17][li * 64 + lane];
#pragma unroll
  for (int s = 1; s < 64; s <<= 1) { d1 += shx(d1, s); d2 += shx(d2, s); }
  const float lam_init = 0.8f - 0.6f * expf(-0.3f * (float)li);
  const float lam = expf(d1) - expf(d2) + lam_init;
  const u16* QA = (const u16*)(p.ws + O_QA);
  u16* mixed = (u16*)(p.ws + O_MIXED);
  const float* subg = p.in[18] + li * 128;
  int qrow0, L;
  const u16 *Kb, *VT;
  int h;
  if (it < 256) {
    int b = it >> 7, qb = it & 31;
    h = (it >> 5) & 3;
    Kb = (const u16*)(p.ws + O_KALAT) + (size_t)(li * 2 + b) * 1536 * 512 + h * 128;
    VT = (const u16*)(p.ws + O_VTALAT) + (size_t)((li * 2 + b) * 4 + h) * 128 * 1536;
    qrow0 = NCTX + b * 1024 + qb * 32;
    L = 1536;
  } else {
    it -= 256;
    int b = it >> 5, qb = it & 7;
    h = (it >> 3) & 3;
    Kb = (const u16*)(p.ws + O_KACTX) + (size_t)b * 256 * 512 + h * 128;
    VT = (const u16*)(p.ws + O_VTACTX) + (size_t)(b * 4 + h) * 128 * 256;
    qrow0 = b * 256 + qb * 32;
    L = 256;
  }
  attn_item<128, 128, true>(QA, 512, h * 128, qrow0, Kb, 512, VT, L, L, mixed, h * 128, lam, 1.f - lam_init, subg, smem);
}
DI void attnC_item(const P& p, int li, int it, char* smem) {
  const u16* QC = (const u16*)(p.ws + O_QC);
  u16* mixed = (u16*)(p.ws + O_MIXED);
  int qrow0, L, n;
  const u16 *Kb, *VT;
  if (it < 128) {
    int b = it >> 6, qb = it & 31;
    n = (it >> 5) & 1;
    Kb = (const u16*)(p.ws + O_KCLAT) + (size_t)(li * 2 + b) * 1536 * 128 + n * 64;
    VT = (const u16*)(p.ws + O_VTCLAT) + (size_t)((li * 2 + b) * 2 + n) * 64 * 1536;
    qrow0 = NCTX + b * 1024 + qb * 32;
    L = 1536;
  } else {
    it -= 128;
    int b = it >> 4, qb = it & 7;
    n = (it >> 3) & 1;
    Kb = (const u16*)(p.ws + O_KCCTX) + (size_t)b * 256 * 128 + n * 64;
    VT = (const u16*)(p.ws + O_VTCCTX) + (size_t)(b * 2 + n) * 64 * 256;
    qrow0 = b * 256 + qb * 32;
    L = 256;
  }
  attn_item<64, 64, false>(QC, 256, n * 128, qrow0, Kb, 128, VT, L, L, mixed, 768 + n * 128, 0.f, 1.f, nullptr, smem);
}

DI void h1_item(const P& p, int item, char* smem) {
  const int tid = threadIdx.x;
  const int dir = item & 1, h = (item >> 1) & 3, tc = item >> 3;
  const int row0 = tc * 64;
  float* sQ = (float*)smem;
  float* sB = sQ + 64 * 68;
  float* sK = sB + 64 * 68;
  float* sV = sK + 64 * 68;
  float* sTot = sV + 64 * 64;
  const float* HQ = (const float*)(p.ws + O_HQ);
  const float* HG = (const float*)(p.ws + (dir ? O_HGB : O_HGF));
  const float* HI = (const float*)(p.ws + O_HI);
  float* OI = (float*)(p.ws + O_OI) + (size_t)dir * NTOK * 256;
  float* QE = (float*)(p.ws + O_QE) + (size_t)dir * NTOK * 256;
  float* KV = (float*)(p.ws + O_KV) + (size_t)item * 4096;
  float* DEC = (float*)(p.ws + O_DEC) + (size_t)item * 64;

  __syncthreads();
#pragma unroll
  for (int i = 0; i < 4; ++i) {
    int idx = tid + 256 * i;
    int lo = idx >> 4, c4 = idx & 15;
    int row = dir ? row0 + 63 - lo : row0 + lo;
    size_t off = (size_t)row * 256 + h * 64 + c4 * 4;
    *(float4*)(sQ + lo * 68 + c4 * 4) = *(const float4*)(HQ + off);
    *(float4*)(sB + lo * 68 + c4 * 4) = *(const float4*)(HG + off);
    *(float4*)(sV + lo * 64 + c4 * 4) = *(const float4*)(HI + off);
  }
  __syncthreads();
  {
    const int k = tid & 63, part = tid >> 6;
    float run = 0.f;
#pragma unroll 4
    for (int e = 0; e < 16; ++e) {
      int i = part * 16 + e;
      float g = sB[i * 68 + k];
      sK[i * 68 + k] = -expm1f(g);
      run += g * LOG2E;
      sB[i * 68 + k] = run;
    }
    sTot[part * 64 + k] = run;
    __syncthreads();
    float add = 0.f;
    for (int pp = 0; pp < part; ++pp) add += sTot[pp * 64 + k];
    if (part > 0)
      for (int e = 0; e < 16; ++e) sB[(part * 16 + e) * 68 + k] += add;
  }
  __syncthreads();
#pragma unroll
  for (int i = 0; i < 4; ++i) {
    int idx = tid + 256 * i;
    int lo = idx >> 4, c4 = idx & 15;
    int row = dir ? row0 + 63 - lo : row0 + lo;
    float4 q = *(const float4*)(sQ + lo * 68 + c4 * 4);
    float4 bb = *(const float4*)(sB + lo * 68 + c4 * 4);
    *(float4*)(QE + (size_t)row * 256 + h * 64 + c4 * 4) = make_float4(q.x * ex2(bb.x), q.y * ex2(bb.y), q.z * ex2(bb.z), q.w * ex2(bb.w));
  }
  const int ty = tid >> 4, tx = tid & 15;
  float at[4][4];
#pragma unroll
  for (int a = 0; a < 4; ++a)
#pragma unroll
    for (int cc = 0; cc < 4; ++cc) at[a][cc] = 0.f;
#pragma unroll 1
  for (int k = 0; k < 64; k += 4) {
    float4 qt[4], bt[4], ks[4], bs[4];
#pragma unroll
    for (int a = 0; a < 4; ++a) {
      qt[a] = *(const float4*)(sQ + (ty + 16 * a) * 68 + k);
      bt[a] = *(const float4*)(sB + (ty + 16 * a) * 68 + k);
      ks[a] = *(const float4*)(sK + (tx + 16 * a) * 68 + k);
      bs[a] = *(const float4*)(sB + (tx + 16 * a) * 68 + k);
    }
#pragma unroll
    for (int a = 0; a < 4; ++a)
#pragma unroll
      for (int cc = 0; cc <= a; ++cc) {
        float s = at[a][cc];
        s += qt[a].x * ks[cc].x * ex2(bt[a].x - bs[cc].x);
        s += qt[a].y * ks[cc].y * ex2(bt[a].y - bs[cc].y);
        s += qt[a].z * ks[cc].z * ex2(bt[a].z - bs[cc].z);
        s += qt[a].w * ks[cc].w * ex2(bt[a].w - bs[cc].w);
        at[a][cc] = s;
      }
  }
  __syncthreads();
  float* sA = sQ;
#pragma unroll
  for (int a = 0; a < 4; ++a)
#pragma unroll
    for (int cc = 0; cc < 4; ++cc) {
      float v = (cc < a) ? at[a][cc] : ((cc == a && tx <= ty) ? at[a][cc] : 0.f);
      sA[(ty + 16 * a) * 68 + tx + 16 * cc] = v;
    }
  __syncthreads();
  {
    float4 oa[4];
#pragma unroll
    for (int a = 0; a < 4; ++a) oa[a] = make_float4(0.f, 0.f, 0.f, 0.f);
#pragma unroll 1
    for (int s = 0; s < 64; s += 4) {
      float4 v0 = *(const float4*)(sV + (s + 0) * 64 + tx * 4);
      float4 v1 = *(const float4*)(sV + (s + 1) * 64 + tx * 4);
      float4 v2 = *(const float4*)(sV + (s + 2) * 64 + tx * 4);
      float4 v3 = *(const float4*)(sV + (s + 3) * 64 + tx * 4);
#pragma unroll
      for (int a = 0; a < 4; ++a) {
        float4 w = *(const float4*)(sA + (ty + 16 * a) * 68 + s);
        oa[a].x += w.x * v0.x + w.y * v1.x + w.z * v2.x + w.w * v3.x;
        oa[a].y += w.x * v0.y + w.y * v1.y + w.z * v2.y + w.w * v3.y;
        oa[a].z += w.x * v0.z + w.y * v1.z + w.z * v2.z + w.w * v3.z;
        oa[a].w += w.x * v0.w + w.y * v1.w + w.z * v2.w + w.w * v3.w;
      }
    }
#pragma unroll
    for (int a = 0; a < 4; ++a) {
      int t = ty + 16 * a;
      int row = dir ? row0 + 63 - t : row0 + t;
      *(float4*)(OI + (size_t)row * 256 + h * 64 + tx * 4) = oa[a];
    }
  }
  {
    float bend[4];
    float4 kva[4];
#pragma unroll
    for (int a = 0; a < 4; ++a) {
      bend[a] = sB[63 * 68 + ty + 16 * a];
      kva[a] = make_float4(0.f, 0.f, 0.f, 0.f);
    }
#pragma unroll 2
    for (int s = 0; s < 64; ++s) {
      float4 v = *(const float4*)(sV + s * 64 + tx * 4);
#pragma unroll
      for (int a = 0; a < 4; ++a) {
        int k = ty + 16 * a;
        float kd = sK[s * 68 + k] * ex2(bend[a] - sB[s * 68 + k]);
        kva[a].x += kd * v.x; kva[a].y += kd * v.y; kva[a].z += kd * v.z; kva[a].w += kd * v.w;
      }
    }
#pragma unroll
    for (int a = 0; a < 4; ++a) {
      int k = ty + 16 * a;
      *(float4*)(KV + k * 64 + tx * 4) = kva[a];
      if (tx == 0) DEC[k] = ex2(bend[a]);
    }
  }
}

DI void h2_item(const P& p, int li, int item, char* smem) {
  const int tid = threadIdx.x, ty = tid >> 4, tx = tid & 15;
  const int h = item & 3, tc = item >> 2, row0 = tc * 64;
  const bool lat = tc >= 64;
  int seq, cl, nc;
  if (!lat) { seq = tc >> 2; cl = tc & 3; nc = 4; } else { seq = (tc - 64) >> 4; cl = (tc - 64) & 15; nc = 16; }
  const int tcbase = tc - cl;
  float* sS = (float*)smem;
  float* sQE = sS + 4096;
  const float* KVb = (const float*)(p.ws + O_KV);
  const float* DECb = (const float*)(p.ws + O_DEC);
  float4 oa[4];
#pragma unroll
  for (int a = 0; a < 4; ++a) {
    size_t off = (size_t)(row0 + ty + 16 * a) * 256 + h * 64 + tx * 4;
    float4 x = *(const float4*)((const float*)(p.ws + O_OI) + off);
    float4 y = *(const float4*)((const float*)(p.ws + O_OI) + (size_t)NTOK * 256 + off);
    oa[a] = make_float4(x.x + y.x, x.y + y.y, x.z + y.z, x.w + y.w);
  }
#pragma unroll 1
  for (int dir = 0; dir < 2; ++dir) {
    float4 S[4];
#pragma unroll
    for (int a = 0; a < 4; ++a) {
      if (lat) S[a] = *(const float4*)(p.in[6 + dir] + ((size_t)((seq * 2 + li) * 4 + h) * 64 + ty + 16 * a) * 64 + tx * 4);
      else S[a] = make_float4(0.f, 0.f, 0.f, 0.f);
    }
    const int nprev = dir == 0 ? cl : nc - 1 - cl;
#pragma unroll 1
    for (int j = 0; j < nprev; ++j) {
      int tcj = tcbase + (dir == 0 ? j : nc - 1 - j);
      size_t itj = (size_t)((tcj * 4 + h) * 2 + dir);
#pragma unroll
      for (int a = 0; a < 4; ++a) {
        int k = ty + 16 * a;
        float dcy = DECb[itj * 64 + k];
        float4 kv = *(const float4*)(KVb + itj * 4096 + k * 64 + tx * 4);
        S[a].x = dcy * S[a].x + kv.x; S[a].y = dcy * S[a].y + kv.y; S[a].z = dcy * S[a].z + kv.z; S[a].w = dcy * S[a].w + kv.w;
      }
    }
    if (!lat && nprev == nc - 1) {
      size_t itj = (size_t)((tc * 4 + h) * 2 + dir);
      float* so = p.out + (dir == 0 ? OUT_SF : OUT_SB) + (size_t)((seq * 2 + li) * 4 + h) * 4096;
#pragma unroll
      for (int a = 0; a < 4; ++a) {
        int k = ty + 16 * a;
        float dcy = DECb[itj * 64 + k];
        float4 kv = *(const float4*)(KVb + itj * 4096 + k * 64 + tx * 4);
        *(float4*)(so + k * 64 + tx * 4) = make_float4(dcy * S[a].x + kv.x, dcy * S[a].y + kv.y, dcy * S[a].z + kv.z, dcy * S[a].w + kv.w);
      }
    }
    __syncthreads();
#pragma unroll
    for (int a = 0; a < 4; ++a) *(float4*)(sS + (ty + 16 * a) * 64 + tx * 4) = S[a];
    const float* QE = (const float*)(p.ws + O_QE) + (size_t)dir * NTOK * 256;
#pragma unroll
    for (int i = 0; i < 4; ++i) {
      int idx = tid + 256 * i;
      int t = idx >> 4, c4 = idx & 15;
      *(float4*)(sQE + t * 68 + c4 * 4) = *(const float4*)(QE + (size_t)(row0 + t) * 256 + h * 64 + c4 * 4);
    }
    __syncthreads();
#pragma unroll 1
    for (int k = 0; k < 64; k += 4) {
      float4 s0 = *(const float4*)(sS + (k + 0) * 64 + tx * 4);
      float4 s1 = *(const float4*)(sS + (k + 1) * 64 + tx * 4);
      float4 s2 = *(const float4*)(sS + (k + 2) * 64 + tx * 4);
      float4 s3 = *(const float4*)(sS + (k + 3) * 64 + tx * 4);
#pragma unroll
      for (int a = 0; a < 4; ++a) {
        float4 w = *(const float4*)(sQE + (ty + 16 * a) * 68 + k);
        oa[a].x += w.x * s0.x + w.y * s1.x + w.z * s2.x + w.w * s3.x;
        oa[a].y += w.x * s0.y + w.y * s1.y + w.z * s2.y + w.w * s3.y;
        oa[a].z += w.x * s0.z + w.y * s1.z + w.z * s2.z + w.w * s3.z;
        oa[a].w += w.x * s0.w + w.y * s1.w + w.z * s2.w + w.w * s3.w;
      }
    }
  }
  const float4 gn = *(const float4*)(p.in[21] + li * 64 + tx * 4);
  u16* mixed = (u16*)(p.ws + O_MIXED);
#pragma unroll
  for (int a = 0; a < 4; ++a) {
    float ss = oa[a].x * oa[a].x + oa[a].y * oa[a].y + oa[a].z * oa[a].z + oa[a].w * oa[a].w;
    ss += shx(ss, 1); ss += shx(ss, 2); ss += shx(ss, 4); ss += shx(ss, 8);
    float rs = rsqrtf(ss * (1.f / 64.f) + 1e-6f);
    int row = row0 + ty + 16 * a;
    float4 sg = *(const float4*)((const float*)(p.ws + O_HSG) + (size_t)row * 256 + h * 64 + tx * 4);
    uint2 ov;
    ov.x = pack2(oa[a].x * rs * gn.x * sg.x, oa[a].y * rs * gn.y * sg.y);
    ov.y = pack2(oa[a].z * rs * gn.z * sg.z, oa[a].w * rs * gn.w * sg.w);
    *(uint2*)(mixed + (size_t)row * 1024 + 512 + h * 64 + tx * 4) = ov;
  }
}

DI void final_ln(const P& p) {
  const int lane = threadIdx.x & 63, wid = threadIdx.x >> 6;
  const float* X = (const float*)(p.ws + O_XPRE2);
  const float* ST = (const float*)(p.ws + O_ST2);
  const float* g = p.in[26] + 1024;
  const float* bb = p.in[27] + 1024;
  for (int it = blockIdx.x; it < NTOK / 4; it += gridDim.x) {
    int row = it * 4 + wid;
    float s1 = 0.f, s2 = 0.f;
    if (lane < 16) {
      float2 v = *(const float2*)(ST + (size_t)row * 32 + lane * 2);
      s1 = v.x;
      s2 = v.y;
    }
#pragma unroll
    for (int s = 1; s < 16; s <<= 1) { s1 += shx(s1, s); s2 += shx(s2, s); }
    s1 = __shfl(s1, 0, 64);
    s2 = __shfl(s2, 0, 64);
    float mu = s1 * (1.f / 1024.f);
    float rs = rsqrtf(fmaxf(s2 * (1.f / 1024.f) - mu * mu, 0.f) + 1e-6f);
    float* out = p.out + (row < NCTX ? OUT_YP + (size_t)row * 1024 : OUT_YS + (size_t)(row - NCTX) * 1024);
#pragma unroll
    for (int i = 0; i < 4; ++i) {
      int c = (lane + 64 * i) * 4;
      float4 x = *(const float4*)(X + (size_t)row * 1024 + c);
      float4 gg = *(const float4*)(g + c);
      float4 b4 = *(const float4*)(bb + c);
      *(float4*)(out + c) = make_float4((x.x - mu) * rs * gg.x + b4.x, (x.y - mu) * rs * gg.y + b4.y,
                                         (x.z - mu) * rs * gg.z + b4.z, (x.w - mu) * rs * gg.w + b4.w);
    }
  }
}

DI void run_phase(const P& p, int ph, char* smem) {
  if (ph == 0) { phase0(p, smem); return; }
  if (ph == NPHASE - 1) { final_ln(p); return; }
  const int li = (ph - 1) / 6, s = (ph - 1) % 6;
  float* XPRE1 = (float*)(p.ws + O_XPRE1);
  float* XPRE2 = (float*)(p.ws + O_XPRE2);
  float* ST1 = (float*)(p.ws + O_ST1);
  float* ST2 = (float*)(p.ws + O_ST2);
  GA g;
  g.mods = (const float*)(p.ws + O_MODS) + li * 3 * 6144;
  g.a16 = nullptr; g.xout = nullptr; g.sout = nullptr; g.hid = nullptr;
  const float* xin_lo = li == 0 ? p.in[0] : XPRE2;
  const float* xin_hi = li == 0 ? p.in[1] : XPRE2 + (size_t)NCTX * 1024;
  const float* xin_st = li == 0 ? nullptr : ST2;
  const float* xin_g = p.in[26] + (li == 0 ? 0 : (li - 1) * 1024);
  const float* xin_b = p.in[27] + (li == 0 ? 0 : (li - 1) * 1024);
  if (s == 0) {
    g.alo = xin_lo; g.ahi = xin_hi; g.stats = xin_st; g.lng = xin_g; g.lnb = xin_b;
    g.sc_off = 1024; g.sh_off = 0;
    g.bt = (const u16*)(p.ws + O_WTIN) + (size_t)li * NIN * D; g.K = D; g.N = NIN;
    gemm_phase<1, 0>(p, g, li, smem);
  } else if (s == 1) {
    for (int it = blockIdx.x; it < 768 + 768; it += gridDim.x) {
      if (it >= 256 && it < 1024) h1_item(p, it - 256, smem);
      else attnA_item(p, li, it < 256 ? it : it - 768, smem);
    }
  } else if (s == 2) {
    for (int it = blockIdx.x; it < 384 + 384; it += gridDim.x) {
      if (it >= 128 && it < 512) h2_item(p, li, it - 128, smem);
      else attnC_item(p, li, it < 128 ? it : it - 384, smem);
    }
  } else if (s == 3) {
    g.alo = xin_lo; g.ahi = xin_hi; g.stats = xin_st; g.lng = xin_g; g.lnb = xin_b;
    g.sc_off = 2048; g.sh_off = 0;
    g.a16 = (const u16*)(p.ws + O_MIXED);
    g.bt = (const u16*)(p.ws + O_WTOUT) + (size_t)li * D * D; g.K = D; g.N = D;
    g.xout = XPRE1; g.sout = ST1;
    gemm_phase<0, 1>(p, g, li, smem);
  } else if (s == 4) {
    g.alo = XPRE1; g.ahi = XPRE1 + (size_t)NCTX * 1024; g.stats = ST1; g.lng = p.in[24] + li * 1024; g.lnb = p.in[25] + li * 1024;
    g.sc_off = 4096; g.sh_off = 3072;
    g.bt = (const u16*)(p.ws + O_WTFF1) + (size_t)li * DFF * D; g.K = D; g.N = DFF;
    g.hid = (u16*)(p.ws + O_HID);
    gemm_phase<1, 2>(p, g, li, smem);
  } else {
    g.alo = XPRE1; g.ahi = XPRE1 + (size_t)NCTX * 1024; g.stats = ST1; g.lng = p.in[24] + li * 1024; g.lnb = p.in[25] + li * 1024;
    g.sc_off = 5120; g.sh_off = 0;
    g.a16 = (const u16*)(p.ws + O_HID);
    g.bt = (const u16*)(p.ws + O_WTFF2) + (size_t)li * D * DFF; g.K = DFF; g.N = D;
    g.xout = XPRE2; g.sout = ST2;
    gemm_phase<0, 1>(p, g, li, smem);
  }
}


#define XB_TMO      128
#define XB_XCNT(j)  (256  + 64 * (j))
#define XB_XSUB(j)  (1280 + 64 * (j))
#define XB_XGEN(j)  (2304 + 64 * (j))
#define XB_TOP      3328
#define XB_TOPGEN   3392
#define XCD_BAR_WORDS 3456
#define XB_SPIN_CAP (1u << 20)
#define LAS __attribute__((address_space(3)))
DI unsigned xb_ld(unsigned* p) { return __hip_atomic_load(p, __ATOMIC_RELAXED, __HIP_MEMORY_SCOPE_AGENT); }
DI unsigned xb_add(unsigned* p, unsigned v) { return __hip_atomic_fetch_add(p, v, __ATOMIC_RELAXED, __HIP_MEMORY_SCOPE_AGENT); }
DI unsigned xb_xcc_id() { return (unsigned)__builtin_amdgcn_s_getreg((3 << 11) | 20) & 0xFu; }
#define XB_SPIN(cond, bar) do { unsigned _sp = 0; while (cond) { __builtin_amdgcn_s_sleep(1); \
    if ((++_sp & 255u) == 0u) { if (xb_ld(&(bar)[XB_TMO])) break; if (_sp > XB_SPIN_CAP) { atomicAdd(&(bar)[XB_TMO], 1u); break; } } } } while (0)
struct XcdBarrier { unsigned* bar; unsigned x; volatile LAS unsigned* st; };
DI XcdBarrier xcd_barrier_post(unsigned* bar, volatile LAS unsigned* st) {
  XcdBarrier b; b.bar = bar; b.x = xb_xcc_id(); b.st = st;
  if (threadIdx.x == 0) (void)xb_add(&bar[XB_XCNT(b.x)], 1u);
  return b;
}
DI void xcd_barrier_complete(unsigned* bar, unsigned x, unsigned& nloc, unsigned& nx) {
  const unsigned G = gridDim.x * gridDim.y * gridDim.z;
  unsigned sum, cnt, mine, sp = 0u;
  for (;;) {
    sum = 0u; cnt = 0u; mine = 0u;
#pragma unroll
    for (unsigned j = 0; j < 16; ++j) { const unsigned c = xb_ld(&bar[XB_XCNT(j)]); sum += c; cnt += (c > 0u) ? 1u : 0u; mine = (j == x) ? c : mine; }
    if (sum == G) break;
    __builtin_amdgcn_s_sleep(1);
    if ((++sp & 255u) == 0u) { if (xb_ld(&bar[XB_TMO])) break; if (sp > XB_SPIN_CAP) { atomicAdd(&bar[XB_TMO], 1u); break; } }
  }
  nloc = mine > 0u ? mine : 1u; nx = cnt > 0u ? cnt : 1u;
}
DI void xcd_barrier(const XcdBarrier& b) {
  asm volatile("s_waitcnt vmcnt(0)" ::: "memory");
  __syncthreads();
  if (threadIdx.x == 0) {
    unsigned* bar = b.bar;
    __builtin_amdgcn_s_waitcnt(0);
    unsigned nloc = b.st[0], nx = b.st[1];
    if (nloc == 0u) { xcd_barrier_complete(bar, b.x, nloc, nx); b.st[0] = nloc; b.st[1] = nx; }
    const unsigned old = xb_add(&bar[XB_XSUB(b.x)], 1u);
    const unsigned gen = old / nloc;
    if (old + 1u == (gen + 1u) * nloc) {
      __builtin_amdgcn_fence(__ATOMIC_RELEASE, "agent");
      asm volatile("s_waitcnt vmcnt(0)" ::: "memory");
      const unsigned og = xb_add(&bar[XB_TOP], 1u);
      const unsigned tg = og / nx;
      if (og + 1u == (tg + 1u) * nx) xb_add(&bar[XB_TOPGEN], 1u);
      else XB_SPIN(xb_ld(&bar[XB_TOPGEN]) == tg, bar);
      __builtin_amdgcn_fence(__ATOMIC_ACQUIRE, "agent");
      xb_add(&bar[XB_XGEN(b.x)], 1u);
      asm volatile("s_waitcnt vmcnt(0)" ::: "memory");
    } else {
      XB_SPIN(xb_ld(&bar[XB_XGEN(b.x)]) == gen, bar);
      __builtin_amdgcn_fence(__ATOMIC_ACQUIRE, "agent");
      asm volatile("s_waitcnt vmcnt(0)" ::: "memory");
    }
  }
  __syncthreads();
}
constexpr size_t O_BAR = O_END1;
static_assert(O_BAR + XCD_BAR_WORDS * 4 <= (size_t)256 * 1024 * 1024, "barrier words must fit");

#if !MULTI_LAUNCH
__global__ void __launch_bounds__(256, 2) mega_kernel(P p) {
  extern __shared__ __attribute__((aligned(16))) char smem[];
  cg::grid_group grid = cg::this_grid();
  if (p.ws == nullptr) grid.sync();
  if (threadIdx.x == 0) *(uint4*)(smem + LDS_BYTES - 16) = make_uint4(0u, 0u, 0u, 0u);
  __syncthreads();
  XcdBarrier xb = xcd_barrier_post((unsigned*)(p.ws + O_BAR), (volatile LAS unsigned*)(smem + LDS_BYTES - 16));
  run_phase(p, 0, smem); xcd_barrier(xb);
  run_phase(p, 1, smem); xcd_barrier(xb);
  run_phase(p, 2, smem); xcd_barrier(xb);
  run_phase(p, 3, smem); xcd_barrier(xb);
  run_phase(p, 4, smem); xcd_barrier(xb);
  run_phase(p, 5, smem); xcd_barrier(xb);
  run_phase(p, 6, smem); xcd_barrier(xb);
  run_phase(p, 7, smem); xcd_barrier(xb);
  run_phase(p, 8, smem); xcd_barrier(xb);
  run_phase(p, 9, smem); xcd_barrier(xb);
  run_phase(p, 10, smem); xcd_barrier(xb);
  run_phase(p, 11, smem); xcd_barrier(xb);
  run_phase(p, 12, smem); xcd_barrier(xb);
  run_phase(p, 13, smem);
}
#define MAIN_KERNEL mega_kernel
#else
__global__ void __launch_bounds__(256, 2) phase_kernel(P p, int ph) {
  extern __shared__ __attribute__((aligned(16))) char smem[];
  run_phase(p, ph, smem);
}
#define MAIN_KERNEL phase_kernel
#endif

extern "C" void kernel_launch(void* const* d_in, const int* in_sizes, int n_in, void* d_out, int out_size, void* d_ws,
                              size_t ws_size, hipStream_t stream) {
  static int grid_blocks = 0;
  if (!grid_blocks) {
    int dev = 0, cus = 0, per_cu = 0;
    (void)hipGetDevice(&dev);
    (void)hipDeviceGetAttribute(&cus, hipDeviceAttributeMultiprocessorCount, dev);
    (void)hipFuncSetAttribute((const void*)MAIN_KERNEL, hipFuncAttributeMaxDynamicSharedMemorySize, LDS_BYTES);
    (void)hipOccupancyMaxActiveBlocksPerMultiprocessor(&per_cu, MAIN_KERNEL, 256, LDS_BYTES);
    if (per_cu > 2) per_cu = 2;
    if (per_cu < 1) per_cu = 1;
    grid_blocks = cus * per_cu;
  }
  P p{};
  for (int i = 0; i < 30; ++i) p.in[i] = (const float*)d_in[i];
  p.out = (float*)d_out;
  p.ws = (char*)d_ws;
#if MULTI_LAUNCH
  for (int ph = 0; ph < NPHASE; ++ph) phase_kernel<<<dim3(grid_blocks), dim3(256), LDS_BYTES, stream>>>(p, ph);
#else
  (void)hipMemsetAsync((char*)d_ws + O_BAR, 0, XCD_BAR_WORDS * 4, stream);
  void* args[] = {&p};
  hipError_t e = hipLaunchCooperativeKernel((void*)mega_kernel, dim3(grid_blocks), dim3(256), args, LDS_BYTES, stream);
  if (e != hipSuccess) fprintf(stderr, "cooperative launch failed: %s (grid %d)\n", hipGetErrorString(e), grid_blocks);
#endif
}
```

```cpp
#include <hip/hip_runtime.h>
#include <hip/hip_cooperative_groups.h>
#include <stdint.h>
#include <stdio.h>
namespace cg = cooperative_groups;

#ifndef MULTI_LAUNCH
#define MULTI_LAUNCH 0
#endif

#define DI __device__ __forceinline__
typedef unsigned short u16;
using bf16x8 = __attribute__((ext_vector_type(8))) short;
using f32x4 = __attribute__((ext_vector_type(4))) float;
typedef __bf16 bf2_t __attribute__((ext_vector_type(2)));
typedef float f2_t __attribute__((ext_vector_type(2)));

constexpr int D = 1024, NTOK = 6144, NCTX = 4096, NIN = 3328, DFF = 4096;
constexpr float ALPHA = 1.41421356237309515f;
constexpr float LOG2E = 1.44269504088896341f;
constexpr int LDS_BYTES = 75776;
constexpr int NPHASE = 18;

constexpr size_t O_WTIN = 0;
constexpr size_t O_WTOUT = O_WTIN + (size_t)2 * NIN * D * 2;
constexpr size_t O_WTFF1 = O_WTOUT + (size_t)2 * D * D * 2;
constexpr size_t O_WTFF2 = O_WTFF1 + (size_t)2 * DFF * D * 2;
constexpr size_t O_MODS = O_WTFF2 + (size_t)2 * D * DFF * 2;
constexpr size_t O_ROPE = O_MODS + (size_t)2 * 3 * 6144 * 4;
constexpr size_t O_QA = O_ROPE + (size_t)1024 * 32 * 2 * 4;
constexpr size_t O_KACTX = O_QA + (size_t)NTOK * 512 * 2;
constexpr size_t O_KALAT = O_KACTX + (size_t)NCTX * 512 * 2;
constexpr size_t O_VTACTX = O_KALAT + (size_t)2 * 2 * 1536 * 512 * 2;
constexpr size_t O_VTALAT = O_VTACTX + (size_t)16 * 4 * 128 * 256 * 2;
constexpr size_t O_QC = O_VTALAT + (size_t)2 * 2 * 4 * 128 * 1536 * 2;
constexpr size_t O_KCCTX = O_QC + (size_t)NTOK * 256 * 2;
constexpr size_t O_KCLAT = O_KCCTX + (size_t)NCTX * 128 * 2;
constexpr size_t O_VTCCTX = O_KCLAT + (size_t)2 * 2 * 1536 * 128 * 2;
constexpr size_t O_VTCLAT = O_VTCCTX + (size_t)16 * 2 * 64 * 256 * 2;
constexpr size_t O_KV = O_VTCLAT + (size_t)2 * 2 * 2 * 64 * 1536 * 2;
constexpr size_t O_DEC = O_KV + (size_t)768 * 4096 * 4;
constexpr size_t O_MIXED = O_DEC + (size_t)768 * 64 * 4;
constexpr size_t O_XPRE1 = O_MIXED + (size_t)NTOK * 1024 * 2;
constexpr size_t O_ST1 = O_XPRE1 + (size_t)NTOK * 1024 * 4;
constexpr size_t O_XPRE2 = O_ST1 + (size_t)NTOK * 32 * 4;
constexpr size_t O_ST2 = O_XPRE2 + (size_t)NTOK * 1024 * 4;
constexpr size_t O_ABF = O_ST2 + (size_t)NTOK * 32 * 4;
constexpr size_t O_HQ = O_ABF + (size_t)NTOK * 1024 * 2;
constexpr size_t O_HGF = O_HQ + (size_t)NTOK * 256 * 4;
constexpr size_t O_HGB = O_HGF + (size_t)NTOK * 256 * 4;
constexpr size_t O_HI = O_HGB + (size_t)NTOK * 256 * 4;
constexpr size_t O_HSG = O_HI + (size_t)NTOK * 256 * 4;
constexpr size_t O_OI = O_HSG + (size_t)NTOK * 256 * 4;
constexpr size_t O_QE = O_OI + (size_t)2 * NTOK * 256 * 4;
constexpr size_t O_END1 = O_QE + (size_t)2 * NTOK * 256 * 4;
constexpr size_t O_HID = O_HQ;
constexpr size_t O_END2 = O_HID + (size_t)NTOK * 4096 * 2;
static_assert(O_END2 <= O_END1, "HID alias must fit");
static_assert(O_END1 <= (size_t)256 * 1024 * 1024, "workspace too big");

constexpr size_t OUT_YP = 0, OUT_YS = 4194304, OUT_AK = 6291456, OUT_AV = 10485760, OUT_CK = 14680064,
                 OUT_CV = 15728640, OUT_SF = 16777216, OUT_SB = 17301504;

struct P {
  const float* in[30];
  float* out;
  char* ws;
};

DI unsigned pack2(float a, float b) {
  f2_t v = {a, b};
  bf2_t r = __builtin_convertvector(v, bf2_t);
  return __builtin_bit_cast(unsigned, r);
}
DI u16 f2bf(float x) { return (u16)(pack2(x, 0.f) & 0xffffu); }
DI float ex2(float x) { return __builtin_amdgcn_exp2f(x); }
DI float siluf(float x) { return x / (1.f + expf(-x)); }
DI float shx(float v, int m) { return __shfl_xor(v, m, 64); }
DI int ltid() { int t = threadIdx.x; asm volatile("" : "+v"(t)); return t; }
#define MFMA16(a, b, c) __builtin_amdgcn_mfma_f32_16x16x32_bf16((a), (b), (c), 0, 0, 0)

DI void p0_mod(const P& p, int item, char* smem) {
  float* ssilu = (float*)smem;
  float* red = ssilu + 3072;
  const int tid = ltid();
  __syncthreads();
  for (int i = tid; i < 3072; i += 256) {
    int w = i >> 10, k = i & 1023;
    float v = (w == 0) ? p.in[9][k] : p.in[8][(w - 1) * 1024 + k];
    ssilu[i] = siluf(v);
  }
  __syncthreads();
  const int li = item / 96, j0 = (item % 96) * 64;
  const int c4 = tid & 15, kp = tid >> 4;
  const float* W = p.in[10] + (size_t)li * 1024 * 6144 + j0 + c4 * 4;
  float4 a0 = {0, 0, 0, 0}, a1 = a0, a2 = a0;
#pragma unroll 4
  for (int kk = 0; kk < 64; ++kk) {
    int k = kp * 64 + kk;
    float4 w4 = *(const float4*)(W + (size_t)k * 6144);
    float s0 = ssilu[k], s1 = ssilu[1024 + k], s2 = ssilu[2048 + k];
    a0.x += s0 * w4.x; a0.y += s0 * w4.y; a0.z += s0 * w4.z; a0.w += s0 * w4.w;
    a1.x += s1 * w4.x; a1.y += s1 * w4.y; a1.z += s1 * w4.z; a1.w += s1 * w4.w;
    a2.x += s2 * w4.x; a2.y += s2 * w4.y; a2.z += s2 * w4.z; a2.w += s2 * w4.w;
  }
  *(float4*)(red + (kp * 3 + 0) * 64 + c4 * 4) = a0;
  *(float4*)(red + (kp * 3 + 1) * 64 + c4 * 4) = a1;
  *(float4*)(red + (kp * 3 + 2) * 64 + c4 * 4) = a2;
  __syncthreads();
  if (tid < 192) {
    int w = tid >> 6, c = tid & 63;
    float s = p.in[11][li * 6144 + j0 + c];
    for (int q = 0; q < 16; ++q) s += red[(q * 3 + w) * 64 + c];
    ((float*)(p.ws + O_MODS))[(li * 3 + w) * 6144 + j0 + c] = s;
  }
}

DI void p0_rope(const P& p, int item) {
  float* R = (float*)(p.ws + O_ROPE);
  for (int i = ltid(); i < 4096; i += 256) {
    int idx = item * 4096 + i;
    int t = idx >> 5, pp = idx & 31;
    float inv = powf(10000.f, -(float)(pp & 15) / 16.f);
    float pos = (pp < 16) ? (float)(t >> 6) : (float)(t & 63);
    float ang = pos * inv;
    R[idx * 2] = cosf(ang);
    R[idx * 2 + 1] = sinf(ang);
  }
}

DI void p0_copyk(const P& p, int item, bool isA) {
  const int W = isA ? 512 : 128;
  const float* src = isA ? p.in[2] : p.in[4];
  u16* dst = (u16*)(p.ws + (isA ? O_KALAT : O_KCLAT));
  for (int i = 0; i < 4; ++i) {
    size_t e = (size_t)item * 4096 + (size_t)(ltid() + 256 * i) * 4;
    float4 v = *(const float4*)(src + e);
    int c = (int)(e % W);
    size_t r = e / W;
    int pp = (int)(r % 512);
    int bl = (int)(r / 512);
    int b = bl >> 1, li = bl & 1;
    uint2 o;
    o.x = pack2(v.x, v.y);
    o.y = pack2(v.z, v.w);
    *(uint2*)(dst + ((size_t)((li * 2 + b) * 1536 + 1024 + pp)) * W + c) = o;
  }
}

DI void transpose_tile(const float* src, int sstride, u16* dst, int dstride, char* smem) {
  float* t = (float*)smem;
  const int tid = ltid();
  __syncthreads();
#pragma unroll
  for (int i = 0; i < 4; ++i) {
    int idx = tid + 256 * i;
    int r = idx >> 4, c4 = idx & 15;
    float4 v = *(const float4*)(src + (size_t)r * sstride + c4 * 4);
    float* q = t + r * 65 + c4 * 4;
    q[0] = v.x; q[1] = v.y; q[2] = v.z; q[3] = v.w;
  }
  __syncthreads();
  const int c = tid >> 2, rs = tid & 3;
  unsigned o[8];
#pragma unroll
  for (int e = 0; e < 8; ++e) {
    float a = t[(rs * 16 + 2 * e) * 65 + c], b = t[(rs * 16 + 2 * e + 1) * 65 + c];
    o[e] = pack2(a, b);
  }
  uint4* dp = (uint4*)(dst + (size_t)c * dstride + rs * 16);
  dp[0] = make_uint4(o[0], o[1], o[2], o[3]);
  dp[1] = make_uint4(o[4], o[5], o[6], o[7]);
}

DI void phase0(const P& p, char* smem) {
  constexpr int N_MOD = 192, N_ROPE = 8, N_AK = 256, N_CK = 64;
  constexpr int T_IN = 1664, T_OUT = 512, T_FF1 = 2048, T_FF2 = 2048, T_AV = 256, T_CV = 64;
  constexpr int B_ROPE = N_MOD, B_AK = B_ROPE + N_ROPE, B_CK = B_AK + N_AK, B_T = B_CK + N_CK;
  constexpr int TOTAL = B_T + T_IN + T_OUT + T_FF1 + T_FF2 + T_AV + T_CV;
  for (int it = blockIdx.x; it < TOTAL; it += gridDim.x) {
    if (it < B_ROPE) p0_mod(p, it, smem);
    else if (it < B_AK) p0_rope(p, it - B_ROPE);
    else if (it < B_CK) p0_copyk(p, it - B_AK, true);
    else if (it < B_T) p0_copyk(p, it - B_CK, false);
    else {
      int t = it - B_T;
      if (t < T_IN) {
        int li = t / 832, r = t % 832, kt = r / 52, nt = r % 52;
        transpose_tile(p.in[12] + (size_t)li * 1024 * NIN + (size_t)(kt * 64) * NIN + nt * 64, NIN,
                       (u16*)(p.ws + O_WTIN) + (size_t)li * NIN * 1024 + (size_t)(nt * 64) * 1024 + kt * 64, 1024, smem);
      } else if ((t -= T_IN) < T_OUT) {
        int li = t / 256, r = t % 256, kt = r / 16, nt = r % 16;
        transpose_tile(p.in[13] + (size_t)li * 1024 * 1024 + (size_t)(kt * 64) * 1024 + nt * 64, 1024,
                       (u16*)(p.ws + O_WTOUT) + (size_t)li * 1024 * 1024 + (size_t)(nt * 64) * 1024 + kt * 64, 1024, smem);
      } else if ((t -= T_OUT) < T_FF1) {
        int li = t / 1024, r = t % 1024, kt = r / 64, nt = r % 64;
        transpose_tile(p.in[28] + (size_t)li * 1024 * DFF + (size_t)(kt * 64) * DFF + nt * 64, DFF,
                       (u16*)(p.ws + O_WTFF1) + (size_t)li * DFF * 1024 + (size_t)(nt * 64) * 1024 + kt * 64, 1024, smem);
      } else if ((t -= T_FF1) < T_FF2) {
        int li = t / 1024, r = t % 1024, kt = r / 16, nt = r % 16;
        transpose_tile(p.in[29] + (size_t)li * DFF * 1024 + (size_t)(kt * 64) * 1024 + nt * 64, 1024,
                       (u16*)(p.ws + O_WTFF2) + (size_t)li * 1024 * DFF + (size_t)(nt * 64) * DFF + kt * 64, DFF, smem);
      } else if ((t -= T_FF2) < T_AV) {
        int bl = t / 64, r = t % 64, pt = r / 8, ct = r % 8;
        int b = bl >> 1, li = bl & 1;
        transpose_tile(p.in[3] + ((size_t)bl * 512 + pt * 64) * 512 + ct * 64, 512,
                       (u16*)(p.ws + O_VTALAT) + ((size_t)(li * 2 + b) * 512 + ct * 64) * 1536 + 1024 + pt * 64, 1536, smem);
      } else {
        t -= T_AV;
        int bl = t / 16, r = t % 16, pt = r / 2, ct = r % 2;
        int b = bl >> 1, li = bl & 1;
        transpose_tile(p.in[5] + ((size_t)bl * 512 + pt * 64) * 128 + ct * 64, 128,
                       (u16*)(p.ws + O_VTCLAT) + ((size_t)(li * 2 + b) * 128 + ct * 64) * 1536 + 1024 + pt * 64, 1536, smem);
      }
    }
  }
}

struct GA {
  const float* alo;
  const float* ahi;
  const float* stats;
  const float* lng;
  const float* lnb;
  const float* mods;
  int sc_off, sh_off;
  const u16* a16;
  const u16* bt;
  int K, N;
  float* xout;
  float* sout;
  u16* hid;
};

DI void epi_inproj(const P& p, int li, f32x4 (&acc)[4][4], int R0, int C0);

typedef unsigned u32x4 __attribute__((ext_vector_type(4)));
typedef unsigned u32x2 __attribute__((ext_vector_type(2)));

template <int EPI>
DI void gemm_tile(const P& p, const GA& g, int li, int m0, int n0, char* smem) {
  const int tid = ltid(), lane = tid & 63, wid = tid >> 6, wr = wid >> 1, wc = wid & 1;
  const int l16 = lane & 15, q4 = lane >> 4;
  u16* sA0 = (u16*)smem;
  u16* sB0 = sA0 + 128 * 72;
  u16* sA1 = sB0 + 128 * 72;
  u16* sB1 = sA1 + 128 * 72;
  float2* sStat = (float2*)(smem + 73728);
  const int K = g.K;
  const int rtype = (m0 < NCTX) ? 0 : 1 + ((m0 - NCTX) >> 10);
  const float* modv = g.mods + rtype * 6144;
  const float* fsrc = (m0 < NCTX) ? g.alo + (size_t)m0 * 1024 : g.ahi + (size_t)(m0 - NCTX) * 1024;

  __syncthreads();
  if constexpr (EPI == 1) {
    if (g.stats != nullptr && tid < 128) {
      const float4* sp = (const float4*)(g.stats + (size_t)(m0 + tid) * 32);
      float s1 = 0.f, s2 = 0.f;
#pragma unroll
      for (int i = 0; i < 8; ++i) {
        float4 v = sp[i];
        s1 += v.x + v.z;
        s2 += v.y + v.w;
      }
      float mu = s1 * (1.f / 1024.f);
      float var = s2 * (1.f / 1024.f) - mu * mu;
      sStat[tid] = make_float2(mu, rsqrtf(fmaxf(var, 0.f) + 1e-6f));
    }
  }

  f32x4 acc[4][4];
#pragma unroll
  for (int i = 0; i < 4; ++i)
#pragma unroll
    for (int j = 0; j < 4; ++j) acc[i][j] = f32x4{0.f, 0.f, 0.f, 0.f};

  u32x4 ra0[4], rb0[4], ra1[4], rb1[4];
  const unsigned goff = (unsigned)(tid >> 3) * (unsigned)K + (unsigned)(tid & 7) * 8u;
  const unsigned loff = (unsigned)(tid >> 3) * 72u + (unsigned)(tid & 7) * 8u;
  const u16* abase = g.a16 + (size_t)m0 * K;
  const u16* bbase = g.bt + (size_t)n0 * K;
#define GLOAD(RA, RB, KT)                                                        \
  _Pragma("unroll") for (int i = 0; i < 4; ++i) {                                \
    RA[i] = *(const u32x4*)(abase + (size_t)(32 * i) * K + (KT) * 64 + goff);    \
    RB[i] = *(const u32x4*)(bbase + (size_t)(32 * i) * K + (KT) * 64 + goff);    \
  }
#define LSTORE(SA, SB, RA, RB)                                                   \
  _Pragma("unroll") for (int i = 0; i < 4; ++i) {                                \
    *(u32x4*)(SA + 32 * i * 72 + loff) = RA[i];                                  \
    *(u32x4*)(SB + 32 * i * 72 + loff) = RB[i];                                  \
  }
#define COMPUTE(SA, SB)                                                          \
  _Pragma("unroll") for (int s = 0; s < 2; ++s) {                                \
    bf16x8 af[4], bfr[4];                                                        \
    _Pragma("unroll") for (int i = 0; i < 4; ++i) {                              \
      af[i] = *(const bf16x8*)(SA + (wr * 64 + i * 16 + l16) * 72 + s * 32 + q4 * 8);  \
      bfr[i] = *(const bf16x8*)(SB + (wc * 64 + i * 16 + l16) * 72 + s * 32 + q4 * 8); \
    }                                                                            \
    _Pragma("unroll") for (int i = 0; i < 4; ++i)                                \
      _Pragma("unroll") for (int j = 0; j < 4; ++j) acc[i][j] = MFMA16(af[i], bfr[j], acc[i][j]); \
    __builtin_amdgcn_sched_barrier(0);                                           \
  }

  const int nk = K >> 6;
  GLOAD(ra0, rb0, 0);
  GLOAD(ra1, rb1, 1);
  LSTORE(sA0, sB0, ra0, rb0);
  GLOAD(ra0, rb0, 2);
  __syncthreads();
#pragma unroll 1
  for (int kt = 0; kt < nk; kt += 2) {
    LSTORE(sA1, sB1, ra1, rb1);
    if (kt + 3 < nk) { GLOAD(ra1, rb1, kt + 3); }
    COMPUTE(sA0, sB0);
    __syncthreads();
    if (kt + 2 < nk) { LSTORE(sA0, sB0, ra0, rb0); }
    if (kt + 4 < nk) { GLOAD(ra0, rb0, kt + 4); }
    COMPUTE(sA1, sB1);
    __syncthreads();
  }
#undef GLOAD
#undef LSTORE
#undef COMPUTE
  asm volatile("" ::: "memory");

  const int R0 = m0 + wr * 64, C0 = n0 + wc * 64;
  if constexpr (EPI == 0) {
    epi_inproj(p, li, acc, R0, C0);
  } else if constexpr (EPI == 1) {
    float gate[4], lg[4], lb[4];
#pragma unroll
    for (int j = 0; j < 4; ++j) {
      int col = C0 + j * 16 + l16;
      gate[j] = modv[g.sc_off + col];
      lg[j] = g.stats ? g.lng[col] : 1.f;
      lb[j] = g.stats ? g.lnb[col] : 0.f;
    }
#pragma unroll
    for (int i = 0; i < 4; ++i) {
#pragma unroll
      for (int r = 0; r < 4; ++r) {
        int lrow = wr * 64 + i * 16 + q4 * 4 + r;
        float mu = 0.f, rs = 1.f;
        if (g.stats != nullptr) {
          float2 st = sStat[lrow];
          mu = st.x;
          rs = st.y;
        }
        float s1 = 0.f, s2 = 0.f;
#pragma unroll
        for (int j = 0; j < 4; ++j) {
          int col = C0 + j * 16 + l16;
          float x = fsrc[(size_t)lrow * 1024 + col];
          x = (x - mu) * rs * lg[j] + lb[j];
          float v = ALPHA * x + gate[j] * acc[i][j][r];
          g.xout[(size_t)(m0 + lrow) * 1024 + col] = v;
          s1 += v;
          s2 += v * v;
        }
        s1 += shx(s1, 1); s2 += shx(s2, 1);
        s1 += shx(s1, 2); s2 += shx(s2, 2);
        s1 += shx(s1, 4); s2 += shx(s2, 4);
        s1 += shx(s1, 8); s2 += shx(s2, 8);
        if (l16 == 0) *(float2*)(g.sout + (size_t)(m0 + lrow) * 32 + (C0 >> 6) * 2) = make_float2(s1, s2);
      }
    }
  } else {
#pragma unroll
    for (int i = 0; i < 4; ++i)
#pragma unroll
      for (int r = 0; r < 4; ++r) {
        int row = R0 + i * 16 + q4 * 4 + r;
#pragma unroll
        for (int j = 0; j < 4; ++j) {
          float v = fmaxf(acc[i][j][r], 0.f);
          g.hid[(size_t)row * DFF + C0 + j * 16 + l16] = f2bf(v * v);
        }
      }
  }
}

DI void epi_inproj(const P& p, int li, f32x4 (&acc)[4][4], int R0, int C0) {
  const int lane = ltid() & 63, l16 = lane & 15, q4 = lane >> 4;
  const int seg = C0 >> 6;
  const bool lat = R0 >= NCTX;
  const float2* rope = (const float2*)(p.ws + O_ROPE);
  int b, tb;
  if (!lat) { b = R0 >> 8; tb = R0 & 255; } else { b = (R0 - NCTX) >> 10; tb = (R0 - NCTX) & 1023; }

  enum { T_QA, T_KA, T_VA, T_QB, T_FF, T_FB, T_IB, T_GB, T_QC, T_KC, T_VC };
  int type, cbase;
  if (seg < 8) { type = T_QA; cbase = seg * 64; }
  else if (seg < 16) { type = T_KA; cbase = (seg - 8) * 64; }
  else if (seg < 24) { type = T_VA; cbase = (seg - 16) * 64; }
  else if (seg < 28) { type = T_QB; cbase = (seg - 24) * 64; }
  else if (seg < 32) { type = T_FF; cbase = (seg - 28) * 64; }
  else if (seg < 36) { type = T_FB; cbase = (seg - 32) * 64; }
  else if (seg < 40) { type = T_IB; cbase = (seg - 36) * 64; }
  else if (seg < 44) { type = T_GB; cbase = (seg - 40) * 64; }
  else if (seg < 48) { type = T_QC; cbase = (seg - 44) * 64; }
  else if (seg < 50) { type = T_KC; cbase = (seg - 48) * 64; }
  else { type = T_VC; cbase = (seg - 50) * 64; }

  if (type == T_QC || type == T_KC) {
    const float* gv = (type == T_QC ? p.in[22] : p.in[23]) + li * 64;
    float gj[4];
#pragma unroll
    for (int j = 0; j < 4; ++j) gj[j] = gv[j * 16 + l16];
#pragma unroll
    for (int i = 0; i < 4; ++i)
#pragma unroll
      for (int r = 0; r < 4; ++r) {
        float ss = 0.f;
#pragma unroll
        for (int j = 0; j < 4; ++j) ss += acc[i][j][r] * acc[i][j][r];
        ss += shx(ss, 1); ss += shx(ss, 2); ss += shx(ss, 4); ss += shx(ss, 8);
        float rs = rsqrtf(ss * (1.f / 64.f) + 1e-6f);
#pragma unroll
        for (int j = 0; j < 4; ++j) acc[i][j][r] = acc[i][j][r] * rs * gj[j];
      }
  }
  if (!lat && (type == T_KA || type == T_VA || type == T_KC || type == T_VC)) {
    float* o;
    int W;
    if (type == T_KA) { o = p.out + OUT_AK; W = 512; }
    else if (type == T_VA) { o = p.out + OUT_AV; W = 512; }
    else if (type == T_KC) { o = p.out + OUT_CK; W = 128; }
    else { o = p.out + OUT_CV; W = 128; }
#pragma unroll
    for (int i = 0; i < 4; ++i)
#pragma unroll
      for (int r = 0; r < 4; ++r) {
        int t = tb + i * 16 + q4 * 4 + r;
        size_t base = ((size_t)(b * 2 + li) * 256 + t) * W + cbase;
#pragma unroll
        for (int j = 0; j < 4; ++j) o[base + j * 16 + l16] = acc[i][j][r];
      }
  }
  if (lat && (type == T_QA || type == T_KA || type == T_QC || type == T_KC)) {
#pragma unroll
    for (int i = 0; i < 4; ++i)
#pragma unroll
      for (int r = 0; r < 4; ++r) {
        int t = tb + i * 16 + q4 * 4 + r;
#pragma unroll
        for (int j = 0; j < 4; ++j) {
          float v = acc[i][j][r];
          float pv = shx(v, 1);
          float2 cs = rope[t * 32 + j * 8 + (l16 >> 1)];
          acc[i][j][r] = (l16 & 1) ? (pv * cs.y + v * cs.x) : (v * cs.x - pv * cs.y);
        }
      }
  }

  if (type == T_QA || type == T_KA || type == T_QC || type == T_KC) {
    u16* dst;
    int W;
    size_t rowbase;
    if (type == T_QA) { dst = (u16*)(p.ws + O_QA); W = 512; rowbase = (size_t)R0 * 512; }
    else if (type == T_QC) { dst = (u16*)(p.ws + O_QC); W = 256; rowbase = (size_t)R0 * 256; }
    else if (type == T_KA) {
      W = 512;
      if (!lat) { dst = (u16*)(p.ws + O_KACTX); rowbase = (size_t)R0 * 512; }
      else { dst = (u16*)(p.ws + O_KALAT); rowbase = ((size_t)(li * 2 + b) * 1536 + tb) * 512; }
    } else {
      W = 128;
      if (!lat) { dst = (u16*)(p.ws + O_KCCTX); rowbase = (size_t)R0 * 128; }
      else { dst = (u16*)(p.ws + O_KCLAT); rowbase = ((size_t)(li * 2 + b) * 1536 + tb) * 128; }
    }
#pragma unroll
    for (int i = 0; i < 4; ++i)
#pragma unroll
      for (int r = 0; r < 4; ++r) {
        size_t base = rowbase + (size_t)(i * 16 + q4 * 4 + r) * W + cbase;
#pragma unroll
        for (int j = 0; j < 4; ++j) dst[base + j * 16 + l16] = f2bf(acc[i][j][r]);
      }
  } else if (type == T_VA || type == T_VC) {
    u16* dst;
    int L;
    size_t hb;
    if (type == T_VA) {
      int h = cbase >> 7, dv0 = cbase & 127;
      if (!lat) { dst = (u16*)(p.ws + O_VTACTX); L = 256; hb = ((size_t)(b * 4 + h) * 128 + dv0) * 256; }
      else { dst = (u16*)(p.ws + O_VTALAT); L = 1536; hb = ((size_t)((li * 2 + b) * 4 + h) * 128 + dv0) * 1536; }
    } else {
      int n = cbase >> 6;
      if (!lat) { dst = (u16*)(p.ws + O_VTCCTX); L = 256; hb = ((size_t)(b * 2 + n) * 64) * 256; }
      else { dst = (u16*)(p.ws + O_VTCLAT); L = 1536; hb = ((size_t)((li * 2 + b) * 2 + n) * 64) * 1536; }
    }
#pragma unroll
    for (int i = 0; i < 4; ++i)
#pragma unroll
      for (int j = 0; j < 4; ++j) {
        uint2 o;
        o.x = pack2(acc[i][j][0], acc[i][j][1]);
        o.y = pack2(acc[i][j][2], acc[i][j][3]);
        *(uint2*)(dst + hb + (size_t)(j * 16 + l16) * L + tb + i * 16 + q4 * 4) = o;
      }
  } else {
    float* dst;
    if (type == T_QB) dst = (float*)(p.ws + O_HQ);
    else if (type == T_FF) dst = (float*)(p.ws + O_HGF);
    else if (type == T_FB) dst = (float*)(p.ws + O_HGB);
    else if (type == T_IB) dst = (float*)(p.ws + O_HI);
    else dst = (float*)(p.ws + O_HSG);
    float lbv[4] = {0.f, 0.f, 0.f, 0.f};
    if ((type == T_FF || type == T_FB) && li == 1) {
      const float* lg = (type == T_FF) ? p.in[19] : p.in[20];
#pragma unroll
      for (int j = 0; j < 4; ++j) {
        int c = cbase + j * 16 + l16;
        lbv[j] = 1.f / (1.f + expf(lg[c] - lg[256 + c]));
      }
    }
#pragma unroll
    for (int i = 0; i < 4; ++i)
#pragma unroll
      for (int r = 0; r < 4; ++r) {
        size_t base = (size_t)(R0 + i * 16 + q4 * 4 + r) * 256 + cbase;
#pragma unroll
        for (int j = 0; j < 4; ++j) {
          float v = acc[i][j][r];
          float o;
          if (type == T_QB || type == T_GB) o = siluf(v);
          else if (type == T_IB) o = v;
          else {
            float sg = 1.f / (1.f + expf(-v));
            float f = lbv[j] + (1.f - lbv[j]) * sg;
            o = logf(fmaxf(f, 1e-6f));
          }
          dst[base + j * 16 + l16] = o;
        }
      }
  }
}

template <int EPI>
DI void gemm_phase(const P& p, const GA& g, int li, char* smem) {
  const int NT = g.N >> 7;
  const int xcd = blockIdx.x & 7, lb = blockIdx.x >> 3, nlb = gridDim.x >> 3;
  if (lb >= nlb) return;
  for (int t = lb; t < 6 * NT; t += nlb) {
    int mt = xcd * 6 + t / NT, nt = t % NT;
    gemm_tile<EPI>(p, g, li, mt * 128, nt * 128, smem);
  }
}


template <int KW, int DV>
DI void attn_gload(const u16* Kb, int kstride, const u16* VT, int L, int kb, int tid, u32x4 (&kr)[KW / 32], u32x4 (&vr)[DV / 32]) {
  constexpr int KPR = 256 / (KW / 8);
  const unsigned koff = (unsigned)(tid / (KW / 8)) * (unsigned)kstride + (unsigned)(tid % (KW / 8)) * 8u;
  const unsigned voff = (unsigned)(tid >> 3) * (unsigned)L + (unsigned)(tid & 7) * 8u;
#pragma unroll
  for (int i = 0; i < KW / 32; ++i) {
    const u16* kbp = Kb + (size_t)(kb * 64 + KPR * i) * kstride;
    kr[i] = *(const u32x4*)(kbp + koff);
  }
#pragma unroll
  for (int i = 0; i < DV / 32; ++i) {
    const u16* vbp = VT + (size_t)(32 * i) * L + kb * 64;
    vr[i] = *(const u32x4*)(vbp + voff);
  }
}
template <int KW, int DV, bool DIFF>
DI void attn_item(const u16* Q, int qstride, int qcol, int qrow0, const u16* Kb, int kstride, const u16* VT, int L,
                          int nkeys, u16* mixed, int mixcol, float lam, float postscale, const float* subg, char* smem) {
  const int tid = ltid(), lane = tid & 63, wid = tid >> 6, l16 = lane & 15, q4 = lane >> 4;
  const int qsub = wid & 1, var = wid >> 1;
  constexpr int KS = KW + 8;
  u16* sK = (u16*)smem;
  u16* sV = sK + 64 * KS;
  constexpr int KPT = KW / 32, VPT = DV / 32, NDT = DV / 16;
  const int kfo = DIFF ? var * 64 : 0;
  const float c = 0.125f * LOG2E;

  const u16* qp = Q + (size_t)(qrow0 + qsub * 16 + l16) * qstride + qcol + var * 64 + q4 * 8;
  const bf16x8 qf0 = *(const bf16x8*)qp;
  const bf16x8 qf1 = *(const bf16x8*)(qp + 32);

  u32x4 kr[KPT], vr[VPT];
  f32x4 o[NDT];
#pragma unroll
  for (int d = 0; d < NDT; ++d) o[d] = f32x4{0.f, 0.f, 0.f, 0.f};
  float m = -INFINITY, l = 0.f;
  const int nkb = nkeys >> 6;
  attn_gload<KW, DV>(Kb, kstride, VT, L, 0, tid, kr, vr);
  for (int kb = 0; kb < nkb; ++kb) {
    __syncthreads();
#pragma unroll
    for (int i = 0; i < KPT; ++i) {
      int idx = tid + 256 * i;
      int key = idx / (KW / 8), cc = idx % (KW / 8);
      *(u32x4*)(sK + key * KS + cc * 8) = kr[i];
    }
#pragma unroll
    for (int i = 0; i < VPT; ++i) {
      int idx = tid + 256 * i;
      int row = idx >> 3, cc = idx & 7;
      *(u32x4*)(sV + row * 72 + cc * 8) = vr[i];
    }
    __syncthreads();
    if (kb + 1 < nkb) attn_gload<KW, DV>(Kb, kstride, VT, L, kb + 1, tid, kr, vr);

    f32x4 st[4];
#pragma unroll
    for (int kt = 0; kt < 4; ++kt) {
      const u16* kp = sK + (kt * 16 + l16) * KS + kfo + q4 * 8;
      bf16x8 k0 = *(const bf16x8*)kp;
      bf16x8 k1 = *(const bf16x8*)(kp + 32);
      f32x4 z = {0.f, 0.f, 0.f, 0.f};
      z = MFMA16(k0, qf0, z);
      st[kt] = MFMA16(k1, qf1, z);
    }
    float bm = st[0][0];
#pragma unroll
    for (int kt = 0; kt < 4; ++kt)
#pragma unroll
      for (int r = 0; r < 4; ++r) bm = fmaxf(bm, st[kt][r]);
    bm = fmaxf(bm, shx(bm, 16));
    bm = fmaxf(bm, shx(bm, 32));
    const float mn = fmaxf(m, bm);
    const float alpha = ex2((m - mn) * c);
    m = mn;
    float ps = 0.f;
#pragma unroll
    for (int kt = 0; kt < 4; ++kt)
#pragma unroll
      for (int r = 0; r < 4; ++r) {
        float pv = ex2((st[kt][r] - mn) * c);
        st[kt][r] = pv;
        ps += pv;
      }
    l = l * alpha + ps;
#pragma unroll
    for (int d = 0; d < NDT; ++d) {
      o[d][0] *= alpha; o[d][1] *= alpha; o[d][2] *= alpha; o[d][3] *= alpha;
    }
#pragma unroll
    for (int ks = 0; ks < 2; ++ks) {
      unsigned pk[4];
      pk[0] = pack2(st[2 * ks][0], st[2 * ks][1]);
      pk[1] = pack2(st[2 * ks][2], st[2 * ks][3]);
      pk[2] = pack2(st[2 * ks + 1][0], st[2 * ks + 1][1]);
      pk[3] = pack2(st[2 * ks + 1][2], st[2 * ks + 1][3]);
      uint4 pu = make_uint4(pk[0], pk[1], pk[2], pk[3]);
      bf16x8 pf = __builtin_bit_cast(bf16x8, pu);
#pragma unroll
      for (int d = 0; d < NDT; ++d) {
        const u16* vp = sV + (d * 16 + l16) * 72 + ks * 32 + q4 * 4;
        uint2 v0 = *(const uint2*)vp;
        uint2 v1 = *(const uint2*)(vp + 16);
        uint4 vu = make_uint4(v0.x, v0.y, v1.x, v1.y);
        bf16x8 vf = __builtin_bit_cast(bf16x8, vu);
        o[d] = MFMA16(vf, pf, o[d]);
      }
    }
  }
  l += shx(l, 16);
  l += shx(l, 32);
  const float inv = 1.f / l;
  const int row = qrow0 + qsub * 16 + l16;
  if constexpr (DIFF) {
    __syncthreads();
    float* sO = (float*)smem;
    if (var == 1) {
#pragma unroll
      for (int d = 0; d < NDT; ++d)
        *(float4*)(sO + (qsub * 16 + l16) * 132 + d * 16 + q4 * 4) =
            make_float4(o[d][0] * inv, o[d][1] * inv, o[d][2] * inv, o[d][3] * inv);
    }
    __syncthreads();
    if (var == 0) {
      float ss = 0.f;
#pragma unroll
      for (int d = 0; d < NDT; ++d) {
        float4 o1 = *(const float4*)(sO + (qsub * 16 + l16) * 132 + d * 16 + q4 * 4);
        o[d][0] = o[d][0] * inv - lam * o1.x;
        o[d][1] = o[d][1] * inv - lam * o1.y;
        o[d][2] = o[d][2] * inv - lam * o1.z;
        o[d][3] = o[d][3] * inv - lam * o1.w;
        ss += o[d][0] * o[d][0] + o[d][1] * o[d][1] + o[d][2] * o[d][2] + o[d][3] * o[d][3];
      }
      ss += shx(ss, 16);
      ss += shx(ss, 32);
      const float rs = rsqrtf(ss * (1.f / 128.f) + 1e-6f) * postscale;
#pragma unroll
      for (int d = 0; d < NDT; ++d) {
        float4 gg = *(const float4*)(subg + d * 16 + q4 * 4);
        uint2 ov;
        ov.x = pack2(o[d][0] * rs * gg.x, o[d][1] * rs * gg.y);
        ov.y = pack2(o[d][2] * rs * gg.z, o[d][3] * rs * gg.w);
        *(uint2*)(mixed + (size_t)row * 1024 + mixcol + d * 16 + q4 * 4) = ov;
      }
    }
  } else {
#pragma unroll
    for (int d = 0; d < NDT; ++d) {
      uint2 ov;
      ov.x = pack2(o[d][0] * inv, o[d][1] * inv);
      ov.y = pack2(o[d][2] * inv, o[d][3] * inv);
      *(uint2*)(mixed + (size_t)row * 1024 + mixcol + var * 64 + d * 16 + q4 * 4) = ov;
    }
  }
}

DI void attnA_item(const P& p, int li, int it, char* smem) {
  const int lane = ltid() & 63;
  float d1 = p.in[14][li * 64 + lane] * p.in[15][li * 64 + lane];
  float d2 = p.in[16][li * 64 + lane] * p.in[17][li * 64 + lane];
#pragma unroll
  for (int s = 1; s < 64; s <<= 1) { d1 += shx(d1, s); d2 += shx(d2, s); }
  const float lam_init = 0.8f - 0.6f * expf(-0.3f * (float)li);
  const float lam = expf(d1) - expf(d2) + lam_init;
  const u16* QA = (const u16*)(p.ws + O_QA);
  u16* mixed = (u16*)(p.ws + O_MIXED);
  const float* subg = p.in[18] + li * 128;
  int qrow0, L;
  const u16 *Kb, *VT;
  int h;
  if (it < 256) {
    int b = it >> 7, qb = it & 31;
    h = (it >> 5) & 3;
    Kb = (const u16*)(p.ws + O_KALAT) + (size_t)(li * 2 + b) * 1536 * 512 + h * 128;
    VT = (const u16*)(p.ws + O_VTALAT) + (size_t)((li * 2 + b) * 4 + h) * 128 * 1536;
    qrow0 = NCTX + b * 1024 + qb * 32;
    L = 1536;
  } else {
    it -= 256;
    int b = it >> 5, qb = it & 7;
    h = (it >> 3) & 3;
    Kb = (const u16*)(p.ws + O_KACTX) + (size_t)b * 256 * 512 + h * 128;
    VT = (const u16*)(p.ws + O_VTACTX) + (size_t)(b * 4 + h) * 128 * 256;
    qrow0 = b * 256 + qb * 32;
    L = 256;
  }
  attn_item<128, 128, true>(QA, 512, h * 128, qrow0, Kb, 512, VT, L, L, mixed, h * 128, lam, 1.f - lam_init, subg, smem);
}
DI void attnC_item(const P& p, int li, int it, char* smem) {
  const u16* QC = (const u16*)(p.ws + O_QC);
  u16* mixed = (u16*)(p.ws + O_MIXED);
  int qrow0, L, n;
  const u16 *Kb, *VT;
  if (it < 128) {
    int b = it >> 6, qb = it & 31;
    n = (it >> 5) & 1;
    Kb = (const u16*)(p.ws + O_KCLAT) + (size_t)(li * 2 + b) * 1536 * 128 + n * 64;
    VT = (const u16*)(p.ws + O_VTCLAT) + (size_t)((li * 2 + b) * 2 + n) * 64 * 1536;
    qrow0 = NCTX + b * 1024 + qb * 32;
    L = 1536;
  } else {
    it -= 128;
    int b = it >> 4, qb = it & 7;
    n = (it >> 3) & 1;
    Kb = (const u16*)(p.ws + O_KCCTX) + (size_t)b * 256 * 128 + n * 64;
    VT = (const u16*)(p.ws + O_VTCCTX) + (size_t)(b * 2 + n) * 64 * 256;
    qrow0 = b * 256 + qb * 32;
    L = 256;
  }
  attn_item<64, 64, false>(QC, 256, n * 128, qrow0, Kb, 128, VT, L, L, mixed, 768 + n * 128, 0.f, 1.f, nullptr, smem);
}

DI void h1_item(const P& p, int item, char* smem) {
  const int tid = ltid();
  const int dir = item & 1, h = (item >> 1) & 3, tc = item >> 3;
  const int row0 = tc * 64;
  float* sQ = (float*)smem;
  float* sB = sQ + 64 * 68;
  float* sK = sB + 64 * 68;
  float* sV = sK + 64 * 68;
  float* sTot = sV + 64 * 64;
  const float* HQ = (const float*)(p.ws + O_HQ);
  const float* HG = (const float*)(p.ws + (dir ? O_HGB : O_HGF));
  const float* HI = (const float*)(p.ws + O_HI);
  float* OI = (float*)(p.ws + O_OI) + (size_t)dir * NTOK * 256;
  float* QE = (float*)(p.ws + O_QE) + (size_t)dir * NTOK * 256;
  float* KV = (float*)(p.ws + O_KV) + (size_t)item * 4096;
  float* DEC = (float*)(p.ws + O_DEC) + (size_t)item * 64;

  __syncthreads();
#pragma unroll
  for (int i = 0; i < 4; ++i) {
    int idx = tid + 256 * i;
    int lo = idx >> 4, c4 = idx & 15;
    int row = dir ? row0 + 63 - lo : row0 + lo;
    size_t off = (size_t)row * 256 + h * 64 + c4 * 4;
    *(float4*)(sQ + lo * 68 + c4 * 4) = *(const float4*)(HQ + off);
    *(float4*)(sB + lo * 68 + c4 * 4) = *(const float4*)(HG + off);
    *(float4*)(sV + lo * 64 + c4 * 4) = *(const float4*)(HI + off);
  }
  __syncthreads();
  {
    const int k = tid & 63, part = tid >> 6;
    float run = 0.f;
#pragma unroll 4
    for (int e = 0; e < 16; ++e) {
      int i = part * 16 + e;
      float g = sB[i * 68 + k];
      sK[i * 68 + k] = -expm1f(g);
      run += g * LOG2E;
      sB[i * 68 + k] = run;
    }
    sTot[part * 64 + k] = run;
    __syncthreads();
    float add = 0.f;
    for (int pp = 0; pp < part; ++pp) add += sTot[pp * 64 + k];
    if (part > 0)
      for (int e = 0; e < 16; ++e) sB[(part * 16 + e) * 68 + k] += add;
  }
  __syncthreads();
#pragma unroll
  for (int i = 0; i < 4; ++i) {
    int idx = tid + 256 * i;
    int lo = idx >> 4, c4 = idx & 15;
    int row = dir ? row0 + 63 - lo : row0 + lo;
    float4 q = *(const float4*)(sQ + lo * 68 + c4 * 4);
    float4 bb = *(const float4*)(sB + lo * 68 + c4 * 4);
    *(float4*)(QE + (size_t)row * 256 + h * 64 + c4 * 4) = make_float4(q.x * ex2(bb.x), q.y * ex2(bb.y), q.z * ex2(bb.z), q.w * ex2(bb.w));
  }
  const int ty = tid >> 4, tx = tid & 15;
  float at[4][4];
#pragma unroll
  for (int a = 0; a < 4; ++a)
#pragma unroll
    for (int cc = 0; cc < 4; ++cc) at[a][cc] = 0.f;
#pragma unroll 1
  for (int k = 0; k < 64; k += 4) {
    float4 qt[4], bt[4], ks[4], bs[4];
#pragma unroll
    for (int a = 0; a < 4; ++a) {
      qt[a] = *(const float4*)(sQ + (ty + 16 * a) * 68 + k);
      bt[a] = *(const float4*)(sB + (ty + 16 * a) * 68 + k);
      ks[a] = *(const float4*)(sK + (tx + 16 * a) * 68 + k);
      bs[a] = *(const float4*)(sB + (tx + 16 * a) * 68 + k);
    }
#pragma unroll
    for (int a = 0; a < 4; ++a)
#pragma unroll
      for (int cc = 0; cc <= a; ++cc) {
        float s = at[a][cc];
        s += qt[a].x * ks[cc].x * ex2(bt[a].x - bs[cc].x);
        s += qt[a].y * ks[cc].y * ex2(bt[a].y - bs[cc].y);
        s += qt[a].z * ks[cc].z * ex2(bt[a].z - bs[cc].z);
        s += qt[a].w * ks[cc].w * ex2(bt[a].w - bs[cc].w);
        at[a][cc] = s;
      }
  }
  __syncthreads();
  float* sA = sQ;
#pragma unroll
  for (int a = 0; a < 4; ++a)
#pragma unroll
    for (int cc = 0; cc < 4; ++cc) {
      float v = (cc < a) ? at[a][cc] : ((cc == a && tx <= ty) ? at[a][cc] : 0.f);
      sA[(ty + 16 * a) * 68 + tx + 16 * cc] = v;
    }
  __syncthreads();
  {
    float4 oa[4];
#pragma unroll
    for (int a = 0; a < 4; ++a) oa[a] = make_float4(0.f, 0.f, 0.f, 0.f);
#pragma unroll 1
    for (int s = 0; s < 64; s += 4) {
      float4 v0 = *(const float4*)(sV + (s + 0) * 64 + tx * 4);
      float4 v1 = *(const float4*)(sV + (s + 1) * 64 + tx * 4);
      float4 v2 = *(const float4*)(sV + (s + 2) * 64 + tx * 4);
      float4 v3 = *(const float4*)(sV + (s + 3) * 64 + tx * 4);
#pragma unroll
      for (int a = 0; a < 4; ++a) {
        float4 w = *(const float4*)(sA + (ty + 16 * a) * 68 + s);
        oa[a].x += w.x * v0.x + w.y * v1.x + w.z * v2.x + w.w * v3.x;
        oa[a].y += w.x * v0.y + w.y * v1.y + w.z * v2.y + w.w * v3.y;
        oa[a].z += w.x * v0.z + w.y * v1.z + w.z * v2.z + w.w * v3.z;
        oa[a].w += w.x * v0.w + w.y * v1.w + w.z * v2.w + w.w * v3.w;
      }
    }
#pragma unroll
    for (int a = 0; a < 4; ++a) {
      int t = ty + 16 * a;
      int row = dir ? row0 + 63 - t : row0 + t;
      *(float4*)(OI + (size_t)row * 256 + h * 64 + tx * 4) = oa[a];
    }
  }
  {
    float bend[4];
    float4 kva[4];
#pragma unroll
    for (int a = 0; a < 4; ++a) {
      bend[a] = sB[63 * 68 + ty + 16 * a];
      kva[a] = make_float4(0.f, 0.f, 0.f, 0.f);
    }
#pragma unroll 2
    for (int s = 0; s < 64; ++s) {
      float4 v = *(const float4*)(sV + s * 64 + tx * 4);
#pragma unroll
      for (int a = 0; a < 4; ++a) {
        int k = ty + 16 * a;
        float kd = sK[s * 68 + k] * ex2(bend[a] - sB[s * 68 + k]);
        kva[a].x += kd * v.x; kva[a].y += kd * v.y; kva[a].z += kd * v.z; kva[a].w += kd * v.w;
      }
    }
#pragma unroll
    for (int a = 0; a < 4; ++a) {
      int k = ty + 16 * a;
      *(float4*)(KV + k * 64 + tx * 4) = kva[a];
      if (tx == 0) DEC[k] = ex2(bend[a]);
    }
  }
}

DI void h2_item(const P& p, int li, int item, char* smem) {
  const int tid = ltid(), ty = tid >> 4, tx = tid & 15;
  const int h = item & 3, tc = item >> 2, row0 = tc * 64;
  const bool lat = tc >= 64;
  int seq, cl, nc;
  if (!lat) { seq = tc >> 2; cl = tc & 3; nc = 4; } else { seq = (tc - 64) >> 4; cl = (tc - 64) & 15; nc = 16; }
  const int tcbase = tc - cl;
  float* sS = (float*)smem;
  float* sQE = sS + 4096;
  const float* KVb = (const float*)(p.ws + O_KV);
  const float* DECb = (const float*)(p.ws + O_DEC);
  float4 oa[4];
#pragma unroll
  for (int a = 0; a < 4; ++a) {
    size_t off = (size_t)(row0 + ty + 16 * a) * 256 + h * 64 + tx * 4;
    float4 x = *(const float4*)((const float*)(p.ws + O_OI) + off);
    float4 y = *(const float4*)((const float*)(p.ws + O_OI) + (size_t)NTOK * 256 + off);
    oa[a] = make_float4(x.x + y.x, x.y + y.y, x.z + y.z, x.w + y.w);
  }
#pragma unroll 1
  for (int dir = 0; dir < 2; ++dir) {
    float4 S[4];
#pragma unroll
    for (int a = 0; a < 4; ++a) {
      if (lat) S[a] = *(const float4*)(p.in[6 + dir] + ((size_t)((seq * 2 + li) * 4 + h) * 64 + ty + 16 * a) * 64 + tx * 4);
      else S[a] = make_float4(0.f, 0.f, 0.f, 0.f);
    }
    const int nprev = dir == 0 ? cl : nc - 1 - cl;
#pragma unroll 1
    for (int j = 0; j < nprev; ++j) {
      int tcj = tcbase + (dir == 0 ? j : nc - 1 - j);
      size_t itj = (size_t)((tcj * 4 + h) * 2 + dir);
#pragma unroll
      for (int a = 0; a < 4; ++a) {
        int k = ty + 16 * a;
        float dcy = DECb[itj * 64 + k];
        float4 kv = *(const float4*)(KVb + itj * 4096 + k * 64 + tx * 4);
        S[a].x = dcy * S[a].x + kv.x; S[a].y = dcy * S[a].y + kv.y; S[a].z = dcy * S[a].z + kv.z; S[a].w = dcy * S[a].w + kv.w;
      }
    }
    if (!lat && nprev == nc - 1) {
      size_t itj = (size_t)((tc * 4 + h) * 2 + dir);
      float* so = p.out + (dir == 0 ? OUT_SF : OUT_SB) + (size_t)((seq * 2 + li) * 4 + h) * 4096;
#pragma unroll
      for (int a = 0; a < 4; ++a) {
        int k = ty + 16 * a;
        float dcy = DECb[itj * 64 + k];
        float4 kv = *(const float4*)(KVb + itj * 4096 + k * 64 + tx * 4);
        *(float4*)(so + k * 64 + tx * 4) = make_float4(dcy * S[a].x + kv.x, dcy * S[a].y + kv.y, dcy * S[a].z + kv.z, dcy * S[a].w + kv.w);
      }
    }
    __syncthreads();
#pragma unroll
    for (int a = 0; a < 4; ++a) *(float4*)(sS + (ty + 16 * a) * 64 + tx * 4) = S[a];
    const float* QE = (const float*)(p.ws + O_QE) + (size_t)dir * NTOK * 256;
#pragma unroll
    for (int i = 0; i < 4; ++i) {
      int idx = tid + 256 * i;
      int t = idx >> 4, c4 = idx & 15;
      *(float4*)(sQE + t * 68 + c4 * 4) = *(const float4*)(QE + (size_t)(row0 + t) * 256 + h * 64 + c4 * 4);
    }
    __syncthreads();
#pragma unroll 1
    for (int k = 0; k < 64; k += 4) {
      float4 s0 = *(const float4*)(sS + (k + 0) * 64 + tx * 4);
      float4 s1 = *(const float4*)(sS + (k + 1) * 64 + tx * 4);
      float4 s2 = *(const float4*)(sS + (k + 2) * 64 + tx * 4);
      float4 s3 = *(const float4*)(sS + (k + 3) * 64 + tx * 4);
#pragma unroll
      for (int a = 0; a < 4; ++a) {
        float4 w = *(const float4*)(sQE + (ty + 16 * a) * 68 + k);
        oa[a].x += w.x * s0.x + w.y * s1.x + w.z * s2.x + w.w * s3.x;
        oa[a].y += w.x * s0.y + w.y * s1.y + w.z * s2.y + w.w * s3.y;
        oa[a].z += w.x * s0.z + w.y * s1.z + w.z * s2.z + w.w * s3.z;
        oa[a].w += w.x * s0.w + w.y * s1.w + w.z * s2.w + w.w * s3.w;
      }
    }
  }
  const float4 gn = *(const float4*)(p.in[21] + li * 64 + tx * 4);
  u16* mixed = (u16*)(p.ws + O_MIXED);
#pragma unroll
  for (int a = 0; a < 4; ++a) {
    float ss = oa[a].x * oa[a].x + oa[a].y * oa[a].y + oa[a].z * oa[a].z + oa[a].w * oa[a].w;
    ss += shx(ss, 1); ss += shx(ss, 2); ss += shx(ss, 4); ss += shx(ss, 8);
    float rs = rsqrtf(ss * (1.f / 64.f) + 1e-6f);
    int row = row0 + ty + 16 * a;
    float4 sg = *(const float4*)((const float*)(p.ws + O_HSG) + (size_t)row * 256 + h * 64 + tx * 4);
    uint2 ov;
    ov.x = pack2(oa[a].x * rs * gn.x * sg.x, oa[a].y * rs * gn.y * sg.y);
    ov.y = pack2(oa[a].z * rs * gn.z * sg.z, oa[a].w * rs * gn.w * sg.w);
    *(uint2*)(mixed + (size_t)row * 1024 + 512 + h * 64 + tx * 4) = ov;
  }
}


DI void ln_apply(const P& p, const float* lo, const float* hi, const float* stats, const float* lng, const float* lnb,
                 const float* mods, int sc_off, int sh_off) {
  const int lane = ltid() & 63, wid = ltid() >> 6;
  u16* dst = (u16*)(p.ws + O_ABF);
  for (int it = blockIdx.x; it < NTOK / 4; it += gridDim.x) {
    const int row = it * 4 + wid;
    float mu = 0.f, rs = 1.f;
    if (stats != nullptr) {
      float s1 = 0.f, s2 = 0.f;
      if (lane < 16) {
        float2 v = *(const float2*)(stats + (size_t)row * 32 + lane * 2);
        s1 = v.x;
        s2 = v.y;
      }
#pragma unroll
      for (int s = 1; s < 16; s <<= 1) { s1 += shx(s1, s); s2 += shx(s2, s); }
      s1 = __shfl(s1, 0, 64);
      s2 = __shfl(s2, 0, 64);
      mu = s1 * (1.f / 1024.f);
      rs = rsqrtf(fmaxf(s2 * (1.f / 1024.f) - mu * mu, 0.f) + 1e-6f);
    }
    const float* x = row < NCTX ? lo + (size_t)row * 1024 : hi + (size_t)(row - NCTX) * 1024;
    const int rtype = row < NCTX ? 0 : 1 + ((row - NCTX) >> 10);
    const float* mv = mods + rtype * 6144;
#pragma unroll
    for (int i = 0; i < 4; ++i) {
      const int c = (lane + 64 * i) * 4;
      f32x4 v = *(const f32x4*)(x + c);
      f32x4 sc = *(const f32x4*)(mv + sc_off + c) + 1.f;
      f32x4 sh = *(const f32x4*)(mv + sh_off + c);
      if (stats != nullptr) {
        f32x4 gg = *(const f32x4*)(lng + c);
        f32x4 bb = *(const f32x4*)(lnb + c);
        v = (v - mu) * rs * gg + bb;
      }
      v = v * sc + sh;
      u32x2 o;
      o.x = pack2(v.x, v.y);
      o.y = pack2(v.z, v.w);
      *(u32x2*)(dst + (size_t)row * 1024 + c) = o;
    }
  }
}

DI void final_ln(const P& p) {
  const int lane = ltid() & 63, wid = ltid() >> 6;
  const float* X = (const float*)(p.ws + O_XPRE2);
  const float* ST = (const float*)(p.ws + O_ST2);
  const float* g = p.in[26] + 1024;
  const float* bb = p.in[27] + 1024;
  for (int it = blockIdx.x; it < NTOK / 4; it += gridDim.x) {
    int row = it * 4 + wid;
    float s1 = 0.f, s2 = 0.f;
    if (lane < 16) {
      float2 v = *(const float2*)(ST + (size_t)row * 32 + lane * 2);
      s1 = v.x;
      s2 = v.y;
    }
#pragma unroll
    for (int s = 1; s < 16; s <<= 1) { s1 += shx(s1, s); s2 += shx(s2, s); }
    s1 = __shfl(s1, 0, 64);
    s2 = __shfl(s2, 0, 64);
    float mu = s1 * (1.f / 1024.f);
    float rs = rsqrtf(fmaxf(s2 * (1.f / 1024.f) - mu * mu, 0.f) + 1e-6f);
    float* out = p.out + (row < NCTX ? OUT_YP + (size_t)row * 1024 : OUT_YS + (size_t)(row - NCTX) * 1024);
#pragma unroll
    for (int i = 0; i < 4; ++i) {
      int c = (lane + 64 * i) * 4;
      float4 x = *(const float4*)(X + (size_t)row * 1024 + c);
      float4 gg = *(const float4*)(g + c);
      float4 b4 = *(const float4*)(bb + c);
      *(float4*)(out + c) = make_float4((x.x - mu) * rs * gg.x + b4.x, (x.y - mu) * rs * gg.y + b4.y,
                                         (x.z - mu) * rs * gg.z + b4.z, (x.w - mu) * rs * gg.w + b4.w);
    }
  }
}

DI void run_phase(const P& p, int ph, char* smem) {
  if (ph == 0) { phase0(p, smem); return; }
  if (ph == NPHASE - 1) { final_ln(p); return; }
  const int li = (ph - 1) >> 3, s = (ph - 1) & 7;
  float* XPRE1 = (float*)(p.ws + O_XPRE1);
  float* XPRE2 = (float*)(p.ws + O_XPRE2);
  float* ST1 = (float*)(p.ws + O_ST1);
  float* ST2 = (float*)(p.ws + O_ST2);
  GA g;
  g.mods = (const float*)(p.ws + O_MODS) + li * 3 * 6144;
  g.a16 = (const u16*)(p.ws + O_ABF); g.xout = nullptr; g.sout = nullptr; g.hid = nullptr;
  g.alo = nullptr; g.ahi = nullptr; g.stats = nullptr; g.lng = nullptr; g.lnb = nullptr; g.sc_off = 0; g.sh_off = 0;
  const float* xin_lo = li == 0 ? p.in[0] : XPRE2;
  const float* xin_hi = li == 0 ? p.in[1] : XPRE2 + (size_t)NCTX * 1024;
  const float* xin_st = li == 0 ? nullptr : ST2;
  const float* xin_g = p.in[26] + (li == 0 ? 0 : (li - 1) * 1024);
  const float* xin_b = p.in[27] + (li == 0 ? 0 : (li - 1) * 1024);
  if (s == 0) {
    ln_apply(p, xin_lo, xin_hi, xin_st, xin_g, xin_b, g.mods, 1024, 0);
  } else if (s == 1) {
    g.bt = (const u16*)(p.ws + O_WTIN) + (size_t)li * NIN * D; g.K = D; g.N = NIN;
    gemm_phase<0>(p, g, li, smem);
  } else if (s == 2) {
    for (int it = blockIdx.x; it < 768 + 768; it += gridDim.x) {
      if (it >= 256 && it < 1024) h1_item(p, it - 256, smem);
      else attnA_item(p, li, it < 256 ? it : it - 768, smem);
    }
  } else if (s == 3) {
    for (int it = blockIdx.x; it < 384 + 384; it += gridDim.x) {
      if (it >= 128 && it < 512) h2_item(p, li, it - 128, smem);
      else attnC_item(p, li, it < 128 ? it : it - 384, smem);
    }
  } else if (s == 4) {
    g.alo = xin_lo; g.ahi = xin_hi; g.stats = xin_st; g.lng = xin_g; g.lnb = xin_b;
    g.sc_off = 2048;
    g.a16 = (const u16*)(p.ws + O_MIXED);
    g.bt = (const u16*)(p.ws + O_WTOUT) + (size_t)li * D * D; g.K = D; g.N = D;
    g.xout = XPRE1; g.sout = ST1;
    gemm_phase<1>(p, g, li, smem);
  } else if (s == 5) {
    ln_apply(p, XPRE1, XPRE1 + (size_t)NCTX * 1024, ST1, p.in[24] + li * 1024, p.in[25] + li * 1024, g.mods, 4096, 3072);
  } else if (s == 6) {
    g.bt = (const u16*)(p.ws + O_WTFF1) + (size_t)li * DFF * D; g.K = D; g.N = DFF;
    g.hid = (u16*)(p.ws + O_HID);
    gemm_phase<2>(p, g, li, smem);
  } else {
    g.alo = XPRE1; g.ahi = XPRE1 + (size_t)NCTX * 1024; g.stats = ST1; g.lng = p.in[24] + li * 1024; g.lnb = p.in[25] + li * 1024;
    g.sc_off = 5120;
    g.a16 = (const u16*)(p.ws + O_HID);
    g.bt = (const u16*)(p.ws + O_WTFF2) + (size_t)li * D * DFF; g.K = DFF; g.N = D;
    g.xout = XPRE2; g.sout = ST2;
    gemm_phase<1>(p, g, li, smem);
  }
}

#define XB_TMO      128
#define XB_XCNT(j)  (256  + 64 * (j))
#define XB_XSUB(j)  (1280 + 64 * (j))
#define XB_XGEN(j)  (2304 + 64 * (j))
#define XB_TOP      3328
#define XB_TOPGEN   3392
#define XCD_BAR_WORDS 3456
#define XB_SPIN_CAP (1u << 20)
#define LAS __attribute__((address_space(3)))
DI unsigned xb_ld(unsigned* p) { return __hip_atomic_load(p, __ATOMIC_RELAXED, __HIP_MEMORY_SCOPE_AGENT); }
DI unsigned xb_add(unsigned* p, unsigned v) { return __hip_atomic_fetch_add(p, v, __ATOMIC_RELAXED, __HIP_MEMORY_SCOPE_AGENT); }
DI unsigned xb_xcc_id() { return (unsigned)__builtin_amdgcn_s_getreg((3 << 11) | 20) & 0xFu; }
#define XB_SPIN(cond, bar) do { unsigned _sp = 0; while (cond) { __builtin_amdgcn_s_sleep(1); \
    if ((++_sp & 255u) == 0u) { if (xb_ld(&(bar)[XB_TMO])) break; if (_sp > XB_SPIN_CAP) { atomicAdd(&(bar)[XB_TMO], 1u); break; } } } } while (0)
struct XcdBarrier { unsigned* bar; unsigned x; volatile LAS unsigned* st; };
DI XcdBarrier xcd_barrier_post(unsigned* bar, volatile LAS unsigned* st) {
  XcdBarrier b; b.bar = bar; b.x = xb_xcc_id(); b.st = st;
  if (threadIdx.x == 0) (void)xb_add(&bar[XB_XCNT(b.x)], 1u);
  return b;
}
DI void xcd_barrier_complete(unsigned* bar, unsigned x, unsigned& nloc, unsigned& nx) {
  const unsigned G = gridDim.x * gridDim.y * gridDim.z;
  unsigned sum, cnt, mine, sp = 0u;
  for (;;) {
    sum = 0u; cnt = 0u; mine = 0u;
#pragma unroll
    for (unsigned j = 0; j < 16; ++j) { const unsigned c = xb_ld(&bar[XB_XCNT(j)]); sum += c; cnt += (c > 0u) ? 1u : 0u; mine = (j == x) ? c : mine; }
    if (sum == G) break;
    __builtin_amdgcn_s_sleep(1);
    if ((++sp & 255u) == 0u) { if (xb_ld(&bar[XB_TMO])) break; if (sp > XB_SPIN_CAP) { atomicAdd(&bar[XB_TMO], 1u); break; } }
  }
  nloc = mine > 0u ? mine : 1u; nx = cnt > 0u ? cnt : 1u;
}
DI void xcd_barrier(const XcdBarrier& b) {
  asm volatile("s_waitcnt vmcnt(0)" ::: "memory");
  __syncthreads();
  if (threadIdx.x == 0) {
    unsigned* bar = b.bar;
    __builtin_amdgcn_s_waitcnt(0);
    unsigned nloc = b.st[0], nx = b.st[1];
    if (nloc == 0u) { xcd_barrier_complete(bar, b.x, nloc, nx); b.st[0] = nloc; b.st[1] = nx; }
    const unsigned old = xb_add(&bar[XB_XSUB(b.x)], 1u);
    const unsigned gen = old / nloc;
    if (old + 1u == (gen + 1u) * nloc) {
      __builtin_amdgcn_fence(__ATOMIC_RELEASE, "agent");
      asm volatile("s_waitcnt vmcnt(0)" ::: "memory");
      const unsigned og = xb_add(&bar[XB_TOP], 1u);
      const unsigned tg = og / nx;
      if (og + 1u == (tg + 1u) * nx) xb_add(&bar[XB_TOPGEN], 1u);
      else XB_SPIN(xb_ld(&bar[XB_TOPGEN]) == tg, bar);
      __builtin_amdgcn_fence(__ATOMIC_ACQUIRE, "agent");
      xb_add(&bar[XB_XGEN(b.x)], 1u);
      asm volatile("s_waitcnt vmcnt(0)" ::: "memory");
    } else {
      XB_SPIN(xb_ld(&bar[XB_XGEN(b.x)]) == gen, bar);
      __builtin_amdgcn_fence(__ATOMIC_ACQUIRE, "agent");
      asm volatile("s_waitcnt vmcnt(0)" ::: "memory");
    }
  }
  __syncthreads();
}
constexpr size_t O_BAR = O_END1;
static_assert(O_BAR + XCD_BAR_WORDS * 4 <= (size_t)256 * 1024 * 1024, "barrier words must fit");

#if !MULTI_LAUNCH
__global__ void __launch_bounds__(256, 2) mega_kernel(P p) {
  extern __shared__ __attribute__((aligned(16))) char smem[];
  cg::grid_group grid = cg::this_grid();
  if (p.ws == nullptr) grid.sync();
  if (threadIdx.x == 0) *(uint4*)(smem + LDS_BYTES - 16) = make_uint4(0u, 0u, 0u, 0u);
  __syncthreads();
  XcdBarrier xb = xcd_barrier_post((unsigned*)(p.ws + O_BAR), (volatile LAS unsigned*)(smem + LDS_BYTES - 16));
  run_phase(p, 0, smem); xcd_barrier(xb);
  run_phase(p, 1, smem); xcd_barrier(xb);
  run_phase(p, 2, smem); xcd_barrier(xb);
  run_phase(p, 3, smem); xcd_barrier(xb);
  run_phase(p, 4, smem); xcd_barrier(xb);
  run_phase(p, 5, smem); xcd_barrier(xb);
  run_phase(p, 6, smem); xcd_barrier(xb);
  run_phase(p, 7, smem); xcd_barrier(xb);
  run_phase(p, 8, smem); xcd_barrier(xb);
  run_phase(p, 9, smem); xcd_barrier(xb);
  run_phase(p, 10, smem); xcd_barrier(xb);
  run_phase(p, 11, smem); xcd_barrier(xb);
  run_phase(p, 12, smem); xcd_barrier(xb);
  run_phase(p, 13, smem); xcd_barrier(xb);
  run_phase(p, 14, smem); xcd_barrier(xb);
  run_phase(p, 15, smem); xcd_barrier(xb);
  run_phase(p, 16, smem); xcd_barrier(xb);
  run_phase(p, 17, smem);
}
#define MAIN_KERNEL mega_kernel
#else
__global__ void __launch_bounds__(256, 2) phase_kernel(P p, int ph) {
  extern __shared__ __attribute__((aligned(16))) char smem[];
  run_phase(p, ph, smem);
}
#define MAIN_KERNEL phase_kernel
#endif

extern "C" void kernel_launch(void* const* d_in, const int* in_sizes, int n_in, void* d_out, int out_size, void* d_ws,
                              size_t ws_size, hipStream_t stream) {
  static int grid_blocks = 0;
  if (!grid_blocks) {
    int dev = 0, cus = 0, per_cu = 0;
    (void)hipGetDevice(&dev);
    (void)hipDeviceGetAttribute(&cus, hipDeviceAttributeMultiprocessorCount, dev);
    (void)hipFuncSetAttribute((const void*)MAIN_KERNEL, hipFuncAttributeMaxDynamicSharedMemorySize, LDS_BYTES);
    (void)hipOccupancyMaxActiveBlocksPerMultiprocessor(&per_cu, MAIN_KERNEL, 256, LDS_BYTES);
    if (per_cu > 2) per_cu = 2;
    if (per_cu < 1) per_cu = 1;
    grid_blocks = cus * per_cu;
  }
  P p{};
  for (int i = 0; i < 30; ++i) p.in[i] = (const float*)d_in[i];
  p.out = (float*)d_out;
  p.ws = (char*)d_ws;
#if MULTI_LAUNCH
  for (int ph = 0; ph < NPHASE; ++ph) {
    phase_kernel<<<dim3(grid_blocks), dim3(256), LDS_BYTES, stream>>>(p, ph);
#ifdef DUP_MASK
    int bit = (ph == 0) ? 8 : (ph == NPHASE - 1 ? 9 : (ph - 1) & 7);
    if ((DUP_MASK >> bit) & 1) phase_kernel<<<dim3(grid_blocks), dim3(256), LDS_BYTES, stream>>>(p, ph);
#endif
  }
#else
  (void)hipMemsetAsync((char*)d_ws + O_BAR, 0, XCD_BAR_WORDS * 4, stream);
  void* args[] = {&p};
  hipError_t e = hipLaunchCooperativeKernel((void*)mega_kernel, dim3(grid_blocks), dim3(256), args, LDS_BYTES, stream);
  if (e != hipSuccess) fprintf(stderr, "cooperative launch failed: %s (grid %d)\n", hipGetErrorString(e), grid_blocks);
#endif
}
```

```cpp
#include <hip/hip_runtime.h>
#include <hip/hip_cooperative_groups.h>
#include <stdint.h>
#include <stdio.h>
namespace cg = cooperative_groups;

#ifndef MULTI_LAUNCH
#define MULTI_LAUNCH 0
#endif

#define DI __device__ __forceinline__
typedef unsigned short u16;
using bf16x8 = __attribute__((ext_vector_type(8))) short;
using f32x4 = __attribute__((ext_vector_type(4))) float;
typedef __bf16 bf2_t __attribute__((ext_vector_type(2)));
typedef float f2_t __attribute__((ext_vector_type(2)));

constexpr int D = 1024, NTOK = 6144, NCTX = 4096, NIN = 3328, DFF = 4096;
constexpr float ALPHA = 1.41421356237309515f;
constexpr float LOG2E = 1.44269504088896341f;
constexpr int LDS_BYTES = 75776;
constexpr int NPHASE = 18;

constexpr size_t O_WTIN = 0;
constexpr size_t O_WTOUT = O_WTIN + (size_t)2 * NIN * D * 2;
constexpr size_t O_WTFF1 = O_WTOUT + (size_t)2 * D * D * 2;
constexpr size_t O_WTFF2 = O_WTFF1 + (size_t)2 * DFF * D * 2;
constexpr size_t O_MODS = O_WTFF2 + (size_t)2 * D * DFF * 2;
constexpr size_t O_ROPE = O_MODS + (size_t)2 * 3 * 6144 * 4;
constexpr size_t O_QA = O_ROPE + (size_t)1024 * 32 * 2 * 4;
constexpr size_t O_KACTX = O_QA + (size_t)NTOK * 512 * 2;
constexpr size_t O_KALAT = O_KACTX + (size_t)NCTX * 512 * 2;
constexpr size_t O_VTACTX = O_KALAT + (size_t)2 * 2 * 1536 * 512 * 2;
constexpr size_t O_VTALAT = O_VTACTX + (size_t)16 * 4 * 128 * 256 * 2;
constexpr size_t O_QC = O_VTALAT + (size_t)2 * 2 * 4 * 128 * 1536 * 2;
constexpr size_t O_KCCTX = O_QC + (size_t)NTOK * 256 * 2;
constexpr size_t O_KCLAT = O_KCCTX + (size_t)NCTX * 128 * 2;
constexpr size_t O_VTCCTX = O_KCLAT + (size_t)2 * 2 * 1536 * 128 * 2;
constexpr size_t O_VTCLAT = O_VTCCTX + (size_t)16 * 2 * 64 * 256 * 2;
constexpr size_t O_KV = O_VTCLAT + (size_t)2 * 2 * 2 * 64 * 1536 * 2;
constexpr size_t O_DEC = O_KV + (size_t)768 * 4096 * 4;
constexpr size_t O_MIXED = O_DEC + (size_t)768 * 64 * 4;
constexpr size_t O_XPRE1 = O_MIXED + (size_t)NTOK * 1024 * 2;
constexpr size_t O_ST1 = O_XPRE1 + (size_t)NTOK * 1024 * 4;
constexpr size_t O_XPRE2 = O_ST1 + (size_t)NTOK * 32 * 4;
constexpr size_t O_ST2 = O_XPRE2 + (size_t)NTOK * 1024 * 4;
constexpr size_t O_ABF = O_ST2 + (size_t)NTOK * 32 * 4;
constexpr size_t O_HQ = O_ABF + (size_t)NTOK * 1024 * 2;
constexpr size_t O_HGF = O_HQ + (size_t)NTOK * 256 * 4;
constexpr size_t O_HGB = O_HGF + (size_t)NTOK * 256 * 4;
constexpr size_t O_HI = O_HGB + (size_t)NTOK * 256 * 4;
constexpr size_t O_HSG = O_HI + (size_t)NTOK * 256 * 4;
constexpr size_t O_OI = O_HSG + (size_t)NTOK * 256 * 4;
constexpr size_t O_QE = O_OI + (size_t)2 * NTOK * 256 * 4;
constexpr size_t O_END1 = O_QE + (size_t)2 * NTOK * 256 * 4;
constexpr size_t O_HID = O_HQ;
constexpr size_t O_END2 = O_HID + (size_t)NTOK * 4096 * 2;
static_assert(O_END2 <= O_END1, "HID alias must fit");
static_assert(O_END1 <= (size_t)256 * 1024 * 1024, "workspace too big");

constexpr size_t OUT_YP = 0, OUT_YS = 4194304, OUT_AK = 6291456, OUT_AV = 10485760, OUT_CK = 14680064,
                 OUT_CV = 15728640, OUT_SF = 16777216, OUT_SB = 17301504;

struct P {
  const float* in[30];
  float* out;
  char* ws;
};

DI unsigned pack2(float a, float b) {
  f2_t v = {a, b};
  bf2_t r = __builtin_convertvector(v, bf2_t);
  return __builtin_bit_cast(unsigned, r);
}
DI u16 f2bf(float x) { return (u16)(pack2(x, 0.f) & 0xffffu); }
DI float ex2(float x) { return __builtin_amdgcn_exp2f(x); }
DI float siluf(float x) { return x / (1.f + expf(-x)); }
DI float shx(float v, int m) { return __shfl_xor(v, m, 64); }
DI int ltid() { int t = threadIdx.x; asm volatile("" : "+v"(t)); return t; }
#define MFMA16(a, b, c) __builtin_amdgcn_mfma_f32_16x16x32_bf16((a), (b), (c), 0, 0, 0)

DI void p0_mod(const P& p, int item, char* smem) {
  float* ssilu = (float*)smem;
  float* red = ssilu + 3072;
  const int tid = ltid();
  __syncthreads();
  for (int i = tid; i < 3072; i += 256) {
    int w = i >> 10, k = i & 1023;
    float v = (w == 0) ? p.in[9][k] : p.in[8][(w - 1) * 1024 + k];
    ssilu[i] = siluf(v);
  }
  __syncthreads();
  const int li = item / 96, j0 = (item % 96) * 64;
  const int c4 = tid & 15, kp = tid >> 4;
  const float* W = p.in[10] + (size_t)li * 1024 * 6144 + j0 + c4 * 4;
  float4 a0 = {0, 0, 0, 0}, a1 = a0, a2 = a0;
#pragma unroll 4
  for (int kk = 0; kk < 64; ++kk) {
    int k = kp * 64 + kk;
    float4 w4 = *(const float4*)(W + (size_t)k * 6144);
    float s0 = ssilu[k], s1 = ssilu[1024 + k], s2 = ssilu[2048 + k];
    a0.x += s0 * w4.x; a0.y += s0 * w4.y; a0.z += s0 * w4.z; a0.w += s0 * w4.w;
    a1.x += s1 * w4.x; a1.y += s1 * w4.y; a1.z += s1 * w4.z; a1.w += s1 * w4.w;
    a2.x += s2 * w4.x; a2.y += s2 * w4.y; a2.z += s2 * w4.z; a2.w += s2 * w4.w;
  }
  *(float4*)(red + (kp * 3 + 0) * 64 + c4 * 4) = a0;
  *(float4*)(red + (kp * 3 + 1) * 64 + c4 * 4) = a1;
  *(float4*)(red + (kp * 3 + 2) * 64 + c4 * 4) = a2;
  __syncthreads();
  if (tid < 192) {
    int w = tid >> 6, c = tid & 63;
    float s = p.in[11][li * 6144 + j0 + c];
    for (int q = 0; q < 16; ++q) s += red[(q * 3 + w) * 64 + c];
    ((float*)(p.ws + O_MODS))[(li * 3 + w) * 6144 + j0 + c] = s;
  }
}

DI void p0_rope(const P& p, int item) {
  float* R = (float*)(p.ws + O_ROPE);
  for (int i = ltid(); i < 4096; i += 256) {
    int idx = item * 4096 + i;
    int t = idx >> 5, pp = idx & 31;
    float inv = powf(10000.f, -(float)(pp & 15) / 16.f);
    float pos = (pp < 16) ? (float)(t >> 6) : (float)(t & 63);
    float ang = pos * inv;
    R[idx * 2] = cosf(ang);
    R[idx * 2 + 1] = sinf(ang);
  }
}

DI void p0_copyk(const P& p, int item, bool isA) {
  const int W = isA ? 512 : 128;
  const float* src = isA ? p.in[2] : p.in[4];
  u16* dst = (u16*)(p.ws + (isA ? O_KALAT : O_KCLAT));
  for (int i = 0; i < 4; ++i) {
    size_t e = (size_t)item * 4096 + (size_t)(ltid() + 256 * i) * 4;
    float4 v = *(const float4*)(src + e);
    int c = (int)(e % W);
    size_t r = e / W;
    int pp = (int)(r % 512);
    int bl = (int)(r / 512);
    int b = bl >> 1, li = bl & 1;
    uint2 o;
    o.x = pack2(v.x, v.y);
    o.y = pack2(v.z, v.w);
    *(uint2*)(dst + ((size_t)((li * 2 + b) * 1536 + 1024 + pp)) * W + c) = o;
  }
}

DI void transpose_tile(const float* src, int sstride, u16* dst, int dstride, char* smem) {
  float* t = (float*)smem;
  const int tid = ltid();
  __syncthreads();
#pragma unroll
  for (int i = 0; i < 4; ++i) {
    int idx = tid + 256 * i;
    int r = idx >> 4, c4 = idx & 15;
    float4 v = *(const float4*)(src + (size_t)r * sstride + c4 * 4);
    float* q = t + r * 65 + c4 * 4;
    q[0] = v.x; q[1] = v.y; q[2] = v.z; q[3] = v.w;
  }
  __syncthreads();
  const int c = tid >> 2, rs = tid & 3;
  unsigned o[8];
#pragma unroll
  for (int e = 0; e < 8; ++e) {
    float a = t[(rs * 16 + 2 * e) * 65 + c], b = t[(rs * 16 + 2 * e + 1) * 65 + c];
    o[e] = pack2(a, b);
  }
  uint4* dp = (uint4*)(dst + (size_t)c * dstride + rs * 16);
  dp[0] = make_uint4(o[0], o[1], o[2], o[3]);
  dp[1] = make_uint4(o[4], o[5], o[6], o[7]);
}

DI void phase0(const P& p, char* smem) {
  constexpr int N_MOD = 192, N_ROPE = 8, N_AK = 256, N_CK = 64;
  constexpr int T_IN = 1664, T_OUT = 512, T_FF1 = 2048, T_FF2 = 2048, T_AV = 256, T_CV = 64;
  constexpr int B_ROPE = N_MOD, B_AK = B_ROPE + N_ROPE, B_CK = B_AK + N_AK, B_T = B_CK + N_CK;
  constexpr int TOTAL = B_T + T_IN + T_OUT + T_FF1 + T_FF2 + T_AV + T_CV;
  for (int it = blockIdx.x; it < TOTAL; it += gridDim.x) {
    if (it < B_ROPE) p0_mod(p, it, smem);
    else if (it < B_AK) p0_rope(p, it - B_ROPE);
    else if (it < B_CK) p0_copyk(p, it - B_AK, true);
    else if (it < B_T) p0_copyk(p, it - B_CK, false);
    else {
      int t = it - B_T;
      if (t < T_IN) {
        int li = t / 832, r = t % 832, kt = r / 52, nt = r % 52;
        transpose_tile(p.in[12] + (size_t)li * 1024 * NIN + (size_t)(kt * 64) * NIN + nt * 64, NIN,
                       (u16*)(p.ws + O_WTIN) + (size_t)li * NIN * 1024 + (size_t)(nt * 64) * 1024 + kt * 64, 1024, smem);
      } else if ((t -= T_IN) < T_OUT) {
        int li = t / 256, r = t % 256, kt = r / 16, nt = r % 16;
        transpose_tile(p.in[13] + (size_t)li * 1024 * 1024 + (size_t)(kt * 64) * 1024 + nt * 64, 1024,
                       (u16*)(p.ws + O_WTOUT) + (size_t)li * 1024 * 1024 + (size_t)(nt * 64) * 1024 + kt * 64, 1024, smem);
      } else if ((t -= T_OUT) < T_FF1) {
        int li = t / 1024, r = t % 1024, kt = r / 64, nt = r % 64;
        transpose_tile(p.in[28] + (size_t)li * 1024 * DFF + (size_t)(kt * 64) * DFF + nt * 64, DFF,
                       (u16*)(p.ws + O_WTFF1) + (size_t)li * DFF * 1024 + (size_t)(nt * 64) * 1024 + kt * 64, 1024, smem);
      } else if ((t -= T_FF1) < T_FF2) {
        int li = t / 1024, r = t % 1024, kt = r / 16, nt = r % 16;
        transpose_tile(p.in[29] + (size_t)li * DFF * 1024 + (size_t)(kt * 64) * 1024 + nt * 64, 1024,
                       (u16*)(p.ws + O_WTFF2) + (size_t)li * 1024 * DFF + (size_t)(nt * 64) * DFF + kt * 64, DFF, smem);
      } else if ((t -= T_FF2) < T_AV) {
        int bl = t / 64, r = t % 64, pt = r / 8, ct = r % 8;
        int b = bl >> 1, li = bl & 1;
        transpose_tile(p.in[3] + ((size_t)bl * 512 + pt * 64) * 512 + ct * 64, 512,
                       (u16*)(p.ws + O_VTALAT) + ((size_t)(li * 2 + b) * 512 + ct * 64) * 1536 + 1024 + pt * 64, 1536, smem);
      } else {
        t -= T_AV;
        int bl = t / 16, r = t % 16, pt = r / 2, ct = r % 2;
        int b = bl >> 1, li = bl & 1;
        transpose_tile(p.in[5] + ((size_t)bl * 512 + pt * 64) * 128 + ct * 64, 128,
                       (u16*)(p.ws + O_VTCLAT) + ((size_t)(li * 2 + b) * 128 + ct * 64) * 1536 + 1024 + pt * 64, 1536, smem);
      }
    }
  }
}

struct GA {
  const float* alo;
  const float* ahi;
  const float* stats;
  const float* lng;
  const float* lnb;
  const float* mods;
  int sc_off, sh_off;
  const u16* a16;
  const u16* bt;
  int K, N;
  float* xout;
  float* sout;
  u16* hid;
};

DI void epi_inproj(const P& p, int li, f32x4 (&acc)[4][4], int R0, int C0);

typedef unsigned u32x4 __attribute__((ext_vector_type(4)));
typedef unsigned u32x2 __attribute__((ext_vector_type(2)));

template <int EPI>
DI void gemm_tile(const P& p, const GA& g, int li, int m0, int n0, char* smem) {
  const int tid = ltid(), lane = tid & 63, wid = tid >> 6, wr = wid >> 1, wc = wid & 1;
  const int l16 = lane & 15, q4 = lane >> 4;
  u16* sA0 = (u16*)smem;
  u16* sB0 = sA0 + 128 * 72;
  u16* sA1 = sB0 + 128 * 72;
  u16* sB1 = sA1 + 128 * 72;
  float2* sStat = (float2*)(smem + 73728);
  const int K = g.K;
  const int rtype = (m0 < NCTX) ? 0 : 1 + ((m0 - NCTX) >> 10);
  const float* modv = g.mods + rtype * 6144;
  const float* fsrc = (m0 < NCTX) ? g.alo + (size_t)m0 * 1024 : g.ahi + (size_t)(m0 - NCTX) * 1024;

  __syncthreads();
  if constexpr (EPI == 1) {
    if (g.stats != nullptr && tid < 128) {
      const float4* sp = (const float4*)(g.stats + (size_t)(m0 + tid) * 32);
      float s1 = 0.f, s2 = 0.f;
#pragma unroll
      for (int i = 0; i < 8; ++i) {
        float4 v = sp[i];
        s1 += v.x + v.z;
        s2 += v.y + v.w;
      }
      float mu = s1 * (1.f / 1024.f);
      float var = s2 * (1.f / 1024.f) - mu * mu;
      sStat[tid] = make_float2(mu, rsqrtf(fmaxf(var, 0.f) + 1e-6f));
    }
  }

  f32x4 acc[4][4];
#pragma unroll
  for (int i = 0; i < 4; ++i)
#pragma unroll
    for (int j = 0; j < 4; ++j) acc[i][j] = f32x4{0.f, 0.f, 0.f, 0.f};

  u32x4 ra0[4], rb0[4], ra1[4], rb1[4];
  const unsigned goff = (unsigned)(tid >> 3) * (unsigned)K + (unsigned)(tid & 7) * 8u;
  const unsigned loff = (unsigned)(tid >> 3) * 72u + (unsigned)(tid & 7) * 8u;
  const u16* abase = g.a16 + (size_t)m0 * K;
  const u16* bbase = g.bt + (size_t)n0 * K;
#define GLOAD(RA, RB, KT)                                                        \
  _Pragma("unroll") for (int i = 0; i < 4; ++i) {                                \
    RA[i] = *(const u32x4*)(abase + (size_t)(32 * i) * K + (KT) * 64 + goff);    \
    RB[i] = *(const u32x4*)(bbase + (size_t)(32 * i) * K + (KT) * 64 + goff);    \
  }
#define LSTORE(SA, SB, RA, RB)                                                   \
  _Pragma("unroll") for (int i = 0; i < 4; ++i) {                                \
    *(u32x4*)(SA + 32 * i * 72 + loff) = RA[i];                                  \
    *(u32x4*)(SB + 32 * i * 72 + loff) = RB[i];                                  \
  }
#define COMPUTE(SA, SB)                                                          \
  _Pragma("unroll") for (int s = 0; s < 2; ++s) {                                \
    bf16x8 af[4], bfr[4];                                                        \
    _Pragma("unroll") for (int i = 0; i < 4; ++i) {                              \
      af[i] = *(const bf16x8*)(SA + (wr * 64 + i * 16 + l16) * 72 + s * 32 + q4 * 8);  \
      bfr[i] = *(const bf16x8*)(SB + (wc * 64 + i * 16 + l16) * 72 + s * 32 + q4 * 8); \
    }                                                                            \
    _Pragma("unroll") for (int i = 0; i < 4; ++i)                                \
      _Pragma("unroll") for (int j = 0; j < 4; ++j) acc[i][j] = MFMA16(af[i], bfr[j], acc[i][j]); \
    __builtin_amdgcn_sched_barrier(0);                                           \
  }

  const int nk = K >> 6;
  GLOAD(ra0, rb0, 0);
  GLOAD(ra1, rb1, 1);
  LSTORE(sA0, sB0, ra0, rb0);
  GLOAD(ra0, rb0, 2);
  __syncthreads();
#pragma unroll 1
  for (int kt = 0; kt < nk; kt += 2) {
    LSTORE(sA1, sB1, ra1, rb1);
    if (kt + 3 < nk) { GLOAD(ra1, rb1, kt + 3); }
    COMPUTE(sA0, sB0);
    __syncthreads();
    if (kt + 2 < nk) { LSTORE(sA0, sB0, ra0, rb0); }
    if (kt + 4 < nk) { GLOAD(ra0, rb0, kt + 4); }
    COMPUTE(sA1, sB1);
    __syncthreads();
  }
#undef GLOAD
#undef LSTORE
#undef COMPUTE
  asm volatile("" ::: "memory");

  const int R0 = m0 + wr * 64, C0 = n0 + wc * 64;
  if constexpr (EPI == 0) {
    epi_inproj(p, li, acc, R0, C0);
  } else if constexpr (EPI == 1) {
    float gate[4], lg[4], lb[4];
#pragma unroll
    for (int j = 0; j < 4; ++j) {
      int col = C0 + j * 16 + l16;
      gate[j] = modv[g.sc_off + col];
      lg[j] = g.stats ? g.lng[col] : 1.f;
      lb[j] = g.stats ? g.lnb[col] : 0.f;
    }
#pragma unroll
    for (int i = 0; i < 4; ++i) {
#pragma unroll
      for (int r = 0; r < 4; ++r) {
        int lrow = wr * 64 + i * 16 + q4 * 4 + r;
        float mu = 0.f, rs = 1.f;
        if (g.stats != nullptr) {
          float2 st = sStat[lrow];
          mu = st.x;
          rs = st.y;
        }
        float s1 = 0.f, s2 = 0.f;
#pragma unroll
        for (int j = 0; j < 4; ++j) {
          int col = C0 + j * 16 + l16;
          float x = fsrc[(size_t)lrow * 1024 + col];
          x = (x - mu) * rs * lg[j] + lb[j];
          float v = ALPHA * x + gate[j] * acc[i][j][r];
          g.xout[(size_t)(m0 + lrow) * 1024 + col] = v;
          s1 += v;
          s2 += v * v;
        }
        s1 += shx(s1, 1); s2 += shx(s2, 1);
        s1 += shx(s1, 2); s2 += shx(s2, 2);
        s1 += shx(s1, 4); s2 += shx(s2, 4);
        s1 += shx(s1, 8); s2 += shx(s2, 8);
        if (l16 == 0) *(float2*)(g.sout + (size_t)(m0 + lrow) * 32 + (C0 >> 6) * 2) = make_float2(s1, s2);
      }
    }
  } else {
#pragma unroll
    for (int i = 0; i < 4; ++i)
#pragma unroll
      for (int r = 0; r < 4; ++r) {
        int row = R0 + i * 16 + q4 * 4 + r;
#pragma unroll
        for (int j = 0; j < 4; ++j) {
          float v = fmaxf(acc[i][j][r], 0.f);
          g.hid[(size_t)row * DFF + C0 + j * 16 + l16] = f2bf(v * v);
        }
      }
  }
}

DI void epi_inproj(const P& p, int li, f32x4 (&acc)[4][4], int R0, int C0) {
  const int lane = ltid() & 63, l16 = lane & 15, q4 = lane >> 4;
  const int seg = C0 >> 6;
  const bool lat = R0 >= NCTX;
  const float2* rope = (const float2*)(p.ws + O_ROPE);
  int b, tb;
  if (!lat) { b = R0 >> 8; tb = R0 & 255; } else { b = (R0 - NCTX) >> 10; tb = (R0 - NCTX) & 1023; }

  enum { T_QA, T_KA, T_VA, T_QB, T_FF, T_FB, T_IB, T_GB, T_QC, T_KC, T_VC };
  int type, cbase;
  if (seg < 8) { type = T_QA; cbase = seg * 64; }
  else if (seg < 16) { type = T_KA; cbase = (seg - 8) * 64; }
  else if (seg < 24) { type = T_VA; cbase = (seg - 16) * 64; }
  else if (seg < 28) { type = T_QB; cbase = (seg - 24) * 64; }
  else if (seg < 32) { type = T_FF; cbase = (seg - 28) * 64; }
  else if (seg < 36) { type = T_FB; cbase = (seg - 32) * 64; }
  else if (seg < 40) { type = T_IB; cbase = (seg - 36) * 64; }
  else if (seg < 44) { type = T_GB; cbase = (seg - 40) * 64; }
  else if (seg < 48) { type = T_QC; cbase = (seg - 44) * 64; }
  else if (seg < 50) { type = T_KC; cbase = (seg - 48) * 64; }
  else { type = T_VC; cbase = (seg - 50) * 64; }

  if (type == T_QC || type == T_KC) {
    const float* gv = (type == T_QC ? p.in[22] : p.in[23]) + li * 64;
    float gj[4];
#pragma unroll
    for (int j = 0; j < 4; ++j) gj[j] = gv[j * 16 + l16];
#pragma unroll
    for (int i = 0; i < 4; ++i)
#pragma unroll
      for (int r = 0; r < 4; ++r) {
        float ss = 0.f;
#pragma unroll
        for (int j = 0; j < 4; ++j) ss += acc[i][j][r] * acc[i][j][r];
        ss += shx(ss, 1); ss += shx(ss, 2); ss += shx(ss, 4); ss += shx(ss, 8);
        float rs = rsqrtf(ss * (1.f / 64.f) + 1e-6f);
#pragma unroll
        for (int j = 0; j < 4; ++j) acc[i][j][r] = acc[i][j][r] * rs * gj[j];
      }
  }
  if (!lat && (type == T_KA || type == T_VA || type == T_KC || type == T_VC)) {
    float* o;
    int W;
    if (type == T_KA) { o = p.out + OUT_AK; W = 512; }
    else if (type == T_VA) { o = p.out + OUT_AV; W = 512; }
    else if (type == T_KC) { o = p.out + OUT_CK; W = 128; }
    else { o = p.out + OUT_CV; W = 128; }
#pragma unroll
    for (int i = 0; i < 4; ++i)
#pragma unroll
      for (int r = 0; r < 4; ++r) {
        int t = tb + i * 16 + q4 * 4 + r;
        size_t base = ((size_t)(b * 2 + li) * 256 + t) * W + cbase;
#pragma unroll
        for (int j = 0; j < 4; ++j) o[base + j * 16 + l16] = acc[i][j][r];
      }
  }
  if (lat && (type == T_QA || type == T_KA || type == T_QC || type == T_KC)) {
#pragma unroll
    for (int i = 0; i < 4; ++i)
#pragma unroll
      for (int r = 0; r < 4; ++r) {
        int t = tb + i * 16 + q4 * 4 + r;
#pragma unroll
        for (int j = 0; j < 4; ++j) {
          float v = acc[i][j][r];
          float pv = shx(v, 1);
          float2 cs = rope[t * 32 + j * 8 + (l16 >> 1)];
          acc[i][j][r] = (l16 & 1) ? (pv * cs.y + v * cs.x) : (v * cs.x - pv * cs.y);
        }
      }
  }

  if (type == T_QA || type == T_KA || type == T_QC || type == T_KC) {
    u16* dst;
    int W;
    size_t rowbase;
    if (type == T_QA) { dst = (u16*)(p.ws + O_QA); W = 512; rowbase = (size_t)R0 * 512; }
    else if (type == T_QC) { dst = (u16*)(p.ws + O_QC); W = 256; rowbase = (size_t)R0 * 256; }
    else if (type == T_KA) {
      W = 512;
      if (!lat) { dst = (u16*)(p.ws + O_KACTX); rowbase = (size_t)R0 * 512; }
      else { dst = (u16*)(p.ws + O_KALAT); rowbase = ((size_t)(li * 2 + b) * 1536 + tb) * 512; }
    } else {
      W = 128;
      if (!lat) { dst = (u16*)(p.ws + O_KCCTX); rowbase = (size_t)R0 * 128; }
      else { dst = (u16*)(p.ws + O_KCLAT); rowbase = ((size_t)(li * 2 + b) * 1536 + tb) * 128; }
    }
#pragma unroll
    for (int i = 0; i < 4; ++i)
#pragma unroll
      for (int r = 0; r < 4; ++r) {
        size_t base = rowbase + (size_t)(i * 16 + q4 * 4 + r) * W + cbase;
#pragma unroll
        for (int j = 0; j < 4; ++j) dst[base + j * 16 + l16] = f2bf(acc[i][j][r]);
      }
  } else if (type == T_VA || type == T_VC) {
    u16* dst;
    int L;
    size_t hb;
    if (type == T_VA) {
      int h = cbase >> 7, dv0 = cbase & 127;
      if (!lat) { dst = (u16*)(p.ws + O_VTACTX); L = 256; hb = ((size_t)(b * 4 + h) * 128 + dv0) * 256; }
      else { dst = (u16*)(p.ws + O_VTALAT); L = 1536; hb = ((size_t)((li * 2 + b) * 4 + h) * 128 + dv0) * 1536; }
    } else {
      int n = cbase >> 6;
      if (!lat) { dst = (u16*)(p.ws + O_VTCCTX); L = 256; hb = ((size_t)(b * 2 + n) * 64) * 256; }
      else { dst = (u16*)(p.ws + O_VTCLAT); L = 1536; hb = ((size_t)((li * 2 + b) * 2 + n) * 64) * 1536; }
    }
#pragma unroll
    for (int i = 0; i < 4; ++i)
#pragma unroll
      for (int j = 0; j < 4; ++j) {
        uint2 o;
        o.x = pack2(acc[i][j][0], acc[i][j][1]);
        o.y = pack2(acc[i][j][2], acc[i][j][3]);
        *(uint2*)(dst + hb + (size_t)(j * 16 + l16) * L + tb + i * 16 + q4 * 4) = o;
      }
  } else {
    float* dst;
    if (type == T_QB) dst = (float*)(p.ws + O_HQ);
    else if (type == T_FF) dst = (float*)(p.ws + O_HGF);
    else if (type == T_FB) dst = (float*)(p.ws + O_HGB);
    else if (type == T_IB) dst = (float*)(p.ws + O_HI);
    else dst = (float*)(p.ws + O_HSG);
    float lbv[4] = {0.f, 0.f, 0.f, 0.f};
    if ((type == T_FF || type == T_FB) && li == 1) {
      const float* lg = (type == T_FF) ? p.in[19] : p.in[20];
#pragma unroll
      for (int j = 0; j < 4; ++j) {
        int c = cbase + j * 16 + l16;
        lbv[j] = 1.f / (1.f + expf(lg[c] - lg[256 + c]));
      }
    }
#pragma unroll
    for (int i = 0; i < 4; ++i)
#pragma unroll
      for (int r = 0; r < 4; ++r) {
        size_t base = (size_t)(R0 + i * 16 + q4 * 4 + r) * 256 + cbase;
#pragma unroll
        for (int j = 0; j < 4; ++j) {
          float v = acc[i][j][r];
          float o;
          if (type == T_QB || type == T_GB) o = siluf(v);
          else if (type == T_IB) o = v;
          else {
            float sg = 1.f / (1.f + expf(-v));
            float f = lbv[j] + (1.f - lbv[j]) * sg;
            o = logf(fmaxf(f, 1e-6f));
          }
          dst[base + j * 16 + l16] = o;
        }
      }
  }
}

template <int EPI>
DI void gemm_phase(const P& p, const GA& g, int li, char* smem) {
  const int NT = g.N >> 7;
  const int xcd = blockIdx.x & 7, lb = blockIdx.x >> 3, nlb = gridDim.x >> 3;
  if (lb >= nlb) return;
  for (int t = lb; t < 6 * NT; t += nlb) {
    int mt = xcd * 6 + t / NT, nt = t % NT;
    gemm_tile<EPI>(p, g, li, mt * 128, nt * 128, smem);
  }
}


template <int KW, int DV>
DI void attn_gload(const u16* Kb, int kstride, const u16* VT, int L, int kb, int tid, u32x4 (&kr)[KW / 32], u32x4 (&vr)[DV / 32]) {
  constexpr int KPR = 256 / (KW / 8);
  const unsigned koff = (unsigned)(tid / (KW / 8)) * (unsigned)kstride + (unsigned)(tid % (KW / 8)) * 8u;
  const unsigned voff = (unsigned)(tid >> 3) * (unsigned)L + (unsigned)(tid & 7) * 8u;
#pragma unroll
  for (int i = 0; i < KW / 32; ++i) {
    const u16* kbp = Kb + (size_t)(kb * 64 + KPR * i) * kstride;
    kr[i] = *(const u32x4*)(kbp + koff);
  }
#pragma unroll
  for (int i = 0; i < DV / 32; ++i) {
    const u16* vbp = VT + (size_t)(32 * i) * L + kb * 64;
    vr[i] = *(const u32x4*)(vbp + voff);
  }
}
template <int KW, int DV>
DI void attn_lstore(u16* sK, u16* sV, int tid, const u32x4 (&kr)[KW / 32], const u32x4 (&vr)[DV / 32]) {
  constexpr int KS = KW + 8;
#pragma unroll
  for (int i = 0; i < KW / 32; ++i) {
    int idx = tid + 256 * i;
    int key = idx / (KW / 8), cc = idx % (KW / 8);
    *(u32x4*)(sK + key * KS + cc * 8) = kr[i];
  }
#pragma unroll
  for (int i = 0; i < DV / 32; ++i) {
    int idx = tid + 256 * i;
    int row = idx >> 3, cc = idx & 7;
    *(u32x4*)(sV + row * 72 + cc * 8) = vr[i];
  }
}

template <int KW, int DV>
DI void attn_compute(const u16* sK, const u16* sV, int kfo, int l16, int q4, const bf16x8& qf0, const bf16x8& qf1,
                     f32x4 (&o)[DV / 16], float& m, float& l) {
  constexpr int KS = KW + 8, NDT = DV / 16;
  const float c = 0.125f * LOG2E;
  f32x4 st[4];
#pragma unroll
  for (int kt = 0; kt < 4; ++kt) {
    const u16* kp = sK + (kt * 16 + l16) * KS + kfo + q4 * 8;
    bf16x8 k0 = *(const bf16x8*)kp;
    bf16x8 k1 = *(const bf16x8*)(kp + 32);
    f32x4 z = {0.f, 0.f, 0.f, 0.f};
    z = MFMA16(k0, qf0, z);
    st[kt] = MFMA16(k1, qf1, z);
  }
  float bm = st[0][0];
#pragma unroll
  for (int kt = 0; kt < 4; ++kt)
#pragma unroll
    for (int r = 0; r < 4; ++r) bm = fmaxf(bm, st[kt][r]);
  bm = fmaxf(bm, shx(bm, 16));
  bm = fmaxf(bm, shx(bm, 32));
  const float mn = fmaxf(m, bm);
  const float alpha = ex2((m - mn) * c);
  m = mn;
  float ps = 0.f;
#pragma unroll
  for (int kt = 0; kt < 4; ++kt)
#pragma unroll
    for (int r = 0; r < 4; ++r) {
      float pv = ex2((st[kt][r] - mn) * c);
      st[kt][r] = pv;
      ps += pv;
    }
  l = l * alpha + ps;
#pragma unroll
  for (int d = 0; d < NDT; ++d) {
    o[d][0] *= alpha; o[d][1] *= alpha; o[d][2] *= alpha; o[d][3] *= alpha;
  }
#pragma unroll
  for (int ks = 0; ks < 2; ++ks) {
    u32x4 pu;
    pu.x = pack2(st[2 * ks][0], st[2 * ks][1]);
    pu.y = pack2(st[2 * ks][2], st[2 * ks][3]);
    pu.z = pack2(st[2 * ks + 1][0], st[2 * ks + 1][1]);
    pu.w = pack2(st[2 * ks + 1][2], st[2 * ks + 1][3]);
    bf16x8 pf = __builtin_bit_cast(bf16x8, pu);
#pragma unroll
    for (int d = 0; d < NDT; ++d) {
      const u16* vp = sV + (d * 16 + l16) * 72 + ks * 32 + q4 * 4;
      u32x2 v0 = *(const u32x2*)vp;
      u32x2 v1 = *(const u32x2*)(vp + 16);
      u32x4 vu = {v0.x, v0.y, v1.x, v1.y};
      bf16x8 vf = __builtin_bit_cast(bf16x8, vu);
      o[d] = MFMA16(vf, pf, o[d]);
    }
  }
}

template <int KW, int DV, bool DIFF>
DI void attn_item(const u16* Q, int qstride, int qcol, int qrow0, const u16* Kb, int kstride, const u16* VT, int L,
                          int nkeys, u16* mixed, int mixcol, float lam, float postscale, const float* subg, char* smem) {
  const int tid = ltid(), lane = tid & 63, wid = tid >> 6, l16 = lane & 15, q4 = lane >> 4;
  const int qsub = wid & 1, var = wid >> 1;
  constexpr int KS = KW + 8;
  constexpr int STAGE = 64 * KS + DV * 72;
  u16* sK0 = (u16*)smem;
  u16* sV0 = sK0 + 64 * KS;
  u16* sK1 = sK0 + STAGE;
  u16* sV1 = sV0 + STAGE;
  constexpr int KPT = KW / 32, VPT = DV / 32, NDT = DV / 16;
  const int kfo = DIFF ? var * 64 : 0;

  const u16* qp = Q + (size_t)(qrow0 + qsub * 16 + l16) * qstride + qcol + var * 64 + q4 * 8;
  const bf16x8 qf0 = *(const bf16x8*)qp;
  const bf16x8 qf1 = *(const bf16x8*)(qp + 32);

  u32x4 kr0[KPT], vr0[VPT], kr1[KPT], vr1[VPT];
  f32x4 o[NDT];
#pragma unroll
  for (int d = 0; d < NDT; ++d) o[d] = f32x4{0.f, 0.f, 0.f, 0.f};
  float m = -INFINITY, l = 0.f;
  const int nkb = nkeys >> 6;
  attn_gload<KW, DV>(Kb, kstride, VT, L, 0, tid, kr0, vr0);
  attn_gload<KW, DV>(Kb, kstride, VT, L, 1, tid, kr1, vr1);
  __syncthreads();
  attn_lstore<KW, DV>(sK0, sV0, tid, kr0, vr0);
  attn_gload<KW, DV>(Kb, kstride, VT, L, 2, tid, kr0, vr0);
  __syncthreads();
#pragma unroll 1
  for (int kb = 0; kb < nkb; kb += 2) {
    attn_lstore<KW, DV>(sK1, sV1, tid, kr1, vr1);
    if (kb + 3 < nkb) attn_gload<KW, DV>(Kb, kstride, VT, L, kb + 3, tid, kr1, vr1);
    attn_compute<KW, DV>(sK0, sV0, kfo, l16, q4, qf0, qf1, o, m, l);
    __syncthreads();
    if (kb + 2 < nkb) attn_lstore<KW, DV>(sK0, sV0, tid, kr0, vr0);
    if (kb + 4 < nkb) attn_gload<KW, DV>(Kb, kstride, VT, L, kb + 4, tid, kr0, vr0);
    attn_compute<KW, DV>(sK1, sV1, kfo, l16, q4, qf0, qf1, o, m, l);
    __syncthreads();
  }
  l += shx(l, 16);
  l += shx(l, 32);
  const float inv = 1.f / l;
  const int row = qrow0 + qsub * 16 + l16;
  if constexpr (DIFF) {
    __syncthreads();
    float* sO = (float*)smem;
    if (var == 1) {
#pragma unroll
      for (int d = 0; d < NDT; ++d)
        *(float4*)(sO + (qsub * 16 + l16) * 132 + d * 16 + q4 * 4) =
            make_float4(o[d][0] * inv, o[d][1] * inv, o[d][2] * inv, o[d][3] * inv);
    }
    __syncthreads();
    if (var == 0) {
      float ss = 0.f;
#pragma unroll
      for (int d = 0; d < NDT; ++d) {
        float4 o1 = *(const float4*)(sO + (qsub * 16 + l16) * 132 + d * 16 + q4 * 4);
        o[d][0] = o[d][0] * inv - lam * o1.x;
        o[d][1] = o[d][1] * inv - lam * o1.y;
        o[d][2] = o[d][2] * inv - lam * o1.z;
        o[d][3] = o[d][3] * inv - lam * o1.w;
        ss += o[d][0] * o[d][0] + o[d][1] * o[d][1] + o[d][2] * o[d][2] + o[d][3] * o[d][3];
      }
      ss += shx(ss, 16);
      ss += shx(ss, 32);
      const float rs = rsqrtf(ss * (1.f / 128.f) + 1e-6f) * postscale;
#pragma unroll
      for (int d = 0; d < NDT; ++d) {
        float4 gg = *(const float4*)(subg + d * 16 + q4 * 4);
        uint2 ov;
        ov.x = pack2(o[d][0] * rs * gg.x, o[d][1] * rs * gg.y);
        ov.y = pack2(o[d][2] * rs * gg.z, o[d][3] * rs * gg.w);
        *(uint2*)(mixed + (size_t)row * 1024 + mixcol + d * 16 + q4 * 4) = ov;
      }
    }
  } else {
#pragma unroll
    for (int d = 0; d < NDT; ++d) {
      uint2 ov;
      ov.x = pack2(o[d][0] * inv, o[d][1] * inv);
      ov.y = pack2(o[d][2] * inv, o[d][3] * inv);
      *(uint2*)(mixed + (size_t)row * 1024 + mixcol + var * 64 + d * 16 + q4 * 4) = ov;
    }
  }
}

DI void attnA_item(const P& p, int li, int it, char* smem) {
  const int lane = ltid() & 63;
  float d1 = p.in[14][li * 64 + lane] * p.in[15][li * 64 + lane];
  float d2 = p.in[16][li * 64 + lane] * p.in[17][li * 64 + lane];
#pragma unroll
  for (int s = 1; s < 64; s <<= 1) { d1 += shx(d1, s); d2 += shx(d2, s); }
  const float lam_init = 0.8f - 0.6f * expf(-0.3f * (float)li);
  const float lam = expf(d1) - expf(d2) + lam_init;
  const u16* QA = (const u16*)(p.ws + O_QA);
  u16* mixed = (u16*)(p.ws + O_MIXED);
  const float* subg = p.in[18] + li * 128;
  int qrow0, L;
  const u16 *Kb, *VT;
  int h;
  if (it < 256) {
    int b = it >> 7, qb = it & 31;
    h = (it >> 5) & 3;
    Kb = (const u16*)(p.ws + O_KALAT) + (size_t)(li * 2 + b) * 1536 * 512 + h * 128;
    VT = (const u16*)(p.ws + O_VTALAT) + (size_t)((li * 2 + b) * 4 + h) * 128 * 1536;
    qrow0 = NCTX + b * 1024 + qb * 32;
    L = 1536;
  } else {
    it -= 256;
    int b = it >> 5, qb = it & 7;
    h = (it >> 3) & 3;
    Kb = (const u16*)(p.ws + O_KACTX) + (size_t)b * 256 * 512 + h * 128;
    VT = (const u16*)(p.ws + O_VTACTX) + (size_t)(b * 4 + h) * 128 * 256;
    qrow0 = b * 256 + qb * 32;
    L = 256;
  }
  attn_item<128, 128, true>(QA, 512, h * 128, qrow0, Kb, 512, VT, L, L, mixed, h * 128, lam, 1.f - lam_init, subg, smem);
}
DI void attnC_item(const P& p, int li, int it, char* smem) {
  const u16* QC = (const u16*)(p.ws + O_QC);
  u16* mixed = (u16*)(p.ws + O_MIXED);
  int qrow0, L, n;
  const u16 *Kb, *VT;
  if (it < 128) {
    int b = it >> 6, qb = it & 31;
    n = (it >> 5) & 1;
    Kb = (const u16*)(p.ws + O_KCLAT) + (size_t)(li * 2 + b) * 1536 * 128 + n * 64;
    VT = (const u16*)(p.ws + O_VTCLAT) + (size_t)((li * 2 + b) * 2 + n) * 64 * 1536;
    qrow0 = NCTX + b * 1024 + qb * 32;
    L = 1536;
  } else {
    it -= 128;
    int b = it >> 4, qb = it & 7;
    n = (it >> 3) & 1;
    Kb = (const u16*)(p.ws + O_KCCTX) + (size_t)b * 256 * 128 + n * 64;
    VT = (const u16*)(p.ws + O_VTCCTX) + (size_t)(b * 2 + n) * 64 * 256;
    qrow0 = b * 256 + qb * 32;
    L = 256;
  }
  attn_item<64, 64, false>(QC, 256, n * 128, qrow0, Kb, 128, VT, L, L, mixed, 768 + n * 128, 0.f, 1.f, nullptr, smem);
}

DI void h1_item(const P& p, int item, char* smem) {
  const int tid = ltid(), lane = tid & 63, w = tid >> 6, l16 = lane & 15, q4 = lane >> 4;
  const int dir = item & 1, h = (item >> 1) & 3, tc = item >> 3;
  const int row0 = tc * 64;
  float* sQ = (float*)smem;
  float* sB = sQ + 64 * 68;
  float* sK = sB + 64 * 68;
  u16* sVT = (u16*)(sK + 64 * 68);
  float* sTot = (float*)(sVT + 64 * 72);
  const float* HQ = (const float*)(p.ws + O_HQ);
  const float* HG = (const float*)(p.ws + (dir ? O_HGB : O_HGF));
  const float* HI = (const float*)(p.ws + O_HI);
  float* OI = (float*)(p.ws + O_OI) + (size_t)dir * NTOK * 256;
  u16* QE = (u16*)(p.ws + O_QE) + (size_t)dir * NTOK * 256;
  float* KV = (float*)(p.ws + O_KV) + (size_t)item * 4096;
  float* DEC = (float*)(p.ws + O_DEC) + (size_t)item * 64;

  __syncthreads();
#pragma unroll
  for (int i = 0; i < 4; ++i) {
    int idx = tid + 256 * i;
    int lo = idx >> 4, c4 = idx & 15;
    int row = dir ? row0 + 63 - lo : row0 + lo;
    size_t off = (size_t)row * 256 + h * 64 + c4 * 4;
    *(float4*)(sQ + lo * 68 + c4 * 4) = *(const float4*)(HQ + off);
    *(float4*)(sB + lo * 68 + c4 * 4) = *(const float4*)(HG + off);
    float4 v = *(const float4*)(HI + off);
    sVT[(c4 * 4 + 0) * 72 + lo] = f2bf(v.x);
    sVT[(c4 * 4 + 1) * 72 + lo] = f2bf(v.y);
    sVT[(c4 * 4 + 2) * 72 + lo] = f2bf(v.z);
    sVT[(c4 * 4 + 3) * 72 + lo] = f2bf(v.w);
  }
  __syncthreads();
  {
    const int k = tid & 63, part = tid >> 6;
    float run = 0.f;
#pragma unroll 4
    for (int e = 0; e < 16; ++e) {
      int i = part * 16 + e;
      float g = sB[i * 68 + k];
      sK[i * 68 + k] = -expm1f(g);
      run += g * LOG2E;
      sB[i * 68 + k] = run;
    }
    sTot[part * 64 + k] = run;
    __syncthreads();
    float add = 0.f;
    for (int pp = 0; pp < part; ++pp) add += sTot[pp * 64 + k];
    if (part > 0)
      for (int e = 0; e < 16; ++e) sB[(part * 16 + e) * 68 + k] += add;
  }
  __syncthreads();
#pragma unroll
  for (int i = 0; i < 4; ++i) {
    int idx = tid + 256 * i;
    int lo = idx >> 4, c4 = idx & 15;
    int row = dir ? row0 + 63 - lo : row0 + lo;
    f32x4 q = *(const f32x4*)(sQ + lo * 68 + c4 * 4);
    f32x4 bb = *(const f32x4*)(sB + lo * 68 + c4 * 4);
    u32x2 o;
    o.x = pack2(q.x * ex2(bb.x), q.y * ex2(bb.y));
    o.y = pack2(q.z * ex2(bb.z), q.w * ex2(bb.w));
    *(u32x2*)(QE + (size_t)row * 256 + h * 64 + c4 * 4) = o;
  }
  {
    const int I = w;
    bf16x8 qs[2];
    f32x4 rr[2][2];
#pragma unroll
    for (int s = 0; s < 2; ++s) {
      const int kk0 = s * 32 + q4 * 8;
      if (I > 0) {
        rr[s][0] = *(const f32x4*)(sB + (16 * I - 1) * 68 + kk0);
        rr[s][1] = *(const f32x4*)(sB + (16 * I - 1) * 68 + kk0 + 4);
      } else {
        rr[s][0] = f32x4{0.f, 0.f, 0.f, 0.f};
        rr[s][1] = rr[s][0];
      }
      const float* qr = sQ + (16 * I + l16) * 68 + kk0;
      const float* br = sB + (16 * I + l16) * 68 + kk0;
      f32x4 q0 = *(const f32x4*)qr, q1 = *(const f32x4*)(qr + 4);
      f32x4 b0 = *(const f32x4*)br, b1 = *(const f32x4*)(br + 4);
      u32x4 pu;
      pu.x = pack2(q0.x * ex2(b0.x - rr[s][0].x), q0.y * ex2(b0.y - rr[s][0].y));
      pu.y = pack2(q0.z * ex2(b0.z - rr[s][0].z), q0.w * ex2(b0.w - rr[s][0].w));
      pu.z = pack2(q1.x * ex2(b1.x - rr[s][1].x), q1.y * ex2(b1.y - rr[s][1].y));
      pu.w = pack2(q1.z * ex2(b1.z - rr[s][1].z), q1.w * ex2(b1.w - rr[s][1].w));
      qs[s] = __builtin_bit_cast(bf16x8, pu);
    }
    f32x4 at[4];
#pragma unroll
    for (int J = 0; J < 4; ++J) {
      at[J] = f32x4{0.f, 0.f, 0.f, 0.f};
      if (J <= I) {
#pragma unroll
        for (int s = 0; s < 2; ++s) {
          const int kk0 = s * 32 + q4 * 8;
          const float* kr = sK + (16 * J + l16) * 68 + kk0;
          const float* br = sB + (16 * J + l16) * 68 + kk0;
          f32x4 k0 = *(const f32x4*)kr, k1 = *(const f32x4*)(kr + 4);
          f32x4 b0 = *(const f32x4*)br, b1 = *(const f32x4*)(br + 4);
          u32x4 pu;
          pu.x = pack2(k0.x * ex2(fminf(rr[s][0].x - b0.x, 100.f)), k0.y * ex2(fminf(rr[s][0].y - b0.y, 100.f)));
          pu.y = pack2(k0.z * ex2(fminf(rr[s][0].z - b0.z, 100.f)), k0.w * ex2(fminf(rr[s][0].w - b0.w, 100.f)));
          pu.z = pack2(k1.x * ex2(fminf(rr[s][1].x - b1.x, 100.f)), k1.y * ex2(fminf(rr[s][1].y - b1.y, 100.f)));
          pu.w = pack2(k1.z * ex2(fminf(rr[s][1].z - b1.z, 100.f)), k1.w * ex2(fminf(rr[s][1].w - b1.w, 100.f)));
          bf16x8 kf = __builtin_bit_cast(bf16x8, pu);
          at[J] = MFMA16(kf, qs[s], at[J]);
        }
        if (J == I) {
#pragma unroll
          for (int r = 0; r < 4; ++r)
            if (q4 * 4 + r > l16) at[J][r] = 0.f;
        }
      }
    }
    f32x4 oc[4];
#pragma unroll
    for (int vt = 0; vt < 4; ++vt) oc[vt] = f32x4{0.f, 0.f, 0.f, 0.f};
#pragma unroll
    for (int ks = 0; ks < 2; ++ks) {
      if (2 * ks <= I) {
        u32x4 pu;
        pu.x = pack2(at[2 * ks][0], at[2 * ks][1]);
        pu.y = pack2(at[2 * ks][2], at[2 * ks][3]);
        pu.z = pack2(at[2 * ks + 1][0], at[2 * ks + 1][1]);
        pu.w = pack2(at[2 * ks + 1][2], at[2 * ks + 1][3]);
        bf16x8 pf = __builtin_bit_cast(bf16x8, pu);
#pragma unroll
        for (int vt = 0; vt < 4; ++vt) {
          const u16* vp = sVT + (vt * 16 + l16) * 72 + ks * 32 + q4 * 4;
          u32x2 v0 = *(const u32x2*)vp;
          u32x2 v1 = *(const u32x2*)(vp + 16);
          u32x4 vu = {v0.x, v0.y, v1.x, v1.y};
          oc[vt] = MFMA16(__builtin_bit_cast(bf16x8, vu), pf, oc[vt]);
        }
      }
    }
    {
      const int t = 16 * I + l16;
      const int row = dir ? row0 + 63 - t : row0 + t;
#pragma unroll
      for (int vt = 0; vt < 4; ++vt) *(f32x4*)(OI + (size_t)row * 256 + h * 64 + vt * 16 + q4 * 4) = oc[vt];
    }
  }
  {
    const int k = 16 * w + l16;
    const float bend = sB[63 * 68 + k];
    f32x4 kc[4];
#pragma unroll
    for (int vt = 0; vt < 4; ++vt) kc[vt] = f32x4{0.f, 0.f, 0.f, 0.f};
#pragma unroll
    for (int ks = 0; ks < 2; ++ks) {
      float kd[8];
#pragma unroll
      for (int j = 0; j < 8; ++j) {
        const int s = ks * 32 + q4 * 8 + j;
        kd[j] = sK[s * 68 + k] * ex2(bend - sB[s * 68 + k]);
      }
      u32x4 pu;
      pu.x = pack2(kd[0], kd[1]);
      pu.y = pack2(kd[2], kd[3]);
      pu.z = pack2(kd[4], kd[5]);
      pu.w = pack2(kd[6], kd[7]);
      bf16x8 af = __builtin_bit_cast(bf16x8, pu);
#pragma unroll
      for (int vt = 0; vt < 4; ++vt) {
        bf16x8 vf = *(const bf16x8*)(sVT + (vt * 16 + l16) * 72 + ks * 32 + q4 * 8);
        kc[vt] = MFMA16(af, vf, kc[vt]);
      }
    }
#pragma unroll
    for (int vt = 0; vt < 4; ++vt)
#pragma unroll
      for (int r = 0; r < 4; ++r) KV[(16 * w + q4 * 4 + r) * 64 + vt * 16 + l16] = kc[vt][r];
    if (q4 == 0) DEC[k] = ex2(bend);
  }
}

DI void h2_item(const P& p, int li, int item, char* smem) {
  const int tid = ltid(), ty = tid >> 4, tx = tid & 15;
  const int lane = tid & 63, w = tid >> 6, l16 = lane & 15, q4 = lane >> 4;
  const int h = item & 3, tc = item >> 2, row0 = tc * 64;
  const bool lat = tc >= 64;
  int seq, cl, nc;
  if (!lat) { seq = tc >> 2; cl = tc & 3; nc = 4; } else { seq = (tc - 64) >> 4; cl = (tc - 64) & 15; nc = 16; }
  const int tcbase = tc - cl;
  u16* sST = (u16*)smem;
  const float* KVb = (const float*)(p.ws + O_KV);
  const float* DECb = (const float*)(p.ws + O_DEC);
  __syncthreads();
#pragma unroll 1
  for (int dir = 0; dir < 2; ++dir) {
    float4 S[4];
#pragma unroll
    for (int a = 0; a < 4; ++a) {
      if (lat) S[a] = *(const float4*)(p.in[6 + dir] + ((size_t)((seq * 2 + li) * 4 + h) * 64 + ty + 16 * a) * 64 + tx * 4);
      else S[a] = make_float4(0.f, 0.f, 0.f, 0.f);
    }
    const int nprev = dir == 0 ? cl : nc - 1 - cl;
#pragma unroll 1
    for (int j = 0; j < nprev; ++j) {
      int tcj = tcbase + (dir == 0 ? j : nc - 1 - j);
      size_t itj = (size_t)((tcj * 4 + h) * 2 + dir);
#pragma unroll
      for (int a = 0; a < 4; ++a) {
        int k = ty + 16 * a;
        float dcy = DECb[itj * 64 + k];
        float4 kv = *(const float4*)(KVb + itj * 4096 + k * 64 + tx * 4);
        S[a].x = dcy * S[a].x + kv.x; S[a].y = dcy * S[a].y + kv.y; S[a].z = dcy * S[a].z + kv.z; S[a].w = dcy * S[a].w + kv.w;
      }
    }
    if (!lat && nprev == nc - 1) {
      size_t itj = (size_t)((tc * 4 + h) * 2 + dir);
      float* so = p.out + (dir == 0 ? OUT_SF : OUT_SB) + (size_t)((seq * 2 + li) * 4 + h) * 4096;
#pragma unroll
      for (int a = 0; a < 4; ++a) {
        int k = ty + 16 * a;
        float dcy = DECb[itj * 64 + k];
        float4 kv = *(const float4*)(KVb + itj * 4096 + k * 64 + tx * 4);
        *(float4*)(so + k * 64 + tx * 4) = make_float4(dcy * S[a].x + kv.x, dcy * S[a].y + kv.y, dcy * S[a].z + kv.z, dcy * S[a].w + kv.w);
      }
    }
    u16* st = sST + dir * 64 * 72;
#pragma unroll
    for (int a = 0; a < 4; ++a) {
      int k = ty + 16 * a;
      st[(tx * 4 + 0) * 72 + k] = f2bf(S[a].x);
      st[(tx * 4 + 1) * 72 + k] = f2bf(S[a].y);
      st[(tx * 4 + 2) * 72 + k] = f2bf(S[a].z);
      st[(tx * 4 + 3) * 72 + k] = f2bf(S[a].w);
    }
  }
  __syncthreads();
  f32x4 oc[4];
#pragma unroll
  for (int vt = 0; vt < 4; ++vt) oc[vt] = f32x4{0.f, 0.f, 0.f, 0.f};
#pragma unroll
  for (int dir = 0; dir < 2; ++dir) {
    const u16* QE = (const u16*)(p.ws + O_QE) + (size_t)dir * NTOK * 256 + (size_t)(row0 + 16 * w + l16) * 256 + h * 64 + q4 * 8;
    const u16* st = sST + dir * 64 * 72;
#pragma unroll
    for (int ks = 0; ks < 2; ++ks) {
      bf16x8 af = *(const bf16x8*)(QE + ks * 32);
#pragma unroll
      for (int vt = 0; vt < 4; ++vt) {
        bf16x8 bf = *(const bf16x8*)(st + (vt * 16 + l16) * 72 + ks * 32 + q4 * 8);
        oc[vt] = MFMA16(af, bf, oc[vt]);
      }
    }
  }
  const float* OI0 = (const float*)(p.ws + O_OI);
  const float* OI1 = OI0 + (size_t)NTOK * 256;
  const float* HSG = (const float*)(p.ws + O_HSG);
  u16* mixed = (u16*)(p.ws + O_MIXED);
  float gn[4];
#pragma unroll
  for (int vt = 0; vt < 4; ++vt) gn[vt] = p.in[21][li * 64 + vt * 16 + l16];
#pragma unroll
  for (int r = 0; r < 4; ++r) {
    const int row = row0 + 16 * w + q4 * 4 + r;
    const size_t off = (size_t)row * 256 + h * 64 + l16;
    float val[4];
    float ss = 0.f;
#pragma unroll
    for (int vt = 0; vt < 4; ++vt) {
      val[vt] = oc[vt][r] + OI0[off + vt * 16] + OI1[off + vt * 16];
      ss += val[vt] * val[vt];
    }
    ss += shx(ss, 1); ss += shx(ss, 2); ss += shx(ss, 4); ss += shx(ss, 8);
    const float rs = rsqrtf(ss * (1.f / 64.f) + 1e-6f);
#pragma unroll
    for (int vt = 0; vt < 4; ++vt)
      mixed[(size_t)row * 1024 + 512 + h * 64 + vt * 16 + l16] = f2bf(val[vt] * rs * gn[vt] * HSG[off + vt * 16]);
  }
}

DI void ln_apply(const P& p, const float* lo, const float* hi, const float* stats, const float* lng, const float* lnb,
                 const float* mods, int sc_off, int sh_off) {
  const int lane = ltid() & 63, wid = ltid() >> 6;
  u16* dst = (u16*)(p.ws + O_ABF);
  for (int it = blockIdx.x; it < NTOK / 4; it += gridDim.x) {
    const int row = it * 4 + wid;
    float mu = 0.f, rs = 1.f;
    if (stats != nullptr) {
      float s1 = 0.f, s2 = 0.f;
      if (lane < 16) {
        float2 v = *(const float2*)(stats + (size_t)row * 32 + lane * 2);
        s1 = v.x;
        s2 = v.y;
      }
#pragma unroll
      for (int s = 1; s < 16; s <<= 1) { s1 += shx(s1, s); s2 += shx(s2, s); }
      s1 = __shfl(s1, 0, 64);
      s2 = __shfl(s2, 0, 64);
      mu = s1 * (1.f / 1024.f);
      rs = rsqrtf(fmaxf(s2 * (1.f / 1024.f) - mu * mu, 0.f) + 1e-6f);
    }
    const float* x = row < NCTX ? lo + (size_t)row * 1024 : hi + (size_t)(row - NCTX) * 1024;
    const int rtype = row < NCTX ? 0 : 1 + ((row - NCTX) >> 10);
    const float* mv = mods + rtype * 6144;
#pragma unroll
    for (int i = 0; i < 4; ++i) {
      const int c = (lane + 64 * i) * 4;
      f32x4 v = *(const f32x4*)(x + c);
      f32x4 sc = *(const f32x4*)(mv + sc_off + c) + 1.f;
      f32x4 sh = *(const f32x4*)(mv + sh_off + c);
      if (stats != nullptr) {
        f32x4 gg = *(const f32x4*)(lng + c);
        f32x4 bb = *(const f32x4*)(lnb + c);
        v = (v - mu) * rs * gg + bb;
      }
      v = v * sc + sh;
      u32x2 o;
      o.x = pack2(v.x, v.y);
      o.y = pack2(v.z, v.w);
      *(u32x2*)(dst + (size_t)row * 1024 + c) = o;
    }
  }
}

DI void final_ln(const P& p) {
  const int lane = ltid() & 63, wid = ltid() >> 6;
  const float* X = (const float*)(p.ws + O_XPRE2);
  const float* ST = (const float*)(p.ws + O_ST2);
  const float* g = p.in[26] + 1024;
  const float* bb = p.in[27] + 1024;
  for (int it = blockIdx.x; it < NTOK / 4; it += gridDim.x) {
    int row = it * 4 + wid;
    float s1 = 0.f, s2 = 0.f;
    if (lane < 16) {
      float2 v = *(const float2*)(ST + (size_t)row * 32 + lane * 2);
      s1 = v.x;
      s2 = v.y;
    }
#pragma unroll
    for (int s = 1; s < 16; s <<= 1) { s1 += shx(s1, s); s2 += shx(s2, s); }
    s1 = __shfl(s1, 0, 64);
    s2 = __shfl(s2, 0, 64);
    float mu = s1 * (1.f / 1024.f);
    float rs = rsqrtf(fmaxf(s2 * (1.f / 1024.f) - mu * mu, 0.f) + 1e-6f);
    float* out = p.out + (row < NCTX ? OUT_YP + (size_t)row * 1024 : OUT_YS + (size_t)(row - NCTX) * 1024);
#pragma unroll
    for (int i = 0; i < 4; ++i) {
      int c = (lane + 64 * i) * 4;
      float4 x = *(const float4*)(X + (size_t)row * 1024 + c);
      float4 gg = *(const float4*)(g + c);
      float4 b4 = *(const float4*)(bb + c);
      *(float4*)(out + c) = make_float4((x.x - mu) * rs * gg.x + b4.x, (x.y - mu) * rs * gg.y + b4.y,
                                         (x.z - mu) * rs * gg.z + b4.z, (x.w - mu) * rs * gg.w + b4.w);
    }
  }
}

DI void run_phase(const P& p, int ph, char* smem) {
  if (ph == 0) { phase0(p, smem); return; }
  if (ph == NPHASE - 1) { final_ln(p); return; }
  const int li = (ph - 1) >> 3, s = (ph - 1) & 7;
  float* XPRE1 = (float*)(p.ws + O_XPRE1);
  float* XPRE2 = (float*)(p.ws + O_XPRE2);
  float* ST1 = (float*)(p.ws + O_ST1);
  float* ST2 = (float*)(p.ws + O_ST2);
  GA g;
  g.mods = (const float*)(p.ws + O_MODS) + li * 3 * 6144;
  g.a16 = (const u16*)(p.ws + O_ABF); g.xout = nullptr; g.sout = nullptr; g.hid = nullptr;
  g.alo = nullptr; g.ahi = nullptr; g.stats = nullptr; g.lng = nullptr; g.lnb = nullptr; g.sc_off = 0; g.sh_off = 0;
  const float* xin_lo = li == 0 ? p.in[0] : XPRE2;
  const float* xin_hi = li == 0 ? p.in[1] : XPRE2 + (size_t)NCTX * 1024;
  const float* xin_st = li == 0 ? nullptr : ST2;
  const float* xin_g = p.in[26] + (li == 0 ? 0 : (li - 1) * 1024);
  const float* xin_b = p.in[27] + (li == 0 ? 0 : (li - 1) * 1024);
  if (s == 0) {
    ln_apply(p, xin_lo, xin_hi, xin_st, xin_g, xin_b, g.mods, 1024, 0);
  } else if (s == 1) {
    g.bt = (const u16*)(p.ws + O_WTIN) + (size_t)li * NIN * D; g.K = D; g.N = NIN;
    gemm_phase<0>(p, g, li, smem);
  } else if (s == 2) {
    for (int it = blockIdx.x; it < 768 + 768; it += gridDim.x) {
      if (it >= 256 && it < 1024) h1_item(p, it - 256, smem);
      else attnA_item(p, li, it < 256 ? it : it - 768, smem);
    }
  } else if (s == 3) {
    for (int it = blockIdx.x; it < 384 + 384; it += gridDim.x) {
      if (it >= 128 && it < 512) h2_item(p, li, it - 128, smem);
      else attnC_item(p, li, it < 128 ? it : it - 384, smem);
    }
  } else if (s == 4) {
    g.alo = xin_lo; g.ahi = xin_hi; g.stats = xin_st; g.lng = xin_g; g.lnb = xin_b;
    g.sc_off = 2048;
    g.a16 = (const u16*)(p.ws + O_MIXED);
    g.bt = (const u16*)(p.ws + O_WTOUT) + (size_t)li * D * D; g.K = D; g.N = D;
    g.xout = XPRE1; g.sout = ST1;
    gemm_phase<1>(p, g, li, smem);
  } else if (s == 5) {
    ln_apply(p, XPRE1, XPRE1 + (size_t)NCTX * 1024, ST1, p.in[24] + li * 1024, p.in[25] + li * 1024, g.mods, 4096, 3072);
  } else if (s == 6) {
    g.bt = (const u16*)(p.ws + O_WTFF1) + (size_t)li * DFF * D; g.K = D; g.N = DFF;
    g.hid = (u16*)(p.ws + O_HID);
    gemm_phase<2>(p, g, li, smem);
  } else {
    g.alo = XPRE1; g.ahi = XPRE1 + (size_t)NCTX * 1024; g.stats = ST1; g.lng = p.in[24] + li * 1024; g.lnb = p.in[25] + li * 1024;
    g.sc_off = 5120;
    g.a16 = (const u16*)(p.ws + O_HID);
    g.bt = (const u16*)(p.ws + O_WTFF2) + (size_t)li * D * DFF; g.K = DFF; g.N = D;
    g.xout = XPRE2; g.sout = ST2;
    gemm_phase<1>(p, g, li, smem);
  }
}

#define XB_TMO      128
#define XB_XCNT(j)  (256  + 64 * (j))
#define XB_XSUB(j)  (1280 + 64 * (j))
#define XB_XGEN(j)  (2304 + 64 * (j))
#define XB_TOP      3328
#define XB_TOPGEN   3392
#define XCD_BAR_WORDS 3456
#define XB_SPIN_CAP (1u << 20)
#define LAS __attribute__((address_space(3)))
DI unsigned xb_ld(unsigned* p) { return __hip_atomic_load(p, __ATOMIC_RELAXED, __HIP_MEMORY_SCOPE_AGENT); }
DI unsigned xb_add(unsigned* p, unsigned v) { return __hip_atomic_fetch_add(p, v, __ATOMIC_RELAXED, __HIP_MEMORY_SCOPE_AGENT); }
DI unsigned xb_xcc_id() { return (unsigned)__builtin_amdgcn_s_getreg((3 << 11) | 20) & 0xFu; }
#define XB_SPIN(cond, bar) do { unsigned _sp = 0; while (cond) { __builtin_amdgcn_s_sleep(1); \
    if ((++_sp & 255u) == 0u) { if (xb_ld(&(bar)[XB_TMO])) break; if (_sp > XB_SPIN_CAP) { atomicAdd(&(bar)[XB_TMO], 1u); break; } } } } while (0)
struct XcdBarrier { unsigned* bar; unsigned x; volatile LAS unsigned* st; };
DI XcdBarrier xcd_barrier_post(unsigned* bar, volatile LAS unsigned* st) {
  XcdBarrier b; b.bar = bar; b.x = xb_xcc_id(); b.st = st;
  if (threadIdx.x == 0) (void)xb_add(&bar[XB_XCNT(b.x)], 1u);
  return b;
}
DI void xcd_barrier_complete(unsigned* bar, unsigned x, unsigned& nloc, unsigned& nx) {
  const unsigned G = gridDim.x * gridDim.y * gridDim.z;
  unsigned sum, cnt, mine, sp = 0u;
  for (;;) {
    sum = 0u; cnt = 0u; mine = 0u;
#pragma unroll
    for (unsigned j = 0; j < 16; ++j) { const unsigned c = xb_ld(&bar[XB_XCNT(j)]); sum += c; cnt += (c > 0u) ? 1u : 0u; mine = (j == x) ? c : mine; }
    if (sum == G) break;
    __builtin_amdgcn_s_sleep(1);
    if ((++sp & 255u) == 0u) { if (xb_ld(&bar[XB_TMO])) break; if (sp > XB_SPIN_CAP) { atomicAdd(&bar[XB_TMO], 1u); break; } }
  }
  nloc = mine > 0u ? mine : 1u; nx = cnt > 0u ? cnt : 1u;
}
DI void xcd_barrier(const XcdBarrier& b) {
  asm volatile("s_waitcnt vmcnt(0)" ::: "memory");
  __syncthreads();
  if (threadIdx.x == 0) {
    unsigned* bar = b.bar;
    __builtin_amdgcn_s_waitcnt(0);
    unsigned nloc = b.st[0], nx = b.st[1];
    if (nloc == 0u) { xcd_barrier_complete(bar, b.x, nloc, nx); b.st[0] = nloc; b.st[1] = nx; }
    const unsigned old = xb_add(&bar[XB_XSUB(b.x)], 1u);
    const unsigned gen = old / nloc;
    if (old + 1u == (gen + 1u) * nloc) {
      __builtin_amdgcn_fence(__ATOMIC_RELEASE, "agent");
      asm volatile("s_waitcnt vmcnt(0)" ::: "memory");
      const unsigned og = xb_add(&bar[XB_TOP], 1u);
      const unsigned tg = og / nx;
      if (og + 1u == (tg + 1u) * nx) xb_add(&bar[XB_TOPGEN], 1u);
      else XB_SPIN(xb_ld(&bar[XB_TOPGEN]) == tg, bar);
      __builtin_amdgcn_fence(__ATOMIC_ACQUIRE, "agent");
      xb_add(&bar[XB_XGEN(b.x)], 1u);
      asm volatile("s_waitcnt vmcnt(0)" ::: "memory");
    } else {
      XB_SPIN(xb_ld(&bar[XB_XGEN(b.x)]) == gen, bar);
      __builtin_amdgcn_fence(__ATOMIC_ACQUIRE, "agent");
      asm volatile("s_waitcnt vmcnt(0)" ::: "memory");
    }
  }
  __syncthreads();
}
constexpr size_t O_BAR = O_END1;
static_assert(O_BAR + XCD_BAR_WORDS * 4 <= (size_t)256 * 1024 * 1024, "barrier words must fit");

#if !MULTI_LAUNCH
__global__ void __launch_bounds__(256, 2) mega_kernel(P p) {
  extern __shared__ __attribute__((aligned(16))) char smem[];
  cg::grid_group grid = cg::this_grid();
  if (p.ws == nullptr) grid.sync();
  if (threadIdx.x == 0) *(uint4*)(smem + LDS_BYTES - 16) = make_uint4(0u, 0u, 0u, 0u);
  __syncthreads();
  XcdBarrier xb = xcd_barrier_post((unsigned*)(p.ws + O_BAR), (volatile LAS unsigned*)(smem + LDS_BYTES - 16));
  run_phase(p, 0, smem); xcd_barrier(xb);
  run_phase(p, 1, smem); xcd_barrier(xb);
  run_phase(p, 2, smem); xcd_barrier(xb);
  run_phase(p, 3, smem); xcd_barrier(xb);
  run_phase(p, 4, smem); xcd_barrier(xb);
  run_phase(p, 5, smem); xcd_barrier(xb);
  run_phase(p, 6, smem); xcd_barrier(xb);
  run_phase(p, 7, smem); xcd_barrier(xb);
  run_phase(p, 8, smem); xcd_barrier(xb);
  run_phase(p, 9, smem); xcd_barrier(xb);
  run_phase(p, 10, smem); xcd_barrier(xb);
  run_phase(p, 11, smem); xcd_barrier(xb);
  run_phase(p, 12, smem); xcd_barrier(xb);
  run_phase(p, 13, smem); xcd_barrier(xb);
  run_phase(p, 14, smem); xcd_barrier(xb);
  run_phase(p, 15, smem); xcd_barrier(xb);
  run_phase(p, 16, smem); xcd_barrier(xb);
  run_phase(p, 17, smem);
}
#define MAIN_KERNEL mega_kernel
#else
__global__ void __launch_bounds__(256, 2) phase_kernel(P p, int ph) {
  extern __shared__ __attribute__((aligned(16))) char smem[];
  run_phase(p, ph, smem);
}
#define MAIN_KERNEL phase_kernel
#endif

extern "C" void kernel_launch(void* const* d_in, const int* in_sizes, int n_in, void* d_out, int out_size, void* d_ws,
                              size_t ws_size, hipStream_t stream) {
  static int grid_blocks = 0;
  if (!grid_blocks) {
    int dev = 0, cus = 0, per_cu = 0;
    (void)hipGetDevice(&dev);
    (void)hipDeviceGetAttribute(&cus, hipDeviceAttributeMultiprocessorCount, dev);
    (void)hipFuncSetAttribute((const void*)MAIN_KERNEL, hipFuncAttributeMaxDynamicSharedMemorySize, LDS_BYTES);
    (void)hipOccupancyMaxActiveBlocksPerMultiprocessor(&per_cu, MAIN_KERNEL, 256, LDS_BYTES);
    if (per_cu > 2) per_cu = 2;
    if (per_cu < 1) per_cu = 1;
    grid_blocks = cus * per_cu;
  }
  P p{};
  for (int i = 0; i < 30; ++i) p.in[i] = (const float*)d_in[i];
  p.out = (float*)d_out;
  p.ws = (char*)d_ws;
#if MULTI_LAUNCH
  for (int ph = 0; ph < NPHASE; ++ph) {
    phase_kernel<<<dim3(grid_blocks), dim3(256), LDS_BYTES, stream>>>(p, ph);
#ifdef DUP_MASK
    int bit = (ph == 0) ? 8 : (ph == NPHASE - 1 ? 9 : (ph - 1) & 7);
    if ((DUP_MASK >> bit) & 1) phase_kernel<<<dim3(grid_blocks), dim3(256), LDS_BYTES, stream>>>(p, ph);
#endif
  }
#else
  (void)hipMemsetAsync((char*)d_ws + O_BAR, 0, XCD_BAR_WORDS * 4, stream);
  void* args[] = {&p};
  hipError_t e = hipLaunchCooperativeKernel((void*)mega_kernel, dim3(grid_blocks), dim3(256), args, LDS_BYTES, stream);
  if (e != hipSuccess) fprintf(stderr, "cooperative launch failed: %s (grid %d)\n", hipGetErrorString(e), grid_blocks);
#endif
}
```

```cpp
#include <hip/hip_runtime.h>
#include <hip/hip_cooperative_groups.h>
#include <stdint.h>
#include <stdio.h>
namespace cg = cooperative_groups;

#ifndef MULTI_LAUNCH
#define MULTI_LAUNCH 0
#endif

#define DI __device__ __forceinline__
typedef unsigned short u16;
using bf16x8 = __attribute__((ext_vector_type(8))) short;
using f32x4 = __attribute__((ext_vector_type(4))) float;
typedef __bf16 bf2_t __attribute__((ext_vector_type(2)));
typedef float f2_t __attribute__((ext_vector_type(2)));

constexpr int D = 1024, NTOK = 6144, NCTX = 4096, NIN = 3328, DFF = 4096;
constexpr float ALPHA = 1.41421356237309515f;
constexpr float LOG2E = 1.44269504088896341f;
constexpr int LDS_BYTES = 75776;
constexpr int NPHASE = 18;

constexpr size_t O_WTIN = 0;
constexpr size_t O_WTOUT = O_WTIN + (size_t)2 * NIN * D * 2;
constexpr size_t O_WTFF1 = O_WTOUT + (size_t)2 * D * D * 2;
constexpr size_t O_WTFF2 = O_WTFF1 + (size_t)2 * DFF * D * 2;
constexpr size_t O_MODS = O_WTFF2 + (size_t)2 * D * DFF * 2;
constexpr size_t O_ROPE = O_MODS + (size_t)2 * 3 * 6144 * 4;
constexpr size_t O_QA = O_ROPE + (size_t)1024 * 32 * 2 * 4;
constexpr size_t O_KACTX = O_QA + (size_t)NTOK * 512 * 2;
constexpr size_t O_KALAT = O_KACTX + (size_t)NCTX * 512 * 2;
constexpr size_t O_VTACTX = O_KALAT + (size_t)2 * 2 * 1536 * 512 * 2;
constexpr size_t O_VTALAT = O_VTACTX + (size_t)16 * 4 * 128 * 256 * 2;
constexpr size_t O_QC = O_VTALAT + (size_t)2 * 2 * 4 * 128 * 1536 * 2;
constexpr size_t O_KCCTX = O_QC + (size_t)NTOK * 256 * 2;
constexpr size_t O_KCLAT = O_KCCTX + (size_t)NCTX * 128 * 2;
constexpr size_t O_VTCCTX = O_KCLAT + (size_t)2 * 2 * 1536 * 128 * 2;
constexpr size_t O_VTCLAT = O_VTCCTX + (size_t)16 * 2 * 64 * 256 * 2;
constexpr size_t O_KV = O_VTCLAT + (size_t)2 * 2 * 2 * 64 * 1536 * 2;
constexpr size_t O_DEC = O_KV + (size_t)768 * 4096 * 4;
constexpr size_t O_MIXED = O_DEC + (size_t)768 * 64 * 4;
constexpr size_t O_XPRE1 = O_MIXED + (size_t)NTOK * 1024 * 2;
constexpr size_t O_ST1 = O_XPRE1 + (size_t)NTOK * 1024 * 4;
constexpr size_t O_XPRE2 = O_ST1 + (size_t)NTOK * 32 * 4;
constexpr size_t O_ST2 = O_XPRE2 + (size_t)NTOK * 1024 * 4;
constexpr size_t O_ABF = O_ST2 + (size_t)NTOK * 32 * 4;
constexpr size_t O_HQ = O_ABF + (size_t)NTOK * 1024 * 2;
constexpr size_t O_HGF = O_HQ + (size_t)NTOK * 256 * 4;
constexpr size_t O_HGB = O_HGF + (size_t)NTOK * 256 * 4;
constexpr size_t O_HI = O_HGB + (size_t)NTOK * 256 * 4;
constexpr size_t O_HSG = O_HI + (size_t)NTOK * 256 * 4;
constexpr size_t O_OI = O_HSG + (size_t)NTOK * 256 * 4;
constexpr size_t O_QE = O_OI + (size_t)2 * NTOK * 256 * 4;
constexpr size_t O_END1 = O_QE + (size_t)2 * NTOK * 256 * 4;
constexpr size_t O_HID = O_HQ;
constexpr size_t O_END2 = O_HID + (size_t)NTOK * 4096 * 2;
static_assert(O_END2 <= O_END1, "HID alias must fit");
static_assert(O_END1 <= (size_t)256 * 1024 * 1024, "workspace too big");

constexpr size_t OUT_YP = 0, OUT_YS = 4194304, OUT_AK = 6291456, OUT_AV = 10485760, OUT_CK = 14680064,
                 OUT_CV = 15728640, OUT_SF = 16777216, OUT_SB = 17301504;

struct P {
  const float* in[30];
  float* out;
  char* ws;
};

DI unsigned pack2(float a, float b) {
  f2_t v = {a, b};
  bf2_t r = __builtin_convertvector(v, bf2_t);
  return __builtin_bit_cast(unsigned, r);
}
DI u16 f2bf(float x) { return (u16)(pack2(x, 0.f) & 0xffffu); }
DI float ex2(float x) { return __builtin_amdgcn_exp2f(x); }
DI float siluf(float x) { return x / (1.f + expf(-x)); }
DI float shx(float v, int m) { return __shfl_xor(v, m, 64); }
DI float red16(float x) {
  x += __builtin_bit_cast(float, __builtin_amdgcn_update_dpp(0, __builtin_bit_cast(int, x), 0xB1, 0xF, 0xF, true));
  x += __builtin_bit_cast(float, __builtin_amdgcn_update_dpp(0, __builtin_bit_cast(int, x), 0x4E, 0xF, 0xF, true));
  x += __builtin_bit_cast(float, __builtin_amdgcn_update_dpp(0, __builtin_bit_cast(int, x), 0x141, 0xF, 0xF, true));
  x += __builtin_bit_cast(float, __builtin_amdgcn_update_dpp(0, __builtin_bit_cast(int, x), 0x140, 0xF, 0xF, true));
  return x;
}
DI float xor1(float x) { return __builtin_bit_cast(float, __builtin_amdgcn_update_dpp(0, __builtin_bit_cast(int, x), 0xB1, 0xF, 0xF, true)); }
DI int ltid() { int t = threadIdx.x; asm volatile("" : "+v"(t)); return t; }
#define MFMA16(a, b, c) __builtin_amdgcn_mfma_f32_16x16x32_bf16((a), (b), (c), 0, 0, 0)

DI void p0_mod(const P& p, int item, char* smem) {
  float* ssilu = (float*)smem;
  float* red = ssilu + 3072;
  const int tid = ltid();
  __syncthreads();
  for (int i = tid; i < 3072; i += 256) {
    int w = i >> 10, k = i & 1023;
    float v = (w == 0) ? p.in[9][k] : p.in[8][(w - 1) * 1024 + k];
    ssilu[i] = siluf(v);
  }
  __syncthreads();
  const int li = item / 96, j0 = (item % 96) * 64;
  const int c4 = tid & 15, kp = tid >> 4;
  const float* W = p.in[10] + (size_t)li * 1024 * 6144 + j0 + c4 * 4;
  float4 a0 = {0, 0, 0, 0}, a1 = a0, a2 = a0;
#pragma unroll 4
  for (int kk = 0; kk < 64; ++kk) {
    int k = kp * 64 + kk;
    float4 w4 = *(const float4*)(W + (size_t)k * 6144);
    float s0 = ssilu[k], s1 = ssilu[1024 + k], s2 = ssilu[2048 + k];
    a0.x += s0 * w4.x; a0.y += s0 * w4.y; a0.z += s0 * w4.z; a0.w += s0 * w4.w;
    a1.x += s1 * w4.x; a1.y += s1 * w4.y; a1.z += s1 * w4.z; a1.w += s1 * w4.w;
    a2.x += s2 * w4.x; a2.y += s2 * w4.y; a2.z += s2 * w4.z; a2.w += s2 * w4.w;
  }
  *(float4*)(red + (kp * 3 + 0) * 64 + c4 * 4) = a0;
  *(float4*)(red + (kp * 3 + 1) * 64 + c4 * 4) = a1;
  *(float4*)(red + (kp * 3 + 2) * 64 + c4 * 4) = a2;
  __syncthreads();
  if (tid < 192) {
    int w = tid >> 6, c = tid & 63;
    float s = p.in[11][li * 6144 + j0 + c];
    for (int q = 0; q < 16; ++q) s += red[(q * 3 + w) * 64 + c];
    ((float*)(p.ws + O_MODS))[(li * 3 + w) * 6144 + j0 + c] = s;
  }
}

DI void p0_rope(const P& p, int item) {
  float* R = (float*)(p.ws + O_ROPE);
  for (int i = ltid(); i < 4096; i += 256) {
    int idx = item * 4096 + i;
    int t = idx >> 5, pp = idx & 31;
    float inv = powf(10000.f, -(float)(pp & 15) / 16.f);
    float pos = (pp < 16) ? (float)(t >> 6) : (float)(t & 63);
    float ang = pos * inv;
    R[idx * 2] = cosf(ang);
    R[idx * 2 + 1] = sinf(ang);
  }
}

DI void p0_copyk(const P& p, int item, bool isA) {
  const int W = isA ? 512 : 128;
  const float* src = isA ? p.in[2] : p.in[4];
  u16* dst = (u16*)(p.ws + (isA ? O_KALAT : O_KCLAT));
  for (int i = 0; i < 4; ++i) {
    size_t e = (size_t)item * 4096 + (size_t)(ltid() + 256 * i) * 4;
    float4 v = *(const float4*)(src + e);
    int c = (int)(e % W);
    size_t r = e / W;
    int pp = (int)(r % 512);
    int bl = (int)(r / 512);
    int b = bl >> 1, li = bl & 1;
    uint2 o;
    o.x = pack2(v.x, v.y);
    o.y = pack2(v.z, v.w);
    *(uint2*)(dst + ((size_t)((li * 2 + b) * 1536 + 1024 + pp)) * W + c) = o;
  }
}

DI void transpose_tile(const float* src, int sstride, u16* dst, int dstride, char* smem) {
  float* t = (float*)smem;
  const int tid = ltid();
  __syncthreads();
#pragma unroll
  for (int i = 0; i < 4; ++i) {
    int idx = tid + 256 * i;
    int r = idx >> 4, c4 = idx & 15;
    float4 v = *(const float4*)(src + (size_t)r * sstride + c4 * 4);
    float* q = t + r * 65 + c4 * 4;
    q[0] = v.x; q[1] = v.y; q[2] = v.z; q[3] = v.w;
  }
  __syncthreads();
  const int c = tid >> 2, rs = tid & 3;
  unsigned o[8];
#pragma unroll
  for (int e = 0; e < 8; ++e) {
    float a = t[(rs * 16 + 2 * e) * 65 + c], b = t[(rs * 16 + 2 * e + 1) * 65 + c];
    o[e] = pack2(a, b);
  }
  uint4* dp = (uint4*)(dst + (size_t)c * dstride + rs * 16);
  dp[0] = make_uint4(o[0], o[1], o[2], o[3]);
  dp[1] = make_uint4(o[4], o[5], o[6], o[7]);
}

DI void phase0(const P& p, char* smem) {
  constexpr int N_MOD = 192, N_ROPE = 8, N_AK = 256, N_CK = 64;
  constexpr int T_IN = 1664, T_OUT = 512, T_FF1 = 2048, T_FF2 = 2048, T_AV = 256, T_CV = 64;
  constexpr int B_ROPE = N_MOD, B_AK = B_ROPE + N_ROPE, B_CK = B_AK + N_AK, B_T = B_CK + N_CK;
  constexpr int TOTAL = B_T + T_IN + T_OUT + T_FF1 + T_FF2 + T_AV + T_CV;
  for (int it = blockIdx.x; it < TOTAL; it += gridDim.x) {
    if (it < B_ROPE) p0_mod(p, it, smem);
    else if (it < B_AK) p0_rope(p, it - B_ROPE);
    else if (it < B_CK) p0_copyk(p, it - B_AK, true);
    else if (it < B_T) p0_copyk(p, it - B_CK, false);
    else {
      int t = it - B_T;
      if (t < T_IN) {
        int li = t / 832, r = t % 832, kt = r / 52, nt = r % 52;
        transpose_tile(p.in[12] + (size_t)li * 1024 * NIN + (size_t)(kt * 64) * NIN + nt * 64, NIN,
                       (u16*)(p.ws + O_WTIN) + (size_t)li * NIN * 1024 + (size_t)(nt * 64) * 1024 + kt * 64, 1024, smem);
      } else if ((t -= T_IN) < T_OUT) {
        int li = t / 256, r = t % 256, kt = r / 16, nt = r % 16;
        transpose_tile(p.in[13] + (size_t)li * 1024 * 1024 + (size_t)(kt * 64) * 1024 + nt * 64, 1024,
                       (u16*)(p.ws + O_WTOUT) + (size_t)li * 1024 * 1024 + (size_t)(nt * 64) * 1024 + kt * 64, 1024, smem);
      } else if ((t -= T_OUT) < T_FF1) {
        int li = t / 1024, r = t % 1024, kt = r / 64, nt = r % 64;
        transpose_tile(p.in[28] + (size_t)li * 1024 * DFF + (size_t)(kt * 64) * DFF + nt * 64, DFF,
                       (u16*)(p.ws + O_WTFF1) + (size_t)li * DFF * 1024 + (size_t)(nt * 64) * 1024 + kt * 64, 1024, smem);
      } else if ((t -= T_FF1) < T_FF2) {
        int li = t / 1024, r = t % 1024, kt = r / 16, nt = r % 16;
        transpose_tile(p.in[29] + (size_t)li * DFF * 1024 + (size_t)(kt * 64) * 1024 + nt * 64, 1024,
                       (u16*)(p.ws + O_WTFF2) + (size_t)li * 1024 * DFF + (size_t)(nt * 64) * DFF + kt * 64, DFF, smem);
      } else if ((t -= T_FF2) < T_AV) {
        int bl = t / 64, r = t % 64, pt = r / 8, ct = r % 8;
        int b = bl >> 1, li = bl & 1;
        transpose_tile(p.in[3] + ((size_t)bl * 512 + pt * 64) * 512 + ct * 64, 512,
                       (u16*)(p.ws + O_VTALAT) + ((size_t)(li * 2 + b) * 512 + ct * 64) * 1536 + 1024 + pt * 64, 1536, smem);
      } else {
        t -= T_AV;
        int bl = t / 16, r = t % 16, pt = r / 2, ct = r % 2;
        int b = bl >> 1, li = bl & 1;
        transpose_tile(p.in[5] + ((size_t)bl * 512 + pt * 64) * 128 + ct * 64, 128,
                       (u16*)(p.ws + O_VTCLAT) + ((size_t)(li * 2 + b) * 128 + ct * 64) * 1536 + 1024 + pt * 64, 1536, smem);
      }
    }
  }
}

struct GA {
  const float* alo;
  const float* ahi;
  const float* stats;
  const float* lng;
  const float* lnb;
  const float* mods;
  int sc_off, sh_off;
  const u16* a16;
  const u16* bt;
  int K, N;
  float* xout;
  float* sout;
  u16* hid;
};

DI void epi_inproj(const P& p, int li, f32x4 (&acc)[4][4], int R0, int C0);

typedef unsigned u32x4 __attribute__((ext_vector_type(4)));
typedef unsigned u32x2 __attribute__((ext_vector_type(2)));

template <int EPI>
DI void gemm_tile(const P& p, const GA& g, int li, int m0, int n0, char* smem) {
  const int tid = ltid(), lane = tid & 63, wid = tid >> 6, wr = wid >> 1, wc = wid & 1;
  const int l16 = lane & 15, q4 = lane >> 4;
  u16* sA0 = (u16*)smem;
  u16* sB0 = sA0 + 128 * 72;
  u16* sA1 = sB0 + 128 * 72;
  u16* sB1 = sA1 + 128 * 72;
  float2* sStat = (float2*)(smem + 73728);
  const int K = g.K;
  const int rtype = (m0 < NCTX) ? 0 : 1 + ((m0 - NCTX) >> 10);
  const float* modv = g.mods + rtype * 6144;
  const float* fsrc = (m0 < NCTX) ? g.alo + (size_t)m0 * 1024 : g.ahi + (size_t)(m0 - NCTX) * 1024;

  __syncthreads();
  if constexpr (EPI == 1) {
    if (g.stats != nullptr && tid < 128) {
      const float4* sp = (const float4*)(g.stats + (size_t)(m0 + tid) * 32);
      float s1 = 0.f, s2 = 0.f;
#pragma unroll
      for (int i = 0; i < 8; ++i) {
        float4 v = sp[i];
        s1 += v.x + v.z;
        s2 += v.y + v.w;
      }
      float mu = s1 * (1.f / 1024.f);
      float var = s2 * (1.f / 1024.f) - mu * mu;
      sStat[tid] = make_float2(mu, rsqrtf(fmaxf(var, 0.f) + 1e-6f));
    }
  }

  f32x4 acc[4][4];
#pragma unroll
  for (int i = 0; i < 4; ++i)
#pragma unroll
    for (int j = 0; j < 4; ++j) acc[i][j] = f32x4{0.f, 0.f, 0.f, 0.f};

  u32x4 ra0[4], rb0[4], ra1[4], rb1[4];
  const unsigned goff = (unsigned)(tid >> 3) * (unsigned)K + (unsigned)(tid & 7) * 8u;
  const unsigned loff = (unsigned)(tid >> 3) * 72u + (unsigned)(tid & 7) * 8u;
  const u16* abase = g.a16 + (size_t)m0 * K;
  const u16* bbase = g.bt + (size_t)n0 * K;
#define GLOAD(RA, RB, KT)                                                        \
  _Pragma("unroll") for (int i = 0; i < 4; ++i) {                                \
    RA[i] = *(const u32x4*)(abase + (size_t)(32 * i) * K + (KT) * 64 + goff);    \
    RB[i] = *(const u32x4*)(bbase + (size_t)(32 * i) * K + (KT) * 64 + goff);    \
  }
#define LSTORE(SA, SB, RA, RB)                                                   \
  _Pragma("unroll") for (int i = 0; i < 4; ++i) {                                \
    *(u32x4*)(SA + 32 * i * 72 + loff) = RA[i];                                  \
    *(u32x4*)(SB + 32 * i * 72 + loff) = RB[i];                                  \
  }
#define COMPUTE(SA, SB)                                                          \
  _Pragma("unroll") for (int s = 0; s < 2; ++s) {                                \
    bf16x8 af[4], bfr[4];                                                        \
    _Pragma("unroll") for (int i = 0; i < 4; ++i) {                              \
      af[i] = *(const bf16x8*)(SA + (wr * 64 + i * 16 + l16) * 72 + s * 32 + q4 * 8);  \
      bfr[i] = *(const bf16x8*)(SB + (wc * 64 + i * 16 + l16) * 72 + s * 32 + q4 * 8); \
    }                                                                            \
    _Pragma("unroll") for (int i = 0; i < 4; ++i)                                \
      _Pragma("unroll") for (int j = 0; j < 4; ++j) acc[i][j] = MFMA16(af[i], bfr[j], acc[i][j]); \
    __builtin_amdgcn_sched_barrier(0);                                           \
  }

  const int nk = K >> 6;
#define SB0 __builtin_amdgcn_sched_barrier(0)
  GLOAD(ra0, rb0, 0);
  SB0;
  GLOAD(ra1, rb1, 1);
  SB0;
  LSTORE(sA0, sB0, ra0, rb0);
  SB0;
  GLOAD(ra0, rb0, 2);
  SB0;
  __syncthreads();
#pragma unroll 1
  for (int kt = 0; kt < nk - 4; kt += 2) {
    SB0;
    LSTORE(sA1, sB1, ra1, rb1);
    SB0;
    GLOAD(ra1, rb1, kt + 3);
    SB0;
    COMPUTE(sA0, sB0);
    __syncthreads();
    SB0;
    LSTORE(sA0, sB0, ra0, rb0);
    SB0;
    GLOAD(ra0, rb0, kt + 4);
    SB0;
    COMPUTE(sA1, sB1);
    __syncthreads();
  }
  SB0;
  LSTORE(sA1, sB1, ra1, rb1);
  SB0;
  GLOAD(ra1, rb1, nk - 1);
  SB0;
  COMPUTE(sA0, sB0);
  __syncthreads();
  SB0;
  LSTORE(sA0, sB0, ra0, rb0);
  SB0;
  COMPUTE(sA1, sB1);
  __syncthreads();
  SB0;
  LSTORE(sA1, sB1, ra1, rb1);
  SB0;
  COMPUTE(sA0, sB0);
  __syncthreads();
  SB0;
  COMPUTE(sA1, sB1);
#undef GLOAD
#undef LSTORE
#undef COMPUTE
#undef SB0
  asm volatile("" ::: "memory");

  const int R0 = m0 + wr * 64, C0 = n0 + wc * 64;
  if constexpr (EPI == 0) {
    epi_inproj(p, li, acc, R0, C0);
  } else if constexpr (EPI == 1) {
    float gate[4], lg[4], lb[4];
#pragma unroll
    for (int j = 0; j < 4; ++j) {
      int col = C0 + j * 16 + l16;
      gate[j] = modv[g.sc_off + col];
      lg[j] = g.stats ? g.lng[col] : 1.f;
      lb[j] = g.stats ? g.lnb[col] : 0.f;
    }
#pragma unroll
    for (int i = 0; i < 4; ++i) {
#pragma unroll
      for (int r = 0; r < 4; ++r) {
        int lrow = wr * 64 + i * 16 + q4 * 4 + r;
        float mu = 0.f, rs = 1.f;
        if (g.stats != nullptr) {
          float2 st = sStat[lrow];
          mu = st.x;
          rs = st.y;
        }
        float s1 = 0.f, s2 = 0.f;
#pragma unroll
        for (int j = 0; j < 4; ++j) {
          int col = C0 + j * 16 + l16;
          float x = fsrc[(size_t)lrow * 1024 + col];
          x = (x - mu) * rs * lg[j] + lb[j];
          float v = ALPHA * x + gate[j] * acc[i][j][r];
          g.xout[(size_t)(m0 + lrow) * 1024 + col] = v;
          s1 += v;
          s2 += v * v;
        }
        s1 = red16(s1);
        s2 = red16(s2);
        if (l16 == 0) *(float2*)(g.sout + (size_t)(m0 + lrow) * 32 + (C0 >> 6) * 2) = make_float2(s1, s2);
      }
    }
  } else {
    float* sC = (float*)smem;
    __syncthreads();
#pragma unroll
    for (int i = 0; i < 4; ++i)
#pragma unroll
      for (int j = 0; j < 4; ++j)
#pragma unroll
        for (int r = 0; r < 4; ++r) sC[(wr * 64 + i * 16 + q4 * 4 + r) * 132 + wc * 64 + j * 16 + l16] = acc[i][j][r];
    __syncthreads();
    if constexpr (EPI == 1) {
      const int hl = lane & 31, rsel = lane >> 5;
      const int col = n0 + hl * 4;
      const f32x4 gate4 = *(const f32x4*)(modv + g.sc_off + col);
      f32x4 lg4 = {1.f, 1.f, 1.f, 1.f}, lb4 = {0.f, 0.f, 0.f, 0.f};
      if (g.stats != nullptr) {
        lg4 = *(const f32x4*)(g.lng + col);
        lb4 = *(const f32x4*)(g.lnb + col);
      }
#pragma unroll 4
      for (int pp = 0; pp < 16; ++pp) {
        const int lrow = pp * 8 + wid * 2 + rsel;
        f32x4 a = *(const f32x4*)(sC + lrow * 132 + hl * 4);
        f32x4 x = *(const f32x4*)(fsrc + (size_t)lrow * 1024 + col);
        float mu = 0.f, rs = 1.f;
        if (g.stats != nullptr) {
          float2 st = sStat[lrow];
          mu = st.x;
          rs = st.y;
        }
        x = (x - mu) * rs * lg4 + lb4;
        f32x4 v = ALPHA * x + gate4 * a;
        *(f32x4*)(g.xout + (size_t)(m0 + lrow) * 1024 + col) = v;
        float s1 = (v.x + v.y) + (v.z + v.w);
        float s2 = (v.x * v.x + v.y * v.y) + (v.z * v.z + v.w * v.w);
        s1 = red16(s1);
        s2 = red16(s2);
        if ((lane & 15) == 0) *(float2*)(g.sout + (size_t)(m0 + lrow) * 32 + ((n0 >> 6) + (hl >> 4)) * 2) = make_float2(s1, s2);
      }
    } else {
#pragma unroll
      for (int pp = 0; pp < 8; ++pp) {
        const int idx = tid + 256 * pp;
        const int lrow = idx >> 4, c8 = idx & 15;
        f32x4 a0 = *(const f32x4*)(sC + lrow * 132 + c8 * 8);
        f32x4 a1 = *(const f32x4*)(sC + lrow * 132 + c8 * 8 + 4);
        a0.x = fmaxf(a0.x, 0.f); a0.y = fmaxf(a0.y, 0.f); a0.z = fmaxf(a0.z, 0.f); a0.w = fmaxf(a0.w, 0.f);
        a1.x = fmaxf(a1.x, 0.f); a1.y = fmaxf(a1.y, 0.f); a1.z = fmaxf(a1.z, 0.f); a1.w = fmaxf(a1.w, 0.f);
        u32x4 o;
        o.x = pack2(a0.x * a0.x, a0.y * a0.y);
        o.y = pack2(a0.z * a0.z, a0.w * a0.w);
        o.z = pack2(a1.x * a1.x, a1.y * a1.y);
        o.w = pack2(a1.z * a1.z, a1.w * a1.w);
        *(u32x4*)(g.hid + (size_t)(m0 + lrow) * DFF + n0 + c8 * 8) = o;
      }
    }
  }
}

DI void epi_inproj(const P& p, int li, f32x4 (&acc)[4][4], int R0, int C0) {
  const int lane = ltid() & 63, l16 = lane & 15, q4 = lane >> 4;
  const int seg = C0 >> 6;
  const bool lat = R0 >= NCTX;
  const float2* rope = (const float2*)(p.ws + O_ROPE);
  int b, tb;
  if (!lat) { b = R0 >> 8; tb = R0 & 255; } else { b = (R0 - NCTX) >> 10; tb = (R0 - NCTX) & 1023; }

  enum { T_QA, T_KA, T_VA, T_QB, T_FF, T_FB, T_IB, T_GB, T_QC, T_KC, T_VC };
  int type, cbase;
  if (seg < 8) { type = T_QA; cbase = seg * 64; }
  else if (seg < 16) { type = T_KA; cbase = (seg - 8) * 64; }
  else if (seg < 24) { type = T_VA; cbase = (seg - 16) * 64; }
  else if (seg < 28) { type = T_QB; cbase = (seg - 24) * 64; }
  else if (seg < 32) { type = T_FF; cbase = (seg - 28) * 64; }
  else if (seg < 36) { type = T_FB; cbase = (seg - 32) * 64; }
  else if (seg < 40) { type = T_IB; cbase = (seg - 36) * 64; }
  else if (seg < 44) { type = T_GB; cbase = (seg - 40) * 64; }
  else if (seg < 48) { type = T_QC; cbase = (seg - 44) * 64; }
  else if (seg < 50) { type = T_KC; cbase = (seg - 48) * 64; }
  else { type = T_VC; cbase = (seg - 50) * 64; }

  if (type == T_QC || type == T_KC) {
    const float* gv = (type == T_QC ? p.in[22] : p.in[23]) + li * 64;
    float gj[4];
#pragma unroll
    for (int j = 0; j < 4; ++j) gj[j] = gv[j * 16 + l16];
#pragma unroll
    for (int i = 0; i < 4; ++i)
#pragma unroll
      for (int r = 0; r < 4; ++r) {
        float ss = 0.f;
#pragma unroll
        for (int j = 0; j < 4; ++j) ss += acc[i][j][r] * acc[i][j][r];
        ss += shx(ss, 1); ss += shx(ss, 2); ss += shx(ss, 4); ss += shx(ss, 8);
        float rs = rsqrtf(ss * (1.f / 64.f) + 1e-6f);
#pragma unroll
        for (int j = 0; j < 4; ++j) acc[i][j][r] = acc[i][j][r] * rs * gj[j];
      }
  }
  if (!lat && (type == T_KA || type == T_VA || type == T_KC || type == T_VC)) {
    float* o;
    int W;
    if (type == T_KA) { o = p.out + OUT_AK; W = 512; }
    else if (type == T_VA) { o = p.out + OUT_AV; W = 512; }
    else if (type == T_KC) { o = p.out + OUT_CK; W = 128; }
    else { o = p.out + OUT_CV; W = 128; }
#pragma unroll
    for (int i = 0; i < 4; ++i)
#pragma unroll
      for (int r = 0; r < 4; ++r) {
        int t = tb + i * 16 + q4 * 4 + r;
        size_t base = ((size_t)(b * 2 + li) * 256 + t) * W + cbase;
#pragma unroll
        for (int j = 0; j < 4; ++j) o[base + j * 16 + l16] = acc[i][j][r];
      }
  }
  if (lat && (type == T_QA || type == T_KA || type == T_QC || type == T_KC)) {
#pragma unroll
    for (int i = 0; i < 4; ++i)
#pragma unroll
      for (int r = 0; r < 4; ++r) {
        int t = tb + i * 16 + q4 * 4 + r;
#pragma unroll
        for (int j = 0; j < 4; ++j) {
          float v = acc[i][j][r];
          float pv = shx(v, 1);
          float2 cs = rope[t * 32 + j * 8 + (l16 >> 1)];
          acc[i][j][r] = (l16 & 1) ? (pv * cs.y + v * cs.x) : (v * cs.x - pv * cs.y);
        }
      }
  }

  if (type == T_QA || type == T_KA || type == T_QC || type == T_KC) {
    u16* dst;
    int W;
    size_t rowbase;
    if (type == T_QA) { dst = (u16*)(p.ws + O_QA); W = 512; rowbase = (size_t)R0 * 512; }
    else if (type == T_QC) { dst = (u16*)(p.ws + O_QC); W = 256; rowbase = (size_t)R0 * 256; }
    else if (type == T_KA) {
      W = 512;
      if (!lat) { dst = (u16*)(p.ws + O_KACTX); rowbase = (size_t)R0 * 512; }
      else { dst = (u16*)(p.ws + O_KALAT); rowbase = ((size_t)(li * 2 + b) * 1536 + tb) * 512; }
    } else {
      W = 128;
      if (!lat) { dst = (u16*)(p.ws + O_KCCTX); rowbase = (size_t)R0 * 128; }
      else { dst = (u16*)(p.ws + O_KCLAT); rowbase = ((size_t)(li * 2 + b) * 1536 + tb) * 128; }
    }
#pragma unroll
    for (int i = 0; i < 4; ++i)
#pragma unroll
      for (int r = 0; r < 4; ++r) {
        size_t base = rowbase + (size_t)(i * 16 + q4 * 4 + r) * W + cbase;
#pragma unroll
        for (int j = 0; j < 4; ++j) dst[base + j * 16 + l16] = f2bf(acc[i][j][r]);
      }
  } else if (type == T_VA || type == T_VC) {
    u16* dst;
    int L;
    size_t hb;
    if (type == T_VA) {
      int h = cbase >> 7, dv0 = cbase & 127;
      if (!lat) { dst = (u16*)(p.ws + O_VTACTX); L = 256; hb = ((size_t)(b * 4 + h) * 128 + dv0) * 256; }
      else { dst = (u16*)(p.ws + O_VTALAT); L = 1536; hb = ((size_t)((li * 2 + b) * 4 + h) * 128 + dv0) * 1536; }
    } else {
      int n = cbase >> 6;
      if (!lat) { dst = (u16*)(p.ws + O_VTCCTX); L = 256; hb = ((size_t)(b * 2 + n) * 64) * 256; }
      else { dst = (u16*)(p.ws + O_VTCLAT); L = 1536; hb = ((size_t)((li * 2 + b) * 2 + n) * 64) * 1536; }
    }
#pragma unroll
    for (int i = 0; i < 4; ++i)
#pragma unroll
      for (int j = 0; j < 4; ++j) {
        uint2 o;
        o.x = pack2(acc[i][j][0], acc[i][j][1]);
        o.y = pack2(acc[i][j][2], acc[i][j][3]);
        *(uint2*)(dst + hb + (size_t)(j * 16 + l16) * L + tb + i * 16 + q4 * 4) = o;
      }
  } else {
    float* dst;
    if (type == T_QB) dst = (float*)(p.ws + O_HQ);
    else if (type == T_FF) dst = (float*)(p.ws + O_HGF);
    else if (type == T_FB) dst = (float*)(p.ws + O_HGB);
    else if (type == T_IB) dst = (float*)(p.ws + O_HI);
    else dst = (float*)(p.ws + O_HSG);
    float lbv[4] = {0.f, 0.f, 0.f, 0.f};
    if ((type == T_FF || type == T_FB) && li == 1) {
      const float* lg = (type == T_FF) ? p.in[19] : p.in[20];
#pragma unroll
      for (int j = 0; j < 4; ++j) {
        int c = cbase + j * 16 + l16;
        lbv[j] = 1.f / (1.f + expf(lg[c] - lg[256 + c]));
      }
    }
#pragma unroll
    for (int i = 0; i < 4; ++i)
#pragma unroll
      for (int r = 0; r < 4; ++r) {
        size_t base = (size_t)(R0 + i * 16 + q4 * 4 + r) * 256 + cbase;
#pragma unroll
        for (int j = 0; j < 4; ++j) {
          float v = acc[i][j][r];
          float o;
          if (type == T_QB || type == T_GB) o = siluf(v);
          else if (type == T_IB) o = v;
          else {
            float sg = 1.f / (1.f + expf(-v));
            float f = lbv[j] + (1.f - lbv[j]) * sg;
            o = logf(fmaxf(f, 1e-6f));
          }
          dst[base + j * 16 + l16] = o;
        }
      }
  }
}

template <int EPI>
DI void gemm_phase(const P& p, const GA& g, int li, char* smem) {
  const int NT = g.N >> 7;
  const int xcd = blockIdx.x & 7, lb = blockIdx.x >> 3, nlb = gridDim.x >> 3;
  if (lb >= nlb) return;
  for (int t = lb; t < 6 * NT; t += nlb) {
    int mt = xcd * 6 + t / NT, nt = t % NT;
    gemm_tile<EPI>(p, g, li, mt * 128, nt * 128, smem);
  }
}


template <int KW, int DV>
DI void attn_gload(const u16* Kb, int kstride, const u16* VT, int L, int kb, int tid, u32x4 (&kr)[KW / 32], u32x4 (&vr)[DV / 32]) {
  constexpr int KPR = 256 / (KW / 8);
  const unsigned koff = (unsigned)(tid / (KW / 8)) * (unsigned)kstride + (unsigned)(tid % (KW / 8)) * 8u;
  const unsigned voff = (unsigned)(tid >> 3) * (unsigned)L + (unsigned)(tid & 7) * 8u;
#pragma unroll
  for (int i = 0; i < KW / 32; ++i) {
    const u16* kbp = Kb + (size_t)(kb * 64 + KPR * i) * kstride;
    kr[i] = *(const u32x4*)(kbp + koff);
  }
#pragma unroll
  for (int i = 0; i < DV / 32; ++i) {
    const u16* vbp = VT + (size_t)(32 * i) * L + kb * 64;
    vr[i] = *(const u32x4*)(vbp + voff);
  }
}
template <int KW, int DV>
DI void attn_lstore(u16* sK, u16* sV, int tid, const u32x4 (&kr)[KW / 32], const u32x4 (&vr)[DV / 32]) {
  constexpr int KS = KW + 8;
#pragma unroll
  for (int i = 0; i < KW / 32; ++i) {
    int idx = tid + 256 * i;
    int key = idx / (KW / 8), cc = idx % (KW / 8);
    *(u32x4*)(sK + key * KS + cc * 8) = kr[i];
  }
#pragma unroll
  for (int i = 0; i < DV / 32; ++i) {
    int idx = tid + 256 * i;
    int row = idx >> 3, cc = idx & 7;
    *(u32x4*)(sV + row * 72 + cc * 8) = vr[i];
  }
}

template <int KW, int DV>
DI void attn_compute(const u16* sK, const u16* sV, int kfo, int l16, int q4, const bf16x8& qf0, const bf16x8& qf1,
                     f32x4 (&o)[DV / 16], float& m, float& l) {
  constexpr int KS = KW + 8, NDT = DV / 16;
  const float c = 0.125f * LOG2E;
  f32x4 st[4];
#pragma unroll
  for (int kt = 0; kt < 4; ++kt) {
    const u16* kp = sK + (kt * 16 + l16) * KS + kfo + q4 * 8;
    bf16x8 k0 = *(const bf16x8*)kp;
    bf16x8 k1 = *(const bf16x8*)(kp + 32);
    f32x4 z = {0.f, 0.f, 0.f, 0.f};
    z = MFMA16(k0, qf0, z);
    st[kt] = MFMA16(k1, qf1, z);
  }
  float bm = st[0][0];
#pragma unroll
  for (int kt = 0; kt < 4; ++kt)
#pragma unroll
    for (int r = 0; r < 4; ++r) bm = fmaxf(bm, st[kt][r]);
  bm = fmaxf(bm, shx(bm, 16));
  bm = fmaxf(bm, shx(bm, 32));
  const float mn = fmaxf(m, bm);
  const float alpha = ex2((m - mn) * c);
  m = mn;
  float ps = 0.f;
#pragma unroll
  for (int kt = 0; kt < 4; ++kt)
#pragma unroll
    for (int r = 0; r < 4; ++r) {
      float pv = ex2((st[kt][r] - mn) * c);
      st[kt][r] = pv;
      ps += pv;
    }
  l = l * alpha + ps;
#pragma unroll
  for (int d = 0; d < NDT; ++d) {
    o[d][0] *= alpha; o[d][1] *= alpha; o[d][2] *= alpha; o[d][3] *= alpha;
  }
#pragma unroll
  for (int ks = 0; ks < 2; ++ks) {
    u32x4 pu;
    pu.x = pack2(st[2 * ks][0], st[2 * ks][1]);
    pu.y = pack2(st[2 * ks][2], st[2 * ks][3]);
    pu.z = pack2(st[2 * ks + 1][0], st[2 * ks + 1][1]);
    pu.w = pack2(st[2 * ks + 1][2], st[2 * ks + 1][3]);
    bf16x8 pf = __builtin_bit_cast(bf16x8, pu);
#pragma unroll
    for (int d = 0; d < NDT; ++d) {
      const u16* vp = sV + (d * 16 + l16) * 72 + ks * 32 + q4 * 4;
      u32x2 v0 = *(const u32x2*)vp;
      u32x2 v1 = *(const u32x2*)(vp + 16);
      u32x4 vu = {v0.x, v0.y, v1.x, v1.y};
      bf16x8 vf = __builtin_bit_cast(bf16x8, vu);
      o[d] = MFMA16(vf, pf, o[d]);
    }
  }
}

template <int KW, int DV, bool DIFF>
DI void attn_item(const u16* Q, int qstride, int qcol, int qrow0, const u16* Kb, int kstride, const u16* VT, int L,
                          int nkeys, u16* mixed, int mixcol, float lam, float postscale, const float* subg, char* smem) {
  const int tid = ltid(), lane = tid & 63, wid = tid >> 6, l16 = lane & 15, q4 = lane >> 4;
  const int qsub = wid & 1, var = wid >> 1;
  constexpr int KS = KW + 8;
  constexpr int STAGE = 64 * KS + DV * 72;
  u16* sK0 = (u16*)smem;
  u16* sV0 = sK0 + 64 * KS;
  u16* sK1 = sK0 + STAGE;
  u16* sV1 = sV0 + STAGE;
  constexpr int KPT = KW / 32, VPT = DV / 32, NDT = DV / 16;
  const int kfo = DIFF ? var * 64 : 0;

  const u16* qp = Q + (size_t)(qrow0 + qsub * 16 + l16) * qstride + qcol + var * 64 + q4 * 8;
  const bf16x8 qf0 = *(const bf16x8*)qp;
  const bf16x8 qf1 = *(const bf16x8*)(qp + 32);

  u32x4 kr0[KPT], vr0[VPT], kr1[KPT], vr1[VPT];
  f32x4 o[NDT];
#pragma unroll
  for (int d = 0; d < NDT; ++d) o[d] = f32x4{0.f, 0.f, 0.f, 0.f};
  float m = -INFINITY, l = 0.f;
  const int nkb = nkeys >> 6;
#define SB0 __builtin_amdgcn_sched_barrier(0)
  attn_gload<KW, DV>(Kb, kstride, VT, L, 0, tid, kr0, vr0);
  SB0;
  attn_gload<KW, DV>(Kb, kstride, VT, L, 1, tid, kr1, vr1);
  SB0;
  __syncthreads();
  attn_lstore<KW, DV>(sK0, sV0, tid, kr0, vr0);
  SB0;
  attn_gload<KW, DV>(Kb, kstride, VT, L, 2, tid, kr0, vr0);
  SB0;
  __syncthreads();
#pragma unroll 1
  for (int kb = 0; kb < nkb - 4; kb += 2) {
    SB0;
    attn_lstore<KW, DV>(sK1, sV1, tid, kr1, vr1);
    SB0;
    attn_gload<KW, DV>(Kb, kstride, VT, L, kb + 3, tid, kr1, vr1);
    SB0;
    attn_compute<KW, DV>(sK0, sV0, kfo, l16, q4, qf0, qf1, o, m, l);
    __syncthreads();
    SB0;
    attn_lstore<KW, DV>(sK0, sV0, tid, kr0, vr0);
    SB0;
    attn_gload<KW, DV>(Kb, kstride, VT, L, kb + 4, tid, kr0, vr0);
    SB0;
    attn_compute<KW, DV>(sK1, sV1, kfo, l16, q4, qf0, qf1, o, m, l);
    __syncthreads();
  }
  SB0;
  attn_lstore<KW, DV>(sK1, sV1, tid, kr1, vr1);
  SB0;
  attn_gload<KW, DV>(Kb, kstride, VT, L, nkb - 1, tid, kr1, vr1);
  SB0;
  attn_compute<KW, DV>(sK0, sV0, kfo, l16, q4, qf0, qf1, o, m, l);
  __syncthreads();
  SB0;
  attn_lstore<KW, DV>(sK0, sV0, tid, kr0, vr0);
  SB0;
  attn_compute<KW, DV>(sK1, sV1, kfo, l16, q4, qf0, qf1, o, m, l);
  __syncthreads();
  SB0;
  attn_lstore<KW, DV>(sK1, sV1, tid, kr1, vr1);
  SB0;
  attn_compute<KW, DV>(sK0, sV0, kfo, l16, q4, qf0, qf1, o, m, l);
  __syncthreads();
  SB0;
  attn_compute<KW, DV>(sK1, sV1, kfo, l16, q4, qf0, qf1, o, m, l);
  __syncthreads();
#undef SB0
  l += shx(l, 16);
  l += shx(l, 32);
  const float inv = 1.f / l;
  const int row = qrow0 + qsub * 16 + l16;
  if constexpr (DIFF) {
    __syncthreads();
    float* sO = (float*)smem;
    if (var == 1) {
#pragma unroll
      for (int d = 0; d < NDT; ++d)
        *(float4*)(sO + (qsub * 16 + l16) * 132 + d * 16 + q4 * 4) =
            make_float4(o[d][0] * inv, o[d][1] * inv, o[d][2] * inv, o[d][3] * inv);
    }
    __syncthreads();
    if (var == 0) {
      float ss = 0.f;
#pragma unroll
      for (int d = 0; d < NDT; ++d) {
        float4 o1 = *(const float4*)(sO + (qsub * 16 + l16) * 132 + d * 16 + q4 * 4);
        o[d][0] = o[d][0] * inv - lam * o1.x;
        o[d][1] = o[d][1] * inv - lam * o1.y;
        o[d][2] = o[d][2] * inv - lam * o1.z;
        o[d][3] = o[d][3] * inv - lam * o1.w;
        ss += o[d][0] * o[d][0] + o[d][1] * o[d][1] + o[d][2] * o[d][2] + o[d][3] * o[d][3];
      }
      ss += shx(ss, 16);
      ss += shx(ss, 32);
      const float rs = rsqrtf(ss * (1.f / 128.f) + 1e-6f) * postscale;
#pragma unroll
      for (int d = 0; d < NDT; ++d) {
        float4 gg = *(const float4*)(subg + d * 16 + q4 * 4);
        uint2 ov;
        ov.x = pack2(o[d][0] * rs * gg.x, o[d][1] * rs * gg.y);
        ov.y = pack2(o[d][2] * rs * gg.z, o[d][3] * rs * gg.w);
        *(uint2*)(mixed + (size_t)row * 1024 + mixcol + d * 16 + q4 * 4) = ov;
      }
    }
  } else {
#pragma unroll
    for (int d = 0; d < NDT; ++d) {
      uint2 ov;
      ov.x = pack2(o[d][0] * inv, o[d][1] * inv);
      ov.y = pack2(o[d][2] * inv, o[d][3] * inv);
      *(uint2*)(mixed + (size_t)row * 1024 + mixcol + var * 64 + d * 16 + q4 * 4) = ov;
    }
  }
}

DI void attnA_item(const P& p, int li, int it, char* smem) {
  const int lane = ltid() & 63;
  float d1 = p.in[14][li * 64 + lane] * p.in[15][li * 64 + lane];
  float d2 = p.in[16][li * 64 + lane] * p.in[17][li * 64 + lane];
#pragma unroll
  for (int s = 1; s < 64; s <<= 1) { d1 += shx(d1, s); d2 += shx(d2, s); }
  const float lam_init = 0.8f - 0.6f * expf(-0.3f * (float)li);
  const float lam = expf(d1) - expf(d2) + lam_init;
  const u16* QA = (const u16*)(p.ws + O_QA);
  u16* mixed = (u16*)(p.ws + O_MIXED);
  const float* subg = p.in[18] + li * 128;
  int qrow0, L;
  const u16 *Kb, *VT;
  int h;
  if (it < 256) {
    int b = it >> 7, qb = it & 31;
    h = (it >> 5) & 3;
    Kb = (const u16*)(p.ws + O_KALAT) + (size_t)(li * 2 + b) * 1536 * 512 + h * 128;
    VT = (const u16*)(p.ws + O_VTALAT) + (size_t)((li * 2 + b) * 4 + h) * 128 * 1536;
    qrow0 = NCTX + b * 1024 + qb * 32;
    L = 1536;
  } else {
    it -= 256;
    int b = it >> 5, qb = it & 7;
    h = (it >> 3) & 3;
    Kb = (const u16*)(p.ws + O_KACTX) + (size_t)b * 256 * 512 + h * 128;
    VT = (const u16*)(p.ws + O_VTACTX) + (size_t)(b * 4 + h) * 128 * 256;
    qrow0 = b * 256 + qb * 32;
    L = 256;
  }
  attn_item<128, 128, true>(QA, 512, h * 128, qrow0, Kb, 512, VT, L, L, mixed, h * 128, lam, 1.f - lam_init, subg, smem);
}
DI void attnC_item(const P& p, int li, int it, char* smem) {
  const u16* QC = (const u16*)(p.ws + O_QC);
  u16* mixed = (u16*)(p.ws + O_MIXED);
  int qrow0, L, n;
  const u16 *Kb, *VT;
  if (it < 128) {
    int b = it >> 6, qb = it & 31;
    n = (it >> 5) & 1;
    Kb = (const u16*)(p.ws + O_KCLAT) + (size_t)(li * 2 + b) * 1536 * 128 + n * 64;
    VT = (const u16*)(p.ws + O_VTCLAT) + (size_t)((li * 2 + b) * 2 + n) * 64 * 1536;
    qrow0 = NCTX + b * 1024 + qb * 32;
    L = 1536;
  } else {
    it -= 128;
    int b = it >> 4, qb = it & 7;
    n = (it >> 3) & 1;
    Kb = (const u16*)(p.ws + O_KCCTX) + (size_t)b * 256 * 128 + n * 64;
    VT = (const u16*)(p.ws + O_VTCCTX) + (size_t)(b * 2 + n) * 64 * 256;
    qrow0 = b * 256 + qb * 32;
    L = 256;
  }
  attn_item<64, 64, false>(QC, 256, n * 128, qrow0, Kb, 128, VT, L, L, mixed, 768 + n * 128, 0.f, 1.f, nullptr, smem);
}

DI void h1_item(const P& p, int item, char* smem) {
  const int tid = ltid(), lane = tid & 63, w = tid >> 6, l16 = lane & 15, q4 = lane >> 4;
  const int dir = item & 1, h = (item >> 1) & 3, tc = item >> 3;
  const int row0 = tc * 64;
  float* sQ = (float*)smem;
  float* sB = sQ + 64 * 68;
  float* sK = sB + 64 * 68;
  u16* sVT = (u16*)(sK + 64 * 68);
  float* sTot = (float*)(sVT + 64 * 72);
  const float* HQ = (const float*)(p.ws + O_HQ);
  const float* HG = (const float*)(p.ws + (dir ? O_HGB : O_HGF));
  const float* HI = (const float*)(p.ws + O_HI);
  float* OI = (float*)(p.ws + O_OI) + (size_t)dir * NTOK * 256;
  u16* QE = (u16*)(p.ws + O_QE) + (size_t)dir * NTOK * 256;
  float* KV = (float*)(p.ws + O_KV) + (size_t)item * 4096;
  float* DEC = (float*)(p.ws + O_DEC) + (size_t)item * 64;

  __syncthreads();
#pragma unroll
  for (int i = 0; i < 4; ++i) {
    int idx = tid + 256 * i;
    int lo = idx >> 4, c4 = idx & 15;
    int row = dir ? row0 + 63 - lo : row0 + lo;
    size_t off = (size_t)row * 256 + h * 64 + c4 * 4;
    *(float4*)(sQ + lo * 68 + c4 * 4) = *(const float4*)(HQ + off);
    *(float4*)(sB + lo * 68 + c4 * 4) = *(const float4*)(HG + off);
    float4 v = *(const float4*)(HI + off);
    sVT[(c4 * 4 + 0) * 72 + lo] = f2bf(v.x);
    sVT[(c4 * 4 + 1) * 72 + lo] = f2bf(v.y);
    sVT[(c4 * 4 + 2) * 72 + lo] = f2bf(v.z);
    sVT[(c4 * 4 + 3) * 72 + lo] = f2bf(v.w);
  }
  __syncthreads();
  {
    const int k = tid & 63, part = tid >> 6;
    float run = 0.f;
#pragma unroll 4
    for (int e = 0; e < 16; ++e) {
      int i = part * 16 + e;
      float g = sB[i * 68 + k];
      sK[i * 68 + k] = -expm1f(g);
      run += g * LOG2E;
      sB[i * 68 + k] = run;
    }
    sTot[part * 64 + k] = run;
    __syncthreads();
    float add = 0.f;
    for (int pp = 0; pp < part; ++pp) add += sTot[pp * 64 + k];
    if (part > 0)
      for (int e = 0; e < 16; ++e) sB[(part * 16 + e) * 68 + k] += add;
  }
  __syncthreads();
#pragma unroll
  for (int i = 0; i < 4; ++i) {
    int idx = tid + 256 * i;
    int lo = idx >> 4, c4 = idx & 15;
    int row = dir ? row0 + 63 - lo : row0 + lo;
    f32x4 q = *(const f32x4*)(sQ + lo * 68 + c4 * 4);
    f32x4 bb = *(const f32x4*)(sB + lo * 68 + c4 * 4);
    u32x2 o;
    o.x = pack2(q.x * ex2(bb.x), q.y * ex2(bb.y));
    o.y = pack2(q.z * ex2(bb.z), q.w * ex2(bb.w));
    *(u32x2*)(QE + (size_t)row * 256 + h * 64 + c4 * 4) = o;
  }
  {
    const int I = w;
    bf16x8 qs[2];
    f32x4 rr[2][2];
#pragma unroll
    for (int s = 0; s < 2; ++s) {
      const int kk0 = s * 32 + q4 * 8;
      if (I > 0) {
        rr[s][0] = *(const f32x4*)(sB + (16 * I - 1) * 68 + kk0);
        rr[s][1] = *(const f32x4*)(sB + (16 * I - 1) * 68 + kk0 + 4);
      } else {
        rr[s][0] = f32x4{0.f, 0.f, 0.f, 0.f};
        rr[s][1] = rr[s][0];
      }
      const float* qr = sQ + (16 * I + l16) * 68 + kk0;
      const float* br = sB + (16 * I + l16) * 68 + kk0;
      f32x4 q0 = *(const f32x4*)qr, q1 = *(const f32x4*)(qr + 4);
      f32x4 b0 = *(const f32x4*)br, b1 = *(const f32x4*)(br + 4);
      u32x4 pu;
      pu.x = pack2(q0.x * ex2(b0.x - rr[s][0].x), q0.y * ex2(b0.y - rr[s][0].y));
      pu.y = pack2(q0.z * ex2(b0.z - rr[s][0].z), q0.w * ex2(b0.w - rr[s][0].w));
      pu.z = pack2(q1.x * ex2(b1.x - rr[s][1].x), q1.y * ex2(b1.y - rr[s][1].y));
      pu.w = pack2(q1.z * ex2(b1.z - rr[s][1].z), q1.w * ex2(b1.w - rr[s][1].w));
      qs[s] = __builtin_bit_cast(bf16x8, pu);
    }
    f32x4 at[4];
#pragma unroll
    for (int J = 0; J < 4; ++J) {
      at[J] = f32x4{0.f, 0.f, 0.f, 0.f};
      if (J <= I) {
#pragma unroll
        for (int s = 0; s < 2; ++s) {
          const int kk0 = s * 32 + q4 * 8;
          const float* kr = sK + (16 * J + l16) * 68 + kk0;
          const float* br = sB + (16 * J + l16) * 68 + kk0;
          f32x4 k0 = *(const f32x4*)kr, k1 = *(const f32x4*)(kr + 4);
          f32x4 b0 = *(const f32x4*)br, b1 = *(const f32x4*)(br + 4);
          u32x4 pu;
          pu.x = pack2(k0.x * ex2(fminf(rr[s][0].x - b0.x, 100.f)), k0.y * ex2(fminf(rr[s][0].y - b0.y, 100.f)));
          pu.y = pack2(k0.z * ex2(fminf(rr[s][0].z - b0.z, 100.f)), k0.w * ex2(fminf(rr[s][0].w - b0.w, 100.f)));
          pu.z = pack2(k1.x * ex2(fminf(rr[s][1].x - b1.x, 100.f)), k1.y * ex2(fminf(rr[s][1].y - b1.y, 100.f)));
          pu.w = pack2(k1.z * ex2(fminf(rr[s][1].z - b1.z, 100.f)), k1.w * ex2(fminf(rr[s][1].w - b1.w, 100.f)));
          bf16x8 kf = __builtin_bit_cast(bf16x8, pu);
          at[J] = MFMA16(kf, qs[s], at[J]);
        }
        if (J == I) {
#pragma unroll
          for (int r = 0; r < 4; ++r)
            if (q4 * 4 + r > l16) at[J][r] = 0.f;
        }
      }
    }
    f32x4 oc[4];
#pragma unroll
    for (int vt = 0; vt < 4; ++vt) oc[vt] = f32x4{0.f, 0.f, 0.f, 0.f};
#pragma unroll
    for (int ks = 0; ks < 2; ++ks) {
      if (2 * ks <= I) {
        u32x4 pu;
        pu.x = pack2(at[2 * ks][0], at[2 * ks][1]);
        pu.y = pack2(at[2 * ks][2], at[2 * ks][3]);
        pu.z = pack2(at[2 * ks + 1][0], at[2 * ks + 1][1]);
        pu.w = pack2(at[2 * ks + 1][2], at[2 * ks + 1][3]);
        bf16x8 pf = __builtin_bit_cast(bf16x8, pu);
#pragma unroll
        for (int vt = 0; vt < 4; ++vt) {
          const u16* vp = sVT + (vt * 16 + l16) * 72 + ks * 32 + q4 * 4;
          u32x2 v0 = *(const u32x2*)vp;
          u32x2 v1 = *(const u32x2*)(vp + 16);
          u32x4 vu = {v0.x, v0.y, v1.x, v1.y};
          oc[vt] = MFMA16(__builtin_bit_cast(bf16x8, vu), pf, oc[vt]);
        }
      }
    }
    {
      const int t = 16 * I + l16;
      const int row = dir ? row0 + 63 - t : row0 + t;
#pragma unroll
      for (int vt = 0; vt < 4; ++vt) *(f32x4*)(OI + (size_t)row * 256 + h * 64 + vt * 16 + q4 * 4) = oc[vt];
    }
  }
  {
    const int k = 16 * w + l16;
    const float bend = sB[63 * 68 + k];
    f32x4 kc[4];
#pragma unroll
    for (int vt = 0; vt < 4; ++vt) kc[vt] = f32x4{0.f, 0.f, 0.f, 0.f};
#pragma unroll
    for (int ks = 0; ks < 2; ++ks) {
      float kd[8];
#pragma unroll
      for (int j = 0; j < 8; ++j) {
        const int s = ks * 32 + q4 * 8 + j;
        kd[j] = sK[s * 68 + k] * ex2(bend - sB[s * 68 + k]);
      }
      u32x4 pu;
      pu.x = pack2(kd[0], kd[1]);
      pu.y = pack2(kd[2], kd[3]);
      pu.z = pack2(kd[4], kd[5]);
      pu.w = pack2(kd[6], kd[7]);
      bf16x8 af = __builtin_bit_cast(bf16x8, pu);
#pragma unroll
      for (int vt = 0; vt < 4; ++vt) {
        bf16x8 vf = *(const bf16x8*)(sVT + (vt * 16 + l16) * 72 + ks * 32 + q4 * 8);
        kc[vt] = MFMA16(af, vf, kc[vt]);
      }
    }
#pragma unroll
    for (int vt = 0; vt < 4; ++vt)
#pragma unroll
      for (int r = 0; r < 4; ++r) KV[(16 * w + q4 * 4 + r) * 64 + vt * 16 + l16] = kc[vt][r];
    if (q4 == 0) DEC[k] = ex2(bend);
  }
}

DI void h2_item(const P& p, int li, int item, char* smem) {
  const int tid = ltid(), ty = tid >> 4, tx = tid & 15;
  const int lane = tid & 63, w = tid >> 6, l16 = lane & 15, q4 = lane >> 4;
  const int h = item & 3, tc = item >> 2, row0 = tc * 64;
  const bool lat = tc >= 64;
  int seq, cl, nc;
  if (!lat) { seq = tc >> 2; cl = tc & 3; nc = 4; } else { seq = (tc - 64) >> 4; cl = (tc - 64) & 15; nc = 16; }
  const int tcbase = tc - cl;
  u16* sST = (u16*)smem;
  const float* KVb = (const float*)(p.ws + O_KV);
  const float* DECb = (const float*)(p.ws + O_DEC);
  __syncthreads();
#pragma unroll 1
  for (int dir = 0; dir < 2; ++dir) {
    float4 S[4];
#pragma unroll
    for (int a = 0; a < 4; ++a) {
      if (lat) S[a] = *(const float4*)(p.in[6 + dir] + ((size_t)((seq * 2 + li) * 4 + h) * 64 + ty + 16 * a) * 64 + tx * 4);
      else S[a] = make_float4(0.f, 0.f, 0.f, 0.f);
    }
    const int nprev = dir == 0 ? cl : nc - 1 - cl;
#pragma unroll 1
    for (int j = 0; j < nprev; ++j) {
      int tcj = tcbase + (dir == 0 ? j : nc - 1 - j);
      size_t itj = (size_t)((tcj * 4 + h) * 2 + dir);
#pragma unroll
      for (int a = 0; a < 4; ++a) {
        int k = ty + 16 * a;
        float dcy = DECb[itj * 64 + k];
        float4 kv = *(const float4*)(KVb + itj * 4096 + k * 64 + tx * 4);
        S[a].x = dcy * S[a].x + kv.x; S[a].y = dcy * S[a].y + kv.y; S[a].z = dcy * S[a].z + kv.z; S[a].w = dcy * S[a].w + kv.w;
      }
    }
    if (!lat && nprev == nc - 1) {
      size_t itj = (size_t)((tc * 4 + h) * 2 + dir);
      float* so = p.out + (dir == 0 ? OUT_SF : OUT_SB) + (size_t)((seq * 2 + li) * 4 + h) * 4096;
#pragma unroll
      for (int a = 0; a < 4; ++a) {
        int k = ty + 16 * a;
        float dcy = DECb[itj * 64 + k];
        float4 kv = *(const float4*)(KVb + itj * 4096 + k * 64 + tx * 4);
        *(float4*)(so + k * 64 + tx * 4) = make_float4(dcy * S[a].x + kv.x, dcy * S[a].y + kv.y, dcy * S[a].z + kv.z, dcy * S[a].w + kv.w);
      }
    }
    u16* st = sST + dir * 64 * 72;
#pragma unroll
    for (int a = 0; a < 4; ++a) {
      int k = ty + 16 * a;
      st[(tx * 4 + 0) * 72 + k] = f2bf(S[a].x);
      st[(tx * 4 + 1) * 72 + k] = f2bf(S[a].y);
      st[(tx * 4 + 2) * 72 + k] = f2bf(S[a].z);
      st[(tx * 4 + 3) * 72 + k] = f2bf(S[a].w);
    }
  }
  __syncthreads();
  f32x4 oc[4];
#pragma unroll
  for (int vt = 0; vt < 4; ++vt) oc[vt] = f32x4{0.f, 0.f, 0.f, 0.f};
#pragma unroll
  for (int dir = 0; dir < 2; ++dir) {
    const u16* QE = (const u16*)(p.ws + O_QE) + (size_t)dir * NTOK * 256 + (size_t)(row0 + 16 * w + l16) * 256 + h * 64 + q4 * 8;
    const u16* st = sST + dir * 64 * 72;
#pragma unroll
    for (int ks = 0; ks < 2; ++ks) {
      bf16x8 af = *(const bf16x8*)(QE + ks * 32);
#pragma unroll
      for (int vt = 0; vt < 4; ++vt) {
        bf16x8 bf = *(const bf16x8*)(st + (vt * 16 + l16) * 72 + ks * 32 + q4 * 8);
        oc[vt] = MFMA16(af, bf, oc[vt]);
      }
    }
  }
  const float* OI0 = (const float*)(p.ws + O_OI);
  const float* OI1 = OI0 + (size_t)NTOK * 256;
  const float* HSG = (const float*)(p.ws + O_HSG);
  u16* mixed = (u16*)(p.ws + O_MIXED);
  float gn[4];
#pragma unroll
  for (int vt = 0; vt < 4; ++vt) gn[vt] = p.in[21][li * 64 + vt * 16 + l16];
#pragma unroll
  for (int r = 0; r < 4; ++r) {
    const int row = row0 + 16 * w + q4 * 4 + r;
    const size_t off = (size_t)row * 256 + h * 64 + l16;
    float val[4];
    float ss = 0.f;
#pragma unroll
    for (int vt = 0; vt < 4; ++vt) {
      val[vt] = oc[vt][r] + OI0[off + vt * 16] + OI1[off + vt * 16];
      ss += val[vt] * val[vt];
    }
    ss += shx(ss, 1); ss += shx(ss, 2); ss += shx(ss, 4); ss += shx(ss, 8);
    const float rs = rsqrtf(ss * (1.f / 64.f) + 1e-6f);
#pragma unroll
    for (int vt = 0; vt < 4; ++vt)
      mixed[(size_t)row * 1024 + 512 + h * 64 + vt * 16 + l16] = f2bf(val[vt] * rs * gn[vt] * HSG[off + vt * 16]);
  }
}

DI void ln_apply(const P& p, const float* lo, const float* hi, const float* stats, const float* lng, const float* lnb,
                 const float* mods, int sc_off, int sh_off) {
  const int lane = ltid() & 63, wid = ltid() >> 6;
  u16* dst = (u16*)(p.ws + O_ABF);
  for (int it = blockIdx.x; it < NTOK / 4; it += gridDim.x) {
    const int row = it * 4 + wid;
    float mu = 0.f, rs = 1.f;
    if (stats != nullptr) {
      float s1 = 0.f, s2 = 0.f;
      if (lane < 16) {
        float2 v = *(const float2*)(stats + (size_t)row * 32 + lane * 2);
        s1 = v.x;
        s2 = v.y;
      }
#pragma unroll
      for (int s = 1; s < 16; s <<= 1) { s1 += shx(s1, s); s2 += shx(s2, s); }
      s1 = __shfl(s1, 0, 64);
      s2 = __shfl(s2, 0, 64);
      mu = s1 * (1.f / 1024.f);
      rs = rsqrtf(fmaxf(s2 * (1.f / 1024.f) - mu * mu, 0.f) + 1e-6f);
    }
    const float* x = row < NCTX ? lo + (size_t)row * 1024 : hi + (size_t)(row - NCTX) * 1024;
    const int rtype = row < NCTX ? 0 : 1 + ((row - NCTX) >> 10);
    const float* mv = mods + rtype * 6144;
#pragma unroll
    for (int i = 0; i < 4; ++i) {
      const int c = (lane + 64 * i) * 4;
      f32x4 v = *(const f32x4*)(x + c);
      f32x4 sc = *(const f32x4*)(mv + sc_off + c) + 1.f;
      f32x4 sh = *(const f32x4*)(mv + sh_off + c);
      if (stats != nullptr) {
        f32x4 gg = *(const f32x4*)(lng + c);
        f32x4 bb = *(const f32x4*)(lnb + c);
        v = (v - mu) * rs * gg + bb;
      }
      v = v * sc + sh;
      u32x2 o;
      o.x = pack2(v.x, v.y);
      o.y = pack2(v.z, v.w);
      *(u32x2*)(dst + (size_t)row * 1024 + c) = o;
    }
  }
}

DI void final_ln(const P& p) {
  const int lane = ltid() & 63, wid = ltid() >> 6;
  const float* X = (const float*)(p.ws + O_XPRE2);
  const float* ST = (const float*)(p.ws + O_ST2);
  const float* g = p.in[26] + 1024;
  const float* bb = p.in[27] + 1024;
  for (int it = blockIdx.x; it < NTOK / 4; it += gridDim.x) {
    int row = it * 4 + wid;
    float s1 = 0.f, s2 = 0.f;
    if (lane < 16) {
      float2 v = *(const float2*)(ST + (size_t)row * 32 + lane * 2);
      s1 = v.x;
      s2 = v.y;
    }
#pragma unroll
    for (int s = 1; s < 16; s <<= 1) { s1 += shx(s1, s); s2 += shx(s2, s); }
    s1 = __shfl(s1, 0, 64);
    s2 = __shfl(s2, 0, 64);
    float mu = s1 * (1.f / 1024.f);
    float rs = rsqrtf(fmaxf(s2 * (1.f / 1024.f) - mu * mu, 0.f) + 1e-6f);
    float* out = p.out + (row < NCTX ? OUT_YP + (size_t)row * 1024 : OUT_YS + (size_t)(row - NCTX) * 1024);
#pragma unroll
    for (int i = 0; i < 4; ++i) {
      int c = (lane + 64 * i) * 4;
      float4 x = *(const float4*)(X + (size_t)row * 1024 + c);
      float4 gg = *(const float4*)(g + c);
      float4 b4 = *(const float4*)(bb + c);
      *(float4*)(out + c) = make_float4((x.x - mu) * rs * gg.x + b4.x, (x.y - mu) * rs * gg.y + b4.y,
                                         (x.z - mu) * rs * gg.z + b4.z, (x.w - mu) * rs * gg.w + b4.w);
    }
  }
}

DI void run_phase(const P& p, int ph, char* smem, int sub = 0) {
  if (ph == 0) { phase0(p, smem); return; }
  if (ph == NPHASE - 1) { final_ln(p); return; }
  const int li = (ph - 1) >> 3, s = (ph - 1) & 7;
  float* XPRE1 = (float*)(p.ws + O_XPRE1);
  float* XPRE2 = (float*)(p.ws + O_XPRE2);
  float* ST1 = (float*)(p.ws + O_ST1);
  float* ST2 = (float*)(p.ws + O_ST2);
  GA g;
  g.mods = (const float*)(p.ws + O_MODS) + li * 3 * 6144;
  g.a16 = (const u16*)(p.ws + O_ABF); g.xout = nullptr; g.sout = nullptr; g.hid = nullptr;
  g.alo = nullptr; g.ahi = nullptr; g.stats = nullptr; g.lng = nullptr; g.lnb = nullptr; g.sc_off = 0; g.sh_off = 0;
  const float* xin_lo = li == 0 ? p.in[0] : XPRE2;
  const float* xin_hi = li == 0 ? p.in[1] : XPRE2 + (size_t)NCTX * 1024;
  const float* xin_st = li == 0 ? nullptr : ST2;
  const float* xin_g = p.in[26] + (li == 0 ? 0 : (li - 1) * 1024);
  const float* xin_b = p.in[27] + (li == 0 ? 0 : (li - 1) * 1024);
  if (s == 0) {
    ln_apply(p, xin_lo, xin_hi, xin_st, xin_g, xin_b, g.mods, 1024, 0);
  } else if (s == 1) {
    g.bt = (const u16*)(p.ws + O_WTIN) + (size_t)li * NIN * D; g.K = D; g.N = NIN;
    gemm_phase<0>(p, g, li, smem);
  } else if (s == 2) {
    const int it_lo = sub == 2 ? 256 : (sub == 3 ? 1024 : 0), it_hi = sub == 1 ? 256 : (sub == 2 ? 1024 : 1536);
    for (int it = it_lo + blockIdx.x; it < it_hi; it += gridDim.x) {
      if (it >= 256 && it < 1024) h1_item(p, it - 256, smem);
      else attnA_item(p, li, it < 256 ? it : it - 768, smem);
    }
  } else if (s == 3) {
    for (int it = blockIdx.x; it < 384 + 384; it += gridDim.x) {
      if (it >= 128 && it < 512) h2_item(p, li, it - 128, smem);
      else attnC_item(p, li, it < 128 ? it : it - 384, smem);
    }
  } else if (s == 4) {
    g.alo = xin_lo; g.ahi = xin_hi; g.stats = xin_st; g.lng = xin_g; g.lnb = xin_b;
    g.sc_off = 2048;
    g.a16 = (const u16*)(p.ws + O_MIXED);
    g.bt = (const u16*)(p.ws + O_WTOUT) + (size_t)li * D * D; g.K = D; g.N = D;
    g.xout = XPRE1; g.sout = ST1;
    gemm_phase<1>(p, g, li, smem);
  } else if (s == 5) {
    ln_apply(p, XPRE1, XPRE1 + (size_t)NCTX * 1024, ST1, p.in[24] + li * 1024, p.in[25] + li * 1024, g.mods, 4096, 3072);
  } else if (s == 6) {
    g.bt = (const u16*)(p.ws + O_WTFF1) + (size_t)li * DFF * D; g.K = D; g.N = DFF;
    g.hid = (u16*)(p.ws + O_HID);
    gemm_phase<2>(p, g, li, smem);
  } else {
    g.alo = XPRE1; g.ahi = XPRE1 + (size_t)NCTX * 1024; g.stats = ST1; g.lng = p.in[24] + li * 1024; g.lnb = p.in[25] + li * 1024;
    g.sc_off = 5120;
    g.a16 = (const u16*)(p.ws + O_HID);
    g.bt = (const u16*)(p.ws + O_WTFF2) + (size_t)li * D * DFF; g.K = DFF; g.N = D;
    g.xout = XPRE2; g.sout = ST2;
    gemm_phase<1>(p, g, li, smem);
  }
}

#define XB_TMO      128
#define XB_XCNT(j)  (256  + 64 * (j))
#define XB_XSUB(j)  (1280 + 64 * (j))
#define XB_XGEN(j)  (2304 + 64 * (j))
#define XB_TOP      3328
#define XB_TOPGEN   3392
#define XCD_BAR_WORDS 3456
#define XB_SPIN_CAP (1u << 20)
#define LAS __attribute__((address_space(3)))
DI unsigned xb_ld(unsigned* p) { return __hip_atomic_load(p, __ATOMIC_RELAXED, __HIP_MEMORY_SCOPE_AGENT); }
DI unsigned xb_add(unsigned* p, unsigned v) { return __hip_atomic_fetch_add(p, v, __ATOMIC_RELAXED, __HIP_MEMORY_SCOPE_AGENT); }
DI unsigned xb_xcc_id() { return (unsigned)__builtin_amdgcn_s_getreg((3 << 11) | 20) & 0xFu; }
#define XB_SPIN(cond, bar) do { unsigned _sp = 0; while (cond) { __builtin_amdgcn_s_sleep(1); \
    if ((++_sp & 255u) == 0u) { if (xb_ld(&(bar)[XB_TMO])) break; if (_sp > XB_SPIN_CAP) { atomicAdd(&(bar)[XB_TMO], 1u); break; } } } } while (0)
struct XcdBarrier { unsigned* bar; unsigned x; volatile LAS unsigned* st; };
DI XcdBarrier xcd_barrier_post(unsigned* bar, volatile LAS unsigned* st) {
  XcdBarrier b; b.bar = bar; b.x = xb_xcc_id(); b.st = st;
  if (threadIdx.x == 0) (void)xb_add(&bar[XB_XCNT(b.x)], 1u);
  return b;
}
DI void xcd_barrier_complete(unsigned* bar, unsigned x, unsigned& nloc, unsigned& nx) {
  const unsigned G = gridDim.x * gridDim.y * gridDim.z;
  unsigned sum, cnt, mine, sp = 0u;
  for (;;) {
    sum = 0u; cnt = 0u; mine = 0u;
#pragma unroll
    for (unsigned j = 0; j < 16; ++j) { const unsigned c = xb_ld(&bar[XB_XCNT(j)]); sum += c; cnt += (c > 0u) ? 1u : 0u; mine = (j == x) ? c : mine; }
    if (sum == G) break;
    __builtin_amdgcn_s_sleep(1);
    if ((++sp & 255u) == 0u) { if (xb_ld(&bar[XB_TMO])) break; if (sp > XB_SPIN_CAP) { atomicAdd(&bar[XB_TMO], 1u); break; } }
  }
  nloc = mine > 0u ? mine : 1u; nx = cnt > 0u ? cnt : 1u;
}
DI void xcd_barrier(const XcdBarrier& b) {
  asm volatile("s_waitcnt vmcnt(0)" ::: "memory");
  __syncthreads();
  if (threadIdx.x == 0) {
    unsigned* bar = b.bar;
    __builtin_amdgcn_s_waitcnt(0);
    unsigned nloc = b.st[0], nx = b.st[1];
    if (nloc == 0u) { xcd_barrier_complete(bar, b.x, nloc, nx); b.st[0] = nloc; b.st[1] = nx; }
    const unsigned old = xb_add(&bar[XB_XSUB(b.x)], 1u);
    const unsigned gen = old / nloc;
    if (old + 1u == (gen + 1u) * nloc) {
      __builtin_amdgcn_fence(__ATOMIC_RELEASE, "agent");
      asm volatile("s_waitcnt vmcnt(0)" ::: "memory");
      const unsigned og = xb_add(&bar[XB_TOP], 1u);
      const unsigned tg = og / nx;
      if (og + 1u == (tg + 1u) * nx) xb_add(&bar[XB_TOPGEN], 1u);
      else XB_SPIN(xb_ld(&bar[XB_TOPGEN]) == tg, bar);
      __builtin_amdgcn_fence(__ATOMIC_ACQUIRE, "agent");
      xb_add(&bar[XB_XGEN(b.x)], 1u);
      asm volatile("s_waitcnt vmcnt(0)" ::: "memory");
    } else {
      XB_SPIN(xb_ld(&bar[XB_XGEN(b.x)]) == gen, bar);
      __builtin_amdgcn_fence(__ATOMIC_ACQUIRE, "agent");
      asm volatile("s_waitcnt vmcnt(0)" ::: "memory");
    }
  }
  __syncthreads();
}
constexpr size_t O_BAR = O_END1;
static_assert(O_BAR + XCD_BAR_WORDS * 4 <= (size_t)256 * 1024 * 1024, "barrier words must fit");

#if !MULTI_LAUNCH
__global__ void __launch_bounds__(256, 2) mega_kernel(P p) {
  extern __shared__ __attribute__((aligned(16))) char smem[];
  cg::grid_group grid = cg::this_grid();
  if (p.ws == nullptr) grid.sync();
  if (threadIdx.x == 0) *(uint4*)(smem + LDS_BYTES - 16) = make_uint4(0u, 0u, 0u, 0u);
  __syncthreads();
  XcdBarrier xb = xcd_barrier_post((unsigned*)(p.ws + O_BAR), (volatile LAS unsigned*)(smem + LDS_BYTES - 16));
  run_phase(p, 0, smem); xcd_barrier(xb);
  run_phase(p, 1, smem); xcd_barrier(xb);
  run_phase(p, 2, smem); xcd_barrier(xb);
  run_phase(p, 3, smem); xcd_barrier(xb);
  run_phase(p, 4, smem); xcd_barrier(xb);
  run_phase(p, 5, smem); xcd_barrier(xb);
  run_phase(p, 6, smem); xcd_barrier(xb);
  run_phase(p, 7, smem); xcd_barrier(xb);
  run_phase(p, 8, smem); xcd_barrier(xb);
  run_phase(p, 9, smem); xcd_barrier(xb);
  run_phase(p, 10, smem); xcd_barrier(xb);
  run_phase(p, 11, smem); xcd_barrier(xb);
  run_phase(p, 12, smem); xcd_barrier(xb);
  run_phase(p, 13, smem); xcd_barrier(xb);
  run_phase(p, 14, smem); xcd_barrier(xb);
  run_phase(p, 15, smem); xcd_barrier(xb);
  run_phase(p, 16, smem); xcd_barrier(xb);
  run_phase(p, 17, smem);
}
#define MAIN_KERNEL mega_kernel
#else
__global__ void __launch_bounds__(256, 2) phase_kernel(P p, int ph, int sub) {
  extern __shared__ __attribute__((aligned(16))) char smem[];
  run_phase(p, ph, smem, sub);
}
#define MAIN_KERNEL phase_kernel
#endif

extern "C" void kernel_launch(void* const* d_in, const int* in_sizes, int n_in, void* d_out, int out_size, void* d_ws,
                              size_t ws_size, hipStream_t stream) {
  static int grid_blocks = 0;
  if (!grid_blocks) {
    int dev = 0, cus = 0, per_cu = 0;
    (void)hipGetDevice(&dev);
    (void)hipDeviceGetAttribute(&cus, hipDeviceAttributeMultiprocessorCount, dev);
    (void)hipFuncSetAttribute((const void*)MAIN_KERNEL, hipFuncAttributeMaxDynamicSharedMemorySize, LDS_BYTES);
    (void)hipOccupancyMaxActiveBlocksPerMultiprocessor(&per_cu, MAIN_KERNEL, 256, LDS_BYTES);
    if (per_cu > 2) per_cu = 2;
    if (per_cu < 1) per_cu = 1;
    grid_blocks = cus * per_cu;
  }
  P p{};
  for (int i = 0; i < 30; ++i) p.in[i] = (const float*)d_in[i];
  p.out = (float*)d_out;
  p.ws = (char*)d_ws;
#if MULTI_LAUNCH
  for (int ph = 0; ph < NPHASE; ++ph) {
    phase_kernel<<<dim3(grid_blocks), dim3(256), LDS_BYTES, stream>>>(p, ph, 0);
#ifdef DUP_MASK
    int bit = (ph == 0) ? 8 : (ph == NPHASE - 1 ? 9 : (ph - 1) & 7);
    if ((DUP_MASK >> bit) & 1) phase_kernel<<<dim3(grid_blocks), dim3(256), LDS_BYTES, stream>>>(p, ph, DUP_SUB);
#endif
  }
#else
  (void)hipMemsetAsync((char*)d_ws + O_BAR, 0, XCD_BAR_WORDS * 4, stream);
  void* args[] = {&p};
  hipError_t e = hipLaunchCooperativeKernel((void*)mega_kernel, dim3(grid_blocks), dim3(256), args, LDS_BYTES, stream);
  if (e != hipSuccess) fprintf(stderr, "cooperative launch failed: %s (grid %d)\n", hipGetErrorString(e), grid_blocks);
#endif
}
```

```cpp
#include <hip/hip_runtime.h>
#include <hip/hip_cooperative_groups.h>
#include <stdint.h>
#include <stdio.h>
namespace cg = cooperative_groups;

#ifndef MULTI_LAUNCH
#define MULTI_LAUNCH 0
#endif

#define DI __device__ __forceinline__
typedef unsigned short u16;
using bf16x8 = __attribute__((ext_vector_type(8))) short;
using f32x4 = __attribute__((ext_vector_type(4))) float;
typedef __bf16 bf2_t __attribute__((ext_vector_type(2)));
typedef float f2_t __attribute__((ext_vector_type(2)));

constexpr int D = 1024, NTOK = 6144, NCTX = 4096, NIN = 3328, DFF = 4096;
constexpr float ALPHA = 1.41421356237309515f;
constexpr float LOG2E = 1.44269504088896341f;
constexpr int LDS_BYTES = 75776;
constexpr int NPHASE = 18;

constexpr size_t O_WTIN = 0;
constexpr size_t O_WTOUT = O_WTIN + (size_t)2 * NIN * D * 2;
constexpr size_t O_WTFF1 = O_WTOUT + (size_t)2 * D * D * 2;
constexpr size_t O_WTFF2 = O_WTFF1 + (size_t)2 * DFF * D * 2;
constexpr size_t O_MODS = O_WTFF2 + (size_t)2 * D * DFF * 2;
constexpr size_t O_ROPE = O_MODS + (size_t)2 * 3 * 6144 * 4;
constexpr size_t O_QA = O_ROPE + (size_t)1024 * 32 * 2 * 4;
constexpr size_t O_KACTX = O_QA + (size_t)NTOK * 512 * 2;
constexpr size_t O_KALAT = O_KACTX + (size_t)NCTX * 512 * 2;
constexpr size_t O_VTACTX = O_KALAT + (size_t)2 * 2 * 1536 * 512 * 2;
constexpr size_t O_VTALAT = O_VTACTX + (size_t)16 * 4 * 128 * 256 * 2;
constexpr size_t O_QC = O_VTALAT + (size_t)2 * 2 * 4 * 128 * 1536 * 2;
constexpr size_t O_KCCTX = O_QC + (size_t)NTOK * 256 * 2;
constexpr size_t O_KCLAT = O_KCCTX + (size_t)NCTX * 128 * 2;
constexpr size_t O_VTCCTX = O_KCLAT + (size_t)2 * 2 * 1536 * 128 * 2;
constexpr size_t O_VTCLAT = O_VTCCTX + (size_t)16 * 2 * 64 * 256 * 2;
constexpr size_t O_KV = O_VTCLAT + (size_t)2 * 2 * 2 * 64 * 1536 * 2;
constexpr size_t O_DEC = O_KV + (size_t)768 * 4096 * 4;
constexpr size_t O_MIXED = O_DEC + (size_t)768 * 64 * 4;
constexpr size_t O_XPRE1 = O_MIXED + (size_t)NTOK * 1024 * 2;
constexpr size_t O_ST1 = O_XPRE1 + (size_t)NTOK * 1024 * 4;
constexpr size_t O_XPRE2 = O_ST1 + (size_t)NTOK * 32 * 4;
constexpr size_t O_ST2 = O_XPRE2 + (size_t)NTOK * 1024 * 4;
constexpr size_t O_ABF = O_ST2 + (size_t)NTOK * 32 * 4;
constexpr size_t O_HQ = O_ABF + (size_t)NTOK * 1024 * 2;
constexpr size_t O_HGF = O_HQ + (size_t)NTOK * 256 * 4;
constexpr size_t O_HGB = O_HGF + (size_t)NTOK * 256 * 4;
constexpr size_t O_HI = O_HGB + (size_t)NTOK * 256 * 4;
constexpr size_t O_HSG = O_HI + (size_t)NTOK * 256 * 4;
constexpr size_t O_OI = O_HSG + (size_t)NTOK * 256 * 4;
constexpr size_t O_QE = O_OI + (size_t)2 * NTOK * 256 * 4;
constexpr size_t O_END1 = O_QE + (size_t)2 * NTOK * 256 * 4;
constexpr size_t O_HID = O_HQ;
constexpr size_t O_END2 = O_HID + (size_t)NTOK * 4096 * 2;
static_assert(O_END2 <= O_END1, "HID alias must fit");
static_assert(O_END1 <= (size_t)256 * 1024 * 1024, "workspace too big");

constexpr size_t OUT_YP = 0, OUT_YS = 4194304, OUT_AK = 6291456, OUT_AV = 10485760, OUT_CK = 14680064,
                 OUT_CV = 15728640, OUT_SF = 16777216, OUT_SB = 17301504;

struct P {
  const float* in[30];
  float* out;
  char* ws;
};

DI unsigned pack2(float a, float b) {
  f2_t v = {a, b};
  bf2_t r = __builtin_convertvector(v, bf2_t);
  return __builtin_bit_cast(unsigned, r);
}
DI u16 f2bf(float x) { return (u16)(pack2(x, 0.f) & 0xffffu); }
DI float ex2(float x) { return __builtin_amdgcn_exp2f(x); }
DI float siluf(float x) { return x / (1.f + expf(-x)); }
DI float shx(float v, int m) { return __shfl_xor(v, m, 64); }
DI float red16(float x) {
  x += __builtin_bit_cast(float, __builtin_amdgcn_update_dpp(0, __builtin_bit_cast(int, x), 0xB1, 0xF, 0xF, true));
  x += __builtin_bit_cast(float, __builtin_amdgcn_update_dpp(0, __builtin_bit_cast(int, x), 0x4E, 0xF, 0xF, true));
  x += __builtin_bit_cast(float, __builtin_amdgcn_update_dpp(0, __builtin_bit_cast(int, x), 0x141, 0xF, 0xF, true));
  x += __builtin_bit_cast(float, __builtin_amdgcn_update_dpp(0, __builtin_bit_cast(int, x), 0x140, 0xF, 0xF, true));
  return x;
}
DI float xor1(float x) { return __builtin_bit_cast(float, __builtin_amdgcn_update_dpp(0, __builtin_bit_cast(int, x), 0xB1, 0xF, 0xF, true)); }
DI int ltid() { int t = threadIdx.x; asm volatile("" : "+v"(t)); return t; }
#define MFMA16(a, b, c) __builtin_amdgcn_mfma_f32_16x16x32_bf16((a), (b), (c), 0, 0, 0)

DI void p0_mod(const P& p, int item, char* smem) {
  float* ssilu = (float*)smem;
  float* red = ssilu + 3072;
  const int tid = ltid();
  __syncthreads();
  for (int i = tid; i < 3072; i += 256) {
    int w = i >> 10, k = i & 1023;
    float v = (w == 0) ? p.in[9][k] : p.in[8][(w - 1) * 1024 + k];
    ssilu[i] = siluf(v);
  }
  __syncthreads();
  const int li = item / 96, j0 = (item % 96) * 64;
  const int c4 = tid & 15, kp = tid >> 4;
  const float* W = p.in[10] + (size_t)li * 1024 * 6144 + j0 + c4 * 4;
  float4 a0 = {0, 0, 0, 0}, a1 = a0, a2 = a0;
#pragma unroll 4
  for (int kk = 0; kk < 64; ++kk) {
    int k = kp * 64 + kk;
    float4 w4 = *(const float4*)(W + (size_t)k * 6144);
    float s0 = ssilu[k], s1 = ssilu[1024 + k], s2 = ssilu[2048 + k];
    a0.x += s0 * w4.x; a0.y += s0 * w4.y; a0.z += s0 * w4.z; a0.w += s0 * w4.w;
    a1.x += s1 * w4.x; a1.y += s1 * w4.y; a1.z += s1 * w4.z; a1.w += s1 * w4.w;
    a2.x += s2 * w4.x; a2.y += s2 * w4.y; a2.z += s2 * w4.z; a2.w += s2 * w4.w;
  }
  *(float4*)(red + (kp * 3 + 0) * 64 + c4 * 4) = a0;
  *(float4*)(red + (kp * 3 + 1) * 64 + c4 * 4) = a1;
  *(float4*)(red + (kp * 3 + 2) * 64 + c4 * 4) = a2;
  __syncthreads();
  if (tid < 192) {
    int w = tid >> 6, c = tid & 63;
    float s = p.in[11][li * 6144 + j0 + c];
    for (int q = 0; q < 16; ++q) s += red[(q * 3 + w) * 64 + c];
    ((float*)(p.ws + O_MODS))[(li * 3 + w) * 6144 + j0 + c] = s;
  }
}

DI void p0_rope(const P& p, int item) {
  float* R = (float*)(p.ws + O_ROPE);
  for (int i = ltid(); i < 4096; i += 256) {
    int idx = item * 4096 + i;
    int t = idx >> 5, pp = idx & 31;
    float inv = powf(10000.f, -(float)(pp & 15) / 16.f);
    float pos = (pp < 16) ? (float)(t >> 6) : (float)(t & 63);
    float ang = pos * inv;
    R[idx * 2] = cosf(ang);
    R[idx * 2 + 1] = sinf(ang);
  }
}

DI void p0_copyk(const P& p, int item, bool isA) {
  const int W = isA ? 512 : 128;
  const float* src = isA ? p.in[2] : p.in[4];
  u16* dst = (u16*)(p.ws + (isA ? O_KALAT : O_KCLAT));
  for (int i = 0; i < 4; ++i) {
    size_t e = (size_t)item * 4096 + (size_t)(ltid() + 256 * i) * 4;
    float4 v = *(const float4*)(src + e);
    int c = (int)(e % W);
    size_t r = e / W;
    int pp = (int)(r % 512);
    int bl = (int)(r / 512);
    int b = bl >> 1, li = bl & 1;
    uint2 o;
    o.x = pack2(v.x, v.y);
    o.y = pack2(v.z, v.w);
    *(uint2*)(dst + ((size_t)((li * 2 + b) * 1536 + 1024 + pp)) * W + c) = o;
  }
}

DI void transpose_tile(const float* src, int sstride, u16* dst, int dstride, char* smem) {
  float* t = (float*)smem;
  const int tid = ltid();
  __syncthreads();
#pragma unroll
  for (int i = 0; i < 4; ++i) {
    int idx = tid + 256 * i;
    int r = idx >> 4, c4 = idx & 15;
    float4 v = *(const float4*)(src + (size_t)r * sstride + c4 * 4);
    float* q = t + r * 65 + c4 * 4;
    q[0] = v.x; q[1] = v.y; q[2] = v.z; q[3] = v.w;
  }
  __syncthreads();
  const int c = tid >> 2, rs = tid & 3;
  unsigned o[8];
#pragma unroll
  for (int e = 0; e < 8; ++e) {
    float a = t[(rs * 16 + 2 * e) * 65 + c], b = t[(rs * 16 + 2 * e + 1) * 65 + c];
    o[e] = pack2(a, b);
  }
  uint4* dp = (uint4*)(dst + (size_t)c * dstride + rs * 16);
  dp[0] = make_uint4(o[0], o[1], o[2], o[3]);
  dp[1] = make_uint4(o[4], o[5], o[6], o[7]);
}

DI void phase0(const P& p, char* smem) {
  constexpr int N_MOD = 192, N_ROPE = 8, N_AK = 256, N_CK = 64;
  constexpr int T_IN = 1664, T_OUT = 512, T_FF1 = 2048, T_FF2 = 2048, T_AV = 256, T_CV = 64;
  constexpr int B_ROPE = N_MOD, B_AK = B_ROPE + N_ROPE, B_CK = B_AK + N_AK, B_T = B_CK + N_CK;
  constexpr int TOTAL = B_T + T_IN + T_OUT + T_FF1 + T_FF2 + T_AV + T_CV;
  for (int it = blockIdx.x; it < TOTAL; it += gridDim.x) {
    if (it < B_ROPE) p0_mod(p, it, smem);
    else if (it < B_AK) p0_rope(p, it - B_ROPE);
    else if (it < B_CK) p0_copyk(p, it - B_AK, true);
    else if (it < B_T) p0_copyk(p, it - B_CK, false);
    else {
      int t = it - B_T;
      if (t < T_IN) {
        int li = t / 832, r = t % 832, kt = r / 52, nt = r % 52;
        transpose_tile(p.in[12] + (size_t)li * 1024 * NIN + (size_t)(kt * 64) * NIN + nt * 64, NIN,
                       (u16*)(p.ws + O_WTIN) + (size_t)li * NIN * 1024 + (size_t)(nt * 64) * 1024 + kt * 64, 1024, smem);
      } else if ((t -= T_IN) < T_OUT) {
        int li = t / 256, r = t % 256, kt = r / 16, nt = r % 16;
        transpose_tile(p.in[13] + (size_t)li * 1024 * 1024 + (size_t)(kt * 64) * 1024 + nt * 64, 1024,
                       (u16*)(p.ws + O_WTOUT) + (size_t)li * 1024 * 1024 + (size_t)(nt * 64) * 1024 + kt * 64, 1024, smem);
      } else if ((t -= T_OUT) < T_FF1) {
        int li = t / 1024, r = t % 1024, kt = r / 64, nt = r % 64;
        transpose_tile(p.in[28] + (size_t)li * 1024 * DFF + (size_t)(kt * 64) * DFF + nt * 64, DFF,
                       (u16*)(p.ws + O_WTFF1) + (size_t)li * DFF * 1024 + (size_t)(nt * 64) * 1024 + kt * 64, 1024, smem);
      } else if ((t -= T_FF1) < T_FF2) {
        int li = t / 1024, r = t % 1024, kt = r / 16, nt = r % 16;
        transpose_tile(p.in[29] + (size_t)li * DFF * 1024 + (size_t)(kt * 64) * 1024 + nt * 64, 1024,
                       (u16*)(p.ws + O_WTFF2) + (size_t)li * 1024 * DFF + (size_t)(nt * 64) * DFF + kt * 64, DFF, smem);
      } else if ((t -= T_FF2) < T_AV) {
        int bl = t / 64, r = t % 64, pt = r / 8, ct = r % 8;
        int b = bl >> 1, li = bl & 1;
        transpose_tile(p.in[3] + ((size_t)bl * 512 + pt * 64) * 512 + ct * 64, 512,
                       (u16*)(p.ws + O_VTALAT) + ((size_t)(li * 2 + b) * 512 + ct * 64) * 1536 + 1024 + pt * 64, 1536, smem);
      } else {
        t -= T_AV;
        int bl = t / 16, r = t % 16, pt = r / 2, ct = r % 2;
        int b = bl >> 1, li = bl & 1;
        transpose_tile(p.in[5] + ((size_t)bl * 512 + pt * 64) * 128 + ct * 64, 128,
                       (u16*)(p.ws + O_VTCLAT) + ((size_t)(li * 2 + b) * 128 + ct * 64) * 1536 + 1024 + pt * 64, 1536, smem);
      }
    }
  }
}

struct GA {
  const float* alo;
  const float* ahi;
  const float* stats;
  const float* lng;
  const float* lnb;
  const float* mods;
  int sc_off, sh_off;
  const u16* a16;
  const u16* bt;
  int K, N;
  float* xout;
  float* sout;
  u16* hid;
};

DI void epi_inproj(const P& p, int li, f32x4 (&acc)[4][4], int R0, int C0);

typedef unsigned u32x4 __attribute__((ext_vector_type(4)));
typedef unsigned u32x2 __attribute__((ext_vector_type(2)));

template <int EPI>
DI void gemm_tile(const P& p, const GA& g, int li, int m0, int n0, char* smem) {
  const int tid = ltid(), lane = tid & 63, wid = tid >> 6, wr = wid >> 1, wc = wid & 1;
  const int l16 = lane & 15, q4 = lane >> 4;
  u16* sA0 = (u16*)smem;
  u16* sB0 = sA0 + 128 * 72;
  u16* sA1 = sB0 + 128 * 72;
  u16* sB1 = sA1 + 128 * 72;
  float2* sStat = (float2*)(smem + 73728);
  const int K = g.K;
  const int rtype = (m0 < NCTX) ? 0 : 1 + ((m0 - NCTX) >> 10);
  const float* modv = g.mods + rtype * 6144;
  const float* fsrc = (m0 < NCTX) ? g.alo + (size_t)m0 * 1024 : g.ahi + (size_t)(m0 - NCTX) * 1024;

  __syncthreads();
  if constexpr (EPI == 1) {
    if (g.stats != nullptr && tid < 128) {
      const float4* sp = (const float4*)(g.stats + (size_t)(m0 + tid) * 32);
      float s1 = 0.f, s2 = 0.f;
#pragma unroll
      for (int i = 0; i < 8; ++i) {
        float4 v = sp[i];
        s1 += v.x + v.z;
        s2 += v.y + v.w;
      }
      float mu = s1 * (1.f / 1024.f);
      float var = s2 * (1.f / 1024.f) - mu * mu;
      sStat[tid] = make_float2(mu, rsqrtf(fmaxf(var, 0.f) + 1e-6f));
    }
  }

  f32x4 acc[4][4];
#pragma unroll
  for (int i = 0; i < 4; ++i)
#pragma unroll
    for (int j = 0; j < 4; ++j) acc[i][j] = f32x4{0.f, 0.f, 0.f, 0.f};

  u32x4 ra0[4], rb0[4], ra1[4], rb1[4];
  const unsigned goff = (unsigned)(tid >> 3) * (unsigned)K + (unsigned)(tid & 7) * 8u;
  const unsigned loff = (unsigned)(tid >> 3) * 72u + (unsigned)(tid & 7) * 8u;
  const u16* abase = g.a16 + (size_t)m0 * K;
  const u16* bbase = g.bt + (size_t)n0 * K;
#define GLOAD(RA, RB, KT)                                                        \
  _Pragma("unroll") for (int i = 0; i < 4; ++i) {                                \
    RA[i] = *(const u32x4*)(abase + (size_t)(32 * i) * K + (KT) * 64 + goff);    \
    RB[i] = *(const u32x4*)(bbase + (size_t)(32 * i) * K + (KT) * 64 + goff);    \
  }
#define LSTORE(SA, SB, RA, RB)                                                   \
  _Pragma("unroll") for (int i = 0; i < 4; ++i) {                                \
    *(u32x4*)(SA + 32 * i * 72 + loff) = RA[i];                                  \
    *(u32x4*)(SB + 32 * i * 72 + loff) = RB[i];                                  \
  }
#define COMPUTE(SA, SB)                                                          \
  _Pragma("unroll") for (int s = 0; s < 2; ++s) {                                \
    bf16x8 af[4], bfr[4];                                                        \
    _Pragma("unroll") for (int i = 0; i < 4; ++i) {                              \
      af[i] = *(const bf16x8*)(SA + (wr * 64 + i * 16 + l16) * 72 + s * 32 + q4 * 8);  \
      bfr[i] = *(const bf16x8*)(SB + (wc * 64 + i * 16 + l16) * 72 + s * 32 + q4 * 8); \
    }                                                                            \
    _Pragma("unroll") for (int i = 0; i < 4; ++i)                                \
      _Pragma("unroll") for (int j = 0; j < 4; ++j) acc[i][j] = MFMA16(af[i], bfr[j], acc[i][j]); \
    __builtin_amdgcn_sched_barrier(0);                                           \
  }

  const int nk = K >> 6;
#define SB0 __builtin_amdgcn_sched_barrier(0)
  GLOAD(ra0, rb0, 0);
  SB0;
  GLOAD(ra1, rb1, 1);
  SB0;
  LSTORE(sA0, sB0, ra0, rb0);
  SB0;
  GLOAD(ra0, rb0, 2);
  SB0;
  __syncthreads();
#pragma unroll 1
  for (int kt = 0; kt < nk - 4; kt += 2) {
    SB0;
    LSTORE(sA1, sB1, ra1, rb1);
    SB0;
    GLOAD(ra1, rb1, kt + 3);
    SB0;
    COMPUTE(sA0, sB0);
    __syncthreads();
    SB0;
    LSTORE(sA0, sB0, ra0, rb0);
    SB0;
    GLOAD(ra0, rb0, kt + 4);
    SB0;
    COMPUTE(sA1, sB1);
    __syncthreads();
  }
  SB0;
  LSTORE(sA1, sB1, ra1, rb1);
  SB0;
  GLOAD(ra1, rb1, nk - 1);
  SB0;
  COMPUTE(sA0, sB0);
  __syncthreads();
  SB0;
  LSTORE(sA0, sB0, ra0, rb0);
  SB0;
  COMPUTE(sA1, sB1);
  __syncthreads();
  SB0;
  LSTORE(sA1, sB1, ra1, rb1);
  SB0;
  COMPUTE(sA0, sB0);
  __syncthreads();
  SB0;
  COMPUTE(sA1, sB1);
#undef GLOAD
#undef LSTORE
#undef COMPUTE
#undef SB0
  asm volatile("" ::: "memory");

  const int R0 = m0 + wr * 64, C0 = n0 + wc * 64;
  if constexpr (EPI == 0) {
    epi_inproj(p, li, acc, R0, C0);
  } else if constexpr (EPI == 1) {
    float gate[4], lg[4], lb[4];
#pragma unroll
    for (int j = 0; j < 4; ++j) {
      int col = C0 + j * 16 + l16;
      gate[j] = modv[g.sc_off + col];
      lg[j] = g.stats ? g.lng[col] : 1.f;
      lb[j] = g.stats ? g.lnb[col] : 0.f;
    }
#pragma unroll
    for (int i = 0; i < 4; ++i) {
#pragma unroll
      for (int r = 0; r < 4; ++r) {
        int lrow = wr * 64 + i * 16 + q4 * 4 + r;
        float mu = 0.f, rs = 1.f;
        if (g.stats != nullptr) {
          float2 st = sStat[lrow];
          mu = st.x;
          rs = st.y;
        }
        float s1 = 0.f, s2 = 0.f;
#pragma unroll
        for (int j = 0; j < 4; ++j) {
          int col = C0 + j * 16 + l16;
          float x = fsrc[(size_t)lrow * 1024 + col];
          x = (x - mu) * rs * lg[j] + lb[j];
          float v = ALPHA * x + gate[j] * acc[i][j][r];
          g.xout[(size_t)(m0 + lrow) * 1024 + col] = v;
          s1 += v;
          s2 += v * v;
        }
        s1 = red16(s1);
        s2 = red16(s2);
        if (l16 == 0) *(float2*)(g.sout + (size_t)(m0 + lrow) * 32 + (C0 >> 6) * 2) = make_float2(s1, s2);
      }
    }
  } else {
    float* sC = (float*)smem;
    __syncthreads();
#pragma unroll
    for (int i = 0; i < 4; ++i)
#pragma unroll
      for (int j = 0; j < 4; ++j)
#pragma unroll
        for (int r = 0; r < 4; ++r) sC[(wr * 64 + i * 16 + q4 * 4 + r) * 132 + wc * 64 + j * 16 + l16] = acc[i][j][r];
    __syncthreads();
    if constexpr (EPI == 1) {
      const int hl = lane & 31, rsel = lane >> 5;
      const int col = n0 + hl * 4;
      const f32x4 gate4 = *(const f32x4*)(modv + g.sc_off + col);
      f32x4 lg4 = {1.f, 1.f, 1.f, 1.f}, lb4 = {0.f, 0.f, 0.f, 0.f};
      if (g.stats != nullptr) {
        lg4 = *(const f32x4*)(g.lng + col);
        lb4 = *(const f32x4*)(g.lnb + col);
      }
#pragma unroll 4
      for (int pp = 0; pp < 16; ++pp) {
        const int lrow = pp * 8 + wid * 2 + rsel;
        f32x4 a = *(const f32x4*)(sC + lrow * 132 + hl * 4);
        f32x4 x = *(const f32x4*)(fsrc + (size_t)lrow * 1024 + col);
        float mu = 0.f, rs = 1.f;
        if (g.stats != nullptr) {
          float2 st = sStat[lrow];
          mu = st.x;
          rs = st.y;
        }
        x = (x - mu) * rs * lg4 + lb4;
        f32x4 v = ALPHA * x + gate4 * a;
        *(f32x4*)(g.xout + (size_t)(m0 + lrow) * 1024 + col) = v;
        float s1 = (v.x + v.y) + (v.z + v.w);
        float s2 = (v.x * v.x + v.y * v.y) + (v.z * v.z + v.w * v.w);
        s1 = red16(s1);
        s2 = red16(s2);
        if ((lane & 15) == 0) *(float2*)(g.sout + (size_t)(m0 + lrow) * 32 + ((n0 >> 6) + (hl >> 4)) * 2) = make_float2(s1, s2);
      }
    } else {
#pragma unroll
      for (int pp = 0; pp < 8; ++pp) {
        const int idx = tid + 256 * pp;
        const int lrow = idx >> 4, c8 = idx & 15;
        f32x4 a0 = *(const f32x4*)(sC + lrow * 132 + c8 * 8);
        f32x4 a1 = *(const f32x4*)(sC + lrow * 132 + c8 * 8 + 4);
        a0.x = fmaxf(a0.x, 0.f); a0.y = fmaxf(a0.y, 0.f); a0.z = fmaxf(a0.z, 0.f); a0.w = fmaxf(a0.w, 0.f);
        a1.x = fmaxf(a1.x, 0.f); a1.y = fmaxf(a1.y, 0.f); a1.z = fmaxf(a1.z, 0.f); a1.w = fmaxf(a1.w, 0.f);
        u32x4 o;
        o.x = pack2(a0.x * a0.x, a0.y * a0.y);
        o.y = pack2(a0.z * a0.z, a0.w * a0.w);
        o.z = pack2(a1.x * a1.x, a1.y * a1.y);
        o.w = pack2(a1.z * a1.z, a1.w * a1.w);
        *(u32x4*)(g.hid + (size_t)(m0 + lrow) * DFF + n0 + c8 * 8) = o;
      }
    }
  }
}

DI void epi_inproj(const P& p, int li, f32x4 (&acc)[4][4], int R0, int C0) {
  const int lane = ltid() & 63, l16 = lane & 15, q4 = lane >> 4;
  const int seg = C0 >> 6;
  const bool lat = R0 >= NCTX;
  const float2* rope = (const float2*)(p.ws + O_ROPE);
  int b, tb;
  if (!lat) { b = R0 >> 8; tb = R0 & 255; } else { b = (R0 - NCTX) >> 10; tb = (R0 - NCTX) & 1023; }

  enum { T_QA, T_KA, T_VA, T_QB, T_FF, T_FB, T_IB, T_GB, T_QC, T_KC, T_VC };
  int type, cbase;
  if (seg < 8) { type = T_QA; cbase = seg * 64; }
  else if (seg < 16) { type = T_KA; cbase = (seg - 8) * 64; }
  else if (seg < 24) { type = T_VA; cbase = (seg - 16) * 64; }
  else if (seg < 28) { type = T_QB; cbase = (seg - 24) * 64; }
  else if (seg < 32) { type = T_FF; cbase = (seg - 28) * 64; }
  else if (seg < 36) { type = T_FB; cbase = (seg - 32) * 64; }
  else if (seg < 40) { type = T_IB; cbase = (seg - 36) * 64; }
  else if (seg < 44) { type = T_GB; cbase = (seg - 40) * 64; }
  else if (seg < 48) { type = T_QC; cbase = (seg - 44) * 64; }
  else if (seg < 50) { type = T_KC; cbase = (seg - 48) * 64; }
  else { type = T_VC; cbase = (seg - 50) * 64; }

  if (type == T_QC || type == T_KC) {
    const float* gv = (type == T_QC ? p.in[22] : p.in[23]) + li * 64;
    float gj[4];
#pragma unroll
    for (int j = 0; j < 4; ++j) gj[j] = gv[j * 16 + l16];
#pragma unroll
    for (int i = 0; i < 4; ++i)
#pragma unroll
      for (int r = 0; r < 4; ++r) {
        float ss = 0.f;
#pragma unroll
        for (int j = 0; j < 4; ++j) ss += acc[i][j][r] * acc[i][j][r];
        ss = red16(ss);
        float rs = rsqrtf(ss * (1.f / 64.f) + 1e-6f);
#pragma unroll
        for (int j = 0; j < 4; ++j) acc[i][j][r] = acc[i][j][r] * rs * gj[j];
      }
  }
  if (!lat && (type == T_KA || type == T_VA || type == T_KC || type == T_VC)) {
    float* o;
    int W;
    if (type == T_KA) { o = p.out + OUT_AK; W = 512; }
    else if (type == T_VA) { o = p.out + OUT_AV; W = 512; }
    else if (type == T_KC) { o = p.out + OUT_CK; W = 128; }
    else { o = p.out + OUT_CV; W = 128; }
#pragma unroll
    for (int i = 0; i < 4; ++i)
#pragma unroll
      for (int r = 0; r < 4; ++r) {
        int t = tb + i * 16 + q4 * 4 + r;
        size_t base = ((size_t)(b * 2 + li) * 256 + t) * W + cbase;
#pragma unroll
        for (int j = 0; j < 4; ++j) o[base + j * 16 + l16] = acc[i][j][r];
      }
  }
  if (lat && (type == T_QA || type == T_KA || type == T_QC || type == T_KC)) {
#pragma unroll
    for (int i = 0; i < 4; ++i)
#pragma unroll
      for (int r = 0; r < 4; ++r) {
        int t = tb + i * 16 + q4 * 4 + r;
#pragma unroll
        for (int j = 0; j < 4; ++j) {
          float v = acc[i][j][r];
          float pv = xor1(v);
          float2 cs = rope[t * 32 + j * 8 + (l16 >> 1)];
          acc[i][j][r] = (l16 & 1) ? (pv * cs.y + v * cs.x) : (v * cs.x - pv * cs.y);
        }
      }
  }

  if (type == T_QA || type == T_KA || type == T_QC || type == T_KC) {
    u16* dst;
    int W;
    size_t rowbase;
    if (type == T_QA) { dst = (u16*)(p.ws + O_QA); W = 512; rowbase = (size_t)R0 * 512; }
    else if (type == T_QC) { dst = (u16*)(p.ws + O_QC); W = 256; rowbase = (size_t)R0 * 256; }
    else if (type == T_KA) {
      W = 512;
      if (!lat) { dst = (u16*)(p.ws + O_KACTX); rowbase = (size_t)R0 * 512; }
      else { dst = (u16*)(p.ws + O_KALAT); rowbase = ((size_t)(li * 2 + b) * 1536 + tb) * 512; }
    } else {
      W = 128;
      if (!lat) { dst = (u16*)(p.ws + O_KCCTX); rowbase = (size_t)R0 * 128; }
      else { dst = (u16*)(p.ws + O_KCLAT); rowbase = ((size_t)(li * 2 + b) * 1536 + tb) * 128; }
    }
#pragma unroll
    for (int i = 0; i < 4; ++i)
#pragma unroll
      for (int r = 0; r < 4; ++r) {
        size_t base = rowbase + (size_t)(i * 16 + q4 * 4 + r) * W + cbase;
#pragma unroll
        for (int j = 0; j < 4; ++j) dst[base + j * 16 + l16] = f2bf(acc[i][j][r]);
      }
  } else if (type == T_VA || type == T_VC) {
    u16* dst;
    int L;
    size_t hb;
    if (type == T_VA) {
      int h = cbase >> 7, dv0 = cbase & 127;
      if (!lat) { dst = (u16*)(p.ws + O_VTACTX); L = 256; hb = ((size_t)(b * 4 + h) * 128 + dv0) * 256; }
      else { dst = (u16*)(p.ws + O_VTALAT); L = 1536; hb = ((size_t)((li * 2 + b) * 4 + h) * 128 + dv0) * 1536; }
    } else {
      int n = cbase >> 6;
      if (!lat) { dst = (u16*)(p.ws + O_VTCCTX); L = 256; hb = ((size_t)(b * 2 + n) * 64) * 256; }
      else { dst = (u16*)(p.ws + O_VTCLAT); L = 1536; hb = ((size_t)((li * 2 + b) * 2 + n) * 64) * 1536; }
    }
#pragma unroll
    for (int i = 0; i < 4; ++i)
#pragma unroll
      for (int j = 0; j < 4; ++j) {
        uint2 o;
        o.x = pack2(acc[i][j][0], acc[i][j][1]);
        o.y = pack2(acc[i][j][2], acc[i][j][3]);
        *(uint2*)(dst + hb + (size_t)(j * 16 + l16) * L + tb + i * 16 + q4 * 4) = o;
      }
  } else {
    float* dst;
    if (type == T_QB) dst = (float*)(p.ws + O_HQ);
    else if (type == T_FF) dst = (float*)(p.ws + O_HGF);
    else if (type == T_FB) dst = (float*)(p.ws + O_HGB);
    else if (type == T_IB) dst = (float*)(p.ws + O_HI);
    else dst = (float*)(p.ws + O_HSG);
    float lbv[4] = {0.f, 0.f, 0.f, 0.f};
    if ((type == T_FF || type == T_FB) && li == 1) {
      const float* lg = (type == T_FF) ? p.in[19] : p.in[20];
#pragma unroll
      for (int j = 0; j < 4; ++j) {
        int c = cbase + j * 16 + l16;
        lbv[j] = 1.f / (1.f + expf(lg[c] - lg[256 + c]));
      }
    }
#pragma unroll
    for (int i = 0; i < 4; ++i)
#pragma unroll
      for (int r = 0; r < 4; ++r) {
        size_t base = (size_t)(R0 + i * 16 + q4 * 4 + r) * 256 + cbase;
#pragma unroll
        for (int j = 0; j < 4; ++j) {
          float v = acc[i][j][r];
          float o;
          if (type == T_QB || type == T_GB) o = v * __frcp_rn(1.f + __expf(-v));
          else if (type == T_IB) o = v;
          else {
            float sg = __frcp_rn(1.f + __expf(-v));
            float f = lbv[j] + (1.f - lbv[j]) * sg;
            o = __logf(fmaxf(f, 1e-6f));
          }
          dst[base + j * 16 + l16] = o;
        }
      }
  }
}

template <int EPI>
DI void gemm_phase(const P& p, const GA& g, int li, char* smem) {
  const int NT = g.N >> 7;
  const int xcd = blockIdx.x & 7, lb = blockIdx.x >> 3, nlb = gridDim.x >> 3;
  if (lb >= nlb) return;
  for (int t = lb; t < 6 * NT; t += nlb) {
    int mt = xcd * 6 + t / NT, nt = t % NT;
    gemm_tile<EPI>(p, g, li, mt * 128, nt * 128, smem);
  }
}


template <int KW, int DV>
DI void attn_gload(const u16* Kb, int kstride, const u16* VT, int L, int kb, int tid, u32x4 (&kr)[KW / 32], u32x4 (&vr)[DV / 32]) {
  constexpr int KPR = 256 / (KW / 8);
  const unsigned koff = (unsigned)(tid / (KW / 8)) * (unsigned)kstride + (unsigned)(tid % (KW / 8)) * 8u;
  const unsigned voff = (unsigned)(tid >> 3) * (unsigned)L + (unsigned)(tid & 7) * 8u;
#pragma unroll
  for (int i = 0; i < KW / 32; ++i) {
    const u16* kbp = Kb + (size_t)(kb * 64 + KPR * i) * kstride;
    kr[i] = *(const u32x4*)(kbp + koff);
  }
#pragma unroll
  for (int i = 0; i < DV / 32; ++i) {
    const u16* vbp = VT + (size_t)(32 * i) * L + kb * 64;
    vr[i] = *(const u32x4*)(vbp + voff);
  }
}
template <int KW, int DV>
DI void attn_lstore(u16* sK, u16* sV, int tid, const u32x4 (&kr)[KW / 32], const u32x4 (&vr)[DV / 32]) {
  constexpr int KS = KW + 8;
#pragma unroll
  for (int i = 0; i < KW / 32; ++i) {
    int idx = tid + 256 * i;
    int key = idx / (KW / 8), cc = idx % (KW / 8);
    *(u32x4*)(sK + key * KS + cc * 8) = kr[i];
  }
#pragma unroll
  for (int i = 0; i < DV / 32; ++i) {
    int idx = tid + 256 * i;
    int row = idx >> 3, cc = idx & 7;
    *(u32x4*)(sV + row * 72 + cc * 8) = vr[i];
  }
}

template <int KW, int DV>
DI void attn_compute(const u16* sK, const u16* sV, int kfo, int l16, int q4, const bf16x8& qf0, const bf16x8& qf1,
                     f32x4 (&o)[DV / 16], float& m, float& l) {
  constexpr int KS = KW + 8, NDT = DV / 16;
  const float c = 0.125f * LOG2E;
  f32x4 st[4];
#pragma unroll
  for (int kt = 0; kt < 4; ++kt) {
    const u16* kp = sK + (kt * 16 + l16) * KS + kfo + q4 * 8;
    bf16x8 k0 = *(const bf16x8*)kp;
    bf16x8 k1 = *(const bf16x8*)(kp + 32);
    f32x4 z = {0.f, 0.f, 0.f, 0.f};
    z = MFMA16(k0, qf0, z);
    st[kt] = MFMA16(k1, qf1, z);
  }
  float bm = st[0][0];
#pragma unroll
  for (int kt = 0; kt < 4; ++kt)
#pragma unroll
    for (int r = 0; r < 4; ++r) bm = fmaxf(bm, st[kt][r]);
  bm = fmaxf(bm, shx(bm, 16));
  bm = fmaxf(bm, shx(bm, 32));
  const float mn = fmaxf(m, bm);
  const float alpha = ex2((m - mn) * c);
  m = mn;
  float ps = 0.f;
#pragma unroll
  for (int kt = 0; kt < 4; ++kt)
#pragma unroll
    for (int r = 0; r < 4; ++r) {
      float pv = ex2((st[kt][r] - mn) * c);
      st[kt][r] = pv;
      ps += pv;
    }
  l = l * alpha + ps;
#pragma unroll
  for (int d = 0; d < NDT; ++d) {
    o[d][0] *= alpha; o[d][1] *= alpha; o[d][2] *= alpha; o[d][3] *= alpha;
  }
#pragma unroll
  for (int ks = 0; ks < 2; ++ks) {
    u32x4 pu;
    pu.x = pack2(st[2 * ks][0], st[2 * ks][1]);
    pu.y = pack2(st[2 * ks][2], st[2 * ks][3]);
    pu.z = pack2(st[2 * ks + 1][0], st[2 * ks + 1][1]);
    pu.w = pack2(st[2 * ks + 1][2], st[2 * ks + 1][3]);
    bf16x8 pf = __builtin_bit_cast(bf16x8, pu);
#pragma unroll
    for (int d = 0; d < NDT; ++d) {
      const u16* vp = sV + (d * 16 + l16) * 72 + ks * 32 + q4 * 4;
      u32x2 v0 = *(const u32x2*)vp;
      u32x2 v1 = *(const u32x2*)(vp + 16);
      u32x4 vu = {v0.x, v0.y, v1.x, v1.y};
      bf16x8 vf = __builtin_bit_cast(bf16x8, vu);
      o[d] = MFMA16(vf, pf, o[d]);
    }
  }
}

template <int KW, int DV, bool DIFF>
DI void attn_item(const u16* Q, int qstride, int qcol, int qrow0, const u16* Kb, int kstride, const u16* VT, int L,
                          int nkeys, u16* mixed, int mixcol, float lam, float postscale, const float* subg, char* smem) {
  const int tid = ltid(), lane = tid & 63, wid = tid >> 6, l16 = lane & 15, q4 = lane >> 4;
  const int qsub = wid & 1, var = wid >> 1;
  constexpr int KS = KW + 8;
  constexpr int STAGE = 64 * KS + DV * 72;
  u16* sK0 = (u16*)smem;
  u16* sV0 = sK0 + 64 * KS;
  u16* sK1 = sK0 + STAGE;
  u16* sV1 = sV0 + STAGE;
  constexpr int KPT = KW / 32, VPT = DV / 32, NDT = DV / 16;
  const int kfo = DIFF ? var * 64 : 0;

  const u16* qp = Q + (size_t)(qrow0 + qsub * 16 + l16) * qstride + qcol + var * 64 + q4 * 8;
  const bf16x8 qf0 = *(const bf16x8*)qp;
  const bf16x8 qf1 = *(const bf16x8*)(qp + 32);

  u32x4 kr0[KPT], vr0[VPT], kr1[KPT], vr1[VPT];
  f32x4 o[NDT];
#pragma unroll
  for (int d = 0; d < NDT; ++d) o[d] = f32x4{0.f, 0.f, 0.f, 0.f};
  float m = -INFINITY, l = 0.f;
  const int nkb = nkeys >> 6;
#define SB0 __builtin_amdgcn_sched_barrier(0)
  attn_gload<KW, DV>(Kb, kstride, VT, L, 0, tid, kr0, vr0);
  SB0;
  attn_gload<KW, DV>(Kb, kstride, VT, L, 1, tid, kr1, vr1);
  SB0;
  __syncthreads();
  attn_lstore<KW, DV>(sK0, sV0, tid, kr0, vr0);
  SB0;
  attn_gload<KW, DV>(Kb, kstride, VT, L, 2, tid, kr0, vr0);
  SB0;
  __syncthreads();
#pragma unroll 1
  for (int kb = 0; kb < nkb - 4; kb += 2) {
    SB0;
    attn_lstore<KW, DV>(sK1, sV1, tid, kr1, vr1);
    SB0;
    attn_gload<KW, DV>(Kb, kstride, VT, L, kb + 3, tid, kr1, vr1);
    SB0;
    attn_compute<KW, DV>(sK0, sV0, kfo, l16, q4, qf0, qf1, o, m, l);
    __syncthreads();
    SB0;
    attn_lstore<KW, DV>(sK0, sV0, tid, kr0, vr0);
    SB0;
    attn_gload<KW, DV>(Kb, kstride, VT, L, kb + 4, tid, kr0, vr0);
    SB0;
    attn_compute<KW, DV>(sK1, sV1, kfo, l16, q4, qf0, qf1, o, m, l);
    __syncthreads();
  }
  SB0;
  attn_lstore<KW, DV>(sK1, sV1, tid, kr1, vr1);
  SB0;
  attn_gload<KW, DV>(Kb, kstride, VT, L, nkb - 1, tid, kr1, vr1);
  SB0;
  attn_compute<KW, DV>(sK0, sV0, kfo, l16, q4, qf0, qf1, o, m, l);
  __syncthreads();
  SB0;
  attn_lstore<KW, DV>(sK0, sV0, tid, kr0, vr0);
  SB0;
  attn_compute<KW, DV>(sK1, sV1, kfo, l16, q4, qf0, qf1, o, m, l);
  __syncthreads();
  SB0;
  attn_lstore<KW, DV>(sK1, sV1, tid, kr1, vr1);
  SB0;
  attn_compute<KW, DV>(sK0, sV0, kfo, l16, q4, qf0, qf1, o, m, l);
  __syncthreads();
  SB0;
  attn_compute<KW, DV>(sK1, sV1, kfo, l16, q4, qf0, qf1, o, m, l);
  __syncthreads();
#undef SB0
  l += shx(l, 16);
  l += shx(l, 32);
  const float inv = 1.f / l;
  const int row = qrow0 + qsub * 16 + l16;
  if constexpr (DIFF) {
    __syncthreads();
    float* sO = (float*)smem;
    if (var == 1) {
#pragma unroll
      for (int d = 0; d < NDT; ++d)
        *(float4*)(sO + (qsub * 16 + l16) * 132 + d * 16 + q4 * 4) =
            make_float4(o[d][0] * inv, o[d][1] * inv, o[d][2] * inv, o[d][3] * inv);
    }
    __syncthreads();
    if (var == 0) {
      float ss = 0.f;
#pragma unroll
      for (int d = 0; d < NDT; ++d) {
        float4 o1 = *(const float4*)(sO + (qsub * 16 + l16) * 132 + d * 16 + q4 * 4);
        o[d][0] = o[d][0] * inv - lam * o1.x;
        o[d][1] = o[d][1] * inv - lam * o1.y;
        o[d][2] = o[d][2] * inv - lam * o1.z;
        o[d][3] = o[d][3] * inv - lam * o1.w;
        ss += o[d][0] * o[d][0] + o[d][1] * o[d][1] + o[d][2] * o[d][2] + o[d][3] * o[d][3];
      }
      ss += shx(ss, 16);
      ss += shx(ss, 32);
      const float rs = rsqrtf(ss * (1.f / 128.f) + 1e-6f) * postscale;
#pragma unroll
      for (int d = 0; d < NDT; ++d) {
        float4 gg = *(const float4*)(subg + d * 16 + q4 * 4);
        uint2 ov;
        ov.x = pack2(o[d][0] * rs * gg.x, o[d][1] * rs * gg.y);
        ov.y = pack2(o[d][2] * rs * gg.z, o[d][3] * rs * gg.w);
        *(uint2*)(mixed + (size_t)row * 1024 + mixcol + d * 16 + q4 * 4) = ov;
      }
    }
  } else {
#pragma unroll
    for (int d = 0; d < NDT; ++d) {
      uint2 ov;
      ov.x = pack2(o[d][0] * inv, o[d][1] * inv);
      ov.y = pack2(o[d][2] * inv, o[d][3] * inv);
      *(uint2*)(mixed + (size_t)row * 1024 + mixcol + var * 64 + d * 16 + q4 * 4) = ov;
    }
  }
}

DI void attnA_item(const P& p, int li, int it, char* smem) {
  const int lane = ltid() & 63;
  float d1 = p.in[14][li * 64 + lane] * p.in[15][li * 64 + lane];
  float d2 = p.in[16][li * 64 + lane] * p.in[17][li * 64 + lane];
#pragma unroll
  for (int s = 1; s < 64; s <<= 1) { d1 += shx(d1, s); d2 += shx(d2, s); }
  const float lam_init = 0.8f - 0.6f * expf(-0.3f * (float)li);
  const float lam = expf(d1) - expf(d2) + lam_init;
  const u16* QA = (const u16*)(p.ws + O_QA);
  u16* mixed = (u16*)(p.ws + O_MIXED);
  const float* subg = p.in[18] + li * 128;
  int qrow0, L;
  const u16 *Kb, *VT;
  int h;
  if (it < 256) {
    int b = it >> 7, qb = it & 31;
    h = (it >> 5) & 3;
    Kb = (const u16*)(p.ws + O_KALAT) + (size_t)(li * 2 + b) * 1536 * 512 + h * 128;
    VT = (const u16*)(p.ws + O_VTALAT) + (size_t)((li * 2 + b) * 4 + h) * 128 * 1536;
    qrow0 = NCTX + b * 1024 + qb * 32;
    L = 1536;
  } else {
    it -= 256;
    int b = it >> 5, qb = it & 7;
    h = (it >> 3) & 3;
    Kb = (const u16*)(p.ws + O_KACTX) + (size_t)b * 256 * 512 + h * 128;
    VT = (const u16*)(p.ws + O_VTACTX) + (size_t)(b * 4 + h) * 128 * 256;
    qrow0 = b * 256 + qb * 32;
    L = 256;
  }
  attn_item<128, 128, true>(QA, 512, h * 128, qrow0, Kb, 512, VT, L, L, mixed, h * 128, lam, 1.f - lam_init, subg, smem);
}
DI void attnC_item(const P& p, int li, int it, char* smem) {
  const u16* QC = (const u16*)(p.ws + O_QC);
  u16* mixed = (u16*)(p.ws + O_MIXED);
  int qrow0, L, n;
  const u16 *Kb, *VT;
  if (it < 128) {
    int b = it >> 6, qb = it & 31;
    n = (it >> 5) & 1;
    Kb = (const u16*)(p.ws + O_KCLAT) + (size_t)(li * 2 + b) * 1536 * 128 + n * 64;
    VT = (const u16*)(p.ws + O_VTCLAT) + (size_t)((li * 2 + b) * 2 + n) * 64 * 1536;
    qrow0 = NCTX + b * 1024 + qb * 32;
    L = 1536;
  } else {
    it -= 128;
    int b = it >> 4, qb = it & 7;
    n = (it >> 3) & 1;
    Kb = (const u16*)(p.ws + O_KCCTX) + (size_t)b * 256 * 128 + n * 64;
    VT = (const u16*)(p.ws + O_VTCCTX) + (size_t)(b * 2 + n) * 64 * 256;
    qrow0 = b * 256 + qb * 32;
    L = 256;
  }
  attn_item<64, 64, false>(QC, 256, n * 128, qrow0, Kb, 128, VT, L, L, mixed, 768 + n * 128, 0.f, 1.f, nullptr, smem);
}

DI void h1_item(const P& p, int item, char* smem) {
  const int tid = ltid(), lane = tid & 63, w = tid >> 6, l16 = lane & 15, q4 = lane >> 4;
  const int dir = item & 1, h = (item >> 1) & 3, tc = item >> 3;
  const int row0 = tc * 64;
  float* sQ = (float*)smem;
  float* sB = sQ + 64 * 68;
  float* sK = sB + 64 * 68;
  u16* sVT = (u16*)(sK + 64 * 68);
  float* sTot = (float*)(sVT + 64 * 72);
  const float* HQ = (const float*)(p.ws + O_HQ);
  const float* HG = (const float*)(p.ws + (dir ? O_HGB : O_HGF));
  const float* HI = (const float*)(p.ws + O_HI);
  float* OI = (float*)(p.ws + O_OI) + (size_t)dir * NTOK * 256;
  u16* QE = (u16*)(p.ws + O_QE) + (size_t)dir * NTOK * 256;
  float* KV = (float*)(p.ws + O_KV) + (size_t)item * 4096;
  float* DEC = (float*)(p.ws + O_DEC) + (size_t)item * 64;

  __syncthreads();
#pragma unroll
  for (int i = 0; i < 4; ++i) {
    int idx = tid + 256 * i;
    int lo = idx >> 4, c4 = idx & 15;
    int row = dir ? row0 + 63 - lo : row0 + lo;
    size_t off = (size_t)row * 256 + h * 64 + c4 * 4;
    *(float4*)(sQ + lo * 68 + c4 * 4) = *(const float4*)(HQ + off);
    *(float4*)(sB + lo * 68 + c4 * 4) = *(const float4*)(HG + off);
    float4 v = *(const float4*)(HI + off);
    sVT[(c4 * 4 + 0) * 72 + lo] = f2bf(v.x);
    sVT[(c4 * 4 + 1) * 72 + lo] = f2bf(v.y);
    sVT[(c4 * 4 + 2) * 72 + lo] = f2bf(v.z);
    sVT[(c4 * 4 + 3) * 72 + lo] = f2bf(v.w);
  }
  __syncthreads();
  {
    const int k = tid & 63, part = tid >> 6;
    float run = 0.f;
#pragma unroll 4
    for (int e = 0; e < 16; ++e) {
      int i = part * 16 + e;
      float g = sB[i * 68 + k];
      sK[i * 68 + k] = 1.f - ex2(g * LOG2E);
      run += g * LOG2E;
      sB[i * 68 + k] = run;
    }
    sTot[part * 64 + k] = run;
    __syncthreads();
    float add = 0.f;
    for (int pp = 0; pp < part; ++pp) add += sTot[pp * 64 + k];
    if (part > 0)
      for (int e = 0; e < 16; ++e) sB[(part * 16 + e) * 68 + k] += add;
  }
  __syncthreads();
#pragma unroll
  for (int i = 0; i < 4; ++i) {
    int idx = tid + 256 * i;
    int lo = idx >> 4, c4 = idx & 15;
    int row = dir ? row0 + 63 - lo : row0 + lo;
    f32x4 q = *(const f32x4*)(sQ + lo * 68 + c4 * 4);
    f32x4 bb = *(const f32x4*)(sB + lo * 68 + c4 * 4);
    u32x2 o;
    o.x = pack2(q.x * ex2(bb.x), q.y * ex2(bb.y));
    o.y = pack2(q.z * ex2(bb.z), q.w * ex2(bb.w));
    *(u32x2*)(QE + (size_t)row * 256 + h * 64 + c4 * 4) = o;
  }
  {
    const int I = w;
    bf16x8 qs[2];
    f32x4 rr[2][2];
#pragma unroll
    for (int s = 0; s < 2; ++s) {
      const int kk0 = s * 32 + q4 * 8;
      if (I > 0) {
        rr[s][0] = *(const f32x4*)(sB + (16 * I - 1) * 68 + kk0);
        rr[s][1] = *(const f32x4*)(sB + (16 * I - 1) * 68 + kk0 + 4);
      } else {
        rr[s][0] = f32x4{0.f, 0.f, 0.f, 0.f};
        rr[s][1] = rr[s][0];
      }
      const float* qr = sQ + (16 * I + l16) * 68 + kk0;
      const float* br = sB + (16 * I + l16) * 68 + kk0;
      f32x4 q0 = *(const f32x4*)qr, q1 = *(const f32x4*)(qr + 4);
      f32x4 b0 = *(const f32x4*)br, b1 = *(const f32x4*)(br + 4);
      u32x4 pu;
      pu.x = pack2(q0.x * ex2(b0.x - rr[s][0].x), q0.y * ex2(b0.y - rr[s][0].y));
      pu.y = pack2(q0.z * ex2(b0.z - rr[s][0].z), q0.w * ex2(b0.w - rr[s][0].w));
      pu.z = pack2(q1.x * ex2(b1.x - rr[s][1].x), q1.y * ex2(b1.y - rr[s][1].y));
      pu.w = pack2(q1.z * ex2(b1.z - rr[s][1].z), q1.w * ex2(b1.w - rr[s][1].w));
      qs[s] = __builtin_bit_cast(bf16x8, pu);
    }
    f32x4 at[4];
#pragma unroll
    for (int J = 0; J < 4; ++J) {
      at[J] = f32x4{0.f, 0.f, 0.f, 0.f};
      if (J <= I) {
#pragma unroll
        for (int s = 0; s < 2; ++s) {
          const int kk0 = s * 32 + q4 * 8;
          const float* kr = sK + (16 * J + l16) * 68 + kk0;
          const float* br = sB + (16 * J + l16) * 68 + kk0;
          f32x4 k0 = *(const f32x4*)kr, k1 = *(const f32x4*)(kr + 4);
          f32x4 b0 = *(const f32x4*)br, b1 = *(const f32x4*)(br + 4);
          u32x4 pu;
          pu.x = pack2(k0.x * ex2(fminf(rr[s][0].x - b0.x, 100.f)), k0.y * ex2(fminf(rr[s][0].y - b0.y, 100.f)));
          pu.y = pack2(k0.z * ex2(fminf(rr[s][0].z - b0.z, 100.f)), k0.w * ex2(fminf(rr[s][0].w - b0.w, 100.f)));
          pu.z = pack2(k1.x * ex2(fminf(rr[s][1].x - b1.x, 100.f)), k1.y * ex2(fminf(rr[s][1].y - b1.y, 100.f)));
          pu.w = pack2(k1.z * ex2(fminf(rr[s][1].z - b1.z, 100.f)), k1.w * ex2(fminf(rr[s][1].w - b1.w, 100.f)));
          bf16x8 kf = __builtin_bit_cast(bf16x8, pu);
          at[J] = MFMA16(kf, qs[s], at[J]);
        }
        if (J == I) {
#pragma unroll
          for (int r = 0; r < 4; ++r)
            if (q4 * 4 + r > l16) at[J][r] = 0.f;
        }
      }
    }
    f32x4 oc[4];
#pragma unroll
    for (int vt = 0; vt < 4; ++vt) oc[vt] = f32x4{0.f, 0.f, 0.f, 0.f};
#pragma unroll
    for (int ks = 0; ks < 2; ++ks) {
      if (2 * ks <= I) {
        u32x4 pu;
        pu.x = pack2(at[2 * ks][0], at[2 * ks][1]);
        pu.y = pack2(at[2 * ks][2], at[2 * ks][3]);
        pu.z = pack2(at[2 * ks + 1][0], at[2 * ks + 1][1]);
        pu.w = pack2(at[2 * ks + 1][2], at[2 * ks + 1][3]);
        bf16x8 pf = __builtin_bit_cast(bf16x8, pu);
#pragma unroll
        for (int vt = 0; vt < 4; ++vt) {
          const u16* vp = sVT + (vt * 16 + l16) * 72 + ks * 32 + q4 * 4;
          u32x2 v0 = *(const u32x2*)vp;
          u32x2 v1 = *(const u32x2*)(vp + 16);
          u32x4 vu = {v0.x, v0.y, v1.x, v1.y};
          oc[vt] = MFMA16(__builtin_bit_cast(bf16x8, vu), pf, oc[vt]);
        }
      }
    }
    {
      const int t = 16 * I + l16;
      const int row = dir ? row0 + 63 - t : row0 + t;
#pragma unroll
      for (int vt = 0; vt < 4; ++vt) *(f32x4*)(OI + (size_t)row * 256 + h * 64 + vt * 16 + q4 * 4) = oc[vt];
    }
  }
  {
    const int k = 16 * w + l16;
    const float bend = sB[63 * 68 + k];
    f32x4 kc[4];
#pragma unroll
    for (int vt = 0; vt < 4; ++vt) kc[vt] = f32x4{0.f, 0.f, 0.f, 0.f};
#pragma unroll
    for (int ks = 0; ks < 2; ++ks) {
      float kd[8];
#pragma unroll
      for (int j = 0; j < 8; ++j) {
        const int s = ks * 32 + q4 * 8 + j;
        kd[j] = sK[s * 68 + k] * ex2(bend - sB[s * 68 + k]);
      }
      u32x4 pu;
      pu.x = pack2(kd[0], kd[1]);
      pu.y = pack2(kd[2], kd[3]);
      pu.z = pack2(kd[4], kd[5]);
      pu.w = pack2(kd[6], kd[7]);
      bf16x8 af = __builtin_bit_cast(bf16x8, pu);
#pragma unroll
      for (int vt = 0; vt < 4; ++vt) {
        bf16x8 vf = *(const bf16x8*)(sVT + (vt * 16 + l16) * 72 + ks * 32 + q4 * 8);
        kc[vt] = MFMA16(af, vf, kc[vt]);
      }
    }
#pragma unroll
    for (int vt = 0; vt < 4; ++vt)
#pragma unroll
      for (int r = 0; r < 4; ++r) KV[(16 * w + q4 * 4 + r) * 64 + vt * 16 + l16] = kc[vt][r];
    if (q4 == 0) DEC[k] = ex2(bend);
  }
}

DI void h2_item(const P& p, int li, int item, char* smem) {
  const int tid = ltid(), ty = tid >> 4, tx = tid & 15;
  const int lane = tid & 63, w = tid >> 6, l16 = lane & 15, q4 = lane >> 4;
  const int h = item & 3, tc = item >> 2, row0 = tc * 64;
  const bool lat = tc >= 64;
  int seq, cl, nc;
  if (!lat) { seq = tc >> 2; cl = tc & 3; nc = 4; } else { seq = (tc - 64) >> 4; cl = (tc - 64) & 15; nc = 16; }
  const int tcbase = tc - cl;
  u16* sST = (u16*)smem;
  const float* KVb = (const float*)(p.ws + O_KV);
  const float* DECb = (const float*)(p.ws + O_DEC);
  __syncthreads();
#pragma unroll 1
  for (int dir = 0; dir < 2; ++dir) {
    float4 S[4];
#pragma unroll
    for (int a = 0; a < 4; ++a) {
      if (lat) S[a] = *(const float4*)(p.in[6 + dir] + ((size_t)((seq * 2 + li) * 4 + h) * 64 + ty + 16 * a) * 64 + tx * 4);
      else S[a] = make_float4(0.f, 0.f, 0.f, 0.f);
    }
    const int nprev = dir == 0 ? cl : nc - 1 - cl;
#pragma unroll 1
    for (int j = 0; j < nprev; ++j) {
      int tcj = tcbase + (dir == 0 ? j : nc - 1 - j);
      size_t itj = (size_t)((tcj * 4 + h) * 2 + dir);
#pragma unroll
      for (int a = 0; a < 4; ++a) {
        int k = ty + 16 * a;
        float dcy = DECb[itj * 64 + k];
        float4 kv = *(const float4*)(KVb + itj * 4096 + k * 64 + tx * 4);
        S[a].x = dcy * S[a].x + kv.x; S[a].y = dcy * S[a].y + kv.y; S[a].z = dcy * S[a].z + kv.z; S[a].w = dcy * S[a].w + kv.w;
      }
    }
    if (!lat && nprev == nc - 1) {
      size_t itj = (size_t)((tc * 4 + h) * 2 + dir);
      float* so = p.out + (dir == 0 ? OUT_SF : OUT_SB) + (size_t)((seq * 2 + li) * 4 + h) * 4096;
#pragma unroll
      for (int a = 0; a < 4; ++a) {
        int k = ty + 16 * a;
        float dcy = DECb[itj * 64 + k];
        float4 kv = *(const float4*)(KVb + itj * 4096 + k * 64 + tx * 4);
        *(float4*)(so + k * 64 + tx * 4) = make_float4(dcy * S[a].x + kv.x, dcy * S[a].y + kv.y, dcy * S[a].z + kv.z, dcy * S[a].w + kv.w);
      }
    }
    u16* st = sST + dir * 64 * 72;
#pragma unroll
    for (int a = 0; a < 4; ++a) {
      int k = ty + 16 * a;
      st[(tx * 4 + 0) * 72 + k] = f2bf(S[a].x);
      st[(tx * 4 + 1) * 72 + k] = f2bf(S[a].y);
      st[(tx * 4 + 2) * 72 + k] = f2bf(S[a].z);
      st[(tx * 4 + 3) * 72 + k] = f2bf(S[a].w);
    }
  }
  __syncthreads();
  f32x4 oc[4];
#pragma unroll
  for (int vt = 0; vt < 4; ++vt) oc[vt] = f32x4{0.f, 0.f, 0.f, 0.f};
#pragma unroll
  for (int dir = 0; dir < 2; ++dir) {
    const u16* QE = (const u16*)(p.ws + O_QE) + (size_t)dir * NTOK * 256 + (size_t)(row0 + 16 * w + l16) * 256 + h * 64 + q4 * 8;
    const u16* st = sST + dir * 64 * 72;
#pragma unroll
    for (int ks = 0; ks < 2; ++ks) {
      bf16x8 af = *(const bf16x8*)(QE + ks * 32);
#pragma unroll
      for (int vt = 0; vt < 4; ++vt) {
        bf16x8 bf = *(const bf16x8*)(st + (vt * 16 + l16) * 72 + ks * 32 + q4 * 8);
        oc[vt] = MFMA16(af, bf, oc[vt]);
      }
    }
  }
  const float* OI0 = (const float*)(p.ws + O_OI);
  const float* OI1 = OI0 + (size_t)NTOK * 256;
  const float* HSG = (const float*)(p.ws + O_HSG);
  u16* mixed = (u16*)(p.ws + O_MIXED);
  float gn[4];
#pragma unroll
  for (int vt = 0; vt < 4; ++vt) gn[vt] = p.in[21][li * 64 + vt * 16 + l16];
#pragma unroll
  for (int r = 0; r < 4; ++r) {
    const int row = row0 + 16 * w + q4 * 4 + r;
    const size_t off = (size_t)row * 256 + h * 64 + l16;
    float val[4];
    float ss = 0.f;
#pragma unroll
    for (int vt = 0; vt < 4; ++vt) {
      val[vt] = oc[vt][r] + OI0[off + vt * 16] + OI1[off + vt * 16];
      ss += val[vt] * val[vt];
    }
    ss = red16(ss);
    const float rs = rsqrtf(ss * (1.f / 64.f) + 1e-6f);
#pragma unroll
    for (int vt = 0; vt < 4; ++vt)
      mixed[(size_t)row * 1024 + 512 + h * 64 + vt * 16 + l16] = f2bf(val[vt] * rs * gn[vt] * HSG[off + vt * 16]);
  }
}

DI void ln_apply(const P& p, const float* lo, const float* hi, const float* stats, const float* lng, const float* lnb,
                 const float* mods, int sc_off, int sh_off) {
  const int lane = ltid() & 63, wid = ltid() >> 6;
  u16* dst = (u16*)(p.ws + O_ABF);
  for (int it = blockIdx.x; it < NTOK / 4; it += gridDim.x) {
    const int row = it * 4 + wid;
    float mu = 0.f, rs = 1.f;
    if (stats != nullptr) {
      float s1 = 0.f, s2 = 0.f;
      if (lane < 16) {
        float2 v = *(const float2*)(stats + (size_t)row * 32 + lane * 2);
        s1 = v.x;
        s2 = v.y;
      }
#pragma unroll
      for (int s = 1; s < 16; s <<= 1) { s1 += shx(s1, s); s2 += shx(s2, s); }
      s1 = __shfl(s1, 0, 64);
      s2 = __shfl(s2, 0, 64);
      mu = s1 * (1.f / 1024.f);
      rs = rsqrtf(fmaxf(s2 * (1.f / 1024.f) - mu * mu, 0.f) + 1e-6f);
    }
    const float* x = row < NCTX ? lo + (size_t)row * 1024 : hi + (size_t)(row - NCTX) * 1024;
    const int rtype = row < NCTX ? 0 : 1 + ((row - NCTX) >> 10);
    const float* mv = mods + rtype * 6144;
#pragma unroll
    for (int i = 0; i < 4; ++i) {
      const int c = (lane + 64 * i) * 4;
      f32x4 v = *(const f32x4*)(x + c);
      f32x4 sc = *(const f32x4*)(mv + sc_off + c) + 1.f;
      f32x4 sh = *(const f32x4*)(mv + sh_off + c);
      if (stats != nullptr) {
        f32x4 gg = *(const f32x4*)(lng + c);
        f32x4 bb = *(const f32x4*)(lnb + c);
        v = (v - mu) * rs * gg + bb;
      }
      v = v * sc + sh;
      u32x2 o;
      o.x = pack2(v.x, v.y);
      o.y = pack2(v.z, v.w);
      *(u32x2*)(dst + (size_t)row * 1024 + c) = o;
    }
  }
}

DI void final_ln(const P& p) {
  const int lane = ltid() & 63, wid = ltid() >> 6;
  const float* X = (const float*)(p.ws + O_XPRE2);
  const float* ST = (const float*)(p.ws + O_ST2);
  const float* g = p.in[26] + 1024;
  const float* bb = p.in[27] + 1024;
  for (int it = blockIdx.x; it < NTOK / 4; it += gridDim.x) {
    int row = it * 4 + wid;
    float s1 = 0.f, s2 = 0.f;
    if (lane < 16) {
      float2 v = *(const float2*)(ST + (size_t)row * 32 + lane * 2);
      s1 = v.x;
      s2 = v.y;
    }
#pragma unroll
    for (int s = 1; s < 16; s <<= 1) { s1 += shx(s1, s); s2 += shx(s2, s); }
    s1 = __shfl(s1, 0, 64);
    s2 = __shfl(s2, 0, 64);
    float mu = s1 * (1.f / 1024.f);
    float rs = rsqrtf(fmaxf(s2 * (1.f / 1024.f) - mu * mu, 0.f) + 1e-6f);
    float* out = p.out + (row < NCTX ? OUT_YP + (size_t)row * 1024 : OUT_YS + (size_t)(row - NCTX) * 1024);
#pragma unroll
    for (int i = 0; i < 4; ++i) {
      int c = (lane + 64 * i) * 4;
      float4 x = *(const float4*)(X + (size_t)row * 1024 + c);
      float4 gg = *(const float4*)(g + c);
      float4 b4 = *(const float4*)(bb + c);
      *(float4*)(out + c) = make_float4((x.x - mu) * rs * gg.x + b4.x, (x.y - mu) * rs * gg.y + b4.y,
                                         (x.z - mu) * rs * gg.z + b4.z, (x.w - mu) * rs * gg.w + b4.w);
    }
  }
}

DI void run_phase(const P& p, int ph, char* smem, int sub = 0) {
  if (ph == 0) { phase0(p, smem); return; }
  if (ph == NPHASE - 1) { final_ln(p); return; }
  const int li = (ph - 1) >> 3, s = (ph - 1) & 7;
  float* XPRE1 = (float*)(p.ws + O_XPRE1);
  float* XPRE2 = (float*)(p.ws + O_XPRE2);
  float* ST1 = (float*)(p.ws + O_ST1);
  float* ST2 = (float*)(p.ws + O_ST2);
  GA g;
  g.mods = (const float*)(p.ws + O_MODS) + li * 3 * 6144;
  g.a16 = (const u16*)(p.ws + O_ABF); g.xout = nullptr; g.sout = nullptr; g.hid = nullptr;
  g.alo = nullptr; g.ahi = nullptr; g.stats = nullptr; g.lng = nullptr; g.lnb = nullptr; g.sc_off = 0; g.sh_off = 0;
  const float* xin_lo = li == 0 ? p.in[0] : XPRE2;
  const float* xin_hi = li == 0 ? p.in[1] : XPRE2 + (size_t)NCTX * 1024;
  const float* xin_st = li == 0 ? nullptr : ST2;
  const float* xin_g = p.in[26] + (li == 0 ? 0 : (li - 1) * 1024);
  const float* xin_b = p.in[27] + (li == 0 ? 0 : (li - 1) * 1024);
  if (s == 0) {
    ln_apply(p, xin_lo, xin_hi, xin_st, xin_g, xin_b, g.mods, 1024, 0);
  } else if (s == 1) {
    g.bt = (const u16*)(p.ws + O_WTIN) + (size_t)li * NIN * D; g.K = D; g.N = NIN;
    gemm_phase<0>(p, g, li, smem);
  } else if (s == 2) {
    const int it_lo = sub == 2 ? 256 : (sub == 3 ? 1024 : 0), it_hi = sub == 1 ? 256 : (sub == 2 ? 1024 : 1536);
    for (int it = it_lo + blockIdx.x; it < it_hi; it += gridDim.x) {
      if (it >= 256 && it < 1024) h1_item(p, it - 256, smem);
      else attnA_item(p, li, it < 256 ? it : it - 768, smem);
    }
  } else if (s == 3) {
    for (int it = blockIdx.x; it < 384 + 384; it += gridDim.x) {
      if (it >= 128 && it < 512) h2_item(p, li, it - 128, smem);
      else attnC_item(p, li, it < 128 ? it : it - 384, smem);
    }
  } else if (s == 4) {
    g.alo = xin_lo; g.ahi = xin_hi; g.stats = xin_st; g.lng = xin_g; g.lnb = xin_b;
    g.sc_off = 2048;
    g.a16 = (const u16*)(p.ws + O_MIXED);
    g.bt = (const u16*)(p.ws + O_WTOUT) + (size_t)li * D * D; g.K = D; g.N = D;
    g.xout = XPRE1; g.sout = ST1;
    gemm_phase<1>(p, g, li, smem);
  } else if (s == 5) {
    ln_apply(p, XPRE1, XPRE1 + (size_t)NCTX * 1024, ST1, p.in[24] + li * 1024, p.in[25] + li * 1024, g.mods, 4096, 3072);
  } else if (s == 6) {
    g.bt = (const u16*)(p.ws + O_WTFF1) + (size_t)li * DFF * D; g.K = D; g.N = DFF;
    g.hid = (u16*)(p.ws + O_HID);
    gemm_phase<2>(p, g, li, smem);
  } else {
    g.alo = XPRE1; g.ahi = XPRE1 + (size_t)NCTX * 1024; g.stats = ST1; g.lng = p.in[24] + li * 1024; g.lnb = p.in[25] + li * 1024;
    g.sc_off = 5120;
    g.a16 = (const u16*)(p.ws + O_HID);
    g.bt = (const u16*)(p.ws + O_WTFF2) + (size_t)li * D * DFF; g.K = DFF; g.N = D;
    g.xout = XPRE2; g.sout = ST2;
    gemm_phase<1>(p, g, li, smem);
  }
}

#define XB_TMO      128
#define XB_XCNT(j)  (256  + 64 * (j))
#define XB_XSUB(j)  (1280 + 64 * (j))
#define XB_XGEN(j)  (2304 + 64 * (j))
#define XB_TOP      3328
#define XB_TOPGEN   3392
#define XCD_BAR_WORDS 3456
#define XB_SPIN_CAP (1u << 20)
#define LAS __attribute__((address_space(3)))
DI unsigned xb_ld(unsigned* p) { return __hip_atomic_load(p, __ATOMIC_RELAXED, __HIP_MEMORY_SCOPE_AGENT); }
DI unsigned xb_add(unsigned* p, unsigned v) { return __hip_atomic_fetch_add(p, v, __ATOMIC_RELAXED, __HIP_MEMORY_SCOPE_AGENT); }
DI unsigned xb_xcc_id() { return (unsigned)__builtin_amdgcn_s_getreg((3 << 11) | 20) & 0xFu; }
#define XB_SPIN(cond, bar) do { unsigned _sp = 0; while (cond) { __builtin_amdgcn_s_sleep(1); \
    if ((++_sp & 255u) == 0u) { if (xb_ld(&(bar)[XB_TMO])) break; if (_sp > XB_SPIN_CAP) { atomicAdd(&(bar)[XB_TMO], 1u); break; } } } } while (0)
struct XcdBarrier { unsigned* bar; unsigned x; volatile LAS unsigned* st; };
DI XcdBarrier xcd_barrier_post(unsigned* bar, volatile LAS unsigned* st) {
  XcdBarrier b; b.bar = bar; b.x = xb_xcc_id(); b.st = st;
  if (threadIdx.x == 0) (void)xb_add(&bar[XB_XCNT(b.x)], 1u);
  return b;
}
DI void xcd_barrier_complete(unsigned* bar, unsigned x, unsigned& nloc, unsigned& nx) {
  const unsigned G = gridDim.x * gridDim.y * gridDim.z;
  unsigned sum, cnt, mine, sp = 0u;
  for (;;) {
    sum = 0u; cnt = 0u; mine = 0u;
#pragma unroll
    for (unsigned j = 0; j < 16; ++j) { const unsigned c = xb_ld(&bar[XB_XCNT(j)]); sum += c; cnt += (c > 0u) ? 1u : 0u; mine = (j == x) ? c : mine; }
    if (sum == G) break;
    __builtin_amdgcn_s_sleep(1);
    if ((++sp & 255u) == 0u) { if (xb_ld(&bar[XB_TMO])) break; if (sp > XB_SPIN_CAP) { atomicAdd(&bar[XB_TMO], 1u); break; } }
  }
  nloc = mine > 0u ? mine : 1u; nx = cnt > 0u ? cnt : 1u;
}
DI void xcd_barrier(const XcdBarrier& b) {
  asm volatile("s_waitcnt vmcnt(0)" ::: "memory");
  __syncthreads();
  if (threadIdx.x == 0) {
    unsigned* bar = b.bar;
    __builtin_amdgcn_s_waitcnt(0);
    unsigned nloc = b.st[0], nx = b.st[1];
    if (nloc == 0u) { xcd_barrier_complete(bar, b.x, nloc, nx); b.st[0] = nloc; b.st[1] = nx; }
    const unsigned old = xb_add(&bar[XB_XSUB(b.x)], 1u);
    const unsigned gen = old / nloc;
    if (old + 1u == (gen + 1u) * nloc) {
      __builtin_amdgcn_fence(__ATOMIC_RELEASE, "agent");
      asm volatile("s_waitcnt vmcnt(0)" ::: "memory");
      const unsigned og = xb_add(&bar[XB_TOP], 1u);
      const unsigned tg = og / nx;
      if (og + 1u == (tg + 1u) * nx) xb_add(&bar[XB_TOPGEN], 1u);
      else XB_SPIN(xb_ld(&bar[XB_TOPGEN]) == tg, bar);
      __builtin_amdgcn_fence(__ATOMIC_ACQUIRE, "agent");
      xb_add(&bar[XB_XGEN(b.x)], 1u);
      asm volatile("s_waitcnt vmcnt(0)" ::: "memory");
    } else {
      XB_SPIN(xb_ld(&bar[XB_XGEN(b.x)]) == gen, bar);
      __builtin_amdgcn_fence(__ATOMIC_ACQUIRE, "agent");
      asm volatile("s_waitcnt vmcnt(0)" ::: "memory");
    }
  }
  __syncthreads();
}
constexpr size_t O_BAR = O_END1;
static_assert(O_BAR + XCD_BAR_WORDS * 4 <= (size_t)256 * 1024 * 1024, "barrier words must fit");

#if !MULTI_LAUNCH
__global__ void __launch_bounds__(256, 2) mega_kernel(P p) {
  extern __shared__ __attribute__((aligned(16))) char smem[];
  cg::grid_group grid = cg::this_grid();
  if (p.ws == nullptr) grid.sync();
  if (threadIdx.x == 0) *(uint4*)(smem + LDS_BYTES - 16) = make_uint4(0u, 0u, 0u, 0u);
  __syncthreads();
  XcdBarrier xb = xcd_barrier_post((unsigned*)(p.ws + O_BAR), (volatile LAS unsigned*)(smem + LDS_BYTES - 16));
  run_phase(p, 0, smem); xcd_barrier(xb);
  run_phase(p, 1, smem); xcd_barrier(xb);
  run_phase(p, 2, smem); xcd_barrier(xb);
  run_phase(p, 3, smem); xcd_barrier(xb);
  run_phase(p, 4, smem); xcd_barrier(xb);
  run_phase(p, 5, smem); xcd_barrier(xb);
  run_phase(p, 6, smem); xcd_barrier(xb);
  run_phase(p, 7, smem); xcd_barrier(xb);
  run_phase(p, 8, smem); xcd_barrier(xb);
  run_phase(p, 9, smem); xcd_barrier(xb);
  run_phase(p, 10, smem); xcd_barrier(xb);
  run_phase(p, 11, smem); xcd_barrier(xb);
  run_phase(p, 12, smem); xcd_barrier(xb);
  run_phase(p, 13, smem); xcd_barrier(xb);
  run_phase(p, 14, smem); xcd_barrier(xb);
  run_phase(p, 15, smem); xcd_barrier(xb);
  run_phase(p, 16, smem); xcd_barrier(xb);
  run_phase(p, 17, smem);
}
#define MAIN_KERNEL mega_kernel
#else
__global__ void __launch_bounds__(256, 2) phase_kernel(P p, int ph, int sub) {
  extern __shared__ __attribute__((aligned(16))) char smem[];
  run_phase(p, ph, smem, sub);
}
#define MAIN_KERNEL phase_kernel
#endif

extern "C" void kernel_launch(void* const* d_in, const int* in_sizes, int n_in, void* d_out, int out_size, void* d_ws,
                              size_t ws_size, hipStream_t stream) {
  static int grid_blocks = 0;
  if (!grid_blocks) {
    int dev = 0, cus = 0, per_cu = 0;
    (void)hipGetDevice(&dev);
    (void)hipDeviceGetAttribute(&cus, hipDeviceAttributeMultiprocessorCount, dev);
    (void)hipFuncSetAttribute((const void*)MAIN_KERNEL, hipFuncAttributeMaxDynamicSharedMemorySize, LDS_BYTES);
    (void)hipOccupancyMaxActiveBlocksPerMultiprocessor(&per_cu, MAIN_KERNEL, 256, LDS_BYTES);
    if (per_cu > 2) per_cu = 2;
    if (per_cu < 1) per_cu = 1;
    grid_blocks = cus * per_cu;
  }
  P p{};
  for (int i = 0; i < 30; ++i) p.in[i] = (const float*)d_in[i];
  p.out = (float*)d_out;
  p.ws = (char*)d_ws;
#if MULTI_LAUNCH
  for (int ph = 0; ph < NPHASE; ++ph) {
    phase_kernel<<<dim3(grid_blocks), dim3(256), LDS_BYTES, stream>>>(p, ph, 0);
#ifdef DUP_MASK
    int bit = (ph == 0) ? 8 : (ph == NPHASE - 1 ? 9 : (ph - 1) & 7);
    if ((DUP_MASK >> bit) & 1) phase_kernel<<<dim3(grid_blocks), dim3(256), LDS_BYTES, stream>>>(p, ph, DUP_SUB);
#endif
  }
#else
  (void)hipMemsetAsync((char*)d_ws + O_BAR, 0, XCD_BAR_WORDS * 4, stream);
  void* args[] = {&p};
  hipError_t e = hipLaunchCooperativeKernel((void*)mega_kernel, dim3(grid_blocks), dim3(256), args, LDS_BYTES, stream);
  if (e != hipSuccess) fprintf(stderr, "cooperative launch failed: %s (grid %d)\n", hipGetErrorString(e), grid_blocks);
#endif
}
```

```cpp
#include <hip/hip_runtime.h>
#include <hip/hip_cooperative_groups.h>
#include <stdint.h>
#include <stdio.h>
namespace cg = cooperative_groups;

#ifndef MULTI_LAUNCH
#define MULTI_LAUNCH 0
#endif

#define DI __device__ __forceinline__
typedef unsigned short u16;
using bf16x8 = __attribute__((ext_vector_type(8))) short;
using f32x4 = __attribute__((ext_vector_type(4))) float;
typedef __bf16 bf2_t __attribute__((ext_vector_type(2)));
typedef float f2_t __attribute__((ext_vector_type(2)));
typedef unsigned u32x4 __attribute__((ext_vector_type(4)));
typedef unsigned u32x2 __attribute__((ext_vector_type(2)));

constexpr int D = 1024, NTOK = 6144, NCTX = 4096, NIN = 3328, DFF = 4096;
constexpr float ALPHA = 1.41421356237309515f;
constexpr float LOG2E = 1.44269504088896341f;
constexpr int LDS_BYTES = 75776;
constexpr int NPHASE = 18;

constexpr size_t O_WTIN = 0;
constexpr size_t O_WTOUT = O_WTIN + (size_t)2 * NIN * D * 2;
constexpr size_t O_WTFF1 = O_WTOUT + (size_t)2 * D * D * 2;
constexpr size_t O_WTFF2 = O_WTFF1 + (size_t)2 * DFF * D * 2;
constexpr size_t O_MODS = O_WTFF2 + (size_t)2 * D * DFF * 2;
constexpr size_t O_ROPE = O_MODS + (size_t)2 * 3 * 6144 * 4;
constexpr size_t O_QA = O_ROPE + (size_t)1024 * 32 * 2 * 4;
constexpr size_t O_KACTX = O_QA + (size_t)NTOK * 512 * 2;
constexpr size_t O_KALAT = O_KACTX + (size_t)NCTX * 512 * 2;
constexpr size_t O_VTACTX = O_KALAT + (size_t)2 * 2 * 1536 * 512 * 2;
constexpr size_t O_VTALAT = O_VTACTX + (size_t)16 * 4 * 128 * 256 * 2;
constexpr size_t O_QC = O_VTALAT + (size_t)2 * 2 * 4 * 128 * 1536 * 2;
constexpr size_t O_KCCTX = O_QC + (size_t)NTOK * 256 * 2;
constexpr size_t O_KCLAT = O_KCCTX + (size_t)NCTX * 128 * 2;
constexpr size_t O_VTCCTX = O_KCLAT + (size_t)2 * 2 * 1536 * 128 * 2;
constexpr size_t O_VTCLAT = O_VTCCTX + (size_t)16 * 2 * 64 * 256 * 2;
constexpr size_t O_KV = O_VTCLAT + (size_t)2 * 2 * 2 * 64 * 1536 * 2;
constexpr size_t O_DEC = O_KV + (size_t)768 * 4096 * 4;
constexpr size_t O_MIXED = O_DEC + (size_t)768 * 64 * 4;
constexpr size_t O_XPRE1 = O_MIXED + (size_t)NTOK * 1024 * 2;
constexpr size_t O_ST1 = O_XPRE1 + (size_t)NTOK * 1024 * 4;
constexpr size_t O_XPRE2 = O_ST1 + (size_t)NTOK * 32 * 4;
constexpr size_t O_ST2 = O_XPRE2 + (size_t)NTOK * 1024 * 4;
constexpr size_t O_ABF = O_ST2 + (size_t)NTOK * 32 * 4;
constexpr size_t O_HQ = O_ABF + (size_t)NTOK * 1024 * 2;
constexpr size_t O_HGF = O_HQ + (size_t)NTOK * 256 * 4;
constexpr size_t O_HGB = O_HGF + (size_t)NTOK * 256 * 4;
constexpr size_t O_HI = O_HGB + (size_t)NTOK * 256 * 4;
constexpr size_t O_HSG = O_HI + (size_t)NTOK * 256 * 4;
constexpr size_t O_OI = O_HSG + (size_t)NTOK * 256 * 4;
constexpr size_t O_QE = O_OI + (size_t)2 * NTOK * 256 * 4;
constexpr size_t O_END1 = O_QE + (size_t)2 * NTOK * 256 * 4;
constexpr size_t O_HID = O_HQ;
constexpr size_t O_END2 = O_HID + (size_t)NTOK * 4096 * 2;
static_assert(O_END2 <= O_END1, "HID alias must fit");
static_assert(O_END1 <= (size_t)256 * 1024 * 1024, "workspace too big");

constexpr size_t OUT_YP = 0, OUT_YS = 4194304, OUT_AK = 6291456, OUT_AV = 10485760, OUT_CK = 14680064,
                 OUT_CV = 15728640, OUT_SF = 16777216, OUT_SB = 17301504;

struct P {
  const float* in[30];
  float* out;
  char* ws;
};

DI unsigned pack2(float a, float b) {
  f2_t v = {a, b};
  bf2_t r = __builtin_convertvector(v, bf2_t);
  return __builtin_bit_cast(unsigned, r);
}
DI u16 f2bf(float x) { return (u16)(pack2(x, 0.f) & 0xffffu); }
DI float ex2(float x) { return __builtin_amdgcn_exp2f(x); }
DI float siluf(float x) { return x / (1.f + expf(-x)); }
DI float shx(float v, int m) { return __shfl_xor(v, m, 64); }
DI float red16(float x) {
  x += __builtin_bit_cast(float, __builtin_amdgcn_update_dpp(0, __builtin_bit_cast(int, x), 0xB1, 0xF, 0xF, true));
  x += __builtin_bit_cast(float, __builtin_amdgcn_update_dpp(0, __builtin_bit_cast(int, x), 0x4E, 0xF, 0xF, true));
  x += __builtin_bit_cast(float, __builtin_amdgcn_update_dpp(0, __builtin_bit_cast(int, x), 0x141, 0xF, 0xF, true));
  x += __builtin_bit_cast(float, __builtin_amdgcn_update_dpp(0, __builtin_bit_cast(int, x), 0x140, 0xF, 0xF, true));
  return x;
}
DI float xor1(float x) { return __builtin_bit_cast(float, __builtin_amdgcn_update_dpp(0, __builtin_bit_cast(int, x), 0xB1, 0xF, 0xF, true)); }
DI int ltid() { int t = threadIdx.x; asm volatile("" : "+v"(t)); return t; }
#define MFMA16(a, b, c) __builtin_amdgcn_mfma_f32_16x16x32_bf16((a), (b), (c), 0, 0, 0)

DI void p0_mod(const P& p, int item, char* smem) {
  float* ssilu = (float*)smem;
  float* red = ssilu + 3072;
  const int tid = ltid();
  __syncthreads();
  for (int i = tid; i < 3072; i += 256) {
    int w = i >> 10, k = i & 1023;
    float v = (w == 0) ? p.in[9][k] : p.in[8][(w - 1) * 1024 + k];
    ssilu[i] = siluf(v);
  }
  __syncthreads();
  const int li = item / 96, j0 = (item % 96) * 64;
  const int c4 = tid & 15, kp = tid >> 4;
  const float* W = p.in[10] + (size_t)li * 1024 * 6144 + j0 + c4 * 4;
  float4 a0 = {0, 0, 0, 0}, a1 = a0, a2 = a0;
#pragma unroll 16
  for (int kk = 0; kk < 64; ++kk) {
    int k = kp * 64 + kk;
    float4 w4 = *(const float4*)(W + (size_t)k * 6144);
    float s0 = ssilu[k], s1 = ssilu[1024 + k], s2 = ssilu[2048 + k];
    a0.x += s0 * w4.x; a0.y += s0 * w4.y; a0.z += s0 * w4.z; a0.w += s0 * w4.w;
    a1.x += s1 * w4.x; a1.y += s1 * w4.y; a1.z += s1 * w4.z; a1.w += s1 * w4.w;
    a2.x += s2 * w4.x; a2.y += s2 * w4.y; a2.z += s2 * w4.z; a2.w += s2 * w4.w;
  }
  *(float4*)(red + (kp * 3 + 0) * 64 + c4 * 4) = a0;
  *(float4*)(red + (kp * 3 + 1) * 64 + c4 * 4) = a1;
  *(float4*)(red + (kp * 3 + 2) * 64 + c4 * 4) = a2;
  __syncthreads();
  if (tid < 192) {
    int w = tid >> 6, c = tid & 63;
    float s = p.in[11][li * 6144 + j0 + c];
    for (int q = 0; q < 16; ++q) s += red[(q * 3 + w) * 64 + c];
    ((float*)(p.ws + O_MODS))[(li * 3 + w) * 6144 + j0 + c] = s;
  }
}

DI void p0_rope(const P& p, int item) {
  float* R = (float*)(p.ws + O_ROPE);
  for (int i = ltid(); i < 4096; i += 256) {
    int idx = item * 4096 + i;
    int t = idx >> 5, pp = idx & 31;
    float inv = powf(10000.f, -(float)(pp & 15) / 16.f);
    float pos = (pp < 16) ? (float)(t >> 6) : (float)(t & 63);
    float ang = pos * inv;
    R[idx * 2] = cosf(ang);
    R[idx * 2 + 1] = sinf(ang);
  }
}

DI void p0_copyk(const P& p, int item, bool isA) {
  const int W = isA ? 512 : 128;
  const float* src = isA ? p.in[2] : p.in[4];
  u16* dst = (u16*)(p.ws + (isA ? O_KALAT : O_KCLAT));
  for (int i = 0; i < 4; ++i) {
    size_t e = (size_t)item * 4096 + (size_t)(ltid() + 256 * i) * 4;
    float4 v = *(const float4*)(src + e);
    int c = (int)(e % W);
    size_t r = e / W;
    int pp = (int)(r % 512);
    int bl = (int)(r / 512);
    int b = bl >> 1, li = bl & 1;
    uint2 o;
    o.x = pack2(v.x, v.y);
    o.y = pack2(v.z, v.w);
    *(uint2*)(dst + ((size_t)((li * 2 + b) * 1536 + 1024 + pp)) * W + c) = o;
  }
}

struct TDesc { const float* src; int sstride; u16* dst; int dstride; };

DI TDesc tdesc(const P& p, int t) {
  constexpr int T_IN = 1664, T_OUT = 512, T_FF1 = 2048, T_FF2 = 2048, T_AV = 256;
  TDesc d;
  if (t < T_IN) {
    int li = t / 832, r = t % 832, kt = r / 52, nt = r % 52;
    d.src = p.in[12] + (size_t)li * 1024 * NIN + (size_t)(kt * 64) * NIN + nt * 64; d.sstride = NIN;
    d.dst = (u16*)(p.ws + O_WTIN) + (size_t)li * NIN * 1024 + (size_t)(nt * 64) * 1024 + kt * 64; d.dstride = 1024;
  } else if ((t -= T_IN) < T_OUT) {
    int li = t / 256, r = t % 256, kt = r / 16, nt = r % 16;
    d.src = p.in[13] + (size_t)li * 1024 * 1024 + (size_t)(kt * 64) * 1024 + nt * 64; d.sstride = 1024;
    d.dst = (u16*)(p.ws + O_WTOUT) + (size_t)li * 1024 * 1024 + (size_t)(nt * 64) * 1024 + kt * 64; d.dstride = 1024;
  } else if ((t -= T_OUT) < T_FF1) {
    int li = t / 1024, r = t % 1024, kt = r / 64, nt = r % 64;
    d.src = p.in[28] + (size_t)li * 1024 * DFF + (size_t)(kt * 64) * DFF + nt * 64; d.sstride = DFF;
    d.dst = (u16*)(p.ws + O_WTFF1) + (size_t)li * DFF * 1024 + (size_t)(nt * 64) * 1024 + kt * 64; d.dstride = 1024;
  } else if ((t -= T_FF1) < T_FF2) {
    int li = t / 1024, r = t % 1024, kt = r / 16, nt = r % 16;
    d.src = p.in[29] + (size_t)li * DFF * 1024 + (size_t)(kt * 64) * 1024 + nt * 64; d.sstride = 1024;
    d.dst = (u16*)(p.ws + O_WTFF2) + (size_t)li * 1024 * DFF + (size_t)(nt * 64) * DFF + kt * 64; d.dstride = DFF;
  } else if ((t -= T_FF2) < T_AV) {
    int bl = t / 64, r = t % 64, pt = r / 8, ct = r % 8;
    int b = bl >> 1, li = bl & 1;
    d.src = p.in[3] + ((size_t)bl * 512 + pt * 64) * 512 + ct * 64; d.sstride = 512;
    d.dst = (u16*)(p.ws + O_VTALAT) + ((size_t)(li * 2 + b) * 512 + ct * 64) * 1536 + 1024 + pt * 64; d.dstride = 1536;
  } else {
    t -= T_AV;
    int bl = t / 16, r = t % 16, pt = r / 2, ct = r % 2;
    int b = bl >> 1, li = bl & 1;
    d.src = p.in[5] + ((size_t)bl * 512 + pt * 64) * 128 + ct * 64; d.sstride = 128;
    d.dst = (u16*)(p.ws + O_VTCLAT) + ((size_t)(li * 2 + b) * 128 + ct * 64) * 1536 + 1024 + pt * 64; d.dstride = 1536;
  }
  return d;
}

DI void phase0(const P& p, char* smem) {
  constexpr int N_MOD = 192, N_ROPE = 8, N_AK = 256, N_CK = 64;
  constexpr int B_ROPE = N_MOD, B_AK = B_ROPE + N_ROPE, B_CK = B_AK + N_AK, B_T = B_CK + N_CK;
  constexpr int NTILES = 1664 + 512 + 2048 + 2048 + 256 + 64;
  for (int it = blockIdx.x; it < B_T; it += gridDim.x) {
    if (it < B_ROPE) p0_mod(p, it, smem);
    else if (it < B_AK) p0_rope(p, it - B_ROPE);
    else if (it < B_CK) p0_copyk(p, it - B_AK, true);
    else p0_copyk(p, it - B_CK, false);
  }
  float* tl = (float*)smem;
  const int tid = ltid();
  const int lr = tid >> 4, lc4 = tid & 15;
  const int c = tid >> 2, rs = tid & 3;
  int t = blockIdx.x;
  f32x4 v[4];
  TDesc cur;
  if (t < NTILES) {
    cur = tdesc(p, t);
#pragma unroll
    for (int i = 0; i < 4; ++i) v[i] = *(const f32x4*)(cur.src + (size_t)(lr + 16 * i) * cur.sstride + lc4 * 4);
  }
  while (t < NTILES) {
    __syncthreads();
#pragma unroll
    for (int i = 0; i < 4; ++i) {
      float* q = tl + (lr + 16 * i) * 65 + lc4 * 4;
      q[0] = v[i].x; q[1] = v[i].y; q[2] = v[i].z; q[3] = v[i].w;
    }
    const int tn = t + gridDim.x;
    TDesc nxt = cur;
    if (tn < NTILES) {
      nxt = tdesc(p, tn);
#pragma unroll
      for (int i = 0; i < 4; ++i) v[i] = *(const f32x4*)(nxt.src + (size_t)(lr + 16 * i) * nxt.sstride + lc4 * 4);
    }
    __syncthreads();
    u32x4 o0, o1;
    {
      const float* q = tl + (rs * 16) * 65 + c;
      o0.x = pack2(q[0 * 65], q[1 * 65]);   o0.y = pack2(q[2 * 65], q[3 * 65]);
      o0.z = pack2(q[4 * 65], q[5 * 65]);   o0.w = pack2(q[6 * 65], q[7 * 65]);
      o1.x = pack2(q[8 * 65], q[9 * 65]);   o1.y = pack2(q[10 * 65], q[11 * 65]);
      o1.z = pack2(q[12 * 65], q[13 * 65]); o1.w = pack2(q[14 * 65], q[15 * 65]);
    }
    u32x4* dp = (u32x4*)(cur.dst + (size_t)c * cur.dstride + rs * 16);
    dp[0] = o0;
    dp[1] = o1;
    cur = nxt;
    t = tn;
  }
}

struct GA {
  const float* alo;
  const float* ahi;
  const float* stats;
  const float* lng;
  const float* lnb;
  const float* mods;
  int sc_off, sh_off;
  const u16* a16;
  const u16* bt;
  int K, N;
  float* xout;
  float* sout;
  u16* hid;
};

DI void epi_inproj(const P& p, int li, f32x4 (&acc)[4][4], int R0, int C0);


template <int EPI>
DI void gemm_tile(const P& p, const GA& g, int li, int m0, int n0, char* smem) {
  const int tid = ltid(), lane = tid & 63, wid = tid >> 6, wr = wid >> 1, wc = wid & 1;
  const int l16 = lane & 15, q4 = lane >> 4;
  u16* sA0 = (u16*)smem;
  u16* sB0 = sA0 + 128 * 72;
  u16* sA1 = sB0 + 128 * 72;
  u16* sB1 = sA1 + 128 * 72;
  float2* sStat = (float2*)(smem + 73728);
  const int K = g.K;
  const int rtype = (m0 < NCTX) ? 0 : 1 + ((m0 - NCTX) >> 10);
  const float* modv = g.mods + rtype * 6144;
  const float* fsrc = (m0 < NCTX) ? g.alo + (size_t)m0 * 1024 : g.ahi + (size_t)(m0 - NCTX) * 1024;

  __syncthreads();
  if constexpr (EPI == 1) {
    if (g.stats != nullptr && tid < 128) {
      const float4* sp = (const float4*)(g.stats + (size_t)(m0 + tid) * 32);
      float s1 = 0.f, s2 = 0.f;
#pragma unroll
      for (int i = 0; i < 8; ++i) {
        float4 v = sp[i];
        s1 += v.x + v.z;
        s2 += v.y + v.w;
      }
      float mu = s1 * (1.f / 1024.f);
      float var = s2 * (1.f / 1024.f) - mu * mu;
      sStat[tid] = make_float2(mu, rsqrtf(fmaxf(var, 0.f) + 1e-6f));
    }
  }

  f32x4 acc[4][4];
#pragma unroll
  for (int i = 0; i < 4; ++i)
#pragma unroll
    for (int j = 0; j < 4; ++j) acc[i][j] = f32x4{0.f, 0.f, 0.f, 0.f};

  u32x4 ra0[4], rb0[4], ra1[4], rb1[4];
  const unsigned goff = (unsigned)(tid >> 3) * (unsigned)K + (unsigned)(tid & 7) * 8u;
  const unsigned loff = (unsigned)(tid >> 3) * 72u + (unsigned)(tid & 7) * 8u;
  const u16* abase = g.a16 + (size_t)m0 * K;
  const u16* bbase = g.bt + (size_t)n0 * K;
#define GLOAD(RA, RB, KT)                                                        \
  _Pragma("unroll") for (int i = 0; i < 4; ++i) {                                \
    RA[i] = *(const u32x4*)(abase + (size_t)(32 * i) * K + (KT) * 64 + goff);    \
    RB[i] = *(const u32x4*)(bbase + (size_t)(32 * i) * K + (KT) * 64 + goff);    \
  }
#define LSTORE(SA, SB, RA, RB)                                                   \
  _Pragma("unroll") for (int i = 0; i < 4; ++i) {                                \
    *(u32x4*)(SA + 32 * i * 72 + loff) = RA[i];                                  \
    *(u32x4*)(SB + 32 * i * 72 + loff) = RB[i];                                  \
  }
#define COMPUTE(SA, SB)                                                          \
  _Pragma("unroll") for (int s = 0; s < 2; ++s) {                                \
    bf16x8 af[4], bfr[4];                                                        \
    _Pragma("unroll") for (int i = 0; i < 4; ++i) {                              \
      af[i] = *(const bf16x8*)(SA + (wr * 64 + i * 16 + l16) * 72 + s * 32 + q4 * 8);  \
      bfr[i] = *(const bf16x8*)(SB + (wc * 64 + i * 16 + l16) * 72 + s * 32 + q4 * 8); \
    }                                                                            \
    _Pragma("unroll") for (int i = 0; i < 4; ++i)                                \
      _Pragma("unroll") for (int j = 0; j < 4; ++j) acc[i][j] = MFMA16(af[i], bfr[j], acc[i][j]); \
    __builtin_amdgcn_sched_barrier(0);                                           \
  }

  const int nk = K >> 6;
#define SB0 __builtin_amdgcn_sched_barrier(0)
  GLOAD(ra0, rb0, 0);
  SB0;
  GLOAD(ra1, rb1, 1);
  SB0;
  LSTORE(sA0, sB0, ra0, rb0);
  SB0;
  GLOAD(ra0, rb0, 2);
  SB0;
  __syncthreads();
#pragma unroll 1
  for (int kt = 0; kt < nk - 4; kt += 2) {
    SB0;
    LSTORE(sA1, sB1, ra1, rb1);
    SB0;
    GLOAD(ra1, rb1, kt + 3);
    SB0;
    COMPUTE(sA0, sB0);
    __syncthreads();
    SB0;
    LSTORE(sA0, sB0, ra0, rb0);
    SB0;
    GLOAD(ra0, rb0, kt + 4);
    SB0;
    COMPUTE(sA1, sB1);
    __syncthreads();
  }
  SB0;
  LSTORE(sA1, sB1, ra1, rb1);
  SB0;
  GLOAD(ra1, rb1, nk - 1);
  SB0;
  COMPUTE(sA0, sB0);
  __syncthreads();
  SB0;
  LSTORE(sA0, sB0, ra0, rb0);
  SB0;
  COMPUTE(sA1, sB1);
  __syncthreads();
  SB0;
  LSTORE(sA1, sB1, ra1, rb1);
  SB0;
  COMPUTE(sA0, sB0);
  __syncthreads();
  SB0;
  COMPUTE(sA1, sB1);
#undef GLOAD
#undef LSTORE
#undef COMPUTE
#undef SB0
  asm volatile("" ::: "memory");

  const int R0 = m0 + wr * 64, C0 = n0 + wc * 64;
  if constexpr (EPI == 0) {
    epi_inproj(p, li, acc, R0, C0);
  } else if constexpr (EPI == 1) {
    float gate[4], lg[4], lb[4];
#pragma unroll
    for (int j = 0; j < 4; ++j) {
      int col = C0 + j * 16 + l16;
      gate[j] = modv[g.sc_off + col];
      lg[j] = g.stats ? g.lng[col] : 1.f;
      lb[j] = g.stats ? g.lnb[col] : 0.f;
    }
#pragma unroll
    for (int i = 0; i < 4; ++i) {
#pragma unroll
      for (int r = 0; r < 4; ++r) {
        int lrow = wr * 64 + i * 16 + q4 * 4 + r;
        float mu = 0.f, rs = 1.f;
        if (g.stats != nullptr) {
          float2 st = sStat[lrow];
          mu = st.x;
          rs = st.y;
        }
        float s1 = 0.f, s2 = 0.f;
#pragma unroll
        for (int j = 0; j < 4; ++j) {
          int col = C0 + j * 16 + l16;
          float x = fsrc[(size_t)lrow * 1024 + col];
          x = (x - mu) * rs * lg[j] + lb[j];
          float v = ALPHA * x + gate[j] * acc[i][j][r];
          g.xout[(size_t)(m0 + lrow) * 1024 + col] = v;
          s1 += v;
          s2 += v * v;
        }
        s1 = red16(s1);
        s2 = red16(s2);
        if (l16 == 0) *(float2*)(g.sout + (size_t)(m0 + lrow) * 32 + (C0 >> 6) * 2) = make_float2(s1, s2);
      }
    }
  } else {
    float* sC = (float*)smem;
    __syncthreads();
#pragma unroll
    for (int i = 0; i < 4; ++i)
#pragma unroll
      for (int j = 0; j < 4; ++j)
#pragma unroll
        for (int r = 0; r < 4; ++r) sC[(wr * 64 + i * 16 + q4 * 4 + r) * 132 + wc * 64 + j * 16 + l16] = acc[i][j][r];
    __syncthreads();
    if constexpr (EPI == 1) {
      const int hl = lane & 31, rsel = lane >> 5;
      const int col = n0 + hl * 4;
      const f32x4 gate4 = *(const f32x4*)(modv + g.sc_off + col);
      f32x4 lg4 = {1.f, 1.f, 1.f, 1.f}, lb4 = {0.f, 0.f, 0.f, 0.f};
      if (g.stats != nullptr) {
        lg4 = *(const f32x4*)(g.lng + col);
        lb4 = *(const f32x4*)(g.lnb + col);
      }
#pragma unroll 4
      for (int pp = 0; pp < 16; ++pp) {
        const int lrow = pp * 8 + wid * 2 + rsel;
        f32x4 a = *(const f32x4*)(sC + lrow * 132 + hl * 4);
        f32x4 x = *(const f32x4*)(fsrc + (size_t)lrow * 1024 + col);
        float mu = 0.f, rs = 1.f;
        if (g.stats != nullptr) {
          float2 st = sStat[lrow];
          mu = st.x;
          rs = st.y;
        }
        x = (x - mu) * rs * lg4 + lb4;
        f32x4 v = ALPHA * x + gate4 * a;
        *(f32x4*)(g.xout + (size_t)(m0 + lrow) * 1024 + col) = v;
        float s1 = (v.x + v.y) + (v.z + v.w);
        float s2 = (v.x * v.x + v.y * v.y) + (v.z * v.z + v.w * v.w);
        s1 = red16(s1);
        s2 = red16(s2);
        if ((lane & 15) == 0) *(float2*)(g.sout + (size_t)(m0 + lrow) * 32 + ((n0 >> 6) + (hl >> 4)) * 2) = make_float2(s1, s2);
      }
    } else {
#pragma unroll
      for (int pp = 0; pp < 8; ++pp) {
        const int idx = tid + 256 * pp;
        const int lrow = idx >> 4, c8 = idx & 15;
        f32x4 a0 = *(const f32x4*)(sC + lrow * 132 + c8 * 8);
        f32x4 a1 = *(const f32x4*)(sC + lrow * 132 + c8 * 8 + 4);
        a0.x = fmaxf(a0.x, 0.f); a0.y = fmaxf(a0.y, 0.f); a0.z = fmaxf(a0.z, 0.f); a0.w = fmaxf(a0.w, 0.f);
        a1.x = fmaxf(a1.x, 0.f); a1.y = fmaxf(a1.y, 0.f); a1.z = fmaxf(a1.z, 0.f); a1.w = fmaxf(a1.w, 0.f);
        u32x4 o;
        o.x = pack2(a0.x * a0.x, a0.y * a0.y);
        o.y = pack2(a0.z * a0.z, a0.w * a0.w);
        o.z = pack2(a1.x * a1.x, a1.y * a1.y);
        o.w = pack2(a1.z * a1.z, a1.w * a1.w);
        *(u32x4*)(g.hid + (size_t)(m0 + lrow) * DFF + n0 + c8 * 8) = o;
      }
    }
  }
}

DI void epi_inproj(const P& p, int li, f32x4 (&acc)[4][4], int R0, int C0) {
  const int lane = ltid() & 63, l16 = lane & 15, q4 = lane >> 4;
  const int seg = C0 >> 6;
  const bool lat = R0 >= NCTX;
  const float2* rope = (const float2*)(p.ws + O_ROPE);
  int b, tb;
  if (!lat) { b = R0 >> 8; tb = R0 & 255; } else { b = (R0 - NCTX) >> 10; tb = (R0 - NCTX) & 1023; }

  enum { T_QA, T_KA, T_VA, T_QB, T_FF, T_FB, T_IB, T_GB, T_QC, T_KC, T_VC };
  int type, cbase;
  if (seg < 8) { type = T_QA; cbase = seg * 64; }
  else if (seg < 16) { type = T_KA; cbase = (seg - 8) * 64; }
  else if (seg < 24) { type = T_VA; cbase = (seg - 16) * 64; }
  else if (seg < 28) { type = T_QB; cbase = (seg - 24) * 64; }
  else if (seg < 32) { type = T_FF; cbase = (seg - 28) * 64; }
  else if (seg < 36) { type = T_FB; cbase = (seg - 32) * 64; }
  else if (seg < 40) { type = T_IB; cbase = (seg - 36) * 64; }
  else if (seg < 44) { type = T_GB; cbase = (seg - 40) * 64; }
  else if (seg < 48) { type = T_QC; cbase = (seg - 44) * 64; }
  else if (seg < 50) { type = T_KC; cbase = (seg - 48) * 64; }
  else { type = T_VC; cbase = (seg - 50) * 64; }

  if (type == T_QC || type == T_KC) {
    const float* gv = (type == T_QC ? p.in[22] : p.in[23]) + li * 64;
    float gj[4];
#pragma unroll
    for (int j = 0; j < 4; ++j) gj[j] = gv[j * 16 + l16];
#pragma unroll
    for (int i = 0; i < 4; ++i)
#pragma unroll
      for (int r = 0; r < 4; ++r) {
        float ss = 0.f;
#pragma unroll
        for (int j = 0; j < 4; ++j) ss += acc[i][j][r] * acc[i][j][r];
        ss = red16(ss);
        float rs = rsqrtf(ss * (1.f / 64.f) + 1e-6f);
#pragma unroll
        for (int j = 0; j < 4; ++j) acc[i][j][r] = acc[i][j][r] * rs * gj[j];
      }
  }
  if (!lat && (type == T_KA || type == T_VA || type == T_KC || type == T_VC)) {
    float* o;
    int W;
    if (type == T_KA) { o = p.out + OUT_AK; W = 512; }
    else if (type == T_VA) { o = p.out + OUT_AV; W = 512; }
    else if (type == T_KC) { o = p.out + OUT_CK; W = 128; }
    else { o = p.out + OUT_CV; W = 128; }
#pragma unroll
    for (int i = 0; i < 4; ++i)
#pragma unroll
      for (int r = 0; r < 4; ++r) {
        int t = tb + i * 16 + q4 * 4 + r;
        size_t base = ((size_t)(b * 2 + li) * 256 + t) * W + cbase;
#pragma unroll
        for (int j = 0; j < 4; ++j) o[base + j * 16 + l16] = acc[i][j][r];
      }
  }
  if (lat && (type == T_QA || type == T_KA || type == T_QC || type == T_KC)) {
#pragma unroll
    for (int i = 0; i < 4; ++i)
#pragma unroll
      for (int r = 0; r < 4; ++r) {
        int t = tb + i * 16 + q4 * 4 + r;
#pragma unroll
        for (int j = 0; j < 4; ++j) {
          float v = acc[i][j][r];
          float pv = xor1(v);
          float2 cs = rope[t * 32 + j * 8 + (l16 >> 1)];
          acc[i][j][r] = (l16 & 1) ? (pv * cs.y + v * cs.x) : (v * cs.x - pv * cs.y);
        }
      }
  }

  if (type == T_QA || type == T_KA || type == T_QC || type == T_KC) {
    u16* dst;
    int W;
    size_t rowbase;
    if (type == T_QA) { dst = (u16*)(p.ws + O_QA); W = 512; rowbase = (size_t)R0 * 512; }
    else if (type == T_QC) { dst = (u16*)(p.ws + O_QC); W = 256; rowbase = (size_t)R0 * 256; }
    else if (type == T_KA) {
      W = 512;
      if (!lat) { dst = (u16*)(p.ws + O_KACTX); rowbase = (size_t)R0 * 512; }
      else { dst = (u16*)(p.ws + O_KALAT); rowbase = ((size_t)(li * 2 + b) * 1536 + tb) * 512; }
    } else {
      W = 128;
      if (!lat) { dst = (u16*)(p.ws + O_KCCTX); rowbase = (size_t)R0 * 128; }
      else { dst = (u16*)(p.ws + O_KCLAT); rowbase = ((size_t)(li * 2 + b) * 1536 + tb) * 128; }
    }
#pragma unroll
    for (int i = 0; i < 4; ++i)
#pragma unroll
      for (int r = 0; r < 4; ++r) {
        size_t base = rowbase + (size_t)(i * 16 + q4 * 4 + r) * W + cbase;
#pragma unroll
        for (int j = 0; j < 4; ++j) dst[base + j * 16 + l16] = f2bf(acc[i][j][r]);
      }
  } else if (type == T_VA || type == T_VC) {
    u16* dst;
    int L;
    size_t hb;
    if (type == T_VA) {
      int h = cbase >> 7, dv0 = cbase & 127;
      if (!lat) { dst = (u16*)(p.ws + O_VTACTX); L = 256; hb = ((size_t)(b * 4 + h) * 128 + dv0) * 256; }
      else { dst = (u16*)(p.ws + O_VTALAT); L = 1536; hb = ((size_t)((li * 2 + b) * 4 + h) * 128 + dv0) * 1536; }
    } else {
      int n = cbase >> 6;
      if (!lat) { dst = (u16*)(p.ws + O_VTCCTX); L = 256; hb = ((size_t)(b * 2 + n) * 64) * 256; }
      else { dst = (u16*)(p.ws + O_VTCLAT); L = 1536; hb = ((size_t)((li * 2 + b) * 2 + n) * 64) * 1536; }
    }
#pragma unroll
    for (int i = 0; i < 4; ++i)
#pragma unroll
      for (int j = 0; j < 4; ++j) {
        uint2 o;
        o.x = pack2(acc[i][j][0], acc[i][j][1]);
        o.y = pack2(acc[i][j][2], acc[i][j][3]);
        *(uint2*)(dst + hb + (size_t)(j * 16 + l16) * L + tb + i * 16 + q4 * 4) = o;
      }
  } else {
    float* dst;
    if (type == T_QB) dst = (float*)(p.ws + O_HQ);
    else if (type == T_FF) dst = (float*)(p.ws + O_HGF);
    else if (type == T_FB) dst = (float*)(p.ws + O_HGB);
    else if (type == T_IB) dst = (float*)(p.ws + O_HI);
    else dst = (float*)(p.ws + O_HSG);
    float lbv[4] = {0.f, 0.f, 0.f, 0.f};
    if ((type == T_FF || type == T_FB) && li == 1) {
      const float* lg = (type == T_FF) ? p.in[19] : p.in[20];
#pragma unroll
      for (int j = 0; j < 4; ++j) {
        int c = cbase + j * 16 + l16;
        lbv[j] = 1.f / (1.f + expf(lg[c] - lg[256 + c]));
      }
    }
#pragma unroll
    for (int i = 0; i < 4; ++i)
#pragma unroll
      for (int r = 0; r < 4; ++r) {
        size_t base = (size_t)(R0 + i * 16 + q4 * 4 + r) * 256 + cbase;
#pragma unroll
        for (int j = 0; j < 4; ++j) {
          float v = acc[i][j][r];
          float o;
          if (type == T_QB || type == T_GB) o = v * __frcp_rn(1.f + __expf(-v));
          else if (type == T_IB) o = v;
          else {
            float sg = __frcp_rn(1.f + __expf(-v));
            float f = lbv[j] + (1.f - lbv[j]) * sg;
            o = __logf(fmaxf(f, 1e-6f));
          }
          dst[base + j * 16 + l16] = o;
        }
      }
  }
}

template <int EPI>
DI void gemm_phase(const P& p, const GA& g, int li, char* smem) {
  const int NT = g.N >> 7;
  const int xcd = blockIdx.x & 7, lb = blockIdx.x >> 3, nlb = gridDim.x >> 3;
  if (lb >= nlb) return;
  for (int t = lb; t < 6 * NT; t += nlb) {
    int mt = xcd * 6 + t % 6, nt = t / 6;
    gemm_tile<EPI>(p, g, li, mt * 128, nt * 128, smem);
  }
}


template <int KW, int DV>
DI void attn_gload(const u16* Kb, int kstride, const u16* VT, int L, int kb, int tid, u32x4 (&kr)[KW / 32], u32x4 (&vr)[DV / 32]) {
  constexpr int KPR = 256 / (KW / 8);
  const unsigned koff = (unsigned)(tid / (KW / 8)) * (unsigned)kstride + (unsigned)(tid % (KW / 8)) * 8u;
  const unsigned voff = (unsigned)(tid >> 3) * (unsigned)L + (unsigned)(tid & 7) * 8u;
#pragma unroll
  for (int i = 0; i < KW / 32; ++i) {
    const u16* kbp = Kb + (size_t)(kb * 64 + KPR * i) * kstride;
    kr[i] = *(const u32x4*)(kbp + koff);
  }
#pragma unroll
  for (int i = 0; i < DV / 32; ++i) {
    const u16* vbp = VT + (size_t)(32 * i) * L + kb * 64;
    vr[i] = *(const u32x4*)(vbp + voff);
  }
}
template <int KW, int DV>
DI void attn_lstore(u16* sK, u16* sV, int tid, const u32x4 (&kr)[KW / 32], const u32x4 (&vr)[DV / 32]) {
  constexpr int KS = KW + 8;
#pragma unroll
  for (int i = 0; i < KW / 32; ++i) {
    int idx = tid + 256 * i;
    int key = idx / (KW / 8), cc = idx % (KW / 8);
    *(u32x4*)(sK + key * KS + cc * 8) = kr[i];
  }
#pragma unroll
  for (int i = 0; i < DV / 32; ++i) {
    int idx = tid + 256 * i;
    int row = idx >> 3, cc = idx & 7;
    *(u32x4*)(sV + row * 72 + cc * 8) = vr[i];
  }
}

template <int KW, int DV>
DI void attn_compute(const u16* sK, const u16* sV, int kfo, int l16, int q4, const bf16x8& qf0, const bf16x8& qf1,
                     f32x4 (&o)[DV / 16], float& m, float& l) {
  constexpr int KS = KW + 8, NDT = DV / 16;
  const float c = 0.125f * LOG2E;
  f32x4 st[4];
#pragma unroll
  for (int kt = 0; kt < 4; ++kt) {
    const u16* kp = sK + (kt * 16 + l16) * KS + kfo + q4 * 8;
    bf16x8 k0 = *(const bf16x8*)kp;
    bf16x8 k1 = *(const bf16x8*)(kp + 32);
    f32x4 z = {0.f, 0.f, 0.f, 0.f};
    z = MFMA16(k0, qf0, z);
    st[kt] = MFMA16(k1, qf1, z);
  }
  float bm = st[0][0];
#pragma unroll
  for (int kt = 0; kt < 4; ++kt)
#pragma unroll
    for (int r = 0; r < 4; ++r) bm = fmaxf(bm, st[kt][r]);
  bm = fmaxf(bm, shx(bm, 16));
  bm = fmaxf(bm, shx(bm, 32));
  const float mn = fmaxf(m, bm);
  const float alpha = ex2((m - mn) * c);
  m = mn;
  float ps = 0.f;
#pragma unroll
  for (int kt = 0; kt < 4; ++kt)
#pragma unroll
    for (int r = 0; r < 4; ++r) {
      float pv = ex2((st[kt][r] - mn) * c);
      st[kt][r] = pv;
      ps += pv;
    }
  l = l * alpha + ps;
#pragma unroll
  for (int d = 0; d < NDT; ++d) {
    o[d][0] *= alpha; o[d][1] *= alpha; o[d][2] *= alpha; o[d][3] *= alpha;
  }
#pragma unroll
  for (int ks = 0; ks < 2; ++ks) {
    u32x4 pu;
    pu.x = pack2(st[2 * ks][0], st[2 * ks][1]);
    pu.y = pack2(st[2 * ks][2], st[2 * ks][3]);
    pu.z = pack2(st[2 * ks + 1][0], st[2 * ks + 1][1]);
    pu.w = pack2(st[2 * ks + 1][2], st[2 * ks + 1][3]);
    bf16x8 pf = __builtin_bit_cast(bf16x8, pu);
#pragma unroll
    for (int d = 0; d < NDT; ++d) {
      const u16* vp = sV + (d * 16 + l16) * 72 + ks * 32 + q4 * 4;
      u32x2 v0 = *(const u32x2*)vp;
      u32x2 v1 = *(const u32x2*)(vp + 16);
      u32x4 vu = {v0.x, v0.y, v1.x, v1.y};
      bf16x8 vf = __builtin_bit_cast(bf16x8, vu);
      o[d] = MFMA16(vf, pf, o[d]);
    }
  }
}

template <int KW, int DV, bool DIFF>
DI void attn_item(const u16* Q, int qstride, int qcol, int qrow0, const u16* Kb, int kstride, const u16* VT, int L,
                          int nkeys, u16* mixed, int mixcol, float lam, float postscale, const float* subg, char* smem) {
  const int tid = ltid(), lane = tid & 63, wid = tid >> 6, l16 = lane & 15, q4 = lane >> 4;
  const int qsub = wid & 1, var = wid >> 1;
  constexpr int KS = KW + 8;
  constexpr int STAGE = 64 * KS + DV * 72;
  u16* sK0 = (u16*)smem;
  u16* sV0 = sK0 + 64 * KS;
  u16* sK1 = sK0 + STAGE;
  u16* sV1 = sV0 + STAGE;
  constexpr int KPT = KW / 32, VPT = DV / 32, NDT = DV / 16;
  const int kfo = DIFF ? var * 64 : 0;

  const u16* qp = Q + (size_t)(qrow0 + qsub * 16 + l16) * qstride + qcol + var * 64 + q4 * 8;
  const bf16x8 qf0 = *(const bf16x8*)qp;
  const bf16x8 qf1 = *(const bf16x8*)(qp + 32);

  u32x4 kr0[KPT], vr0[VPT], kr1[KPT], vr1[VPT];
  f32x4 o[NDT];
#pragma unroll
  for (int d = 0; d < NDT; ++d) o[d] = f32x4{0.f, 0.f, 0.f, 0.f};
  float m = -INFINITY, l = 0.f;
  const int nkb = nkeys >> 6;
#define SB0 __builtin_amdgcn_sched_barrier(0)
  attn_gload<KW, DV>(Kb, kstride, VT, L, 0, tid, kr0, vr0);
  SB0;
  attn_gload<KW, DV>(Kb, kstride, VT, L, 1, tid, kr1, vr1);
  SB0;
  __syncthreads();
  attn_lstore<KW, DV>(sK0, sV0, tid, kr0, vr0);
  SB0;
  attn_gload<KW, DV>(Kb, kstride, VT, L, 2, tid, kr0, vr0);
  SB0;
  __syncthreads();
#pragma unroll 1
  for (int kb = 0; kb < nkb - 4; kb += 2) {
    SB0;
    attn_lstore<KW, DV>(sK1, sV1, tid, kr1, vr1);
    SB0;
    attn_gload<KW, DV>(Kb, kstride, VT, L, kb + 3, tid, kr1, vr1);
    SB0;
    attn_compute<KW, DV>(sK0, sV0, kfo, l16, q4, qf0, qf1, o, m, l);
    __syncthreads();
    SB0;
    attn_lstore<KW, DV>(sK0, sV0, tid, kr0, vr0);
    SB0;
    attn_gload<KW, DV>(Kb, kstride, VT, L, kb + 4, tid, kr0, vr0);
    SB0;
    attn_compute<KW, DV>(sK1, sV1, kfo, l16, q4, qf0, qf1, o, m, l);
    __syncthreads();
  }
  SB0;
  attn_lstore<KW, DV>(sK1, sV1, tid, kr1, vr1);
  SB0;
  attn_gload<KW, DV>(Kb, kstride, VT, L, nkb - 1, tid, kr1, vr1);
  SB0;
  attn_compute<KW, DV>(sK0, sV0, kfo, l16, q4, qf0, qf1, o, m, l);
  __syncthreads();
  SB0;
  attn_lstore<KW, DV>(sK0, sV0, tid, kr0, vr0);
  SB0;
  attn_compute<KW, DV>(sK1, sV1, kfo, l16, q4, qf0, qf1, o, m, l);
  __syncthreads();
  SB0;
  attn_lstore<KW, DV>(sK1, sV1, tid, kr1, vr1);
  SB0;
  attn_compute<KW, DV>(sK0, sV0, kfo, l16, q4, qf0, qf1, o, m, l);
  __syncthreads();
  SB0;
  attn_compute<KW, DV>(sK1, sV1, kfo, l16, q4, qf0, qf1, o, m, l);
  __syncthreads();
#undef SB0
  l += shx(l, 16);
  l += shx(l, 32);
  const float inv = 1.f / l;
  const int row = qrow0 + qsub * 16 + l16;
  if constexpr (DIFF) {
    __syncthreads();
    float* sO = (float*)smem;
    if (var == 1) {
#pragma unroll
      for (int d = 0; d < NDT; ++d)
        *(float4*)(sO + (qsub * 16 + l16) * 132 + d * 16 + q4 * 4) =
            make_float4(o[d][0] * inv, o[d][1] * inv, o[d][2] * inv, o[d][3] * inv);
    }
    __syncthreads();
    if (var == 0) {
      float ss = 0.f;
#pragma unroll
      for (int d = 0; d < NDT; ++d) {
        float4 o1 = *(const float4*)(sO + (qsub * 16 + l16) * 132 + d * 16 + q4 * 4);
        o[d][0] = o[d][0] * inv - lam * o1.x;
        o[d][1] = o[d][1] * inv - lam * o1.y;
        o[d][2] = o[d][2] * inv - lam * o1.z;
        o[d][3] = o[d][3] * inv - lam * o1.w;
        ss += o[d][0] * o[d][0] + o[d][1] * o[d][1] + o[d][2] * o[d][2] + o[d][3] * o[d][3];
      }
      ss += shx(ss, 16);
      ss += shx(ss, 32);
      const float rs = rsqrtf(ss * (1.f / 128.f) + 1e-6f) * postscale;
#pragma unroll
      for (int d = 0; d < NDT; ++d) {
        float4 gg = *(const float4*)(subg + d * 16 + q4 * 4);
        uint2 ov;
        ov.x = pack2(o[d][0] * rs * gg.x, o[d][1] * rs * gg.y);
        ov.y = pack2(o[d][2] * rs * gg.z, o[d][3] * rs * gg.w);
        *(uint2*)(mixed + (size_t)row * 1024 + mixcol + d * 16 + q4 * 4) = ov;
      }
    }
  } else {
#pragma unroll
    for (int d = 0; d < NDT; ++d) {
      uint2 ov;
      ov.x = pack2(o[d][0] * inv, o[d][1] * inv);
      ov.y = pack2(o[d][2] * inv, o[d][3] * inv);
      *(uint2*)(mixed + (size_t)row * 1024 + mixcol + var * 64 + d * 16 + q4 * 4) = ov;
    }
  }
}

DI void attnA_item(const P& p, int li, int it, char* smem) {
  const int lane = ltid() & 63;
  float d1 = p.in[14][li * 64 + lane] * p.in[15][li * 64 + lane];
  float d2 = p.in[16][li * 64 + lane] * p.in[17][li * 64 + lane];
#pragma unroll
  for (int s = 1; s < 64; s <<= 1) { d1 += shx(d1, s); d2 += shx(d2, s); }
  const float lam_init = 0.8f - 0.6f * expf(-0.3f * (float)li);
  const float lam = expf(d1) - expf(d2) + lam_init;
  const u16* QA = (const u16*)(p.ws + O_QA);
  u16* mixed = (u16*)(p.ws + O_MIXED);
  const float* subg = p.in[18] + li * 128;
  int qrow0, L;
  const u16 *Kb, *VT;
  int h;
  if (it < 256) {
    int b = it >> 7, qb = it & 31;
    h = (it >> 5) & 3;
    Kb = (const u16*)(p.ws + O_KALAT) + (size_t)(li * 2 + b) * 1536 * 512 + h * 128;
    VT = (const u16*)(p.ws + O_VTALAT) + (size_t)((li * 2 + b) * 4 + h) * 128 * 1536;
    qrow0 = NCTX + b * 1024 + qb * 32;
    L = 1536;
  } else {
    it -= 256;
    int b = it >> 5, qb = it & 7;
    h = (it >> 3) & 3;
    Kb = (const u16*)(p.ws + O_KACTX) + (size_t)b * 256 * 512 + h * 128;
    VT = (const u16*)(p.ws + O_VTACTX) + (size_t)(b * 4 + h) * 128 * 256;
    qrow0 = b * 256 + qb * 32;
    L = 256;
  }
  attn_item<128, 128, true>(QA, 512, h * 128, qrow0, Kb, 512, VT, L, L, mixed, h * 128, lam, 1.f - lam_init, subg, smem);
}
DI void attnC_item(const P& p, int li, int it, char* smem) {
  const u16* QC = (const u16*)(p.ws + O_QC);
  u16* mixed = (u16*)(p.ws + O_MIXED);
  int qrow0, L, n;
  const u16 *Kb, *VT;
  if (it < 128) {
    int b = it >> 6, qb = it & 31;
    n = (it >> 5) & 1;
    Kb = (const u16*)(p.ws + O_KCLAT) + (size_t)(li * 2 + b) * 1536 * 128 + n * 64;
    VT = (const u16*)(p.ws + O_VTCLAT) + (size_t)((li * 2 + b) * 2 + n) * 64 * 1536;
    qrow0 = NCTX + b * 1024 + qb * 32;
    L = 1536;
  } else {
    it -= 128;
    int b = it >> 4, qb = it & 7;
    n = (it >> 3) & 1;
    Kb = (const u16*)(p.ws + O_KCCTX) + (size_t)b * 256 * 128 + n * 64;
    VT = (const u16*)(p.ws + O_VTCCTX) + (size_t)(b * 2 + n) * 64 * 256;
    qrow0 = b * 256 + qb * 32;
    L = 256;
  }
  attn_item<64, 64, false>(QC, 256, n * 128, qrow0, Kb, 128, VT, L, L, mixed, 768 + n * 128, 0.f, 1.f, nullptr, smem);
}

DI void h1_item(const P& p, int item, char* smem) {
  const int tid = ltid(), lane = tid & 63, w = tid >> 6, l16 = lane & 15, q4 = lane >> 4;
  const int dir = item & 1, h = (item >> 1) & 3, tc = item >> 3;
  const int row0 = tc * 64;
  float* sQ = (float*)smem;
  float* sB = sQ + 64 * 68;
  float* sK = sB + 64 * 68;
  u16* sVT = (u16*)(sK + 64 * 68);
  float* sTot = (float*)(sVT + 64 * 72);
  const float* HQ = (const float*)(p.ws + O_HQ);
  const float* HG = (const float*)(p.ws + (dir ? O_HGB : O_HGF));
  const float* HI = (const float*)(p.ws + O_HI);
  float* OI = (float*)(p.ws + O_OI) + (size_t)dir * NTOK * 256;
  u16* QE = (u16*)(p.ws + O_QE) + (size_t)dir * NTOK * 256;
  float* KV = (float*)(p.ws + O_KV) + (size_t)item * 4096;
  float* DEC = (float*)(p.ws + O_DEC) + (size_t)item * 64;

  __syncthreads();
#pragma unroll
  for (int i = 0; i < 4; ++i) {
    int idx = tid + 256 * i;
    int lo = idx >> 4, c4 = idx & 15;
    int row = dir ? row0 + 63 - lo : row0 + lo;
    size_t off = (size_t)row * 256 + h * 64 + c4 * 4;
    *(float4*)(sQ + lo * 68 + c4 * 4) = *(const float4*)(HQ + off);
    *(float4*)(sB + lo * 68 + c4 * 4) = *(const float4*)(HG + off);
    float4 v = *(const float4*)(HI + off);
    sVT[(c4 * 4 + 0) * 72 + lo] = f2bf(v.x);
    sVT[(c4 * 4 + 1) * 72 + lo] = f2bf(v.y);
    sVT[(c4 * 4 + 2) * 72 + lo] = f2bf(v.z);
    sVT[(c4 * 4 + 3) * 72 + lo] = f2bf(v.w);
  }
  __syncthreads();
  {
    const int k = tid & 63, part = tid >> 6;
    float run = 0.f;
#pragma unroll 4
    for (int e = 0; e < 16; ++e) {
      int i = part * 16 + e;
      float g = sB[i * 68 + k];
      sK[i * 68 + k] = 1.f - ex2(g * LOG2E);
      run += g * LOG2E;
      sB[i * 68 + k] = run;
    }
    sTot[part * 64 + k] = run;
    __syncthreads();
    float add = 0.f;
    for (int pp = 0; pp < part; ++pp) add += sTot[pp * 64 + k];
    if (part > 0)
      for (int e = 0; e < 16; ++e) sB[(part * 16 + e) * 68 + k] += add;
  }
  __syncthreads();
#pragma unroll
  for (int i = 0; i < 4; ++i) {
    int idx = tid + 256 * i;
    int lo = idx >> 4, c4 = idx & 15;
    int row = dir ? row0 + 63 - lo : row0 + lo;
    f32x4 q = *(const f32x4*)(sQ + lo * 68 + c4 * 4);
    f32x4 bb = *(const f32x4*)(sB + lo * 68 + c4 * 4);
    u32x2 o;
    o.x = pack2(q.x * ex2(bb.x), q.y * ex2(bb.y));
    o.y = pack2(q.z * ex2(bb.z), q.w * ex2(bb.w));
    *(u32x2*)(QE + (size_t)row * 256 + h * 64 + c4 * 4) = o;
  }
  {
    const int I = w;
    bf16x8 qs[2];
    f32x4 rr[2][2];
#pragma unroll
    for (int s = 0; s < 2; ++s) {
      const int kk0 = s * 32 + q4 * 8;
      if (I > 0) {
        rr[s][0] = *(const f32x4*)(sB + (16 * I - 1) * 68 + kk0);
        rr[s][1] = *(const f32x4*)(sB + (16 * I - 1) * 68 + kk0 + 4);
      } else {
        rr[s][0] = f32x4{0.f, 0.f, 0.f, 0.f};
        rr[s][1] = rr[s][0];
      }
      const float* qr = sQ + (16 * I + l16) * 68 + kk0;
      const float* br = sB + (16 * I + l16) * 68 + kk0;
      f32x4 q0 = *(const f32x4*)qr, q1 = *(const f32x4*)(qr + 4);
      f32x4 b0 = *(const f32x4*)br, b1 = *(const f32x4*)(br + 4);
      u32x4 pu;
      pu.x = pack2(q0.x * ex2(b0.x - rr[s][0].x), q0.y * ex2(b0.y - rr[s][0].y));
      pu.y = pack2(q0.z * ex2(b0.z - rr[s][0].z), q0.w * ex2(b0.w - rr[s][0].w));
      pu.z = pack2(q1.x * ex2(b1.x - rr[s][1].x), q1.y * ex2(b1.y - rr[s][1].y));
      pu.w = pack2(q1.z * ex2(b1.z - rr[s][1].z), q1.w * ex2(b1.w - rr[s][1].w));
      qs[s] = __builtin_bit_cast(bf16x8, pu);
    }
    f32x4 at[4];
#pragma unroll
    for (int J = 0; J < 4; ++J) {
      at[J] = f32x4{0.f, 0.f, 0.f, 0.f};
      if (J <= I) {
#pragma unroll
        for (int s = 0; s < 2; ++s) {
          const int kk0 = s * 32 + q4 * 8;
          const float* kr = sK + (16 * J + l16) * 68 + kk0;
          const float* br = sB + (16 * J + l16) * 68 + kk0;
          f32x4 k0 = *(const f32x4*)kr, k1 = *(const f32x4*)(kr + 4);
          f32x4 b0 = *(const f32x4*)br, b1 = *(const f32x4*)(br + 4);
          u32x4 pu;
          pu.x = pack2(k0.x * ex2(fminf(rr[s][0].x - b0.x, 100.f)), k0.y * ex2(fminf(rr[s][0].y - b0.y, 100.f)));
          pu.y = pack2(k0.z * ex2(fminf(rr[s][0].z - b0.z, 100.f)), k0.w * ex2(fminf(rr[s][0].w - b0.w, 100.f)));
          pu.z = pack2(k1.x * ex2(fminf(rr[s][1].x - b1.x, 100.f)), k1.y * ex2(fminf(rr[s][1].y - b1.y, 100.f)));
          pu.w = pack2(k1.z * ex2(fminf(rr[s][1].z - b1.z, 100.f)), k1.w * ex2(fminf(rr[s][1].w - b1.w, 100.f)));
          bf16x8 kf = __builtin_bit_cast(bf16x8, pu);
          at[J] = MFMA16(kf, qs[s], at[J]);
        }
        if (J == I) {
#pragma unroll
          for (int r = 0; r < 4; ++r)
            if (q4 * 4 + r > l16) at[J][r] = 0.f;
        }
      }
    }
    f32x4 oc[4];
#pragma unroll
    for (int vt = 0; vt < 4; ++vt) oc[vt] = f32x4{0.f, 0.f, 0.f, 0.f};
#pragma unroll
    for (int ks = 0; ks < 2; ++ks) {
      if (2 * ks <= I) {
        u32x4 pu;
        pu.x = pack2(at[2 * ks][0], at[2 * ks][1]);
        pu.y = pack2(at[2 * ks][2], at[2 * ks][3]);
        pu.z = pack2(at[2 * ks + 1][0], at[2 * ks + 1][1]);
        pu.w = pack2(at[2 * ks + 1][2], at[2 * ks + 1][3]);
        bf16x8 pf = __builtin_bit_cast(bf16x8, pu);
#pragma unroll
        for (int vt = 0; vt < 4; ++vt) {
          const u16* vp = sVT + (vt * 16 + l16) * 72 + ks * 32 + q4 * 4;
          u32x2 v0 = *(const u32x2*)vp;
          u32x2 v1 = *(const u32x2*)(vp + 16);
          u32x4 vu = {v0.x, v0.y, v1.x, v1.y};
          oc[vt] = MFMA16(__builtin_bit_cast(bf16x8, vu), pf, oc[vt]);
        }
      }
    }
    {
      const int t = 16 * I + l16;
      const int row = dir ? row0 + 63 - t : row0 + t;
#pragma unroll
      for (int vt = 0; vt < 4; ++vt) *(f32x4*)(OI + (size_t)row * 256 + h * 64 + vt * 16 + q4 * 4) = oc[vt];
    }
  }
  {
    const int k = 16 * w + l16;
    const float bend = sB[63 * 68 + k];
    f32x4 kc[4];
#pragma unroll
    for (int vt = 0; vt < 4; ++vt) kc[vt] = f32x4{0.f, 0.f, 0.f, 0.f};
#pragma unroll
    for (int ks = 0; ks < 2; ++ks) {
      float kd[8];
#pragma unroll
      for (int j = 0; j < 8; ++j) {
        const int s = ks * 32 + q4 * 8 + j;
        kd[j] = sK[s * 68 + k] * ex2(bend - sB[s * 68 + k]);
      }
      u32x4 pu;
      pu.x = pack2(kd[0], kd[1]);
      pu.y = pack2(kd[2], kd[3]);
      pu.z = pack2(kd[4], kd[5]);
      pu.w = pack2(kd[6], kd[7]);
      bf16x8 af = __builtin_bit_cast(bf16x8, pu);
#pragma unroll
      for (int vt = 0; vt < 4; ++vt) {
        bf16x8 vf = *(const bf16x8*)(sVT + (vt * 16 + l16) * 72 + ks * 32 + q4 * 8);
        kc[vt] = MFMA16(af, vf, kc[vt]);
      }
    }
#pragma unroll
    for (int vt = 0; vt < 4; ++vt)
#pragma unroll
      for (int r = 0; r < 4; ++r) KV[(16 * w + q4 * 4 + r) * 64 + vt * 16 + l16] = kc[vt][r];
    if (q4 == 0) DEC[k] = ex2(bend);
  }
}

DI void h2_item(const P& p, int li, int item, char* smem) {
  const int tid = ltid(), ty = tid >> 4, tx = tid & 15;
  const int lane = tid & 63, w = tid >> 6, l16 = lane & 15, q4 = lane >> 4;
  const int h = item & 3, tc = item >> 2, row0 = tc * 64;
  const bool lat = tc >= 64;
  int seq, cl, nc;
  if (!lat) { seq = tc >> 2; cl = tc & 3; nc = 4; } else { seq = (tc - 64) >> 4; cl = (tc - 64) & 15; nc = 16; }
  const int tcbase = tc - cl;
  u16* sST = (u16*)smem;
  const float* KVb = (const float*)(p.ws + O_KV);
  const float* DECb = (const float*)(p.ws + O_DEC);
  __syncthreads();
#pragma unroll 1
  for (int dir = 0; dir < 2; ++dir) {
    float4 S[4];
#pragma unroll
    for (int a = 0; a < 4; ++a) {
      if (lat) S[a] = *(const float4*)(p.in[6 + dir] + ((size_t)((seq * 2 + li) * 4 + h) * 64 + ty + 16 * a) * 64 + tx * 4);
      else S[a] = make_float4(0.f, 0.f, 0.f, 0.f);
    }
    const int nprev = dir == 0 ? cl : nc - 1 - cl;
#pragma unroll 1
    for (int j = 0; j < nprev; ++j) {
      int tcj = tcbase + (dir == 0 ? j : nc - 1 - j);
      size_t itj = (size_t)((tcj * 4 + h) * 2 + dir);
#pragma unroll
      for (int a = 0; a < 4; ++a) {
        int k = ty + 16 * a;
        float dcy = DECb[itj * 64 + k];
        float4 kv = *(const float4*)(KVb + itj * 4096 + k * 64 + tx * 4);
        S[a].x = dcy * S[a].x + kv.x; S[a].y = dcy * S[a].y + kv.y; S[a].z = dcy * S[a].z + kv.z; S[a].w = dcy * S[a].w + kv.w;
      }
    }
    if (!lat && nprev == nc - 1) {
      size_t itj = (size_t)((tc * 4 + h) * 2 + dir);
      float* so = p.out + (dir == 0 ? OUT_SF : OUT_SB) + (size_t)((seq * 2 + li) * 4 + h) * 4096;
#pragma unroll
      for (int a = 0; a < 4; ++a) {
        int k = ty + 16 * a;
        float dcy = DECb[itj * 64 + k];
        float4 kv = *(const float4*)(KVb + itj * 4096 + k * 64 + tx * 4);
        *(float4*)(so + k * 64 + tx * 4) = make_float4(dcy * S[a].x + kv.x, dcy * S[a].y + kv.y, dcy * S[a].z + kv.z, dcy * S[a].w + kv.w);
      }
    }
    u16* st = sST + dir * 64 * 72;
#pragma unroll
    for (int a = 0; a < 4; ++a) {
      int k = ty + 16 * a;
      st[(tx * 4 + 0) * 72 + k] = f2bf(S[a].x);
      st[(tx * 4 + 1) * 72 + k] = f2bf(S[a].y);
      st[(tx * 4 + 2) * 72 + k] = f2bf(S[a].z);
      st[(tx * 4 + 3) * 72 + k] = f2bf(S[a].w);
    }
  }
  __syncthreads();
  f32x4 oc[4];
#pragma unroll
  for (int vt = 0; vt < 4; ++vt) oc[vt] = f32x4{0.f, 0.f, 0.f, 0.f};
#pragma unroll
  for (int dir = 0; dir < 2; ++dir) {
    const u16* QE = (const u16*)(p.ws + O_QE) + (size_t)dir * NTOK * 256 + (size_t)(row0 + 16 * w + l16) * 256 + h * 64 + q4 * 8;
    const u16* st = sST + dir * 64 * 72;
#pragma unroll
    for (int ks = 0; ks < 2; ++ks) {
      bf16x8 af = *(const bf16x8*)(QE + ks * 32);
#pragma unroll
      for (int vt = 0; vt < 4; ++vt) {
        bf16x8 bf = *(const bf16x8*)(st + (vt * 16 + l16) * 72 + ks * 32 + q4 * 8);
        oc[vt] = MFMA16(af, bf, oc[vt]);
      }
    }
  }
  const float* OI0 = (const float*)(p.ws + O_OI);
  const float* OI1 = OI0 + (size_t)NTOK * 256;
  const float* HSG = (const float*)(p.ws + O_HSG);
  u16* mixed = (u16*)(p.ws + O_MIXED);
  float gn[4];
#pragma unroll
  for (int vt = 0; vt < 4; ++vt) gn[vt] = p.in[21][li * 64 + vt * 16 + l16];
#pragma unroll
  for (int r = 0; r < 4; ++r) {
    const int row = row0 + 16 * w + q4 * 4 + r;
    const size_t off = (size_t)row * 256 + h * 64 + l16;
    float val[4];
    float ss = 0.f;
#pragma unroll
    for (int vt = 0; vt < 4; ++vt) {
      val[vt] = oc[vt][r] + OI0[off + vt * 16] + OI1[off + vt * 16];
      ss += val[vt] * val[vt];
    }
    ss = red16(ss);
    const float rs = rsqrtf(ss * (1.f / 64.f) + 1e-6f);
#pragma unroll
    for (int vt = 0; vt < 4; ++vt)
      mixed[(size_t)row * 1024 + 512 + h * 64 + vt * 16 + l16] = f2bf(val[vt] * rs * gn[vt] * HSG[off + vt * 16]);
  }
}

DI void ln_apply(const P& p, const float* lo, const float* hi, const float* stats, const float* lng, const float* lnb,
                 const float* mods, int sc_off, int sh_off) {
  const int lane = ltid() & 63, wid = ltid() >> 6;
  u16* dst = (u16*)(p.ws + O_ABF);
  for (int it = blockIdx.x; it < NTOK / 4; it += gridDim.x) {
    const int row = it * 4 + wid;
    float mu = 0.f, rs = 1.f;
    if (stats != nullptr) {
      float s1 = 0.f, s2 = 0.f;
      if (lane < 16) {
        float2 v = *(const float2*)(stats + (size_t)row * 32 + lane * 2);
        s1 = v.x;
        s2 = v.y;
      }
#pragma unroll
      for (int s = 1; s < 16; s <<= 1) { s1 += shx(s1, s); s2 += shx(s2, s); }
      s1 = __shfl(s1, 0, 64);
      s2 = __shfl(s2, 0, 64);
      mu = s1 * (1.f / 1024.f);
      rs = rsqrtf(fmaxf(s2 * (1.f / 1024.f) - mu * mu, 0.f) + 1e-6f);
    }
    const float* x = row < NCTX ? lo + (size_t)row * 1024 : hi + (size_t)(row - NCTX) * 1024;
    const int rtype = row < NCTX ? 0 : 1 + ((row - NCTX) >> 10);
    const float* mv = mods + rtype * 6144;
#pragma unroll
    for (int i = 0; i < 4; ++i) {
      const int c = (lane + 64 * i) * 4;
      f32x4 v = *(const f32x4*)(x + c);
      f32x4 sc = *(const f32x4*)(mv + sc_off + c) + 1.f;
      f32x4 sh = *(const f32x4*)(mv + sh_off + c);
      if (stats != nullptr) {
        f32x4 gg = *(const f32x4*)(lng + c);
        f32x4 bb = *(const f32x4*)(lnb + c);
        v = (v - mu) * rs * gg + bb;
      }
      v = v * sc + sh;
      u32x2 o;
      o.x = pack2(v.x, v.y);
      o.y = pack2(v.z, v.w);
      *(u32x2*)(dst + (size_t)row * 1024 + c) = o;
    }
  }
}

DI void final_ln(const P& p) {
  const int lane = ltid() & 63, wid = ltid() >> 6;
  const float* X = (const float*)(p.ws + O_XPRE2);
  const float* ST = (const float*)(p.ws + O_ST2);
  const float* g = p.in[26] + 1024;
  const float* bb = p.in[27] + 1024;
  for (int it = blockIdx.x; it < NTOK / 4; it += gridDim.x) {
    int row = it * 4 + wid;
    float s1 = 0.f, s2 = 0.f;
    if (lane < 16) {
      float2 v = *(const float2*)(ST + (size_t)row * 32 + lane * 2);
      s1 = v.x;
      s2 = v.y;
    }
#pragma unroll
    for (int s = 1; s < 16; s <<= 1) { s1 += shx(s1, s); s2 += shx(s2, s); }
    s1 = __shfl(s1, 0, 64);
    s2 = __shfl(s2, 0, 64);
    float mu = s1 * (1.f / 1024.f);
    float rs = rsqrtf(fmaxf(s2 * (1.f / 1024.f) - mu * mu, 0.f) + 1e-6f);
    float* out = p.out + (row < NCTX ? OUT_YP + (size_t)row * 1024 : OUT_YS + (size_t)(row - NCTX) * 1024);
#pragma unroll
    for (int i = 0; i < 4; ++i) {
      int c = (lane + 64 * i) * 4;
      float4 x = *(const float4*)(X + (size_t)row * 1024 + c);
      float4 gg = *(const float4*)(g + c);
      float4 b4 = *(const float4*)(bb + c);
      *(float4*)(out + c) = make_float4((x.x - mu) * rs * gg.x + b4.x, (x.y - mu) * rs * gg.y + b4.y,
                                         (x.z - mu) * rs * gg.z + b4.z, (x.w - mu) * rs * gg.w + b4.w);
    }
  }
}

DI void run_phase(const P& p, int ph, char* smem, int sub = 0) {
  if (ph == 0) { phase0(p, smem); return; }
  if (ph == NPHASE - 1) { final_ln(p); return; }
  const int li = (ph - 1) >> 3, s = (ph - 1) & 7;
  float* XPRE1 = (float*)(p.ws + O_XPRE1);
  float* XPRE2 = (float*)(p.ws + O_XPRE2);
  float* ST1 = (float*)(p.ws + O_ST1);
  float* ST2 = (float*)(p.ws + O_ST2);
  GA g;
  g.mods = (const float*)(p.ws + O_MODS) + li * 3 * 6144;
  g.a16 = (const u16*)(p.ws + O_ABF); g.xout = nullptr; g.sout = nullptr; g.hid = nullptr;
  g.alo = nullptr; g.ahi = nullptr; g.stats = nullptr; g.lng = nullptr; g.lnb = nullptr; g.sc_off = 0; g.sh_off = 0;
  const float* xin_lo = li == 0 ? p.in[0] : XPRE2;
  const float* xin_hi = li == 0 ? p.in[1] : XPRE2 + (size_t)NCTX * 1024;
  const float* xin_st = li == 0 ? nullptr : ST2;
  const float* xin_g = p.in[26] + (li == 0 ? 0 : (li - 1) * 1024);
  const float* xin_b = p.in[27] + (li == 0 ? 0 : (li - 1) * 1024);
  if (s == 0) {
    ln_apply(p, xin_lo, xin_hi, xin_st, xin_g, xin_b, g.mods, 1024, 0);
  } else if (s == 1) {
    g.bt = (const u16*)(p.ws + O_WTIN) + (size_t)li * NIN * D; g.K = D; g.N = NIN;
    gemm_phase<0>(p, g, li, smem);
  } else if (s == 2) {
    for (int it = blockIdx.x; it < 1664; it += gridDim.x) {
      if (it >= 384 && it < 1152) h1_item(p, it - 384, smem);
      else if (it >= 256 && it < 384) attnC_item(p, li, it - 256, smem);
      else attnA_item(p, li, it < 256 ? it : it - 896, smem);
    }
  } else if (s == 3) {
    for (int it = blockIdx.x; it < 640; it += gridDim.x) {
      if (it < 384) h2_item(p, li, it, smem);
      else attnC_item(p, li, it - 384 + 128, smem);
    }
  } else if (s == 4) {
    g.alo = xin_lo; g.ahi = xin_hi; g.stats = xin_st; g.lng = xin_g; g.lnb = xin_b;
    g.sc_off = 2048;
    g.a16 = (const u16*)(p.ws + O_MIXED);
    g.bt = (const u16*)(p.ws + O_WTOUT) + (size_t)li * D * D; g.K = D; g.N = D;
    g.xout = XPRE1; g.sout = ST1;
    gemm_phase<1>(p, g, li, smem);
  } else if (s == 5) {
    ln_apply(p, XPRE1, XPRE1 + (size_t)NCTX * 1024, ST1, p.in[24] + li * 1024, p.in[25] + li * 1024, g.mods, 4096, 3072);
  } else if (s == 6) {
    g.bt = (const u16*)(p.ws + O_WTFF1) + (size_t)li * DFF * D; g.K = D; g.N = DFF;
    g.hid = (u16*)(p.ws + O_HID);
    gemm_phase<2>(p, g, li, smem);
  } else {
    g.alo = XPRE1; g.ahi = XPRE1 + (size_t)NCTX * 1024; g.stats = ST1; g.lng = p.in[24] + li * 1024; g.lnb = p.in[25] + li * 1024;
    g.sc_off = 5120;
    g.a16 = (const u16*)(p.ws + O_HID);
    g.bt = (const u16*)(p.ws + O_WTFF2) + (size_t)li * D * DFF; g.K = DFF; g.N = D;
    g.xout = XPRE2; g.sout = ST2;
    gemm_phase<1>(p, g, li, smem);
  }
}

#define XB_TMO      128
#define XB_XCNT(j)  (256  + 64 * (j))
#define XB_XSUB(j)  (1280 + 64 * (j))
#define XB_XGEN(j)  (2304 + 64 * (j))
#define XB_TOP      3328
#define XB_TOPGEN   3392
#define XCD_BAR_WORDS 3456
#define XB_SPIN_CAP (1u << 20)
#define LAS __attribute__((address_space(3)))
DI unsigned xb_ld(unsigned* p) { return __hip_atomic_load(p, __ATOMIC_RELAXED, __HIP_MEMORY_SCOPE_AGENT); }
DI unsigned xb_add(unsigned* p, unsigned v) { return __hip_atomic_fetch_add(p, v, __ATOMIC_RELAXED, __HIP_MEMORY_SCOPE_AGENT); }
DI unsigned xb_xcc_id() { return (unsigned)__builtin_amdgcn_s_getreg((3 << 11) | 20) & 0xFu; }
#define XB_SPIN(cond, bar) do { unsigned _sp = 0; while (cond) { __builtin_amdgcn_s_sleep(1); \
    if ((++_sp & 255u) == 0u) { if (xb_ld(&(bar)[XB_TMO])) break; if (_sp > XB_SPIN_CAP) { atomicAdd(&(bar)[XB_TMO], 1u); break; } } } } while (0)
struct XcdBarrier { unsigned* bar; unsigned x; volatile LAS unsigned* st; };
DI XcdBarrier xcd_barrier_post(unsigned* bar, volatile LAS unsigned* st) {
  XcdBarrier b; b.bar = bar; b.x = xb_xcc_id(); b.st = st;
  if (threadIdx.x == 0) (void)xb_add(&bar[XB_XCNT(b.x)], 1u);
  return b;
}
DI void xcd_barrier_complete(unsigned* bar, unsigned x, unsigned& nloc, unsigned& nx) {
  const unsigned G = gridDim.x * gridDim.y * gridDim.z;
  unsigned sum, cnt, mine, sp = 0u;
  for (;;) {
    sum = 0u; cnt = 0u; mine = 0u;
#pragma unroll
    for (unsigned j = 0; j < 16; ++j) { const unsigned c = xb_ld(&bar[XB_XCNT(j)]); sum += c; cnt += (c > 0u) ? 1u : 0u; mine = (j == x) ? c : mine; }
    if (sum == G) break;
    __builtin_amdgcn_s_sleep(1);
    if ((++sp & 255u) == 0u) { if (xb_ld(&bar[XB_TMO])) break; if (sp > XB_SPIN_CAP) { atomicAdd(&bar[XB_TMO], 1u); break; } }
  }
  nloc = mine > 0u ? mine : 1u; nx = cnt > 0u ? cnt : 1u;
}
DI void xcd_barrier(const XcdBarrier& b) {
  asm volatile("s_waitcnt vmcnt(0)" ::: "memory");
  __syncthreads();
  if (threadIdx.x == 0) {
    unsigned* bar = b.bar;
    __builtin_amdgcn_s_waitcnt(0);
    unsigned nloc = b.st[0], nx = b.st[1];
    if (nloc == 0u) { xcd_barrier_complete(bar, b.x, nloc, nx); b.st[0] = nloc; b.st[1] = nx; }
    const unsigned old = xb_add(&bar[XB_XSUB(b.x)], 1u);
    const unsigned gen = old / nloc;
    if (old + 1u == (gen + 1u) * nloc) {
      __builtin_amdgcn_fence(__ATOMIC_RELEASE, "agent");
      asm volatile("s_waitcnt vmcnt(0)" ::: "memory");
      const unsigned og = xb_add(&bar[XB_TOP], 1u);
      const unsigned tg = og / nx;
      if (og + 1u == (tg + 1u) * nx) xb_add(&bar[XB_TOPGEN], 1u);
      else XB_SPIN(xb_ld(&bar[XB_TOPGEN]) == tg, bar);
      __builtin_amdgcn_fence(__ATOMIC_ACQUIRE, "agent");
      xb_add(&bar[XB_XGEN(b.x)], 1u);
      asm volatile("s_waitcnt vmcnt(0)" ::: "memory");
    } else {
      XB_SPIN(xb_ld(&bar[XB_XGEN(b.x)]) == gen, bar);
      __builtin_amdgcn_fence(__ATOMIC_ACQUIRE, "agent");
      asm volatile("s_waitcnt vmcnt(0)" ::: "memory");
    }
  }
  __syncthreads();
}
constexpr size_t O_BAR = O_END1;
static_assert(O_BAR + XCD_BAR_WORDS * 4 <= (size_t)256 * 1024 * 1024, "barrier words must fit");

#if !MULTI_LAUNCH
__global__ void __launch_bounds__(256, 2) mega_kernel(P p) {
  extern __shared__ __attribute__((aligned(16))) char smem[];
  cg::grid_group grid = cg::this_grid();
  if (p.ws == nullptr) grid.sync();
  if (threadIdx.x == 0) *(uint4*)(smem + LDS_BYTES - 16) = make_uint4(0u, 0u, 0u, 0u);
  __syncthreads();
  XcdBarrier xb = xcd_barrier_post((unsigned*)(p.ws + O_BAR), (volatile LAS unsigned*)(smem + LDS_BYTES - 16));
  run_phase(p, 0, smem); xcd_barrier(xb);
  run_phase(p, 1, smem); xcd_barrier(xb);
  run_phase(p, 2, smem); xcd_barrier(xb);
  run_phase(p, 3, smem); xcd_barrier(xb);
  run_phase(p, 4, smem); xcd_barrier(xb);
  run_phase(p, 5, smem); xcd_barrier(xb);
  run_phase(p, 6, smem); xcd_barrier(xb);
  run_phase(p, 7, smem); xcd_barrier(xb);
  run_phase(p, 8, smem); xcd_barrier(xb);
  run_phase(p, 9, smem); xcd_barrier(xb);
  run_phase(p, 10, smem); xcd_barrier(xb);
  run_phase(p, 11, smem); xcd_barrier(xb);
  run_phase(p, 12, smem); xcd_barrier(xb);
  run_phase(p, 13, smem); xcd_barrier(xb);
  run_phase(p, 14, smem); xcd_barrier(xb);
  run_phase(p, 15, smem); xcd_barrier(xb);
  run_phase(p, 16, smem); xcd_barrier(xb);
  run_phase(p, 17, smem);
}
#define MAIN_KERNEL mega_kernel
#else
__global__ void __launch_bounds__(256, 2) phase_kernel(P p, int ph, int sub) {
  extern __shared__ __attribute__((aligned(16))) char smem[];
  run_phase(p, ph, smem, sub);
}
#define MAIN_KERNEL phase_kernel
#endif

extern "C" void kernel_launch(void* const* d_in, const int* in_sizes, int n_in, void* d_out, int out_size, void* d_ws,
                              size_t ws_size, hipStream_t stream) {
  static int grid_blocks = 0;
  if (!grid_blocks) {
    int dev = 0, cus = 0, per_cu = 0;
    (void)hipGetDevice(&dev);
    (void)hipDeviceGetAttribute(&cus, hipDeviceAttributeMultiprocessorCount, dev);
    (void)hipFuncSetAttribute((const void*)MAIN_KERNEL, hipFuncAttributeMaxDynamicSharedMemorySize, LDS_BYTES);
    (void)hipOccupancyMaxActiveBlocksPerMultiprocessor(&per_cu, MAIN_KERNEL, 256, LDS_BYTES);
    if (per_cu > 2) per_cu = 2;
    if (per_cu < 1) per_cu = 1;
    grid_blocks = cus * per_cu;
  }
  P p{};
  for (int i = 0; i < 30; ++i) p.in[i] = (const float*)d_in[i];
  p.out = (float*)d_out;
  p.ws = (char*)d_ws;
#if MULTI_LAUNCH
  for (int ph = 0; ph < NPHASE; ++ph) {
    phase_kernel<<<dim3(grid_blocks), dim3(256), LDS_BYTES, stream>>>(p, ph, 0);
#ifdef DUP_MASK
    int bit = (ph == 0) ? 8 : (ph == NPHASE - 1 ? 9 : (ph - 1) & 7);
    if ((DUP_MASK >> bit) & 1) phase_kernel<<<dim3(grid_blocks), dim3(256), LDS_BYTES, stream>>>(p, ph, DUP_SUB);
#endif
  }
#else
  (void)hipMemsetAsync((char*)d_ws + O_BAR, 0, XCD_BAR_WORDS * 4, stream);
  void* args[] = {&p};
  hipError_t e = hipLaunchCooperativeKernel((void*)mega_kernel, dim3(grid_blocks), dim3(256), args, LDS_BYTES, stream);
  if (e != hipSuccess) fprintf(stderr, "cooperative launch failed: %s (grid %d)\n", hipGetErrorString(e), grid_blocks);
#endif
}
```

```cpp
#include <hip/hip_runtime.h>
#include <hip/hip_cooperative_groups.h>
#include <stdint.h>
#include <stdio.h>
namespace cg = cooperative_groups;

#ifndef MULTI_LAUNCH
#define MULTI_LAUNCH 0
#endif

#define DI __device__ __forceinline__
typedef unsigned short u16;
using bf16x8 = __attribute__((ext_vector_type(8))) short;
using f32x4 = __attribute__((ext_vector_type(4))) float;
typedef __bf16 bf2_t __attribute__((ext_vector_type(2)));
typedef float f2_t __attribute__((ext_vector_type(2)));
typedef unsigned u32x4 __attribute__((ext_vector_type(4)));
typedef unsigned u32x2 __attribute__((ext_vector_type(2)));

constexpr int D = 1024, NTOK = 6144, NCTX = 4096, NIN = 3328, DFF = 4096;
constexpr float ALPHA = 1.41421356237309515f;
constexpr float LOG2E = 1.44269504088896341f;
constexpr int LDS_BYTES = 75776;
constexpr int NPHASE = 18;

constexpr size_t O_WTIN = 0;
constexpr size_t O_WTOUT = O_WTIN + (size_t)2 * NIN * D * 2;
constexpr size_t O_WTFF1 = O_WTOUT + (size_t)2 * D * D * 2;
constexpr size_t O_WTFF2 = O_WTFF1 + (size_t)2 * DFF * D * 2;
constexpr size_t O_MODS = O_WTFF2 + (size_t)2 * D * DFF * 2;
constexpr size_t O_ROPE = O_MODS + (size_t)2 * 3 * 6144 * 4;
constexpr size_t O_QA = O_ROPE + (size_t)1024 * 32 * 2 * 4;
constexpr size_t O_KACTX = O_QA + (size_t)NTOK * 512 * 2;
constexpr size_t O_KALAT = O_KACTX + (size_t)NCTX * 512 * 2;
constexpr size_t O_VTACTX = O_KALAT + (size_t)2 * 2 * 1536 * 512 * 2;
constexpr size_t O_VTALAT = O_VTACTX + (size_t)16 * 4 * 128 * 256 * 2;
constexpr size_t O_QC = O_VTALAT + (size_t)2 * 2 * 4 * 128 * 1536 * 2;
constexpr size_t O_KCCTX = O_QC + (size_t)NTOK * 256 * 2;
constexpr size_t O_KCLAT = O_KCCTX + (size_t)NCTX * 128 * 2;
constexpr size_t O_VTCCTX = O_KCLAT + (size_t)2 * 2 * 1536 * 128 * 2;
constexpr size_t O_VTCLAT = O_VTCCTX + (size_t)16 * 2 * 64 * 256 * 2;
constexpr size_t O_KV = O_VTCLAT + (size_t)2 * 2 * 2 * 64 * 1536 * 2;
constexpr size_t O_DEC = O_KV + (size_t)768 * 4096 * 4;
constexpr size_t O_MIXED = O_DEC + (size_t)768 * 64 * 4;
constexpr size_t O_XPRE1 = O_MIXED + (size_t)NTOK * 1024 * 2;
constexpr size_t O_ST1 = O_XPRE1 + (size_t)NTOK * 1024 * 4;
constexpr size_t O_XPRE2 = O_ST1 + (size_t)NTOK * 32 * 4;
constexpr size_t O_ST2 = O_XPRE2 + (size_t)NTOK * 1024 * 4;
constexpr size_t O_ABF = O_ST2 + (size_t)NTOK * 32 * 4;
constexpr size_t O_HQ = O_ABF + (size_t)NTOK * 1024 * 2;
constexpr size_t O_HGF = O_HQ + (size_t)NTOK * 256 * 4;
constexpr size_t O_HGB = O_HGF + (size_t)NTOK * 256 * 4;
constexpr size_t O_HI = O_HGB + (size_t)NTOK * 256 * 4;
constexpr size_t O_HSG = O_HI + (size_t)NTOK * 256 * 4;
constexpr size_t O_OI = O_HSG + (size_t)NTOK * 256 * 4;
constexpr size_t O_QE = O_OI + (size_t)2 * NTOK * 256 * 4;
constexpr size_t O_END1 = O_QE + (size_t)2 * NTOK * 256 * 4;
constexpr size_t O_HID = O_HQ;
constexpr size_t O_END2 = O_HID + (size_t)NTOK * 4096 * 2;
static_assert(O_END2 <= O_END1, "HID alias must fit");
static_assert(O_END1 <= (size_t)256 * 1024 * 1024, "workspace too big");

constexpr size_t OUT_YP = 0, OUT_YS = 4194304, OUT_AK = 6291456, OUT_AV = 10485760, OUT_CK = 14680064,
                 OUT_CV = 15728640, OUT_SF = 16777216, OUT_SB = 17301504;

struct P {
  const float* in[30];
  float* out;
  char* ws;
};

DI unsigned pack2(float a, float b) {
  f2_t v = {a, b};
  bf2_t r = __builtin_convertvector(v, bf2_t);
  return __builtin_bit_cast(unsigned, r);
}
DI u16 f2bf(float x) { return (u16)(pack2(x, 0.f) & 0xffffu); }
DI float ex2(float x) { return __builtin_amdgcn_exp2f(x); }
DI float siluf(float x) { return x / (1.f + expf(-x)); }
DI float shx(float v, int m) { return __shfl_xor(v, m, 64); }
DI float red16(float x) {
  x += __builtin_bit_cast(float, __builtin_amdgcn_update_dpp(0, __builtin_bit_cast(int, x), 0xB1, 0xF, 0xF, true));
  x += __builtin_bit_cast(float, __builtin_amdgcn_update_dpp(0, __builtin_bit_cast(int, x), 0x4E, 0xF, 0xF, true));
  x += __builtin_bit_cast(float, __builtin_amdgcn_update_dpp(0, __builtin_bit_cast(int, x), 0x141, 0xF, 0xF, true));
  x += __builtin_bit_cast(float, __builtin_amdgcn_update_dpp(0, __builtin_bit_cast(int, x), 0x140, 0xF, 0xF, true));
  return x;
}
DI float xor1(float x) { return __builtin_bit_cast(float, __builtin_amdgcn_update_dpp(0, __builtin_bit_cast(int, x), 0xB1, 0xF, 0xF, true)); }
DI int ltid() { int t = threadIdx.x; asm volatile("" : "+v"(t)); return t; }
#define MFMA16(a, b, c) __builtin_amdgcn_mfma_f32_16x16x32_bf16((a), (b), (c), 0, 0, 0)

DI void p0_mod(const P& p, int item, char* smem) {
  float* ssilu = (float*)smem;
  float* red = ssilu + 3072;
  const int tid = ltid();
  __syncthreads();
  for (int i = tid; i < 3072; i += 256) {
    int w = i >> 10, k = i & 1023;
    float v = (w == 0) ? p.in[9][k] : p.in[8][(w - 1) * 1024 + k];
    ssilu[i] = siluf(v);
  }
  __syncthreads();
  const int li = item / 96, j0 = (item % 96) * 64;
  const int c4 = tid & 15, kp = tid >> 4;
  const float* W = p.in[10] + (size_t)li * 1024 * 6144 + j0 + c4 * 4;
  float4 a0 = {0, 0, 0, 0}, a1 = a0, a2 = a0;
#pragma unroll 16
  for (int kk = 0; kk < 64; ++kk) {
    int k = kp * 64 + kk;
    float4 w4 = *(const float4*)(W + (size_t)k * 6144);
    float s0 = ssilu[k], s1 = ssilu[1024 + k], s2 = ssilu[2048 + k];
    a0.x += s0 * w4.x; a0.y += s0 * w4.y; a0.z += s0 * w4.z; a0.w += s0 * w4.w;
    a1.x += s1 * w4.x; a1.y += s1 * w4.y; a1.z += s1 * w4.z; a1.w += s1 * w4.w;
    a2.x += s2 * w4.x; a2.y += s2 * w4.y; a2.z += s2 * w4.z; a2.w += s2 * w4.w;
  }
  *(float4*)(red + (kp * 3 + 0) * 64 + c4 * 4) = a0;
  *(float4*)(red + (kp * 3 + 1) * 64 + c4 * 4) = a1;
  *(float4*)(red + (kp * 3 + 2) * 64 + c4 * 4) = a2;
  __syncthreads();
  if (tid < 192) {
    int w = tid >> 6, c = tid & 63;
    float s = p.in[11][li * 6144 + j0 + c];
    for (int q = 0; q < 16; ++q) s += red[(q * 3 + w) * 64 + c];
    ((float*)(p.ws + O_MODS))[(li * 3 + w) * 6144 + j0 + c] = s;
  }
}

DI void p0_rope(const P& p, int item) {
  float* R = (float*)(p.ws + O_ROPE);
  for (int i = ltid(); i < 4096; i += 256) {
    int idx = item * 4096 + i;
    int t = idx >> 5, pp = idx & 31;
    float inv = powf(10000.f, -(float)(pp & 15) / 16.f);
    float pos = (pp < 16) ? (float)(t >> 6) : (float)(t & 63);
    float ang = pos * inv;
    R[idx * 2] = cosf(ang);
    R[idx * 2 + 1] = sinf(ang);
  }
}

DI void p0_copyk(const P& p, int item, bool isA) {
  const int W = isA ? 512 : 128;
  const float* src = isA ? p.in[2] : p.in[4];
  u16* dst = (u16*)(p.ws + (isA ? O_KALAT : O_KCLAT));
  for (int i = 0; i < 4; ++i) {
    size_t e = (size_t)item * 4096 + (size_t)(ltid() + 256 * i) * 4;
    float4 v = *(const float4*)(src + e);
    int c = (int)(e % W);
    size_t r = e / W;
    int pp = (int)(r % 512);
    int bl = (int)(r / 512);
    int b = bl >> 1, li = bl & 1;
    uint2 o;
    o.x = pack2(v.x, v.y);
    o.y = pack2(v.z, v.w);
    *(uint2*)(dst + ((size_t)((li * 2 + b) * 1536 + 1024 + pp)) * W + c) = o;
  }
}

struct TDesc { const float* src; int sstride; u16* dst; int dstride; };

DI TDesc tdesc(const P& p, int t) {
  constexpr int T_IN = 1664, T_OUT = 512, T_FF1 = 2048, T_FF2 = 2048, T_AV = 256;
  TDesc d;
  if (t < T_IN) {
    int li = t / 832, r = t % 832, kt = r / 52, nt = r % 52;
    d.src = p.in[12] + (size_t)li * 1024 * NIN + (size_t)(kt * 64) * NIN + nt * 64; d.sstride = NIN;
    d.dst = (u16*)(p.ws + O_WTIN) + (size_t)li * NIN * 1024 + (size_t)(nt * 64) * 1024 + kt * 64; d.dstride = 1024;
  } else if ((t -= T_IN) < T_OUT) {
    int li = t / 256, r = t % 256, kt = r / 16, nt = r % 16;
    d.src = p.in[13] + (size_t)li * 1024 * 1024 + (size_t)(kt * 64) * 1024 + nt * 64; d.sstride = 1024;
    d.dst = (u16*)(p.ws + O_WTOUT) + (size_t)li * 1024 * 1024 + (size_t)(nt * 64) * 1024 + kt * 64; d.dstride = 1024;
  } else if ((t -= T_OUT) < T_FF1) {
    int li = t / 1024, r = t % 1024, kt = r / 64, nt = r % 64;
    d.src = p.in[28] + (size_t)li * 1024 * DFF + (size_t)(kt * 64) * DFF + nt * 64; d.sstride = DFF;
    d.dst = (u16*)(p.ws + O_WTFF1) + (size_t)li * DFF * 1024 + (size_t)(nt * 64) * 1024 + kt * 64; d.dstride = 1024;
  } else if ((t -= T_FF1) < T_FF2) {
    int li = t / 1024, r = t % 1024, kt = r / 16, nt = r % 16;
    d.src = p.in[29] + (size_t)li * DFF * 1024 + (size_t)(kt * 64) * 1024 + nt * 64; d.sstride = 1024;
    d.dst = (u16*)(p.ws + O_WTFF2) + (size_t)li * 1024 * DFF + (size_t)(nt * 64) * DFF + kt * 64; d.dstride = DFF;
  } else if ((t -= T_FF2) < T_AV) {
    int bl = t / 64, r = t % 64, pt = r / 8, ct = r % 8;
    int b = bl >> 1, li = bl & 1;
    d.src = p.in[3] + ((size_t)bl * 512 + pt * 64) * 512 + ct * 64; d.sstride = 512;
    d.dst = (u16*)(p.ws + O_VTALAT) + ((size_t)(li * 2 + b) * 512 + ct * 64) * 1536 + 1024 + pt * 64; d.dstride = 1536;
  } else {
    t -= T_AV;
    int bl = t / 16, r = t % 16, pt = r / 2, ct = r % 2;
    int b = bl >> 1, li = bl & 1;
    d.src = p.in[5] + ((size_t)bl * 512 + pt * 64) * 128 + ct * 64; d.sstride = 128;
    d.dst = (u16*)(p.ws + O_VTCLAT) + ((size_t)(li * 2 + b) * 128 + ct * 64) * 1536 + 1024 + pt * 64; d.dstride = 1536;
  }
  return d;
}

DI void phase0(const P& p, char* smem) {
  constexpr int N_MOD = 192, N_ROPE = 8, N_AK = 256, N_CK = 64;
  constexpr int B_ROPE = N_MOD, B_AK = B_ROPE + N_ROPE, B_CK = B_AK + N_AK, B_T = B_CK + N_CK;
  constexpr int NTILES = 1664 + 512 + 2048 + 2048 + 256 + 64;
  for (int it = blockIdx.x; it < B_T; it += gridDim.x) {
    if (it < B_ROPE) p0_mod(p, it, smem);
    else if (it < B_AK) p0_rope(p, it - B_ROPE);
    else if (it < B_CK) p0_copyk(p, it - B_AK, true);
    else p0_copyk(p, it - B_CK, false);
  }
  float* tl = (float*)smem;
  const int tid = ltid();
  const int lr = tid >> 4, lc4 = tid & 15;
  const int c = tid >> 2, rs = tid & 3;
  int t = blockIdx.x;
  f32x4 v[4];
  TDesc cur;
  if (t < NTILES) {
    cur = tdesc(p, t);
#pragma unroll
    for (int i = 0; i < 4; ++i) v[i] = *(const f32x4*)(cur.src + (size_t)(lr + 16 * i) * cur.sstride + lc4 * 4);
  }
  while (t < NTILES) {
    __syncthreads();
#pragma unroll
    for (int i = 0; i < 4; ++i) {
      float* q = tl + (lr + 16 * i) * 65 + lc4 * 4;
      q[0] = v[i].x; q[1] = v[i].y; q[2] = v[i].z; q[3] = v[i].w;
    }
    const int tn = t + gridDim.x;
    TDesc nxt = cur;
    if (tn < NTILES) {
      nxt = tdesc(p, tn);
#pragma unroll
      for (int i = 0; i < 4; ++i) v[i] = *(const f32x4*)(nxt.src + (size_t)(lr + 16 * i) * nxt.sstride + lc4 * 4);
    }
    __syncthreads();
    u32x4 o0, o1;
    {
      const float* q = tl + (rs * 16) * 65 + c;
      o0.x = pack2(q[0 * 65], q[1 * 65]);   o0.y = pack2(q[2 * 65], q[3 * 65]);
      o0.z = pack2(q[4 * 65], q[5 * 65]);   o0.w = pack2(q[6 * 65], q[7 * 65]);
      o1.x = pack2(q[8 * 65], q[9 * 65]);   o1.y = pack2(q[10 * 65], q[11 * 65]);
      o1.z = pack2(q[12 * 65], q[13 * 65]); o1.w = pack2(q[14 * 65], q[15 * 65]);
    }
    u32x4* dp = (u32x4*)(cur.dst + (size_t)c * cur.dstride + rs * 16);
    dp[0] = o0;
    dp[1] = o1;
    cur = nxt;
    t = tn;
  }
}

struct GA {
  const float* alo;
  const float* ahi;
  const float* stats;
  const float* lng;
  const float* lnb;
  const float* mods;
  int sc_off, sh_off;
  const u16* a16;
  const u16* bt;
  int K, N;
  float* xout;
  float* sout;
  u16* hid;
};

DI void epi_inproj(const P& p, int li, f32x4 (&acc)[4][4], int R0, int C0);


template <int EPI>
DI void gemm_tile(const P& p, const GA& g, int li, int m0, int n0, char* smem, u32x4 (&ra0)[4], u32x4 (&rb0)[4],
                  u32x4 (&ra1)[4], u32x4 (&rb1)[4], bool primed, int nm0, int nn0) {
  const int tid = ltid(), lane = tid & 63, wid = tid >> 6, wr = wid >> 1, wc = wid & 1;
  const int l16 = lane & 15, q4 = lane >> 4;
  u16* sA0 = (u16*)smem;
  u16* sB0 = sA0 + 128 * 72;
  u16* sA1 = sB0 + 128 * 72;
  u16* sB1 = sA1 + 128 * 72;
  float2* sStat = (float2*)(smem + 73728);
  const int K = g.K;
  const int rtype = (m0 < NCTX) ? 0 : 1 + ((m0 - NCTX) >> 10);
  const float* modv = g.mods + rtype * 6144;
  const float* fsrc = (m0 < NCTX) ? g.alo + (size_t)m0 * 1024 : g.ahi + (size_t)(m0 - NCTX) * 1024;

  if (!primed) {
    const unsigned goff_ = (unsigned)(tid >> 3) * (unsigned)g.K + (unsigned)(tid & 7) * 8u;
    const u16* ab_ = g.a16 + (size_t)m0 * g.K;
    const u16* bb_ = g.bt + (size_t)n0 * g.K;
#pragma unroll
    for (int i = 0; i < 4; ++i) {
      ra0[i] = *(const u32x4*)(ab_ + (size_t)(32 * i) * g.K + goff_);
      rb0[i] = *(const u32x4*)(bb_ + (size_t)(32 * i) * g.K + goff_);
    }
    __builtin_amdgcn_sched_barrier(0);
#pragma unroll
    for (int i = 0; i < 4; ++i) {
      ra1[i] = *(const u32x4*)(ab_ + (size_t)(32 * i) * g.K + 64 + goff_);
      rb1[i] = *(const u32x4*)(bb_ + (size_t)(32 * i) * g.K + 64 + goff_);
    }
    __builtin_amdgcn_sched_barrier(0);
  }
  __syncthreads();
  if constexpr (EPI == 1) {
    if (g.stats != nullptr && tid < 128) {
      const float4* sp = (const float4*)(g.stats + (size_t)(m0 + tid) * 32);
      float s1 = 0.f, s2 = 0.f;
#pragma unroll
      for (int i = 0; i < 8; ++i) {
        float4 v = sp[i];
        s1 += v.x + v.z;
        s2 += v.y + v.w;
      }
      float mu = s1 * (1.f / 1024.f);
      float var = s2 * (1.f / 1024.f) - mu * mu;
      sStat[tid] = make_float2(mu, rsqrtf(fmaxf(var, 0.f) + 1e-6f));
    }
  }

  f32x4 acc[4][4];
#pragma unroll
  for (int i = 0; i < 4; ++i)
#pragma unroll
    for (int j = 0; j < 4; ++j) acc[i][j] = f32x4{0.f, 0.f, 0.f, 0.f};

  const unsigned goff = (unsigned)(tid >> 3) * (unsigned)K + (unsigned)(tid & 7) * 8u;
  const unsigned loff = (unsigned)(tid >> 3) * 72u + (unsigned)(tid & 7) * 8u;
  const u16* abase = g.a16 + (size_t)m0 * K;
  const u16* bbase = g.bt + (size_t)n0 * K;
#define GLOAD(RA, RB, KT)                                                        \
  _Pragma("unroll") for (int i = 0; i < 4; ++i) {                                \
    RA[i] = *(const u32x4*)(abase + (size_t)(32 * i) * K + (KT) * 64 + goff);    \
    RB[i] = *(const u32x4*)(bbase + (size_t)(32 * i) * K + (KT) * 64 + goff);    \
  }
#define LSTORE(SA, SB, RA, RB)                                                   \
  _Pragma("unroll") for (int i = 0; i < 4; ++i) {                                \
    *(u32x4*)(SA + 32 * i * 72 + loff) = RA[i];                                  \
    *(u32x4*)(SB + 32 * i * 72 + loff) = RB[i];                                  \
  }
#define COMPUTE(SA, SB)                                                          \
  _Pragma("unroll") for (int s = 0; s < 2; ++s) {                                \
    bf16x8 af[4], bfr[4];                                                        \
    _Pragma("unroll") for (int i = 0; i < 4; ++i) {                              \
      af[i] = *(const bf16x8*)(SA + (wr * 64 + i * 16 + l16) * 72 + s * 32 + q4 * 8);  \
      bfr[i] = *(const bf16x8*)(SB + (wc * 64 + i * 16 + l16) * 72 + s * 32 + q4 * 8); \
    }                                                                            \
    _Pragma("unroll") for (int i = 0; i < 4; ++i)                                \
      _Pragma("unroll") for (int j = 0; j < 4; ++j) acc[i][j] = MFMA16(af[i], bfr[j], acc[i][j]); \
    __builtin_amdgcn_sched_barrier(0);                                           \
  }

  const int nk = K >> 6;
#define SB0 __builtin_amdgcn_sched_barrier(0)
  LSTORE(sA0, sB0, ra0, rb0);
  SB0;
  GLOAD(ra0, rb0, 2);
  SB0;
  __syncthreads();
#pragma unroll 1
  for (int kt = 0; kt < nk - 4; kt += 2) {
    SB0;
    LSTORE(sA1, sB1, ra1, rb1);
    SB0;
    GLOAD(ra1, rb1, kt + 3);
    SB0;
    COMPUTE(sA0, sB0);
    __syncthreads();
    SB0;
    LSTORE(sA0, sB0, ra0, rb0);
    SB0;
    GLOAD(ra0, rb0, kt + 4);
    SB0;
    COMPUTE(sA1, sB1);
    __syncthreads();
  }
  SB0;
  LSTORE(sA1, sB1, ra1, rb1);
  SB0;
  GLOAD(ra1, rb1, nk - 1);
  SB0;
  COMPUTE(sA0, sB0);
  __syncthreads();
  const u16* nabase = g.a16 + (size_t)nm0 * K;
  const u16* nbbase = g.bt + (size_t)nn0 * K;
  SB0;
  LSTORE(sA0, sB0, ra0, rb0);
  SB0;
  _Pragma("unroll") for (int i = 0; i < 4; ++i) {
    ra0[i] = *(const u32x4*)(nabase + (size_t)(32 * i) * K + goff);
    rb0[i] = *(const u32x4*)(nbbase + (size_t)(32 * i) * K + goff);
  }
  SB0;
  COMPUTE(sA1, sB1);
  __syncthreads();
  SB0;
  LSTORE(sA1, sB1, ra1, rb1);
  SB0;
  _Pragma("unroll") for (int i = 0; i < 4; ++i) {
    ra1[i] = *(const u32x4*)(nabase + (size_t)(32 * i) * K + 64 + goff);
    rb1[i] = *(const u32x4*)(nbbase + (size_t)(32 * i) * K + 64 + goff);
  }
  SB0;
  COMPUTE(sA0, sB0);
  __syncthreads();
  SB0;
  COMPUTE(sA1, sB1);
#undef GLOAD
#undef LSTORE
#undef COMPUTE
#undef SB0
  asm volatile("" ::: "memory");

  const int R0 = m0 + wr * 64, C0 = n0 + wc * 64;
  if constexpr (EPI == 0) {
    epi_inproj(p, li, acc, R0, C0);
  } else if constexpr (EPI == 1) {
    float gate[4], lg[4], lb[4];
#pragma unroll
    for (int j = 0; j < 4; ++j) {
      int col = C0 + j * 16 + l16;
      gate[j] = modv[g.sc_off + col];
      lg[j] = g.stats ? g.lng[col] : 1.f;
      lb[j] = g.stats ? g.lnb[col] : 0.f;
    }
#pragma unroll
    for (int i = 0; i < 4; ++i) {
#pragma unroll
      for (int r = 0; r < 4; ++r) {
        int lrow = wr * 64 + i * 16 + q4 * 4 + r;
        float mu = 0.f, rs = 1.f;
        if (g.stats != nullptr) {
          float2 st = sStat[lrow];
          mu = st.x;
          rs = st.y;
        }
        float s1 = 0.f, s2 = 0.f;
#pragma unroll
        for (int j = 0; j < 4; ++j) {
          int col = C0 + j * 16 + l16;
          float x = fsrc[(size_t)lrow * 1024 + col];
          x = (x - mu) * rs * lg[j] + lb[j];
          float v = ALPHA * x + gate[j] * acc[i][j][r];
          g.xout[(size_t)(m0 + lrow) * 1024 + col] = v;
          s1 += v;
          s2 += v * v;
        }
        s1 = red16(s1);
        s2 = red16(s2);
        if (l16 == 0) *(float2*)(g.sout + (size_t)(m0 + lrow) * 32 + (C0 >> 6) * 2) = make_float2(s1, s2);
      }
    }
  } else {
    float* sC = (float*)smem;
    __syncthreads();
#pragma unroll
    for (int i = 0; i < 4; ++i)
#pragma unroll
      for (int j = 0; j < 4; ++j)
#pragma unroll
        for (int r = 0; r < 4; ++r) sC[(wr * 64 + i * 16 + q4 * 4 + r) * 132 + wc * 64 + j * 16 + l16] = acc[i][j][r];
    __syncthreads();
    if constexpr (EPI == 1) {
      const int hl = lane & 31, rsel = lane >> 5;
      const int col = n0 + hl * 4;
      const f32x4 gate4 = *(const f32x4*)(modv + g.sc_off + col);
      f32x4 lg4 = {1.f, 1.f, 1.f, 1.f}, lb4 = {0.f, 0.f, 0.f, 0.f};
      if (g.stats != nullptr) {
        lg4 = *(const f32x4*)(g.lng + col);
        lb4 = *(const f32x4*)(g.lnb + col);
      }
#pragma unroll 4
      for (int pp = 0; pp < 16; ++pp) {
        const int lrow = pp * 8 + wid * 2 + rsel;
        f32x4 a = *(const f32x4*)(sC + lrow * 132 + hl * 4);
        f32x4 x = *(const f32x4*)(fsrc + (size_t)lrow * 1024 + col);
        float mu = 0.f, rs = 1.f;
        if (g.stats != nullptr) {
          float2 st = sStat[lrow];
          mu = st.x;
          rs = st.y;
        }
        x = (x - mu) * rs * lg4 + lb4;
        f32x4 v = ALPHA * x + gate4 * a;
        *(f32x4*)(g.xout + (size_t)(m0 + lrow) * 1024 + col) = v;
        float s1 = (v.x + v.y) + (v.z + v.w);
        float s2 = (v.x * v.x + v.y * v.y) + (v.z * v.z + v.w * v.w);
        s1 = red16(s1);
        s2 = red16(s2);
        if ((lane & 15) == 0) *(float2*)(g.sout + (size_t)(m0 + lrow) * 32 + ((n0 >> 6) + (hl >> 4)) * 2) = make_float2(s1, s2);
      }
    } else {
#pragma unroll
      for (int pp = 0; pp < 8; ++pp) {
        const int idx = tid + 256 * pp;
        const int lrow = idx >> 4, c8 = idx & 15;
        f32x4 a0 = *(const f32x4*)(sC + lrow * 132 + c8 * 8);
        f32x4 a1 = *(const f32x4*)(sC + lrow * 132 + c8 * 8 + 4);
        a0.x = fmaxf(a0.x, 0.f); a0.y = fmaxf(a0.y, 0.f); a0.z = fmaxf(a0.z, 0.f); a0.w = fmaxf(a0.w, 0.f);
        a1.x = fmaxf(a1.x, 0.f); a1.y = fmaxf(a1.y, 0.f); a1.z = fmaxf(a1.z, 0.f); a1.w = fmaxf(a1.w, 0.f);
        u32x4 o;
        o.x = pack2(a0.x * a0.x, a0.y * a0.y);
        o.y = pack2(a0.z * a0.z, a0.w * a0.w);
        o.z = pack2(a1.x * a1.x, a1.y * a1.y);
        o.w = pack2(a1.z * a1.z, a1.w * a1.w);
        *(u32x4*)(g.hid + (size_t)(m0 + lrow) * DFF + n0 + c8 * 8) = o;
      }
    }
  }
}

DI void epi_inproj(const P& p, int li, f32x4 (&acc)[4][4], int R0, int C0) {
  const int lane = ltid() & 63, l16 = lane & 15, q4 = lane >> 4;
  const int seg = C0 >> 6;
  const bool lat = R0 >= NCTX;
  const float2* rope = (const float2*)(p.ws + O_ROPE);
  int b, tb;
  if (!lat) { b = R0 >> 8; tb = R0 & 255; } else { b = (R0 - NCTX) >> 10; tb = (R0 - NCTX) & 1023; }

  enum { T_QA, T_KA, T_VA, T_QB, T_FF, T_FB, T_IB, T_GB, T_QC, T_KC, T_VC };
  int type, cbase;
  if (seg < 8) { type = T_QA; cbase = seg * 64; }
  else if (seg < 16) { type = T_KA; cbase = (seg - 8) * 64; }
  else if (seg < 24) { type = T_VA; cbase = (seg - 16) * 64; }
  else if (seg < 28) { type = T_QB; cbase = (seg - 24) * 64; }
  else if (seg < 32) { type = T_FF; cbase = (seg - 28) * 64; }
  else if (seg < 36) { type = T_FB; cbase = (seg - 32) * 64; }
  else if (seg < 40) { type = T_IB; cbase = (seg - 36) * 64; }
  else if (seg < 44) { type = T_GB; cbase = (seg - 40) * 64; }
  else if (seg < 48) { type = T_QC; cbase = (seg - 44) * 64; }
  else if (seg < 50) { type = T_KC; cbase = (seg - 48) * 64; }
  else { type = T_VC; cbase = (seg - 50) * 64; }

  if (type == T_QC || type == T_KC) {
    const float* gv = (type == T_QC ? p.in[22] : p.in[23]) + li * 64;
    float gj[4];
#pragma unroll
    for (int j = 0; j < 4; ++j) gj[j] = gv[j * 16 + l16];
#pragma unroll
    for (int i = 0; i < 4; ++i)
#pragma unroll
      for (int r = 0; r < 4; ++r) {
        float ss = 0.f;
#pragma unroll
        for (int j = 0; j < 4; ++j) ss += acc[i][j][r] * acc[i][j][r];
        ss = red16(ss);
        float rs = rsqrtf(ss * (1.f / 64.f) + 1e-6f);
#pragma unroll
        for (int j = 0; j < 4; ++j) acc[i][j][r] = acc[i][j][r] * rs * gj[j];
      }
  }
  if (!lat && (type == T_KA || type == T_VA || type == T_KC || type == T_VC)) {
    float* o;
    int W;
    if (type == T_KA) { o = p.out + OUT_AK; W = 512; }
    else if (type == T_VA) { o = p.out + OUT_AV; W = 512; }
    else if (type == T_KC) { o = p.out + OUT_CK; W = 128; }
    else { o = p.out + OUT_CV; W = 128; }
#pragma unroll
    for (int i = 0; i < 4; ++i)
#pragma unroll
      for (int r = 0; r < 4; ++r) {
        int t = tb + i * 16 + q4 * 4 + r;
        size_t base = ((size_t)(b * 2 + li) * 256 + t) * W + cbase;
#pragma unroll
        for (int j = 0; j < 4; ++j) o[base + j * 16 + l16] = acc[i][j][r];
      }
  }
  if (lat && (type == T_QA || type == T_KA || type == T_QC || type == T_KC)) {
#pragma unroll
    for (int i = 0; i < 4; ++i)
#pragma unroll
      for (int r = 0; r < 4; ++r) {
        int t = tb + i * 16 + q4 * 4 + r;
#pragma unroll
        for (int j = 0; j < 4; ++j) {
          float v = acc[i][j][r];
          float pv = xor1(v);
          float2 cs = rope[t * 32 + j * 8 + (l16 >> 1)];
          acc[i][j][r] = (l16 & 1) ? (pv * cs.y + v * cs.x) : (v * cs.x - pv * cs.y);
        }
      }
  }

  if (type == T_QA || type == T_KA || type == T_QC || type == T_KC) {
    u16* dst;
    int W;
    size_t rowbase;
    if (type == T_QA) { dst = (u16*)(p.ws + O_QA); W = 512; rowbase = (size_t)R0 * 512; }
    else if (type == T_QC) { dst = (u16*)(p.ws + O_QC); W = 256; rowbase = (size_t)R0 * 256; }
    else if (type == T_KA) {
      W = 512;
      if (!lat) { dst = (u16*)(p.ws + O_KACTX); rowbase = (size_t)R0 * 512; }
      else { dst = (u16*)(p.ws + O_KALAT); rowbase = ((size_t)(li * 2 + b) * 1536 + tb) * 512; }
    } else {
      W = 128;
      if (!lat) { dst = (u16*)(p.ws + O_KCCTX); rowbase = (size_t)R0 * 128; }
      else { dst = (u16*)(p.ws + O_KCLAT); rowbase = ((size_t)(li * 2 + b) * 1536 + tb) * 128; }
    }
#pragma unroll
    for (int i = 0; i < 4; ++i)
#pragma unroll
      for (int r = 0; r < 4; ++r) {
        size_t base = rowbase + (size_t)(i * 16 + q4 * 4 + r) * W + cbase;
#pragma unroll
        for (int j = 0; j < 4; ++j) dst[base + j * 16 + l16] = f2bf(acc[i][j][r]);
      }
  } else if (type == T_VA || type == T_VC) {
    u16* dst;
    int L;
    size_t hb;
    if (type == T_VA) {
      int h = cbase >> 7, dv0 = cbase & 127;
      if (!lat) { dst = (u16*)(p.ws + O_VTACTX); L = 256; hb = ((size_t)(b * 4 + h) * 128 + dv0) * 256; }
      else { dst = (u16*)(p.ws + O_VTALAT); L = 1536; hb = ((size_t)((li * 2 + b) * 4 + h) * 128 + dv0) * 1536; }
    } else {
      int n = cbase >> 6;
      if (!lat) { dst = (u16*)(p.ws + O_VTCCTX); L = 256; hb = ((size_t)(b * 2 + n) * 64) * 256; }
      else { dst = (u16*)(p.ws + O_VTCLAT); L = 1536; hb = ((size_t)((li * 2 + b) * 2 + n) * 64) * 1536; }
    }
#pragma unroll
    for (int i = 0; i < 4; ++i)
#pragma unroll
      for (int j = 0; j < 4; ++j) {
        uint2 o;
        o.x = pack2(acc[i][j][0], acc[i][j][1]);
        o.y = pack2(acc[i][j][2], acc[i][j][3]);
        *(uint2*)(dst + hb + (size_t)(j * 16 + l16) * L + tb + i * 16 + q4 * 4) = o;
      }
  } else {
    float* dst;
    if (type == T_QB) dst = (float*)(p.ws + O_HQ);
    else if (type == T_FF) dst = (float*)(p.ws + O_HGF);
    else if (type == T_FB) dst = (float*)(p.ws + O_HGB);
    else if (type == T_IB) dst = (float*)(p.ws + O_HI);
    else dst = (float*)(p.ws + O_HSG);
    float lbv[4] = {0.f, 0.f, 0.f, 0.f};
    if ((type == T_FF || type == T_FB) && li == 1) {
      const float* lg = (type == T_FF) ? p.in[19] : p.in[20];
#pragma unroll
      for (int j = 0; j < 4; ++j) {
        int c = cbase + j * 16 + l16;
        lbv[j] = 1.f / (1.f + expf(lg[c] - lg[256 + c]));
      }
    }
#pragma unroll
    for (int i = 0; i < 4; ++i)
#pragma unroll
      for (int r = 0; r < 4; ++r) {
        size_t base = (size_t)(R0 + i * 16 + q4 * 4 + r) * 256 + cbase;
#pragma unroll
        for (int j = 0; j < 4; ++j) {
          float v = acc[i][j][r];
          float o;
          if (type == T_QB || type == T_GB) o = v * __frcp_rn(1.f + __expf(-v));
          else if (type == T_IB) o = v;
          else {
            float sg = __frcp_rn(1.f + __expf(-v));
            float f = lbv[j] + (1.f - lbv[j]) * sg;
            o = __logf(fmaxf(f, 1e-6f));
          }
          dst[base + j * 16 + l16] = o;
        }
      }
  }
}

template <int EPI>
DI void gemm_phase(const P& p, const GA& g, int li, char* smem) {
  const int NT = g.N >> 7;
  const int xcd = blockIdx.x & 7, lb = blockIdx.x >> 3, nlb = gridDim.x >> 3;
  if (lb >= nlb) return;
  u32x4 ra0[4], rb0[4], ra1[4], rb1[4];
  bool primed = false;
  for (int t = lb; t < 6 * NT; t += nlb) {
    int mt = xcd * 6 + t % 6, nt = t / 6;
    const int tn = (t + nlb < 6 * NT) ? t + nlb : t;
    const int nmt = xcd * 6 + tn % 6, nnt = tn / 6;
    gemm_tile<EPI>(p, g, li, mt * 128, nt * 128, smem, ra0, rb0, ra1, rb1, primed, nmt * 128, nnt * 128);
    primed = true;
  }
}


template <int KW, int DV>
DI void attn_gload(const u16* Kb, int kstride, const u16* VT, int L, int kb, int tid, u32x4 (&kr)[KW / 32], u32x4 (&vr)[DV / 32]) {
  constexpr int KPR = 256 / (KW / 8);
  const unsigned koff = (unsigned)(tid / (KW / 8)) * (unsigned)kstride + (unsigned)(tid % (KW / 8)) * 8u;
  const unsigned voff = (unsigned)(tid >> 3) * (unsigned)L + (unsigned)(tid & 7) * 8u;
#pragma unroll
  for (int i = 0; i < KW / 32; ++i) {
    const u16* kbp = Kb + (size_t)(kb * 64 + KPR * i) * kstride;
    kr[i] = *(const u32x4*)(kbp + koff);
  }
#pragma unroll
  for (int i = 0; i < DV / 32; ++i) {
    const u16* vbp = VT + (size_t)(32 * i) * L + kb * 64;
    vr[i] = *(const u32x4*)(vbp + voff);
  }
}
template <int KW, int DV>
DI void attn_lstore(u16* sK, u16* sV, int tid, const u32x4 (&kr)[KW / 32], const u32x4 (&vr)[DV / 32]) {
  constexpr int KS = KW + 8;
#pragma unroll
  for (int i = 0; i < KW / 32; ++i) {
    int idx = tid + 256 * i;
    int key = idx / (KW / 8), cc = idx % (KW / 8);
    *(u32x4*)(sK + key * KS + cc * 8) = kr[i];
  }
#pragma unroll
  for (int i = 0; i < DV / 32; ++i) {
    int idx = tid + 256 * i;
    int row = idx >> 3, cc = idx & 7;
    *(u32x4*)(sV + row * 72 + cc * 8) = vr[i];
  }
}

template <int KW, int DV>
DI void attn_compute(const u16* sK, const u16* sV, int kfo, int l16, int q4, const bf16x8& qf0, const bf16x8& qf1,
                     f32x4 (&o)[DV / 16], float& m, float& l) {
  constexpr int KS = KW + 8, NDT = DV / 16;
  const float c = 0.125f * LOG2E;
  f32x4 st[4];
#pragma unroll
  for (int kt = 0; kt < 4; ++kt) {
    const u16* kp = sK + (kt * 16 + l16) * KS + kfo + q4 * 8;
    bf16x8 k0 = *(const bf16x8*)kp;
    bf16x8 k1 = *(const bf16x8*)(kp + 32);
    f32x4 z = {0.f, 0.f, 0.f, 0.f};
    z = MFMA16(k0, qf0, z);
    st[kt] = MFMA16(k1, qf1, z);
  }
  float bm = st[0][0];
#pragma unroll
  for (int kt = 0; kt < 4; ++kt)
#pragma unroll
    for (int r = 0; r < 4; ++r) bm = fmaxf(bm, st[kt][r]);
  bm = fmaxf(bm, shx(bm, 16));
  bm = fmaxf(bm, shx(bm, 32));
  const float mn = fmaxf(m, bm);
  const float alpha = ex2((m - mn) * c);
  m = mn;
  float ps = 0.f;
#pragma unroll
  for (int kt = 0; kt < 4; ++kt)
#pragma unroll
    for (int r = 0; r < 4; ++r) {
      float pv = ex2((st[kt][r] - mn) * c);
      st[kt][r] = pv;
      ps += pv;
    }
  l = l * alpha + ps;
#pragma unroll
  for (int d = 0; d < NDT; ++d) {
    o[d][0] *= alpha; o[d][1] *= alpha; o[d][2] *= alpha; o[d][3] *= alpha;
  }
#pragma unroll
  for (int ks = 0; ks < 2; ++ks) {
    u32x4 pu;
    pu.x = pack2(st[2 * ks][0], st[2 * ks][1]);
    pu.y = pack2(st[2 * ks][2], st[2 * ks][3]);
    pu.z = pack2(st[2 * ks + 1][0], st[2 * ks + 1][1]);
    pu.w = pack2(st[2 * ks + 1][2], st[2 * ks + 1][3]);
    bf16x8 pf = __builtin_bit_cast(bf16x8, pu);
#pragma unroll
    for (int d = 0; d < NDT; ++d) {
      const u16* vp = sV + (d * 16 + l16) * 72 + ks * 32 + q4 * 4;
      u32x2 v0 = *(const u32x2*)vp;
      u32x2 v1 = *(const u32x2*)(vp + 16);
      u32x4 vu = {v0.x, v0.y, v1.x, v1.y};
      bf16x8 vf = __builtin_bit_cast(bf16x8, vu);
      o[d] = MFMA16(vf, pf, o[d]);
    }
  }
}

template <int KW, int DV, bool DIFF>
DI void attn_item(const u16* Q, int qstride, int qcol, int qrow0, const u16* Kb, int kstride, const u16* VT, int L,
                          int nkeys, u16* mixed, int mixcol, float lam, float postscale, const float* subg, char* smem) {
  const int tid = ltid(), lane = tid & 63, wid = tid >> 6, l16 = lane & 15, q4 = lane >> 4;
  const int qsub = wid & 1, var = wid >> 1;
  constexpr int KS = KW + 8;
  constexpr int STAGE = 64 * KS + DV * 72;
  u16* sK0 = (u16*)smem;
  u16* sV0 = sK0 + 64 * KS;
  u16* sK1 = sK0 + STAGE;
  u16* sV1 = sV0 + STAGE;
  constexpr int KPT = KW / 32, VPT = DV / 32, NDT = DV / 16;
  const int kfo = DIFF ? var * 64 : 0;

  const u16* qp = Q + (size_t)(qrow0 + qsub * 16 + l16) * qstride + qcol + var * 64 + q4 * 8;
  const bf16x8 qf0 = *(const bf16x8*)qp;
  const bf16x8 qf1 = *(const bf16x8*)(qp + 32);

  u32x4 kr0[KPT], vr0[VPT], kr1[KPT], vr1[VPT];
  f32x4 o[NDT];
#pragma unroll
  for (int d = 0; d < NDT; ++d) o[d] = f32x4{0.f, 0.f, 0.f, 0.f};
  float m = -INFINITY, l = 0.f;
  const int nkb = nkeys >> 6;
#define SB0 __builtin_amdgcn_sched_barrier(0)
  attn_gload<KW, DV>(Kb, kstride, VT, L, 0, tid, kr0, vr0);
  SB0;
  attn_gload<KW, DV>(Kb, kstride, VT, L, 1, tid, kr1, vr1);
  SB0;
  __syncthreads();
  attn_lstore<KW, DV>(sK0, sV0, tid, kr0, vr0);
  SB0;
  attn_gload<KW, DV>(Kb, kstride, VT, L, 2, tid, kr0, vr0);
  SB0;
  __syncthreads();
#pragma unroll 1
  for (int kb = 0; kb < nkb - 4; kb += 2) {
    SB0;
    attn_lstore<KW, DV>(sK1, sV1, tid, kr1, vr1);
    SB0;
    attn_gload<KW, DV>(Kb, kstride, VT, L, kb + 3, tid, kr1, vr1);
    SB0;
    attn_compute<KW, DV>(sK0, sV0, kfo, l16, q4, qf0, qf1, o, m, l);
    __syncthreads();
    SB0;
    attn_lstore<KW, DV>(sK0, sV0, tid, kr0, vr0);
    SB0;
    attn_gload<KW, DV>(Kb, kstride, VT, L, kb + 4, tid, kr0, vr0);
    SB0;
    attn_compute<KW, DV>(sK1, sV1, kfo, l16, q4, qf0, qf1, o, m, l);
    __syncthreads();
  }
  SB0;
  attn_lstore<KW, DV>(sK1, sV1, tid, kr1, vr1);
  SB0;
  attn_gload<KW, DV>(Kb, kstride, VT, L, nkb - 1, tid, kr1, vr1);
  SB0;
  attn_compute<KW, DV>(sK0, sV0, kfo, l16, q4, qf0, qf1, o, m, l);
  __syncthreads();
  SB0;
  attn_lstore<KW, DV>(sK0, sV0, tid, kr0, vr0);
  SB0;
  attn_compute<KW, DV>(sK1, sV1, kfo, l16, q4, qf0, qf1, o, m, l);
  __syncthreads();
  SB0;
  attn_lstore<KW, DV>(sK1, sV1, tid, kr1, vr1);
  SB0;
  attn_compute<KW, DV>(sK0, sV0, kfo, l16, q4, qf0, qf1, o, m, l);
  __syncthreads();
  SB0;
  attn_compute<KW, DV>(sK1, sV1, kfo, l16, q4, qf0, qf1, o, m, l);
  __syncthreads();
#undef SB0
  l += shx(l, 16);
  l += shx(l, 32);
  const float inv = 1.f / l;
  const int row = qrow0 + qsub * 16 + l16;
  if constexpr (DIFF) {
    __syncthreads();
    float* sO = (float*)smem;
    if (var == 1) {
#pragma unroll
      for (int d = 0; d < NDT; ++d)
        *(float4*)(sO + (qsub * 16 + l16) * 132 + d * 16 + q4 * 4) =
            make_float4(o[d][0] * inv, o[d][1] * inv, o[d][2] * inv, o[d][3] * inv);
    }
    __syncthreads();
    if (var == 0) {
      float ss = 0.f;
#pragma unroll
      for (int d = 0; d < NDT; ++d) {
        float4 o1 = *(const float4*)(sO + (qsub * 16 + l16) * 132 + d * 16 + q4 * 4);
        o[d][0] = o[d][0] * inv - lam * o1.x;
        o[d][1] = o[d][1] * inv - lam * o1.y;
        o[d][2] = o[d][2] * inv - lam * o1.z;
        o[d][3] = o[d][3] * inv - lam * o1.w;
        ss += o[d][0] * o[d][0] + o[d][1] * o[d][1] + o[d][2] * o[d][2] + o[d][3] * o[d][3];
      }
      ss += shx(ss, 16);
      ss += shx(ss, 32);
      const float rs = rsqrtf(ss * (1.f / 128.f) + 1e-6f) * postscale;
#pragma unroll
      for (int d = 0; d < NDT; ++d) {
        float4 gg = *(const float4*)(subg + d * 16 + q4 * 4);
        uint2 ov;
        ov.x = pack2(o[d][0] * rs * gg.x, o[d][1] * rs * gg.y);
        ov.y = pack2(o[d][2] * rs * gg.z, o[d][3] * rs * gg.w);
        *(uint2*)(mixed + (size_t)row * 1024 + mixcol + d * 16 + q4 * 4) = ov;
      }
    }
  } else {
#pragma unroll
    for (int d = 0; d < NDT; ++d) {
      uint2 ov;
      ov.x = pack2(o[d][0] * inv, o[d][1] * inv);
      ov.y = pack2(o[d][2] * inv, o[d][3] * inv);
      *(uint2*)(mixed + (size_t)row * 1024 + mixcol + var * 64 + d * 16 + q4 * 4) = ov;
    }
  }
}

DI void attnA_item(const P& p, int li, int it, char* smem) {
  const int lane = ltid() & 63;
  float d1 = p.in[14][li * 64 + lane] * p.in[15][li * 64 + lane];
  float d2 = p.in[16][li * 64 + lane] * p.in[17][li * 64 + lane];
#pragma unroll
  for (int s = 1; s < 64; s <<= 1) { d1 += shx(d1, s); d2 += shx(d2, s); }
  const float lam_init = 0.8f - 0.6f * expf(-0.3f * (float)li);
  const float lam = expf(d1) - expf(d2) + lam_init;
  const u16* QA = (const u16*)(p.ws + O_QA);
  u16* mixed = (u16*)(p.ws + O_MIXED);
  const float* subg = p.in[18] + li * 128;
  int qrow0, L;
  const u16 *Kb, *VT;
  int h;
  if (it < 256) {
    int b = it >> 7, qb = it & 31;
    h = (it >> 5) & 3;
    Kb = (const u16*)(p.ws + O_KALAT) + (size_t)(li * 2 + b) * 1536 * 512 + h * 128;
    VT = (const u16*)(p.ws + O_VTALAT) + (size_t)((li * 2 + b) * 4 + h) * 128 * 1536;
    qrow0 = NCTX + b * 1024 + qb * 32;
    L = 1536;
  } else {
    it -= 256;
    int b = it >> 5, qb = it & 7;
    h = (it >> 3) & 3;
    Kb = (const u16*)(p.ws + O_KACTX) + (size_t)b * 256 * 512 + h * 128;
    VT = (const u16*)(p.ws + O_VTACTX) + (size_t)(b * 4 + h) * 128 * 256;
    qrow0 = b * 256 + qb * 32;
    L = 256;
  }
  attn_item<128, 128, true>(QA, 512, h * 128, qrow0, Kb, 512, VT, L, L, mixed, h * 128, lam, 1.f - lam_init, subg, smem);
}
DI void attnC_item(const P& p, int li, int it, char* smem) {
  const u16* QC = (const u16*)(p.ws + O_QC);
  u16* mixed = (u16*)(p.ws + O_MIXED);
  int qrow0, L, n;
  const u16 *Kb, *VT;
  if (it < 128) {
    int b = it >> 6, qb = it & 31;
    n = (it >> 5) & 1;
    Kb = (const u16*)(p.ws + O_KCLAT) + (size_t)(li * 2 + b) * 1536 * 128 + n * 64;
    VT = (const u16*)(p.ws + O_VTCLAT) + (size_t)((li * 2 + b) * 2 + n) * 64 * 1536;
    qrow0 = NCTX + b * 1024 + qb * 32;
    L = 1536;
  } else {
    it -= 128;
    int b = it >> 4, qb = it & 7;
    n = (it >> 3) & 1;
    Kb = (const u16*)(p.ws + O_KCCTX) + (size_t)b * 256 * 128 + n * 64;
    VT = (const u16*)(p.ws + O_VTCCTX) + (size_t)(b * 2 + n) * 64 * 256;
    qrow0 = b * 256 + qb * 32;
    L = 256;
  }
  attn_item<64, 64, false>(QC, 256, n * 128, qrow0, Kb, 128, VT, L, L, mixed, 768 + n * 128, 0.f, 1.f, nullptr, smem);
}

DI void h1_item(const P& p, int item, char* smem) {
  const int tid = ltid(), lane = tid & 63, w = tid >> 6, l16 = lane & 15, q4 = lane >> 4;
  const int dir = item & 1, h = (item >> 1) & 3, tc = item >> 3;
  const int row0 = tc * 64;
  float* sQ = (float*)smem;
  float* sB = sQ + 64 * 68;
  float* sK = sB + 64 * 68;
  u16* sVT = (u16*)(sK + 64 * 68);
  float* sTot = (float*)(sVT + 64 * 72);
  const float* HQ = (const float*)(p.ws + O_HQ);
  const float* HG = (const float*)(p.ws + (dir ? O_HGB : O_HGF));
  const float* HI = (const float*)(p.ws + O_HI);
  float* OI = (float*)(p.ws + O_OI) + (size_t)dir * NTOK * 256;
  u16* QE = (u16*)(p.ws + O_QE) + (size_t)dir * NTOK * 256;
  float* KV = (float*)(p.ws + O_KV) + (size_t)item * 4096;
  float* DEC = (float*)(p.ws + O_DEC) + (size_t)item * 64;

  __syncthreads();
#pragma unroll
  for (int i = 0; i < 4; ++i) {
    int idx = tid + 256 * i;
    int lo = idx >> 4, c4 = idx & 15;
    int row = dir ? row0 + 63 - lo : row0 + lo;
    size_t off = (size_t)row * 256 + h * 64 + c4 * 4;
    *(float4*)(sQ + lo * 68 + c4 * 4) = *(const float4*)(HQ + off);
    *(float4*)(sB + lo * 68 + c4 * 4) = *(const float4*)(HG + off);
    float4 v = *(const float4*)(HI + off);
    sVT[(c4 * 4 + 0) * 72 + lo] = f2bf(v.x);
    sVT[(c4 * 4 + 1) * 72 + lo] = f2bf(v.y);
    sVT[(c4 * 4 + 2) * 72 + lo] = f2bf(v.z);
    sVT[(c4 * 4 + 3) * 72 + lo] = f2bf(v.w);
  }
  __syncthreads();
  {
    const int k = tid & 63, part = tid >> 6;
    float run = 0.f;
#pragma unroll 4
    for (int e = 0; e < 16; ++e) {
      int i = part * 16 + e;
      float g = sB[i * 68 + k];
      sK[i * 68 + k] = 1.f - ex2(g * LOG2E);
      run += g * LOG2E;
      sB[i * 68 + k] = run;
    }
    sTot[part * 64 + k] = run;
    __syncthreads();
    float add = 0.f;
    for (int pp = 0; pp < part; ++pp) add += sTot[pp * 64 + k];
    if (part > 0)
      for (int e = 0; e < 16; ++e) sB[(part * 16 + e) * 68 + k] += add;
  }
  __syncthreads();
#pragma unroll
  for (int i = 0; i < 4; ++i) {
    int idx = tid + 256 * i;
    int lo = idx >> 4, c4 = idx & 15;
    int row = dir ? row0 + 63 - lo : row0 + lo;
    f32x4 q = *(const f32x4*)(sQ + lo * 68 + c4 * 4);
    f32x4 bb = *(const f32x4*)(sB + lo * 68 + c4 * 4);
    u32x2 o;
    o.x = pack2(q.x * ex2(bb.x), q.y * ex2(bb.y));
    o.y = pack2(q.z * ex2(bb.z), q.w * ex2(bb.w));
    *(u32x2*)(QE + (size_t)row * 256 + h * 64 + c4 * 4) = o;
  }
  {
    const int I = w;
    bf16x8 qs[2];
    f32x4 rr[2][2];
#pragma unroll
    for (int s = 0; s < 2; ++s) {
      const int kk0 = s * 32 + q4 * 8;
      if (I > 0) {
        rr[s][0] = *(const f32x4*)(sB + (16 * I - 1) * 68 + kk0);
        rr[s][1] = *(const f32x4*)(sB + (16 * I - 1) * 68 + kk0 + 4);
      } else {
        rr[s][0] = f32x4{0.f, 0.f, 0.f, 0.f};
        rr[s][1] = rr[s][0];
      }
      const float* qr = sQ + (16 * I + l16) * 68 + kk0;
      const float* br = sB + (16 * I + l16) * 68 + kk0;
      f32x4 q0 = *(const f32x4*)qr, q1 = *(const f32x4*)(qr + 4);
      f32x4 b0 = *(const f32x4*)br, b1 = *(const f32x4*)(br + 4);
      u32x4 pu;
      pu.x = pack2(q0.x * ex2(b0.x - rr[s][0].x), q0.y * ex2(b0.y - rr[s][0].y));
      pu.y = pack2(q0.z * ex2(b0.z - rr[s][0].z), q0.w * ex2(b0.w - rr[s][0].w));
      pu.z = pack2(q1.x * ex2(b1.x - rr[s][1].x), q1.y * ex2(b1.y - rr[s][1].y));
      pu.w = pack2(q1.z * ex2(b1.z - rr[s][1].z), q1.w * ex2(b1.w - rr[s][1].w));
      qs[s] = __builtin_bit_cast(bf16x8, pu);
    }
    f32x4 at[4];
#pragma unroll
    for (int J = 0; J < 4; ++J) {
      at[J] = f32x4{0.f, 0.f, 0.f, 0.f};
      if (J <= I) {
#pragma unroll
        for (int s = 0; s < 2; ++s) {
          const int kk0 = s * 32 + q4 * 8;
          const float* kr = sK + (16 * J + l16) * 68 + kk0;
          const float* br = sB + (16 * J + l16) * 68 + kk0;
          f32x4 k0 = *(const f32x4*)kr, k1 = *(const f32x4*)(kr + 4);
          f32x4 b0 = *(const f32x4*)br, b1 = *(const f32x4*)(br + 4);
          u32x4 pu;
          pu.x = pack2(k0.x * ex2(fminf(rr[s][0].x - b0.x, 100.f)), k0.y * ex2(fminf(rr[s][0].y - b0.y, 100.f)));
          pu.y = pack2(k0.z * ex2(fminf(rr[s][0].z - b0.z, 100.f)), k0.w * ex2(fminf(rr[s][0].w - b0.w, 100.f)));
          pu.z = pack2(k1.x * ex2(fminf(rr[s][1].x - b1.x, 100.f)), k1.y * ex2(fminf(rr[s][1].y - b1.y, 100.f)));
          pu.w = pack2(k1.z * ex2(fminf(rr[s][1].z - b1.z, 100.f)), k1.w * ex2(fminf(rr[s][1].w - b1.w, 100.f)));
          bf16x8 kf = __builtin_bit_cast(bf16x8, pu);
          at[J] = MFMA16(kf, qs[s], at[J]);
        }
        if (J == I) {
#pragma unroll
          for (int r = 0; r < 4; ++r)
            if (q4 * 4 + r > l16) at[J][r] = 0.f;
        }
      }
    }
    f32x4 oc[4];
#pragma unroll
    for (int vt = 0; vt < 4; ++vt) oc[vt] = f32x4{0.f, 0.f, 0.f, 0.f};
#pragma unroll
    for (int ks = 0; ks < 2; ++ks) {
      if (2 * ks <= I) {
        u32x4 pu;
        pu.x = pack2(at[2 * ks][0], at[2 * ks][1]);
        pu.y = pack2(at[2 * ks][2], at[2 * ks][3]);
        pu.z = pack2(at[2 * ks + 1][0], at[2 * ks + 1][1]);
        pu.w = pack2(at[2 * ks + 1][2], at[2 * ks + 1][3]);
        bf16x8 pf = __builtin_bit_cast(bf16x8, pu);
#pragma unroll
        for (int vt = 0; vt < 4; ++vt) {
          const u16* vp = sVT + (vt * 16 + l16) * 72 + ks * 32 + q4 * 4;
          u32x2 v0 = *(const u32x2*)vp;
          u32x2 v1 = *(const u32x2*)(vp + 16);
          u32x4 vu = {v0.x, v0.y, v1.x, v1.y};
          oc[vt] = MFMA16(__builtin_bit_cast(bf16x8, vu), pf, oc[vt]);
        }
      }
    }
    {
      const int t = 16 * I + l16;
      const int row = dir ? row0 + 63 - t : row0 + t;
#pragma unroll
      for (int vt = 0; vt < 4; ++vt) *(f32x4*)(OI + (size_t)row * 256 + h * 64 + vt * 16 + q4 * 4) = oc[vt];
    }
  }
  {
    const int k = 16 * w + l16;
    const float bend = sB[63 * 68 + k];
    f32x4 kc[4];
#pragma unroll
    for (int vt = 0; vt < 4; ++vt) kc[vt] = f32x4{0.f, 0.f, 0.f, 0.f};
#pragma unroll
    for (int ks = 0; ks < 2; ++ks) {
      float kd[8];
#pragma unroll
      for (int j = 0; j < 8; ++j) {
        const int s = ks * 32 + q4 * 8 + j;
        kd[j] = sK[s * 68 + k] * ex2(bend - sB[s * 68 + k]);
      }
      u32x4 pu;
      pu.x = pack2(kd[0], kd[1]);
      pu.y = pack2(kd[2], kd[3]);
      pu.z = pack2(kd[4], kd[5]);
      pu.w = pack2(kd[6], kd[7]);
      bf16x8 af = __builtin_bit_cast(bf16x8, pu);
#pragma unroll
      for (int vt = 0; vt < 4; ++vt) {
        bf16x8 vf = *(const bf16x8*)(sVT + (vt * 16 + l16) * 72 + ks * 32 + q4 * 8);
        kc[vt] = MFMA16(af, vf, kc[vt]);
      }
    }
#pragma unroll
    for (int vt = 0; vt < 4; ++vt)
#pragma unroll
      for (int r = 0; r < 4; ++r) KV[(16 * w + q4 * 4 + r) * 64 + vt * 16 + l16] = kc[vt][r];
    if (q4 == 0) DEC[k] = ex2(bend);
  }
}

DI void h2_item(const P& p, int li, int item, char* smem) {
  const int tid = ltid(), ty = tid >> 4, tx = tid & 15;
  const int lane = tid & 63, w = tid >> 6, l16 = lane & 15, q4 = lane >> 4;
  const int h = item & 3, tc = item >> 2, row0 = tc * 64;
  const bool lat = tc >= 64;
  int seq, cl, nc;
  if (!lat) { seq = tc >> 2; cl = tc & 3; nc = 4; } else { seq = (tc - 64) >> 4; cl = (tc - 64) & 15; nc = 16; }
  const int tcbase = tc - cl;
  u16* sST = (u16*)smem;
  const float* KVb = (const float*)(p.ws + O_KV);
  const float* DECb = (const float*)(p.ws + O_DEC);
  __syncthreads();
#pragma unroll 1
  for (int dir = 0; dir < 2; ++dir) {
    float4 S[4];
#pragma unroll
    for (int a = 0; a < 4; ++a) {
      if (lat) S[a] = *(const float4*)(p.in[6 + dir] + ((size_t)((seq * 2 + li) * 4 + h) * 64 + ty + 16 * a) * 64 + tx * 4);
      else S[a] = make_float4(0.f, 0.f, 0.f, 0.f);
    }
    const int nprev = dir == 0 ? cl : nc - 1 - cl;
#pragma unroll 1
    for (int j = 0; j < nprev; ++j) {
      int tcj = tcbase + (dir == 0 ? j : nc - 1 - j);
      size_t itj = (size_t)((tcj * 4 + h) * 2 + dir);
#pragma unroll
      for (int a = 0; a < 4; ++a) {
        int k = ty + 16 * a;
        float dcy = DECb[itj * 64 + k];
        float4 kv = *(const float4*)(KVb + itj * 4096 + k * 64 + tx * 4);
        S[a].x = dcy * S[a].x + kv.x; S[a].y = dcy * S[a].y + kv.y; S[a].z = dcy * S[a].z + kv.z; S[a].w = dcy * S[a].w + kv.w;
      }
    }
    if (!lat && nprev == nc - 1) {
      size_t itj = (size_t)((tc * 4 + h) * 2 + dir);
      float* so = p.out + (dir == 0 ? OUT_SF : OUT_SB) + (size_t)((seq * 2 + li) * 4 + h) * 4096;
#pragma unroll
      for (int a = 0; a < 4; ++a) {
        int k = ty + 16 * a;
        float dcy = DECb[itj * 64 + k];
        float4 kv = *(const float4*)(KVb + itj * 4096 + k * 64 + tx * 4);
        *(float4*)(so + k * 64 + tx * 4) = make_float4(dcy * S[a].x + kv.x, dcy * S[a].y + kv.y, dcy * S[a].z + kv.z, dcy * S[a].w + kv.w);
      }
    }
    u16* st = sST + dir * 64 * 72;
#pragma unroll
    for (int a = 0; a < 4; ++a) {
      int k = ty + 16 * a;
      st[(tx * 4 + 0) * 72 + k] = f2bf(S[a].x);
      st[(tx * 4 + 1) * 72 + k] = f2bf(S[a].y);
      st[(tx * 4 + 2) * 72 + k] = f2bf(S[a].z);
      st[(tx * 4 + 3) * 72 + k] = f2bf(S[a].w);
    }
  }
  __syncthreads();
  f32x4 oc[4];
#pragma unroll
  for (int vt = 0; vt < 4; ++vt) oc[vt] = f32x4{0.f, 0.f, 0.f, 0.f};
#pragma unroll
  for (int dir = 0; dir < 2; ++dir) {
    const u16* QE = (const u16*)(p.ws + O_QE) + (size_t)dir * NTOK * 256 + (size_t)(row0 + 16 * w + l16) * 256 + h * 64 + q4 * 8;
    const u16* st = sST + dir * 64 * 72;
#pragma unroll
    for (int ks = 0; ks < 2; ++ks) {
      bf16x8 af = *(const bf16x8*)(QE + ks * 32);
#pragma unroll
      for (int vt = 0; vt < 4; ++vt) {
        bf16x8 bf = *(const bf16x8*)(st + (vt * 16 + l16) * 72 + ks * 32 + q4 * 8);
        oc[vt] = MFMA16(af, bf, oc[vt]);
      }
    }
  }
  const float* OI0 = (const float*)(p.ws + O_OI);
  const float* OI1 = OI0 + (size_t)NTOK * 256;
  const float* HSG = (const float*)(p.ws + O_HSG);
  u16* mixed = (u16*)(p.ws + O_MIXED);
  float gn[4];
#pragma unroll
  for (int vt = 0; vt < 4; ++vt) gn[vt] = p.in[21][li * 64 + vt * 16 + l16];
#pragma unroll
  for (int r = 0; r < 4; ++r) {
    const int row = row0 + 16 * w + q4 * 4 + r;
    const size_t off = (size_t)row * 256 + h * 64 + l16;
    float val[4];
    float ss = 0.f;
#pragma unroll
    for (int vt = 0; vt < 4; ++vt) {
      val[vt] = oc[vt][r] + OI0[off + vt * 16] + OI1[off + vt * 16];
      ss += val[vt] * val[vt];
    }
    ss = red16(ss);
    const float rs = rsqrtf(ss * (1.f / 64.f) + 1e-6f);
#pragma unroll
    for (int vt = 0; vt < 4; ++vt)
      mixed[(size_t)row * 1024 + 512 + h * 64 + vt * 16 + l16] = f2bf(val[vt] * rs * gn[vt] * HSG[off + vt * 16]);
  }
}

DI void ln_apply(const P& p, const float* lo, const float* hi, const float* stats, const float* lng, const float* lnb,
                 const float* mods, int sc_off, int sh_off) {
  const int lane = ltid() & 63, wid = ltid() >> 6;
  u16* dst = (u16*)(p.ws + O_ABF);
  for (int it = blockIdx.x; it < NTOK / 4; it += gridDim.x) {
    const int row = it * 4 + wid;
    float mu = 0.f, rs = 1.f;
    if (stats != nullptr) {
      float s1 = 0.f, s2 = 0.f;
      if (lane < 16) {
        float2 v = *(const float2*)(stats + (size_t)row * 32 + lane * 2);
        s1 = v.x;
        s2 = v.y;
      }
#pragma unroll
      for (int s = 1; s < 16; s <<= 1) { s1 += shx(s1, s); s2 += shx(s2, s); }
      s1 = __shfl(s1, 0, 64);
      s2 = __shfl(s2, 0, 64);
      mu = s1 * (1.f / 1024.f);
      rs = rsqrtf(fmaxf(s2 * (1.f / 1024.f) - mu * mu, 0.f) + 1e-6f);
    }
    const float* x = row < NCTX ? lo + (size_t)row * 1024 : hi + (size_t)(row - NCTX) * 1024;
    const int rtype = row < NCTX ? 0 : 1 + ((row - NCTX) >> 10);
    const float* mv = mods + rtype * 6144;
#pragma unroll
    for (int i = 0; i < 4; ++i) {
      const int c = (lane + 64 * i) * 4;
      f32x4 v = *(const f32x4*)(x + c);
      f32x4 sc = *(const f32x4*)(mv + sc_off + c) + 1.f;
      f32x4 sh = *(const f32x4*)(mv + sh_off + c);
      if (stats != nullptr) {
        f32x4 gg = *(const f32x4*)(lng + c);
        f32x4 bb = *(const f32x4*)(lnb + c);
        v = (v - mu) * rs * gg + bb;
      }
      v = v * sc + sh;
      u32x2 o;
      o.x = pack2(v.x, v.y);
      o.y = pack2(v.z, v.w);
      *(u32x2*)(dst + (size_t)row * 1024 + c) = o;
    }
  }
}

DI void final_ln(const P& p) {
  const int lane = ltid() & 63, wid = ltid() >> 6;
  const float* X = (const float*)(p.ws + O_XPRE2);
  const float* ST = (const float*)(p.ws + O_ST2);
  const float* g = p.in[26] + 1024;
  const float* bb = p.in[27] + 1024;
  for (int it = blockIdx.x; it < NTOK / 4; it += gridDim.x) {
    int row = it * 4 + wid;
    float s1 = 0.f, s2 = 0.f;
    if (lane < 16) {
      float2 v = *(const float2*)(ST + (size_t)row * 32 + lane * 2);
      s1 = v.x;
      s2 = v.y;
    }
#pragma unroll
    for (int s = 1; s < 16; s <<= 1) { s1 += shx(s1, s); s2 += shx(s2, s); }
    s1 = __shfl(s1, 0, 64);
    s2 = __shfl(s2, 0, 64);
    float mu = s1 * (1.f / 1024.f);
    float rs = rsqrtf(fmaxf(s2 * (1.f / 1024.f) - mu * mu, 0.f) + 1e-6f);
    float* out = p.out + (row < NCTX ? OUT_YP + (size_t)row * 1024 : OUT_YS + (size_t)(row - NCTX) * 1024);
#pragma unroll
    for (int i = 0; i < 4; ++i) {
      int c = (lane + 64 * i) * 4;
      float4 x = *(const float4*)(X + (size_t)row * 1024 + c);
      float4 gg = *(const float4*)(g + c);
      float4 b4 = *(const float4*)(bb + c);
      *(float4*)(out + c) = make_float4((x.x - mu) * rs * gg.x + b4.x, (x.y - mu) * rs * gg.y + b4.y,
                                         (x.z - mu) * rs * gg.z + b4.z, (x.w - mu) * rs * gg.w + b4.w);
    }
  }
}

DI void run_phase(const P& p, int ph, char* smem, int sub = 0) {
  if (ph == 0) { phase0(p, smem); return; }
  if (ph == NPHASE - 1) { final_ln(p); return; }
  const int li = (ph - 1) >> 3, s = (ph - 1) & 7;
  float* XPRE1 = (float*)(p.ws + O_XPRE1);
  float* XPRE2 = (float*)(p.ws + O_XPRE2);
  float* ST1 = (float*)(p.ws + O_ST1);
  float* ST2 = (float*)(p.ws + O_ST2);
  GA g;
  g.mods = (const float*)(p.ws + O_MODS) + li * 3 * 6144;
  g.a16 = (const u16*)(p.ws + O_ABF); g.xout = nullptr; g.sout = nullptr; g.hid = nullptr;
  g.alo = nullptr; g.ahi = nullptr; g.stats = nullptr; g.lng = nullptr; g.lnb = nullptr; g.sc_off = 0; g.sh_off = 0;
  const float* xin_lo = li == 0 ? p.in[0] : XPRE2;
  const float* xin_hi = li == 0 ? p.in[1] : XPRE2 + (size_t)NCTX * 1024;
  const float* xin_st = li == 0 ? nullptr : ST2;
  const float* xin_g = p.in[26] + (li == 0 ? 0 : (li - 1) * 1024);
  const float* xin_b = p.in[27] + (li == 0 ? 0 : (li - 1) * 1024);
  if (s == 0) {
    ln_apply(p, xin_lo, xin_hi, xin_st, xin_g, xin_b, g.mods, 1024, 0);
  } else if (s == 1) {
    g.bt = (const u16*)(p.ws + O_WTIN) + (size_t)li * NIN * D; g.K = D; g.N = NIN;
    gemm_phase<0>(p, g, li, smem);
  } else if (s == 2) {
    for (int it = blockIdx.x; it < 1664; it += gridDim.x) {
      if (it >= 384 && it < 1152) h1_item(p, it - 384, smem);
      else if (it >= 256 && it < 384) attnC_item(p, li, it - 256, smem);
      else attnA_item(p, li, it < 256 ? it : it - 896, smem);
    }
  } else if (s == 3) {
    for (int it = blockIdx.x; it < 640; it += gridDim.x) {
      if (it < 384) h2_item(p, li, it, smem);
      else attnC_item(p, li, it - 384 + 128, smem);
    }
  } else if (s == 4) {
    g.alo = xin_lo; g.ahi = xin_hi; g.stats = xin_st; g.lng = xin_g; g.lnb = xin_b;
    g.sc_off = 2048;
    g.a16 = (const u16*)(p.ws + O_MIXED);
    g.bt = (const u16*)(p.ws + O_WTOUT) + (size_t)li * D * D; g.K = D; g.N = D;
    g.xout = XPRE1; g.sout = ST1;
    gemm_phase<1>(p, g, li, smem);
  } else if (s == 5) {
    ln_apply(p, XPRE1, XPRE1 + (size_t)NCTX * 1024, ST1, p.in[24] + li * 1024, p.in[25] + li * 1024, g.mods, 4096, 3072);
  } else if (s == 6) {
    g.bt = (const u16*)(p.ws + O_WTFF1) + (size_t)li * DFF * D; g.K = D; g.N = DFF;
    g.hid = (u16*)(p.ws + O_HID);
    gemm_phase<2>(p, g, li, smem);
  } else {
    g.alo = XPRE1; g.ahi = XPRE1 + (size_t)NCTX * 1024; g.stats = ST1; g.lng = p.in[24] + li * 1024; g.lnb = p.in[25] + li * 1024;
    g.sc_off = 5120;
    g.a16 = (const u16*)(p.ws + O_HID);
    g.bt = (const u16*)(p.ws + O_WTFF2) + (size_t)li * D * DFF; g.K = DFF; g.N = D;
    g.xout = XPRE2; g.sout = ST2;
    gemm_phase<1>(p, g, li, smem);
  }
}

#define XB_TMO      128
#define XB_XCNT(j)  (256  + 64 * (j))
#define XB_XSUB(j)  (1280 + 64 * (j))
#define XB_XGEN(j)  (2304 + 64 * (j))
#define XB_TOP      3328
#define XB_TOPGEN   3392
#define XCD_BAR_WORDS 3456
#define XB_SPIN_CAP (1u << 20)
#define LAS __attribute__((address_space(3)))
DI unsigned xb_ld(unsigned* p) { return __hip_atomic_load(p, __ATOMIC_RELAXED, __HIP_MEMORY_SCOPE_AGENT); }
DI unsigned xb_add(unsigned* p, unsigned v) { return __hip_atomic_fetch_add(p, v, __ATOMIC_RELAXED, __HIP_MEMORY_SCOPE_AGENT); }
DI unsigned xb_xcc_id() { return (unsigned)__builtin_amdgcn_s_getreg((3 << 11) | 20) & 0xFu; }
#define XB_SPIN(cond, bar) do { unsigned _sp = 0; while (cond) { __builtin_amdgcn_s_sleep(1); \
    if ((++_sp & 255u) == 0u) { if (xb_ld(&(bar)[XB_TMO])) break; if (_sp > XB_SPIN_CAP) { atomicAdd(&(bar)[XB_TMO], 1u); break; } } } } while (0)
struct XcdBarrier { unsigned* bar; unsigned x; volatile LAS unsigned* st; };
DI XcdBarrier xcd_barrier_post(unsigned* bar, volatile LAS unsigned* st) {
  XcdBarrier b; b.bar = bar; b.x = xb_xcc_id(); b.st = st;
  if (threadIdx.x == 0) (void)xb_add(&bar[XB_XCNT(b.x)], 1u);
  return b;
}
DI void xcd_barrier_complete(unsigned* bar, unsigned x, unsigned& nloc, unsigned& nx) {
  const unsigned G = gridDim.x * gridDim.y * gridDim.z;
  unsigned sum, cnt, mine, sp = 0u;
  for (;;) {
    sum = 0u; cnt = 0u; mine = 0u;
#pragma unroll
    for (unsigned j = 0; j < 16; ++j) { const unsigned c = xb_ld(&bar[XB_XCNT(j)]); sum += c; cnt += (c > 0u) ? 1u : 0u; mine = (j == x) ? c : mine; }
    if (sum == G) break;
    __builtin_amdgcn_s_sleep(1);
    if ((++sp & 255u) == 0u) { if (xb_ld(&bar[XB_TMO])) break; if (sp > XB_SPIN_CAP) { atomicAdd(&bar[XB_TMO], 1u); break; } }
  }
  nloc = mine > 0u ? mine : 1u; nx = cnt > 0u ? cnt : 1u;
}
DI void xcd_barrier(const XcdBarrier& b) {
  asm volatile("s_waitcnt vmcnt(0)" ::: "memory");
  __syncthreads();
  if (threadIdx.x == 0) {
    unsigned* bar = b.bar;
    __builtin_amdgcn_s_waitcnt(0);
    unsigned nloc = b.st[0], nx = b.st[1];
    if (nloc == 0u) { xcd_barrier_complete(bar, b.x, nloc, nx); b.st[0] = nloc; b.st[1] = nx; }
    const unsigned old = xb_add(&bar[XB_XSUB(b.x)], 1u);
    const unsigned gen = old / nloc;
    if (old + 1u == (gen + 1u) * nloc) {
      __builtin_amdgcn_fence(__ATOMIC_RELEASE, "agent");
      asm volatile("s_waitcnt vmcnt(0)" ::: "memory");
      const unsigned og = xb_add(&bar[XB_TOP], 1u);
      const unsigned tg = og / nx;
      if (og + 1u == (tg + 1u) * nx) xb_add(&bar[XB_TOPGEN], 1u);
      else XB_SPIN(xb_ld(&bar[XB_TOPGEN]) == tg, bar);
      __builtin_amdgcn_fence(__ATOMIC_ACQUIRE, "agent");
      xb_add(&bar[XB_XGEN(b.x)], 1u);
      asm volatile("s_waitcnt vmcnt(0)" ::: "memory");
    } else {
      XB_SPIN(xb_ld(&bar[XB_XGEN(b.x)]) == gen, bar);
      __builtin_amdgcn_fence(__ATOMIC_ACQUIRE, "agent");
      asm volatile("s_waitcnt vmcnt(0)" ::: "memory");
    }
  }
  __syncthreads();
}
constexpr size_t O_BAR = O_END1;
static_assert(O_BAR + XCD_BAR_WORDS * 4 <= (size_t)256 * 1024 * 1024, "barrier words must fit");

#if !MULTI_LAUNCH
__global__ void __launch_bounds__(256, 2) mega_kernel(P p) {
  extern __shared__ __attribute__((aligned(16))) char smem[];
  cg::grid_group grid = cg::this_grid();
  if (p.ws == nullptr) grid.sync();
  if (threadIdx.x == 0) *(uint4*)(smem + LDS_BYTES - 16) = make_uint4(0u, 0u, 0u, 0u);
  __syncthreads();
  XcdBarrier xb = xcd_barrier_post((unsigned*)(p.ws + O_BAR), (volatile LAS unsigned*)(smem + LDS_BYTES - 16));
  run_phase(p, 0, smem); xcd_barrier(xb);
  run_phase(p, 1, smem); xcd_barrier(xb);
  run_phase(p, 2, smem); xcd_barrier(xb);
  run_phase(p, 3, smem); xcd_barrier(xb);
  run_phase(p, 4, smem); xcd_barrier(xb);
  run_phase(p, 5, smem); xcd_barrier(xb);
  run_phase(p, 6, smem); xcd_barrier(xb);
  run_phase(p, 7, smem); xcd_barrier(xb);
  run_phase(p, 8, smem); xcd_barrier(xb);
  run_phase(p, 9, smem); xcd_barrier(xb);
  run_phase(p, 10, smem); xcd_barrier(xb);
  run_phase(p, 11, smem); xcd_barrier(xb);
  run_phase(p, 12, smem); xcd_barrier(xb);
  run_phase(p, 13, smem); xcd_barrier(xb);
  run_phase(p, 14, smem); xcd_barrier(xb);
  run_phase(p, 15, smem); xcd_barrier(xb);
  run_phase(p, 16, smem); xcd_barrier(xb);
  run_phase(p, 17, smem);
}
#define MAIN_KERNEL mega_kernel
#else
__global__ void __launch_bounds__(256, 2) phase_kernel(P p, int ph, int sub) {
  extern __shared__ __attribute__((aligned(16))) char smem[];
  run_phase(p, ph, smem, sub);
}
#define MAIN_KERNEL phase_kernel
#endif

extern "C" void kernel_launch(void* const* d_in, const int* in_sizes, int n_in, void* d_out, int out_size, void* d_ws,
                              size_t ws_size, hipStream_t stream) {
  static int grid_blocks = 0;
  if (!grid_blocks) {
    int dev = 0, cus = 0, per_cu = 0;
    (void)hipGetDevice(&dev);
    (void)hipDeviceGetAttribute(&cus, hipDeviceAttributeMultiprocessorCount, dev);
    (void)hipFuncSetAttribute((const void*)MAIN_KERNEL, hipFuncAttributeMaxDynamicSharedMemorySize, LDS_BYTES);
    (void)hipOccupancyMaxActiveBlocksPerMultiprocessor(&per_cu, MAIN_KERNEL, 256, LDS_BYTES);
    if (per_cu > 2) per_cu = 2;
    if (per_cu < 1) per_cu = 1;
    grid_blocks = cus * per_cu;
  }
  P p{};
  for (int i = 0; i < 30; ++i) p.in[i] = (const float*)d_in[i];
  p.out = (float*)d_out;
  p.ws = (char*)d_ws;
#if MULTI_LAUNCH
  for (int ph = 0; ph < NPHASE; ++ph) {
    phase_kernel<<<dim3(grid_blocks), dim3(256), LDS_BYTES, stream>>>(p, ph, 0);
#ifdef DUP_MASK
    int bit = (ph == 0) ? 8 : (ph == NPHASE - 1 ? 9 : (ph - 1) & 7);
    if ((DUP_MASK >> bit) & 1) phase_kernel<<<dim3(grid_blocks), dim3(256), LDS_BYTES, stream>>>(p, ph, DUP_SUB);
#endif
  }
#else
  (void)hipMemsetAsync((char*)d_ws + O_BAR, 0, XCD_BAR_WORDS * 4, stream);
  void* args[] = {&p};
  hipError_t e = hipLaunchCooperativeKernel((void*)mega_kernel, dim3(grid_blocks), dim3(256), args, LDS_BYTES, stream);
  if (e != hipSuccess) fprintf(stderr, "cooperative launch failed: %s (grid %d)\n", hipGetErrorString(e), grid_blocks);
#endif
}
```

```cpp
#include <hip/hip_runtime.h>
#include <hip/hip_cooperative_groups.h>
#include <stdint.h>
#include <stdio.h>
namespace cg = cooperative_groups;

#ifndef MULTI_LAUNCH
#define MULTI_LAUNCH 0
#endif

#define DI __device__ __forceinline__
typedef unsigned short u16;
using bf16x8 = __attribute__((ext_vector_type(8))) short;
using f32x4 = __attribute__((ext_vector_type(4))) float;
typedef __bf16 bf2_t __attribute__((ext_vector_type(2)));
typedef float f2_t __attribute__((ext_vector_type(2)));
typedef unsigned u32x4 __attribute__((ext_vector_type(4)));
typedef unsigned u32x2 __attribute__((ext_vector_type(2)));

constexpr int D = 1024, NTOK = 6144, NCTX = 4096, NIN = 3328, DFF = 4096;
constexpr float ALPHA = 1.41421356237309515f;
constexpr float LOG2E = 1.44269504088896341f;
constexpr int LDS_BYTES = 75776;
constexpr int NPHASE = 18;

constexpr size_t O_WTIN = 0;
constexpr size_t O_WTOUT = O_WTIN + (size_t)2 * NIN * D * 2;
constexpr size_t O_WTFF1 = O_WTOUT + (size_t)2 * D * D * 2;
constexpr size_t O_WTFF2 = O_WTFF1 + (size_t)2 * DFF * D * 2;
constexpr size_t O_MODS = O_WTFF2 + (size_t)2 * D * DFF * 2;
constexpr size_t O_ROPE = O_MODS + (size_t)2 * 3 * 6144 * 4;
constexpr size_t O_QA = O_ROPE + (size_t)1024 * 32 * 2 * 4;
constexpr size_t O_KACTX = O_QA + (size_t)NTOK * 512 * 2;
constexpr size_t O_KALAT = O_KACTX + (size_t)NCTX * 512 * 2;
constexpr size_t O_VTACTX = O_KALAT + (size_t)2 * 2 * 1536 * 512 * 2;
constexpr size_t O_VTALAT = O_VTACTX + (size_t)16 * 4 * 128 * 256 * 2;
constexpr size_t O_QC = O_VTALAT + (size_t)2 * 2 * 4 * 128 * 1536 * 2;
constexpr size_t O_KCCTX = O_QC + (size_t)NTOK * 256 * 2;
constexpr size_t O_KCLAT = O_KCCTX + (size_t)NCTX * 128 * 2;
constexpr size_t O_VTCCTX = O_KCLAT + (size_t)2 * 2 * 1536 * 128 * 2;
constexpr size_t O_VTCLAT = O_VTCCTX + (size_t)16 * 2 * 64 * 256 * 2;
constexpr size_t O_KV = O_VTCLAT + (size_t)2 * 2 * 2 * 64 * 1536 * 2;
constexpr size_t O_DEC = O_KV + (size_t)768 * 4096 * 4;
constexpr size_t O_MIXED = O_DEC + (size_t)768 * 64 * 4;
constexpr size_t O_XPRE1 = O_MIXED + (size_t)NTOK * 1024 * 2;
constexpr size_t O_ST1 = O_XPRE1 + (size_t)NTOK * 1024 * 4;
constexpr size_t O_XPRE2 = O_ST1 + (size_t)NTOK * 32 * 4;
constexpr size_t O_ST2 = O_XPRE2 + (size_t)NTOK * 1024 * 4;
constexpr size_t O_ABF = O_ST2 + (size_t)NTOK * 32 * 4;
constexpr size_t O_HQ = O_ABF + (size_t)NTOK * 1024 * 2;
constexpr size_t O_HGF = O_HQ + (size_t)NTOK * 256 * 4;
constexpr size_t O_HGB = O_HGF + (size_t)NTOK * 256 * 4;
constexpr size_t O_HI = O_HGB + (size_t)NTOK * 256 * 4;
constexpr size_t O_HSG = O_HI + (size_t)NTOK * 256 * 4;
constexpr size_t O_OI = O_HSG + (size_t)NTOK * 256 * 4;
constexpr size_t O_QE = O_OI + (size_t)2 * NTOK * 256 * 4;
constexpr size_t O_END1 = O_QE + (size_t)2 * NTOK * 256 * 4;
constexpr size_t O_HID = O_HQ;
constexpr size_t O_END2 = O_HID + (size_t)NTOK * 4096 * 2;
static_assert(O_END2 <= O_END1, "HID alias must fit");
static_assert(O_END1 <= (size_t)256 * 1024 * 1024, "workspace too big");

constexpr size_t OUT_YP = 0, OUT_YS = 4194304, OUT_AK = 6291456, OUT_AV = 10485760, OUT_CK = 14680064,
                 OUT_CV = 15728640, OUT_SF = 16777216, OUT_SB = 17301504;

struct P {
  const float* in[30];
  float* out;
  char* ws;
};

DI unsigned pack2(float a, float b) {
  f2_t v = {a, b};
  bf2_t r = __builtin_convertvector(v, bf2_t);
  return __builtin_bit_cast(unsigned, r);
}
DI u16 f2bf(float x) { return (u16)(pack2(x, 0.f) & 0xffffu); }
DI float ex2(float x) { return __builtin_amdgcn_exp2f(x); }
DI float siluf(float x) { return x / (1.f + expf(-x)); }
DI float shx(float v, int m) { return __shfl_xor(v, m, 64); }
DI float red16(float x) {
  x += __builtin_bit_cast(float, __builtin_amdgcn_update_dpp(0, __builtin_bit_cast(int, x), 0xB1, 0xF, 0xF, true));
  x += __builtin_bit_cast(float, __builtin_amdgcn_update_dpp(0, __builtin_bit_cast(int, x), 0x4E, 0xF, 0xF, true));
  x += __builtin_bit_cast(float, __builtin_amdgcn_update_dpp(0, __builtin_bit_cast(int, x), 0x141, 0xF, 0xF, true));
  x += __builtin_bit_cast(float, __builtin_amdgcn_update_dpp(0, __builtin_bit_cast(int, x), 0x140, 0xF, 0xF, true));
  return x;
}
DI float xor1(float x) { return __builtin_bit_cast(float, __builtin_amdgcn_update_dpp(0, __builtin_bit_cast(int, x), 0xB1, 0xF, 0xF, true)); }
DI int ltid() { int t = threadIdx.x; asm volatile("" : "+v"(t)); return t; }
#define MFMA16(a, b, c) __builtin_amdgcn_mfma_f32_16x16x32_bf16((a), (b), (c), 0, 0, 0)

DI void p0_mod(const P& p, int item, char* smem) {
  float* ssilu = (float*)smem;
  float* red = ssilu + 3072;
  const int tid = ltid();
  __syncthreads();
  for (int i = tid; i < 3072; i += 256) {
    int w = i >> 10, k = i & 1023;
    float v = (w == 0) ? p.in[9][k] : p.in[8][(w - 1) * 1024 + k];
    ssilu[i] = siluf(v);
  }
  __syncthreads();
  const int li = item / 96, j0 = (item % 96) * 64;
  const int c4 = tid & 15, kp = tid >> 4;
  const float* W = p.in[10] + (size_t)li * 1024 * 6144 + j0 + c4 * 4;
  float4 a0 = {0, 0, 0, 0}, a1 = a0, a2 = a0;
#pragma unroll 16
  for (int kk = 0; kk < 64; ++kk) {
    int k = kp * 64 + kk;
    float4 w4 = *(const float4*)(W + (size_t)k * 6144);
    float s0 = ssilu[k], s1 = ssilu[1024 + k], s2 = ssilu[2048 + k];
    a0.x += s0 * w4.x; a0.y += s0 * w4.y; a0.z += s0 * w4.z; a0.w += s0 * w4.w;
    a1.x += s1 * w4.x; a1.y += s1 * w4.y; a1.z += s1 * w4.z; a1.w += s1 * w4.w;
    a2.x += s2 * w4.x; a2.y += s2 * w4.y; a2.z += s2 * w4.z; a2.w += s2 * w4.w;
  }
  *(float4*)(red + (kp * 3 + 0) * 64 + c4 * 4) = a0;
  *(float4*)(red + (kp * 3 + 1) * 64 + c4 * 4) = a1;
  *(float4*)(red + (kp * 3 + 2) * 64 + c4 * 4) = a2;
  __syncthreads();
  if (tid < 192) {
    int w = tid >> 6, c = tid & 63;
    float s = p.in[11][li * 6144 + j0 + c];
    for (int q = 0; q < 16; ++q) s += red[(q * 3 + w) * 64 + c];
    ((float*)(p.ws + O_MODS))[(li * 3 + w) * 6144 + j0 + c] = s;
  }
}

DI void p0_rope(const P& p, int item) {
  float* R = (float*)(p.ws + O_ROPE);
  for (int i = ltid(); i < 4096; i += 256) {
    int idx = item * 4096 + i;
    int t = idx >> 5, pp = idx & 31;
    float inv = powf(10000.f, -(float)(pp & 15) / 16.f);
    float pos = (pp < 16) ? (float)(t >> 6) : (float)(t & 63);
    float ang = pos * inv;
    R[idx * 2] = cosf(ang);
    R[idx * 2 + 1] = sinf(ang);
  }
}

DI void p0_copyk(const P& p, int item, bool isA) {
  const int W = isA ? 512 : 128;
  const float* src = isA ? p.in[2] : p.in[4];
  u16* dst = (u16*)(p.ws + (isA ? O_KALAT : O_KCLAT));
  for (int i = 0; i < 4; ++i) {
    size_t e = (size_t)item * 4096 + (size_t)(ltid() + 256 * i) * 4;
    float4 v = *(const float4*)(src + e);
    int c = (int)(e % W);
    size_t r = e / W;
    int pp = (int)(r % 512);
    int bl = (int)(r / 512);
    int b = bl >> 1, li = bl & 1;
    uint2 o;
    o.x = pack2(v.x, v.y);
    o.y = pack2(v.z, v.w);
    *(uint2*)(dst + ((size_t)((li * 2 + b) * 1536 + 1024 + pp)) * W + c) = o;
  }
}

struct TDesc { const float* src; int sstride; u16* dst; int dstride; };

DI TDesc tdesc(const P& p, int t) {
  constexpr int T_IN = 1664, T_OUT = 512, T_FF1 = 2048, T_FF2 = 2048, T_AV = 256;
  TDesc d;
  if (t < T_IN) {
    int li = t / 832, r = t % 832, kt = r / 52, nt = r % 52;
    d.src = p.in[12] + (size_t)li * 1024 * NIN + (size_t)(kt * 64) * NIN + nt * 64; d.sstride = NIN;
    d.dst = (u16*)(p.ws + O_WTIN) + (size_t)li * NIN * 1024 + (size_t)(nt * 64) * 1024 + kt * 64; d.dstride = 1024;
  } else if ((t -= T_IN) < T_OUT) {
    int li = t / 256, r = t % 256, kt = r / 16, nt = r % 16;
    d.src = p.in[13] + (size_t)li * 1024 * 1024 + (size_t)(kt * 64) * 1024 + nt * 64; d.sstride = 1024;
    d.dst = (u16*)(p.ws + O_WTOUT) + (size_t)li * 1024 * 1024 + (size_t)(nt * 64) * 1024 + kt * 64; d.dstride = 1024;
  } else if ((t -= T_OUT) < T_FF1) {
    int li = t / 1024, r = t % 1024, kt = r / 64, nt = r % 64;
    d.src = p.in[28] + (size_t)li * 1024 * DFF + (size_t)(kt * 64) * DFF + nt * 64; d.sstride = DFF;
    d.dst = (u16*)(p.ws + O_WTFF1) + (size_t)li * DFF * 1024 + (size_t)(nt * 64) * 1024 + kt * 64; d.dstride = 1024;
  } else if ((t -= T_FF1) < T_FF2) {
    int li = t / 1024, r = t % 1024, kt = r / 16, nt = r % 16;
    d.src = p.in[29] + (size_t)li * DFF * 1024 + (size_t)(kt * 64) * 1024 + nt * 64; d.sstride = 1024;
    d.dst = (u16*)(p.ws + O_WTFF2) + (size_t)li * 1024 * DFF + (size_t)(nt * 64) * DFF + kt * 64; d.dstride = DFF;
  } else if ((t -= T_FF2) < T_AV) {
    int bl = t / 64, r = t % 64, pt = r / 8, ct = r % 8;
    int b = bl >> 1, li = bl & 1;
    d.src = p.in[3] + ((size_t)bl * 512 + pt * 64) * 512 + ct * 64; d.sstride = 512;
    d.dst = (u16*)(p.ws + O_VTALAT) + ((size_t)(li * 2 + b) * 512 + ct * 64) * 1536 + 1024 + pt * 64; d.dstride = 1536;
  } else {
    t -= T_AV;
    int bl = t / 16, r = t % 16, pt = r / 2, ct = r % 2;
    int b = bl >> 1, li = bl & 1;
    d.src = p.in[5] + ((size_t)bl * 512 + pt * 64) * 128 + ct * 64; d.sstride = 128;
    d.dst = (u16*)(p.ws + O_VTCLAT) + ((size_t)(li * 2 + b) * 128 + ct * 64) * 1536 + 1024 + pt * 64; d.dstride = 1536;
  }
  return d;
}

DI void phase0(const P& p, char* smem) {
  constexpr int N_MOD = 192, N_ROPE = 8, N_AK = 256, N_CK = 64;
  constexpr int B_ROPE = N_MOD, B_AK = B_ROPE + N_ROPE, B_CK = B_AK + N_AK, B_T = B_CK + N_CK;
  constexpr int NTILES = 1664 + 512 + 2048 + 2048 + 256 + 64;
  for (int it = blockIdx.x; it < B_T; it += gridDim.x) {
    if (it < B_ROPE) p0_mod(p, it, smem);
    else if (it < B_AK) p0_rope(p, it - B_ROPE);
    else if (it < B_CK) p0_copyk(p, it - B_AK, true);
    else p0_copyk(p, it - B_CK, false);
  }
  float* tl = (float*)smem;
  const int tid = ltid();
  const int lr = tid >> 4, lc4 = tid & 15;
  const int c = tid >> 2, rs = tid & 3;
  int t = blockIdx.x;
  f32x4 v[4];
  TDesc cur;
  if (t < NTILES) {
    cur = tdesc(p, t);
#pragma unroll
    for (int i = 0; i < 4; ++i) v[i] = *(const f32x4*)(cur.src + (size_t)(lr + 16 * i) * cur.sstride + lc4 * 4);
  }
  while (t < NTILES) {
    __syncthreads();
#pragma unroll
    for (int i = 0; i < 4; ++i) {
      float* q = tl + (lr + 16 * i) * 65 + lc4 * 4;
      q[0] = v[i].x; q[1] = v[i].y; q[2] = v[i].z; q[3] = v[i].w;
    }
    const int tn = t + gridDim.x;
    TDesc nxt = cur;
    if (tn < NTILES) {
      nxt = tdesc(p, tn);
#pragma unroll
      for (int i = 0; i < 4; ++i) v[i] = *(const f32x4*)(nxt.src + (size_t)(lr + 16 * i) * nxt.sstride + lc4 * 4);
    }
    __syncthreads();
    u32x4 o0, o1;
    {
      const float* q = tl + (rs * 16) * 65 + c;
      o0.x = pack2(q[0 * 65], q[1 * 65]);   o0.y = pack2(q[2 * 65], q[3 * 65]);
      o0.z = pack2(q[4 * 65], q[5 * 65]);   o0.w = pack2(q[6 * 65], q[7 * 65]);
      o1.x = pack2(q[8 * 65], q[9 * 65]);   o1.y = pack2(q[10 * 65], q[11 * 65]);
      o1.z = pack2(q[12 * 65], q[13 * 65]); o1.w = pack2(q[14 * 65], q[15 * 65]);
    }
    u32x4* dp = (u32x4*)(cur.dst + (size_t)c * cur.dstride + rs * 16);
    dp[0] = o0;
    dp[1] = o1;
    cur = nxt;
    t = tn;
  }
}

struct GA {
  const float* alo;
  const float* ahi;
  const float* stats;
  const float* lng;
  const float* lnb;
  const float* mods;
  int sc_off, sh_off;
  const u16* a16;
  const u16* bt;
  int K, N;
  float* xout;
  float* sout;
  u16* hid;
};

DI void epi_inproj(const P& p, int li, f32x4 (&acc)[4][4], int R0, int C0);


template <int EPI>
DI void gemm_tile(const P& p, const GA& g, int li, int m0, int n0, char* smem, u32x4 (&ra0)[4], u32x4 (&rb0)[4],
                  u32x4 (&ra1)[4], u32x4 (&rb1)[4], bool primed, int nm0, int nn0) {
  const int tid = ltid(), lane = tid & 63, wid = tid >> 6, wr = wid >> 1, wc = wid & 1;
  const int l16 = lane & 15, q4 = lane >> 4;
  u16* sA0 = (u16*)smem;
  u16* sB0 = sA0 + 128 * 72;
  u16* sA1 = sB0 + 128 * 72;
  u16* sB1 = sA1 + 128 * 72;
  float2* sStat = (float2*)(smem + 73728);
  const int K = g.K;
  const int rtype = (m0 < NCTX) ? 0 : 1 + ((m0 - NCTX) >> 10);
  const float* modv = g.mods + rtype * 6144;
  const float* fsrc = (m0 < NCTX) ? g.alo + (size_t)m0 * 1024 : g.ahi + (size_t)(m0 - NCTX) * 1024;

  if (!primed) {
    const unsigned goff_ = (unsigned)(tid >> 3) * (unsigned)g.K + (unsigned)(tid & 7) * 8u;
    const u16* ab_ = g.a16 + (size_t)m0 * g.K;
    const u16* bb_ = g.bt + (size_t)n0 * g.K;
#pragma unroll
    for (int i = 0; i < 4; ++i) {
      ra0[i] = *(const u32x4*)(ab_ + (size_t)(32 * i) * g.K + goff_);
      rb0[i] = *(const u32x4*)(bb_ + (size_t)(32 * i) * g.K + goff_);
    }
    __builtin_amdgcn_sched_barrier(0);
#pragma unroll
    for (int i = 0; i < 4; ++i) {
      ra1[i] = *(const u32x4*)(ab_ + (size_t)(32 * i) * g.K + 64 + goff_);
      rb1[i] = *(const u32x4*)(bb_ + (size_t)(32 * i) * g.K + 64 + goff_);
    }
    __builtin_amdgcn_sched_barrier(0);
  }
  __syncthreads();
  if constexpr (EPI == 1 || EPI == 3) {
    if (g.stats != nullptr && tid < 128) {
      const float4* sp = (const float4*)(g.stats + (size_t)(m0 + tid) * 32);
      float s1 = 0.f, s2 = 0.f;
#pragma unroll
      for (int i = 0; i < 8; ++i) {
        float4 v = sp[i];
        s1 += v.x + v.z;
        s2 += v.y + v.w;
      }
      float mu = s1 * (1.f / 1024.f);
      float var = s2 * (1.f / 1024.f) - mu * mu;
      sStat[tid] = make_float2(mu, rsqrtf(fmaxf(var, 0.f) + 1e-6f));
    }
  }

  f32x4 acc[4][4];
#pragma unroll
  for (int i = 0; i < 4; ++i)
#pragma unroll
    for (int j = 0; j < 4; ++j) acc[i][j] = f32x4{0.f, 0.f, 0.f, 0.f};

  const unsigned goff = (unsigned)(tid >> 3) * (unsigned)K + (unsigned)(tid & 7) * 8u;
  const unsigned loff = (unsigned)(tid >> 3) * 72u + (unsigned)(tid & 7) * 8u;
  const u16* abase = g.a16 + (size_t)m0 * K;
  const u16* bbase = g.bt + (size_t)n0 * K;
#define GLOAD(RA, RB, KT)                                                        \
  _Pragma("unroll") for (int i = 0; i < 4; ++i) {                                \
    RA[i] = *(const u32x4*)(abase + (size_t)(32 * i) * K + (KT) * 64 + goff);    \
    RB[i] = *(const u32x4*)(bbase + (size_t)(32 * i) * K + (KT) * 64 + goff);    \
  }
#define LSTORE(SA, SB, RA, RB)                                                   \
  _Pragma("unroll") for (int i = 0; i < 4; ++i) {                                \
    *(u32x4*)(SA + 32 * i * 72 + loff) = RA[i];                                  \
    *(u32x4*)(SB + 32 * i * 72 + loff) = RB[i];                                  \
  }
#define COMPUTE(SA, SB)                                                          \
  _Pragma("unroll") for (int s = 0; s < 2; ++s) {                                \
    bf16x8 af[4], bfr[4];                                                        \
    _Pragma("unroll") for (int i = 0; i < 4; ++i) {                              \
      af[i] = *(const bf16x8*)(SA + (wr * 64 + i * 16 + l16) * 72 + s * 32 + q4 * 8);  \
      bfr[i] = *(const bf16x8*)(SB + (wc * 64 + i * 16 + l16) * 72 + s * 32 + q4 * 8); \
    }                                                                            \
    _Pragma("unroll") for (int i = 0; i < 4; ++i)                                \
      _Pragma("unroll") for (int j = 0; j < 4; ++j) acc[i][j] = MFMA16(af[i], bfr[j], acc[i][j]); \
    __builtin_amdgcn_sched_barrier(0);                                           \
  }

  const int nk = K >> 6;
#define SB0 __builtin_amdgcn_sched_barrier(0)
  LSTORE(sA0, sB0, ra0, rb0);
  SB0;
  GLOAD(ra0, rb0, 2);
  SB0;
  __syncthreads();
#pragma unroll 1
  for (int kt = 0; kt < nk - 4; kt += 2) {
    SB0;
    LSTORE(sA1, sB1, ra1, rb1);
    SB0;
    GLOAD(ra1, rb1, kt + 3);
    SB0;
    COMPUTE(sA0, sB0);
    __syncthreads();
    SB0;
    LSTORE(sA0, sB0, ra0, rb0);
    SB0;
    GLOAD(ra0, rb0, kt + 4);
    SB0;
    COMPUTE(sA1, sB1);
    __syncthreads();
  }
  SB0;
  LSTORE(sA1, sB1, ra1, rb1);
  SB0;
  GLOAD(ra1, rb1, nk - 1);
  SB0;
  COMPUTE(sA0, sB0);
  __syncthreads();
  const u16* nabase = g.a16 + (size_t)nm0 * K;
  const u16* nbbase = g.bt + (size_t)nn0 * K;
  SB0;
  LSTORE(sA0, sB0, ra0, rb0);
  SB0;
  _Pragma("unroll") for (int i = 0; i < 4; ++i) {
    ra0[i] = *(const u32x4*)(nabase + (size_t)(32 * i) * K + goff);
    rb0[i] = *(const u32x4*)(nbbase + (size_t)(32 * i) * K + goff);
  }
  SB0;
  COMPUTE(sA1, sB1);
  __syncthreads();
  SB0;
  LSTORE(sA1, sB1, ra1, rb1);
  SB0;
  _Pragma("unroll") for (int i = 0; i < 4; ++i) {
    ra1[i] = *(const u32x4*)(nabase + (size_t)(32 * i) * K + 64 + goff);
    rb1[i] = *(const u32x4*)(nbbase + (size_t)(32 * i) * K + 64 + goff);
  }
  SB0;
  COMPUTE(sA0, sB0);
  __syncthreads();
  SB0;
  COMPUTE(sA1, sB1);
#undef GLOAD
#undef LSTORE
#undef COMPUTE
#undef SB0
  asm volatile("" ::: "memory");

  const int R0 = m0 + wr * 64, C0 = n0 + wc * 64;
  if constexpr (EPI == 0) {
    epi_inproj(p, li, acc, R0, C0);
  } else if constexpr (EPI == 1) {
    float gate[4], lg[4], lb[4];
#pragma unroll
    for (int j = 0; j < 4; ++j) {
      int col = C0 + j * 16 + l16;
      gate[j] = modv[g.sc_off + col];
      lg[j] = g.stats ? g.lng[col] : 1.f;
      lb[j] = g.stats ? g.lnb[col] : 0.f;
    }
    float xr[4][4][4];
#pragma unroll
    for (int i = 0; i < 4; ++i)
#pragma unroll
      for (int r = 0; r < 4; ++r)
#pragma unroll
        for (int j = 0; j < 4; ++j)
          xr[i][r][j] = fsrc[(size_t)(wr * 64 + i * 16 + q4 * 4 + r) * 1024 + C0 + j * 16 + l16];
#pragma unroll
    for (int i = 0; i < 4; ++i) {
#pragma unroll
      for (int r = 0; r < 4; ++r) {
        int lrow = wr * 64 + i * 16 + q4 * 4 + r;
        float mu = 0.f, rs = 1.f;
        if (g.stats != nullptr) {
          float2 st = sStat[lrow];
          mu = st.x;
          rs = st.y;
        }
        float s1 = 0.f, s2 = 0.f;
#pragma unroll
        for (int j = 0; j < 4; ++j) {
          int col = C0 + j * 16 + l16;
          float x = xr[i][r][j];
          x = (x - mu) * rs * lg[j] + lb[j];
          float v = ALPHA * x + gate[j] * acc[i][j][r];
          g.xout[(size_t)(m0 + lrow) * 1024 + col] = v;
          s1 += v;
          s2 += v * v;
        }
        s1 = red16(s1);
        s2 = red16(s2);
        if (l16 == 0) *(float2*)(g.sout + (size_t)(m0 + lrow) * 32 + (C0 >> 6) * 2) = make_float2(s1, s2);
      }
    }
  } else {
    float* sC = (float*)smem;
    __syncthreads();
#pragma unroll
    for (int i = 0; i < 4; ++i)
#pragma unroll
      for (int j = 0; j < 4; ++j)
#pragma unroll
        for (int r = 0; r < 4; ++r) sC[(wr * 64 + i * 16 + q4 * 4 + r) * 132 + wc * 64 + j * 16 + l16] = acc[i][j][r];
    __syncthreads();
    if constexpr (EPI == 3) {
      const int hl = lane & 31, rsel = lane >> 5;
      const int col = n0 + hl * 4;
      const f32x4 gate4 = *(const f32x4*)(modv + g.sc_off + col);
      f32x4 lg4 = {1.f, 1.f, 1.f, 1.f}, lb4 = {0.f, 0.f, 0.f, 0.f};
      if (g.stats != nullptr) {
        lg4 = *(const f32x4*)(g.lng + col);
        lb4 = *(const f32x4*)(g.lnb + col);
      }
#pragma unroll 4
      for (int pp = 0; pp < 16; ++pp) {
        const int lrow = pp * 8 + wid * 2 + rsel;
        f32x4 a = *(const f32x4*)(sC + lrow * 132 + hl * 4);
        f32x4 x = *(const f32x4*)(fsrc + (size_t)lrow * 1024 + col);
        float mu = 0.f, rs = 1.f;
        if (g.stats != nullptr) {
          float2 st = sStat[lrow];
          mu = st.x;
          rs = st.y;
        }
        x = (x - mu) * rs * lg4 + lb4;
        f32x4 v = ALPHA * x + gate4 * a;
        *(f32x4*)(g.xout + (size_t)(m0 + lrow) * 1024 + col) = v;
        float s1 = (v.x + v.y) + (v.z + v.w);
        float s2 = (v.x * v.x + v.y * v.y) + (v.z * v.z + v.w * v.w);
        s1 = red16(s1);
        s2 = red16(s2);
        if ((lane & 15) == 0) *(float2*)(g.sout + (size_t)(m0 + lrow) * 32 + ((n0 >> 6) + (hl >> 4)) * 2) = make_float2(s1, s2);
      }
    } else {
#pragma unroll
      for (int pp = 0; pp < 8; ++pp) {
        const int idx = tid + 256 * pp;
        const int lrow = idx >> 4, c8 = idx & 15;
        f32x4 a0 = *(const f32x4*)(sC + lrow * 132 + c8 * 8);
        f32x4 a1 = *(const f32x4*)(sC + lrow * 132 + c8 * 8 + 4);
        a0.x = fmaxf(a0.x, 0.f); a0.y = fmaxf(a0.y, 0.f); a0.z = fmaxf(a0.z, 0.f); a0.w = fmaxf(a0.w, 0.f);
        a1.x = fmaxf(a1.x, 0.f); a1.y = fmaxf(a1.y, 0.f); a1.z = fmaxf(a1.z, 0.f); a1.w = fmaxf(a1.w, 0.f);
        u32x4 o;
        o.x = pack2(a0.x * a0.x, a0.y * a0.y);
        o.y = pack2(a0.z * a0.z, a0.w * a0.w);
        o.z = pack2(a1.x * a1.x, a1.y * a1.y);
        o.w = pack2(a1.z * a1.z, a1.w * a1.w);
        *(u32x4*)(g.hid + (size_t)(m0 + lrow) * DFF + n0 + c8 * 8) = o;
      }
    }
  }
}

DI void epi_inproj(const P& p, int li, f32x4 (&acc)[4][4], int R0, int C0) {
  const int lane = ltid() & 63, l16 = lane & 15, q4 = lane >> 4;
  const int seg = C0 >> 6;
  const bool lat = R0 >= NCTX;
  const float2* rope = (const float2*)(p.ws + O_ROPE);
  int b, tb;
  if (!lat) { b = R0 >> 8; tb = R0 & 255; } else { b = (R0 - NCTX) >> 10; tb = (R0 - NCTX) & 1023; }

  enum { T_QA, T_KA, T_VA, T_QB, T_FF, T_FB, T_IB, T_GB, T_QC, T_KC, T_VC };
  int type, cbase;
  if (seg < 8) { type = T_QA; cbase = seg * 64; }
  else if (seg < 16) { type = T_KA; cbase = (seg - 8) * 64; }
  else if (seg < 24) { type = T_VA; cbase = (seg - 16) * 64; }
  else if (seg < 28) { type = T_QB; cbase = (seg - 24) * 64; }
  else if (seg < 32) { type = T_FF; cbase = (seg - 28) * 64; }
  else if (seg < 36) { type = T_FB; cbase = (seg - 32) * 64; }
  else if (seg < 40) { type = T_IB; cbase = (seg - 36) * 64; }
  else if (seg < 44) { type = T_GB; cbase = (seg - 40) * 64; }
  else if (seg < 48) { type = T_QC; cbase = (seg - 44) * 64; }
  else if (seg < 50) { type = T_KC; cbase = (seg - 48) * 64; }
  else { type = T_VC; cbase = (seg - 50) * 64; }

  if (type == T_QC || type == T_KC) {
    const float* gv = (type == T_QC ? p.in[22] : p.in[23]) + li * 64;
    float gj[4];
#pragma unroll
    for (int j = 0; j < 4; ++j) gj[j] = gv[j * 16 + l16];
#pragma unroll
    for (int i = 0; i < 4; ++i)
#pragma unroll
      for (int r = 0; r < 4; ++r) {
        float ss = 0.f;
#pragma unroll
        for (int j = 0; j < 4; ++j) ss += acc[i][j][r] * acc[i][j][r];
        ss = red16(ss);
        float rs = rsqrtf(ss * (1.f / 64.f) + 1e-6f);
#pragma unroll
        for (int j = 0; j < 4; ++j) acc[i][j][r] = acc[i][j][r] * rs * gj[j];
      }
  }
  if (!lat && (type == T_KA || type == T_VA || type == T_KC || type == T_VC)) {
    float* o;
    int W;
    if (type == T_KA) { o = p.out + OUT_AK; W = 512; }
    else if (type == T_VA) { o = p.out + OUT_AV; W = 512; }
    else if (type == T_KC) { o = p.out + OUT_CK; W = 128; }
    else { o = p.out + OUT_CV; W = 128; }
#pragma unroll
    for (int i = 0; i < 4; ++i)
#pragma unroll
      for (int r = 0; r < 4; ++r) {
        int t = tb + i * 16 + q4 * 4 + r;
        size_t base = ((size_t)(b * 2 + li) * 256 + t) * W + cbase;
#pragma unroll
        for (int j = 0; j < 4; ++j) o[base + j * 16 + l16] = acc[i][j][r];
      }
  }
  if (lat && (type == T_QA || type == T_KA || type == T_QC || type == T_KC)) {
#pragma unroll
    for (int i = 0; i < 4; ++i)
#pragma unroll
      for (int r = 0; r < 4; ++r) {
        int t = tb + i * 16 + q4 * 4 + r;
#pragma unroll
        for (int j = 0; j < 4; ++j) {
          float v = acc[i][j][r];
          float pv = xor1(v);
          float2 cs = rope[t * 32 + j * 8 + (l16 >> 1)];
          acc[i][j][r] = (l16 & 1) ? (pv * cs.y + v * cs.x) : (v * cs.x - pv * cs.y);
        }
      }
  }

  if (type == T_QA || type == T_KA || type == T_QC || type == T_KC) {
    u16* dst;
    int W;
    size_t rowbase;
    if (type == T_QA) { dst = (u16*)(p.ws + O_QA); W = 512; rowbase = (size_t)R0 * 512; }
    else if (type == T_QC) { dst = (u16*)(p.ws + O_QC); W = 256; rowbase = (size_t)R0 * 256; }
    else if (type == T_KA) {
      W = 512;
      if (!lat) { dst = (u16*)(p.ws + O_KACTX); rowbase = (size_t)R0 * 512; }
      else { dst = (u16*)(p.ws + O_KALAT); rowbase = ((size_t)(li * 2 + b) * 1536 + tb) * 512; }
    } else {
      W = 128;
      if (!lat) { dst = (u16*)(p.ws + O_KCCTX); rowbase = (size_t)R0 * 128; }
      else { dst = (u16*)(p.ws + O_KCLAT); rowbase = ((size_t)(li * 2 + b) * 1536 + tb) * 128; }
    }
#pragma unroll
    for (int i = 0; i < 4; ++i)
#pragma unroll
      for (int r = 0; r < 4; ++r) {
        size_t base = rowbase + (size_t)(i * 16 + q4 * 4 + r) * W + cbase;
#pragma unroll
        for (int j = 0; j < 4; ++j) dst[base + j * 16 + l16] = f2bf(acc[i][j][r]);
      }
  } else if (type == T_VA || type == T_VC) {
    u16* dst;
    int L;
    size_t hb;
    if (type == T_VA) {
      int h = cbase >> 7, dv0 = cbase & 127;
      if (!lat) { dst = (u16*)(p.ws + O_VTACTX); L = 256; hb = ((size_t)(b * 4 + h) * 128 + dv0) * 256; }
      else { dst = (u16*)(p.ws + O_VTALAT); L = 1536; hb = ((size_t)((li * 2 + b) * 4 + h) * 128 + dv0) * 1536; }
    } else {
      int n = cbase >> 6;
      if (!lat) { dst = (u16*)(p.ws + O_VTCCTX); L = 256; hb = ((size_t)(b * 2 + n) * 64) * 256; }
      else { dst = (u16*)(p.ws + O_VTCLAT); L = 1536; hb = ((size_t)((li * 2 + b) * 2 + n) * 64) * 1536; }
    }
#pragma unroll
    for (int i = 0; i < 4; ++i)
#pragma unroll
      for (int j = 0; j < 4; ++j) {
        uint2 o;
        o.x = pack2(acc[i][j][0], acc[i][j][1]);
        o.y = pack2(acc[i][j][2], acc[i][j][3]);
        *(uint2*)(dst + hb + (size_t)(j * 16 + l16) * L + tb + i * 16 + q4 * 4) = o;
      }
  } else {
    float* dst;
    if (type == T_QB) dst = (float*)(p.ws + O_HQ);
    else if (type == T_FF) dst = (float*)(p.ws + O_HGF);
    else if (type == T_FB) dst = (float*)(p.ws + O_HGB);
    else if (type == T_IB) dst = (float*)(p.ws + O_HI);
    else dst = (float*)(p.ws + O_HSG);
    float lbv[4] = {0.f, 0.f, 0.f, 0.f};
    if ((type == T_FF || type == T_FB) && li == 1) {
      const float* lg = (type == T_FF) ? p.in[19] : p.in[20];
#pragma unroll
      for (int j = 0; j < 4; ++j) {
        int c = cbase + j * 16 + l16;
        lbv[j] = 1.f / (1.f + expf(lg[c] - lg[256 + c]));
      }
    }
#pragma unroll
    for (int i = 0; i < 4; ++i)
#pragma unroll
      for (int r = 0; r < 4; ++r) {
        size_t base = (size_t)(R0 + i * 16 + q4 * 4 + r) * 256 + cbase;
#pragma unroll
        for (int j = 0; j < 4; ++j) {
          float v = acc[i][j][r];
          float o;
          if (type == T_QB || type == T_GB) o = v * __frcp_rn(1.f + __expf(-v));
          else if (type == T_IB) o = v;
          else {
            float sg = __frcp_rn(1.f + __expf(-v));
            float f = lbv[j] + (1.f - lbv[j]) * sg;
            o = __logf(fmaxf(f, 1e-6f));
          }
          dst[base + j * 16 + l16] = o;
        }
      }
  }
}

template <int EPI>
DI void gemm_phase(const P& p, const GA& g, int li, char* smem) {
  const int NT = g.N >> 7;
  const int xcd = blockIdx.x & 7, lb = blockIdx.x >> 3, nlb = gridDim.x >> 3;
  if (lb >= nlb) return;
  u32x4 ra0[4], rb0[4], ra1[4], rb1[4];
  bool primed = false;
  for (int t = lb; t < 6 * NT; t += nlb) {
    int mt = xcd * 6 + t % 6, nt = t / 6;
    const int tn = (t + nlb < 6 * NT) ? t + nlb : t;
    const int nmt = xcd * 6 + tn % 6, nnt = tn / 6;
    gemm_tile<EPI>(p, g, li, mt * 128, nt * 128, smem, ra0, rb0, ra1, rb1, primed, nmt * 128, nnt * 128);
    primed = true;
  }
}


template <int KW, int DV>
DI void attn_gload(const u16* Kb, int kstride, const u16* VT, int L, int kb, int tid, u32x4 (&kr)[KW / 32], u32x4 (&vr)[DV / 32]) {
  constexpr int KPR = 256 / (KW / 8);
  const unsigned koff = (unsigned)(tid / (KW / 8)) * (unsigned)kstride + (unsigned)(tid % (KW / 8)) * 8u;
  const unsigned voff = (unsigned)(tid >> 3) * (unsigned)L + (unsigned)(tid & 7) * 8u;
#pragma unroll
  for (int i = 0; i < KW / 32; ++i) {
    const u16* kbp = Kb + (size_t)(kb * 64 + KPR * i) * kstride;
    kr[i] = *(const u32x4*)(kbp + koff);
  }
#pragma unroll
  for (int i = 0; i < DV / 32; ++i) {
    const u16* vbp = VT + (size_t)(32 * i) * L + kb * 64;
    vr[i] = *(const u32x4*)(vbp + voff);
  }
}
template <int KW, int DV>
DI void attn_lstore(u16* sK, u16* sV, int tid, const u32x4 (&kr)[KW / 32], const u32x4 (&vr)[DV / 32]) {
  constexpr int KS = KW + 8;
#pragma unroll
  for (int i = 0; i < KW / 32; ++i) {
    int idx = tid + 256 * i;
    int key = idx / (KW / 8), cc = idx % (KW / 8);
    *(u32x4*)(sK + key * KS + cc * 8) = kr[i];
  }
#pragma unroll
  for (int i = 0; i < DV / 32; ++i) {
    int idx = tid + 256 * i;
    int row = idx >> 3, cc = idx & 7;
    *(u32x4*)(sV + row * 72 + cc * 8) = vr[i];
  }
}

template <int KW, int DV>
DI void attn_compute(const u16* sK, const u16* sV, int kfo, int l16, int q4, const bf16x8& qf0, const bf16x8& qf1,
                     f32x4 (&o)[DV / 16], float& m, float& l) {
  constexpr int KS = KW + 8, NDT = DV / 16;
  const float c = 0.125f * LOG2E;
  f32x4 st[4];
#pragma unroll
  for (int kt = 0; kt < 4; ++kt) {
    const u16* kp = sK + (kt * 16 + l16) * KS + kfo + q4 * 8;
    bf16x8 k0 = *(const bf16x8*)kp;
    bf16x8 k1 = *(const bf16x8*)(kp + 32);
    f32x4 z = {0.f, 0.f, 0.f, 0.f};
    z = MFMA16(k0, qf0, z);
    st[kt] = MFMA16(k1, qf1, z);
  }
  float bm = st[0][0];
#pragma unroll
  for (int kt = 0; kt < 4; ++kt)
#pragma unroll
    for (int r = 0; r < 4; ++r) bm = fmaxf(bm, st[kt][r]);
  bm = fmaxf(bm, shx(bm, 16));
  bm = fmaxf(bm, shx(bm, 32));
  const float mn = fmaxf(m, bm);
  const float alpha = ex2((m - mn) * c);
  m = mn;
  float ps = 0.f;
#pragma unroll
  for (int kt = 0; kt < 4; ++kt)
#pragma unroll
    for (int r = 0; r < 4; ++r) {
      float pv = ex2((st[kt][r] - mn) * c);
      st[kt][r] = pv;
      ps += pv;
    }
  l = l * alpha + ps;
#pragma unroll
  for (int d = 0; d < NDT; ++d) {
    o[d][0] *= alpha; o[d][1] *= alpha; o[d][2] *= alpha; o[d][3] *= alpha;
  }
#pragma unroll
  for (int ks = 0; ks < 2; ++ks) {
    u32x4 pu;
    pu.x = pack2(st[2 * ks][0], st[2 * ks][1]);
    pu.y = pack2(st[2 * ks][2], st[2 * ks][3]);
    pu.z = pack2(st[2 * ks + 1][0], st[2 * ks + 1][1]);
    pu.w = pack2(st[2 * ks + 1][2], st[2 * ks + 1][3]);
    bf16x8 pf = __builtin_bit_cast(bf16x8, pu);
#pragma unroll
    for (int d = 0; d < NDT; ++d) {
      const u16* vp = sV + (d * 16 + l16) * 72 + ks * 32 + q4 * 4;
      u32x2 v0 = *(const u32x2*)vp;
      u32x2 v1 = *(const u32x2*)(vp + 16);
      u32x4 vu = {v0.x, v0.y, v1.x, v1.y};
      bf16x8 vf = __builtin_bit_cast(bf16x8, vu);
      o[d] = MFMA16(vf, pf, o[d]);
    }
  }
}

template <int KW, int DV, bool DIFF>
DI void attn_item(const u16* Q, int qstride, int qcol, int qrow0, const u16* Kb, int kstride, const u16* VT, int L,
                          int nkeys, u16* mixed, int mixcol, float lam, float postscale, const float* subg, char* smem) {
  const int tid = ltid(), lane = tid & 63, wid = tid >> 6, l16 = lane & 15, q4 = lane >> 4;
  const int qsub = wid & 1, var = wid >> 1;
  constexpr int KS = KW + 8;
  constexpr int STAGE = 64 * KS + DV * 72;
  u16* sK0 = (u16*)smem;
  u16* sV0 = sK0 + 64 * KS;
  u16* sK1 = sK0 + STAGE;
  u16* sV1 = sV0 + STAGE;
  constexpr int KPT = KW / 32, VPT = DV / 32, NDT = DV / 16;
  const int kfo = DIFF ? var * 64 : 0;

  const u16* qp = Q + (size_t)(qrow0 + qsub * 16 + l16) * qstride + qcol + var * 64 + q4 * 8;
  const bf16x8 qf0 = *(const bf16x8*)qp;
  const bf16x8 qf1 = *(const bf16x8*)(qp + 32);

  u32x4 kr0[KPT], vr0[VPT], kr1[KPT], vr1[VPT];
  f32x4 o[NDT];
#pragma unroll
  for (int d = 0; d < NDT; ++d) o[d] = f32x4{0.f, 0.f, 0.f, 0.f};
  float m = -INFINITY, l = 0.f;
  const int nkb = nkeys >> 6;
#define SB0 __builtin_amdgcn_sched_barrier(0)
  attn_gload<KW, DV>(Kb, kstride, VT, L, 0, tid, kr0, vr0);
  SB0;
  attn_gload<KW, DV>(Kb, kstride, VT, L, 1, tid, kr1, vr1);
  SB0;
  __syncthreads();
  attn_lstore<KW, DV>(sK0, sV0, tid, kr0, vr0);
  SB0;
  attn_gload<KW, DV>(Kb, kstride, VT, L, 2, tid, kr0, vr0);
  SB0;
  __syncthreads();
#pragma unroll 1
  for (int kb = 0; kb < nkb - 4; kb += 2) {
    SB0;
    attn_lstore<KW, DV>(sK1, sV1, tid, kr1, vr1);
    SB0;
    attn_gload<KW, DV>(Kb, kstride, VT, L, kb + 3, tid, kr1, vr1);
    SB0;
    attn_compute<KW, DV>(sK0, sV0, kfo, l16, q4, qf0, qf1, o, m, l);
    __syncthreads();
    SB0;
    attn_lstore<KW, DV>(sK0, sV0, tid, kr0, vr0);
    SB0;
    attn_gload<KW, DV>(Kb, kstride, VT, L, kb + 4, tid, kr0, vr0);
    SB0;
    attn_compute<KW, DV>(sK1, sV1, kfo, l16, q4, qf0, qf1, o, m, l);
    __syncthreads();
  }
  SB0;
  attn_lstore<KW, DV>(sK1, sV1, tid, kr1, vr1);
  SB0;
  attn_gload<KW, DV>(Kb, kstride, VT, L, nkb - 1, tid, kr1, vr1);
  SB0;
  attn_compute<KW, DV>(sK0, sV0, kfo, l16, q4, qf0, qf1, o, m, l);
  __syncthreads();
  SB0;
  attn_lstore<KW, DV>(sK0, sV0, tid, kr0, vr0);
  SB0;
  attn_compute<KW, DV>(sK1, sV1, kfo, l16, q4, qf0, qf1, o, m, l);
  __syncthreads();
  SB0;
  attn_lstore<KW, DV>(sK1, sV1, tid, kr1, vr1);
  SB0;
  attn_compute<KW, DV>(sK0, sV0, kfo, l16, q4, qf0, qf1, o, m, l);
  __syncthreads();
  SB0;
  attn_compute<KW, DV>(sK1, sV1, kfo, l16, q4, qf0, qf1, o, m, l);
  __syncthreads();
#undef SB0
  l += shx(l, 16);
  l += shx(l, 32);
  const float inv = 1.f / l;
  const int row = qrow0 + qsub * 16 + l16;
  if constexpr (DIFF) {
    __syncthreads();
    float* sO = (float*)smem;
    if (var == 1) {
#pragma unroll
      for (int d = 0; d < NDT; ++d)
        *(float4*)(sO + (qsub * 16 + l16) * 132 + d * 16 + q4 * 4) =
            make_float4(o[d][0] * inv, o[d][1] * inv, o[d][2] * inv, o[d][3] * inv);
    }
    __syncthreads();
    if (var == 0) {
      float ss = 0.f;
#pragma unroll
      for (int d = 0; d < NDT; ++d) {
        float4 o1 = *(const float4*)(sO + (qsub * 16 + l16) * 132 + d * 16 + q4 * 4);
        o[d][0] = o[d][0] * inv - lam * o1.x;
        o[d][1] = o[d][1] * inv - lam * o1.y;
        o[d][2] = o[d][2] * inv - lam * o1.z;
        o[d][3] = o[d][3] * inv - lam * o1.w;
        ss += o[d][0] * o[d][0] + o[d][1] * o[d][1] + o[d][2] * o[d][2] + o[d][3] * o[d][3];
      }
      ss += shx(ss, 16);
      ss += shx(ss, 32);
      const float rs = rsqrtf(ss * (1.f / 128.f) + 1e-6f) * postscale;
      float4 ggv[NDT];
#pragma unroll
      for (int d = 0; d < NDT; ++d) ggv[d] = *(const float4*)(subg + d * 16 + q4 * 4);
#pragma unroll
      for (int d = 0; d < NDT; ++d) {
        float4 gg = ggv[d];
        uint2 ov;
        ov.x = pack2(o[d][0] * rs * gg.x, o[d][1] * rs * gg.y);
        ov.y = pack2(o[d][2] * rs * gg.z, o[d][3] * rs * gg.w);
        *(uint2*)(mixed + (size_t)row * 1024 + mixcol + d * 16 + q4 * 4) = ov;
      }
    }
  } else {
#pragma unroll
    for (int d = 0; d < NDT; ++d) {
      uint2 ov;
      ov.x = pack2(o[d][0] * inv, o[d][1] * inv);
      ov.y = pack2(o[d][2] * inv, o[d][3] * inv);
      *(uint2*)(mixed + (size_t)row * 1024 + mixcol + var * 64 + d * 16 + q4 * 4) = ov;
    }
  }
}

DI void attnA_item(const P& p, int li, int it, char* smem) {
  const int lane = ltid() & 63;
  float d1 = p.in[14][li * 64 + lane] * p.in[15][li * 64 + lane];
  float d2 = p.in[16][li * 64 + lane] * p.in[17][li * 64 + lane];
#pragma unroll
  for (int s = 1; s < 64; s <<= 1) { d1 += shx(d1, s); d2 += shx(d2, s); }
  const float lam_init = 0.8f - 0.6f * expf(-0.3f * (float)li);
  const float lam = expf(d1) - expf(d2) + lam_init;
  const u16* QA = (const u16*)(p.ws + O_QA);
  u16* mixed = (u16*)(p.ws + O_MIXED);
  const float* subg = p.in[18] + li * 128;
  int qrow0, L;
  const u16 *Kb, *VT;
  int h;
  if (it < 256) {
    int b = it >> 7, qb = it & 31;
    h = (it >> 5) & 3;
    Kb = (const u16*)(p.ws + O_KALAT) + (size_t)(li * 2 + b) * 1536 * 512 + h * 128;
    VT = (const u16*)(p.ws + O_VTALAT) + (size_t)((li * 2 + b) * 4 + h) * 128 * 1536;
    qrow0 = NCTX + b * 1024 + qb * 32;
    L = 1536;
  } else {
    it -= 256;
    int b = it >> 5, qb = it & 7;
    h = (it >> 3) & 3;
    Kb = (const u16*)(p.ws + O_KACTX) + (size_t)b * 256 * 512 + h * 128;
    VT = (const u16*)(p.ws + O_VTACTX) + (size_t)(b * 4 + h) * 128 * 256;
    qrow0 = b * 256 + qb * 32;
    L = 256;
  }
  attn_item<128, 128, true>(QA, 512, h * 128, qrow0, Kb, 512, VT, L, L, mixed, h * 128, lam, 1.f - lam_init, subg, smem);
}
DI void attnC_item(const P& p, int li, int it, char* smem) {
  const u16* QC = (const u16*)(p.ws + O_QC);
  u16* mixed = (u16*)(p.ws + O_MIXED);
  int qrow0, L, n;
  const u16 *Kb, *VT;
  if (it < 128) {
    int b = it >> 6, qb = it & 31;
    n = (it >> 5) & 1;
    Kb = (const u16*)(p.ws + O_KCLAT) + (size_t)(li * 2 + b) * 1536 * 128 + n * 64;
    VT = (const u16*)(p.ws + O_VTCLAT) + (size_t)((li * 2 + b) * 2 + n) * 64 * 1536;
    qrow0 = NCTX + b * 1024 + qb * 32;
    L = 1536;
  } else {
    it -= 128;
    int b = it >> 4, qb = it & 7;
    n = (it >> 3) & 1;
    Kb = (const u16*)(p.ws + O_KCCTX) + (size_t)b * 256 * 128 + n * 64;
    VT = (const u16*)(p.ws + O_VTCCTX) + (size_t)(b * 2 + n) * 64 * 256;
    qrow0 = b * 256 + qb * 32;
    L = 256;
  }
  attn_item<64, 64, false>(QC, 256, n * 128, qrow0, Kb, 128, VT, L, L, mixed, 768 + n * 128, 0.f, 1.f, nullptr, smem);
}

DI void h1_item(const P& p, int item, char* smem) {
  const int tid = ltid(), lane = tid & 63, w = tid >> 6, l16 = lane & 15, q4 = lane >> 4;
  const int dir = item & 1, h = (item >> 1) & 3, tc = item >> 3;
  const int row0 = tc * 64;
  float* sQ = (float*)smem;
  float* sB = sQ + 64 * 68;
  float* sK = sB + 64 * 68;
  u16* sVT = (u16*)(sK + 64 * 68);
  float* sTot = (float*)(sVT + 64 * 72);
  const float* HQ = (const float*)(p.ws + O_HQ);
  const float* HG = (const float*)(p.ws + (dir ? O_HGB : O_HGF));
  const float* HI = (const float*)(p.ws + O_HI);
  float* OI = (float*)(p.ws + O_OI) + (size_t)dir * NTOK * 256;
  u16* QE = (u16*)(p.ws + O_QE) + (size_t)dir * NTOK * 256;
  float* KV = (float*)(p.ws + O_KV) + (size_t)item * 4096;
  float* DEC = (float*)(p.ws + O_DEC) + (size_t)item * 64;

  __syncthreads();
#pragma unroll
  for (int i = 0; i < 4; ++i) {
    int idx = tid + 256 * i;
    int lo = idx >> 4, c4 = idx & 15;
    int row = dir ? row0 + 63 - lo : row0 + lo;
    size_t off = (size_t)row * 256 + h * 64 + c4 * 4;
    *(float4*)(sQ + lo * 68 + c4 * 4) = *(const float4*)(HQ + off);
    *(float4*)(sB + lo * 68 + c4 * 4) = *(const float4*)(HG + off);
    float4 v = *(const float4*)(HI + off);
    sVT[(c4 * 4 + 0) * 72 + lo] = f2bf(v.x);
    sVT[(c4 * 4 + 1) * 72 + lo] = f2bf(v.y);
    sVT[(c4 * 4 + 2) * 72 + lo] = f2bf(v.z);
    sVT[(c4 * 4 + 3) * 72 + lo] = f2bf(v.w);
  }
  __syncthreads();
  {
    const int k = tid & 63, part = tid >> 6;
    float run = 0.f;
#pragma unroll 4
    for (int e = 0; e < 16; ++e) {
      int i = part * 16 + e;
      float g = sB[i * 68 + k];
      sK[i * 68 + k] = 1.f - ex2(g * LOG2E);
      run += g * LOG2E;
      sB[i * 68 + k] = run;
    }
    sTot[part * 64 + k] = run;
    __syncthreads();
    float add = 0.f;
    for (int pp = 0; pp < part; ++pp) add += sTot[pp * 64 + k];
    if (part > 0)
      for (int e = 0; e < 16; ++e) sB[(part * 16 + e) * 68 + k] += add;
  }
  __syncthreads();
#pragma unroll
  for (int i = 0; i < 4; ++i) {
    int idx = tid + 256 * i;
    int lo = idx >> 4, c4 = idx & 15;
    int row = dir ? row0 + 63 - lo : row0 + lo;
    f32x4 q = *(const f32x4*)(sQ + lo * 68 + c4 * 4);
    f32x4 bb = *(const f32x4*)(sB + lo * 68 + c4 * 4);
    u32x2 o;
    o.x = pack2(q.x * ex2(bb.x), q.y * ex2(bb.y));
    o.y = pack2(q.z * ex2(bb.z), q.w * ex2(bb.w));
    *(u32x2*)(QE + (size_t)row * 256 + h * 64 + c4 * 4) = o;
  }
  {
    const int I = w;
    bf16x8 qs[2];
    f32x4 rr[2][2];
#pragma unroll
    for (int s = 0; s < 2; ++s) {
      const int kk0 = s * 32 + q4 * 8;
      if (I > 0) {
        rr[s][0] = *(const f32x4*)(sB + (16 * I - 1) * 68 + kk0);
        rr[s][1] = *(const f32x4*)(sB + (16 * I - 1) * 68 + kk0 + 4);
      } else {
        rr[s][0] = f32x4{0.f, 0.f, 0.f, 0.f};
        rr[s][1] = rr[s][0];
      }
      const float* qr = sQ + (16 * I + l16) * 68 + kk0;
      const float* br = sB + (16 * I + l16) * 68 + kk0;
      f32x4 q0 = *(const f32x4*)qr, q1 = *(const f32x4*)(qr + 4);
      f32x4 b0 = *(const f32x4*)br, b1 = *(const f32x4*)(br + 4);
      u32x4 pu;
      pu.x = pack2(q0.x * ex2(b0.x - rr[s][0].x), q0.y * ex2(b0.y - rr[s][0].y));
      pu.y = pack2(q0.z * ex2(b0.z - rr[s][0].z), q0.w * ex2(b0.w - rr[s][0].w));
      pu.z = pack2(q1.x * ex2(b1.x - rr[s][1].x), q1.y * ex2(b1.y - rr[s][1].y));
      pu.w = pack2(q1.z * ex2(b1.z - rr[s][1].z), q1.w * ex2(b1.w - rr[s][1].w));
      qs[s] = __builtin_bit_cast(bf16x8, pu);
    }
    f32x4 at[4];
#pragma unroll
    for (int J = 0; J < 4; ++J) {
      at[J] = f32x4{0.f, 0.f, 0.f, 0.f};
      if (J <= I) {
#pragma unroll
        for (int s = 0; s < 2; ++s) {
          const int kk0 = s * 32 + q4 * 8;
          const float* kr = sK + (16 * J + l16) * 68 + kk0;
          const float* br = sB + (16 * J + l16) * 68 + kk0;
          f32x4 k0 = *(const f32x4*)kr, k1 = *(const f32x4*)(kr + 4);
          f32x4 b0 = *(const f32x4*)br, b1 = *(const f32x4*)(br + 4);
          u32x4 pu;
          pu.x = pack2(k0.x * ex2(fminf(rr[s][0].x - b0.x, 100.f)), k0.y * ex2(fminf(rr[s][0].y - b0.y, 100.f)));
          pu.y = pack2(k0.z * ex2(fminf(rr[s][0].z - b0.z, 100.f)), k0.w * ex2(fminf(rr[s][0].w - b0.w, 100.f)));
          pu.z = pack2(k1.x * ex2(fminf(rr[s][1].x - b1.x, 100.f)), k1.y * ex2(fminf(rr[s][1].y - b1.y, 100.f)));
          pu.w = pack2(k1.z * ex2(fminf(rr[s][1].z - b1.z, 100.f)), k1.w * ex2(fminf(rr[s][1].w - b1.w, 100.f)));
          bf16x8 kf = __builtin_bit_cast(bf16x8, pu);
          at[J] = MFMA16(kf, qs[s], at[J]);
        }
        if (J == I) {
#pragma unroll
          for (int r = 0; r < 4; ++r)
            if (q4 * 4 + r > l16) at[J][r] = 0.f;
        }
      }
    }
    f32x4 oc[4];
#pragma unroll
    for (int vt = 0; vt < 4; ++vt) oc[vt] = f32x4{0.f, 0.f, 0.f, 0.f};
#pragma unroll
    for (int ks = 0; ks < 2; ++ks) {
      if (2 * ks <= I) {
        u32x4 pu;
        pu.x = pack2(at[2 * ks][0], at[2 * ks][1]);
        pu.y = pack2(at[2 * ks][2], at[2 * ks][3]);
        pu.z = pack2(at[2 * ks + 1][0], at[2 * ks + 1][1]);
        pu.w = pack2(at[2 * ks + 1][2], at[2 * ks + 1][3]);
        bf16x8 pf = __builtin_bit_cast(bf16x8, pu);
#pragma unroll
        for (int vt = 0; vt < 4; ++vt) {
          const u16* vp = sVT + (vt * 16 + l16) * 72 + ks * 32 + q4 * 4;
          u32x2 v0 = *(const u32x2*)vp;
          u32x2 v1 = *(const u32x2*)(vp + 16);
          u32x4 vu = {v0.x, v0.y, v1.x, v1.y};
          oc[vt] = MFMA16(__builtin_bit_cast(bf16x8, vu), pf, oc[vt]);
        }
      }
    }
    {
      const int t = 16 * I + l16;
      const int row = dir ? row0 + 63 - t : row0 + t;
#pragma unroll
      for (int vt = 0; vt < 4; ++vt) *(f32x4*)(OI + (size_t)row * 256 + h * 64 + vt * 16 + q4 * 4) = oc[vt];
    }
  }
  {
    const int k = 16 * w + l16;
    const float bend = sB[63 * 68 + k];
    f32x4 kc[4];
#pragma unroll
    for (int vt = 0; vt < 4; ++vt) kc[vt] = f32x4{0.f, 0.f, 0.f, 0.f};
#pragma unroll
    for (int ks = 0; ks < 2; ++ks) {
      float kd[8];
#pragma unroll
      for (int j = 0; j < 8; ++j) {
        const int s = ks * 32 + q4 * 8 + j;
        kd[j] = sK[s * 68 + k] * ex2(bend - sB[s * 68 + k]);
      }
      u32x4 pu;
      pu.x = pack2(kd[0], kd[1]);
      pu.y = pack2(kd[2], kd[3]);
      pu.z = pack2(kd[4], kd[5]);
      pu.w = pack2(kd[6], kd[7]);
      bf16x8 af = __builtin_bit_cast(bf16x8, pu);
#pragma unroll
      for (int vt = 0; vt < 4; ++vt) {
        bf16x8 vf = *(const bf16x8*)(sVT + (vt * 16 + l16) * 72 + ks * 32 + q4 * 8);
        kc[vt] = MFMA16(af, vf, kc[vt]);
      }
    }
#pragma unroll
    for (int vt = 0; vt < 4; ++vt)
#pragma unroll
      for (int r = 0; r < 4; ++r) KV[(16 * w + q4 * 4 + r) * 64 + vt * 16 + l16] = kc[vt][r];
    if (q4 == 0) DEC[k] = ex2(bend);
  }
}

DI void h2_item(const P& p, int li, int item, char* smem) {
  const int tid = ltid(), ty = tid >> 4, tx = tid & 15;
  const int lane = tid & 63, w = tid >> 6, l16 = lane & 15, q4 = lane >> 4;
  const int h = item & 3, tc = item >> 2, row0 = tc * 64;
  const bool lat = tc >= 64;
  int seq, cl, nc;
  if (!lat) { seq = tc >> 2; cl = tc & 3; nc = 4; } else { seq = (tc - 64) >> 4; cl = (tc - 64) & 15; nc = 16; }
  const int tcbase = tc - cl;
  u16* sST = (u16*)smem;
  const float* KVb = (const float*)(p.ws + O_KV);
  const float* DECb = (const float*)(p.ws + O_DEC);
  __syncthreads();
#pragma unroll 1
  for (int dir = 0; dir < 2; ++dir) {
    float4 S[4];
#pragma unroll
    for (int a = 0; a < 4; ++a) {
      if (lat) S[a] = *(const float4*)(p.in[6 + dir] + ((size_t)((seq * 2 + li) * 4 + h) * 64 + ty + 16 * a) * 64 + tx * 4);
      else S[a] = make_float4(0.f, 0.f, 0.f, 0.f);
    }
    const int nprev = dir == 0 ? cl : nc - 1 - cl;
#pragma unroll 1
    for (int j = 0; j < nprev; ++j) {
      int tcj = tcbase + (dir == 0 ? j : nc - 1 - j);
      size_t itj = (size_t)((tcj * 4 + h) * 2 + dir);
#pragma unroll
      for (int a = 0; a < 4; ++a) {
        int k = ty + 16 * a;
        float dcy = DECb[itj * 64 + k];
        float4 kv = *(const float4*)(KVb + itj * 4096 + k * 64 + tx * 4);
        S[a].x = dcy * S[a].x + kv.x; S[a].y = dcy * S[a].y + kv.y; S[a].z = dcy * S[a].z + kv.z; S[a].w = dcy * S[a].w + kv.w;
      }
    }
    if (!lat && nprev == nc - 1) {
      size_t itj = (size_t)((tc * 4 + h) * 2 + dir);
      float* so = p.out + (dir == 0 ? OUT_SF : OUT_SB) + (size_t)((seq * 2 + li) * 4 + h) * 4096;
#pragma unroll
      for (int a = 0; a < 4; ++a) {
        int k = ty + 16 * a;
        float dcy = DECb[itj * 64 + k];
        float4 kv = *(const float4*)(KVb + itj * 4096 + k * 64 + tx * 4);
        *(float4*)(so + k * 64 + tx * 4) = make_float4(dcy * S[a].x + kv.x, dcy * S[a].y + kv.y, dcy * S[a].z + kv.z, dcy * S[a].w + kv.w);
      }
    }
    u16* st = sST + dir * 64 * 72;
#pragma unroll
    for (int a = 0; a < 4; ++a) {
      int k = ty + 16 * a;
      st[(tx * 4 + 0) * 72 + k] = f2bf(S[a].x);
      st[(tx * 4 + 1) * 72 + k] = f2bf(S[a].y);
      st[(tx * 4 + 2) * 72 + k] = f2bf(S[a].z);
      st[(tx * 4 + 3) * 72 + k] = f2bf(S[a].w);
    }
  }
  __syncthreads();
  f32x4 oc[4];
#pragma unroll
  for (int vt = 0; vt < 4; ++vt) oc[vt] = f32x4{0.f, 0.f, 0.f, 0.f};
#pragma unroll
  for (int dir = 0; dir < 2; ++dir) {
    const u16* QE = (const u16*)(p.ws + O_QE) + (size_t)dir * NTOK * 256 + (size_t)(row0 + 16 * w + l16) * 256 + h * 64 + q4 * 8;
    const u16* st = sST + dir * 64 * 72;
#pragma unroll
    for (int ks = 0; ks < 2; ++ks) {
      bf16x8 af = *(const bf16x8*)(QE + ks * 32);
#pragma unroll
      for (int vt = 0; vt < 4; ++vt) {
        bf16x8 bf = *(const bf16x8*)(st + (vt * 16 + l16) * 72 + ks * 32 + q4 * 8);
        oc[vt] = MFMA16(af, bf, oc[vt]);
      }
    }
  }
  const float* OI0 = (const float*)(p.ws + O_OI);
  const float* OI1 = OI0 + (size_t)NTOK * 256;
  const float* HSG = (const float*)(p.ws + O_HSG);
  u16* mixed = (u16*)(p.ws + O_MIXED);
  float gn[4];
#pragma unroll
  for (int vt = 0; vt < 4; ++vt) gn[vt] = p.in[21][li * 64 + vt * 16 + l16];
  float oi[4][4], sgv[4][4];
#pragma unroll
  for (int r = 0; r < 4; ++r) {
    const size_t off = (size_t)(row0 + 16 * w + q4 * 4 + r) * 256 + h * 64 + l16;
#pragma unroll
    for (int vt = 0; vt < 4; ++vt) {
      oi[r][vt] = OI0[off + vt * 16] + OI1[off + vt * 16];
      sgv[r][vt] = HSG[off + vt * 16];
    }
  }
#pragma unroll
  for (int r = 0; r < 4; ++r) {
    const int row = row0 + 16 * w + q4 * 4 + r;
    float val[4];
    float ss = 0.f;
#pragma unroll
    for (int vt = 0; vt < 4; ++vt) {
      val[vt] = oc[vt][r] + oi[r][vt];
      ss += val[vt] * val[vt];
    }
    ss = red16(ss);
    const float rs = rsqrtf(ss * (1.f / 64.f) + 1e-6f);
#pragma unroll
    for (int vt = 0; vt < 4; ++vt)
      mixed[(size_t)row * 1024 + 512 + h * 64 + vt * 16 + l16] = f2bf(val[vt] * rs * gn[vt] * sgv[r][vt]);
  }
}

DI void ln_apply(const P& p, const float* lo, const float* hi, const float* stats, const float* lng, const float* lnb,
                 const float* mods, int sc_off, int sh_off) {
  const int lane = ltid() & 63, wid = ltid() >> 6;
  u16* dst = (u16*)(p.ws + O_ABF);
  for (int it = blockIdx.x; it < NTOK / 4; it += gridDim.x) {
    const int row = it * 4 + wid;
    float mu = 0.f, rs = 1.f;
    if (stats != nullptr) {
      float s1 = 0.f, s2 = 0.f;
      if (lane < 16) {
        float2 v = *(const float2*)(stats + (size_t)row * 32 + lane * 2);
        s1 = v.x;
        s2 = v.y;
      }
#pragma unroll
      for (int s = 1; s < 16; s <<= 1) { s1 += shx(s1, s); s2 += shx(s2, s); }
      s1 = __shfl(s1, 0, 64);
      s2 = __shfl(s2, 0, 64);
      mu = s1 * (1.f / 1024.f);
      rs = rsqrtf(fmaxf(s2 * (1.f / 1024.f) - mu * mu, 0.f) + 1e-6f);
    }
    const float* x = row < NCTX ? lo + (size_t)row * 1024 : hi + (size_t)(row - NCTX) * 1024;
    const int rtype = row < NCTX ? 0 : 1 + ((row - NCTX) >> 10);
    const float* mv = mods + rtype * 6144;
    f32x4 xv[4], scv[4], shv[4], ggv[4], bbv[4];
#pragma unroll
    for (int i = 0; i < 4; ++i) {
      const int c = (lane + 64 * i) * 4;
      xv[i] = *(const f32x4*)(x + c);
      scv[i] = *(const f32x4*)(mv + sc_off + c);
      shv[i] = *(const f32x4*)(mv + sh_off + c);
      if (stats != nullptr) {
        ggv[i] = *(const f32x4*)(lng + c);
        bbv[i] = *(const f32x4*)(lnb + c);
      }
    }
#pragma unroll
    for (int i = 0; i < 4; ++i) {
      const int c = (lane + 64 * i) * 4;
      f32x4 v = xv[i];
      f32x4 sc = scv[i] + 1.f;
      f32x4 sh = shv[i];
      if (stats != nullptr) v = (v - mu) * rs * ggv[i] + bbv[i];
      v = v * sc + sh;
      u32x2 o;
      o.x = pack2(v.x, v.y);
      o.y = pack2(v.z, v.w);
      *(u32x2*)(dst + (size_t)row * 1024 + c) = o;
    }
  }
}

DI void final_ln(const P& p) {
  const int lane = ltid() & 63, wid = ltid() >> 6;
  const float* X = (const float*)(p.ws + O_XPRE2);
  const float* ST = (const float*)(p.ws + O_ST2);
  const float* g = p.in[26] + 1024;
  const float* bb = p.in[27] + 1024;
  for (int it = blockIdx.x; it < NTOK / 4; it += gridDim.x) {
    int row = it * 4 + wid;
    float s1 = 0.f, s2 = 0.f;
    if (lane < 16) {
      float2 v = *(const float2*)(ST + (size_t)row * 32 + lane * 2);
      s1 = v.x;
      s2 = v.y;
    }
#pragma unroll
    for (int s = 1; s < 16; s <<= 1) { s1 += shx(s1, s); s2 += shx(s2, s); }
    s1 = __shfl(s1, 0, 64);
    s2 = __shfl(s2, 0, 64);
    float mu = s1 * (1.f / 1024.f);
    float rs = rsqrtf(fmaxf(s2 * (1.f / 1024.f) - mu * mu, 0.f) + 1e-6f);
    float* out = p.out + (row < NCTX ? OUT_YP + (size_t)row * 1024 : OUT_YS + (size_t)(row - NCTX) * 1024);
    float4 xv[4], gv[4], bv[4];
#pragma unroll
    for (int i = 0; i < 4; ++i) {
      int c = (lane + 64 * i) * 4;
      xv[i] = *(const float4*)(X + (size_t)row * 1024 + c);
      gv[i] = *(const float4*)(g + c);
      bv[i] = *(const float4*)(bb + c);
    }
#pragma unroll
    for (int i = 0; i < 4; ++i) {
      int c = (lane + 64 * i) * 4;
      float4 x = xv[i];
      float4 gg = gv[i];
      float4 b4 = bv[i];
      *(float4*)(out + c) = make_float4((x.x - mu) * rs * gg.x + b4.x, (x.y - mu) * rs * gg.y + b4.y,
                                         (x.z - mu) * rs * gg.z + b4.z, (x.w - mu) * rs * gg.w + b4.w);
    }
  }
}

DI void run_phase(const P& p, int ph, char* smem, int sub = 0) {
  if (ph == 0) { phase0(p, smem); return; }
  if (ph == NPHASE - 1) { final_ln(p); return; }
  const int li = (ph - 1) >> 3, s = (ph - 1) & 7;
  float* XPRE1 = (float*)(p.ws + O_XPRE1);
  float* XPRE2 = (float*)(p.ws + O_XPRE2);
  float* ST1 = (float*)(p.ws + O_ST1);
  float* ST2 = (float*)(p.ws + O_ST2);
  GA g;
  g.mods = (const float*)(p.ws + O_MODS) + li * 3 * 6144;
  g.a16 = (const u16*)(p.ws + O_ABF); g.xout = nullptr; g.sout = nullptr; g.hid = nullptr;
  g.alo = nullptr; g.ahi = nullptr; g.stats = nullptr; g.lng = nullptr; g.lnb = nullptr; g.sc_off = 0; g.sh_off = 0;
  const float* xin_lo = li == 0 ? p.in[0] : XPRE2;
  const float* xin_hi = li == 0 ? p.in[1] : XPRE2 + (size_t)NCTX * 1024;
  const float* xin_st = li == 0 ? nullptr : ST2;
  const float* xin_g = p.in[26] + (li == 0 ? 0 : (li - 1) * 1024);
  const float* xin_b = p.in[27] + (li == 0 ? 0 : (li - 1) * 1024);
  if (s == 0) {
    ln_apply(p, xin_lo, xin_hi, xin_st, xin_g, xin_b, g.mods, 1024, 0);
  } else if (s == 1) {
    g.bt = (const u16*)(p.ws + O_WTIN) + (size_t)li * NIN * D; g.K = D; g.N = NIN;
    gemm_phase<0>(p, g, li, smem);
  } else if (s == 2) {
    for (int it = blockIdx.x; it < 1664; it += gridDim.x) {
      if (it >= 384 && it < 1152) h1_item(p, it - 384, smem);
      else if (it >= 256 && it < 384) attnC_item(p, li, it - 256, smem);
      else attnA_item(p, li, it < 256 ? it : it - 896, smem);
    }
  } else if (s == 3) {
    for (int it = blockIdx.x; it < 640; it += gridDim.x) {
      if (it < 384) h2_item(p, li, it, smem);
      else attnC_item(p, li, it - 384 + 128, smem);
    }
  } else if (s == 4) {
    g.alo = xin_lo; g.ahi = xin_hi; g.stats = xin_st; g.lng = xin_g; g.lnb = xin_b;
    g.sc_off = 2048;
    g.a16 = (const u16*)(p.ws + O_MIXED);
    g.bt = (const u16*)(p.ws + O_WTOUT) + (size_t)li * D * D; g.K = D; g.N = D;
    g.xout = XPRE1; g.sout = ST1;
    gemm_phase<1>(p, g, li, smem);
  } else if (s == 5) {
    ln_apply(p, XPRE1, XPRE1 + (size_t)NCTX * 1024, ST1, p.in[24] + li * 1024, p.in[25] + li * 1024, g.mods, 4096, 3072);
  } else if (s == 6) {
    g.bt = (const u16*)(p.ws + O_WTFF1) + (size_t)li * DFF * D; g.K = D; g.N = DFF;
    g.hid = (u16*)(p.ws + O_HID);
    gemm_phase<2>(p, g, li, smem);
  } else {
    g.alo = XPRE1; g.ahi = XPRE1 + (size_t)NCTX * 1024; g.stats = ST1; g.lng = p.in[24] + li * 1024; g.lnb = p.in[25] + li * 1024;
    g.sc_off = 5120;
    g.a16 = (const u16*)(p.ws + O_HID);
    g.bt = (const u16*)(p.ws + O_WTFF2) + (size_t)li * D * DFF; g.K = DFF; g.N = D;
    g.xout = XPRE2; g.sout = ST2;
    gemm_phase<1>(p, g, li, smem);
  }
}

#define XB_TMO      128
#define XB_XCNT(j)  (256  + 64 * (j))
#define XB_XSUB(j)  (1280 + 64 * (j))
#define XB_XGEN(j)  (2304 + 64 * (j))
#define XB_TOP      3328
#define XB_TOPGEN   3392
#define XCD_BAR_WORDS 3456
#define XB_SPIN_CAP (1u << 20)
#define LAS __attribute__((address_space(3)))
DI unsigned xb_ld(unsigned* p) { return __hip_atomic_load(p, __ATOMIC_RELAXED, __HIP_MEMORY_SCOPE_AGENT); }
DI unsigned xb_add(unsigned* p, unsigned v) { return __hip_atomic_fetch_add(p, v, __ATOMIC_RELAXED, __HIP_MEMORY_SCOPE_AGENT); }
DI unsigned xb_xcc_id() { return (unsigned)__builtin_amdgcn_s_getreg((3 << 11) | 20) & 0xFu; }
#define XB_SPIN(cond, bar) do { unsigned _sp = 0; while (cond) { __builtin_amdgcn_s_sleep(1); \
    if ((++_sp & 255u) == 0u) { if (xb_ld(&(bar)[XB_TMO])) break; if (_sp > XB_SPIN_CAP) { atomicAdd(&(bar)[XB_TMO], 1u); break; } } } } while (0)
struct XcdBarrier { unsigned* bar; unsigned x; volatile LAS unsigned* st; };
DI XcdBarrier xcd_barrier_post(unsigned* bar, volatile LAS unsigned* st) {
  XcdBarrier b; b.bar = bar; b.x = xb_xcc_id(); b.st = st;
  if (threadIdx.x == 0) (void)xb_add(&bar[XB_XCNT(b.x)], 1u);
  return b;
}
DI void xcd_barrier_complete(unsigned* bar, unsigned x, unsigned& nloc, unsigned& nx) {
  const unsigned G = gridDim.x * gridDim.y * gridDim.z;
  unsigned sum, cnt, mine, sp = 0u;
  for (;;) {
    sum = 0u; cnt = 0u; mine = 0u;
#pragma unroll
    for (unsigned j = 0; j < 16; ++j) { const unsigned c = xb_ld(&bar[XB_XCNT(j)]); sum += c; cnt += (c > 0u) ? 1u : 0u; mine = (j == x) ? c : mine; }
    if (sum == G) break;
    __builtin_amdgcn_s_sleep(1);
    if ((++sp & 255u) == 0u) { if (xb_ld(&bar[XB_TMO])) break; if (sp > XB_SPIN_CAP) { atomicAdd(&bar[XB_TMO], 1u); break; } }
  }
  nloc = mine > 0u ? mine : 1u; nx = cnt > 0u ? cnt : 1u;
}
DI void xcd_barrier(const XcdBarrier& b) {
  asm volatile("s_waitcnt vmcnt(0)" ::: "memory");
  __syncthreads();
  if (threadIdx.x == 0) {
    unsigned* bar = b.bar;
    __builtin_amdgcn_s_waitcnt(0);
    unsigned nloc = b.st[0], nx = b.st[1];
    if (nloc == 0u) { xcd_barrier_complete(bar, b.x, nloc, nx); b.st[0] = nloc; b.st[1] = nx; }
    const unsigned old = xb_add(&bar[XB_XSUB(b.x)], 1u);
    const unsigned gen = old / nloc;
    if (old + 1u == (gen + 1u) * nloc) {
      __builtin_amdgcn_fence(__ATOMIC_RELEASE, "agent");
      asm volatile("s_waitcnt vmcnt(0)" ::: "memory");
      const unsigned og = xb_add(&bar[XB_TOP], 1u);
      const unsigned tg = og / nx;
      if (og + 1u == (tg + 1u) * nx) xb_add(&bar[XB_TOPGEN], 1u);
      else XB_SPIN(xb_ld(&bar[XB_TOPGEN]) == tg, bar);
      __builtin_amdgcn_fence(__ATOMIC_ACQUIRE, "agent");
      xb_add(&bar[XB_XGEN(b.x)], 1u);
      asm volatile("s_waitcnt vmcnt(0)" ::: "memory");
    } else {
      XB_SPIN(xb_ld(&bar[XB_XGEN(b.x)]) == gen, bar);
      __builtin_amdgcn_fence(__ATOMIC_ACQUIRE, "agent");
      asm volatile("s_waitcnt vmcnt(0)" ::: "memory");
    }
  }
  __syncthreads();
}
constexpr size_t O_BAR = O_END1;
static_assert(O_BAR + XCD_BAR_WORDS * 4 <= (size_t)256 * 1024 * 1024, "barrier words must fit");

#if !MULTI_LAUNCH
__global__ void __launch_bounds__(256, 2) mega_kernel(P p) {
  extern __shared__ __attribute__((aligned(16))) char smem[];
  cg::grid_group grid = cg::this_grid();
  if (p.ws == nullptr) grid.sync();
  if (threadIdx.x == 0) *(uint4*)(smem + LDS_BYTES - 16) = make_uint4(0u, 0u, 0u, 0u);
  __syncthreads();
  XcdBarrier xb = xcd_barrier_post((unsigned*)(p.ws + O_BAR), (volatile LAS unsigned*)(smem + LDS_BYTES - 16));
  run_phase(p, 0, smem); xcd_barrier(xb);
  run_phase(p, 1, smem); xcd_barrier(xb);
  run_phase(p, 2, smem); xcd_barrier(xb);
  run_phase(p, 3, smem); xcd_barrier(xb);
  run_phase(p, 4, smem); xcd_barrier(xb);
  run_phase(p, 5, smem); xcd_barrier(xb);
  run_phase(p, 6, smem); xcd_barrier(xb);
  run_phase(p, 7, smem); xcd_barrier(xb);
  run_phase(p, 8, smem); xcd_barrier(xb);
  run_phase(p, 9, smem); xcd_barrier(xb);
  run_phase(p, 10, smem); xcd_barrier(xb);
  run_phase(p, 11, smem); xcd_barrier(xb);
  run_phase(p, 12, smem); xcd_barrier(xb);
  run_phase(p, 13, smem); xcd_barrier(xb);
  run_phase(p, 14, smem); xcd_barrier(xb);
  run_phase(p, 15, smem); xcd_barrier(xb);
  run_phase(p, 16, smem); xcd_barrier(xb);
  run_phase(p, 17, smem);
}
#define MAIN_KERNEL mega_kernel
#else
__global__ void __launch_bounds__(256, 2) phase_kernel(P p, int ph, int sub) {
  extern __shared__ __attribute__((aligned(16))) char smem[];
  run_phase(p, ph, smem, sub);
}
#define MAIN_KERNEL phase_kernel
#endif

extern "C" void kernel_launch(void* const* d_in, const int* in_sizes, int n_in, void* d_out, int out_size, void* d_ws,
                              size_t ws_size, hipStream_t stream) {
  static int grid_blocks = 0;
  if (!grid_blocks) {
    int dev = 0, cus = 0, per_cu = 0;
    (void)hipGetDevice(&dev);
    (void)hipDeviceGetAttribute(&cus, hipDeviceAttributeMultiprocessorCount, dev);
    (void)hipFuncSetAttribute((const void*)MAIN_KERNEL, hipFuncAttributeMaxDynamicSharedMemorySize, LDS_BYTES);
    (void)hipOccupancyMaxActiveBlocksPerMultiprocessor(&per_cu, MAIN_KERNEL, 256, LDS_BYTES);
    if (per_cu > 2) per_cu = 2;
    if (per_cu < 1) per_cu = 1;
    grid_blocks = cus * per_cu;
  }
  P p{};
  for (int i = 0; i < 30; ++i) p.in[i] = (const float*)d_in[i];
  p.out = (float*)d_out;
  p.ws = (char*)d_ws;
#if MULTI_LAUNCH
  for (int ph = 0; ph < NPHASE; ++ph) {
    phase_kernel<<<dim3(grid_blocks), dim3(256), LDS_BYTES, stream>>>(p, ph, 0);
#ifdef DUP_MASK
    int bit = (ph == 0) ? 8 : (ph == NPHASE - 1 ? 9 : (ph - 1) & 7);
    if ((DUP_MASK >> bit) & 1) phase_kernel<<<dim3(grid_blocks), dim3(256), LDS_BYTES, stream>>>(p, ph, DUP_SUB);
#endif
  }
#else
  (void)hipMemsetAsync((char*)d_ws + O_BAR, 0, XCD_BAR_WORDS * 4, stream);
  void* args[] = {&p};
  hipError_t e = hipLaunchCooperativeKernel((void*)mega_kernel, dim3(grid_blocks), dim3(256), args, LDS_BYTES, stream);
  if (e != hipSuccess) fprintf(stderr, "cooperative launch failed: %s (grid %d)\n", hipGetErrorString(e), grid_blocks);
#endif
}
```

```cpp
#include <hip/hip_runtime.h>
#include <hip/hip_cooperative_groups.h>
#include <stdint.h>
#include <stdio.h>
namespace cg = cooperative_groups;

#ifndef MULTI_LAUNCH
#define MULTI_LAUNCH 0
#endif

#define DI __device__ __forceinline__
typedef unsigned short u16;
using bf16x8 = __attribute__((ext_vector_type(8))) short;
using f32x4 = __attribute__((ext_vector_type(4))) float;
typedef __bf16 bf2_t __attribute__((ext_vector_type(2)));
typedef float f2_t __attribute__((ext_vector_type(2)));
typedef unsigned u32x4 __attribute__((ext_vector_type(4)));
typedef unsigned u32x2 __attribute__((ext_vector_type(2)));

constexpr int D = 1024, NTOK = 6144, NCTX = 4096, NIN = 3328, DFF = 4096;
constexpr float ALPHA = 1.41421356237309515f;
constexpr float LOG2E = 1.44269504088896341f;
constexpr int LDS_BYTES = 75776;
constexpr int NPHASE = 18;

constexpr size_t O_WTIN = 0;
constexpr size_t O_WTOUT = O_WTIN + (size_t)2 * NIN * D * 2;
constexpr size_t O_WTFF1 = O_WTOUT + (size_t)2 * D * D * 2;
constexpr size_t O_WTFF2 = O_WTFF1 + (size_t)2 * DFF * D * 2;
constexpr size_t O_MODS = O_WTFF2 + (size_t)2 * D * DFF * 2;
constexpr size_t O_ROPE = O_MODS + (size_t)2 * 3 * 6144 * 4;
constexpr size_t O_QA = O_ROPE + (size_t)1024 * 32 * 2 * 4;
constexpr size_t O_KACTX = O_QA + (size_t)NTOK * 512 * 2;
constexpr size_t O_KALAT = O_KACTX + (size_t)NCTX * 512 * 2;
constexpr size_t O_VTACTX = O_KALAT + (size_t)2 * 2 * 1536 * 512 * 2;
constexpr size_t O_VTALAT = O_VTACTX + (size_t)16 * 4 * 128 * 256 * 2;
constexpr size_t O_QC = O_VTALAT + (size_t)2 * 2 * 4 * 128 * 1536 * 2;
constexpr size_t O_KCCTX = O_QC + (size_t)NTOK * 256 * 2;
constexpr size_t O_KCLAT = O_KCCTX + (size_t)NCTX * 128 * 2;
constexpr size_t O_VTCCTX = O_KCLAT + (size_t)2 * 2 * 1536 * 128 * 2;
constexpr size_t O_VTCLAT = O_VTCCTX + (size_t)16 * 2 * 64 * 256 * 2;
constexpr size_t O_KV = O_VTCLAT + (size_t)2 * 2 * 2 * 64 * 1536 * 2;
constexpr size_t O_DEC = O_KV + (size_t)768 * 4096 * 4;
constexpr size_t O_MIXED = O_DEC + (size_t)768 * 64 * 4;
constexpr size_t O_XPRE1 = O_MIXED + (size_t)NTOK * 1024 * 2;
constexpr size_t O_ST1 = O_XPRE1 + (size_t)NTOK * 1024 * 4;
constexpr size_t O_XPRE2 = O_ST1 + (size_t)NTOK * 32 * 4;
constexpr size_t O_ST2 = O_XPRE2 + (size_t)NTOK * 1024 * 4;
constexpr size_t O_ABF = O_ST2 + (size_t)NTOK * 32 * 4;
constexpr size_t O_HQ = O_ABF + (size_t)NTOK * 1024 * 2;
constexpr size_t O_HGF = O_HQ + (size_t)NTOK * 256 * 4;
constexpr size_t O_HGB = O_HGF + (size_t)NTOK * 256 * 4;
constexpr size_t O_HI = O_HGB + (size_t)NTOK * 256 * 4;
constexpr size_t O_HSG = O_HI + (size_t)NTOK * 256 * 4;
constexpr size_t O_OI = O_HSG + (size_t)NTOK * 256 * 4;
constexpr size_t O_QE = O_OI + (size_t)2 * NTOK * 256 * 4;
constexpr size_t O_END1 = O_QE + (size_t)2 * NTOK * 256 * 4;
constexpr size_t O_HID = O_HQ;
constexpr size_t O_END2 = O_HID + (size_t)NTOK * 4096 * 2;
static_assert(O_END2 <= O_END1, "HID alias must fit");
static_assert(O_END1 <= (size_t)256 * 1024 * 1024, "workspace too big");

constexpr size_t OUT_YP = 0, OUT_YS = 4194304, OUT_AK = 6291456, OUT_AV = 10485760, OUT_CK = 14680064,
                 OUT_CV = 15728640, OUT_SF = 16777216, OUT_SB = 17301504;

struct P {
  const float* in[30];
  float* out;
  char* ws;
};

DI unsigned pack2(float a, float b) {
  f2_t v = {a, b};
  bf2_t r = __builtin_convertvector(v, bf2_t);
  return __builtin_bit_cast(unsigned, r);
}
DI u16 f2bf(float x) { return (u16)(pack2(x, 0.f) & 0xffffu); }
DI float ex2(float x) { return __builtin_amdgcn_exp2f(x); }
DI float siluf(float x) { return x / (1.f + expf(-x)); }
DI float shx(float v, int m) { return __shfl_xor(v, m, 64); }
DI float red16(float x) {
  x += __builtin_bit_cast(float, __builtin_amdgcn_update_dpp(0, __builtin_bit_cast(int, x), 0xB1, 0xF, 0xF, true));
  x += __builtin_bit_cast(float, __builtin_amdgcn_update_dpp(0, __builtin_bit_cast(int, x), 0x4E, 0xF, 0xF, true));
  x += __builtin_bit_cast(float, __builtin_amdgcn_update_dpp(0, __builtin_bit_cast(int, x), 0x141, 0xF, 0xF, true));
  x += __builtin_bit_cast(float, __builtin_amdgcn_update_dpp(0, __builtin_bit_cast(int, x), 0x140, 0xF, 0xF, true));
  return x;
}
DI float xor1(float x) { return __builtin_bit_cast(float, __builtin_amdgcn_update_dpp(0, __builtin_bit_cast(int, x), 0xB1, 0xF, 0xF, true)); }
DI int ltid() { int t = threadIdx.x; asm volatile("" : "+v"(t)); return t; }
#define MFMA16(a, b, c) __builtin_amdgcn_mfma_f32_16x16x32_bf16((a), (b), (c), 0, 0, 0)

DI void p0_mod(const P& p, int item, char* smem) {
  float* ssilu = (float*)smem;
  float* red = ssilu + 3072;
  const int tid = ltid();
  __syncthreads();
  for (int i = tid; i < 3072; i += 256) {
    int w = i >> 10, k = i & 1023;
    float v = (w == 0) ? p.in[9][k] : p.in[8][(w - 1) * 1024 + k];
    ssilu[i] = siluf(v);
  }
  __syncthreads();
  const int li = item / 96, j0 = (item % 96) * 64;
  const int c4 = tid & 15, kp = tid >> 4;
  const float* W = p.in[10] + (size_t)li * 1024 * 6144 + j0 + c4 * 4;
  float4 a0 = {0, 0, 0, 0}, a1 = a0, a2 = a0;
#pragma unroll 16
  for (int kk = 0; kk < 64; ++kk) {
    int k = kp * 64 + kk;
    float4 w4 = *(const float4*)(W + (size_t)k * 6144);
    float s0 = ssilu[k], s1 = ssilu[1024 + k], s2 = ssilu[2048 + k];
    a0.x += s0 * w4.x; a0.y += s0 * w4.y; a0.z += s0 * w4.z; a0.w += s0 * w4.w;
    a1.x += s1 * w4.x; a1.y += s1 * w4.y; a1.z += s1 * w4.z; a1.w += s1 * w4.w;
    a2.x += s2 * w4.x; a2.y += s2 * w4.y; a2.z += s2 * w4.z; a2.w += s2 * w4.w;
  }
  *(float4*)(red + (kp * 3 + 0) * 64 + c4 * 4) = a0;
  *(float4*)(red + (kp * 3 + 1) * 64 + c4 * 4) = a1;
  *(float4*)(red + (kp * 3 + 2) * 64 + c4 * 4) = a2;
  __syncthreads();
  if (tid < 192) {
    int w = tid >> 6, c = tid & 63;
    float s = p.in[11][li * 6144 + j0 + c];
    for (int q = 0; q < 16; ++q) s += red[(q * 3 + w) * 64 + c];
    ((float*)(p.ws + O_MODS))[(li * 3 + w) * 6144 + j0 + c] = s;
  }
}

DI void p0_rope(const P& p, int item) {
  float* R = (float*)(p.ws + O_ROPE);
  for (int i = ltid(); i < 4096; i += 256) {
    int idx = item * 4096 + i;
    int t = idx >> 5, pp = idx & 31;
    float inv = powf(10000.f, -(float)(pp & 15) / 16.f);
    float pos = (pp < 16) ? (float)(t >> 6) : (float)(t & 63);
    float ang = pos * inv;
    R[idx * 2] = cosf(ang);
    R[idx * 2 + 1] = sinf(ang);
  }
}

DI void p0_copyk(const P& p, int item, bool isA) {
  const int W = isA ? 512 : 128;
  const float* src = isA ? p.in[2] : p.in[4];
  u16* dst = (u16*)(p.ws + (isA ? O_KALAT : O_KCLAT));
  for (int i = 0; i < 4; ++i) {
    size_t e = (size_t)item * 4096 + (size_t)(ltid() + 256 * i) * 4;
    float4 v = *(const float4*)(src + e);
    int c = (int)(e % W);
    size_t r = e / W;
    int pp = (int)(r % 512);
    int bl = (int)(r / 512);
    int b = bl >> 1, li = bl & 1;
    uint2 o;
    o.x = pack2(v.x, v.y);
    o.y = pack2(v.z, v.w);
    *(uint2*)(dst + ((size_t)((li * 2 + b) * 1536 + 1024 + pp)) * W + c) = o;
  }
}

struct TDesc { const float* src; int sstride; u16* dst; int dstride; };

DI TDesc tdesc(const P& p, int t) {
  constexpr int T_IN = 1664, T_OUT = 512, T_FF1 = 2048, T_FF2 = 2048, T_AV = 256;
  TDesc d;
  if (t < T_IN) {
    int li = t / 832, r = t % 832, kt = r / 52, nt = r % 52;
    d.src = p.in[12] + (size_t)li * 1024 * NIN + (size_t)(kt * 64) * NIN + nt * 64; d.sstride = NIN;
    d.dst = (u16*)(p.ws + O_WTIN) + (size_t)li * NIN * 1024 + (size_t)(nt * 64) * 1024 + kt * 64; d.dstride = 1024;
  } else if ((t -= T_IN) < T_OUT) {
    int li = t / 256, r = t % 256, kt = r / 16, nt = r % 16;
    d.src = p.in[13] + (size_t)li * 1024 * 1024 + (size_t)(kt * 64) * 1024 + nt * 64; d.sstride = 1024;
    d.dst = (u16*)(p.ws + O_WTOUT) + (size_t)li * 1024 * 1024 + (size_t)(nt * 64) * 1024 + kt * 64; d.dstride = 1024;
  } else if ((t -= T_OUT) < T_FF1) {
    int li = t / 1024, r = t % 1024, kt = r / 64, nt = r % 64;
    d.src = p.in[28] + (size_t)li * 1024 * DFF + (size_t)(kt * 64) * DFF + nt * 64; d.sstride = DFF;
    d.dst = (u16*)(p.ws + O_WTFF1) + (size_t)li * DFF * 1024 + (size_t)(nt * 64) * 1024 + kt * 64; d.dstride = 1024;
  } else if ((t -= T_FF1) < T_FF2) {
    int li = t / 1024, r = t % 1024, kt = r / 16, nt = r % 16;
    d.src = p.in[29] + (size_t)li * DFF * 1024 + (size_t)(kt * 64) * 1024 + nt * 64; d.sstride = 1024;
    d.dst = (u16*)(p.ws + O_WTFF2) + (size_t)li * 1024 * DFF + (size_t)(nt * 64) * DFF + kt * 64; d.dstride = DFF;
  } else if ((t -= T_FF2) < T_AV) {
    int bl = t / 64, r = t % 64, pt = r / 8, ct = r % 8;
    int b = bl >> 1, li = bl & 1;
    d.src = p.in[3] + ((size_t)bl * 512 + pt * 64) * 512 + ct * 64; d.sstride = 512;
    d.dst = (u16*)(p.ws + O_VTALAT) + ((size_t)(li * 2 + b) * 512 + ct * 64) * 1536 + 1024 + pt * 64; d.dstride = 1536;
  } else {
    t -= T_AV;
    int bl = t / 16, r = t % 16, pt = r / 2, ct = r % 2;
    int b = bl >> 1, li = bl & 1;
    d.src = p.in[5] + ((size_t)bl * 512 + pt * 64) * 128 + ct * 64; d.sstride = 128;
    d.dst = (u16*)(p.ws + O_VTCLAT) + ((size_t)(li * 2 + b) * 128 + ct * 64) * 1536 + 1024 + pt * 64; d.dstride = 1536;
  }
  return d;
}

DI void phase0(const P& p, char* smem) {
  constexpr int N_MOD = 192, N_ROPE = 8, N_AK = 256, N_CK = 64;
  constexpr int B_ROPE = N_MOD, B_AK = B_ROPE + N_ROPE, B_CK = B_AK + N_AK, B_T = B_CK + N_CK;
  constexpr int NTILES = 1664 + 512 + 2048 + 2048 + 256 + 64;
  for (int it = blockIdx.x; it < B_T; it += gridDim.x) {
    if (it < B_ROPE) p0_mod(p, it, smem);
    else if (it < B_AK) p0_rope(p, it - B_ROPE);
    else if (it < B_CK) p0_copyk(p, it - B_AK, true);
    else p0_copyk(p, it - B_CK, false);
  }
  float* tl = (float*)smem;
  const int tid = ltid();
  const int lr = tid >> 4, lc4 = tid & 15;
  const int c = tid >> 2, rs = tid & 3;
  int t = blockIdx.x;
  f32x4 v[4];
  TDesc cur;
  if (t < NTILES) {
    cur = tdesc(p, t);
#pragma unroll
    for (int i = 0; i < 4; ++i) v[i] = *(const f32x4*)(cur.src + (size_t)(lr + 16 * i) * cur.sstride + lc4 * 4);
  }
  while (t < NTILES) {
    __syncthreads();
#pragma unroll
    for (int i = 0; i < 4; ++i) {
      float* q = tl + (lr + 16 * i) * 65 + lc4 * 4;
      q[0] = v[i].x; q[1] = v[i].y; q[2] = v[i].z; q[3] = v[i].w;
    }
    const int tn = t + gridDim.x;
    TDesc nxt = cur;
    if (tn < NTILES) {
      nxt = tdesc(p, tn);
#pragma unroll
      for (int i = 0; i < 4; ++i) v[i] = *(const f32x4*)(nxt.src + (size_t)(lr + 16 * i) * nxt.sstride + lc4 * 4);
    }
    __syncthreads();
    u32x4 o0, o1;
    {
      const float* q = tl + (rs * 16) * 65 + c;
      o0.x = pack2(q[0 * 65], q[1 * 65]);   o0.y = pack2(q[2 * 65], q[3 * 65]);
      o0.z = pack2(q[4 * 65], q[5 * 65]);   o0.w = pack2(q[6 * 65], q[7 * 65]);
      o1.x = pack2(q[8 * 65], q[9 * 65]);   o1.y = pack2(q[10 * 65], q[11 * 65]);
      o1.z = pack2(q[12 * 65], q[13 * 65]); o1.w = pack2(q[14 * 65], q[15 * 65]);
    }
    u32x4* dp = (u32x4*)(cur.dst + (size_t)c * cur.dstride + rs * 16);
    dp[0] = o0;
    dp[1] = o1;
    cur = nxt;
    t = tn;
  }
}

struct GA {
  const float* alo;
  const float* ahi;
  const float* stats;
  const float* lng;
  const float* lnb;
  const float* mods;
  int sc_off, sh_off;
  const u16* a16;
  const u16* bt;
  int K, N;
  float* xout;
  float* sout;
  u16* hid;
};

DI void epi_inproj(const P& p, int li, f32x4 (&acc)[4][4], int R0, int C0);


template <int EPI>
DI void gemm_tile(const P& p, const GA& g, int li, int m0, int n0, char* smem, u32x4 (&ra0)[4], u32x4 (&rb0)[4],
                  u32x4 (&ra1)[4], u32x4 (&rb1)[4], bool primed, int nm0, int nn0) {
  const int tid = ltid(), lane = tid & 63, wid = tid >> 6, wr = wid >> 1, wc = wid & 1;
  const int l16 = lane & 15, q4 = lane >> 4;
  u16* sA0 = (u16*)smem;
  u16* sB0 = sA0 + 128 * 72;
  u16* sA1 = sB0 + 128 * 72;
  u16* sB1 = sA1 + 128 * 72;
  float2* sStat = (float2*)(smem + 73728);
  const int K = g.K;
  const int rtype = (m0 < NCTX) ? 0 : 1 + ((m0 - NCTX) >> 10);
  const float* modv = g.mods + rtype * 6144;
  const float* fsrc = (m0 < NCTX) ? g.alo + (size_t)m0 * 1024 : g.ahi + (size_t)(m0 - NCTX) * 1024;

  if (!primed) {
    const unsigned goff_ = (unsigned)(tid >> 3) * (unsigned)g.K + (unsigned)(tid & 7) * 8u;
    const u16* ab_ = g.a16 + (size_t)m0 * g.K;
    const u16* bb_ = g.bt + (size_t)n0 * g.K;
#pragma unroll
    for (int i = 0; i < 4; ++i) {
      ra0[i] = *(const u32x4*)(ab_ + (size_t)(32 * i) * g.K + goff_);
      rb0[i] = *(const u32x4*)(bb_ + (size_t)(32 * i) * g.K + goff_);
    }
    __builtin_amdgcn_sched_barrier(0);
#pragma unroll
    for (int i = 0; i < 4; ++i) {
      ra1[i] = *(const u32x4*)(ab_ + (size_t)(32 * i) * g.K + 64 + goff_);
      rb1[i] = *(const u32x4*)(bb_ + (size_t)(32 * i) * g.K + 64 + goff_);
    }
    __builtin_amdgcn_sched_barrier(0);
  }
  __syncthreads();
  if constexpr (EPI == 1 || EPI == 3) {
    if (g.stats != nullptr && tid < 128) {
      const float4* sp = (const float4*)(g.stats + (size_t)(m0 + tid) * 32);
      float s1 = 0.f, s2 = 0.f;
#pragma unroll
      for (int i = 0; i < 8; ++i) {
        float4 v = sp[i];
        s1 += v.x + v.z;
        s2 += v.y + v.w;
      }
      float mu = s1 * (1.f / 1024.f);
      float var = s2 * (1.f / 1024.f) - mu * mu;
      sStat[tid] = make_float2(mu, rsqrtf(fmaxf(var, 0.f) + 1e-6f));
    }
  }

  f32x4 acc[4][4];
#pragma unroll
  for (int i = 0; i < 4; ++i)
#pragma unroll
    for (int j = 0; j < 4; ++j) acc[i][j] = f32x4{0.f, 0.f, 0.f, 0.f};

  const unsigned goff = (unsigned)(tid >> 3) * (unsigned)K + (unsigned)(tid & 7) * 8u;
  const unsigned loff = (unsigned)(tid >> 3) * 72u + (unsigned)(tid & 7) * 8u;
  const u16* abase = g.a16 + (size_t)m0 * K;
  const u16* bbase = g.bt + (size_t)n0 * K;
#define GLOAD(RA, RB, KT)                                                        \
  _Pragma("unroll") for (int i = 0; i < 4; ++i) {                                \
    RA[i] = *(const u32x4*)(abase + (size_t)(32 * i) * K + (KT) * 64 + goff);    \
    RB[i] = *(const u32x4*)(bbase + (size_t)(32 * i) * K + (KT) * 64 + goff);    \
  }
#define LSTORE(SA, SB, RA, RB)                                                   \
  _Pragma("unroll") for (int i = 0; i < 4; ++i) {                                \
    *(u32x4*)(SA + 32 * i * 72 + loff) = RA[i];                                  \
    *(u32x4*)(SB + 32 * i * 72 + loff) = RB[i];                                  \
  }
#define COMPUTE(SA, SB)                                                          \
  _Pragma("unroll") for (int s = 0; s < 2; ++s) {                                \
    bf16x8 af[4], bfr[4];                                                        \
    _Pragma("unroll") for (int i = 0; i < 4; ++i) {                              \
      af[i] = *(const bf16x8*)(SA + (wr * 64 + i * 16 + l16) * 72 + s * 32 + q4 * 8);  \
      bfr[i] = *(const bf16x8*)(SB + (wc * 64 + i * 16 + l16) * 72 + s * 32 + q4 * 8); \
    }                                                                            \
    _Pragma("unroll") for (int i = 0; i < 4; ++i)                                \
      _Pragma("unroll") for (int j = 0; j < 4; ++j) acc[i][j] = MFMA16(af[i], bfr[j], acc[i][j]); \
    __builtin_amdgcn_sched_barrier(0);                                           \
  }

  const int nk = K >> 6;
#define SB0 __builtin_amdgcn_sched_barrier(0)
  LSTORE(sA0, sB0, ra0, rb0);
  SB0;
  GLOAD(ra0, rb0, 2);
  SB0;
  __syncthreads();
#pragma unroll 1
  for (int kt = 0; kt < nk - 4; kt += 2) {
    SB0;
    LSTORE(sA1, sB1, ra1, rb1);
    SB0;
    GLOAD(ra1, rb1, kt + 3);
    SB0;
    COMPUTE(sA0, sB0);
    __syncthreads();
    SB0;
    LSTORE(sA0, sB0, ra0, rb0);
    SB0;
    GLOAD(ra0, rb0, kt + 4);
    SB0;
    COMPUTE(sA1, sB1);
    __syncthreads();
  }
  SB0;
  LSTORE(sA1, sB1, ra1, rb1);
  SB0;
  GLOAD(ra1, rb1, nk - 1);
  SB0;
  COMPUTE(sA0, sB0);
  __syncthreads();
  const u16* nabase = g.a16 + (size_t)nm0 * K;
  const u16* nbbase = g.bt + (size_t)nn0 * K;
  SB0;
  LSTORE(sA0, sB0, ra0, rb0);
  SB0;
  _Pragma("unroll") for (int i = 0; i < 4; ++i) {
    ra0[i] = *(const u32x4*)(nabase + (size_t)(32 * i) * K + goff);
    rb0[i] = *(const u32x4*)(nbbase + (size_t)(32 * i) * K + goff);
  }
  SB0;
  COMPUTE(sA1, sB1);
  __syncthreads();
  SB0;
  LSTORE(sA1, sB1, ra1, rb1);
  SB0;
  _Pragma("unroll") for (int i = 0; i < 4; ++i) {
    ra1[i] = *(const u32x4*)(nabase + (size_t)(32 * i) * K + 64 + goff);
    rb1[i] = *(const u32x4*)(nbbase + (size_t)(32 * i) * K + 64 + goff);
  }
  SB0;
  COMPUTE(sA0, sB0);
  __syncthreads();
  SB0;
  COMPUTE(sA1, sB1);
#undef GLOAD
#undef LSTORE
#undef COMPUTE
#undef SB0
  asm volatile("" ::: "memory");

  const int R0 = m0 + wr * 64, C0 = n0 + wc * 64;
  if constexpr (EPI == 0) {
    epi_inproj(p, li, acc, R0, C0);
  } else if constexpr (EPI == 1) {
    float gate[4], lg[4], lb[4];
#pragma unroll
    for (int j = 0; j < 4; ++j) {
      int col = C0 + j * 16 + l16;
      gate[j] = modv[g.sc_off + col];
      lg[j] = g.stats ? g.lng[col] : 1.f;
      lb[j] = g.stats ? g.lnb[col] : 0.f;
    }
    float xr[4][4][4];
#pragma unroll
    for (int i = 0; i < 4; ++i)
#pragma unroll
      for (int r = 0; r < 4; ++r)
#pragma unroll
        for (int j = 0; j < 4; ++j)
          xr[i][r][j] = fsrc[(size_t)(wr * 64 + i * 16 + q4 * 4 + r) * 1024 + C0 + j * 16 + l16];
#pragma unroll
    for (int i = 0; i < 4; ++i) {
#pragma unroll
      for (int r = 0; r < 4; ++r) {
        int lrow = wr * 64 + i * 16 + q4 * 4 + r;
        float mu = 0.f, rs = 1.f;
        if (g.stats != nullptr) {
          float2 st = sStat[lrow];
          mu = st.x;
          rs = st.y;
        }
        float s1 = 0.f, s2 = 0.f;
#pragma unroll
        for (int j = 0; j < 4; ++j) {
          int col = C0 + j * 16 + l16;
          float x = xr[i][r][j];
          x = (x - mu) * rs * lg[j] + lb[j];
          float v = ALPHA * x + gate[j] * acc[i][j][r];
          g.xout[(size_t)(m0 + lrow) * 1024 + col] = v;
          s1 += v;
          s2 += v * v;
        }
        s1 = red16(s1);
        s2 = red16(s2);
        if (l16 == 0) *(float2*)(g.sout + (size_t)(m0 + lrow) * 32 + (C0 >> 6) * 2) = make_float2(s1, s2);
      }
    }
  } else {
    float* sC = (float*)smem;
    __syncthreads();
#pragma unroll
    for (int i = 0; i < 4; ++i)
#pragma unroll
      for (int j = 0; j < 4; ++j)
#pragma unroll
        for (int r = 0; r < 4; ++r) sC[(wr * 64 + i * 16 + q4 * 4 + r) * 132 + wc * 64 + j * 16 + l16] = acc[i][j][r];
    __syncthreads();
    if constexpr (EPI == 3) {
      const int hl = lane & 31, rsel = lane >> 5;
      const int col = n0 + hl * 4;
      const f32x4 gate4 = *(const f32x4*)(modv + g.sc_off + col);
      f32x4 lg4 = {1.f, 1.f, 1.f, 1.f}, lb4 = {0.f, 0.f, 0.f, 0.f};
      if (g.stats != nullptr) {
        lg4 = *(const f32x4*)(g.lng + col);
        lb4 = *(const f32x4*)(g.lnb + col);
      }
#pragma unroll 4
      for (int pp = 0; pp < 16; ++pp) {
        const int lrow = pp * 8 + wid * 2 + rsel;
        f32x4 a = *(const f32x4*)(sC + lrow * 132 + hl * 4);
        f32x4 x = *(const f32x4*)(fsrc + (size_t)lrow * 1024 + col);
        float mu = 0.f, rs = 1.f;
        if (g.stats != nullptr) {
          float2 st = sStat[lrow];
          mu = st.x;
          rs = st.y;
        }
        x = (x - mu) * rs * lg4 + lb4;
        f32x4 v = ALPHA * x + gate4 * a;
        *(f32x4*)(g.xout + (size_t)(m0 + lrow) * 1024 + col) = v;
        float s1 = (v.x + v.y) + (v.z + v.w);
        float s2 = (v.x * v.x + v.y * v.y) + (v.z * v.z + v.w * v.w);
        s1 = red16(s1);
        s2 = red16(s2);
        if ((lane & 15) == 0) *(float2*)(g.sout + (size_t)(m0 + lrow) * 32 + ((n0 >> 6) + (hl >> 4)) * 2) = make_float2(s1, s2);
      }
    } else {
#pragma unroll
      for (int pp = 0; pp < 8; ++pp) {
        const int idx = tid + 256 * pp;
        const int lrow = idx >> 4, c8 = idx & 15;
        f32x4 a0 = *(const f32x4*)(sC + lrow * 132 + c8 * 8);
        f32x4 a1 = *(const f32x4*)(sC + lrow * 132 + c8 * 8 + 4);
        a0.x = fmaxf(a0.x, 0.f); a0.y = fmaxf(a0.y, 0.f); a0.z = fmaxf(a0.z, 0.f); a0.w = fmaxf(a0.w, 0.f);
        a1.x = fmaxf(a1.x, 0.f); a1.y = fmaxf(a1.y, 0.f); a1.z = fmaxf(a1.z, 0.f); a1.w = fmaxf(a1.w, 0.f);
        u32x4 o;
        o.x = pack2(a0.x * a0.x, a0.y * a0.y);
        o.y = pack2(a0.z * a0.z, a0.w * a0.w);
        o.z = pack2(a1.x * a1.x, a1.y * a1.y);
        o.w = pack2(a1.z * a1.z, a1.w * a1.w);
        *(u32x4*)(g.hid + (size_t)(m0 + lrow) * DFF + n0 + c8 * 8) = o;
      }
    }
  }
}

DI void epi_inproj(const P& p, int li, f32x4 (&acc)[4][4], int R0, int C0) {
  const int lane = ltid() & 63, l16 = lane & 15, q4 = lane >> 4;
  const int seg = C0 >> 6;
  const bool lat = R0 >= NCTX;
  const float2* rope = (const float2*)(p.ws + O_ROPE);
  int b, tb;
  if (!lat) { b = R0 >> 8; tb = R0 & 255; } else { b = (R0 - NCTX) >> 10; tb = (R0 - NCTX) & 1023; }

  enum { T_QA, T_KA, T_VA, T_QB, T_FF, T_FB, T_IB, T_GB, T_QC, T_KC, T_VC };
  int type, cbase;
  if (seg < 8) { type = T_QA; cbase = seg * 64; }
  else if (seg < 16) { type = T_KA; cbase = (seg - 8) * 64; }
  else if (seg < 24) { type = T_VA; cbase = (seg - 16) * 64; }
  else if (seg < 28) { type = T_QB; cbase = (seg - 24) * 64; }
  else if (seg < 32) { type = T_FF; cbase = (seg - 28) * 64; }
  else if (seg < 36) { type = T_FB; cbase = (seg - 32) * 64; }
  else if (seg < 40) { type = T_IB; cbase = (seg - 36) * 64; }
  else if (seg < 44) { type = T_GB; cbase = (seg - 40) * 64; }
  else if (seg < 48) { type = T_QC; cbase = (seg - 44) * 64; }
  else if (seg < 50) { type = T_KC; cbase = (seg - 48) * 64; }
  else { type = T_VC; cbase = (seg - 50) * 64; }

  if (type == T_QC || type == T_KC) {
    const float* gv = (type == T_QC ? p.in[22] : p.in[23]) + li * 64;
    float gj[4];
#pragma unroll
    for (int j = 0; j < 4; ++j) gj[j] = gv[j * 16 + l16];
#pragma unroll
    for (int i = 0; i < 4; ++i)
#pragma unroll
      for (int r = 0; r < 4; ++r) {
        float ss = 0.f;
#pragma unroll
        for (int j = 0; j < 4; ++j) ss += acc[i][j][r] * acc[i][j][r];
        ss = red16(ss);
        float rs = rsqrtf(ss * (1.f / 64.f) + 1e-6f);
#pragma unroll
        for (int j = 0; j < 4; ++j) acc[i][j][r] = acc[i][j][r] * rs * gj[j];
      }
  }
  if (!lat && (type == T_KA || type == T_VA || type == T_KC || type == T_VC)) {
    float* o;
    int W;
    if (type == T_KA) { o = p.out + OUT_AK; W = 512; }
    else if (type == T_VA) { o = p.out + OUT_AV; W = 512; }
    else if (type == T_KC) { o = p.out + OUT_CK; W = 128; }
    else { o = p.out + OUT_CV; W = 128; }
#pragma unroll
    for (int i = 0; i < 4; ++i)
#pragma unroll
      for (int r = 0; r < 4; ++r) {
        int t = tb + i * 16 + q4 * 4 + r;
        size_t base = ((size_t)(b * 2 + li) * 256 + t) * W + cbase;
#pragma unroll
        for (int j = 0; j < 4; ++j) o[base + j * 16 + l16] = acc[i][j][r];
      }
  }
  if (lat && (type == T_QA || type == T_KA || type == T_QC || type == T_KC)) {
#pragma unroll
    for (int i = 0; i < 4; ++i)
#pragma unroll
      for (int r = 0; r < 4; ++r) {
        int t = tb + i * 16 + q4 * 4 + r;
#pragma unroll
        for (int j = 0; j < 4; ++j) {
          float v = acc[i][j][r];
          float pv = xor1(v);
          float2 cs = rope[t * 32 + j * 8 + (l16 >> 1)];
          acc[i][j][r] = (l16 & 1) ? (pv * cs.y + v * cs.x) : (v * cs.x - pv * cs.y);
        }
      }
  }

  if (type == T_QA || type == T_KA || type == T_QC || type == T_KC) {
    u16* dst;
    int W;
    size_t rowbase;
    if (type == T_QA) { dst = (u16*)(p.ws + O_QA); W = 512; rowbase = (size_t)R0 * 512; }
    else if (type == T_QC) { dst = (u16*)(p.ws + O_QC); W = 256; rowbase = (size_t)R0 * 256; }
    else if (type == T_KA) {
      W = 512;
      if (!lat) { dst = (u16*)(p.ws + O_KACTX); rowbase = (size_t)R0 * 512; }
      else { dst = (u16*)(p.ws + O_KALAT); rowbase = ((size_t)(li * 2 + b) * 1536 + tb) * 512; }
    } else {
      W = 128;
      if (!lat) { dst = (u16*)(p.ws + O_KCCTX); rowbase = (size_t)R0 * 128; }
      else { dst = (u16*)(p.ws + O_KCLAT); rowbase = ((size_t)(li * 2 + b) * 1536 + tb) * 128; }
    }
#pragma unroll
    for (int i = 0; i < 4; ++i)
#pragma unroll
      for (int r = 0; r < 4; ++r) {
        size_t base = rowbase + (size_t)(i * 16 + q4 * 4 + r) * W + cbase;
#pragma unroll
        for (int j = 0; j < 4; ++j) dst[base + j * 16 + l16] = f2bf(acc[i][j][r]);
      }
  } else if (type == T_VA || type == T_VC) {
    u16* dst;
    int L;
    size_t hb;
    if (type == T_VA) {
      int h = cbase >> 7, dv0 = cbase & 127;
      if (!lat) { dst = (u16*)(p.ws + O_VTACTX); L = 256; hb = ((size_t)(b * 4 + h) * 128 + dv0) * 256; }
      else { dst = (u16*)(p.ws + O_VTALAT); L = 1536; hb = ((size_t)((li * 2 + b) * 4 + h) * 128 + dv0) * 1536; }
    } else {
      int n = cbase >> 6;
      if (!lat) { dst = (u16*)(p.ws + O_VTCCTX); L = 256; hb = ((size_t)(b * 2 + n) * 64) * 256; }
      else { dst = (u16*)(p.ws + O_VTCLAT); L = 1536; hb = ((size_t)((li * 2 + b) * 2 + n) * 64) * 1536; }
    }
#pragma unroll
    for (int i = 0; i < 4; ++i)
#pragma unroll
      for (int j = 0; j < 4; ++j) {
        uint2 o;
        o.x = pack2(acc[i][j][0], acc[i][j][1]);
        o.y = pack2(acc[i][j][2], acc[i][j][3]);
        *(uint2*)(dst + hb + (size_t)(j * 16 + l16) * L + tb + i * 16 + q4 * 4) = o;
      }
  } else {
    float* dst;
    if (type == T_QB) dst = (float*)(p.ws + O_HQ);
    else if (type == T_FF) dst = (float*)(p.ws + O_HGF);
    else if (type == T_FB) dst = (float*)(p.ws + O_HGB);
    else if (type == T_IB) dst = (float*)(p.ws + O_HI);
    else dst = (float*)(p.ws + O_HSG);
    float lbv[4] = {0.f, 0.f, 0.f, 0.f};
    if ((type == T_FF || type == T_FB) && li == 1) {
      const float* lg = (type == T_FF) ? p.in[19] : p.in[20];
#pragma unroll
      for (int j = 0; j < 4; ++j) {
        int c = cbase + j * 16 + l16;
        lbv[j] = 1.f / (1.f + expf(lg[c] - lg[256 + c]));
      }
    }
#pragma unroll
    for (int i = 0; i < 4; ++i)
#pragma unroll
      for (int r = 0; r < 4; ++r) {
        size_t base = (size_t)(R0 + i * 16 + q4 * 4 + r) * 256 + cbase;
#pragma unroll
        for (int j = 0; j < 4; ++j) {
          float v = acc[i][j][r];
          float o;
          if (type == T_QB || type == T_GB) o = v * __frcp_rn(1.f + __expf(-v));
          else if (type == T_IB) o = v;
          else {
            float sg = __frcp_rn(1.f + __expf(-v));
            float f = lbv[j] + (1.f - lbv[j]) * sg;
            o = __logf(fmaxf(f, 1e-6f));
          }
          dst[base + j * 16 + l16] = o;
        }
      }
  }
}

template <int EPI>
DI void gemm_phase(const P& p, const GA& g, int li, char* smem) {
  const int NT = g.N >> 7;
  const int xcd = blockIdx.x & 7, lb = blockIdx.x >> 3, nlb = gridDim.x >> 3;
  if (lb >= nlb) return;
  u32x4 ra0[4], rb0[4], ra1[4], rb1[4];
  bool primed = false;
  for (int t = lb; t < 6 * NT; t += nlb) {
    int mt = xcd * 6 + t % 6, nt = t / 6;
    const int tn = (t + nlb < 6 * NT) ? t + nlb : t;
    const int nmt = xcd * 6 + tn % 6, nnt = tn / 6;
    gemm_tile<EPI>(p, g, li, mt * 128, nt * 128, smem, ra0, rb0, ra1, rb1, primed, nmt * 128, nnt * 128);
    primed = true;
  }
}


template <int KW, int DV>
DI void attn_gload(const u16* Kb, int kstride, const u16* VT, int L, int kb, int tid, u32x4 (&kr)[KW / 32], u32x4 (&vr)[DV / 32]) {
  constexpr int KPR = 256 / (KW / 8);
  const unsigned koff = (unsigned)(tid / (KW / 8)) * (unsigned)kstride + (unsigned)(tid % (KW / 8)) * 8u;
  const unsigned voff = (unsigned)(tid >> 3) * (unsigned)L + (unsigned)(tid & 7) * 8u;
#pragma unroll
  for (int i = 0; i < KW / 32; ++i) {
    const u16* kbp = Kb + (size_t)(kb * 64 + KPR * i) * kstride;
    kr[i] = *(const u32x4*)(kbp + koff);
  }
#pragma unroll
  for (int i = 0; i < DV / 32; ++i) {
    const u16* vbp = VT + (size_t)(32 * i) * L + kb * 64;
    vr[i] = *(const u32x4*)(vbp + voff);
  }
}
template <int KW, int DV>
DI void attn_lstore(u16* sK, u16* sV, int tid, const u32x4 (&kr)[KW / 32], const u32x4 (&vr)[DV / 32]) {
  constexpr int KS = KW + 8;
#pragma unroll
  for (int i = 0; i < KW / 32; ++i) {
    int idx = tid + 256 * i;
    int key = idx / (KW / 8), cc = idx % (KW / 8);
    *(u32x4*)(sK + key * KS + cc * 8) = kr[i];
  }
#pragma unroll
  for (int i = 0; i < DV / 32; ++i) {
    int idx = tid + 256 * i;
    int row = idx >> 3, cc = idx & 7;
    *(u32x4*)(sV + row * 72 + cc * 8) = vr[i];
  }
}

template <int KW, int DV, int NQ>
DI void attn_compute(const u16* sK, const u16* sV, int kfo, int l16, int q4, const bf16x8 (&qf)[NQ][2],
                     f32x4 (&o)[NQ][DV / 16], float (&m)[NQ], float (&l)[NQ]) {
  constexpr int KS = KW + 8, NDT = DV / 16;
  const float c = 0.125f * LOG2E;
  f32x4 st[NQ][4];
#pragma unroll
  for (int kt = 0; kt < 4; ++kt) {
    const u16* kp = sK + (kt * 16 + l16) * KS + kfo + q4 * 8;
    bf16x8 k0 = *(const bf16x8*)kp;
    bf16x8 k1 = *(const bf16x8*)(kp + 32);
#pragma unroll
    for (int q = 0; q < NQ; ++q) {
      f32x4 z = {0.f, 0.f, 0.f, 0.f};
      z = MFMA16(k0, qf[q][0], z);
      st[q][kt] = MFMA16(k1, qf[q][1], z);
    }
  }
#pragma unroll
  for (int q = 0; q < NQ; ++q) {
    float bm = st[q][0][0];
#pragma unroll
    for (int kt = 0; kt < 4; ++kt)
#pragma unroll
      for (int r = 0; r < 4; ++r) bm = fmaxf(bm, st[q][kt][r]);
    bm = fmaxf(bm, shx(bm, 16));
    bm = fmaxf(bm, shx(bm, 32));
    const float mn = fmaxf(m[q], bm);
    const float alpha = ex2((m[q] - mn) * c);
    m[q] = mn;
    float ps = 0.f;
#pragma unroll
    for (int kt = 0; kt < 4; ++kt)
#pragma unroll
      for (int r = 0; r < 4; ++r) {
        float pv = ex2((st[q][kt][r] - mn) * c);
        st[q][kt][r] = pv;
        ps += pv;
      }
    l[q] = l[q] * alpha + ps;
#pragma unroll
    for (int d = 0; d < NDT; ++d) {
      o[q][d][0] *= alpha; o[q][d][1] *= alpha; o[q][d][2] *= alpha; o[q][d][3] *= alpha;
    }
  }
#pragma unroll
  for (int ks = 0; ks < 2; ++ks) {
    bf16x8 pf[NQ];
#pragma unroll
    for (int q = 0; q < NQ; ++q) {
      u32x4 pu;
      pu.x = pack2(st[q][2 * ks][0], st[q][2 * ks][1]);
      pu.y = pack2(st[q][2 * ks][2], st[q][2 * ks][3]);
      pu.z = pack2(st[q][2 * ks + 1][0], st[q][2 * ks + 1][1]);
      pu.w = pack2(st[q][2 * ks + 1][2], st[q][2 * ks + 1][3]);
      pf[q] = __builtin_bit_cast(bf16x8, pu);
    }
#pragma unroll
    for (int d = 0; d < NDT; ++d) {
      const u16* vp = sV + (d * 16 + l16) * 72 + ks * 32 + q4 * 4;
      u32x2 v0 = *(const u32x2*)vp;
      u32x2 v1 = *(const u32x2*)(vp + 16);
      u32x4 vu = {v0.x, v0.y, v1.x, v1.y};
      bf16x8 vf = __builtin_bit_cast(bf16x8, vu);
#pragma unroll
      for (int q = 0; q < NQ; ++q) o[q][d] = MFMA16(vf, pf[q], o[q][d]);
    }
  }
}

template <int KW, int DV, bool DIFF>
DI void attn_item(const u16* Q, int qstride, int qcol, int qrow0, const u16* Kb, int kstride, const u16* VT, int L,
                          int nkeys, u16* mixed, int mixcol, float lam, float postscale, const float* subg, char* smem) {
  constexpr int NQ = 2;
  const int tid = ltid(), lane = tid & 63, wid = tid >> 6, l16 = lane & 15, q4 = lane >> 4;
  const int qsub = wid & 1, var = wid >> 1;
  constexpr int KS = KW + 8;
  constexpr int STAGE = 64 * KS + DV * 72;
  u16* sK0 = (u16*)smem;
  u16* sV0 = sK0 + 64 * KS;
  u16* sK1 = sK0 + STAGE;
  u16* sV1 = sV0 + STAGE;
  constexpr int KPT = KW / 32, VPT = DV / 32, NDT = DV / 16;
  const int kfo = DIFF ? var * 64 : 0;

  bf16x8 qf[NQ][2];
#pragma unroll
  for (int q = 0; q < NQ; ++q) {
    const u16* qp = Q + (size_t)(qrow0 + qsub * 32 + q * 16 + l16) * qstride + qcol + var * 64 + q4 * 8;
    qf[q][0] = *(const bf16x8*)qp;
    qf[q][1] = *(const bf16x8*)(qp + 32);
  }

  u32x4 kr0[KPT], vr0[VPT];
  f32x4 o[NQ][NDT];
  float m[NQ], l[NQ];
#pragma unroll
  for (int q = 0; q < NQ; ++q) {
    m[q] = -INFINITY;
    l[q] = 0.f;
#pragma unroll
    for (int d = 0; d < NDT; ++d) o[q][d] = f32x4{0.f, 0.f, 0.f, 0.f};
  }
  const int nkb = nkeys >> 6;
#define SB0 __builtin_amdgcn_sched_barrier(0)
#define ACOMP(SK, SV) attn_compute<KW, DV, NQ>(SK, SV, kfo, l16, q4, qf, o, m, l)
  attn_gload<KW, DV>(Kb, kstride, VT, L, 0, tid, kr0, vr0);
  SB0;
  __syncthreads();
  attn_lstore<KW, DV>(sK0, sV0, tid, kr0, vr0);
  SB0;
  attn_gload<KW, DV>(Kb, kstride, VT, L, 1, tid, kr0, vr0);
  SB0;
  __syncthreads();
#pragma unroll 1
  for (int kb = 0; kb < nkb - 2; kb += 2) {
    SB0;
    attn_lstore<KW, DV>(sK1, sV1, tid, kr0, vr0);
    SB0;
    attn_gload<KW, DV>(Kb, kstride, VT, L, kb + 2, tid, kr0, vr0);
    SB0;
    ACOMP(sK0, sV0);
    __syncthreads();
    SB0;
    attn_lstore<KW, DV>(sK0, sV0, tid, kr0, vr0);
    SB0;
    attn_gload<KW, DV>(Kb, kstride, VT, L, kb + 3, tid, kr0, vr0);
    SB0;
    ACOMP(sK1, sV1);
    __syncthreads();
  }
  SB0;
  attn_lstore<KW, DV>(sK1, sV1, tid, kr0, vr0);
  SB0;
  ACOMP(sK0, sV0);
  __syncthreads();
  SB0;
  ACOMP(sK1, sV1);
  __syncthreads();
#undef SB0
#undef ACOMP
  float inv[NQ];
#pragma unroll
  for (int q = 0; q < NQ; ++q) {
    float lt = l[q];
    lt += shx(lt, 16);
    lt += shx(lt, 32);
    inv[q] = 1.f / lt;
  }
  if constexpr (DIFF) {
    float* sO = (float*)smem;
    if (var == 1) {
#pragma unroll
      for (int q = 0; q < NQ; ++q)
#pragma unroll
        for (int d = 0; d < NDT; ++d)
          *(f32x4*)(sO + (qsub * 32 + q * 16 + l16) * 132 + d * 16 + q4 * 4) = o[q][d] * inv[q];
    }
    __syncthreads();
    if (var == 0) {
      f32x4 ggv[NDT];
#pragma unroll
      for (int d = 0; d < NDT; ++d) ggv[d] = *(const f32x4*)(subg + d * 16 + q4 * 4);
#pragma unroll
      for (int q = 0; q < NQ; ++q) {
        const int row = qrow0 + qsub * 32 + q * 16 + l16;
        float ss = 0.f;
#pragma unroll
        for (int d = 0; d < NDT; ++d) {
          f32x4 o1 = *(const f32x4*)(sO + (qsub * 32 + q * 16 + l16) * 132 + d * 16 + q4 * 4);
          o[q][d] = o[q][d] * inv[q] - lam * o1;
          ss += o[q][d][0] * o[q][d][0] + o[q][d][1] * o[q][d][1] + o[q][d][2] * o[q][d][2] + o[q][d][3] * o[q][d][3];
        }
        ss += shx(ss, 16);
        ss += shx(ss, 32);
        const float rs = rsqrtf(ss * (1.f / 128.f) + 1e-6f) * postscale;
#pragma unroll
        for (int d = 0; d < NDT; ++d) {
          f32x4 v = o[q][d] * rs * ggv[d];
          u32x2 ov;
          ov.x = pack2(v.x, v.y);
          ov.y = pack2(v.z, v.w);
          *(u32x2*)(mixed + (size_t)row * 1024 + mixcol + d * 16 + q4 * 4) = ov;
        }
      }
    }
  } else {
#pragma unroll
    for (int q = 0; q < NQ; ++q) {
      const int row = qrow0 + qsub * 32 + q * 16 + l16;
#pragma unroll
      for (int d = 0; d < NDT; ++d) {
        f32x4 v = o[q][d] * inv[q];
        u32x2 ov;
        ov.x = pack2(v.x, v.y);
        ov.y = pack2(v.z, v.w);
        *(u32x2*)(mixed + (size_t)row * 1024 + mixcol + var * 64 + d * 16 + q4 * 4) = ov;
      }
    }
  }
}

DI void attnA_item(const P& p, int li, int it, char* smem) {
  const int lane = ltid() & 63;
  float d1 = p.in[14][li * 64 + lane] * p.in[15][li * 64 + lane];
  float d2 = p.in[16][li * 64 + lane] * p.in[17][li * 64 + lane];
#pragma unroll
  for (int s = 1; s < 64; s <<= 1) { d1 += shx(d1, s); d2 += shx(d2, s); }
  const float lam_init = 0.8f - 0.6f * expf(-0.3f * (float)li);
  const float lam = expf(d1) - expf(d2) + lam_init;
  const u16* QA = (const u16*)(p.ws + O_QA);
  u16* mixed = (u16*)(p.ws + O_MIXED);
  const float* subg = p.in[18] + li * 128;
  int qrow0, L;
  const u16 *Kb, *VT;
  int h;
  if (it < 128) {
    int b = it >> 6, qb = it & 15;
    h = (it >> 4) & 3;
    Kb = (const u16*)(p.ws + O_KALAT) + (size_t)(li * 2 + b) * 1536 * 512 + h * 128;
    VT = (const u16*)(p.ws + O_VTALAT) + (size_t)((li * 2 + b) * 4 + h) * 128 * 1536;
    qrow0 = NCTX + b * 1024 + qb * 64;
    L = 1536;
  } else {
    it -= 128;
    int b = it >> 4, qb = it & 3;
    h = (it >> 2) & 3;
    Kb = (const u16*)(p.ws + O_KACTX) + (size_t)b * 256 * 512 + h * 128;
    VT = (const u16*)(p.ws + O_VTACTX) + (size_t)(b * 4 + h) * 128 * 256;
    qrow0 = b * 256 + qb * 64;
    L = 256;
  }
  attn_item<128, 128, true>(QA, 512, h * 128, qrow0, Kb, 512, VT, L, L, mixed, h * 128, lam, 1.f - lam_init, subg, smem);
}
DI void attnC_item(const P& p, int li, int it, char* smem) {
  const u16* QC = (const u16*)(p.ws + O_QC);
  u16* mixed = (u16*)(p.ws + O_MIXED);
  int qrow0, L, n;
  const u16 *Kb, *VT;
  if (it < 64) {
    int b = it >> 5, qb = it & 15;
    n = (it >> 4) & 1;
    Kb = (const u16*)(p.ws + O_KCLAT) + (size_t)(li * 2 + b) * 1536 * 128 + n * 64;
    VT = (const u16*)(p.ws + O_VTCLAT) + (size_t)((li * 2 + b) * 2 + n) * 64 * 1536;
    qrow0 = NCTX + b * 1024 + qb * 64;
    L = 1536;
  } else {
    it -= 64;
    int b = it >> 3, qb = it & 3;
    n = (it >> 2) & 1;
    Kb = (const u16*)(p.ws + O_KCCTX) + (size_t)b * 256 * 128 + n * 64;
    VT = (const u16*)(p.ws + O_VTCCTX) + (size_t)(b * 2 + n) * 64 * 256;
    qrow0 = b * 256 + qb * 64;
    L = 256;
  }
  attn_item<64, 64, false>(QC, 256, n * 128, qrow0, Kb, 128, VT, L, L, mixed, 768 + n * 128, 0.f, 1.f, nullptr, smem);
}

DI void h1_item(const P& p, int item, char* smem) {
  const int tid = ltid(), lane = tid & 63, w = tid >> 6, l16 = lane & 15, q4 = lane >> 4;
  const int dir = item & 1, h = (item >> 1) & 3, tc = item >> 3;
  const int row0 = tc * 64;
  float* sQ = (float*)smem;
  float* sB = sQ + 64 * 68;
  float* sK = sB + 64 * 68;
  u16* sVT = (u16*)(sK + 64 * 68);
  float* sTot = (float*)(sVT + 64 * 72);
  const float* HQ = (const float*)(p.ws + O_HQ);
  const float* HG = (const float*)(p.ws + (dir ? O_HGB : O_HGF));
  const float* HI = (const float*)(p.ws + O_HI);
  float* OI = (float*)(p.ws + O_OI) + (size_t)dir * NTOK * 256;
  u16* QE = (u16*)(p.ws + O_QE) + (size_t)dir * NTOK * 256;
  float* KV = (float*)(p.ws + O_KV) + (size_t)item * 4096;
  float* DEC = (float*)(p.ws + O_DEC) + (size_t)item * 64;

  __syncthreads();
#pragma unroll
  for (int i = 0; i < 4; ++i) {
    int idx = tid + 256 * i;
    int lo = idx >> 4, c4 = idx & 15;
    int row = dir ? row0 + 63 - lo : row0 + lo;
    size_t off = (size_t)row * 256 + h * 64 + c4 * 4;
    *(float4*)(sQ + lo * 68 + c4 * 4) = *(const float4*)(HQ + off);
    *(float4*)(sB + lo * 68 + c4 * 4) = *(const float4*)(HG + off);
    float4 v = *(const float4*)(HI + off);
    sVT[(c4 * 4 + 0) * 72 + lo] = f2bf(v.x);
    sVT[(c4 * 4 + 1) * 72 + lo] = f2bf(v.y);
    sVT[(c4 * 4 + 2) * 72 + lo] = f2bf(v.z);
    sVT[(c4 * 4 + 3) * 72 + lo] = f2bf(v.w);
  }
  __syncthreads();
  {
    const int k = tid & 63, part = tid >> 6;
    float run = 0.f;
#pragma unroll 4
    for (int e = 0; e < 16; ++e) {
      int i = part * 16 + e;
      float g = sB[i * 68 + k];
      sK[i * 68 + k] = 1.f - ex2(g * LOG2E);
      run += g * LOG2E;
      sB[i * 68 + k] = run;
    }
    sTot[part * 64 + k] = run;
    __syncthreads();
    float add = 0.f;
    for (int pp = 0; pp < part; ++pp) add += sTot[pp * 64 + k];
    if (part > 0)
      for (int e = 0; e < 16; ++e) sB[(part * 16 + e) * 68 + k] += add;
  }
  __syncthreads();
#pragma unroll
  for (int i = 0; i < 4; ++i) {
    int idx = tid + 256 * i;
    int lo = idx >> 4, c4 = idx & 15;
    int row = dir ? row0 + 63 - lo : row0 + lo;
    f32x4 q = *(const f32x4*)(sQ + lo * 68 + c4 * 4);
    f32x4 bb = *(const f32x4*)(sB + lo * 68 + c4 * 4);
    u32x2 o;
    o.x = pack2(q.x * ex2(bb.x), q.y * ex2(bb.y));
    o.y = pack2(q.z * ex2(bb.z), q.w * ex2(bb.w));
    *(u32x2*)(QE + (size_t)row * 256 + h * 64 + c4 * 4) = o;
  }
  {
    const int I = w;
    bf16x8 qs[2];
    f32x4 rr[2][2];
#pragma unroll
    for (int s = 0; s < 2; ++s) {
      const int kk0 = s * 32 + q4 * 8;
      if (I > 0) {
        rr[s][0] = *(const f32x4*)(sB + (16 * I - 1) * 68 + kk0);
        rr[s][1] = *(const f32x4*)(sB + (16 * I - 1) * 68 + kk0 + 4);
      } else {
        rr[s][0] = f32x4{0.f, 0.f, 0.f, 0.f};
        rr[s][1] = rr[s][0];
      }
      const float* qr = sQ + (16 * I + l16) * 68 + kk0;
      const float* br = sB + (16 * I + l16) * 68 + kk0;
      f32x4 q0 = *(const f32x4*)qr, q1 = *(const f32x4*)(qr + 4);
      f32x4 b0 = *(const f32x4*)br, b1 = *(const f32x4*)(br + 4);
      u32x4 pu;
      pu.x = pack2(q0.x * ex2(b0.x - rr[s][0].x), q0.y * ex2(b0.y - rr[s][0].y));
      pu.y = pack2(q0.z * ex2(b0.z - rr[s][0].z), q0.w * ex2(b0.w - rr[s][0].w));
      pu.z = pack2(q1.x * ex2(b1.x - rr[s][1].x), q1.y * ex2(b1.y - rr[s][1].y));
      pu.w = pack2(q1.z * ex2(b1.z - rr[s][1].z), q1.w * ex2(b1.w - rr[s][1].w));
      qs[s] = __builtin_bit_cast(bf16x8, pu);
    }
    f32x4 at[4];
#pragma unroll
    for (int J = 0; J < 4; ++J) {
      at[J] = f32x4{0.f, 0.f, 0.f, 0.f};
      if (J <= I) {
#pragma unroll
        for (int s = 0; s < 2; ++s) {
          const int kk0 = s * 32 + q4 * 8;
          const float* kr = sK + (16 * J + l16) * 68 + kk0;
          const float* br = sB + (16 * J + l16) * 68 + kk0;
          f32x4 k0 = *(const f32x4*)kr, k1 = *(const f32x4*)(kr + 4);
          f32x4 b0 = *(const f32x4*)br, b1 = *(const f32x4*)(br + 4);
          u32x4 pu;
          pu.x = pack2(k0.x * ex2(fminf(rr[s][0].x - b0.x, 100.f)), k0.y * ex2(fminf(rr[s][0].y - b0.y, 100.f)));
          pu.y = pack2(k0.z * ex2(fminf(rr[s][0].z - b0.z, 100.f)), k0.w * ex2(fminf(rr[s][0].w - b0.w, 100.f)));
          pu.z = pack2(k1.x * ex2(fminf(rr[s][1].x - b1.x, 100.f)), k1.y * ex2(fminf(rr[s][1].y - b1.y, 100.f)));
          pu.w = pack2(k1.z * ex2(fminf(rr[s][1].z - b1.z, 100.f)), k1.w * ex2(fminf(rr[s][1].w - b1.w, 100.f)));
          bf16x8 kf = __builtin_bit_cast(bf16x8, pu);
          at[J] = MFMA16(kf, qs[s], at[J]);
        }
        if (J == I) {
#pragma unroll
          for (int r = 0; r < 4; ++r)
            if (q4 * 4 + r > l16) at[J][r] = 0.f;
        }
      }
    }
    f32x4 oc[4];
#pragma unroll
    for (int vt = 0; vt < 4; ++vt) oc[vt] = f32x4{0.f, 0.f, 0.f, 0.f};
#pragma unroll
    for (int ks = 0; ks < 2; ++ks) {
      if (2 * ks <= I) {
        u32x4 pu;
        pu.x = pack2(at[2 * ks][0], at[2 * ks][1]);
        pu.y = pack2(at[2 * ks][2], at[2 * ks][3]);
        pu.z = pack2(at[2 * ks + 1][0], at[2 * ks + 1][1]);
        pu.w = pack2(at[2 * ks + 1][2], at[2 * ks + 1][3]);
        bf16x8 pf = __builtin_bit_cast(bf16x8, pu);
#pragma unroll
        for (int vt = 0; vt < 4; ++vt) {
          const u16* vp = sVT + (vt * 16 + l16) * 72 + ks * 32 + q4 * 4;
          u32x2 v0 = *(const u32x2*)vp;
          u32x2 v1 = *(const u32x2*)(vp + 16);
          u32x4 vu = {v0.x, v0.y, v1.x, v1.y};
          oc[vt] = MFMA16(__builtin_bit_cast(bf16x8, vu), pf, oc[vt]);
        }
      }
    }
    {
      const int t = 16 * I + l16;
      const int row = dir ? row0 + 63 - t : row0 + t;
#pragma unroll
      for (int vt = 0; vt < 4; ++vt) *(f32x4*)(OI + (size_t)row * 256 + h * 64 + vt * 16 + q4 * 4) = oc[vt];
    }
  }
  {
    const int k = 16 * w + l16;
    const float bend = sB[63 * 68 + k];
    f32x4 kc[4];
#pragma unroll
    for (int vt = 0; vt < 4; ++vt) kc[vt] = f32x4{0.f, 0.f, 0.f, 0.f};
#pragma unroll
    for (int ks = 0; ks < 2; ++ks) {
      float kd[8];
#pragma unroll
      for (int j = 0; j < 8; ++j) {
        const int s = ks * 32 + q4 * 8 + j;
        kd[j] = sK[s * 68 + k] * ex2(bend - sB[s * 68 + k]);
      }
      u32x4 pu;
      pu.x = pack2(kd[0], kd[1]);
      pu.y = pack2(kd[2], kd[3]);
      pu.z = pack2(kd[4], kd[5]);
      pu.w = pack2(kd[6], kd[7]);
      bf16x8 af = __builtin_bit_cast(bf16x8, pu);
#pragma unroll
      for (int vt = 0; vt < 4; ++vt) {
        bf16x8 vf = *(const bf16x8*)(sVT + (vt * 16 + l16) * 72 + ks * 32 + q4 * 8);
        kc[vt] = MFMA16(af, vf, kc[vt]);
      }
    }
#pragma unroll
    for (int vt = 0; vt < 4; ++vt)
#pragma unroll
      for (int r = 0; r < 4; ++r) KV[(16 * w + q4 * 4 + r) * 64 + vt * 16 + l16] = kc[vt][r];
    if (q4 == 0) DEC[k] = ex2(bend);
  }
}

DI void h2_item(const P& p, int li, int item, char* smem) {
  const int tid = ltid(), ty = tid >> 4, tx = tid & 15;
  const int lane = tid & 63, w = tid >> 6, l16 = lane & 15, q4 = lane >> 4;
  const int h = item & 3, tc = item >> 2, row0 = tc * 64;
  const bool lat = tc >= 64;
  int seq, cl, nc;
  if (!lat) { seq = tc >> 2; cl = tc & 3; nc = 4; } else { seq = (tc - 64) >> 4; cl = (tc - 64) & 15; nc = 16; }
  const int tcbase = tc - cl;
  u16* sST = (u16*)smem;
  const float* KVb = (const float*)(p.ws + O_KV);
  const float* DECb = (const float*)(p.ws + O_DEC);
  __syncthreads();
#pragma unroll 1
  for (int dir = 0; dir < 2; ++dir) {
    float4 S[4];
#pragma unroll
    for (int a = 0; a < 4; ++a) {
      if (lat) S[a] = *(const float4*)(p.in[6 + dir] + ((size_t)((seq * 2 + li) * 4 + h) * 64 + ty + 16 * a) * 64 + tx * 4);
      else S[a] = make_float4(0.f, 0.f, 0.f, 0.f);
    }
    const int nprev = dir == 0 ? cl : nc - 1 - cl;
#pragma unroll 1
    for (int j = 0; j < nprev; ++j) {
      int tcj = tcbase + (dir == 0 ? j : nc - 1 - j);
      size_t itj = (size_t)((tcj * 4 + h) * 2 + dir);
#pragma unroll
      for (int a = 0; a < 4; ++a) {
        int k = ty + 16 * a;
        float dcy = DECb[itj * 64 + k];
        float4 kv = *(const float4*)(KVb + itj * 4096 + k * 64 + tx * 4);
        S[a].x = dcy * S[a].x + kv.x; S[a].y = dcy * S[a].y + kv.y; S[a].z = dcy * S[a].z + kv.z; S[a].w = dcy * S[a].w + kv.w;
      }
    }
    if (!lat && nprev == nc - 1) {
      size_t itj = (size_t)((tc * 4 + h) * 2 + dir);
      float* so = p.out + (dir == 0 ? OUT_SF : OUT_SB) + (size_t)((seq * 2 + li) * 4 + h) * 4096;
#pragma unroll
      for (int a = 0; a < 4; ++a) {
        int k = ty + 16 * a;
        float dcy = DECb[itj * 64 + k];
        float4 kv = *(const float4*)(KVb + itj * 4096 + k * 64 + tx * 4);
        *(float4*)(so + k * 64 + tx * 4) = make_float4(dcy * S[a].x + kv.x, dcy * S[a].y + kv.y, dcy * S[a].z + kv.z, dcy * S[a].w + kv.w);
      }
    }
    u16* st = sST + dir * 64 * 72;
#pragma unroll
    for (int a = 0; a < 4; ++a) {
      int k = ty + 16 * a;
      st[(tx * 4 + 0) * 72 + k] = f2bf(S[a].x);
      st[(tx * 4 + 1) * 72 + k] = f2bf(S[a].y);
      st[(tx * 4 + 2) * 72 + k] = f2bf(S[a].z);
      st[(tx * 4 + 3) * 72 + k] = f2bf(S[a].w);
    }
  }
  __syncthreads();
  f32x4 oc[4];
#pragma unroll
  for (int vt = 0; vt < 4; ++vt) oc[vt] = f32x4{0.f, 0.f, 0.f, 0.f};
#pragma unroll
  for (int dir = 0; dir < 2; ++dir) {
    const u16* QE = (const u16*)(p.ws + O_QE) + (size_t)dir * NTOK * 256 + (size_t)(row0 + 16 * w + l16) * 256 + h * 64 + q4 * 8;
    const u16* st = sST + dir * 64 * 72;
#pragma unroll
    for (int ks = 0; ks < 2; ++ks) {
      bf16x8 af = *(const bf16x8*)(QE + ks * 32);
#pragma unroll
      for (int vt = 0; vt < 4; ++vt) {
        bf16x8 bf = *(const bf16x8*)(st + (vt * 16 + l16) * 72 + ks * 32 + q4 * 8);
        oc[vt] = MFMA16(af, bf, oc[vt]);
      }
    }
  }
  const float* OI0 = (const float*)(p.ws + O_OI);
  const float* OI1 = OI0 + (size_t)NTOK * 256;
  const float* HSG = (const float*)(p.ws + O_HSG);
  u16* mixed = (u16*)(p.ws + O_MIXED);
  float gn[4];
#pragma unroll
  for (int vt = 0; vt < 4; ++vt) gn[vt] = p.in[21][li * 64 + vt * 16 + l16];
  float oi[4][4], sgv[4][4];
#pragma unroll
  for (int r = 0; r < 4; ++r) {
    const size_t off = (size_t)(row0 + 16 * w + q4 * 4 + r) * 256 + h * 64 + l16;
#pragma unroll
    for (int vt = 0; vt < 4; ++vt) {
      oi[r][vt] = OI0[off + vt * 16] + OI1[off + vt * 16];
      sgv[r][vt] = HSG[off + vt * 16];
    }
  }
#pragma unroll
  for (int r = 0; r < 4; ++r) {
    const int row = row0 + 16 * w + q4 * 4 + r;
    float val[4];
    float ss = 0.f;
#pragma unroll
    for (int vt = 0; vt < 4; ++vt) {
      val[vt] = oc[vt][r] + oi[r][vt];
      ss += val[vt] * val[vt];
    }
    ss = red16(ss);
    const float rs = rsqrtf(ss * (1.f / 64.f) + 1e-6f);
#pragma unroll
    for (int vt = 0; vt < 4; ++vt)
      mixed[(size_t)row * 1024 + 512 + h * 64 + vt * 16 + l16] = f2bf(val[vt] * rs * gn[vt] * sgv[r][vt]);
  }
}

DI void ln_apply(const P& p, const float* lo, const float* hi, const float* stats, const float* lng, const float* lnb,
                 const float* mods, int sc_off, int sh_off) {
  const int lane = ltid() & 63, wid = ltid() >> 6;
  u16* dst = (u16*)(p.ws + O_ABF);
  for (int it = blockIdx.x; it < NTOK / 4; it += gridDim.x) {
    const int row = it * 4 + wid;
    float mu = 0.f, rs = 1.f;
    if (stats != nullptr) {
      float s1 = 0.f, s2 = 0.f;
      if (lane < 16) {
        float2 v = *(const float2*)(stats + (size_t)row * 32 + lane * 2);
        s1 = v.x;
        s2 = v.y;
      }
#pragma unroll
      for (int s = 1; s < 16; s <<= 1) { s1 += shx(s1, s); s2 += shx(s2, s); }
      s1 = __shfl(s1, 0, 64);
      s2 = __shfl(s2, 0, 64);
      mu = s1 * (1.f / 1024.f);
      rs = rsqrtf(fmaxf(s2 * (1.f / 1024.f) - mu * mu, 0.f) + 1e-6f);
    }
    const float* x = row < NCTX ? lo + (size_t)row * 1024 : hi + (size_t)(row - NCTX) * 1024;
    const int rtype = row < NCTX ? 0 : 1 + ((row - NCTX) >> 10);
    const float* mv = mods + rtype * 6144;
    f32x4 xv[4], scv[4], shv[4], ggv[4], bbv[4];
#pragma unroll
    for (int i = 0; i < 4; ++i) {
      const int c = (lane + 64 * i) * 4;
      xv[i] = *(const f32x4*)(x + c);
      scv[i] = *(const f32x4*)(mv + sc_off + c);
      shv[i] = *(const f32x4*)(mv + sh_off + c);
      if (stats != nullptr) {
        ggv[i] = *(const f32x4*)(lng + c);
        bbv[i] = *(const f32x4*)(lnb + c);
      }
    }
#pragma unroll
    for (int i = 0; i < 4; ++i) {
      const int c = (lane + 64 * i) * 4;
      f32x4 v = xv[i];
      f32x4 sc = scv[i] + 1.f;
      f32x4 sh = shv[i];
      if (stats != nullptr) v = (v - mu) * rs * ggv[i] + bbv[i];
      v = v * sc + sh;
      u32x2 o;
      o.x = pack2(v.x, v.y);
      o.y = pack2(v.z, v.w);
      *(u32x2*)(dst + (size_t)row * 1024 + c) = o;
    }
  }
}

DI void final_ln(const P& p) {
  const int lane = ltid() & 63, wid = ltid() >> 6;
  const float* X = (const float*)(p.ws + O_XPRE2);
  const float* ST = (const float*)(p.ws + O_ST2);
  const float* g = p.in[26] + 1024;
  const float* bb = p.in[27] + 1024;
  for (int it = blockIdx.x; it < NTOK / 4; it += gridDim.x) {
    int row = it * 4 + wid;
    float s1 = 0.f, s2 = 0.f;
    if (lane < 16) {
      float2 v = *(const float2*)(ST + (size_t)row * 32 + lane * 2);
      s1 = v.x;
      s2 = v.y;
    }
#pragma unroll
    for (int s = 1; s < 16; s <<= 1) { s1 += shx(s1, s); s2 += shx(s2, s); }
    s1 = __shfl(s1, 0, 64);
    s2 = __shfl(s2, 0, 64);
    float mu = s1 * (1.f / 1024.f);
    float rs = rsqrtf(fmaxf(s2 * (1.f / 1024.f) - mu * mu, 0.f) + 1e-6f);
    float* out = p.out + (row < NCTX ? OUT_YP + (size_t)row * 1024 : OUT_YS + (size_t)(row - NCTX) * 1024);
    float4 xv[4], gv[4], bv[4];
#pragma unroll
    for (int i = 0; i < 4; ++i) {
      int c = (lane + 64 * i) * 4;
      xv[i] = *(const float4*)(X + (size_t)row * 1024 + c);
      gv[i] = *(const float4*)(g + c);
      bv[i] = *(const float4*)(bb + c);
    }
#pragma unroll
    for (int i = 0; i < 4; ++i) {
      int c = (lane + 64 * i) * 4;
      float4 x = xv[i];
      float4 gg = gv[i];
      float4 b4 = bv[i];
      *(float4*)(out + c) = make_float4((x.x - mu) * rs * gg.x + b4.x, (x.y - mu) * rs * gg.y + b4.y,
                                         (x.z - mu) * rs * gg.z + b4.z, (x.w - mu) * rs * gg.w + b4.w);
    }
  }
}

DI void run_phase(const P& p, int ph, char* smem, int sub = 0) {
  if (ph == 0) { phase0(p, smem); return; }
  if (ph == NPHASE - 1) { final_ln(p); return; }
  const int li = (ph - 1) >> 3, s = (ph - 1) & 7;
  float* XPRE1 = (float*)(p.ws + O_XPRE1);
  float* XPRE2 = (float*)(p.ws + O_XPRE2);
  float* ST1 = (float*)(p.ws + O_ST1);
  float* ST2 = (float*)(p.ws + O_ST2);
  GA g;
  g.mods = (const float*)(p.ws + O_MODS) + li * 3 * 6144;
  g.a16 = (const u16*)(p.ws + O_ABF); g.xout = nullptr; g.sout = nullptr; g.hid = nullptr;
  g.alo = nullptr; g.ahi = nullptr; g.stats = nullptr; g.lng = nullptr; g.lnb = nullptr; g.sc_off = 0; g.sh_off = 0;
  const float* xin_lo = li == 0 ? p.in[0] : XPRE2;
  const float* xin_hi = li == 0 ? p.in[1] : XPRE2 + (size_t)NCTX * 1024;
  const float* xin_st = li == 0 ? nullptr : ST2;
  const float* xin_g = p.in[26] + (li == 0 ? 0 : (li - 1) * 1024);
  const float* xin_b = p.in[27] + (li == 0 ? 0 : (li - 1) * 1024);
  if (s == 0) {
    ln_apply(p, xin_lo, xin_hi, xin_st, xin_g, xin_b, g.mods, 1024, 0);
  } else if (s == 1) {
    g.bt = (const u16*)(p.ws + O_WTIN) + (size_t)li * NIN * D; g.K = D; g.N = NIN;
    gemm_phase<0>(p, g, li, smem);
  } else if (s == 2) {
    if (gridDim.x == 512 && sub == 0) {
      const int b = blockIdx.x;
      if (b < 128) {
        attnA_item(p, li, b, smem);
      } else if (b < 192) {
        attnC_item(p, li, b - 128, smem);
        h1_item(p, b - 128, smem);
      } else {
        const int j = b - 192;
        h1_item(p, 64 + j, smem);
        h1_item(p, 64 + 320 + j, smem);
        if (j < 64) h1_item(p, 64 + 640 + j, smem);
        else attnA_item(p, li, 128 + (j - 64), smem);
      }
    } else {
      const int it_lo = sub == 2 ? 128 : (sub == 3 ? 192 : (sub == 4 ? 960 : 0)), it_hi = sub == 1 ? 128 : (sub == 2 ? 192 : (sub == 3 ? 960 : 1216));
      for (int it = it_lo + blockIdx.x; it < it_hi; it += gridDim.x) {
        if (it >= 192 && it < 960) h1_item(p, it - 192, smem);
        else if (it >= 128 && it < 192) attnC_item(p, li, it - 128, smem);
        else attnA_item(p, li, it < 128 ? it : it - 832, smem);
      }
    }
  } else if (s == 3) {
    for (int it = blockIdx.x; it < 512; it += gridDim.x) {
      if (it < 384) h2_item(p, li, it, smem);
      else attnC_item(p, li, it - 384 + 64, smem);
    }
  } else if (s == 4) {
    g.alo = xin_lo; g.ahi = xin_hi; g.stats = xin_st; g.lng = xin_g; g.lnb = xin_b;
    g.sc_off = 2048;
    g.a16 = (const u16*)(p.ws + O_MIXED);
    g.bt = (const u16*)(p.ws + O_WTOUT) + (size_t)li * D * D; g.K = D; g.N = D;
    g.xout = XPRE1; g.sout = ST1;
    gemm_phase<1>(p, g, li, smem);
  } else if (s == 5) {
    ln_apply(p, XPRE1, XPRE1 + (size_t)NCTX * 1024, ST1, p.in[24] + li * 1024, p.in[25] + li * 1024, g.mods, 4096, 3072);
  } else if (s == 6) {
    g.bt = (const u16*)(p.ws + O_WTFF1) + (size_t)li * DFF * D; g.K = D; g.N = DFF;
    g.hid = (u16*)(p.ws + O_HID);
    gemm_phase<2>(p, g, li, smem);
  } else {
    g.alo = XPRE1; g.ahi = XPRE1 + (size_t)NCTX * 1024; g.stats = ST1; g.lng = p.in[24] + li * 1024; g.lnb = p.in[25] + li * 1024;
    g.sc_off = 5120;
    g.a16 = (const u16*)(p.ws + O_HID);
    g.bt = (const u16*)(p.ws + O_WTFF2) + (size_t)li * D * DFF; g.K = DFF; g.N = D;
    g.xout = XPRE2; g.sout = ST2;
    gemm_phase<1>(p, g, li, smem);
  }
}

#define XB_TMO      128
#define XB_XCNT(j)  (256  + 64 * (j))
#define XB_XSUB(j)  (1280 + 64 * (j))
#define XB_XGEN(j)  (2304 + 64 * (j))
#define XB_TOP      3328
#define XB_TOPGEN   3392
#define XCD_BAR_WORDS 3456
#define XB_SPIN_CAP (1u << 20)
#define LAS __attribute__((address_space(3)))
DI unsigned xb_ld(unsigned* p) { return __hip_atomic_load(p, __ATOMIC_RELAXED, __HIP_MEMORY_SCOPE_AGENT); }
DI unsigned xb_add(unsigned* p, unsigned v) { return __hip_atomic_fetch_add(p, v, __ATOMIC_RELAXED, __HIP_MEMORY_SCOPE_AGENT); }
DI unsigned xb_xcc_id() { return (unsigned)__builtin_amdgcn_s_getreg((3 << 11) | 20) & 0xFu; }
#define XB_SPIN(cond, bar) do { unsigned _sp = 0; while (cond) { __builtin_amdgcn_s_sleep(1); \
    if ((++_sp & 255u) == 0u) { if (xb_ld(&(bar)[XB_TMO])) break; if (_sp > XB_SPIN_CAP) { atomicAdd(&(bar)[XB_TMO], 1u); break; } } } } while (0)
struct XcdBarrier { unsigned* bar; unsigned x; volatile LAS unsigned* st; };
DI XcdBarrier xcd_barrier_post(unsigned* bar, volatile LAS unsigned* st) {
  XcdBarrier b; b.bar = bar; b.x = xb_xcc_id(); b.st = st;
  if (threadIdx.x == 0) (void)xb_add(&bar[XB_XCNT(b.x)], 1u);
  return b;
}
DI void xcd_barrier_complete(unsigned* bar, unsigned x, unsigned& nloc, unsigned& nx) {
  const unsigned G = gridDim.x * gridDim.y * gridDim.z;
  unsigned sum, cnt, mine, sp = 0u;
  for (;;) {
    sum = 0u; cnt = 0u; mine = 0u;
#pragma unroll
    for (unsigned j = 0; j < 16; ++j) { const unsigned c = xb_ld(&bar[XB_XCNT(j)]); sum += c; cnt += (c > 0u) ? 1u : 0u; mine = (j == x) ? c : mine; }
    if (sum == G) break;
    __builtin_amdgcn_s_sleep(1);
    if ((++sp & 255u) == 0u) { if (xb_ld(&bar[XB_TMO])) break; if (sp > XB_SPIN_CAP) { atomicAdd(&bar[XB_TMO], 1u); break; } }
  }
  nloc = mine > 0u ? mine : 1u; nx = cnt > 0u ? cnt : 1u;
}
DI void xcd_barrier(const XcdBarrier& b) {
  asm volatile("s_waitcnt vmcnt(0)" ::: "memory");
  __syncthreads();
  if (threadIdx.x == 0) {
    unsigned* bar = b.bar;
    __builtin_amdgcn_s_waitcnt(0);
    unsigned nloc = b.st[0], nx = b.st[1];
    if (nloc == 0u) { xcd_barrier_complete(bar, b.x, nloc, nx); b.st[0] = nloc; b.st[1] = nx; }
    const unsigned old = xb_add(&bar[XB_XSUB(b.x)], 1u);
    const unsigned gen = old / nloc;
    if (old + 1u == (gen + 1u) * nloc) {
      __builtin_amdgcn_fence(__ATOMIC_RELEASE, "agent");
      asm volatile("s_waitcnt vmcnt(0)" ::: "memory");
      const unsigned og = xb_add(&bar[XB_TOP], 1u);
      const unsigned tg = og / nx;
      if (og + 1u == (tg + 1u) * nx) xb_add(&bar[XB_TOPGEN], 1u);
      else XB_SPIN(xb_ld(&bar[XB_TOPGEN]) == tg, bar);
      __builtin_amdgcn_fence(__ATOMIC_ACQUIRE, "agent");
      xb_add(&bar[XB_XGEN(b.x)], 1u);
      asm volatile("s_waitcnt vmcnt(0)" ::: "memory");
    } else {
      XB_SPIN(xb_ld(&bar[XB_XGEN(b.x)]) == gen, bar);
      __builtin_amdgcn_fence(__ATOMIC_ACQUIRE, "agent");
      asm volatile("s_waitcnt vmcnt(0)" ::: "memory");
    }
  }
  __syncthreads();
}
constexpr size_t O_BAR = O_END1;
static_assert(O_BAR + XCD_BAR_WORDS * 4 <= (size_t)256 * 1024 * 1024, "barrier words must fit");

#if !MULTI_LAUNCH
__global__ void __launch_bounds__(256, 2) mega_kernel(P p) {
  extern __shared__ __attribute__((aligned(16))) char smem[];
  cg::grid_group grid = cg::this_grid();
  if (p.ws == nullptr) grid.sync();
  if (threadIdx.x == 0) *(uint4*)(smem + LDS_BYTES - 16) = make_uint4(0u, 0u, 0u, 0u);
  __syncthreads();
  XcdBarrier xb = xcd_barrier_post((unsigned*)(p.ws + O_BAR), (volatile LAS unsigned*)(smem + LDS_BYTES - 16));
  run_phase(p, 0, smem); xcd_barrier(xb);
  run_phase(p, 1, smem); xcd_barrier(xb);
  run_phase(p, 2, smem); xcd_barrier(xb);
  run_phase(p, 3, smem); xcd_barrier(xb);
  run_phase(p, 4, smem); xcd_barrier(xb);
  run_phase(p, 5, smem); xcd_barrier(xb);
  run_phase(p, 6, smem); xcd_barrier(xb);
  run_phase(p, 7, smem); xcd_barrier(xb);
  run_phase(p, 8, smem); xcd_barrier(xb);
  run_phase(p, 9, smem); xcd_barrier(xb);
  run_phase(p, 10, smem); xcd_barrier(xb);
  run_phase(p, 11, smem); xcd_barrier(xb);
  run_phase(p, 12, smem); xcd_barrier(xb);
  run_phase(p, 13, smem); xcd_barrier(xb);
  run_phase(p, 14, smem); xcd_barrier(xb);
  run_phase(p, 15, smem); xcd_barrier(xb);
  run_phase(p, 16, smem); xcd_barrier(xb);
  run_phase(p, 17, smem);
}
#define MAIN_KERNEL mega_kernel
#else
template <int PH>
__global__ void __launch_bounds__(256, 2) phase_kernel(P p, int sub) {
  extern __shared__ __attribute__((aligned(16))) char smem[];
  run_phase(p, PH, smem, sub);
}
typedef void (*phase_fn)(P, int);
static phase_fn phase_table[NPHASE] = {phase_kernel<0>, phase_kernel<1>, phase_kernel<2>, phase_kernel<3>, phase_kernel<4>, phase_kernel<5>,
                                       phase_kernel<6>, phase_kernel<7>, phase_kernel<8>, phase_kernel<9>, phase_kernel<10>, phase_kernel<11>,
                                       phase_kernel<12>, phase_kernel<13>, phase_kernel<14>, phase_kernel<15>, phase_kernel<16>, phase_kernel<17>};
#define MAIN_KERNEL phase_kernel<2>
#endif

extern "C" void kernel_launch(void* const* d_in, const int* in_sizes, int n_in, void* d_out, int out_size, void* d_ws,
                              size_t ws_size, hipStream_t stream) {
  static int grid_blocks = 0;
  if (!grid_blocks) {
    int dev = 0, cus = 0, per_cu = 0;
    (void)hipGetDevice(&dev);
    (void)hipDeviceGetAttribute(&cus, hipDeviceAttributeMultiprocessorCount, dev);
    (void)hipFuncSetAttribute((const void*)MAIN_KERNEL, hipFuncAttributeMaxDynamicSharedMemorySize, LDS_BYTES);
    (void)hipOccupancyMaxActiveBlocksPerMultiprocessor(&per_cu, MAIN_KERNEL, 256, LDS_BYTES);
    if (per_cu > 2) per_cu = 2;
    if (per_cu < 1) per_cu = 1;
    grid_blocks = cus * per_cu;
  }
  P p{};
  for (int i = 0; i < 30; ++i) p.in[i] = (const float*)d_in[i];
  p.out = (float*)d_out;
  p.ws = (char*)d_ws;
#if MULTI_LAUNCH
  for (int ph = 0; ph < NPHASE; ++ph) {
    (void)hipFuncSetAttribute((const void*)phase_table[ph], hipFuncAttributeMaxDynamicSharedMemorySize, LDS_BYTES);
    phase_table[ph]<<<dim3(grid_blocks), dim3(256), LDS_BYTES, stream>>>(p, 0);
#ifdef DUP_MASK
    int bit = (ph == 0) ? 8 : (ph == NPHASE - 1 ? 9 : (ph - 1) & 7);
    if ((DUP_MASK >> bit) & 1) phase_table[ph]<<<dim3(grid_blocks), dim3(256), LDS_BYTES, stream>>>(p, DUP_SUB);
#endif
  }
#else
  (void)hipMemsetAsync((char*)d_ws + O_BAR, 0, XCD_BAR_WORDS * 4, stream);
  void* args[] = {&p};
  hipError_t e = hipLaunchCooperativeKernel((void*)mega_kernel, dim3(grid_blocks), dim3(256), args, LDS_BYTES, stream);
  if (e != hipSuccess) fprintf(stderr, "cooperative launch failed: %s (grid %d)\n", hipGetErrorString(e), grid_blocks);
#endif
}
```

```cpp
#include <hip/hip_runtime.h>
#include <hip/hip_cooperative_groups.h>
#include <stdint.h>
#include <stdio.h>
namespace cg = cooperative_groups;

#ifndef MULTI_LAUNCH
#define MULTI_LAUNCH 0
#endif

#define DI __device__ __forceinline__
typedef unsigned short u16;
using bf16x8 = __attribute__((ext_vector_type(8))) short;
using f32x4 = __attribute__((ext_vector_type(4))) float;
typedef __bf16 bf2_t __attribute__((ext_vector_type(2)));
typedef float f2_t __attribute__((ext_vector_type(2)));
typedef unsigned u32x4 __attribute__((ext_vector_type(4)));
typedef unsigned u32x2 __attribute__((ext_vector_type(2)));

constexpr int D = 1024, NTOK = 6144, NCTX = 4096, NIN = 3328, DFF = 4096;
constexpr float ALPHA = 1.41421356237309515f;
constexpr float LOG2E = 1.44269504088896341f;
constexpr int LDS_BYTES = 75776;
constexpr int NPHASE = 18;

constexpr size_t O_WTIN = 0;
constexpr size_t O_WTOUT = O_WTIN + (size_t)2 * NIN * D * 2;
constexpr size_t O_WTFF1 = O_WTOUT + (size_t)2 * D * D * 2;
constexpr size_t O_WTFF2 = O_WTFF1 + (size_t)2 * DFF * D * 2;
constexpr size_t O_MODS = O_WTFF2 + (size_t)2 * D * DFF * 2;
constexpr size_t O_ROPE = O_MODS + (size_t)2 * 3 * 6144 * 4;
constexpr size_t O_QA = O_ROPE + (size_t)1024 * 32 * 2 * 4;
constexpr size_t O_KACTX = O_QA + (size_t)NTOK * 512 * 2;
constexpr size_t O_KALAT = O_KACTX + (size_t)NCTX * 512 * 2;
constexpr size_t O_VTACTX = O_KALAT + (size_t)2 * 2 * 1536 * 512 * 2;
constexpr size_t O_VTALAT = O_VTACTX + (size_t)16 * 4 * 128 * 256 * 2;
constexpr size_t O_QC = O_VTALAT + (size_t)2 * 2 * 4 * 128 * 1536 * 2;
constexpr size_t O_KCCTX = O_QC + (size_t)NTOK * 256 * 2;
constexpr size_t O_KCLAT = O_KCCTX + (size_t)NCTX * 128 * 2;
constexpr size_t O_VTCCTX = O_KCLAT + (size_t)2 * 2 * 1536 * 128 * 2;
constexpr size_t O_VTCLAT = O_VTCCTX + (size_t)16 * 2 * 64 * 256 * 2;
constexpr size_t O_KV = O_VTCLAT + (size_t)2 * 2 * 2 * 64 * 1536 * 2;
constexpr size_t O_DEC = O_KV + (size_t)768 * 4096 * 4;
constexpr size_t O_MIXED = O_DEC + (size_t)768 * 64 * 4;
constexpr size_t O_XPRE1 = O_MIXED + (size_t)NTOK * 1024 * 2;
constexpr size_t O_ST1 = O_XPRE1 + (size_t)NTOK * 1024 * 4;
constexpr size_t O_XPRE2 = O_ST1 + (size_t)NTOK * 32 * 4;
constexpr size_t O_ST2 = O_XPRE2 + (size_t)NTOK * 1024 * 4;
constexpr size_t O_ABF = O_ST2 + (size_t)NTOK * 32 * 4;
constexpr size_t O_HQ = O_ABF + (size_t)NTOK * 1024 * 2;
constexpr size_t O_HGF = O_HQ + (size_t)NTOK * 256 * 4;
constexpr size_t O_HGB = O_HGF + (size_t)NTOK * 256 * 4;
constexpr size_t O_HI = O_HGB + (size_t)NTOK * 256 * 4;
constexpr size_t O_HSG = O_HI + (size_t)NTOK * 256 * 4;
constexpr size_t O_OI = O_HSG + (size_t)NTOK * 256 * 4;
constexpr size_t O_QE = O_OI + (size_t)2 * NTOK * 256 * 4;
constexpr size_t O_END1 = O_QE + (size_t)2 * NTOK * 256 * 4;
constexpr size_t O_HID = O_HQ;
constexpr size_t O_END2 = O_HID + (size_t)NTOK * 4096 * 2;
static_assert(O_END2 <= O_END1, "HID alias must fit");
static_assert(O_END1 <= (size_t)256 * 1024 * 1024, "workspace too big");

constexpr size_t OUT_YP = 0, OUT_YS = 4194304, OUT_AK = 6291456, OUT_AV = 10485760, OUT_CK = 14680064,
                 OUT_CV = 15728640, OUT_SF = 16777216, OUT_SB = 17301504;

struct P {
  const float* in[30];
  float* out;
  char* ws;
};

DI unsigned pack2(float a, float b) {
  f2_t v = {a, b};
  bf2_t r = __builtin_convertvector(v, bf2_t);
  return __builtin_bit_cast(unsigned, r);
}
DI u16 f2bf(float x) { return (u16)(pack2(x, 0.f) & 0xffffu); }
DI float ex2(float x) { return __builtin_amdgcn_exp2f(x); }
DI float siluf(float x) { return x / (1.f + expf(-x)); }
DI float shx(float v, int m) { return __shfl_xor(v, m, 64); }
DI float red16(float x) {
  x += __builtin_bit_cast(float, __builtin_amdgcn_update_dpp(0, __builtin_bit_cast(int, x), 0xB1, 0xF, 0xF, true));
  x += __builtin_bit_cast(float, __builtin_amdgcn_update_dpp(0, __builtin_bit_cast(int, x), 0x4E, 0xF, 0xF, true));
  x += __builtin_bit_cast(float, __builtin_amdgcn_update_dpp(0, __builtin_bit_cast(int, x), 0x141, 0xF, 0xF, true));
  x += __builtin_bit_cast(float, __builtin_amdgcn_update_dpp(0, __builtin_bit_cast(int, x), 0x140, 0xF, 0xF, true));
  return x;
}
DI float xor1(float x) { return __builtin_bit_cast(float, __builtin_amdgcn_update_dpp(0, __builtin_bit_cast(int, x), 0xB1, 0xF, 0xF, true)); }
DI int ltid() { int t = threadIdx.x; asm volatile("" : "+v"(t)); return t; }
#define MFMA16(a, b, c) __builtin_amdgcn_mfma_f32_16x16x32_bf16((a), (b), (c), 0, 0, 0)

DI void p0_mod(const P& p, int item, char* smem) {
  float* ssilu = (float*)smem;
  float* red = ssilu + 3072;
  const int tid = ltid();
  __syncthreads();
  for (int i = tid; i < 3072; i += 256) {
    int w = i >> 10, k = i & 1023;
    float v = (w == 0) ? p.in[9][k] : p.in[8][(w - 1) * 1024 + k];
    ssilu[i] = siluf(v);
  }
  __syncthreads();
  const int li = item / 96, j0 = (item % 96) * 64;
  const int c4 = tid & 15, kp = tid >> 4;
  const float* W = p.in[10] + (size_t)li * 1024 * 6144 + j0 + c4 * 4;
  float4 a0 = {0, 0, 0, 0}, a1 = a0, a2 = a0;
#pragma unroll 16
  for (int kk = 0; kk < 64; ++kk) {
    int k = kp * 64 + kk;
    float4 w4 = *(const float4*)(W + (size_t)k * 6144);
    float s0 = ssilu[k], s1 = ssilu[1024 + k], s2 = ssilu[2048 + k];
    a0.x += s0 * w4.x; a0.y += s0 * w4.y; a0.z += s0 * w4.z; a0.w += s0 * w4.w;
    a1.x += s1 * w4.x; a1.y += s1 * w4.y; a1.z += s1 * w4.z; a1.w += s1 * w4.w;
    a2.x += s2 * w4.x; a2.y += s2 * w4.y; a2.z += s2 * w4.z; a2.w += s2 * w4.w;
  }
  *(float4*)(red + (kp * 3 + 0) * 64 + c4 * 4) = a0;
  *(float4*)(red + (kp * 3 + 1) * 64 + c4 * 4) = a1;
  *(float4*)(red + (kp * 3 + 2) * 64 + c4 * 4) = a2;
  __syncthreads();
  if (tid < 192) {
    int w = tid >> 6, c = tid & 63;
    float s = p.in[11][li * 6144 + j0 + c];
    for (int q = 0; q < 16; ++q) s += red[(q * 3 + w) * 64 + c];
    ((float*)(p.ws + O_MODS))[(li * 3 + w) * 6144 + j0 + c] = s;
  }
}

DI void p0_rope(const P& p, int item) {
  float* R = (float*)(p.ws + O_ROPE);
  for (int i = ltid(); i < 4096; i += 256) {
    int idx = item * 4096 + i;
    int t = idx >> 5, pp = idx & 31;
    float inv = powf(10000.f, -(float)(pp & 15) / 16.f);
    float pos = (pp < 16) ? (float)(t >> 6) : (float)(t & 63);
    float ang = pos * inv;
    R[idx * 2] = cosf(ang);
    R[idx * 2 + 1] = sinf(ang);
  }
}

DI void p0_copyk(const P& p, int item, bool isA) {
  const int W = isA ? 512 : 128;
  const float* src = isA ? p.in[2] : p.in[4];
  u16* dst = (u16*)(p.ws + (isA ? O_KALAT : O_KCLAT));
  for (int i = 0; i < 4; ++i) {
    size_t e = (size_t)item * 4096 + (size_t)(ltid() + 256 * i) * 4;
    float4 v = *(const float4*)(src + e);
    int c = (int)(e % W);
    size_t r = e / W;
    int pp = (int)(r % 512);
    int bl = (int)(r / 512);
    int b = bl >> 1, li = bl & 1;
    uint2 o;
    o.x = pack2(v.x, v.y);
    o.y = pack2(v.z, v.w);
    *(uint2*)(dst + ((size_t)((li * 2 + b) * 1536 + 1024 + pp)) * W + c) = o;
  }
}

struct TDesc { const float* src; int sstride; u16* dst; int dstride; };

DI TDesc tdesc(const P& p, int t) {
  constexpr int T_IN = 1664, T_OUT = 512, T_FF1 = 2048, T_FF2 = 2048, T_AV = 256;
  TDesc d;
  if (t < T_IN) {
    int li = t / 832, r = t % 832, kt = r / 52, nt = r % 52;
    d.src = p.in[12] + (size_t)li * 1024 * NIN + (size_t)(kt * 64) * NIN + nt * 64; d.sstride = NIN;
    d.dst = (u16*)(p.ws + O_WTIN) + (size_t)li * NIN * 1024 + (size_t)(nt * 64) * 1024 + kt * 64; d.dstride = 1024;
  } else if ((t -= T_IN) < T_OUT) {
    int li = t / 256, r = t % 256, kt = r / 16, nt = r % 16;
    d.src = p.in[13] + (size_t)li * 1024 * 1024 + (size_t)(kt * 64) * 1024 + nt * 64; d.sstride = 1024;
    d.dst = (u16*)(p.ws + O_WTOUT) + (size_t)li * 1024 * 1024 + (size_t)(nt * 64) * 1024 + kt * 64; d.dstride = 1024;
  } else if ((t -= T_OUT) < T_FF1) {
    int li = t / 1024, r = t % 1024, kt = r / 64, nt = r % 64;
    d.src = p.in[28] + (size_t)li * 1024 * DFF + (size_t)(kt * 64) * DFF + nt * 64; d.sstride = DFF;
    d.dst = (u16*)(p.ws + O_WTFF1) + (size_t)li * DFF * 1024 + (size_t)(nt * 64) * 1024 + kt * 64; d.dstride = 1024;
  } else if ((t -= T_FF1) < T_FF2) {
    int li = t / 1024, r = t % 1024, kt = r / 16, nt = r % 16;
    d.src = p.in[29] + (size_t)li * DFF * 1024 + (size_t)(kt * 64) * 1024 + nt * 64; d.sstride = 1024;
    d.dst = (u16*)(p.ws + O_WTFF2) + (size_t)li * 1024 * DFF + (size_t)(nt * 64) * DFF + kt * 64; d.dstride = DFF;
  } else if ((t -= T_FF2) < T_AV) {
    int bl = t / 64, r = t % 64, pt = r / 8, ct = r % 8;
    int b = bl >> 1, li = bl & 1;
    d.src = p.in[3] + ((size_t)bl * 512 + pt * 64) * 512 + ct * 64; d.sstride = 512;
    d.dst = (u16*)(p.ws + O_VTALAT) + ((size_t)(li * 2 + b) * 512 + ct * 64) * 1536 + 1024 + pt * 64; d.dstride = 1536;
  } else {
    t -= T_AV;
    int bl = t / 16, r = t % 16, pt = r / 2, ct = r % 2;
    int b = bl >> 1, li = bl & 1;
    d.src = p.in[5] + ((size_t)bl * 512 + pt * 64) * 128 + ct * 64; d.sstride = 128;
    d.dst = (u16*)(p.ws + O_VTCLAT) + ((size_t)(li * 2 + b) * 128 + ct * 64) * 1536 + 1024 + pt * 64; d.dstride = 1536;
  }
  return d;
}

DI void phase0(const P& p, char* smem) {
  constexpr int N_MOD = 192, N_ROPE = 8, N_AK = 256, N_CK = 64;
  constexpr int B_ROPE = N_MOD, B_AK = B_ROPE + N_ROPE, B_CK = B_AK + N_AK, B_T = B_CK + N_CK;
  constexpr int NTILES = 1664 + 512 + 2048 + 2048 + 256 + 64;
  for (int it = blockIdx.x; it < B_T; it += gridDim.x) {
    if (it < B_ROPE) p0_mod(p, it, smem);
    else if (it < B_AK) p0_rope(p, it - B_ROPE);
    else if (it < B_CK) p0_copyk(p, it - B_AK, true);
    else p0_copyk(p, it - B_CK, false);
  }
  float* tl = (float*)smem;
  const int tid = ltid();
  const int lr = tid >> 4, lc4 = tid & 15;
  const int c = tid >> 2, rs = tid & 3;
  int t = blockIdx.x;
  f32x4 v[4];
  TDesc cur;
  if (t < NTILES) {
    cur = tdesc(p, t);
#pragma unroll
    for (int i = 0; i < 4; ++i) v[i] = *(const f32x4*)(cur.src + (size_t)(lr + 16 * i) * cur.sstride + lc4 * 4);
  }
  while (t < NTILES) {
    __syncthreads();
#pragma unroll
    for (int i = 0; i < 4; ++i) {
      float* q = tl + (lr + 16 * i) * 65 + lc4 * 4;
      q[0] = v[i].x; q[1] = v[i].y; q[2] = v[i].z; q[3] = v[i].w;
    }
    const int tn = t + gridDim.x;
    TDesc nxt = cur;
    if (tn < NTILES) {
      nxt = tdesc(p, tn);
#pragma unroll
      for (int i = 0; i < 4; ++i) v[i] = *(const f32x4*)(nxt.src + (size_t)(lr + 16 * i) * nxt.sstride + lc4 * 4);
    }
    __syncthreads();
    u32x4 o0, o1;
    {
      const float* q = tl + (rs * 16) * 65 + c;
      o0.x = pack2(q[0 * 65], q[1 * 65]);   o0.y = pack2(q[2 * 65], q[3 * 65]);
      o0.z = pack2(q[4 * 65], q[5 * 65]);   o0.w = pack2(q[6 * 65], q[7 * 65]);
      o1.x = pack2(q[8 * 65], q[9 * 65]);   o1.y = pack2(q[10 * 65], q[11 * 65]);
      o1.z = pack2(q[12 * 65], q[13 * 65]); o1.w = pack2(q[14 * 65], q[15 * 65]);
    }
    u32x4* dp = (u32x4*)(cur.dst + (size_t)c * cur.dstride + rs * 16);
    dp[0] = o0;
    dp[1] = o1;
    cur = nxt;
    t = tn;
  }
}

struct GA {
  const float* alo;
  const float* ahi;
  const float* stats;
  const float* lng;
  const float* lnb;
  const float* mods;
  int sc_off, sh_off;
  const u16* a16;
  const u16* bt;
  int K, N;
  float* xout;
  float* sout;
  u16* hid;
};

DI void epi_inproj(const P& p, int li, f32x4 (&acc)[4][4], int R0, int C0);


template <int EPI, int MI = 4>
DI void gemm_tile(const P& p, const GA& g, int li, int m0, int n0, char* smem, u32x4 (&ra0)[4], u32x4 (&rb0)[4],
                  u32x4 (&ra1)[4], u32x4 (&rb1)[4], bool primed, int nm0, int nn0) {
  static_assert(MI == 4 || EPI == 1, "only the residual epilogue supports 96-row tiles");
  constexpr int WM = MI * 16;
  const int tid = ltid(), lane = tid & 63, wid = tid >> 6, wr = wid >> 1, wc = wid & 1;
  const int l16 = lane & 15, q4 = lane >> 4;
  u16* sA0 = (u16*)smem;
  u16* sB0 = sA0 + 128 * 72;
  u16* sA1 = sB0 + 128 * 72;
  u16* sB1 = sA1 + 128 * 72;
  float2* sStat = (float2*)(smem + 73728);
  const int K = g.K;
  const int rtype = (m0 < NCTX) ? 0 : 1 + ((m0 - NCTX) >> 10);
  const float* modv = g.mods + rtype * 6144;
  const float* fsrc = (m0 < NCTX) ? g.alo + (size_t)m0 * 1024 : g.ahi + (size_t)(m0 - NCTX) * 1024;

  if (!primed) {
    const unsigned goff_ = (unsigned)(tid >> 3) * (unsigned)g.K + (unsigned)(tid & 7) * 8u;
    const u16* ab_ = g.a16 + (size_t)m0 * g.K;
    const u16* bb_ = g.bt + (size_t)n0 * g.K;
#pragma unroll
    for (int i = 0; i < 4; ++i) {
      if (i < MI) ra0[i] = *(const u32x4*)(ab_ + (size_t)(32 * i) * g.K + goff_);
      rb0[i] = *(const u32x4*)(bb_ + (size_t)(32 * i) * g.K + goff_);
    }
    __builtin_amdgcn_sched_barrier(0);
#pragma unroll
    for (int i = 0; i < 4; ++i) {
      if (i < MI) ra1[i] = *(const u32x4*)(ab_ + (size_t)(32 * i) * g.K + 64 + goff_);
      rb1[i] = *(const u32x4*)(bb_ + (size_t)(32 * i) * g.K + 64 + goff_);
    }
    __builtin_amdgcn_sched_barrier(0);
  }
  __syncthreads();
  if constexpr (EPI == 1 || EPI == 3) {
    if (g.stats != nullptr && tid < 2 * WM) {
      const float4* sp = (const float4*)(g.stats + (size_t)(m0 + tid) * 32);
      float s1 = 0.f, s2 = 0.f;
#pragma unroll
      for (int i = 0; i < 8; ++i) {
        float4 v = sp[i];
        s1 += v.x + v.z;
        s2 += v.y + v.w;
      }
      float mu = s1 * (1.f / 1024.f);
      float var = s2 * (1.f / 1024.f) - mu * mu;
      sStat[tid] = make_float2(mu, rsqrtf(fmaxf(var, 0.f) + 1e-6f));
    }
  }

  f32x4 acc[MI][4];
#pragma unroll
  for (int i = 0; i < MI; ++i)
#pragma unroll
    for (int j = 0; j < 4; ++j) acc[i][j] = f32x4{0.f, 0.f, 0.f, 0.f};

  const unsigned goff = (unsigned)(tid >> 3) * (unsigned)K + (unsigned)(tid & 7) * 8u;
  const unsigned loff = (unsigned)(tid >> 3) * 72u + (unsigned)(tid & 7) * 8u;
  const u16* abase = g.a16 + (size_t)m0 * K;
  const u16* bbase = g.bt + (size_t)n0 * K;
#define GLOAD(RA, RB, KT)                                                        \
  _Pragma("unroll") for (int i = 0; i < 4; ++i) {                                \
    if (i < MI) RA[i] = *(const u32x4*)(abase + (size_t)(32 * i) * K + (KT) * 64 + goff); \
    RB[i] = *(const u32x4*)(bbase + (size_t)(32 * i) * K + (KT) * 64 + goff);    \
  }
#define LSTORE(SA, SB, RA, RB)                                                   \
  _Pragma("unroll") for (int i = 0; i < 4; ++i) {                                \
    if (i < MI) *(u32x4*)(SA + 32 * i * 72 + loff) = RA[i];                      \
    *(u32x4*)(SB + 32 * i * 72 + loff) = RB[i];                                  \
  }
#define COMPUTE(SA, SB)                                                          \
  _Pragma("unroll") for (int s = 0; s < 2; ++s) {                                \
    bf16x8 af[MI], bfr[4];                                                       \
    _Pragma("unroll") for (int i = 0; i < 4; ++i) {                              \
      if (i < MI) af[i] = *(const bf16x8*)(SA + (wr * WM + i * 16 + l16) * 72 + s * 32 + q4 * 8);  \
      bfr[i] = *(const bf16x8*)(SB + (wc * 64 + i * 16 + l16) * 72 + s * 32 + q4 * 8); \
    }                                                                            \
    __builtin_amdgcn_s_setprio(1);                                               \
    _Pragma("unroll") for (int i = 0; i < MI; ++i)                               \
      _Pragma("unroll") for (int j = 0; j < 4; ++j) acc[i][j] = MFMA16(af[i], bfr[j], acc[i][j]); \
    __builtin_amdgcn_s_setprio(0);                                               \
    __builtin_amdgcn_sched_barrier(0);                                           \
  }

  const int nk = K >> 6;
#define SB0 __builtin_amdgcn_sched_barrier(0)
  LSTORE(sA0, sB0, ra0, rb0);
  SB0;
  GLOAD(ra0, rb0, 2);
  SB0;
  __syncthreads();
#pragma unroll 1
  for (int kt = 0; kt < nk - 4; kt += 2) {
    SB0;
    LSTORE(sA1, sB1, ra1, rb1);
    SB0;
    GLOAD(ra1, rb1, kt + 3);
    SB0;
    COMPUTE(sA0, sB0);
    __syncthreads();
    SB0;
    LSTORE(sA0, sB0, ra0, rb0);
    SB0;
    GLOAD(ra0, rb0, kt + 4);
    SB0;
    COMPUTE(sA1, sB1);
    __syncthreads();
  }
  SB0;
  LSTORE(sA1, sB1, ra1, rb1);
  SB0;
  GLOAD(ra1, rb1, nk - 1);
  SB0;
  COMPUTE(sA0, sB0);
  __syncthreads();
  const u16* nabase = g.a16 + (size_t)nm0 * K;
  const u16* nbbase = g.bt + (size_t)nn0 * K;
  SB0;
  LSTORE(sA0, sB0, ra0, rb0);
  SB0;
  _Pragma("unroll") for (int i = 0; i < 4; ++i) {
    if (i < MI) ra0[i] = *(const u32x4*)(nabase + (size_t)(32 * i) * K + goff);
    rb0[i] = *(const u32x4*)(nbbase + (size_t)(32 * i) * K + goff);
  }
  SB0;
  COMPUTE(sA1, sB1);
  __syncthreads();
  SB0;
  LSTORE(sA1, sB1, ra1, rb1);
  SB0;
  _Pragma("unroll") for (int i = 0; i < 4; ++i) {
    if (i < MI) ra1[i] = *(const u32x4*)(nabase + (size_t)(32 * i) * K + 64 + goff);
    rb1[i] = *(const u32x4*)(nbbase + (size_t)(32 * i) * K + 64 + goff);
  }
  SB0;
  COMPUTE(sA0, sB0);
  __syncthreads();
  SB0;
  COMPUTE(sA1, sB1);
#undef GLOAD
#undef LSTORE
#undef COMPUTE
#undef SB0
  asm volatile("" ::: "memory");

  const int R0 = m0 + wr * WM, C0 = n0 + wc * 64;
  if constexpr (EPI == 0) {
    if constexpr (MI == 4) epi_inproj(p, li, acc, R0, C0);
  } else if constexpr (EPI == 1) {
    const int rtA = rtype;
    const int mlast = m0 + 2 * WM - 1;
    const int rtB = (mlast < NCTX) ? 0 : 1 + ((mlast - NCTX) >> 10);
    const float* modvB = g.mods + rtB * 6144;
    float gateA[4], gateB[4], lg[4], lb[4];
#pragma unroll
    for (int j = 0; j < 4; ++j) {
      int col = C0 + j * 16 + l16;
      gateA[j] = modv[g.sc_off + col];
      gateB[j] = modvB[g.sc_off + col];
      lg[j] = g.stats ? g.lng[col] : 1.f;
      lb[j] = g.stats ? g.lnb[col] : 0.f;
    }
    float xr[MI][4][4];
#pragma unroll
    for (int i = 0; i < MI; ++i)
#pragma unroll
      for (int r = 0; r < 4; ++r) {
        const int grow = m0 + wr * WM + i * 16 + q4 * 4 + r;
        const float* rp = (grow < NCTX) ? g.alo + (size_t)grow * 1024 : g.ahi + (size_t)(grow - NCTX) * 1024;
#pragma unroll
        for (int j = 0; j < 4; ++j) xr[i][r][j] = rp[C0 + j * 16 + l16];
      }
#pragma unroll
    for (int i = 0; i < MI; ++i) {
#pragma unroll
      for (int r = 0; r < 4; ++r) {
        int lrow = wr * WM + i * 16 + q4 * 4 + r;
        const int grow = m0 + lrow;
        const int rt = (grow < NCTX) ? 0 : 1 + ((grow - NCTX) >> 10);
        const bool useA = (rt == rtA);
        float mu = 0.f, rs = 1.f;
        if (g.stats != nullptr) {
          float2 st = sStat[lrow];
          mu = st.x;
          rs = st.y;
        }
        float s1 = 0.f, s2 = 0.f;
#pragma unroll
        for (int j = 0; j < 4; ++j) {
          int col = C0 + j * 16 + l16;
          float x = xr[i][r][j];
          x = (x - mu) * rs * lg[j] + lb[j];
          float v = ALPHA * x + (useA ? gateA[j] : gateB[j]) * acc[i][j][r];
          g.xout[(size_t)grow * 1024 + col] = v;
          s1 += v;
          s2 += v * v;
        }
        s1 = red16(s1);
        s2 = red16(s2);
        if (l16 == 0) *(float2*)(g.sout + (size_t)grow * 32 + (C0 >> 6) * 2) = make_float2(s1, s2);
      }
    }
  } else {
    float* sC = (float*)smem;
    __syncthreads();
#pragma unroll
    for (int i = 0; i < 4; ++i)
#pragma unroll
      for (int j = 0; j < 4; ++j)
#pragma unroll
        for (int r = 0; r < 4; ++r) if constexpr (MI == 4) sC[(wr * 64 + i * 16 + q4 * 4 + r) * 132 + wc * 64 + j * 16 + l16] = acc[i][j][r];
    __syncthreads();
    if constexpr (EPI == 3) {
      const int hl = lane & 31, rsel = lane >> 5;
      const int col = n0 + hl * 4;
      const f32x4 gate4 = *(const f32x4*)(modv + g.sc_off + col);
      f32x4 lg4 = {1.f, 1.f, 1.f, 1.f}, lb4 = {0.f, 0.f, 0.f, 0.f};
      if (g.stats != nullptr) {
        lg4 = *(const f32x4*)(g.lng + col);
        lb4 = *(const f32x4*)(g.lnb + col);
      }
#pragma unroll 4
      for (int pp = 0; pp < 16; ++pp) {
        const int lrow = pp * 8 + wid * 2 + rsel;
        f32x4 a = *(const f32x4*)(sC + lrow * 132 + hl * 4);
        f32x4 x = *(const f32x4*)(fsrc + (size_t)lrow * 1024 + col);
        float mu = 0.f, rs = 1.f;
        if (g.stats != nullptr) {
          float2 st = sStat[lrow];
          mu = st.x;
          rs = st.y;
        }
        x = (x - mu) * rs * lg4 + lb4;
        f32x4 v = ALPHA * x + gate4 * a;
        *(f32x4*)(g.xout + (size_t)(m0 + lrow) * 1024 + col) = v;
        float s1 = (v.x + v.y) + (v.z + v.w);
        float s2 = (v.x * v.x + v.y * v.y) + (v.z * v.z + v.w * v.w);
        s1 = red16(s1);
        s2 = red16(s2);
        if ((lane & 15) == 0) *(float2*)(g.sout + (size_t)(m0 + lrow) * 32 + ((n0 >> 6) + (hl >> 4)) * 2) = make_float2(s1, s2);
      }
    } else {
#pragma unroll
      for (int pp = 0; pp < 8; ++pp) {
        const int idx = tid + 256 * pp;
        const int lrow = idx >> 4, c8 = idx & 15;
        f32x4 a0 = *(const f32x4*)(sC + lrow * 132 + c8 * 8);
        f32x4 a1 = *(const f32x4*)(sC + lrow * 132 + c8 * 8 + 4);
        a0.x = fmaxf(a0.x, 0.f); a0.y = fmaxf(a0.y, 0.f); a0.z = fmaxf(a0.z, 0.f); a0.w = fmaxf(a0.w, 0.f);
        a1.x = fmaxf(a1.x, 0.f); a1.y = fmaxf(a1.y, 0.f); a1.z = fmaxf(a1.z, 0.f); a1.w = fmaxf(a1.w, 0.f);
        u32x4 o;
        o.x = pack2(a0.x * a0.x, a0.y * a0.y);
        o.y = pack2(a0.z * a0.z, a0.w * a0.w);
        o.z = pack2(a1.x * a1.x, a1.y * a1.y);
        o.w = pack2(a1.z * a1.z, a1.w * a1.w);
        *(u32x4*)(g.hid + (size_t)(m0 + lrow) * DFF + n0 + c8 * 8) = o;
      }
    }
  }
}

DI void epi_inproj(const P& p, int li, f32x4 (&acc)[4][4], int R0, int C0) {
  const int lane = ltid() & 63, l16 = lane & 15, q4 = lane >> 4;
  const int seg = C0 >> 6;
  const bool lat = R0 >= NCTX;
  const float2* rope = (const float2*)(p.ws + O_ROPE);
  int b, tb;
  if (!lat) { b = R0 >> 8; tb = R0 & 255; } else { b = (R0 - NCTX) >> 10; tb = (R0 - NCTX) & 1023; }

  enum { T_QA, T_KA, T_VA, T_QB, T_FF, T_FB, T_IB, T_GB, T_QC, T_KC, T_VC };
  int type, cbase;
  if (seg < 8) { type = T_QA; cbase = seg * 64; }
  else if (seg < 16) { type = T_KA; cbase = (seg - 8) * 64; }
  else if (seg < 24) { type = T_VA; cbase = (seg - 16) * 64; }
  else if (seg < 28) { type = T_QB; cbase = (seg - 24) * 64; }
  else if (seg < 32) { type = T_FF; cbase = (seg - 28) * 64; }
  else if (seg < 36) { type = T_FB; cbase = (seg - 32) * 64; }
  else if (seg < 40) { type = T_IB; cbase = (seg - 36) * 64; }
  else if (seg < 44) { type = T_GB; cbase = (seg - 40) * 64; }
  else if (seg < 48) { type = T_QC; cbase = (seg - 44) * 64; }
  else if (seg < 50) { type = T_KC; cbase = (seg - 48) * 64; }
  else { type = T_VC; cbase = (seg - 50) * 64; }

  if (type == T_QC || type == T_KC) {
    const float* gv = (type == T_QC ? p.in[22] : p.in[23]) + li * 64;
    float gj[4];
#pragma unroll
    for (int j = 0; j < 4; ++j) gj[j] = gv[j * 16 + l16];
#pragma unroll
    for (int i = 0; i < 4; ++i)
#pragma unroll
      for (int r = 0; r < 4; ++r) {
        float ss = 0.f;
#pragma unroll
        for (int j = 0; j < 4; ++j) ss += acc[i][j][r] * acc[i][j][r];
        ss = red16(ss);
        float rs = rsqrtf(ss * (1.f / 64.f) + 1e-6f);
#pragma unroll
        for (int j = 0; j < 4; ++j) acc[i][j][r] = acc[i][j][r] * rs * gj[j];
      }
  }
  if (!lat && (type == T_KA || type == T_VA || type == T_KC || type == T_VC)) {
    float* o;
    int W;
    if (type == T_KA) { o = p.out + OUT_AK; W = 512; }
    else if (type == T_VA) { o = p.out + OUT_AV; W = 512; }
    else if (type == T_KC) { o = p.out + OUT_CK; W = 128; }
    else { o = p.out + OUT_CV; W = 128; }
#pragma unroll
    for (int i = 0; i < 4; ++i)
#pragma unroll
      for (int r = 0; r < 4; ++r) {
        int t = tb + i * 16 + q4 * 4 + r;
        size_t base = ((size_t)(b * 2 + li) * 256 + t) * W + cbase;
#pragma unroll
        for (int j = 0; j < 4; ++j) o[base + j * 16 + l16] = acc[i][j][r];
      }
  }
  if (lat && (type == T_QA || type == T_KA || type == T_QC || type == T_KC)) {
#pragma unroll
    for (int i = 0; i < 4; ++i)
#pragma unroll
      for (int r = 0; r < 4; ++r) {
        int t = tb + i * 16 + q4 * 4 + r;
#pragma unroll
        for (int j = 0; j < 4; ++j) {
          float v = acc[i][j][r];
          float pv = xor1(v);
          float2 cs = rope[t * 32 + j * 8 + (l16 >> 1)];
          acc[i][j][r] = (l16 & 1) ? (pv * cs.y + v * cs.x) : (v * cs.x - pv * cs.y);
        }
      }
  }

  if (type == T_QA || type == T_KA || type == T_QC || type == T_KC) {
    u16* dst;
    int W;
    size_t rowbase;
    if (type == T_QA) { dst = (u16*)(p.ws + O_QA); W = 512; rowbase = (size_t)R0 * 512; }
    else if (type == T_QC) { dst = (u16*)(p.ws + O_QC); W = 256; rowbase = (size_t)R0 * 256; }
    else if (type == T_KA) {
      W = 512;
      if (!lat) { dst = (u16*)(p.ws + O_KACTX); rowbase = (size_t)R0 * 512; }
      else { dst = (u16*)(p.ws + O_KALAT); rowbase = ((size_t)(li * 2 + b) * 1536 + tb) * 512; }
    } else {
      W = 128;
      if (!lat) { dst = (u16*)(p.ws + O_KCCTX); rowbase = (size_t)R0 * 128; }
      else { dst = (u16*)(p.ws + O_KCLAT); rowbase = ((size_t)(li * 2 + b) * 1536 + tb) * 128; }
    }
#pragma unroll
    for (int i = 0; i < 4; ++i)
#pragma unroll
      for (int r = 0; r < 4; ++r) {
        size_t base = rowbase + (size_t)(i * 16 + q4 * 4 + r) * W + cbase;
#pragma unroll
        for (int j = 0; j < 4; ++j) dst[base + j * 16 + l16] = f2bf(acc[i][j][r]);
      }
  } else if (type == T_VA || type == T_VC) {
    u16* dst;
    int L;
    size_t hb;
    if (type == T_VA) {
      int h = cbase >> 7, dv0 = cbase & 127;
      if (!lat) { dst = (u16*)(p.ws + O_VTACTX); L = 256; hb = ((size_t)(b * 4 + h) * 128 + dv0) * 256; }
      else { dst = (u16*)(p.ws + O_VTALAT); L = 1536; hb = ((size_t)((li * 2 + b) * 4 + h) * 128 + dv0) * 1536; }
    } else {
      int n = cbase >> 6;
      if (!lat) { dst = (u16*)(p.ws + O_VTCCTX); L = 256; hb = ((size_t)(b * 2 + n) * 64) * 256; }
      else { dst = (u16*)(p.ws + O_VTCLAT); L = 1536; hb = ((size_t)((li * 2 + b) * 2 + n) * 64) * 1536; }
    }
#pragma unroll
    for (int i = 0; i < 4; ++i)
#pragma unroll
      for (int j = 0; j < 4; ++j) {
        uint2 o;
        o.x = pack2(acc[i][j][0], acc[i][j][1]);
        o.y = pack2(acc[i][j][2], acc[i][j][3]);
        *(uint2*)(dst + hb + (size_t)(j * 16 + l16) * L + tb + i * 16 + q4 * 4) = o;
      }
  } else {
    float* dst;
    if (type == T_QB) dst = (float*)(p.ws + O_HQ);
    else if (type == T_FF) dst = (float*)(p.ws + O_HGF);
    else if (type == T_FB) dst = (float*)(p.ws + O_HGB);
    else if (type == T_IB) dst = (float*)(p.ws + O_HI);
    else dst = (float*)(p.ws + O_HSG);
    float lbv[4] = {0.f, 0.f, 0.f, 0.f};
    if ((type == T_FF || type == T_FB) && li == 1) {
      const float* lg = (type == T_FF) ? p.in[19] : p.in[20];
#pragma unroll
      for (int j = 0; j < 4; ++j) {
        int c = cbase + j * 16 + l16;
        lbv[j] = 1.f / (1.f + expf(lg[c] - lg[256 + c]));
      }
    }
#pragma unroll
    for (int i = 0; i < 4; ++i)
#pragma unroll
      for (int r = 0; r < 4; ++r) {
        size_t base = (size_t)(R0 + i * 16 + q4 * 4 + r) * 256 + cbase;
#pragma unroll
        for (int j = 0; j < 4; ++j) {
          float v = acc[i][j][r];
          float o;
          if (type == T_QB || type == T_GB) o = v * __frcp_rn(1.f + __expf(-v));
          else if (type == T_IB) o = v;
          else {
            float sg = __frcp_rn(1.f + __expf(-v));
            float f = lbv[j] + (1.f - lbv[j]) * sg;
            o = __logf(fmaxf(f, 1e-6f));
          }
          dst[base + j * 16 + l16] = o;
        }
      }
  }
}

template <int EPI, int MI = 4>
DI void gemm_phase(const P& p, const GA& g, int li, char* smem) {
  constexpr int BMT = MI * 32;
  constexpr int MPX = NTOK / BMT / 8;
  const int NT = g.N >> 7;
  const int xcd = blockIdx.x & 7, lb = blockIdx.x >> 3, nlb = gridDim.x >> 3;
  if (lb >= nlb) return;
  u32x4 ra0[4], rb0[4], ra1[4], rb1[4];
  bool primed = false;
  for (int t = lb; t < MPX * NT; t += nlb) {
    int mt = xcd * MPX + t % MPX, nt = t / MPX;
    const int tn = (t + nlb < MPX * NT) ? t + nlb : t;
    const int nmt = xcd * MPX + tn % MPX, nnt = tn / MPX;
    gemm_tile<EPI, MI>(p, g, li, mt * BMT, nt * 128, smem, ra0, rb0, ra1, rb1, primed, nmt * BMT, nnt * 128);
    primed = true;
  }
}


template <int KW, int DV>
DI void attn_gload(const u16* Kb, int kstride, const u16* VT, int L, int kb, int tid, u32x4 (&kr)[KW / 32], u32x4 (&vr)[DV / 32]) {
  constexpr int KPR = 256 / (KW / 8);
  const unsigned koff = (unsigned)(tid / (KW / 8)) * (unsigned)kstride + (unsigned)(tid % (KW / 8)) * 8u;
  const unsigned voff = (unsigned)(tid >> 3) * (unsigned)L + (unsigned)(tid & 7) * 8u;
#pragma unroll
  for (int i = 0; i < KW / 32; ++i) {
    const u16* kbp = Kb + (size_t)(kb * 64 + KPR * i) * kstride;
    kr[i] = *(const u32x4*)(kbp + koff);
  }
#pragma unroll
  for (int i = 0; i < DV / 32; ++i) {
    const u16* vbp = VT + (size_t)(32 * i) * L + kb * 64;
    vr[i] = *(const u32x4*)(vbp + voff);
  }
}
template <int KW, int DV>
DI void attn_lstore(u16* sK, u16* sV, int tid, const u32x4 (&kr)[KW / 32], const u32x4 (&vr)[DV / 32]) {
  constexpr int KS = KW + 8;
#pragma unroll
  for (int i = 0; i < KW / 32; ++i) {
    int idx = tid + 256 * i;
    int key = idx / (KW / 8), cc = idx % (KW / 8);
    *(u32x4*)(sK + key * KS + cc * 8) = kr[i];
  }
#pragma unroll
  for (int i = 0; i < DV / 32; ++i) {
    int idx = tid + 256 * i;
    int row = idx >> 3, cc = idx & 7;
    *(u32x4*)(sV + row * 72 + cc * 8) = vr[i];
  }
}

template <int KW, int DV, int NQ>
DI void attn_compute(const u16* sK, const u16* sV, int kfo, int l16, int q4, const bf16x8 (&qf)[NQ][2],
                     f32x4 (&o)[NQ][DV / 16], float (&m)[NQ], float (&l)[NQ]) {
  constexpr int KS = KW + 8, NDT = DV / 16;
  const float c = 0.125f * LOG2E;
  f32x4 st[NQ][4];
#pragma unroll
  for (int kt = 0; kt < 4; ++kt) {
    const u16* kp = sK + (kt * 16 + l16) * KS + kfo + q4 * 8;
    bf16x8 k0 = *(const bf16x8*)kp;
    bf16x8 k1 = *(const bf16x8*)(kp + 32);
#pragma unroll
    for (int q = 0; q < NQ; ++q) {
      f32x4 z = {0.f, 0.f, 0.f, 0.f};
      z = MFMA16(k0, qf[q][0], z);
      st[q][kt] = MFMA16(k1, qf[q][1], z);
    }
  }
#pragma unroll
  for (int q = 0; q < NQ; ++q) {
    float bm = st[q][0][0];
#pragma unroll
    for (int kt = 0; kt < 4; ++kt)
#pragma unroll
      for (int r = 0; r < 4; ++r) bm = fmaxf(bm, st[q][kt][r]);
    bm = fmaxf(bm, shx(bm, 16));
    bm = fmaxf(bm, shx(bm, 32));
    const float mn = fmaxf(m[q], bm);
    const float alpha = ex2((m[q] - mn) * c);
    m[q] = mn;
    float ps = 0.f;
#pragma unroll
    for (int kt = 0; kt < 4; ++kt)
#pragma unroll
      for (int r = 0; r < 4; ++r) {
        float pv = ex2((st[q][kt][r] - mn) * c);
        st[q][kt][r] = pv;
        ps += pv;
      }
    l[q] = l[q] * alpha + ps;
#pragma unroll
    for (int d = 0; d < NDT; ++d) {
      o[q][d][0] *= alpha; o[q][d][1] *= alpha; o[q][d][2] *= alpha; o[q][d][3] *= alpha;
    }
  }
#pragma unroll
  for (int ks = 0; ks < 2; ++ks) {
    bf16x8 pf[NQ];
#pragma unroll
    for (int q = 0; q < NQ; ++q) {
      u32x4 pu;
      pu.x = pack2(st[q][2 * ks][0], st[q][2 * ks][1]);
      pu.y = pack2(st[q][2 * ks][2], st[q][2 * ks][3]);
      pu.z = pack2(st[q][2 * ks + 1][0], st[q][2 * ks + 1][1]);
      pu.w = pack2(st[q][2 * ks + 1][2], st[q][2 * ks + 1][3]);
      pf[q] = __builtin_bit_cast(bf16x8, pu);
    }
#pragma unroll
    for (int d = 0; d < NDT; ++d) {
      const u16* vp = sV + (d * 16 + l16) * 72 + ks * 32 + q4 * 4;
      u32x2 v0 = *(const u32x2*)vp;
      u32x2 v1 = *(const u32x2*)(vp + 16);
      u32x4 vu = {v0.x, v0.y, v1.x, v1.y};
      bf16x8 vf = __builtin_bit_cast(bf16x8, vu);
#pragma unroll
      for (int q = 0; q < NQ; ++q) o[q][d] = MFMA16(vf, pf[q], o[q][d]);
    }
  }
}

template <int KW, int DV, bool DIFF>
DI void attn_item(const u16* Q, int qstride, int qcol, int qrow0, const u16* Kb, int kstride, const u16* VT, int L,
                          int nkeys, u16* mixed, int mixcol, float lam, float postscale, const float* subg, char* smem) {
  constexpr int NQ = 2;
  const int tid = ltid(), lane = tid & 63, wid = tid >> 6, l16 = lane & 15, q4 = lane >> 4;
  const int qsub = wid & 1, var = wid >> 1;
  constexpr int KS = KW + 8;
  constexpr int STAGE = 64 * KS + DV * 72;
  u16* sK0 = (u16*)smem;
  u16* sV0 = sK0 + 64 * KS;
  u16* sK1 = sK0 + STAGE;
  u16* sV1 = sV0 + STAGE;
  constexpr int KPT = KW / 32, VPT = DV / 32, NDT = DV / 16;
  const int kfo = DIFF ? var * 64 : 0;

  bf16x8 qf[NQ][2];
#pragma unroll
  for (int q = 0; q < NQ; ++q) {
    const u16* qp = Q + (size_t)(qrow0 + qsub * 32 + q * 16 + l16) * qstride + qcol + var * 64 + q4 * 8;
    qf[q][0] = *(const bf16x8*)qp;
    qf[q][1] = *(const bf16x8*)(qp + 32);
  }

  u32x4 kr0[KPT], vr0[VPT];
  f32x4 o[NQ][NDT];
  float m[NQ], l[NQ];
#pragma unroll
  for (int q = 0; q < NQ; ++q) {
    m[q] = -INFINITY;
    l[q] = 0.f;
#pragma unroll
    for (int d = 0; d < NDT; ++d) o[q][d] = f32x4{0.f, 0.f, 0.f, 0.f};
  }
  const int nkb = nkeys >> 6;
#define SB0 __builtin_amdgcn_sched_barrier(0)
#define ACOMP(SK, SV) attn_compute<KW, DV, NQ>(SK, SV, kfo, l16, q4, qf, o, m, l)
  attn_gload<KW, DV>(Kb, kstride, VT, L, 0, tid, kr0, vr0);
  SB0;
  __syncthreads();
  attn_lstore<KW, DV>(sK0, sV0, tid, kr0, vr0);
  SB0;
  attn_gload<KW, DV>(Kb, kstride, VT, L, 1, tid, kr0, vr0);
  SB0;
  __syncthreads();
#pragma unroll 1
  for (int kb = 0; kb < nkb - 2; kb += 2) {
    SB0;
    attn_lstore<KW, DV>(sK1, sV1, tid, kr0, vr0);
    SB0;
    attn_gload<KW, DV>(Kb, kstride, VT, L, kb + 2, tid, kr0, vr0);
    SB0;
    ACOMP(sK0, sV0);
    __syncthreads();
    SB0;
    attn_lstore<KW, DV>(sK0, sV0, tid, kr0, vr0);
    SB0;
    attn_gload<KW, DV>(Kb, kstride, VT, L, kb + 3, tid, kr0, vr0);
    SB0;
    ACOMP(sK1, sV1);
    __syncthreads();
  }
  SB0;
  attn_lstore<KW, DV>(sK1, sV1, tid, kr0, vr0);
  SB0;
  ACOMP(sK0, sV0);
  __syncthreads();
  SB0;
  ACOMP(sK1, sV1);
  __syncthreads();
#undef SB0
#undef ACOMP
  float inv[NQ];
#pragma unroll
  for (int q = 0; q < NQ; ++q) {
    float lt = l[q];
    lt += shx(lt, 16);
    lt += shx(lt, 32);
    inv[q] = 1.f / lt;
  }
  if constexpr (DIFF) {
    float* sO = (float*)smem;
    if (var == 1) {
#pragma unroll
      for (int q = 0; q < NQ; ++q)
#pragma unroll
        for (int d = 0; d < NDT; ++d)
          *(f32x4*)(sO + (qsub * 32 + q * 16 + l16) * 132 + d * 16 + q4 * 4) = o[q][d] * inv[q];
    }
    __syncthreads();
    if (var == 0) {
      f32x4 ggv[NDT];
#pragma unroll
      for (int d = 0; d < NDT; ++d) ggv[d] = *(const f32x4*)(subg + d * 16 + q4 * 4);
#pragma unroll
      for (int q = 0; q < NQ; ++q) {
        const int row = qrow0 + qsub * 32 + q * 16 + l16;
        float ss = 0.f;
#pragma unroll
        for (int d = 0; d < NDT; ++d) {
          f32x4 o1 = *(const f32x4*)(sO + (qsub * 32 + q * 16 + l16) * 132 + d * 16 + q4 * 4);
          o[q][d] = o[q][d] * inv[q] - lam * o1;
          ss += o[q][d][0] * o[q][d][0] + o[q][d][1] * o[q][d][1] + o[q][d][2] * o[q][d][2] + o[q][d][3] * o[q][d][3];
        }
        ss += shx(ss, 16);
        ss += shx(ss, 32);
        const float rs = rsqrtf(ss * (1.f / 128.f) + 1e-6f) * postscale;
#pragma unroll
        for (int d = 0; d < NDT; ++d) {
          f32x4 v = o[q][d] * rs * ggv[d];
          u32x2 ov;
          ov.x = pack2(v.x, v.y);
          ov.y = pack2(v.z, v.w);
          *(u32x2*)(mixed + (size_t)row * 1024 + mixcol + d * 16 + q4 * 4) = ov;
        }
      }
    }
  } else {
#pragma unroll
    for (int q = 0; q < NQ; ++q) {
      const int row = qrow0 + qsub * 32 + q * 16 + l16;
#pragma unroll
      for (int d = 0; d < NDT; ++d) {
        f32x4 v = o[q][d] * inv[q];
        u32x2 ov;
        ov.x = pack2(v.x, v.y);
        ov.y = pack2(v.z, v.w);
        *(u32x2*)(mixed + (size_t)row * 1024 + mixcol + var * 64 + d * 16 + q4 * 4) = ov;
      }
    }
  }
}

DI void attnA_item(const P& p, int li, int it, char* smem) {
  const int lane = ltid() & 63;
  float d1 = p.in[14][li * 64 + lane] * p.in[15][li * 64 + lane];
  float d2 = p.in[16][li * 64 + lane] * p.in[17][li * 64 + lane];
#pragma unroll
  for (int s = 1; s < 64; s <<= 1) { d1 += shx(d1, s); d2 += shx(d2, s); }
  const float lam_init = 0.8f - 0.6f * expf(-0.3f * (float)li);
  const float lam = expf(d1) - expf(d2) + lam_init;
  const u16* QA = (const u16*)(p.ws + O_QA);
  u16* mixed = (u16*)(p.ws + O_MIXED);
  const float* subg = p.in[18] + li * 128;
  int qrow0, L;
  const u16 *Kb, *VT;
  int h;
  if (it < 128) {
    int b = it >> 6, qb = it & 15;
    h = (it >> 4) & 3;
    Kb = (const u16*)(p.ws + O_KALAT) + (size_t)(li * 2 + b) * 1536 * 512 + h * 128;
    VT = (const u16*)(p.ws + O_VTALAT) + (size_t)((li * 2 + b) * 4 + h) * 128 * 1536;
    qrow0 = NCTX + b * 1024 + qb * 64;
    L = 1536;
  } else {
    it -= 128;
    int b = it >> 4, qb = it & 3;
    h = (it >> 2) & 3;
    Kb = (const u16*)(p.ws + O_KACTX) + (size_t)b * 256 * 512 + h * 128;
    VT = (const u16*)(p.ws + O_VTACTX) + (size_t)(b * 4 + h) * 128 * 256;
    qrow0 = b * 256 + qb * 64;
    L = 256;
  }
  attn_item<128, 128, true>(QA, 512, h * 128, qrow0, Kb, 512, VT, L, L, mixed, h * 128, lam, 1.f - lam_init, subg, smem);
}
DI void attnC_item(const P& p, int li, int it, char* smem) {
  const u16* QC = (const u16*)(p.ws + O_QC);
  u16* mixed = (u16*)(p.ws + O_MIXED);
  int qrow0, L, n;
  const u16 *Kb, *VT;
  if (it < 64) {
    int b = it >> 5, qb = it & 15;
    n = (it >> 4) & 1;
    Kb = (const u16*)(p.ws + O_KCLAT) + (size_t)(li * 2 + b) * 1536 * 128 + n * 64;
    VT = (const u16*)(p.ws + O_VTCLAT) + (size_t)((li * 2 + b) * 2 + n) * 64 * 1536;
    qrow0 = NCTX + b * 1024 + qb * 64;
    L = 1536;
  } else {
    it -= 64;
    int b = it >> 3, qb = it & 3;
    n = (it >> 2) & 1;
    Kb = (const u16*)(p.ws + O_KCCTX) + (size_t)b * 256 * 128 + n * 64;
    VT = (const u16*)(p.ws + O_VTCCTX) + (size_t)(b * 2 + n) * 64 * 256;
    qrow0 = b * 256 + qb * 64;
    L = 256;
  }
  attn_item<64, 64, false>(QC, 256, n * 128, qrow0, Kb, 128, VT, L, L, mixed, 768 + n * 128, 0.f, 1.f, nullptr, smem);
}

DI void h1_item(const P& p, int item, char* smem) {
  const int tid = ltid(), lane = tid & 63, w = tid >> 6, l16 = lane & 15, q4 = lane >> 4;
  const int dir = item & 1, h = (item >> 1) & 3, tc = item >> 3;
  const int row0 = tc * 64;
  float* sQ = (float*)smem;
  float* sB = sQ + 64 * 68;
  float* sK = sB + 64 * 68;
  u16* sVT = (u16*)(sK + 64 * 68);
  float* sTot = (float*)(sVT + 64 * 72);
  const float* HQ = (const float*)(p.ws + O_HQ);
  const float* HG = (const float*)(p.ws + (dir ? O_HGB : O_HGF));
  const float* HI = (const float*)(p.ws + O_HI);
  float* OI = (float*)(p.ws + O_OI) + (size_t)dir * NTOK * 256;
  u16* QE = (u16*)(p.ws + O_QE) + (size_t)dir * NTOK * 256;
  float* KV = (float*)(p.ws + O_KV) + (size_t)item * 4096;
  float* DEC = (float*)(p.ws + O_DEC) + (size_t)item * 64;

  __syncthreads();
#pragma unroll
  for (int i = 0; i < 4; ++i) {
    int idx = tid + 256 * i;
    int lo = idx >> 4, c4 = idx & 15;
    int row = dir ? row0 + 63 - lo : row0 + lo;
    size_t off = (size_t)row * 256 + h * 64 + c4 * 4;
    *(float4*)(sQ + lo * 68 + c4 * 4) = *(const float4*)(HQ + off);
    *(float4*)(sB + lo * 68 + c4 * 4) = *(const float4*)(HG + off);
    float4 v = *(const float4*)(HI + off);
    sVT[(c4 * 4 + 0) * 72 + lo] = f2bf(v.x);
    sVT[(c4 * 4 + 1) * 72 + lo] = f2bf(v.y);
    sVT[(c4 * 4 + 2) * 72 + lo] = f2bf(v.z);
    sVT[(c4 * 4 + 3) * 72 + lo] = f2bf(v.w);
  }
  __syncthreads();
  {
    const int k = tid & 63, part = tid >> 6;
    float run = 0.f;
#pragma unroll 4
    for (int e = 0; e < 16; ++e) {
      int i = part * 16 + e;
      float g = sB[i * 68 + k];
      sK[i * 68 + k] = 1.f - ex2(g * LOG2E);
      run += g * LOG2E;
      sB[i * 68 + k] = run;
    }
    sTot[part * 64 + k] = run;
    __syncthreads();
    float add = 0.f;
    for (int pp = 0; pp < part; ++pp) add += sTot[pp * 64 + k];
    if (part > 0)
      for (int e = 0; e < 16; ++e) sB[(part * 16 + e) * 68 + k] += add;
  }
  __syncthreads();
#pragma unroll
  for (int i = 0; i < 4; ++i) {
    int idx = tid + 256 * i;
    int lo = idx >> 4, c4 = idx & 15;
    int row = dir ? row0 + 63 - lo : row0 + lo;
    f32x4 q = *(const f32x4*)(sQ + lo * 68 + c4 * 4);
    f32x4 bb = *(const f32x4*)(sB + lo * 68 + c4 * 4);
    u32x2 o;
    o.x = pack2(q.x * ex2(bb.x), q.y * ex2(bb.y));
    o.y = pack2(q.z * ex2(bb.z), q.w * ex2(bb.w));
    *(u32x2*)(QE + (size_t)row * 256 + h * 64 + c4 * 4) = o;
  }
  {
    const int I = w;
    bf16x8 qs[2];
    f32x4 rr[2][2];
#pragma unroll
    for (int s = 0; s < 2; ++s) {
      const int kk0 = s * 32 + q4 * 8;
      if (I > 0) {
        rr[s][0] = *(const f32x4*)(sB + (16 * I - 1) * 68 + kk0);
        rr[s][1] = *(const f32x4*)(sB + (16 * I - 1) * 68 + kk0 + 4);
      } else {
        rr[s][0] = f32x4{0.f, 0.f, 0.f, 0.f};
        rr[s][1] = rr[s][0];
      }
      const float* qr = sQ + (16 * I + l16) * 68 + kk0;
      const float* br = sB + (16 * I + l16) * 68 + kk0;
      f32x4 q0 = *(const f32x4*)qr, q1 = *(const f32x4*)(qr + 4);
      f32x4 b0 = *(const f32x4*)br, b1 = *(const f32x4*)(br + 4);
      u32x4 pu;
      pu.x = pack2(q0.x * ex2(b0.x - rr[s][0].x), q0.y * ex2(b0.y - rr[s][0].y));
      pu.y = pack2(q0.z * ex2(b0.z - rr[s][0].z), q0.w * ex2(b0.w - rr[s][0].w));
      pu.z = pack2(q1.x * ex2(b1.x - rr[s][1].x), q1.y * ex2(b1.y - rr[s][1].y));
      pu.w = pack2(q1.z * ex2(b1.z - rr[s][1].z), q1.w * ex2(b1.w - rr[s][1].w));
      qs[s] = __builtin_bit_cast(bf16x8, pu);
    }
    f32x4 at[4];
#pragma unroll
    for (int J = 0; J < 4; ++J) {
      at[J] = f32x4{0.f, 0.f, 0.f, 0.f};
      if (J <= I) {
#pragma unroll
        for (int s = 0; s < 2; ++s) {
          const int kk0 = s * 32 + q4 * 8;
          const float* kr = sK + (16 * J + l16) * 68 + kk0;
          const float* br = sB + (16 * J + l16) * 68 + kk0;
          f32x4 k0 = *(const f32x4*)kr, k1 = *(const f32x4*)(kr + 4);
          f32x4 b0 = *(const f32x4*)br, b1 = *(const f32x4*)(br + 4);
          u32x4 pu;
          pu.x = pack2(k0.x * ex2(fminf(rr[s][0].x - b0.x, 100.f)), k0.y * ex2(fminf(rr[s][0].y - b0.y, 100.f)));
          pu.y = pack2(k0.z * ex2(fminf(rr[s][0].z - b0.z, 100.f)), k0.w * ex2(fminf(rr[s][0].w - b0.w, 100.f)));
          pu.z = pack2(k1.x * ex2(fminf(rr[s][1].x - b1.x, 100.f)), k1.y * ex2(fminf(rr[s][1].y - b1.y, 100.f)));
          pu.w = pack2(k1.z * ex2(fminf(rr[s][1].z - b1.z, 100.f)), k1.w * ex2(fminf(rr[s][1].w - b1.w, 100.f)));
          bf16x8 kf = __builtin_bit_cast(bf16x8, pu);
          at[J] = MFMA16(kf, qs[s], at[J]);
        }
        if (J == I) {
#pragma unroll
          for (int r = 0; r < 4; ++r)
            if (q4 * 4 + r > l16) at[J][r] = 0.f;
        }
      }
    }
    f32x4 oc[4];
#pragma unroll
    for (int vt = 0; vt < 4; ++vt) oc[vt] = f32x4{0.f, 0.f, 0.f, 0.f};
#pragma unroll
    for (int ks = 0; ks < 2; ++ks) {
      if (2 * ks <= I) {
        u32x4 pu;
        pu.x = pack2(at[2 * ks][0], at[2 * ks][1]);
        pu.y = pack2(at[2 * ks][2], at[2 * ks][3]);
        pu.z = pack2(at[2 * ks + 1][0], at[2 * ks + 1][1]);
        pu.w = pack2(at[2 * ks + 1][2], at[2 * ks + 1][3]);
        bf16x8 pf = __builtin_bit_cast(bf16x8, pu);
#pragma unroll
        for (int vt = 0; vt < 4; ++vt) {
          const u16* vp = sVT + (vt * 16 + l16) * 72 + ks * 32 + q4 * 4;
          u32x2 v0 = *(const u32x2*)vp;
          u32x2 v1 = *(const u32x2*)(vp + 16);
          u32x4 vu = {v0.x, v0.y, v1.x, v1.y};
          oc[vt] = MFMA16(__builtin_bit_cast(bf16x8, vu), pf, oc[vt]);
        }
      }
    }
    {
      const int t = 16 * I + l16;
      const int row = dir ? row0 + 63 - t : row0 + t;
#pragma unroll
      for (int vt = 0; vt < 4; ++vt) *(f32x4*)(OI + (size_t)row * 256 + h * 64 + vt * 16 + q4 * 4) = oc[vt];
    }
  }
  {
    const int k = 16 * w + l16;
    const float bend = sB[63 * 68 + k];
    f32x4 kc[4];
#pragma unroll
    for (int vt = 0; vt < 4; ++vt) kc[vt] = f32x4{0.f, 0.f, 0.f, 0.f};
#pragma unroll
    for (int ks = 0; ks < 2; ++ks) {
      float kd[8];
#pragma unroll
      for (int j = 0; j < 8; ++j) {
        const int s = ks * 32 + q4 * 8 + j;
        kd[j] = sK[s * 68 + k] * ex2(bend - sB[s * 68 + k]);
      }
      u32x4 pu;
      pu.x = pack2(kd[0], kd[1]);
      pu.y = pack2(kd[2], kd[3]);
      pu.z = pack2(kd[4], kd[5]);
      pu.w = pack2(kd[6], kd[7]);
      bf16x8 af = __builtin_bit_cast(bf16x8, pu);
#pragma unroll
      for (int vt = 0; vt < 4; ++vt) {
        bf16x8 vf = *(const bf16x8*)(sVT + (vt * 16 + l16) * 72 + ks * 32 + q4 * 8);
        kc[vt] = MFMA16(af, vf, kc[vt]);
      }
    }
#pragma unroll
    for (int vt = 0; vt < 4; ++vt)
#pragma unroll
      for (int r = 0; r < 4; ++r) KV[(16 * w + q4 * 4 + r) * 64 + vt * 16 + l16] = kc[vt][r];
    if (q4 == 0) DEC[k] = ex2(bend);
  }
}

DI void h2_item(const P& p, int li, int item, char* smem) {
  const int tid = ltid(), ty = tid >> 4, tx = tid & 15;
  const int lane = tid & 63, w = tid >> 6, l16 = lane & 15, q4 = lane >> 4;
  const int h = item & 3, tc = item >> 2, row0 = tc * 64;
  const bool lat = tc >= 64;
  int seq, cl, nc;
  if (!lat) { seq = tc >> 2; cl = tc & 3; nc = 4; } else { seq = (tc - 64) >> 4; cl = (tc - 64) & 15; nc = 16; }
  const int tcbase = tc - cl;
  u16* sST = (u16*)smem;
  const float* KVb = (const float*)(p.ws + O_KV);
  const float* DECb = (const float*)(p.ws + O_DEC);
  __syncthreads();
#pragma unroll 1
  for (int dir = 0; dir < 2; ++dir) {
    float4 S[4];
#pragma unroll
    for (int a = 0; a < 4; ++a) {
      if (lat) S[a] = *(const float4*)(p.in[6 + dir] + ((size_t)((seq * 2 + li) * 4 + h) * 64 + ty + 16 * a) * 64 + tx * 4);
      else S[a] = make_float4(0.f, 0.f, 0.f, 0.f);
    }
    const int nprev = dir == 0 ? cl : nc - 1 - cl;
#pragma unroll 1
    for (int j = 0; j < nprev; ++j) {
      int tcj = tcbase + (dir == 0 ? j : nc - 1 - j);
      size_t itj = (size_t)((tcj * 4 + h) * 2 + dir);
#pragma unroll
      for (int a = 0; a < 4; ++a) {
        int k = ty + 16 * a;
        float dcy = DECb[itj * 64 + k];
        float4 kv = *(const float4*)(KVb + itj * 4096 + k * 64 + tx * 4);
        S[a].x = dcy * S[a].x + kv.x; S[a].y = dcy * S[a].y + kv.y; S[a].z = dcy * S[a].z + kv.z; S[a].w = dcy * S[a].w + kv.w;
      }
    }
    if (!lat && nprev == nc - 1) {
      size_t itj = (size_t)((tc * 4 + h) * 2 + dir);
      float* so = p.out + (dir == 0 ? OUT_SF : OUT_SB) + (size_t)((seq * 2 + li) * 4 + h) * 4096;
#pragma unroll
      for (int a = 0; a < 4; ++a) {
        int k = ty + 16 * a;
        float dcy = DECb[itj * 64 + k];
        float4 kv = *(const float4*)(KVb + itj * 4096 + k * 64 + tx * 4);
        *(float4*)(so + k * 64 + tx * 4) = make_float4(dcy * S[a].x + kv.x, dcy * S[a].y + kv.y, dcy * S[a].z + kv.z, dcy * S[a].w + kv.w);
      }
    }
    u16* st = sST + dir * 64 * 72;
#pragma unroll
    for (int a = 0; a < 4; ++a) {
      int k = ty + 16 * a;
      st[(tx * 4 + 0) * 72 + k] = f2bf(S[a].x);
      st[(tx * 4 + 1) * 72 + k] = f2bf(S[a].y);
      st[(tx * 4 + 2) * 72 + k] = f2bf(S[a].z);
      st[(tx * 4 + 3) * 72 + k] = f2bf(S[a].w);
    }
  }
  __syncthreads();
  f32x4 oc[4];
#pragma unroll
  for (int vt = 0; vt < 4; ++vt) oc[vt] = f32x4{0.f, 0.f, 0.f, 0.f};
#pragma unroll
  for (int dir = 0; dir < 2; ++dir) {
    const u16* QE = (const u16*)(p.ws + O_QE) + (size_t)dir * NTOK * 256 + (size_t)(row0 + 16 * w + l16) * 256 + h * 64 + q4 * 8;
    const u16* st = sST + dir * 64 * 72;
#pragma unroll
    for (int ks = 0; ks < 2; ++ks) {
      bf16x8 af = *(const bf16x8*)(QE + ks * 32);
#pragma unroll
      for (int vt = 0; vt < 4; ++vt) {
        bf16x8 bf = *(const bf16x8*)(st + (vt * 16 + l16) * 72 + ks * 32 + q4 * 8);
        oc[vt] = MFMA16(af, bf, oc[vt]);
      }
    }
  }
  const float* OI0 = (const float*)(p.ws + O_OI);
  const float* OI1 = OI0 + (size_t)NTOK * 256;
  const float* HSG = (const float*)(p.ws + O_HSG);
  u16* mixed = (u16*)(p.ws + O_MIXED);
  float gn[4];
#pragma unroll
  for (int vt = 0; vt < 4; ++vt) gn[vt] = p.in[21][li * 64 + vt * 16 + l16];
  float oi[4][4], sgv[4][4];
#pragma unroll
  for (int r = 0; r < 4; ++r) {
    const size_t off = (size_t)(row0 + 16 * w + q4 * 4 + r) * 256 + h * 64 + l16;
#pragma unroll
    for (int vt = 0; vt < 4; ++vt) {
      oi[r][vt] = OI0[off + vt * 16] + OI1[off + vt * 16];
      sgv[r][vt] = HSG[off + vt * 16];
    }
  }
#pragma unroll
  for (int r = 0; r < 4; ++r) {
    const int row = row0 + 16 * w + q4 * 4 + r;
    float val[4];
    float ss = 0.f;
#pragma unroll
    for (int vt = 0; vt < 4; ++vt) {
      val[vt] = oc[vt][r] + oi[r][vt];
      ss += val[vt] * val[vt];
    }
    ss = red16(ss);
    const float rs = rsqrtf(ss * (1.f / 64.f) + 1e-6f);
#pragma unroll
    for (int vt = 0; vt < 4; ++vt)
      mixed[(size_t)row * 1024 + 512 + h * 64 + vt * 16 + l16] = f2bf(val[vt] * rs * gn[vt] * sgv[r][vt]);
  }
}

DI void ln_apply(const P& p, const float* lo, const float* hi, const float* stats, const float* lng, const float* lnb,
                 const float* mods, int sc_off, int sh_off) {
  const int lane = ltid() & 63, wid = ltid() >> 6;
  u16* dst = (u16*)(p.ws + O_ABF);
  for (int it = blockIdx.x; it < NTOK / 4; it += gridDim.x) {
    const int row = it * 4 + wid;
    float mu = 0.f, rs = 1.f;
    if (stats != nullptr) {
      float s1 = 0.f, s2 = 0.f;
      if (lane < 16) {
        float2 v = *(const float2*)(stats + (size_t)row * 32 + lane * 2);
        s1 = v.x;
        s2 = v.y;
      }
#pragma unroll
      for (int s = 1; s < 16; s <<= 1) { s1 += shx(s1, s); s2 += shx(s2, s); }
      s1 = __shfl(s1, 0, 64);
      s2 = __shfl(s2, 0, 64);
      mu = s1 * (1.f / 1024.f);
      rs = rsqrtf(fmaxf(s2 * (1.f / 1024.f) - mu * mu, 0.f) + 1e-6f);
    }
    const float* x = row < NCTX ? lo + (size_t)row * 1024 : hi + (size_t)(row - NCTX) * 1024;
    const int rtype = row < NCTX ? 0 : 1 + ((row - NCTX) >> 10);
    const float* mv = mods + rtype * 6144;
    f32x4 xv[4], scv[4], shv[4], ggv[4], bbv[4];
#pragma unroll
    for (int i = 0; i < 4; ++i) {
      const int c = (lane + 64 * i) * 4;
      xv[i] = *(const f32x4*)(x + c);
      scv[i] = *(const f32x4*)(mv + sc_off + c);
      shv[i] = *(const f32x4*)(mv + sh_off + c);
      if (stats != nullptr) {
        ggv[i] = *(const f32x4*)(lng + c);
        bbv[i] = *(const f32x4*)(lnb + c);
      }
    }
#pragma unroll
    for (int i = 0; i < 4; ++i) {
      const int c = (lane + 64 * i) * 4;
      f32x4 v = xv[i];
      f32x4 sc = scv[i] + 1.f;
      f32x4 sh = shv[i];
      if (stats != nullptr) v = (v - mu) * rs * ggv[i] + bbv[i];
      v = v * sc + sh;
      u32x2 o;
      o.x = pack2(v.x, v.y);
      o.y = pack2(v.z, v.w);
      *(u32x2*)(dst + (size_t)row * 1024 + c) = o;
    }
  }
}

DI void final_ln(const P& p) {
  const int lane = ltid() & 63, wid = ltid() >> 6;
  const float* X = (const float*)(p.ws + O_XPRE2);
  const float* ST = (const float*)(p.ws + O_ST2);
  const float* g = p.in[26] + 1024;
  const float* bb = p.in[27] + 1024;
  for (int it = blockIdx.x; it < NTOK / 4; it += gridDim.x) {
    int row = it * 4 + wid;
    float s1 = 0.f, s2 = 0.f;
    if (lane < 16) {
      float2 v = *(const float2*)(ST + (size_t)row * 32 + lane * 2);
      s1 = v.x;
      s2 = v.y;
    }
#pragma unroll
    for (int s = 1; s < 16; s <<= 1) { s1 += shx(s1, s); s2 += shx(s2, s); }
    s1 = __shfl(s1, 0, 64);
    s2 = __shfl(s2, 0, 64);
    float mu = s1 * (1.f / 1024.f);
    float rs = rsqrtf(fmaxf(s2 * (1.f / 1024.f) - mu * mu, 0.f) + 1e-6f);
    float* out = p.out + (row < NCTX ? OUT_YP + (size_t)row * 1024 : OUT_YS + (size_t)(row - NCTX) * 1024);
    float4 xv[4], gv[4], bv[4];
#pragma unroll
    for (int i = 0; i < 4; ++i) {
      int c = (lane + 64 * i) * 4;
      xv[i] = *(const float4*)(X + (size_t)row * 1024 + c);
      gv[i] = *(const float4*)(g + c);
      bv[i] = *(const float4*)(bb + c);
    }
#pragma unroll
    for (int i = 0; i < 4; ++i) {
      int c = (lane + 64 * i) * 4;
      float4 x = xv[i];
      float4 gg = gv[i];
      float4 b4 = bv[i];
      *(float4*)(out + c) = make_float4((x.x - mu) * rs * gg.x + b4.x, (x.y - mu) * rs * gg.y + b4.y,
                                         (x.z - mu) * rs * gg.z + b4.z, (x.w - mu) * rs * gg.w + b4.w);
    }
  }
}

DI void run_phase(const P& p, int ph, char* smem, int sub = 0) {
  if (ph == 0) { phase0(p, smem); return; }
  if (ph == NPHASE - 1) { final_ln(p); return; }
  const int li = (ph - 1) >> 3, s = (ph - 1) & 7;
  float* XPRE1 = (float*)(p.ws + O_XPRE1);
  float* XPRE2 = (float*)(p.ws + O_XPRE2);
  float* ST1 = (float*)(p.ws + O_ST1);
  float* ST2 = (float*)(p.ws + O_ST2);
  GA g;
  g.mods = (const float*)(p.ws + O_MODS) + li * 3 * 6144;
  g.a16 = (const u16*)(p.ws + O_ABF); g.xout = nullptr; g.sout = nullptr; g.hid = nullptr;
  g.alo = nullptr; g.ahi = nullptr; g.stats = nullptr; g.lng = nullptr; g.lnb = nullptr; g.sc_off = 0; g.sh_off = 0;
  const float* xin_lo = li == 0 ? p.in[0] : XPRE2;
  const float* xin_hi = li == 0 ? p.in[1] : XPRE2 + (size_t)NCTX * 1024;
  const float* xin_st = li == 0 ? nullptr : ST2;
  const float* xin_g = p.in[26] + (li == 0 ? 0 : (li - 1) * 1024);
  const float* xin_b = p.in[27] + (li == 0 ? 0 : (li - 1) * 1024);
  if (s == 0) {
    ln_apply(p, xin_lo, xin_hi, xin_st, xin_g, xin_b, g.mods, 1024, 0);
  } else if (s == 1) {
    g.bt = (const u16*)(p.ws + O_WTIN) + (size_t)li * NIN * D; g.K = D; g.N = NIN;
    gemm_phase<0>(p, g, li, smem);
  } else if (s == 2) {
    if (gridDim.x == 512 && sub == 0) {
      const int b = blockIdx.x;
      if (b < 128) {
        attnA_item(p, li, b, smem);
      } else if (b < 192) {
        attnC_item(p, li, b - 128, smem);
        h1_item(p, b - 128, smem);
      } else {
        const int j = b - 192;
        h1_item(p, 64 + j, smem);
        h1_item(p, 64 + 320 + j, smem);
        if (j < 64) h1_item(p, 64 + 640 + j, smem);
        else attnA_item(p, li, 128 + (j - 64), smem);
      }
    } else {
      const int it_lo = sub == 2 ? 128 : (sub == 3 ? 192 : (sub == 4 ? 960 : 0)), it_hi = sub == 1 ? 128 : (sub == 2 ? 192 : (sub == 3 ? 960 : 1216));
      for (int it = it_lo + blockIdx.x; it < it_hi; it += gridDim.x) {
        if (it >= 192 && it < 960) h1_item(p, it - 192, smem);
        else if (it >= 128 && it < 192) attnC_item(p, li, it - 128, smem);
        else attnA_item(p, li, it < 128 ? it : it - 832, smem);
      }
    }
  } else if (s == 3) {
    for (int it = blockIdx.x; it < 512; it += gridDim.x) {
      if (it < 384) h2_item(p, li, it, smem);
      else attnC_item(p, li, it - 384 + 64, smem);
    }
  } else if (s == 4) {
    g.alo = xin_lo; g.ahi = xin_hi; g.stats = xin_st; g.lng = xin_g; g.lnb = xin_b;
    g.sc_off = 2048;
    g.a16 = (const u16*)(p.ws + O_MIXED);
    g.bt = (const u16*)(p.ws + O_WTOUT) + (size_t)li * D * D; g.K = D; g.N = D;
    g.xout = XPRE1; g.sout = ST1;
    gemm_phase<1, 3>(p, g, li, smem);
  } else if (s == 5) {
    ln_apply(p, XPRE1, XPRE1 + (size_t)NCTX * 1024, ST1, p.in[24] + li * 1024, p.in[25] + li * 1024, g.mods, 4096, 3072);
  } else if (s == 6) {
    g.bt = (const u16*)(p.ws + O_WTFF1) + (size_t)li * DFF * D; g.K = D; g.N = DFF;
    g.hid = (u16*)(p.ws + O_HID);
    gemm_phase<2>(p, g, li, smem);
  } else {
    g.alo = XPRE1; g.ahi = XPRE1 + (size_t)NCTX * 1024; g.stats = ST1; g.lng = p.in[24] + li * 1024; g.lnb = p.in[25] + li * 1024;
    g.sc_off = 5120;
    g.a16 = (const u16*)(p.ws + O_HID);
    g.bt = (const u16*)(p.ws + O_WTFF2) + (size_t)li * D * DFF; g.K = DFF; g.N = D;
    g.xout = XPRE2; g.sout = ST2;
    gemm_phase<1, 3>(p, g, li, smem);
  }
}

#define XB_TMO      128
#define XB_XCNT(j)  (256  + 64 * (j))
#define XB_XSUB(j)  (1280 + 64 * (j))
#define XB_XGEN(j)  (2304 + 64 * (j))
#define XB_TOP      3328
#define XB_TOPGEN   3392
#define XCD_BAR_WORDS 3456
#define XB_SPIN_CAP (1u << 20)
#define LAS __attribute__((address_space(3)))
DI unsigned xb_ld(unsigned* p) { return __hip_atomic_load(p, __ATOMIC_RELAXED, __HIP_MEMORY_SCOPE_AGENT); }
DI unsigned xb_add(unsigned* p, unsigned v) { return __hip_atomic_fetch_add(p, v, __ATOMIC_RELAXED, __HIP_MEMORY_SCOPE_AGENT); }
DI unsigned xb_xcc_id() { return (unsigned)__builtin_amdgcn_s_getreg((3 << 11) | 20) & 0xFu; }
#define XB_SPIN(cond, bar) do { unsigned _sp = 0; while (cond) { __builtin_amdgcn_s_sleep(1); \
    if ((++_sp & 255u) == 0u) { if (xb_ld(&(bar)[XB_TMO])) break; if (_sp > XB_SPIN_CAP) { atomicAdd(&(bar)[XB_TMO], 1u); break; } } } } while (0)
struct XcdBarrier { unsigned* bar; unsigned x; volatile LAS unsigned* st; };
DI XcdBarrier xcd_barrier_post(unsigned* bar, volatile LAS unsigned* st) {
  XcdBarrier b; b.bar = bar; b.x = xb_xcc_id(); b.st = st;
  if (threadIdx.x == 0) (void)xb_add(&bar[XB_XCNT(b.x)], 1u);
  return b;
}
DI void xcd_barrier_complete(unsigned* bar, unsigned x, unsigned& nloc, unsigned& nx) {
  const unsigned G = gridDim.x * gridDim.y * gridDim.z;
  unsigned sum, cnt, mine, sp = 0u;
  for (;;) {
    sum = 0u; cnt = 0u; mine = 0u;
#pragma unroll
    for (unsigned j = 0; j < 16; ++j) { const unsigned c = xb_ld(&bar[XB_XCNT(j)]); sum += c; cnt += (c > 0u) ? 1u : 0u; mine = (j == x) ? c : mine; }
    if (sum == G) break;
    __builtin_amdgcn_s_sleep(1);
    if ((++sp & 255u) == 0u) { if (xb_ld(&bar[XB_TMO])) break; if (sp > XB_SPIN_CAP) { atomicAdd(&bar[XB_TMO], 1u); break; } }
  }
  nloc = mine > 0u ? mine : 1u; nx = cnt > 0u ? cnt : 1u;
}
DI void xcd_barrier(const XcdBarrier& b) {
  asm volatile("s_waitcnt vmcnt(0)" ::: "memory");
  __syncthreads();
  if (threadIdx.x == 0) {
    unsigned* bar = b.bar;
    __builtin_amdgcn_s_waitcnt(0);
    unsigned nloc = b.st[0], nx = b.st[1];
    if (nloc == 0u) { xcd_barrier_complete(bar, b.x, nloc, nx); b.st[0] = nloc; b.st[1] = nx; }
    const unsigned old = xb_add(&bar[XB_XSUB(b.x)], 1u);
    const unsigned gen = old / nloc;
    if (old + 1u == (gen + 1u) * nloc) {
      __builtin_amdgcn_fence(__ATOMIC_RELEASE, "agent");
      asm volatile("s_waitcnt vmcnt(0)" ::: "memory");
      const unsigned og = xb_add(&bar[XB_TOP], 1u);
      const unsigned tg = og / nx;
      if (og + 1u == (tg + 1u) * nx) xb_add(&bar[XB_TOPGEN], 1u);
      else XB_SPIN(xb_ld(&bar[XB_TOPGEN]) == tg, bar);
      __builtin_amdgcn_fence(__ATOMIC_ACQUIRE, "agent");
      xb_add(&bar[XB_XGEN(b.x)], 1u);
      asm volatile("s_waitcnt vmcnt(0)" ::: "memory");
    } else {
      XB_SPIN(xb_ld(&bar[XB_XGEN(b.x)]) == gen, bar);
      __builtin_amdgcn_fence(__ATOMIC_ACQUIRE, "agent");
      asm volatile("s_waitcnt vmcnt(0)" ::: "memory");
    }
  }
  __syncthreads();
}
constexpr size_t O_BAR = O_END1;
static_assert(O_BAR + XCD_BAR_WORDS * 4 <= (size_t)256 * 1024 * 1024, "barrier words must fit");

#if !MULTI_LAUNCH
__global__ void __launch_bounds__(256, 2) mega_kernel(P p) {
  extern __shared__ __attribute__((aligned(16))) char smem[];
  cg::grid_group grid = cg::this_grid();
  if (p.ws == nullptr) grid.sync();
  if (threadIdx.x == 0) *(uint4*)(smem + LDS_BYTES - 16) = make_uint4(0u, 0u, 0u, 0u);
  __syncthreads();
  XcdBarrier xb = xcd_barrier_post((unsigned*)(p.ws + O_BAR), (volatile LAS unsigned*)(smem + LDS_BYTES - 16));
  run_phase(p, 0, smem); xcd_barrier(xb);
  run_phase(p, 1, smem); xcd_barrier(xb);
  run_phase(p, 2, smem); xcd_barrier(xb);
  run_phase(p, 3, smem); xcd_barrier(xb);
  run_phase(p, 4, smem); xcd_barrier(xb);
  run_phase(p, 5, smem); xcd_barrier(xb);
  run_phase(p, 6, smem); xcd_barrier(xb);
  run_phase(p, 7, smem); xcd_barrier(xb);
  run_phase(p, 8, smem); xcd_barrier(xb);
  run_phase(p, 9, smem); xcd_barrier(xb);
  run_phase(p, 10, smem); xcd_barrier(xb);
  run_phase(p, 11, smem); xcd_barrier(xb);
  run_phase(p, 12, smem); xcd_barrier(xb);
  run_phase(p, 13, smem); xcd_barrier(xb);
  run_phase(p, 14, smem); xcd_barrier(xb);
  run_phase(p, 15, smem); xcd_barrier(xb);
  run_phase(p, 16, smem); xcd_barrier(xb);
  run_phase(p, 17, smem);
}
#define MAIN_KERNEL mega_kernel
#else
template <int PH>
__global__ void __launch_bounds__(256, 2) phase_kernel(P p, int sub) {
  extern __shared__ __attribute__((aligned(16))) char smem[];
  run_phase(p, PH, smem, sub);
}
typedef void (*phase_fn)(P, int);
static phase_fn phase_table[NPHASE] = {phase_kernel<0>, phase_kernel<1>, phase_kernel<2>, phase_kernel<3>, phase_kernel<4>, phase_kernel<5>,
                                       phase_kernel<6>, phase_kernel<7>, phase_kernel<8>, phase_kernel<9>, phase_kernel<10>, phase_kernel<11>,
                                       phase_kernel<12>, phase_kernel<13>, phase_kernel<14>, phase_kernel<15>, phase_kernel<16>, phase_kernel<17>};
#define MAIN_KERNEL phase_kernel<2>
#endif

extern "C" void kernel_launch(void* const* d_in, const int* in_sizes, int n_in, void* d_out, int out_size, void* d_ws,
                              size_t ws_size, hipStream_t stream) {
  static int grid_blocks = 0;
  if (!grid_blocks) {
    int dev = 0, cus = 0, per_cu = 0;
    (void)hipGetDevice(&dev);
    (void)hipDeviceGetAttribute(&cus, hipDeviceAttributeMultiprocessorCount, dev);
    (void)hipFuncSetAttribute((const void*)MAIN_KERNEL, hipFuncAttributeMaxDynamicSharedMemorySize, LDS_BYTES);
    (void)hipOccupancyMaxActiveBlocksPerMultiprocessor(&per_cu, MAIN_KERNEL, 256, LDS_BYTES);
    if (per_cu > 2) per_cu = 2;
    if (per_cu < 1) per_cu = 1;
    grid_blocks = cus * per_cu;
  }
  P p{};
  for (int i = 0; i < 30; ++i) p.in[i] = (const float*)d_in[i];
  p.out = (float*)d_out;
  p.ws = (char*)d_ws;
#if MULTI_LAUNCH
  for (int ph = 0; ph < NPHASE; ++ph) {
    (void)hipFuncSetAttribute((const void*)phase_table[ph], hipFuncAttributeMaxDynamicSharedMemorySize, LDS_BYTES);
    phase_table[ph]<<<dim3(grid_blocks), dim3(256), LDS_BYTES, stream>>>(p, 0);
#ifdef DUP_MASK
    int bit = (ph == 0) ? 8 : (ph == NPHASE - 1 ? 9 : (ph - 1) & 7);
    if ((DUP_MASK >> bit) & 1) phase_table[ph]<<<dim3(grid_blocks), dim3(256), LDS_BYTES, stream>>>(p, DUP_SUB);
#endif
  }
#else
  (void)hipMemsetAsync((char*)d_ws + O_BAR, 0, XCD_BAR_WORDS * 4, stream);
  void* args[] = {&p};
  hipError_t e = hipLaunchCooperativeKernel((void*)mega_kernel, dim3(grid_blocks), dim3(256), args, LDS_BYTES, stream);
  if (e != hipSuccess) fprintf(stderr, "cooperative launch failed: %s (grid %d)\n", hipGetErrorString(e), grid_blocks);
#endif
}
```

```cpp
#include <hip/hip_runtime.h>
#include <hip/hip_cooperative_groups.h>
#include <stdint.h>
#include <stdio.h>
namespace cg = cooperative_groups;

#ifndef MULTI_LAUNCH
#define MULTI_LAUNCH 0
#endif

#define DI __device__ __forceinline__
typedef unsigned short u16;
using bf16x8 = __attribute__((ext_vector_type(8))) short;
using f32x4 = __attribute__((ext_vector_type(4))) float;
typedef __bf16 bf2_t __attribute__((ext_vector_type(2)));
typedef float f2_t __attribute__((ext_vector_type(2)));
typedef unsigned u32x4 __attribute__((ext_vector_type(4)));
typedef unsigned u32x2 __attribute__((ext_vector_type(2)));

constexpr int D = 1024, NTOK = 6144, NCTX = 4096, NIN = 3328, DFF = 4096;
constexpr float ALPHA = 1.41421356237309515f;
constexpr float LOG2E = 1.44269504088896341f;
constexpr int LDS_BYTES = 75776;
constexpr int NPHASE = 18;

constexpr size_t O_WTIN = 0;
constexpr size_t O_WTOUT = O_WTIN + (size_t)2 * NIN * D * 2;
constexpr size_t O_WTFF1 = O_WTOUT + (size_t)2 * D * D * 2;
constexpr size_t O_WTFF2 = O_WTFF1 + (size_t)2 * DFF * D * 2;
constexpr size_t O_MODS = O_WTFF2 + (size_t)2 * D * DFF * 2;
constexpr size_t O_ROPE = O_MODS + (size_t)2 * 3 * 6144 * 4;
constexpr size_t O_QA = O_ROPE + (size_t)1024 * 32 * 2 * 4;
constexpr size_t O_KACTX = O_QA + (size_t)NTOK * 512 * 2;
constexpr size_t O_KALAT = O_KACTX + (size_t)NCTX * 512 * 2;
constexpr size_t O_VTACTX = O_KALAT + (size_t)2 * 2 * 1536 * 512 * 2;
constexpr size_t O_VTALAT = O_VTACTX + (size_t)16 * 4 * 128 * 256 * 2;
constexpr size_t O_QC = O_VTALAT + (size_t)2 * 2 * 4 * 128 * 1536 * 2;
constexpr size_t O_KCCTX = O_QC + (size_t)NTOK * 256 * 2;
constexpr size_t O_KCLAT = O_KCCTX + (size_t)NCTX * 128 * 2;
constexpr size_t O_VTCCTX = O_KCLAT + (size_t)2 * 2 * 1536 * 128 * 2;
constexpr size_t O_VTCLAT = O_VTCCTX + (size_t)16 * 2 * 64 * 256 * 2;
constexpr size_t O_KV = O_VTCLAT + (size_t)2 * 2 * 2 * 64 * 1536 * 2;
constexpr size_t O_DEC = O_KV + (size_t)768 * 4096 * 4;
constexpr size_t O_MIXED = O_DEC + (size_t)768 * 64 * 4;
constexpr size_t O_XPRE1 = O_MIXED + (size_t)NTOK * 1024 * 2;
constexpr size_t O_ST1 = O_XPRE1 + (size_t)NTOK * 1024 * 4;
constexpr size_t O_XPRE2 = O_ST1 + (size_t)NTOK * 32 * 4;
constexpr size_t O_ST2 = O_XPRE2 + (size_t)NTOK * 1024 * 4;
constexpr size_t O_ABF = O_ST2 + (size_t)NTOK * 32 * 4;
constexpr size_t O_HQ = O_ABF + (size_t)NTOK * 1024 * 2;
constexpr size_t O_HGF = O_HQ + (size_t)NTOK * 256 * 4;
constexpr size_t O_HGB = O_HGF + (size_t)NTOK * 256 * 4;
constexpr size_t O_HI = O_HGB + (size_t)NTOK * 256 * 4;
constexpr size_t O_HSG = O_HI + (size_t)NTOK * 256 * 4;
constexpr size_t O_OI = O_HSG + (size_t)NTOK * 256 * 4;
constexpr size_t O_QE = O_OI + (size_t)2 * NTOK * 256 * 4;
constexpr size_t O_END1 = O_QE + (size_t)2 * NTOK * 256 * 4;
constexpr size_t O_HID = O_HQ;
constexpr size_t O_END2 = O_HID + (size_t)NTOK * 4096 * 2;
static_assert(O_END2 <= O_END1, "HID alias must fit");
static_assert(O_END1 <= (size_t)256 * 1024 * 1024, "workspace too big");

constexpr size_t OUT_YP = 0, OUT_YS = 4194304, OUT_AK = 6291456, OUT_AV = 10485760, OUT_CK = 14680064,
                 OUT_CV = 15728640, OUT_SF = 16777216, OUT_SB = 17301504;

struct P {
  const float* in[30];
  float* out;
  char* ws;
};

DI unsigned pack2(float a, float b) {
  f2_t v = {a, b};
  bf2_t r = __builtin_convertvector(v, bf2_t);
  return __builtin_bit_cast(unsigned, r);
}
DI u16 f2bf(float x) { return (u16)(pack2(x, 0.f) & 0xffffu); }
DI float ex2(float x) { return __builtin_amdgcn_exp2f(x); }
DI float siluf(float x) { return x / (1.f + expf(-x)); }
DI float shx(float v, int m) { return __shfl_xor(v, m, 64); }
DI float red16(float x) {
  x += __builtin_bit_cast(float, __builtin_amdgcn_update_dpp(0, __builtin_bit_cast(int, x), 0xB1, 0xF, 0xF, true));
  x += __builtin_bit_cast(float, __builtin_amdgcn_update_dpp(0, __builtin_bit_cast(int, x), 0x4E, 0xF, 0xF, true));
  x += __builtin_bit_cast(float, __builtin_amdgcn_update_dpp(0, __builtin_bit_cast(int, x), 0x141, 0xF, 0xF, true));
  x += __builtin_bit_cast(float, __builtin_amdgcn_update_dpp(0, __builtin_bit_cast(int, x), 0x140, 0xF, 0xF, true));
  return x;
}
DI float xor1(float x) { return __builtin_bit_cast(float, __builtin_amdgcn_update_dpp(0, __builtin_bit_cast(int, x), 0xB1, 0xF, 0xF, true)); }
DI int ltid() { int t = threadIdx.x; asm volatile("" : "+v"(t)); return t; }
#define MFMA16(a, b, c) __builtin_amdgcn_mfma_f32_16x16x32_bf16((a), (b), (c), 0, 0, 0)

DI void p0_mod(const P& p, int item, char* smem) {
  float* ssilu = (float*)smem;
  float* red = ssilu + 3072;
  const int tid = ltid();
  __syncthreads();
  for (int i = tid; i < 3072; i += 256) {
    int w = i >> 10, k = i & 1023;
    float v = (w == 0) ? p.in[9][k] : p.in[8][(w - 1) * 1024 + k];
    ssilu[i] = siluf(v);
  }
  __syncthreads();
  const int li = item / 96, j0 = (item % 96) * 64;
  const int c4 = tid & 15, kp = tid >> 4;
  const float* W = p.in[10] + (size_t)li * 1024 * 6144 + j0 + c4 * 4;
  float4 a0 = {0, 0, 0, 0}, a1 = a0, a2 = a0;
#pragma unroll 16
  for (int kk = 0; kk < 64; ++kk) {
    int k = kp * 64 + kk;
    float4 w4 = *(const float4*)(W + (size_t)k * 6144);
    float s0 = ssilu[k], s1 = ssilu[1024 + k], s2 = ssilu[2048 + k];
    a0.x += s0 * w4.x; a0.y += s0 * w4.y; a0.z += s0 * w4.z; a0.w += s0 * w4.w;
    a1.x += s1 * w4.x; a1.y += s1 * w4.y; a1.z += s1 * w4.z; a1.w += s1 * w4.w;
    a2.x += s2 * w4.x; a2.y += s2 * w4.y; a2.z += s2 * w4.z; a2.w += s2 * w4.w;
  }
  *(float4*)(red + (kp * 3 + 0) * 64 + c4 * 4) = a0;
  *(float4*)(red + (kp * 3 + 1) * 64 + c4 * 4) = a1;
  *(float4*)(red + (kp * 3 + 2) * 64 + c4 * 4) = a2;
  __syncthreads();
  if (tid < 192) {
    int w = tid >> 6, c = tid & 63;
    float s = p.in[11][li * 6144 + j0 + c];
    for (int q = 0; q < 16; ++q) s += red[(q * 3 + w) * 64 + c];
    ((float*)(p.ws + O_MODS))[(li * 3 + w) * 6144 + j0 + c] = s;
  }
}

DI void p0_rope(const P& p, int item) {
  float* R = (float*)(p.ws + O_ROPE);
  for (int i = ltid(); i < 4096; i += 256) {
    int idx = item * 4096 + i;
    int t = idx >> 5, pp = idx & 31;
    float inv = powf(10000.f, -(float)(pp & 15) / 16.f);
    float pos = (pp < 16) ? (float)(t >> 6) : (float)(t & 63);
    float ang = pos * inv;
    R[idx * 2] = cosf(ang);
    R[idx * 2 + 1] = sinf(ang);
  }
}

DI void p0_copyk(const P& p, int item, bool isA) {
  const int W = isA ? 512 : 128;
  const float* src = isA ? p.in[2] : p.in[4];
  u16* dst = (u16*)(p.ws + (isA ? O_KALAT : O_KCLAT));
  for (int i = 0; i < 4; ++i) {
    size_t e = (size_t)item * 4096 + (size_t)(ltid() + 256 * i) * 4;
    float4 v = *(const float4*)(src + e);
    int c = (int)(e % W);
    size_t r = e / W;
    int pp = (int)(r % 512);
    int bl = (int)(r / 512);
    int b = bl >> 1, li = bl & 1;
    uint2 o;
    o.x = pack2(v.x, v.y);
    o.y = pack2(v.z, v.w);
    *(uint2*)(dst + ((size_t)((li * 2 + b) * 1536 + 1024 + pp)) * W + c) = o;
  }
}

struct TDesc { const float* src; int sstride; u16* dst; int dstride; };

DI TDesc tdesc(const P& p, int t) {
  constexpr int T_IN = 1664, T_OUT = 512, T_FF1 = 2048, T_FF2 = 2048, T_AV = 256;
  TDesc d;
  if (t < T_IN) {
    int li = t / 832, r = t % 832, kt = r / 52, nt = r % 52;
    d.src = p.in[12] + (size_t)li * 1024 * NIN + (size_t)(kt * 64) * NIN + nt * 64; d.sstride = NIN;
    d.dst = (u16*)(p.ws + O_WTIN) + (size_t)li * NIN * 1024 + (size_t)(nt * 64) * 1024 + kt * 64; d.dstride = 1024;
  } else if ((t -= T_IN) < T_OUT) {
    int li = t / 256, r = t % 256, kt = r / 16, nt = r % 16;
    d.src = p.in[13] + (size_t)li * 1024 * 1024 + (size_t)(kt * 64) * 1024 + nt * 64; d.sstride = 1024;
    d.dst = (u16*)(p.ws + O_WTOUT) + (size_t)li * 1024 * 1024 + (size_t)(nt * 64) * 1024 + kt * 64; d.dstride = 1024;
  } else if ((t -= T_OUT) < T_FF1) {
    int li = t / 1024, r = t % 1024, kt = r / 64, nt = r % 64;
    d.src = p.in[28] + (size_t)li * 1024 * DFF + (size_t)(kt * 64) * DFF + nt * 64; d.sstride = DFF;
    d.dst = (u16*)(p.ws + O_WTFF1) + (size_t)li * DFF * 1024 + (size_t)(nt * 64) * 1024 + kt * 64; d.dstride = 1024;
  } else if ((t -= T_FF1) < T_FF2) {
    int li = t / 1024, r = t % 1024, kt = r / 16, nt = r % 16;
    d.src = p.in[29] + (size_t)li * DFF * 1024 + (size_t)(kt * 64) * 1024 + nt * 64; d.sstride = 1024;
    d.dst = (u16*)(p.ws + O_WTFF2) + (size_t)li * 1024 * DFF + (size_t)(nt * 64) * DFF + kt * 64; d.dstride = DFF;
  } else if ((t -= T_FF2) < T_AV) {
    int bl = t / 64, r = t % 64, pt = r / 8, ct = r % 8;
    int b = bl >> 1, li = bl & 1;
    d.src = p.in[3] + ((size_t)bl * 512 + pt * 64) * 512 + ct * 64; d.sstride = 512;
    d.dst = (u16*)(p.ws + O_VTALAT) + ((size_t)(li * 2 + b) * 512 + ct * 64) * 1536 + 1024 + pt * 64; d.dstride = 1536;
  } else {
    t -= T_AV;
    int bl = t / 16, r = t % 16, pt = r / 2, ct = r % 2;
    int b = bl >> 1, li = bl & 1;
    d.src = p.in[5] + ((size_t)bl * 512 + pt * 64) * 128 + ct * 64; d.sstride = 128;
    d.dst = (u16*)(p.ws + O_VTCLAT) + ((size_t)(li * 2 + b) * 128 + ct * 64) * 1536 + 1024 + pt * 64; d.dstride = 1536;
  }
  return d;
}

constexpr int NT_P0 = 832 + 256 + 1024 + 1024 + 320;
constexpr int NT_DEF = 832 + 256 + 1024 + 1024;
DI int tmap(int k, bool deferred) {
  if (!deferred) {
    if (k < 832) return k;
    if (k < 1088) return 1664 + (k - 832);
    if (k < 2112) return 2176 + (k - 1088);
    if (k < 3136) return 4224 + (k - 2112);
    return 6272 + (k - 3136);
  }
  if (k < 832) return 832 + k;
  if (k < 1088) return 1920 + (k - 832);
  if (k < 2112) return 3200 + (k - 1088);
  return 5248 + (k - 2112);
}
DI void run_transposes(const P& p, char* smem, int first, int step, bool deferred, int count_override = -1) {
  const int count = count_override >= 0 ? count_override : (deferred ? NT_DEF : NT_P0);
  float* tl = (float*)smem;
  const int tid = ltid();
  const int lr = tid >> 4, lc4 = tid & 15;
  const int c = tid >> 2, rs = tid & 3;
  int t = first;
  f32x4 v[4];
  TDesc cur;
  if (t < count) {
    cur = tdesc(p, tmap(t, deferred));
#pragma unroll
    for (int i = 0; i < 4; ++i) v[i] = *(const f32x4*)(cur.src + (size_t)(lr + 16 * i) * cur.sstride + lc4 * 4);
  }
  while (t < count) {
    __syncthreads();
#pragma unroll
    for (int i = 0; i < 4; ++i) {
      float* q = tl + (lr + 16 * i) * 65 + lc4 * 4;
      q[0] = v[i].x; q[1] = v[i].y; q[2] = v[i].z; q[3] = v[i].w;
    }
    const int tn = t + step;
    TDesc nxt = cur;
    if (tn < count) {
      nxt = tdesc(p, tmap(tn, deferred));
#pragma unroll
      for (int i = 0; i < 4; ++i) v[i] = *(const f32x4*)(nxt.src + (size_t)(lr + 16 * i) * nxt.sstride + lc4 * 4);
    }
    __syncthreads();
    u32x4 o0, o1;
    {
      const float* q = tl + (rs * 16) * 65 + c;
      o0.x = pack2(q[0 * 65], q[1 * 65]);   o0.y = pack2(q[2 * 65], q[3 * 65]);
      o0.z = pack2(q[4 * 65], q[5 * 65]);   o0.w = pack2(q[6 * 65], q[7 * 65]);
      o1.x = pack2(q[8 * 65], q[9 * 65]);   o1.y = pack2(q[10 * 65], q[11 * 65]);
      o1.z = pack2(q[12 * 65], q[13 * 65]); o1.w = pack2(q[14 * 65], q[15 * 65]);
    }
    u32x4* dp = (u32x4*)(cur.dst + (size_t)c * cur.dstride + rs * 16);
    dp[0] = o0;
    dp[1] = o1;
    cur = nxt;
    t = tn;
  }
}

DI void phase0(const P& p, char* smem) {
  constexpr int N_MOD = 192, N_ROPE = 8, N_AK = 256, N_CK = 64;
  constexpr int B_ROPE = N_MOD, B_AK = B_ROPE + N_ROPE, B_CK = B_AK + N_AK, B_T = B_CK + N_CK;
  constexpr int NTILES = 1664 + 512 + 2048 + 2048 + 256 + 64;
  for (int it = blockIdx.x; it < B_T; it += gridDim.x) {
    if (it < B_ROPE) p0_mod(p, it, smem);
    else if (it < B_AK) p0_rope(p, it - B_ROPE);
    else if (it < B_CK) p0_copyk(p, it - B_AK, true);
    else p0_copyk(p, it - B_CK, false);
  }
  if (gridDim.x == 512) {
    if (blockIdx.x >= 192) run_transposes(p, smem, blockIdx.x - 192, 320, false, 960);
    run_transposes(p, smem, 960 + blockIdx.x, 512, false);
  } else {
    run_transposes(p, smem, blockIdx.x, gridDim.x, false);
  }
}

struct GA {
  const float* alo;
  const float* ahi;
  const float* stats;
  const float* lng;
  const float* lnb;
  const float* mods;
  int sc_off, sh_off;
  const u16* a16;
  const u16* bt;
  int K, N;
  float* xout;
  float* sout;
  u16* hid;
};

DI void epi_inproj(const P& p, int li, f32x4 (&acc)[4][4], int R0, int C0);


template <int EPI, int MI = 4>
DI void gemm_tile(const P& p, const GA& g, int li, int m0, int n0, char* smem, u32x4 (&ra0)[4], u32x4 (&rb0)[4],
                  u32x4 (&ra1)[4], u32x4 (&rb1)[4], bool primed, int nm0, int nn0) {
  static_assert(MI == 4 || EPI == 1, "only the residual epilogue supports 96-row tiles");
  constexpr int WM = MI * 16;
  const int tid = ltid(), lane = tid & 63, wid = tid >> 6, wr = wid >> 1, wc = wid & 1;
  const int l16 = lane & 15, q4 = lane >> 4;
  u16* sA0 = (u16*)smem;
  u16* sB0 = sA0 + 128 * 72;
  u16* sA1 = sB0 + 128 * 72;
  u16* sB1 = sA1 + 128 * 72;
  float2* sStat = (float2*)(smem + 73728);
  const int K = g.K;
  const int rtype = (m0 < NCTX) ? 0 : 1 + ((m0 - NCTX) >> 10);
  const float* modv = g.mods + rtype * 6144;
  const float* fsrc = (m0 < NCTX) ? g.alo + (size_t)m0 * 1024 : g.ahi + (size_t)(m0 - NCTX) * 1024;

  if (!primed) {
    const unsigned goff_ = (unsigned)(tid >> 3) * (unsigned)g.K + (unsigned)(tid & 7) * 8u;
    const u16* ab_ = g.a16 + (size_t)m0 * g.K;
    const u16* bb_ = g.bt + (size_t)n0 * g.K;
#pragma unroll
    for (int i = 0; i < 4; ++i) {
      if (i < MI) ra0[i] = *(const u32x4*)(ab_ + (size_t)(32 * i) * g.K + goff_);
      rb0[i] = *(const u32x4*)(bb_ + (size_t)(32 * i) * g.K + goff_);
    }
    __builtin_amdgcn_sched_barrier(0);
#pragma unroll
    for (int i = 0; i < 4; ++i) {
      if (i < MI) ra1[i] = *(const u32x4*)(ab_ + (size_t)(32 * i) * g.K + 64 + goff_);
      rb1[i] = *(const u32x4*)(bb_ + (size_t)(32 * i) * g.K + 64 + goff_);
    }
    __builtin_amdgcn_sched_barrier(0);
  }
  __syncthreads();
  if constexpr (EPI == 1 || EPI == 3) {
    if (g.stats != nullptr && tid < 2 * WM) {
      const float4* sp = (const float4*)(g.stats + (size_t)(m0 + tid) * 32);
      float s1 = 0.f, s2 = 0.f;
#pragma unroll
      for (int i = 0; i < 8; ++i) {
        float4 v = sp[i];
        s1 += v.x + v.z;
        s2 += v.y + v.w;
      }
      float mu = s1 * (1.f / 1024.f);
      float var = s2 * (1.f / 1024.f) - mu * mu;
      sStat[tid] = make_float2(mu, rsqrtf(fmaxf(var, 0.f) + 1e-6f));
    }
  }

  f32x4 acc[MI][4];
#pragma unroll
  for (int i = 0; i < MI; ++i)
#pragma unroll
    for (int j = 0; j < 4; ++j) acc[i][j] = f32x4{0.f, 0.f, 0.f, 0.f};

  const unsigned goff = (unsigned)(tid >> 3) * (unsigned)K + (unsigned)(tid & 7) * 8u;
  const unsigned loff = (unsigned)(tid >> 3) * 72u + (unsigned)(tid & 7) * 8u;
  const u16* abase = g.a16 + (size_t)m0 * K;
  const u16* bbase = g.bt + (size_t)n0 * K;
#define GLOAD(RA, RB, KT)                                                        \
  _Pragma("unroll") for (int i = 0; i < 4; ++i) {                                \
    if (i < MI) RA[i] = *(const u32x4*)(abase + (size_t)(32 * i) * K + (KT) * 64 + goff); \
    RB[i] = *(const u32x4*)(bbase + (size_t)(32 * i) * K + (KT) * 64 + goff);    \
  }
#define LSTORE(SA, SB, RA, RB)                                                   \
  _Pragma("unroll") for (int i = 0; i < 4; ++i) {                                \
    if (i < MI) *(u32x4*)(SA + 32 * i * 72 + loff) = RA[i];                      \
    *(u32x4*)(SB + 32 * i * 72 + loff) = RB[i];                                  \
  }
#define COMPUTE(SA, SB)                                                          \
  _Pragma("unroll") for (int s = 0; s < 2; ++s) {                                \
    bf16x8 af[MI], bfr[4];                                                       \
    _Pragma("unroll") for (int i = 0; i < 4; ++i) {                              \
      if (i < MI) af[i] = *(const bf16x8*)(SA + (wr * WM + i * 16 + l16) * 72 + s * 32 + q4 * 8);  \
      bfr[i] = *(const bf16x8*)(SB + (wc * 64 + i * 16 + l16) * 72 + s * 32 + q4 * 8); \
    }                                                                            \
    __builtin_amdgcn_s_setprio(1);                                               \
    _Pragma("unroll") for (int i = 0; i < MI; ++i)                               \
      _Pragma("unroll") for (int j = 0; j < 4; ++j) acc[i][j] = MFMA16(af[i], bfr[j], acc[i][j]); \
    __builtin_amdgcn_s_setprio(0);                                               \
    __builtin_amdgcn_sched_barrier(0);                                           \
  }

  const int nk = K >> 6;
#define SB0 __builtin_amdgcn_sched_barrier(0)
  LSTORE(sA0, sB0, ra0, rb0);
  SB0;
  GLOAD(ra0, rb0, 2);
  SB0;
  __syncthreads();
#pragma unroll 1
  for (int kt = 0; kt < nk - 4; kt += 2) {
    SB0;
    LSTORE(sA1, sB1, ra1, rb1);
    SB0;
    GLOAD(ra1, rb1, kt + 3);
    SB0;
    COMPUTE(sA0, sB0);
    __syncthreads();
    SB0;
    LSTORE(sA0, sB0, ra0, rb0);
    SB0;
    GLOAD(ra0, rb0, kt + 4);
    SB0;
    COMPUTE(sA1, sB1);
    __syncthreads();
  }
  SB0;
  LSTORE(sA1, sB1, ra1, rb1);
  SB0;
  GLOAD(ra1, rb1, nk - 1);
  SB0;
  COMPUTE(sA0, sB0);
  __syncthreads();
  const u16* nabase = g.a16 + (size_t)nm0 * K;
  const u16* nbbase = g.bt + (size_t)nn0 * K;
  SB0;
  LSTORE(sA0, sB0, ra0, rb0);
  SB0;
  _Pragma("unroll") for (int i = 0; i < 4; ++i) {
    if (i < MI) ra0[i] = *(const u32x4*)(nabase + (size_t)(32 * i) * K + goff);
    rb0[i] = *(const u32x4*)(nbbase + (size_t)(32 * i) * K + goff);
  }
  SB0;
  COMPUTE(sA1, sB1);
  __syncthreads();
  SB0;
  LSTORE(sA1, sB1, ra1, rb1);
  SB0;
  _Pragma("unroll") for (int i = 0; i < 4; ++i) {
    if (i < MI) ra1[i] = *(const u32x4*)(nabase + (size_t)(32 * i) * K + 64 + goff);
    rb1[i] = *(const u32x4*)(nbbase + (size_t)(32 * i) * K + 64 + goff);
  }
  SB0;
  COMPUTE(sA0, sB0);
  __syncthreads();
  SB0;
  COMPUTE(sA1, sB1);
#undef GLOAD
#undef LSTORE
#undef COMPUTE
#undef SB0
  asm volatile("" ::: "memory");

  const int R0 = m0 + wr * WM, C0 = n0 + wc * 64;
  if constexpr (EPI == 0) {
    if constexpr (MI == 4) epi_inproj(p, li, acc, R0, C0);
  } else if constexpr (EPI == 1) {
    const int rtA = rtype;
    const int mlast = m0 + 2 * WM - 1;
    const int rtB = (mlast < NCTX) ? 0 : 1 + ((mlast - NCTX) >> 10);
    const float* modvB = g.mods + rtB * 6144;
    float gateA[4], gateB[4], lg[4], lb[4];
#pragma unroll
    for (int j = 0; j < 4; ++j) {
      int col = C0 + j * 16 + l16;
      gateA[j] = modv[g.sc_off + col];
      gateB[j] = modvB[g.sc_off + col];
      lg[j] = g.stats ? g.lng[col] : 1.f;
      lb[j] = g.stats ? g.lnb[col] : 0.f;
    }
    float xr[MI][4][4];
#pragma unroll
    for (int i = 0; i < MI; ++i)
#pragma unroll
      for (int r = 0; r < 4; ++r) {
        const int grow = m0 + wr * WM + i * 16 + q4 * 4 + r;
        const float* rp = (grow < NCTX) ? g.alo + (size_t)grow * 1024 : g.ahi + (size_t)(grow - NCTX) * 1024;
#pragma unroll
        for (int j = 0; j < 4; ++j) xr[i][r][j] = rp[C0 + j * 16 + l16];
      }
#pragma unroll
    for (int i = 0; i < MI; ++i) {
#pragma unroll
      for (int r = 0; r < 4; ++r) {
        int lrow = wr * WM + i * 16 + q4 * 4 + r;
        const int grow = m0 + lrow;
        const int rt = (grow < NCTX) ? 0 : 1 + ((grow - NCTX) >> 10);
        const bool useA = (rt == rtA);
        float mu = 0.f, rs = 1.f;
        if (g.stats != nullptr) {
          float2 st = sStat[lrow];
          mu = st.x;
          rs = st.y;
        }
        float s1 = 0.f, s2 = 0.f;
#pragma unroll
        for (int j = 0; j < 4; ++j) {
          int col = C0 + j * 16 + l16;
          float x = xr[i][r][j];
          x = (x - mu) * rs * lg[j] + lb[j];
          float v = ALPHA * x + (useA ? gateA[j] : gateB[j]) * acc[i][j][r];
          g.xout[(size_t)grow * 1024 + col] = v;
          s1 += v;
          s2 += v * v;
        }
        s1 = red16(s1);
        s2 = red16(s2);
        if (l16 == 0) *(float2*)(g.sout + (size_t)grow * 32 + (C0 >> 6) * 2) = make_float2(s1, s2);
      }
    }
  } else {
    float* sC = (float*)smem;
    __syncthreads();
#pragma unroll
    for (int i = 0; i < 4; ++i)
#pragma unroll
      for (int j = 0; j < 4; ++j)
#pragma unroll
        for (int r = 0; r < 4; ++r) if constexpr (MI == 4) sC[(wr * 64 + i * 16 + q4 * 4 + r) * 132 + wc * 64 + j * 16 + l16] = acc[i][j][r];
    __syncthreads();
    if constexpr (EPI == 3) {
      const int hl = lane & 31, rsel = lane >> 5;
      const int col = n0 + hl * 4;
      const f32x4 gate4 = *(const f32x4*)(modv + g.sc_off + col);
      f32x4 lg4 = {1.f, 1.f, 1.f, 1.f}, lb4 = {0.f, 0.f, 0.f, 0.f};
      if (g.stats != nullptr) {
        lg4 = *(const f32x4*)(g.lng + col);
        lb4 = *(const f32x4*)(g.lnb + col);
      }
#pragma unroll 4
      for (int pp = 0; pp < 16; ++pp) {
        const int lrow = pp * 8 + wid * 2 + rsel;
        f32x4 a = *(const f32x4*)(sC + lrow * 132 + hl * 4);
        f32x4 x = *(const f32x4*)(fsrc + (size_t)lrow * 1024 + col);
        float mu = 0.f, rs = 1.f;
        if (g.stats != nullptr) {
          float2 st = sStat[lrow];
          mu = st.x;
          rs = st.y;
        }
        x = (x - mu) * rs * lg4 + lb4;
        f32x4 v = ALPHA * x + gate4 * a;
        *(f32x4*)(g.xout + (size_t)(m0 + lrow) * 1024 + col) = v;
        float s1 = (v.x + v.y) + (v.z + v.w);
        float s2 = (v.x * v.x + v.y * v.y) + (v.z * v.z + v.w * v.w);
        s1 = red16(s1);
        s2 = red16(s2);
        if ((lane & 15) == 0) *(float2*)(g.sout + (size_t)(m0 + lrow) * 32 + ((n0 >> 6) + (hl >> 4)) * 2) = make_float2(s1, s2);
      }
    } else {
#pragma unroll
      for (int pp = 0; pp < 8; ++pp) {
        const int idx = tid + 256 * pp;
        const int lrow = idx >> 4, c8 = idx & 15;
        f32x4 a0 = *(const f32x4*)(sC + lrow * 132 + c8 * 8);
        f32x4 a1 = *(const f32x4*)(sC + lrow * 132 + c8 * 8 + 4);
        a0.x = fmaxf(a0.x, 0.f); a0.y = fmaxf(a0.y, 0.f); a0.z = fmaxf(a0.z, 0.f); a0.w = fmaxf(a0.w, 0.f);
        a1.x = fmaxf(a1.x, 0.f); a1.y = fmaxf(a1.y, 0.f); a1.z = fmaxf(a1.z, 0.f); a1.w = fmaxf(a1.w, 0.f);
        u32x4 o;
        o.x = pack2(a0.x * a0.x, a0.y * a0.y);
        o.y = pack2(a0.z * a0.z, a0.w * a0.w);
        o.z = pack2(a1.x * a1.x, a1.y * a1.y);
        o.w = pack2(a1.z * a1.z, a1.w * a1.w);
        *(u32x4*)(g.hid + (size_t)(m0 + lrow) * DFF + n0 + c8 * 8) = o;
      }
    }
  }
}

DI void epi_inproj(const P& p, int li, f32x4 (&acc)[4][4], int R0, int C0) {
  const int lane = ltid() & 63, l16 = lane & 15, q4 = lane >> 4;
  const int seg = C0 >> 6;
  const bool lat = R0 >= NCTX;
  const float2* rope = (const float2*)(p.ws + O_ROPE);
  int b, tb;
  if (!lat) { b = R0 >> 8; tb = R0 & 255; } else { b = (R0 - NCTX) >> 10; tb = (R0 - NCTX) & 1023; }

  enum { T_QA, T_KA, T_VA, T_QB, T_FF, T_FB, T_IB, T_GB, T_QC, T_KC, T_VC };
  int type, cbase;
  if (seg < 8) { type = T_QA; cbase = seg * 64; }
  else if (seg < 16) { type = T_KA; cbase = (seg - 8) * 64; }
  else if (seg < 24) { type = T_VA; cbase = (seg - 16) * 64; }
  else if (seg < 28) { type = T_QB; cbase = (seg - 24) * 64; }
  else if (seg < 32) { type = T_FF; cbase = (seg - 28) * 64; }
  else if (seg < 36) { type = T_FB; cbase = (seg - 32) * 64; }
  else if (seg < 40) { type = T_IB; cbase = (seg - 36) * 64; }
  else if (seg < 44) { type = T_GB; cbase = (seg - 40) * 64; }
  else if (seg < 48) { type = T_QC; cbase = (seg - 44) * 64; }
  else if (seg < 50) { type = T_KC; cbase = (seg - 48) * 64; }
  else { type = T_VC; cbase = (seg - 50) * 64; }

  if (type == T_QC || type == T_KC) {
    const float* gv = (type == T_QC ? p.in[22] : p.in[23]) + li * 64;
    float gj[4];
#pragma unroll
    for (int j = 0; j < 4; ++j) gj[j] = gv[j * 16 + l16];
#pragma unroll
    for (int i = 0; i < 4; ++i)
#pragma unroll
      for (int r = 0; r < 4; ++r) {
        float ss = 0.f;
#pragma unroll
        for (int j = 0; j < 4; ++j) ss += acc[i][j][r] * acc[i][j][r];
        ss = red16(ss);
        float rs = rsqrtf(ss * (1.f / 64.f) + 1e-6f);
#pragma unroll
        for (int j = 0; j < 4; ++j) acc[i][j][r] = acc[i][j][r] * rs * gj[j];
      }
  }
  if (!lat && (type == T_KA || type == T_VA || type == T_KC || type == T_VC)) {
    float* o;
    int W;
    if (type == T_KA) { o = p.out + OUT_AK; W = 512; }
    else if (type == T_VA) { o = p.out + OUT_AV; W = 512; }
    else if (type == T_KC) { o = p.out + OUT_CK; W = 128; }
    else { o = p.out + OUT_CV; W = 128; }
#pragma unroll
    for (int i = 0; i < 4; ++i)
#pragma unroll
      for (int r = 0; r < 4; ++r) {
        int t = tb + i * 16 + q4 * 4 + r;
        size_t base = ((size_t)(b * 2 + li) * 256 + t) * W + cbase;
#pragma unroll
        for (int j = 0; j < 4; ++j) o[base + j * 16 + l16] = acc[i][j][r];
      }
  }
  if (lat && (type == T_QA || type == T_KA || type == T_QC || type == T_KC)) {
#pragma unroll
    for (int i = 0; i < 4; ++i)
#pragma unroll
      for (int r = 0; r < 4; ++r) {
        int t = tb + i * 16 + q4 * 4 + r;
#pragma unroll
        for (int j = 0; j < 4; ++j) {
          float v = acc[i][j][r];
          float pv = xor1(v);
          float2 cs = rope[t * 32 + j * 8 + (l16 >> 1)];
          acc[i][j][r] = (l16 & 1) ? (pv * cs.y + v * cs.x) : (v * cs.x - pv * cs.y);
        }
      }
  }

  if (type == T_QA || type == T_KA || type == T_QC || type == T_KC) {
    u16* dst;
    int W;
    size_t rowbase;
    if (type == T_QA) { dst = (u16*)(p.ws + O_QA); W = 512; rowbase = (size_t)R0 * 512; }
    else if (type == T_QC) { dst = (u16*)(p.ws + O_QC); W = 256; rowbase = (size_t)R0 * 256; }
    else if (type == T_KA) {
      W = 512;
      if (!lat) { dst = (u16*)(p.ws + O_KACTX); rowbase = (size_t)R0 * 512; }
      else { dst = (u16*)(p.ws + O_KALAT); rowbase = ((size_t)(li * 2 + b) * 1536 + tb) * 512; }
    } else {
      W = 128;
      if (!lat) { dst = (u16*)(p.ws + O_KCCTX); rowbase = (size_t)R0 * 128; }
      else { dst = (u16*)(p.ws + O_KCLAT); rowbase = ((size_t)(li * 2 + b) * 1536 + tb) * 128; }
    }
#pragma unroll
    for (int i = 0; i < 4; ++i)
#pragma unroll
      for (int r = 0; r < 4; ++r) {
        size_t base = rowbase + (size_t)(i * 16 + q4 * 4 + r) * W + cbase;
#pragma unroll
        for (int j = 0; j < 4; ++j) dst[base + j * 16 + l16] = f2bf(acc[i][j][r]);
      }
  } else if (type == T_VA || type == T_VC) {
    u16* dst;
    int L;
    size_t hb;
    if (type == T_VA) {
      int h = cbase >> 7, dv0 = cbase & 127;
      if (!lat) { dst = (u16*)(p.ws + O_VTACTX); L = 256; hb = ((size_t)(b * 4 + h) * 128 + dv0) * 256; }
      else { dst = (u16*)(p.ws + O_VTALAT); L = 1536; hb = ((size_t)((li * 2 + b) * 4 + h) * 128 + dv0) * 1536; }
    } else {
      int n = cbase >> 6;
      if (!lat) { dst = (u16*)(p.ws + O_VTCCTX); L = 256; hb = ((size_t)(b * 2 + n) * 64) * 256; }
      else { dst = (u16*)(p.ws + O_VTCLAT); L = 1536; hb = ((size_t)((li * 2 + b) * 2 + n) * 64) * 1536; }
    }
#pragma unroll
    for (int i = 0; i < 4; ++i)
#pragma unroll
      for (int j = 0; j < 4; ++j) {
        uint2 o;
        o.x = pack2(acc[i][j][0], acc[i][j][1]);
        o.y = pack2(acc[i][j][2], acc[i][j][3]);
        *(uint2*)(dst + hb + (size_t)(j * 16 + l16) * L + tb + i * 16 + q4 * 4) = o;
      }
  } else {
    float* dst;
    if (type == T_QB) dst = (float*)(p.ws + O_HQ);
    else if (type == T_FF) dst = (float*)(p.ws + O_HGF);
    else if (type == T_FB) dst = (float*)(p.ws + O_HGB);
    else if (type == T_IB) dst = (float*)(p.ws + O_HI);
    else dst = (float*)(p.ws + O_HSG);
    float lbv[4] = {0.f, 0.f, 0.f, 0.f};
    if ((type == T_FF || type == T_FB) && li == 1) {
      const float* lg = (type == T_FF) ? p.in[19] : p.in[20];
#pragma unroll
      for (int j = 0; j < 4; ++j) {
        int c = cbase + j * 16 + l16;
        lbv[j] = 1.f / (1.f + expf(lg[c] - lg[256 + c]));
      }
    }
#pragma unroll
    for (int i = 0; i < 4; ++i)
#pragma unroll
      for (int r = 0; r < 4; ++r) {
        size_t base = (size_t)(R0 + i * 16 + q4 * 4 + r) * 256 + cbase;
#pragma unroll
        for (int j = 0; j < 4; ++j) {
          float v = acc[i][j][r];
          float o;
          if (type == T_QB || type == T_GB) o = v * __frcp_rn(1.f + __expf(-v));
          else if (type == T_IB) o = v;
          else {
            float sg = __frcp_rn(1.f + __expf(-v));
            float f = lbv[j] + (1.f - lbv[j]) * sg;
            o = __logf(fmaxf(f, 1e-6f));
          }
          dst[base + j * 16 + l16] = o;
        }
      }
  }
}

template <int EPI, int MI = 4>
DI void gemm_phase(const P& p, const GA& g, int li, char* smem) {
  constexpr int BMT = MI * 32;
  constexpr int MPX = NTOK / BMT / 8;
  const int NT = g.N >> 7;
  const int xcd = blockIdx.x & 7, lb = blockIdx.x >> 3, nlb = gridDim.x >> 3;
  if (lb >= nlb) return;
  u32x4 ra0[4], rb0[4], ra1[4], rb1[4];
  bool primed = false;
  for (int t = lb; t < MPX * NT; t += nlb) {
    int mt = xcd * MPX + t % MPX, nt = t / MPX;
    const int tn = (t + nlb < MPX * NT) ? t + nlb : t;
    const int nmt = xcd * MPX + tn % MPX, nnt = tn / MPX;
    gemm_tile<EPI, MI>(p, g, li, mt * BMT, nt * 128, smem, ra0, rb0, ra1, rb1, primed, nmt * BMT, nnt * 128);
    primed = true;
  }
}


template <int KW, int DV>
DI void attn_gload(const u16* Kb, int kstride, const u16* VT, int L, int kb, int tid, u32x4 (&kr)[KW / 32], u32x4 (&vr)[DV / 32]) {
  constexpr int KPR = 256 / (KW / 8);
  const unsigned koff = (unsigned)(tid / (KW / 8)) * (unsigned)kstride + (unsigned)(tid % (KW / 8)) * 8u;
  const unsigned voff = (unsigned)(tid >> 3) * (unsigned)L + (unsigned)(tid & 7) * 8u;
#pragma unroll
  for (int i = 0; i < KW / 32; ++i) {
    const u16* kbp = Kb + (size_t)(kb * 64 + KPR * i) * kstride;
    kr[i] = *(const u32x4*)(kbp + koff);
  }
#pragma unroll
  for (int i = 0; i < DV / 32; ++i) {
    const u16* vbp = VT + (size_t)(32 * i) * L + kb * 64;
    vr[i] = *(const u32x4*)(vbp + voff);
  }
}
template <int KW, int DV>
DI void attn_lstore(u16* sK, u16* sV, int tid, const u32x4 (&kr)[KW / 32], const u32x4 (&vr)[DV / 32]) {
  constexpr int KS = KW + 8;
#pragma unroll
  for (int i = 0; i < KW / 32; ++i) {
    int idx = tid + 256 * i;
    int key = idx / (KW / 8), cc = idx % (KW / 8);
    *(u32x4*)(sK + key * KS + cc * 8) = kr[i];
  }
#pragma unroll
  for (int i = 0; i < DV / 32; ++i) {
    int idx = tid + 256 * i;
    int row = idx >> 3, cc = idx & 7;
    *(u32x4*)(sV + row * 72 + cc * 8) = vr[i];
  }
}

template <int KW, int DV, int NQ>
DI void attn_compute(const u16* sK, const u16* sV, int kfo, int l16, int q4, const bf16x8 (&qf)[NQ][2],
                     f32x4 (&o)[NQ][DV / 16], float (&m)[NQ], float (&l)[NQ]) {
  constexpr int KS = KW + 8, NDT = DV / 16;
  const float c = 0.125f * LOG2E;
  f32x4 st[NQ][4];
#pragma unroll
  for (int kt = 0; kt < 4; ++kt) {
    const u16* kp = sK + (kt * 16 + l16) * KS + kfo + q4 * 8;
    bf16x8 k0 = *(const bf16x8*)kp;
    bf16x8 k1 = *(const bf16x8*)(kp + 32);
#pragma unroll
    for (int q = 0; q < NQ; ++q) {
      f32x4 z = {0.f, 0.f, 0.f, 0.f};
      z = MFMA16(k0, qf[q][0], z);
      st[q][kt] = MFMA16(k1, qf[q][1], z);
    }
  }
#pragma unroll
  for (int q = 0; q < NQ; ++q) {
    float bm = st[q][0][0];
#pragma unroll
    for (int kt = 0; kt < 4; ++kt)
#pragma unroll
      for (int r = 0; r < 4; ++r) bm = fmaxf(bm, st[q][kt][r]);
    bm = fmaxf(bm, shx(bm, 16));
    bm = fmaxf(bm, shx(bm, 32));
    const float mn = fmaxf(m[q], bm);
    const float alpha = ex2((m[q] - mn) * c);
    m[q] = mn;
    float ps = 0.f;
#pragma unroll
    for (int kt = 0; kt < 4; ++kt)
#pragma unroll
      for (int r = 0; r < 4; ++r) {
        float pv = ex2((st[q][kt][r] - mn) * c);
        st[q][kt][r] = pv;
        ps += pv;
      }
    l[q] = l[q] * alpha + ps;
#pragma unroll
    for (int d = 0; d < NDT; ++d) {
      o[q][d][0] *= alpha; o[q][d][1] *= alpha; o[q][d][2] *= alpha; o[q][d][3] *= alpha;
    }
  }
#pragma unroll
  for (int ks = 0; ks < 2; ++ks) {
    bf16x8 pf[NQ];
#pragma unroll
    for (int q = 0; q < NQ; ++q) {
      u32x4 pu;
      pu.x = pack2(st[q][2 * ks][0], st[q][2 * ks][1]);
      pu.y = pack2(st[q][2 * ks][2], st[q][2 * ks][3]);
      pu.z = pack2(st[q][2 * ks + 1][0], st[q][2 * ks + 1][1]);
      pu.w = pack2(st[q][2 * ks + 1][2], st[q][2 * ks + 1][3]);
      pf[q] = __builtin_bit_cast(bf16x8, pu);
    }
#pragma unroll
    for (int d = 0; d < NDT; ++d) {
      const u16* vp = sV + (d * 16 + l16) * 72 + ks * 32 + q4 * 4;
      u32x2 v0 = *(const u32x2*)vp;
      u32x2 v1 = *(const u32x2*)(vp + 16);
      u32x4 vu = {v0.x, v0.y, v1.x, v1.y};
      bf16x8 vf = __builtin_bit_cast(bf16x8, vu);
#pragma unroll
      for (int q = 0; q < NQ; ++q) o[q][d] = MFMA16(vf, pf[q], o[q][d]);
    }
  }
}

template <int KW, int DV, bool DIFF>
DI void attn_item(const u16* Q, int qstride, int qcol, int qrow0, const u16* Kb, int kstride, const u16* VT, int L,
                          int nkeys, u16* mixed, int mixcol, float lam, float postscale, const float* subg, char* smem) {
  constexpr int NQ = 2;
  const int tid = ltid(), lane = tid & 63, wid = tid >> 6, l16 = lane & 15, q4 = lane >> 4;
  const int qsub = wid & 1, var = wid >> 1;
  constexpr int KS = KW + 8;
  constexpr int STAGE = 64 * KS + DV * 72;
  u16* sK0 = (u16*)smem;
  u16* sV0 = sK0 + 64 * KS;
  u16* sK1 = sK0 + STAGE;
  u16* sV1 = sV0 + STAGE;
  constexpr int KPT = KW / 32, VPT = DV / 32, NDT = DV / 16;
  const int kfo = DIFF ? var * 64 : 0;

  bf16x8 qf[NQ][2];
#pragma unroll
  for (int q = 0; q < NQ; ++q) {
    const u16* qp = Q + (size_t)(qrow0 + qsub * 32 + q * 16 + l16) * qstride + qcol + var * 64 + q4 * 8;
    qf[q][0] = *(const bf16x8*)qp;
    qf[q][1] = *(const bf16x8*)(qp + 32);
  }

  u32x4 kr0[KPT], vr0[VPT];
  f32x4 o[NQ][NDT];
  float m[NQ], l[NQ];
#pragma unroll
  for (int q = 0; q < NQ; ++q) {
    m[q] = -INFINITY;
    l[q] = 0.f;
#pragma unroll
    for (int d = 0; d < NDT; ++d) o[q][d] = f32x4{0.f, 0.f, 0.f, 0.f};
  }
  const int nkb = nkeys >> 6;
#define SB0 __builtin_amdgcn_sched_barrier(0)
#define ACOMP(SK, SV) attn_compute<KW, DV, NQ>(SK, SV, kfo, l16, q4, qf, o, m, l)
  attn_gload<KW, DV>(Kb, kstride, VT, L, 0, tid, kr0, vr0);
  SB0;
  __syncthreads();
  attn_lstore<KW, DV>(sK0, sV0, tid, kr0, vr0);
  SB0;
  attn_gload<KW, DV>(Kb, kstride, VT, L, 1, tid, kr0, vr0);
  SB0;
  __syncthreads();
#pragma unroll 1
  for (int kb = 0; kb < nkb - 2; kb += 2) {
    SB0;
    attn_lstore<KW, DV>(sK1, sV1, tid, kr0, vr0);
    SB0;
    attn_gload<KW, DV>(Kb, kstride, VT, L, kb + 2, tid, kr0, vr0);
    SB0;
    ACOMP(sK0, sV0);
    __syncthreads();
    SB0;
    attn_lstore<KW, DV>(sK0, sV0, tid, kr0, vr0);
    SB0;
    attn_gload<KW, DV>(Kb, kstride, VT, L, kb + 3, tid, kr0, vr0);
    SB0;
    ACOMP(sK1, sV1);
    __syncthreads();
  }
  SB0;
  attn_lstore<KW, DV>(sK1, sV1, tid, kr0, vr0);
  SB0;
  ACOMP(sK0, sV0);
  __syncthreads();
  SB0;
  ACOMP(sK1, sV1);
  __syncthreads();
#undef SB0
#undef ACOMP
  float inv[NQ];
#pragma unroll
  for (int q = 0; q < NQ; ++q) {
    float lt = l[q];
    lt += shx(lt, 16);
    lt += shx(lt, 32);
    inv[q] = 1.f / lt;
  }
  if constexpr (DIFF) {
    float* sO = (float*)smem;
    if (var == 1) {
#pragma unroll
      for (int q = 0; q < NQ; ++q)
#pragma unroll
        for (int d = 0; d < NDT; ++d)
          *(f32x4*)(sO + (qsub * 32 + q * 16 + l16) * 132 + d * 16 + q4 * 4) = o[q][d] * inv[q];
    }
    __syncthreads();
    if (var == 0) {
      f32x4 ggv[NDT];
#pragma unroll
      for (int d = 0; d < NDT; ++d) ggv[d] = *(const f32x4*)(subg + d * 16 + q4 * 4);
#pragma unroll
      for (int q = 0; q < NQ; ++q) {
        const int row = qrow0 + qsub * 32 + q * 16 + l16;
        float ss = 0.f;
#pragma unroll
        for (int d = 0; d < NDT; ++d) {
          f32x4 o1 = *(const f32x4*)(sO + (qsub * 32 + q * 16 + l16) * 132 + d * 16 + q4 * 4);
          o[q][d] = o[q][d] * inv[q] - lam * o1;
          ss += o[q][d][0] * o[q][d][0] + o[q][d][1] * o[q][d][1] + o[q][d][2] * o[q][d][2] + o[q][d][3] * o[q][d][3];
        }
        ss += shx(ss, 16);
        ss += shx(ss, 32);
        const float rs = rsqrtf(ss * (1.f / 128.f) + 1e-6f) * postscale;
#pragma unroll
        for (int d = 0; d < NDT; ++d) {
          f32x4 v = o[q][d] * rs * ggv[d];
          u32x2 ov;
          ov.x = pack2(v.x, v.y);
          ov.y = pack2(v.z, v.w);
          *(u32x2*)(mixed + (size_t)row * 1024 + mixcol + d * 16 + q4 * 4) = ov;
        }
      }
    }
  } else {
#pragma unroll
    for (int q = 0; q < NQ; ++q) {
      const int row = qrow0 + qsub * 32 + q * 16 + l16;
#pragma unroll
      for (int d = 0; d < NDT; ++d) {
        f32x4 v = o[q][d] * inv[q];
        u32x2 ov;
        ov.x = pack2(v.x, v.y);
        ov.y = pack2(v.z, v.w);
        *(u32x2*)(mixed + (size_t)row * 1024 + mixcol + var * 64 + d * 16 + q4 * 4) = ov;
      }
    }
  }
}

DI void attnA_item(const P& p, int li, int it, char* smem) {
  const int lane = ltid() & 63;
  float d1 = p.in[14][li * 64 + lane] * p.in[15][li * 64 + lane];
  float d2 = p.in[16][li * 64 + lane] * p.in[17][li * 64 + lane];
#pragma unroll
  for (int s = 1; s < 64; s <<= 1) { d1 += shx(d1, s); d2 += shx(d2, s); }
  const float lam_init = 0.8f - 0.6f * expf(-0.3f * (float)li);
  const float lam = expf(d1) - expf(d2) + lam_init;
  const u16* QA = (const u16*)(p.ws + O_QA);
  u16* mixed = (u16*)(p.ws + O_MIXED);
  const float* subg = p.in[18] + li * 128;
  int qrow0, L;
  const u16 *Kb, *VT;
  int h;
  if (it < 128) {
    int b = it >> 6, qb = it & 15;
    h = (it >> 4) & 3;
    Kb = (const u16*)(p.ws + O_KALAT) + (size_t)(li * 2 + b) * 1536 * 512 + h * 128;
    VT = (const u16*)(p.ws + O_VTALAT) + (size_t)((li * 2 + b) * 4 + h) * 128 * 1536;
    qrow0 = NCTX + b * 1024 + qb * 64;
    L = 1536;
  } else {
    it -= 128;
    int b = it >> 4, qb = it & 3;
    h = (it >> 2) & 3;
    Kb = (const u16*)(p.ws + O_KACTX) + (size_t)b * 256 * 512 + h * 128;
    VT = (const u16*)(p.ws + O_VTACTX) + (size_t)(b * 4 + h) * 128 * 256;
    qrow0 = b * 256 + qb * 64;
    L = 256;
  }
  attn_item<128, 128, true>(QA, 512, h * 128, qrow0, Kb, 512, VT, L, L, mixed, h * 128, lam, 1.f - lam_init, subg, smem);
}
DI void attnC_item(const P& p, int li, int it, char* smem) {
  const u16* QC = (const u16*)(p.ws + O_QC);
  u16* mixed = (u16*)(p.ws + O_MIXED);
  int qrow0, L, n;
  const u16 *Kb, *VT;
  if (it < 64) {
    int b = it >> 5, qb = it & 15;
    n = (it >> 4) & 1;
    Kb = (const u16*)(p.ws + O_KCLAT) + (size_t)(li * 2 + b) * 1536 * 128 + n * 64;
    VT = (const u16*)(p.ws + O_VTCLAT) + (size_t)((li * 2 + b) * 2 + n) * 64 * 1536;
    qrow0 = NCTX + b * 1024 + qb * 64;
    L = 1536;
  } else {
    it -= 64;
    int b = it >> 3, qb = it & 3;
    n = (it >> 2) & 1;
    Kb = (const u16*)(p.ws + O_KCCTX) + (size_t)b * 256 * 128 + n * 64;
    VT = (const u16*)(p.ws + O_VTCCTX) + (size_t)(b * 2 + n) * 64 * 256;
    qrow0 = b * 256 + qb * 64;
    L = 256;
  }
  attn_item<64, 64, false>(QC, 256, n * 128, qrow0, Kb, 128, VT, L, L, mixed, 768 + n * 128, 0.f, 1.f, nullptr, smem);
}

DI void h1_item(const P& p, int item, char* smem) {
  const int tid = ltid(), lane = tid & 63, w = tid >> 6, l16 = lane & 15, q4 = lane >> 4;
  const int dir = item & 1, h = (item >> 1) & 3, tc = item >> 3;
  const int row0 = tc * 64;
  float* sQ = (float*)smem;
  float* sB = sQ + 64 * 68;
  float* sK = sB + 64 * 68;
  u16* sVT = (u16*)(sK + 64 * 68);
  float* sTot = (float*)(sVT + 64 * 72);
  const float* HQ = (const float*)(p.ws + O_HQ);
  const float* HG = (const float*)(p.ws + (dir ? O_HGB : O_HGF));
  const float* HI = (const float*)(p.ws + O_HI);
  float* OI = (float*)(p.ws + O_OI) + (size_t)dir * NTOK * 256;
  u16* QE = (u16*)(p.ws + O_QE) + (size_t)dir * NTOK * 256;
  float* KV = (float*)(p.ws + O_KV) + (size_t)item * 4096;
  float* DEC = (float*)(p.ws + O_DEC) + (size_t)item * 64;

  __syncthreads();
#pragma unroll
  for (int i = 0; i < 4; ++i) {
    int idx = tid + 256 * i;
    int lo = idx >> 4, c4 = idx & 15;
    int row = dir ? row0 + 63 - lo : row0 + lo;
    size_t off = (size_t)row * 256 + h * 64 + c4 * 4;
    *(float4*)(sQ + lo * 68 + c4 * 4) = *(const float4*)(HQ + off);
    *(float4*)(sB + lo * 68 + c4 * 4) = *(const float4*)(HG + off);
    float4 v = *(const float4*)(HI + off);
    sVT[(c4 * 4 + 0) * 72 + lo] = f2bf(v.x);
    sVT[(c4 * 4 + 1) * 72 + lo] = f2bf(v.y);
    sVT[(c4 * 4 + 2) * 72 + lo] = f2bf(v.z);
    sVT[(c4 * 4 + 3) * 72 + lo] = f2bf(v.w);
  }
  __syncthreads();
  {
    const int k = tid & 63, part = tid >> 6;
    float run = 0.f;
#pragma unroll 4
    for (int e = 0; e < 16; ++e) {
      int i = part * 16 + e;
      float g = sB[i * 68 + k];
      sK[i * 68 + k] = 1.f - ex2(g * LOG2E);
      run += g * LOG2E;
      sB[i * 68 + k] = run;
    }
    sTot[part * 64 + k] = run;
    __syncthreads();
    float add = 0.f;
    for (int pp = 0; pp < part; ++pp) add += sTot[pp * 64 + k];
    if (part > 0)
      for (int e = 0; e < 16; ++e) sB[(part * 16 + e) * 68 + k] += add;
  }
  __syncthreads();
#pragma unroll
  for (int i = 0; i < 4; ++i) {
    int idx = tid + 256 * i;
    int lo = idx >> 4, c4 = idx & 15;
    int row = dir ? row0 + 63 - lo : row0 + lo;
    f32x4 q = *(const f32x4*)(sQ + lo * 68 + c4 * 4);
    f32x4 bb = *(const f32x4*)(sB + lo * 68 + c4 * 4);
    u32x2 o;
    o.x = pack2(q.x * ex2(bb.x), q.y * ex2(bb.y));
    o.y = pack2(q.z * ex2(bb.z), q.w * ex2(bb.w));
    *(u32x2*)(QE + (size_t)row * 256 + h * 64 + c4 * 4) = o;
  }
  {
    const int I = w;
    bf16x8 qs[2];
    f32x4 rr[2][2];
#pragma unroll
    for (int s = 0; s < 2; ++s) {
      const int kk0 = s * 32 + q4 * 8;
      if (I > 0) {
        rr[s][0] = *(const f32x4*)(sB + (16 * I - 1) * 68 + kk0);
        rr[s][1] = *(const f32x4*)(sB + (16 * I - 1) * 68 + kk0 + 4);
      } else {
        rr[s][0] = f32x4{0.f, 0.f, 0.f, 0.f};
        rr[s][1] = rr[s][0];
      }
      const float* qr = sQ + (16 * I + l16) * 68 + kk0;
      const float* br = sB + (16 * I + l16) * 68 + kk0;
      f32x4 q0 = *(const f32x4*)qr, q1 = *(const f32x4*)(qr + 4);
      f32x4 b0 = *(const f32x4*)br, b1 = *(const f32x4*)(br + 4);
      u32x4 pu;
      pu.x = pack2(q0.x * ex2(b0.x - rr[s][0].x), q0.y * ex2(b0.y - rr[s][0].y));
      pu.y = pack2(q0.z * ex2(b0.z - rr[s][0].z), q0.w * ex2(b0.w - rr[s][0].w));
      pu.z = pack2(q1.x * ex2(b1.x - rr[s][1].x), q1.y * ex2(b1.y - rr[s][1].y));
      pu.w = pack2(q1.z * ex2(b1.z - rr[s][1].z), q1.w * ex2(b1.w - rr[s][1].w));
      qs[s] = __builtin_bit_cast(bf16x8, pu);
    }
    f32x4 at[4];
#pragma unroll
    for (int J = 0; J < 4; ++J) {
      at[J] = f32x4{0.f, 0.f, 0.f, 0.f};
      if (J <= I) {
#pragma unroll
        for (int s = 0; s < 2; ++s) {
          const int kk0 = s * 32 + q4 * 8;
          const float* kr = sK + (16 * J + l16) * 68 + kk0;
          const float* br = sB + (16 * J + l16) * 68 + kk0;
          f32x4 k0 = *(const f32x4*)kr, k1 = *(const f32x4*)(kr + 4);
          f32x4 b0 = *(const f32x4*)br, b1 = *(const f32x4*)(br + 4);
          u32x4 pu;
          pu.x = pack2(k0.x * ex2(fminf(rr[s][0].x - b0.x, 100.f)), k0.y * ex2(fminf(rr[s][0].y - b0.y, 100.f)));
          pu.y = pack2(k0.z * ex2(fminf(rr[s][0].z - b0.z, 100.f)), k0.w * ex2(fminf(rr[s][0].w - b0.w, 100.f)));
          pu.z = pack2(k1.x * ex2(fminf(rr[s][1].x - b1.x, 100.f)), k1.y * ex2(fminf(rr[s][1].y - b1.y, 100.f)));
          pu.w = pack2(k1.z * ex2(fminf(rr[s][1].z - b1.z, 100.f)), k1.w * ex2(fminf(rr[s][1].w - b1.w, 100.f)));
          bf16x8 kf = __builtin_bit_cast(bf16x8, pu);
          at[J] = MFMA16(kf, qs[s], at[J]);
        }
        if (J == I) {
#pragma unroll
          for (int r = 0; r < 4; ++r)
            if (q4 * 4 + r > l16) at[J][r] = 0.f;
        }
      }
    }
    f32x4 oc[4];
#pragma unroll
    for (int vt = 0; vt < 4; ++vt) oc[vt] = f32x4{0.f, 0.f, 0.f, 0.f};
#pragma unroll
    for (int ks = 0; ks < 2; ++ks) {
      if (2 * ks <= I) {
        u32x4 pu;
        pu.x = pack2(at[2 * ks][0], at[2 * ks][1]);
        pu.y = pack2(at[2 * ks][2], at[2 * ks][3]);
        pu.z = pack2(at[2 * ks + 1][0], at[2 * ks + 1][1]);
        pu.w = pack2(at[2 * ks + 1][2], at[2 * ks + 1][3]);
        bf16x8 pf = __builtin_bit_cast(bf16x8, pu);
#pragma unroll
        for (int vt = 0; vt < 4; ++vt) {
          const u16* vp = sVT + (vt * 16 + l16) * 72 + ks * 32 + q4 * 4;
          u32x2 v0 = *(const u32x2*)vp;
          u32x2 v1 = *(const u32x2*)(vp + 16);
          u32x4 vu = {v0.x, v0.y, v1.x, v1.y};
          oc[vt] = MFMA16(__builtin_bit_cast(bf16x8, vu), pf, oc[vt]);
        }
      }
    }
    {
      const int t = 16 * I + l16;
      const int row = dir ? row0 + 63 - t : row0 + t;
#pragma unroll
      for (int vt = 0; vt < 4; ++vt) *(f32x4*)(OI + (size_t)row * 256 + h * 64 + vt * 16 + q4 * 4) = oc[vt];
    }
  }
  {
    const int k = 16 * w + l16;
    const float bend = sB[63 * 68 + k];
    f32x4 kc[4];
#pragma unroll
    for (int vt = 0; vt < 4; ++vt) kc[vt] = f32x4{0.f, 0.f, 0.f, 0.f};
#pragma unroll
    for (int ks = 0; ks < 2; ++ks) {
      float kd[8];
#pragma unroll
      for (int j = 0; j < 8; ++j) {
        const int s = ks * 32 + q4 * 8 + j;
        kd[j] = sK[s * 68 + k] * ex2(bend - sB[s * 68 + k]);
      }
      u32x4 pu;
      pu.x = pack2(kd[0], kd[1]);
      pu.y = pack2(kd[2], kd[3]);
      pu.z = pack2(kd[4], kd[5]);
      pu.w = pack2(kd[6], kd[7]);
      bf16x8 af = __builtin_bit_cast(bf16x8, pu);
#pragma unroll
      for (int vt = 0; vt < 4; ++vt) {
        bf16x8 vf = *(const bf16x8*)(sVT + (vt * 16 + l16) * 72 + ks * 32 + q4 * 8);
        kc[vt] = MFMA16(af, vf, kc[vt]);
      }
    }
#pragma unroll
    for (int vt = 0; vt < 4; ++vt)
#pragma unroll
      for (int r = 0; r < 4; ++r) KV[(16 * w + q4 * 4 + r) * 64 + vt * 16 + l16] = kc[vt][r];
    if (q4 == 0) DEC[k] = ex2(bend);
  }
}

DI void h2_item(const P& p, int li, int item, char* smem) {
  const int tid = ltid(), ty = tid >> 4, tx = tid & 15;
  const int lane = tid & 63, w = tid >> 6, l16 = lane & 15, q4 = lane >> 4;
  const int h = item & 3, tc = item >> 2, row0 = tc * 64;
  const bool lat = tc >= 64;
  int seq, cl, nc;
  if (!lat) { seq = tc >> 2; cl = tc & 3; nc = 4; } else { seq = (tc - 64) >> 4; cl = (tc - 64) & 15; nc = 16; }
  const int tcbase = tc - cl;
  u16* sST = (u16*)smem;
  const float* KVb = (const float*)(p.ws + O_KV);
  const float* DECb = (const float*)(p.ws + O_DEC);
  __syncthreads();
#pragma unroll 1
  for (int dir = 0; dir < 2; ++dir) {
    float4 S[4];
#pragma unroll
    for (int a = 0; a < 4; ++a) {
      if (lat) S[a] = *(const float4*)(p.in[6 + dir] + ((size_t)((seq * 2 + li) * 4 + h) * 64 + ty + 16 * a) * 64 + tx * 4);
      else S[a] = make_float4(0.f, 0.f, 0.f, 0.f);
    }
    const int nprev = dir == 0 ? cl : nc - 1 - cl;
#pragma unroll 1
    for (int j = 0; j < nprev; ++j) {
      int tcj = tcbase + (dir == 0 ? j : nc - 1 - j);
      size_t itj = (size_t)((tcj * 4 + h) * 2 + dir);
#pragma unroll
      for (int a = 0; a < 4; ++a) {
        int k = ty + 16 * a;
        float dcy = DECb[itj * 64 + k];
        float4 kv = *(const float4*)(KVb + itj * 4096 + k * 64 + tx * 4);
        S[a].x = dcy * S[a].x + kv.x; S[a].y = dcy * S[a].y + kv.y; S[a].z = dcy * S[a].z + kv.z; S[a].w = dcy * S[a].w + kv.w;
      }
    }
    if (!lat && nprev == nc - 1) {
      size_t itj = (size_t)((tc * 4 + h) * 2 + dir);
      float* so = p.out + (dir == 0 ? OUT_SF : OUT_SB) + (size_t)((seq * 2 + li) * 4 + h) * 4096;
#pragma unroll
      for (int a = 0; a < 4; ++a) {
        int k = ty + 16 * a;
        float dcy = DECb[itj * 64 + k];
        float4 kv = *(const float4*)(KVb + itj * 4096 + k * 64 + tx * 4);
        *(float4*)(so + k * 64 + tx * 4) = make_float4(dcy * S[a].x + kv.x, dcy * S[a].y + kv.y, dcy * S[a].z + kv.z, dcy * S[a].w + kv.w);
      }
    }
    u16* st = sST + dir * 64 * 72;
#pragma unroll
    for (int a = 0; a < 4; ++a) {
      int k = ty + 16 * a;
      st[(tx * 4 + 0) * 72 + k] = f2bf(S[a].x);
      st[(tx * 4 + 1) * 72 + k] = f2bf(S[a].y);
      st[(tx * 4 + 2) * 72 + k] = f2bf(S[a].z);
      st[(tx * 4 + 3) * 72 + k] = f2bf(S[a].w);
    }
  }
  __syncthreads();
  f32x4 oc[4];
#pragma unroll
  for (int vt = 0; vt < 4; ++vt) oc[vt] = f32x4{0.f, 0.f, 0.f, 0.f};
#pragma unroll
  for (int dir = 0; dir < 2; ++dir) {
    const u16* QE = (const u16*)(p.ws + O_QE) + (size_t)dir * NTOK * 256 + (size_t)(row0 + 16 * w + l16) * 256 + h * 64 + q4 * 8;
    const u16* st = sST + dir * 64 * 72;
#pragma unroll
    for (int ks = 0; ks < 2; ++ks) {
      bf16x8 af = *(const bf16x8*)(QE + ks * 32);
#pragma unroll
      for (int vt = 0; vt < 4; ++vt) {
        bf16x8 bf = *(const bf16x8*)(st + (vt * 16 + l16) * 72 + ks * 32 + q4 * 8);
        oc[vt] = MFMA16(af, bf, oc[vt]);
      }
    }
  }
  const float* OI0 = (const float*)(p.ws + O_OI);
  const float* OI1 = OI0 + (size_t)NTOK * 256;
  const float* HSG = (const float*)(p.ws + O_HSG);
  u16* mixed = (u16*)(p.ws + O_MIXED);
  float gn[4];
#pragma unroll
  for (int vt = 0; vt < 4; ++vt) gn[vt] = p.in[21][li * 64 + vt * 16 + l16];
  float oi[4][4], sgv[4][4];
#pragma unroll
  for (int r = 0; r < 4; ++r) {
    const size_t off = (size_t)(row0 + 16 * w + q4 * 4 + r) * 256 + h * 64 + l16;
#pragma unroll
    for (int vt = 0; vt < 4; ++vt) {
      oi[r][vt] = OI0[off + vt * 16] + OI1[off + vt * 16];
      sgv[r][vt] = HSG[off + vt * 16];
    }
  }
#pragma unroll
  for (int r = 0; r < 4; ++r) {
    const int row = row0 + 16 * w + q4 * 4 + r;
    float val[4];
    float ss = 0.f;
#pragma unroll
    for (int vt = 0; vt < 4; ++vt) {
      val[vt] = oc[vt][r] + oi[r][vt];
      ss += val[vt] * val[vt];
    }
    ss = red16(ss);
    const float rs = rsqrtf(ss * (1.f / 64.f) + 1e-6f);
#pragma unroll
    for (int vt = 0; vt < 4; ++vt)
      mixed[(size_t)row * 1024 + 512 + h * 64 + vt * 16 + l16] = f2bf(val[vt] * rs * gn[vt] * sgv[r][vt]);
  }
}

DI void ln_apply(const P& p, const float* lo, const float* hi, const float* stats, const float* lng, const float* lnb,
                 const float* mods, int sc_off, int sh_off) {
  const int lane = ltid() & 63, wid = ltid() >> 6;
  u16* dst = (u16*)(p.ws + O_ABF);
  for (int it = blockIdx.x; it < NTOK / 4; it += gridDim.x) {
    const int row = it * 4 + wid;
    float mu = 0.f, rs = 1.f;
    if (stats != nullptr) {
      float s1 = 0.f, s2 = 0.f;
      if (lane < 16) {
        float2 v = *(const float2*)(stats + (size_t)row * 32 + lane * 2);
        s1 = v.x;
        s2 = v.y;
      }
#pragma unroll
      for (int s = 1; s < 16; s <<= 1) { s1 += shx(s1, s); s2 += shx(s2, s); }
      s1 = __shfl(s1, 0, 64);
      s2 = __shfl(s2, 0, 64);
      mu = s1 * (1.f / 1024.f);
      rs = rsqrtf(fmaxf(s2 * (1.f / 1024.f) - mu * mu, 0.f) + 1e-6f);
    }
    const float* x = row < NCTX ? lo + (size_t)row * 1024 : hi + (size_t)(row - NCTX) * 1024;
    const int rtype = row < NCTX ? 0 : 1 + ((row - NCTX) >> 10);
    const float* mv = mods + rtype * 6144;
    f32x4 xv[4], scv[4], shv[4], ggv[4], bbv[4];
#pragma unroll
    for (int i = 0; i < 4; ++i) {
      const int c = (lane + 64 * i) * 4;
      xv[i] = *(const f32x4*)(x + c);
      scv[i] = *(const f32x4*)(mv + sc_off + c);
      shv[i] = *(const f32x4*)(mv + sh_off + c);
      if (stats != nullptr) {
        ggv[i] = *(const f32x4*)(lng + c);
        bbv[i] = *(const f32x4*)(lnb + c);
      }
    }
#pragma unroll
    for (int i = 0; i < 4; ++i) {
      const int c = (lane + 64 * i) * 4;
      f32x4 v = xv[i];
      f32x4 sc = scv[i] + 1.f;
      f32x4 sh = shv[i];
      if (stats != nullptr) v = (v - mu) * rs * ggv[i] + bbv[i];
      v = v * sc + sh;
      u32x2 o;
      o.x = pack2(v.x, v.y);
      o.y = pack2(v.z, v.w);
      *(u32x2*)(dst + (size_t)row * 1024 + c) = o;
    }
  }
}

DI void final_ln(const P& p) {
  const int lane = ltid() & 63, wid = ltid() >> 6;
  const float* X = (const float*)(p.ws + O_XPRE2);
  const float* ST = (const float*)(p.ws + O_ST2);
  const float* g = p.in[26] + 1024;
  const float* bb = p.in[27] + 1024;
  for (int it = blockIdx.x; it < NTOK / 4; it += gridDim.x) {
    int row = it * 4 + wid;
    float s1 = 0.f, s2 = 0.f;
    if (lane < 16) {
      float2 v = *(const float2*)(ST + (size_t)row * 32 + lane * 2);
      s1 = v.x;
      s2 = v.y;
    }
#pragma unroll
    for (int s = 1; s < 16; s <<= 1) { s1 += shx(s1, s); s2 += shx(s2, s); }
    s1 = __shfl(s1, 0, 64);
    s2 = __shfl(s2, 0, 64);
    float mu = s1 * (1.f / 1024.f);
    float rs = rsqrtf(fmaxf(s2 * (1.f / 1024.f) - mu * mu, 0.f) + 1e-6f);
    float* out = p.out + (row < NCTX ? OUT_YP + (size_t)row * 1024 : OUT_YS + (size_t)(row - NCTX) * 1024);
    float4 xv[4], gv[4], bv[4];
#pragma unroll
    for (int i = 0; i < 4; ++i) {
      int c = (lane + 64 * i) * 4;
      xv[i] = *(const float4*)(X + (size_t)row * 1024 + c);
      gv[i] = *(const float4*)(g + c);
      bv[i] = *(const float4*)(bb + c);
    }
#pragma unroll
    for (int i = 0; i < 4; ++i) {
      int c = (lane + 64 * i) * 4;
      float4 x = xv[i];
      float4 gg = gv[i];
      float4 b4 = bv[i];
      *(float4*)(out + c) = make_float4((x.x - mu) * rs * gg.x + b4.x, (x.y - mu) * rs * gg.y + b4.y,
                                         (x.z - mu) * rs * gg.z + b4.z, (x.w - mu) * rs * gg.w + b4.w);
    }
  }
}

DI void run_phase(const P& p, int ph, char* smem, int sub = 0) {
  if (ph == 0) { phase0(p, smem); return; }
  if (ph == NPHASE - 1) { final_ln(p); return; }
  const int li = (ph - 1) >> 3, s = (ph - 1) & 7;
  float* XPRE1 = (float*)(p.ws + O_XPRE1);
  float* XPRE2 = (float*)(p.ws + O_XPRE2);
  float* ST1 = (float*)(p.ws + O_ST1);
  float* ST2 = (float*)(p.ws + O_ST2);
  GA g;
  g.mods = (const float*)(p.ws + O_MODS) + li * 3 * 6144;
  g.a16 = (const u16*)(p.ws + O_ABF); g.xout = nullptr; g.sout = nullptr; g.hid = nullptr;
  g.alo = nullptr; g.ahi = nullptr; g.stats = nullptr; g.lng = nullptr; g.lnb = nullptr; g.sc_off = 0; g.sh_off = 0;
  const float* xin_lo = li == 0 ? p.in[0] : XPRE2;
  const float* xin_hi = li == 0 ? p.in[1] : XPRE2 + (size_t)NCTX * 1024;
  const float* xin_st = li == 0 ? nullptr : ST2;
  const float* xin_g = p.in[26] + (li == 0 ? 0 : (li - 1) * 1024);
  const float* xin_b = p.in[27] + (li == 0 ? 0 : (li - 1) * 1024);
  if (s == 0) {
    ln_apply(p, xin_lo, xin_hi, xin_st, xin_g, xin_b, g.mods, 1024, 0);
  } else if (s == 1) {
    g.bt = (const u16*)(p.ws + O_WTIN) + (size_t)li * NIN * D; g.K = D; g.N = NIN;
    gemm_phase<0>(p, g, li, smem);
    if (li == 0) {
      const int xcd = blockIdx.x & 7, lb = blockIdx.x >> 3, nlb = gridDim.x >> 3;
      const int busy = 6 * (NIN >> 7) - 2 * nlb;
      if (nlb == 64 && lb >= busy) run_transposes(p, smem, (lb - busy) * 8 + xcd, (nlb - busy) * 8, true);
      else if (nlb != 64) run_transposes(p, smem, blockIdx.x, gridDim.x, true);
    }
  } else if (s == 2) {
    if (gridDim.x == 512 && sub == 0) {
      const int b = blockIdx.x;
      if (b < 128) {
        attnA_item(p, li, b, smem);
      } else if (b < 192) {
        attnC_item(p, li, b - 128, smem);
        h1_item(p, b - 128, smem);
      } else {
        const int j = b - 192;
        h1_item(p, 64 + j, smem);
        h1_item(p, 64 + 320 + j, smem);
        if (j < 64) h1_item(p, 64 + 640 + j, smem);
        else attnA_item(p, li, 128 + (j - 64), smem);
      }
    } else {
      const int it_lo = sub == 2 ? 128 : (sub == 3 ? 192 : (sub == 4 ? 960 : 0)), it_hi = sub == 1 ? 128 : (sub == 2 ? 192 : (sub == 3 ? 960 : 1216));
      for (int it = it_lo + blockIdx.x; it < it_hi; it += gridDim.x) {
        if (it >= 192 && it < 960) h1_item(p, it - 192, smem);
        else if (it >= 128 && it < 192) attnC_item(p, li, it - 128, smem);
        else attnA_item(p, li, it < 128 ? it : it - 832, smem);
      }
    }
  } else if (s == 3) {
    for (int it = blockIdx.x; it < 512; it += gridDim.x) {
      if (it < 384) h2_item(p, li, it, smem);
      else attnC_item(p, li, it - 384 + 64, smem);
    }
  } else if (s == 4) {
    g.alo = xin_lo; g.ahi = xin_hi; g.stats = xin_st; g.lng = xin_g; g.lnb = xin_b;
    g.sc_off = 2048;
    g.a16 = (const u16*)(p.ws + O_MIXED);
    g.bt = (const u16*)(p.ws + O_WTOUT) + (size_t)li * D * D; g.K = D; g.N = D;
    g.xout = XPRE1; g.sout = ST1;
    gemm_phase<1, 3>(p, g, li, smem);
  } else if (s == 5) {
    ln_apply(p, XPRE1, XPRE1 + (size_t)NCTX * 1024, ST1, p.in[24] + li * 1024, p.in[25] + li * 1024, g.mods, 4096, 3072);
  } else if (s == 6) {
    g.bt = (const u16*)(p.ws + O_WTFF1) + (size_t)li * DFF * D; g.K = D; g.N = DFF;
    g.hid = (u16*)(p.ws + O_HID);
    gemm_phase<2>(p, g, li, smem);
  } else {
    g.alo = XPRE1; g.ahi = XPRE1 + (size_t)NCTX * 1024; g.stats = ST1; g.lng = p.in[24] + li * 1024; g.lnb = p.in[25] + li * 1024;
    g.sc_off = 5120;
    g.a16 = (const u16*)(p.ws + O_HID);
    g.bt = (const u16*)(p.ws + O_WTFF2) + (size_t)li * D * DFF; g.K = DFF; g.N = D;
    g.xout = XPRE2; g.sout = ST2;
    gemm_phase<1, 3>(p, g, li, smem);
  }
}

#define XB_TMO      128
#define XB_XCNT(j)  (256  + 64 * (j))
#define XB_XSUB(j)  (1280 + 64 * (j))
#define XB_XGEN(j)  (2304 + 64 * (j))
#define XB_TOP      3328
#define XB_TOPGEN   3392
#define XCD_BAR_WORDS 3456
#define XB_SPIN_CAP (1u << 20)
#define LAS __attribute__((address_space(3)))
DI unsigned xb_ld(unsigned* p) { return __hip_atomic_load(p, __ATOMIC_RELAXED, __HIP_MEMORY_SCOPE_AGENT); }
DI unsigned xb_add(unsigned* p, unsigned v) { return __hip_atomic_fetch_add(p, v, __ATOMIC_RELAXED, __HIP_MEMORY_SCOPE_AGENT); }
DI unsigned xb_xcc_id() { return (unsigned)__builtin_amdgcn_s_getreg((3 << 11) | 20) & 0xFu; }
#define XB_SPIN(cond, bar) do { unsigned _sp = 0; while (cond) { __builtin_amdgcn_s_sleep(1); \
    if ((++_sp & 255u) == 0u) { if (xb_ld(&(bar)[XB_TMO])) break; if (_sp > XB_SPIN_CAP) { atomicAdd(&(bar)[XB_TMO], 1u); break; } } } } while (0)
struct XcdBarrier { unsigned* bar; unsigned x; volatile LAS unsigned* st; };
DI XcdBarrier xcd_barrier_post(unsigned* bar, volatile LAS unsigned* st) {
  XcdBarrier b; b.bar = bar; b.x = xb_xcc_id(); b.st = st;
  if (threadIdx.x == 0) (void)xb_add(&bar[XB_XCNT(b.x)], 1u);
  return b;
}
DI void xcd_barrier_complete(unsigned* bar, unsigned x, unsigned& nloc, unsigned& nx) {
  const unsigned G = gridDim.x * gridDim.y * gridDim.z;
  unsigned sum, cnt, mine, sp = 0u;
  for (;;) {
    sum = 0u; cnt = 0u; mine = 0u;
#pragma unroll
    for (unsigned j = 0; j < 16; ++j) { const unsigned c = xb_ld(&bar[XB_XCNT(j)]); sum += c; cnt += (c > 0u) ? 1u : 0u; mine = (j == x) ? c : mine; }
    if (sum == G) break;
    __builtin_amdgcn_s_sleep(1);
    if ((++sp & 255u) == 0u) { if (xb_ld(&bar[XB_TMO])) break; if (sp > XB_SPIN_CAP) { atomicAdd(&bar[XB_TMO], 1u); break; } }
  }
  nloc = mine > 0u ? mine : 1u; nx = cnt > 0u ? cnt : 1u;
}
DI void xcd_barrier(const XcdBarrier& b) {
  asm volatile("s_waitcnt vmcnt(0)" ::: "memory");
  __syncthreads();
  if (threadIdx.x == 0) {
    unsigned* bar = b.bar;
    __builtin_amdgcn_s_waitcnt(0);
    unsigned nloc = b.st[0], nx = b.st[1];
    if (nloc == 0u) { xcd_barrier_complete(bar, b.x, nloc, nx); b.st[0] = nloc; b.st[1] = nx; }
    const unsigned old = xb_add(&bar[XB_XSUB(b.x)], 1u);
    const unsigned gen = old / nloc;
    if (old + 1u == (gen + 1u) * nloc) {
      __builtin_amdgcn_fence(__ATOMIC_RELEASE, "agent");
      asm volatile("s_waitcnt vmcnt(0)" ::: "memory");
      const unsigned og = xb_add(&bar[XB_TOP], 1u);
      const unsigned tg = og / nx;
      if (og + 1u == (tg + 1u) * nx) xb_add(&bar[XB_TOPGEN], 1u);
      else XB_SPIN(xb_ld(&bar[XB_TOPGEN]) == tg, bar);
      __builtin_amdgcn_fence(__ATOMIC_ACQUIRE, "agent");
      xb_add(&bar[XB_XGEN(b.x)], 1u);
      asm volatile("s_waitcnt vmcnt(0)" ::: "memory");
    } else {
      XB_SPIN(xb_ld(&bar[XB_XGEN(b.x)]) == gen, bar);
      __builtin_amdgcn_fence(__ATOMIC_ACQUIRE, "agent");
      asm volatile("s_waitcnt vmcnt(0)" ::: "memory");
    }
  }
  __syncthreads();
}
constexpr size_t O_BAR = O_END1;
static_assert(O_BAR + XCD_BAR_WORDS * 4 <= (size_t)256 * 1024 * 1024, "barrier words must fit");

#if !MULTI_LAUNCH
__global__ void __launch_bounds__(256, 2) mega_kernel(P p) {
  extern __shared__ __attribute__((aligned(16))) char smem[];
  cg::grid_group grid = cg::this_grid();
  if (p.ws == nullptr) grid.sync();
  if (threadIdx.x == 0) *(uint4*)(smem + LDS_BYTES - 16) = make_uint4(0u, 0u, 0u, 0u);
  __syncthreads();
  XcdBarrier xb = xcd_barrier_post((unsigned*)(p.ws + O_BAR), (volatile LAS unsigned*)(smem + LDS_BYTES - 16));
  run_phase(p, 0, smem); xcd_barrier(xb);
  run_phase(p, 1, smem); xcd_barrier(xb);
  run_phase(p, 2, smem); xcd_barrier(xb);
  run_phase(p, 3, smem); xcd_barrier(xb);
  run_phase(p, 4, smem); xcd_barrier(xb);
  run_phase(p, 5, smem); xcd_barrier(xb);
  run_phase(p, 6, smem); xcd_barrier(xb);
  run_phase(p, 7, smem); xcd_barrier(xb);
  run_phase(p, 8, smem); xcd_barrier(xb);
  run_phase(p, 9, smem); xcd_barrier(xb);
  run_phase(p, 10, smem); xcd_barrier(xb);
  run_phase(p, 11, smem); xcd_barrier(xb);
  run_phase(p, 12, smem); xcd_barrier(xb);
  run_phase(p, 13, smem); xcd_barrier(xb);
  run_phase(p, 14, smem); xcd_barrier(xb);
  run_phase(p, 15, smem); xcd_barrier(xb);
  run_phase(p, 16, smem); xcd_barrier(xb);
  run_phase(p, 17, smem);
}
#define MAIN_KERNEL mega_kernel
#else
template <int PH>
__global__ void __launch_bounds__(256, 2) phase_kernel(P p, int sub) {
  extern __shared__ __attribute__((aligned(16))) char smem[];
  run_phase(p, PH, smem, sub);
}
typedef void (*phase_fn)(P, int);
static phase_fn phase_table[NPHASE] = {phase_kernel<0>, phase_kernel<1>, phase_kernel<2>, phase_kernel<3>, phase_kernel<4>, phase_kernel<5>,
                                       phase_kernel<6>, phase_kernel<7>, phase_kernel<8>, phase_kernel<9>, phase_kernel<10>, phase_kernel<11>,
                                       phase_kernel<12>, phase_kernel<13>, phase_kernel<14>, phase_kernel<15>, phase_kernel<16>, phase_kernel<17>};
#define MAIN_KERNEL phase_kernel<2>
#endif

extern "C" void kernel_launch(void* const* d_in, const int* in_sizes, int n_in, void* d_out, int out_size, void* d_ws,
                              size_t ws_size, hipStream_t stream) {
  static int grid_blocks = 0;
  if (!grid_blocks) {
    int dev = 0, cus = 0, per_cu = 0;
    (void)hipGetDevice(&dev);
    (void)hipDeviceGetAttribute(&cus, hipDeviceAttributeMultiprocessorCount, dev);
    (void)hipFuncSetAttribute((const void*)MAIN_KERNEL, hipFuncAttributeMaxDynamicSharedMemorySize, LDS_BYTES);
    (void)hipOccupancyMaxActiveBlocksPerMultiprocessor(&per_cu, MAIN_KERNEL, 256, LDS_BYTES);
    if (per_cu > 2) per_cu = 2;
    if (per_cu < 1) per_cu = 1;
    grid_blocks = cus * per_cu;
  }
  P p{};
  for (int i = 0; i < 30; ++i) p.in[i] = (const float*)d_in[i];
  p.out = (float*)d_out;
  p.ws = (char*)d_ws;
#if MULTI_LAUNCH
  for (int ph = 0; ph < NPHASE; ++ph) {
    (void)hipFuncSetAttribute((const void*)phase_table[ph], hipFuncAttributeMaxDynamicSharedMemorySize, LDS_BYTES);
    phase_table[ph]<<<dim3(grid_blocks), dim3(256), LDS_BYTES, stream>>>(p, 0);
#ifdef DUP_MASK
    int bit = (ph == 0) ? 8 : (ph == NPHASE - 1 ? 9 : (ph - 1) & 7);
    if ((DUP_MASK >> bit) & 1) phase_table[ph]<<<dim3(grid_blocks), dim3(256), LDS_BYTES, stream>>>(p, DUP_SUB);
#endif
  }
#else
  (void)hipMemsetAsync((char*)d_ws + O_BAR, 0, XCD_BAR_WORDS * 4, stream);
  void* args[] = {&p};
  hipError_t e = hipLaunchCooperativeKernel((void*)mega_kernel, dim3(grid_blocks), dim3(256), args, LDS_BYTES, stream);
  if (e != hipSuccess) fprintf(stderr, "cooperative launch failed: %s (grid %d)\n", hipGetErrorString(e), grid_blocks);
#endif
}
```

```cpp
#include <hip/hip_runtime.h>
#include <hip/hip_cooperative_groups.h>
#include <stdint.h>
#include <stdio.h>
namespace cg = cooperative_groups;

#ifndef MULTI_LAUNCH
#define MULTI_LAUNCH 0
#endif

#define DI __device__ __forceinline__
typedef unsigned short u16;
using bf16x8 = __attribute__((ext_vector_type(8))) short;
using f32x4 = __attribute__((ext_vector_type(4))) float;
typedef __bf16 bf2_t __attribute__((ext_vector_type(2)));
typedef float f2_t __attribute__((ext_vector_type(2)));
typedef unsigned u32x4 __attribute__((ext_vector_type(4)));
typedef unsigned u32x2 __attribute__((ext_vector_type(2)));

constexpr int D = 1024, NTOK = 6144, NCTX = 4096, NIN = 3328, DFF = 4096;
constexpr float ALPHA = 1.41421356237309515f;
constexpr float LOG2E = 1.44269504088896341f;
constexpr int LDS_BYTES = 75776;
constexpr int NPHASE = 18;

constexpr size_t O_WTIN = 0;
constexpr size_t O_WTOUT = O_WTIN + (size_t)2 * NIN * D * 2;
constexpr size_t O_WTFF1 = O_WTOUT + (size_t)2 * D * D * 2;
constexpr size_t O_WTFF2 = O_WTFF1 + (size_t)2 * DFF * D * 2;
constexpr size_t O_MODS = O_WTFF2 + (size_t)2 * D * DFF * 2;
constexpr size_t O_ROPE = O_MODS + (size_t)2 * 3 * 6144 * 4;
constexpr size_t O_QA = O_ROPE + (size_t)1024 * 32 * 2 * 4;
constexpr size_t O_KACTX = O_QA + (size_t)NTOK * 512 * 2;
constexpr size_t O_KALAT = O_KACTX + (size_t)NCTX * 512 * 2;
constexpr size_t O_VTACTX = O_KALAT + (size_t)2 * 2 * 1536 * 512 * 2;
constexpr size_t O_VTALAT = O_VTACTX + (size_t)16 * 4 * 128 * 256 * 2;
constexpr size_t O_QC = O_VTALAT + (size_t)2 * 2 * 4 * 128 * 1536 * 2;
constexpr size_t O_KCCTX = O_QC + (size_t)NTOK * 256 * 2;
constexpr size_t O_KCLAT = O_KCCTX + (size_t)NCTX * 128 * 2;
constexpr size_t O_VTCCTX = O_KCLAT + (size_t)2 * 2 * 1536 * 128 * 2;
constexpr size_t O_VTCLAT = O_VTCCTX + (size_t)16 * 2 * 64 * 256 * 2;
constexpr size_t O_KV = O_VTCLAT + (size_t)2 * 2 * 2 * 64 * 1536 * 2;
constexpr size_t O_DEC = O_KV + (size_t)768 * 4096 * 4;
constexpr size_t O_MIXED = O_DEC + (size_t)768 * 64 * 4;
constexpr size_t O_XPRE1 = O_MIXED + (size_t)NTOK * 1024 * 2;
constexpr size_t O_ST1 = O_XPRE1 + (size_t)NTOK * 1024 * 4;
constexpr size_t O_XPRE2 = O_ST1 + (size_t)NTOK * 32 * 4;
constexpr size_t O_ST2 = O_XPRE2 + (size_t)NTOK * 1024 * 4;
constexpr size_t O_ABF = O_ST2 + (size_t)NTOK * 32 * 4;
constexpr size_t O_HQ = O_ABF + (size_t)NTOK * 1024 * 2;
constexpr size_t O_HGF = O_HQ + (size_t)NTOK * 256 * 4;
constexpr size_t O_HGB = O_HGF + (size_t)NTOK * 256 * 4;
constexpr size_t O_HI = O_HGB + (size_t)NTOK * 256 * 4;
constexpr size_t O_HSG = O_HI + (size_t)NTOK * 256 * 4;
constexpr size_t O_OI = O_HSG + (size_t)NTOK * 256 * 4;
constexpr size_t O_QE = O_OI + (size_t)2 * NTOK * 256 * 4;
constexpr size_t O_END1 = O_QE + (size_t)2 * NTOK * 256 * 4;
constexpr size_t O_HID = O_HQ;
constexpr size_t O_END2 = O_HID + (size_t)NTOK * 4096 * 2;
static_assert(O_END2 <= O_END1, "HID alias must fit");
static_assert(O_END1 <= (size_t)256 * 1024 * 1024, "workspace too big");

constexpr size_t OUT_YP = 0, OUT_YS = 4194304, OUT_AK = 6291456, OUT_AV = 10485760, OUT_CK = 14680064,
                 OUT_CV = 15728640, OUT_SF = 16777216, OUT_SB = 17301504;

struct P {
  const float* in[30];
  float* out;
  char* ws;
};

DI unsigned pack2(float a, float b) {
  f2_t v = {a, b};
  bf2_t r = __builtin_convertvector(v, bf2_t);
  return __builtin_bit_cast(unsigned, r);
}
DI u16 f2bf(float x) { return (u16)(pack2(x, 0.f) & 0xffffu); }
DI float ex2(float x) { return __builtin_amdgcn_exp2f(x); }
DI float siluf(float x) { return x / (1.f + expf(-x)); }
DI float shx(float v, int m) { return __shfl_xor(v, m, 64); }
DI float red16(float x) {
  x += __builtin_bit_cast(float, __builtin_amdgcn_update_dpp(0, __builtin_bit_cast(int, x), 0xB1, 0xF, 0xF, true));
  x += __builtin_bit_cast(float, __builtin_amdgcn_update_dpp(0, __builtin_bit_cast(int, x), 0x4E, 0xF, 0xF, true));
  x += __builtin_bit_cast(float, __builtin_amdgcn_update_dpp(0, __builtin_bit_cast(int, x), 0x141, 0xF, 0xF, true));
  x += __builtin_bit_cast(float, __builtin_amdgcn_update_dpp(0, __builtin_bit_cast(int, x), 0x140, 0xF, 0xF, true));
  return x;
}
DI float xor1(float x) { return __builtin_bit_cast(float, __builtin_amdgcn_update_dpp(0, __builtin_bit_cast(int, x), 0xB1, 0xF, 0xF, true)); }
DI int ltid() { int t = threadIdx.x; asm volatile("" : "+v"(t)); return t; }
#define MFMA16(a, b, c) __builtin_amdgcn_mfma_f32_16x16x32_bf16((a), (b), (c), 0, 0, 0)

DI void p0_mod(const P& p, int item, char* smem) {
  float* ssilu = (float*)smem;
  float* red = ssilu + 3072;
  const int tid = ltid();
  __syncthreads();
  for (int i = tid; i < 3072; i += 256) {
    int w = i >> 10, k = i & 1023;
    float v = (w == 0) ? p.in[9][k] : p.in[8][(w - 1) * 1024 + k];
    ssilu[i] = siluf(v);
  }
  __syncthreads();
  const int li = item / 96, j0 = (item % 96) * 64;
  const int c4 = tid & 15, kp = tid >> 4;
  const float* W = p.in[10] + (size_t)li * 1024 * 6144 + j0 + c4 * 4;
  float4 a0 = {0, 0, 0, 0}, a1 = a0, a2 = a0;
#pragma unroll 16
  for (int kk = 0; kk < 64; ++kk) {
    int k = kp * 64 + kk;
    float4 w4 = *(const float4*)(W + (size_t)k * 6144);
    float s0 = ssilu[k], s1 = ssilu[1024 + k], s2 = ssilu[2048 + k];
    a0.x += s0 * w4.x; a0.y += s0 * w4.y; a0.z += s0 * w4.z; a0.w += s0 * w4.w;
    a1.x += s1 * w4.x; a1.y += s1 * w4.y; a1.z += s1 * w4.z; a1.w += s1 * w4.w;
    a2.x += s2 * w4.x; a2.y += s2 * w4.y; a2.z += s2 * w4.z; a2.w += s2 * w4.w;
  }
  *(float4*)(red + (kp * 3 + 0) * 64 + c4 * 4) = a0;
  *(float4*)(red + (kp * 3 + 1) * 64 + c4 * 4) = a1;
  *(float4*)(red + (kp * 3 + 2) * 64 + c4 * 4) = a2;
  __syncthreads();
  if (tid < 192) {
    int w = tid >> 6, c = tid & 63;
    float s = p.in[11][li * 6144 + j0 + c];
    for (int q = 0; q < 16; ++q) s += red[(q * 3 + w) * 64 + c];
    ((float*)(p.ws + O_MODS))[(li * 3 + w) * 6144 + j0 + c] = s;
  }
}

DI void p0_rope(const P& p, int item) {
  float* R = (float*)(p.ws + O_ROPE);
  for (int i = ltid(); i < 4096; i += 256) {
    int idx = item * 4096 + i;
    int t = idx >> 5, pp = idx & 31;
    float inv = powf(10000.f, -(float)(pp & 15) / 16.f);
    float pos = (pp < 16) ? (float)(t >> 6) : (float)(t & 63);
    float ang = pos * inv;
    R[idx * 2] = cosf(ang);
    R[idx * 2 + 1] = sinf(ang);
  }
}

DI void p0_copyk(const P& p, int item, bool isA) {
  const int W = isA ? 512 : 128;
  const float* src = isA ? p.in[2] : p.in[4];
  u16* dst = (u16*)(p.ws + (isA ? O_KALAT : O_KCLAT));
  for (int i = 0; i < 4; ++i) {
    size_t e = (size_t)item * 4096 + (size_t)(ltid() + 256 * i) * 4;
    float4 v = *(const float4*)(src + e);
    int c = (int)(e % W);
    size_t r = e / W;
    int pp = (int)(r % 512);
    int bl = (int)(r / 512);
    int b = bl >> 1, li = bl & 1;
    uint2 o;
    o.x = pack2(v.x, v.y);
    o.y = pack2(v.z, v.w);
    *(uint2*)(dst + ((size_t)((li * 2 + b) * 1536 + 1024 + pp)) * W + c) = o;
  }
}

struct TDesc { const float* src; int sstride; u16* dst; int dstride; };

DI TDesc tdesc(const P& p, int t) {
  constexpr int T_IN = 1664, T_OUT = 512, T_FF1 = 2048, T_FF2 = 2048, T_AV = 256;
  TDesc d;
  if (t < T_IN) {
    int li = t / 832, r = t % 832, kt = r / 52, nt = r % 52;
    d.src = p.in[12] + (size_t)li * 1024 * NIN + (size_t)(kt * 64) * NIN + nt * 64; d.sstride = NIN;
    d.dst = (u16*)(p.ws + O_WTIN) + (size_t)li * NIN * 1024 + (size_t)(nt * 64) * 1024 + kt * 64; d.dstride = 1024;
  } else if ((t -= T_IN) < T_OUT) {
    int li = t / 256, r = t % 256, kt = r / 16, nt = r % 16;
    d.src = p.in[13] + (size_t)li * 1024 * 1024 + (size_t)(kt * 64) * 1024 + nt * 64; d.sstride = 1024;
    d.dst = (u16*)(p.ws + O_WTOUT) + (size_t)li * 1024 * 1024 + (size_t)(nt * 64) * 1024 + kt * 64; d.dstride = 1024;
  } else if ((t -= T_OUT) < T_FF1) {
    int li = t / 1024, r = t % 1024, kt = r / 64, nt = r % 64;
    d.src = p.in[28] + (size_t)li * 1024 * DFF + (size_t)(kt * 64) * DFF + nt * 64; d.sstride = DFF;
    d.dst = (u16*)(p.ws + O_WTFF1) + (size_t)li * DFF * 1024 + (size_t)(nt * 64) * 1024 + kt * 64; d.dstride = 1024;
  } else if ((t -= T_FF1) < T_FF2) {
    int li = t / 1024, r = t % 1024, kt = r / 16, nt = r % 16;
    d.src = p.in[29] + (size_t)li * DFF * 1024 + (size_t)(kt * 64) * 1024 + nt * 64; d.sstride = 1024;
    d.dst = (u16*)(p.ws + O_WTFF2) + (size_t)li * 1024 * DFF + (size_t)(nt * 64) * DFF + kt * 64; d.dstride = DFF;
  } else if ((t -= T_FF2) < T_AV) {
    int bl = t / 64, r = t % 64, pt = r / 8, ct = r % 8;
    int b = bl >> 1, li = bl & 1;
    d.src = p.in[3] + ((size_t)bl * 512 + pt * 64) * 512 + ct * 64; d.sstride = 512;
    d.dst = (u16*)(p.ws + O_VTALAT) + ((size_t)(li * 2 + b) * 512 + ct * 64) * 1536 + 1024 + pt * 64; d.dstride = 1536;
  } else {
    t -= T_AV;
    int bl = t / 16, r = t % 16, pt = r / 2, ct = r % 2;
    int b = bl >> 1, li = bl & 1;
    d.src = p.in[5] + ((size_t)bl * 512 + pt * 64) * 128 + ct * 64; d.sstride = 128;
    d.dst = (u16*)(p.ws + O_VTCLAT) + ((size_t)(li * 2 + b) * 128 + ct * 64) * 1536 + 1024 + pt * 64; d.dstride = 1536;
  }
  return d;
}

DI int tcount(int mode) { return mode == 0 ? 832 + 256 + 320 : (mode == 1 ? 832 + 256 : 2048); }
DI int tmap(int k, int mode) {
  if (mode == 0) {
    if (k < 832) return k;
    if (k < 1088) return 1664 + (k - 832);
    return 6272 + (k - 1088);
  }
  if (mode == 1) {
    if (k < 832) return 832 + k;
    return 1920 + (k - 832);
  }
  const int li = mode - 2;
  if (k < 1024) return 2176 + li * 1024 + k;
  return 4224 + li * 1024 + (k - 1024);
}
DI void run_transposes(const P& p, char* smem, int first, int step, int deferred, int count_override = -1) {
  const int count = count_override >= 0 ? count_override : tcount(deferred);
  float* tl = (float*)smem;
  const int tid = ltid();
  const int lr = tid >> 4, lc4 = tid & 15;
  const int c = tid >> 2, rs = tid & 3;
  int t = first;
  f32x4 v[4];
  TDesc cur;
  if (t < count) {
    cur = tdesc(p, tmap(t, deferred));
#pragma unroll
    for (int i = 0; i < 4; ++i) v[i] = *(const f32x4*)(cur.src + (size_t)(lr + 16 * i) * cur.sstride + lc4 * 4);
  }
  while (t < count) {
    __syncthreads();
#pragma unroll
    for (int i = 0; i < 4; ++i) {
      float* q = tl + (lr + 16 * i) * 65 + lc4 * 4;
      q[0] = v[i].x; q[1] = v[i].y; q[2] = v[i].z; q[3] = v[i].w;
    }
    const int tn = t + step;
    TDesc nxt = cur;
    if (tn < count) {
      nxt = tdesc(p, tmap(tn, deferred));
#pragma unroll
      for (int i = 0; i < 4; ++i) v[i] = *(const f32x4*)(nxt.src + (size_t)(lr + 16 * i) * nxt.sstride + lc4 * 4);
    }
    __syncthreads();
    u32x4 o0, o1;
    {
      const float* q = tl + (rs * 16) * 65 + c;
      o0.x = pack2(q[0 * 65], q[1 * 65]);   o0.y = pack2(q[2 * 65], q[3 * 65]);
      o0.z = pack2(q[4 * 65], q[5 * 65]);   o0.w = pack2(q[6 * 65], q[7 * 65]);
      o1.x = pack2(q[8 * 65], q[9 * 65]);   o1.y = pack2(q[10 * 65], q[11 * 65]);
      o1.z = pack2(q[12 * 65], q[13 * 65]); o1.w = pack2(q[14 * 65], q[15 * 65]);
    }
    u32x4* dp = (u32x4*)(cur.dst + (size_t)c * cur.dstride + rs * 16);
    dp[0] = o0;
    dp[1] = o1;
    cur = nxt;
    t = tn;
  }
}

DI void phase0(const P& p, char* smem) {
  constexpr int N_MOD = 192, N_ROPE = 8, N_AK = 256, N_CK = 64;
  constexpr int B_ROPE = N_MOD, B_AK = B_ROPE + N_ROPE, B_CK = B_AK + N_AK, B_T = B_CK + N_CK;
  constexpr int NTILES = 1664 + 512 + 2048 + 2048 + 256 + 64;
  for (int it = blockIdx.x; it < B_T; it += gridDim.x) {
    if (it < B_ROPE) p0_mod(p, it, smem);
    else if (it < B_AK) p0_rope(p, it - B_ROPE);
    else if (it < B_CK) p0_copyk(p, it - B_AK, true);
    else p0_copyk(p, it - B_CK, false);
  }
  run_transposes(p, smem, blockIdx.x, gridDim.x, 0);
}

struct GA {
  const float* alo;
  const float* ahi;
  const float* stats;
  const float* lng;
  const float* lnb;
  const float* mods;
  int sc_off, sh_off;
  const u16* a16;
  const u16* bt;
  int K, N;
  float* xout;
  float* sout;
  u16* hid;
};

DI void epi_inproj(const P& p, int li, f32x4 (&acc)[4][4], int R0, int C0);


template <int EPI, int MI = 4>
DI void gemm_tile(const P& p, const GA& g, int li, int m0, int n0, char* smem, u32x4 (&ra0)[4], u32x4 (&rb0)[4],
                  u32x4 (&ra1)[4], u32x4 (&rb1)[4], bool primed, int nm0, int nn0) {
  static_assert(MI == 4 || EPI == 1, "only the residual epilogue supports 96-row tiles");
  constexpr int WM = MI * 16;
  const int tid = ltid(), lane = tid & 63, wid = tid >> 6, wr = wid >> 1, wc = wid & 1;
  const int l16 = lane & 15, q4 = lane >> 4;
  u16* sA0 = (u16*)smem;
  u16* sB0 = sA0 + 128 * 72;
  u16* sA1 = sB0 + 128 * 72;
  u16* sB1 = sA1 + 128 * 72;
  float2* sStat = (float2*)(smem + 73728);
  const int K = g.K;
  const int rtype = (m0 < NCTX) ? 0 : 1 + ((m0 - NCTX) >> 10);
  const float* modv = g.mods + rtype * 6144;
  const float* fsrc = (m0 < NCTX) ? g.alo + (size_t)m0 * 1024 : g.ahi + (size_t)(m0 - NCTX) * 1024;

  if (!primed) {
    const unsigned goff_ = (unsigned)(tid >> 3) * (unsigned)g.K + (unsigned)(tid & 7) * 8u;
    const u16* ab_ = g.a16 + (size_t)m0 * g.K;
    const u16* bb_ = g.bt + (size_t)n0 * g.K;
#pragma unroll
    for (int i = 0; i < 4; ++i) {
      if (i < MI) ra0[i] = *(const u32x4*)(ab_ + (size_t)(32 * i) * g.K + goff_);
      rb0[i] = *(const u32x4*)(bb_ + (size_t)(32 * i) * g.K + goff_);
    }
    __builtin_amdgcn_sched_barrier(0);
#pragma unroll
    for (int i = 0; i < 4; ++i) {
      if (i < MI) ra1[i] = *(const u32x4*)(ab_ + (size_t)(32 * i) * g.K + 64 + goff_);
      rb1[i] = *(const u32x4*)(bb_ + (size_t)(32 * i) * g.K + 64 + goff_);
    }
    __builtin_amdgcn_sched_barrier(0);
  }
  __syncthreads();
  if constexpr (EPI == 1 || EPI == 3) {
    if (g.stats != nullptr && tid < 2 * WM) {
      const float4* sp = (const float4*)(g.stats + (size_t)(m0 + tid) * 32);
      float s1 = 0.f, s2 = 0.f;
#pragma unroll
      for (int i = 0; i < 8; ++i) {
        float4 v = sp[i];
        s1 += v.x + v.z;
        s2 += v.y + v.w;
      }
      float mu = s1 * (1.f / 1024.f);
      float var = s2 * (1.f / 1024.f) - mu * mu;
      sStat[tid] = make_float2(mu, rsqrtf(fmaxf(var, 0.f) + 1e-6f));
    }
  }

  f32x4 acc[MI][4];
#pragma unroll
  for (int i = 0; i < MI; ++i)
#pragma unroll
    for (int j = 0; j < 4; ++j) acc[i][j] = f32x4{0.f, 0.f, 0.f, 0.f};

  const unsigned goff = (unsigned)(tid >> 3) * (unsigned)K + (unsigned)(tid & 7) * 8u;
  const unsigned loff = (unsigned)(tid >> 3) * 72u + (unsigned)(tid & 7) * 8u;
  const u16* abase = g.a16 + (size_t)m0 * K;
  const u16* bbase = g.bt + (size_t)n0 * K;
#define GLOAD(RA, RB, KT)                                                        \
  _Pragma("unroll") for (int i = 0; i < 4; ++i) {                                \
    if (i < MI) RA[i] = *(const u32x4*)(abase + (size_t)(32 * i) * K + (KT) * 64 + goff); \
    RB[i] = *(const u32x4*)(bbase + (size_t)(32 * i) * K + (KT) * 64 + goff);    \
  }
#define LSTORE(SA, SB, RA, RB)                                                   \
  _Pragma("unroll") for (int i = 0; i < 4; ++i) {                                \
    if (i < MI) *(u32x4*)(SA + 32 * i * 72 + loff) = RA[i];                      \
    *(u32x4*)(SB + 32 * i * 72 + loff) = RB[i];                                  \
  }
#define COMPUTE(SA, SB)                                                          \
  _Pragma("unroll") for (int s = 0; s < 2; ++s) {                                \
    bf16x8 af[MI], bfr[4];                                                       \
    _Pragma("unroll") for (int i = 0; i < 4; ++i) {                              \
      if (i < MI) af[i] = *(const bf16x8*)(SA + (wr * WM + i * 16 + l16) * 72 + s * 32 + q4 * 8);  \
      bfr[i] = *(const bf16x8*)(SB + (wc * 64 + i * 16 + l16) * 72 + s * 32 + q4 * 8); \
    }                                                                            \
    __builtin_amdgcn_s_setprio(1);                                               \
    _Pragma("unroll") for (int i = 0; i < MI; ++i)                               \
      _Pragma("unroll") for (int j = 0; j < 4; ++j) acc[i][j] = MFMA16(af[i], bfr[j], acc[i][j]); \
    __builtin_amdgcn_s_setprio(0);                                               \
    __builtin_amdgcn_sched_barrier(0);                                           \
  }

  const int nk = K >> 6;
#define SB0 __builtin_amdgcn_sched_barrier(0)
  LSTORE(sA0, sB0, ra0, rb0);
  SB0;
  GLOAD(ra0, rb0, 2);
  SB0;
  __syncthreads();
#pragma unroll 1
  for (int kt = 0; kt < nk - 4; kt += 2) {
    SB0;
    LSTORE(sA1, sB1, ra1, rb1);
    SB0;
    GLOAD(ra1, rb1, kt + 3);
    SB0;
    COMPUTE(sA0, sB0);
    __syncthreads();
    SB0;
    LSTORE(sA0, sB0, ra0, rb0);
    SB0;
    GLOAD(ra0, rb0, kt + 4);
    SB0;
    COMPUTE(sA1, sB1);
    __syncthreads();
  }
  SB0;
  LSTORE(sA1, sB1, ra1, rb1);
  SB0;
  GLOAD(ra1, rb1, nk - 1);
  SB0;
  COMPUTE(sA0, sB0);
  __syncthreads();
  const u16* nabase = g.a16 + (size_t)nm0 * K;
  const u16* nbbase = g.bt + (size_t)nn0 * K;
  SB0;
  LSTORE(sA0, sB0, ra0, rb0);
  SB0;
  _Pragma("unroll") for (int i = 0; i < 4; ++i) {
    if (i < MI) ra0[i] = *(const u32x4*)(nabase + (size_t)(32 * i) * K + goff);
    rb0[i] = *(const u32x4*)(nbbase + (size_t)(32 * i) * K + goff);
  }
  SB0;
  COMPUTE(sA1, sB1);
  __syncthreads();
  SB0;
  LSTORE(sA1, sB1, ra1, rb1);
  SB0;
  _Pragma("unroll") for (int i = 0; i < 4; ++i) {
    if (i < MI) ra1[i] = *(const u32x4*)(nabase + (size_t)(32 * i) * K + 64 + goff);
    rb1[i] = *(const u32x4*)(nbbase + (size_t)(32 * i) * K + 64 + goff);
  }
  SB0;
  COMPUTE(sA0, sB0);
  __syncthreads();
  SB0;
  COMPUTE(sA1, sB1);
#undef GLOAD
#undef LSTORE
#undef COMPUTE
#undef SB0
  asm volatile("" ::: "memory");

  const int R0 = m0 + wr * WM, C0 = n0 + wc * 64;
  if constexpr (EPI == 0) {
    if constexpr (MI == 4) epi_inproj(p, li, acc, R0, C0);
  } else if constexpr (EPI == 1) {
    const int rtA = rtype;
    const int mlast = m0 + 2 * WM - 1;
    const int rtB = (mlast < NCTX) ? 0 : 1 + ((mlast - NCTX) >> 10);
    const float* modvB = g.mods + rtB * 6144;
    float gateA[4], gateB[4], lg[4], lb[4];
#pragma unroll
    for (int j = 0; j < 4; ++j) {
      int col = C0 + j * 16 + l16;
      gateA[j] = modv[g.sc_off + col];
      gateB[j] = modvB[g.sc_off + col];
      lg[j] = g.stats ? g.lng[col] : 1.f;
      lb[j] = g.stats ? g.lnb[col] : 0.f;
    }
    float xr[MI][4][4];
#pragma unroll
    for (int i = 0; i < MI; ++i)
#pragma unroll
      for (int r = 0; r < 4; ++r) {
        const int grow = m0 + wr * WM + i * 16 + q4 * 4 + r;
        const float* rp = (grow < NCTX) ? g.alo + (size_t)grow * 1024 : g.ahi + (size_t)(grow - NCTX) * 1024;
#pragma unroll
        for (int j = 0; j < 4; ++j) xr[i][r][j] = rp[C0 + j * 16 + l16];
      }
#pragma unroll
    for (int i = 0; i < MI; ++i) {
#pragma unroll
      for (int r = 0; r < 4; ++r) {
        int lrow = wr * WM + i * 16 + q4 * 4 + r;
        const int grow = m0 + lrow;
        const int rt = (grow < NCTX) ? 0 : 1 + ((grow - NCTX) >> 10);
        const bool useA = (rt == rtA);
        float mu = 0.f, rs = 1.f;
        if (g.stats != nullptr) {
          float2 st = sStat[lrow];
          mu = st.x;
          rs = st.y;
        }
        float s1 = 0.f, s2 = 0.f;
#pragma unroll
        for (int j = 0; j < 4; ++j) {
          int col = C0 + j * 16 + l16;
          float x = xr[i][r][j];
          x = (x - mu) * rs * lg[j] + lb[j];
          float v = ALPHA * x + (useA ? gateA[j] : gateB[j]) * acc[i][j][r];
          g.xout[(size_t)grow * 1024 + col] = v;
          s1 += v;
          s2 += v * v;
        }
        s1 = red16(s1);
        s2 = red16(s2);
        if (l16 == 0) *(float2*)(g.sout + (size_t)grow * 32 + (C0 >> 6) * 2) = make_float2(s1, s2);
      }
    }
  } else {
    float* sC = (float*)smem;
    __syncthreads();
#pragma unroll
    for (int i = 0; i < 4; ++i)
#pragma unroll
      for (int j = 0; j < 4; ++j)
#pragma unroll
        for (int r = 0; r < 4; ++r) if constexpr (MI == 4) sC[(wr * 64 + i * 16 + q4 * 4 + r) * 132 + wc * 64 + j * 16 + l16] = acc[i][j][r];
    __syncthreads();
    if constexpr (EPI == 3) {
      const int hl = lane & 31, rsel = lane >> 5;
      const int col = n0 + hl * 4;
      const f32x4 gate4 = *(const f32x4*)(modv + g.sc_off + col);
      f32x4 lg4 = {1.f, 1.f, 1.f, 1.f}, lb4 = {0.f, 0.f, 0.f, 0.f};
      if (g.stats != nullptr) {
        lg4 = *(const f32x4*)(g.lng + col);
        lb4 = *(const f32x4*)(g.lnb + col);
      }
#pragma unroll 4
      for (int pp = 0; pp < 16; ++pp) {
        const int lrow = pp * 8 + wid * 2 + rsel;
        f32x4 a = *(const f32x4*)(sC + lrow * 132 + hl * 4);
        f32x4 x = *(const f32x4*)(fsrc + (size_t)lrow * 1024 + col);
        float mu = 0.f, rs = 1.f;
        if (g.stats != nullptr) {
          float2 st = sStat[lrow];
          mu = st.x;
          rs = st.y;
        }
        x = (x - mu) * rs * lg4 + lb4;
        f32x4 v = ALPHA * x + gate4 * a;
        *(f32x4*)(g.xout + (size_t)(m0 + lrow) * 1024 + col) = v;
        float s1 = (v.x + v.y) + (v.z + v.w);
        float s2 = (v.x * v.x + v.y * v.y) + (v.z * v.z + v.w * v.w);
        s1 = red16(s1);
        s2 = red16(s2);
        if ((lane & 15) == 0) *(float2*)(g.sout + (size_t)(m0 + lrow) * 32 + ((n0 >> 6) + (hl >> 4)) * 2) = make_float2(s1, s2);
      }
    } else {
#pragma unroll
      for (int pp = 0; pp < 8; ++pp) {
        const int idx = tid + 256 * pp;
        const int lrow = idx >> 4, c8 = idx & 15;
        f32x4 a0 = *(const f32x4*)(sC + lrow * 132 + c8 * 8);
        f32x4 a1 = *(const f32x4*)(sC + lrow * 132 + c8 * 8 + 4);
        a0.x = fmaxf(a0.x, 0.f); a0.y = fmaxf(a0.y, 0.f); a0.z = fmaxf(a0.z, 0.f); a0.w = fmaxf(a0.w, 0.f);
        a1.x = fmaxf(a1.x, 0.f); a1.y = fmaxf(a1.y, 0.f); a1.z = fmaxf(a1.z, 0.f); a1.w = fmaxf(a1.w, 0.f);
        u32x4 o;
        o.x = pack2(a0.x * a0.x, a0.y * a0.y);
        o.y = pack2(a0.z * a0.z, a0.w * a0.w);
        o.z = pack2(a1.x * a1.x, a1.y * a1.y);
        o.w = pack2(a1.z * a1.z, a1.w * a1.w);
        *(u32x4*)(g.hid + (size_t)(m0 + lrow) * DFF + n0 + c8 * 8) = o;
      }
    }
  }
}

DI void epi_inproj(const P& p, int li, f32x4 (&acc)[4][4], int R0, int C0) {
  const int lane = ltid() & 63, l16 = lane & 15, q4 = lane >> 4;
  const int seg = C0 >> 6;
  const bool lat = R0 >= NCTX;
  const float2* rope = (const float2*)(p.ws + O_ROPE);
  int b, tb;
  if (!lat) { b = R0 >> 8; tb = R0 & 255; } else { b = (R0 - NCTX) >> 10; tb = (R0 - NCTX) & 1023; }

  enum { T_QA, T_KA, T_VA, T_QB, T_FF, T_FB, T_IB, T_GB, T_QC, T_KC, T_VC };
  int type, cbase;
  if (seg < 8) { type = T_QA; cbase = seg * 64; }
  else if (seg < 16) { type = T_KA; cbase = (seg - 8) * 64; }
  else if (seg < 24) { type = T_VA; cbase = (seg - 16) * 64; }
  else if (seg < 28) { type = T_QB; cbase = (seg - 24) * 64; }
  else if (seg < 32) { type = T_FF; cbase = (seg - 28) * 64; }
  else if (seg < 36) { type = T_FB; cbase = (seg - 32) * 64; }
  else if (seg < 40) { type = T_IB; cbase = (seg - 36) * 64; }
  else if (seg < 44) { type = T_GB; cbase = (seg - 40) * 64; }
  else if (seg < 48) { type = T_QC; cbase = (seg - 44) * 64; }
  else if (seg < 50) { type = T_KC; cbase = (seg - 48) * 64; }
  else { type = T_VC; cbase = (seg - 50) * 64; }

  if (type == T_QC || type == T_KC) {
    const float* gv = (type == T_QC ? p.in[22] : p.in[23]) + li * 64;
    float gj[4];
#pragma unroll
    for (int j = 0; j < 4; ++j) gj[j] = gv[j * 16 + l16];
#pragma unroll
    for (int i = 0; i < 4; ++i)
#pragma unroll
      for (int r = 0; r < 4; ++r) {
        float ss = 0.f;
#pragma unroll
        for (int j = 0; j < 4; ++j) ss += acc[i][j][r] * acc[i][j][r];
        ss = red16(ss);
        float rs = rsqrtf(ss * (1.f / 64.f) + 1e-6f);
#pragma unroll
        for (int j = 0; j < 4; ++j) acc[i][j][r] = acc[i][j][r] * rs * gj[j];
      }
  }
  if (!lat && (type == T_KA || type == T_VA || type == T_KC || type == T_VC)) {
    float* o;
    int W;
    if (type == T_KA) { o = p.out + OUT_AK; W = 512; }
    else if (type == T_VA) { o = p.out + OUT_AV; W = 512; }
    else if (type == T_KC) { o = p.out + OUT_CK; W = 128; }
    else { o = p.out + OUT_CV; W = 128; }
#pragma unroll
    for (int i = 0; i < 4; ++i)
#pragma unroll
      for (int r = 0; r < 4; ++r) {
        int t = tb + i * 16 + q4 * 4 + r;
        size_t base = ((size_t)(b * 2 + li) * 256 + t) * W + cbase;
#pragma unroll
        for (int j = 0; j < 4; ++j) o[base + j * 16 + l16] = acc[i][j][r];
      }
  }
  if (lat && (type == T_QA || type == T_KA || type == T_QC || type == T_KC)) {
#pragma unroll
    for (int i = 0; i < 4; ++i)
#pragma unroll
      for (int r = 0; r < 4; ++r) {
        int t = tb + i * 16 + q4 * 4 + r;
#pragma unroll
        for (int j = 0; j < 4; ++j) {
          float v = acc[i][j][r];
          float pv = xor1(v);
          float2 cs = rope[t * 32 + j * 8 + (l16 >> 1)];
          acc[i][j][r] = (l16 & 1) ? (pv * cs.y + v * cs.x) : (v * cs.x - pv * cs.y);
        }
      }
  }

  if (type == T_QA || type == T_KA || type == T_QC || type == T_KC) {
    u16* dst;
    int W;
    size_t rowbase;
    if (type == T_QA) { dst = (u16*)(p.ws + O_QA); W = 512; rowbase = (size_t)R0 * 512; }
    else if (type == T_QC) { dst = (u16*)(p.ws + O_QC); W = 256; rowbase = (size_t)R0 * 256; }
    else if (type == T_KA) {
      W = 512;
      if (!lat) { dst = (u16*)(p.ws + O_KACTX); rowbase = (size_t)R0 * 512; }
      else { dst = (u16*)(p.ws + O_KALAT); rowbase = ((size_t)(li * 2 + b) * 1536 + tb) * 512; }
    } else {
      W = 128;
      if (!lat) { dst = (u16*)(p.ws + O_KCCTX); rowbase = (size_t)R0 * 128; }
      else { dst = (u16*)(p.ws + O_KCLAT); rowbase = ((size_t)(li * 2 + b) * 1536 + tb) * 128; }
    }
#pragma unroll
    for (int i = 0; i < 4; ++i)
#pragma unroll
      for (int r = 0; r < 4; ++r) {
        size_t base = rowbase + (size_t)(i * 16 + q4 * 4 + r) * W + cbase;
#pragma unroll
        for (int j = 0; j < 4; ++j) dst[base + j * 16 + l16] = f2bf(acc[i][j][r]);
      }
  } else if (type == T_VA || type == T_VC) {
    u16* dst;
    int L;
    size_t hb;
    if (type == T_VA) {
      int h = cbase >> 7, dv0 = cbase & 127;
      if (!lat) { dst = (u16*)(p.ws + O_VTACTX); L = 256; hb = ((size_t)(b * 4 + h) * 128 + dv0) * 256; }
      else { dst = (u16*)(p.ws + O_VTALAT); L = 1536; hb = ((size_t)((li * 2 + b) * 4 + h) * 128 + dv0) * 1536; }
    } else {
      int n = cbase >> 6;
      if (!lat) { dst = (u16*)(p.ws + O_VTCCTX); L = 256; hb = ((size_t)(b * 2 + n) * 64) * 256; }
      else { dst = (u16*)(p.ws + O_VTCLAT); L = 1536; hb = ((size_t)((li * 2 + b) * 2 + n) * 64) * 1536; }
    }
#pragma unroll
    for (int i = 0; i < 4; ++i)
#pragma unroll
      for (int j = 0; j < 4; ++j) {
        uint2 o;
        o.x = pack2(acc[i][j][0], acc[i][j][1]);
        o.y = pack2(acc[i][j][2], acc[i][j][3]);
        *(uint2*)(dst + hb + (size_t)(j * 16 + l16) * L + tb + i * 16 + q4 * 4) = o;
      }
  } else {
    float* dst;
    if (type == T_QB) dst = (float*)(p.ws + O_HQ);
    else if (type == T_FF) dst = (float*)(p.ws + O_HGF);
    else if (type == T_FB) dst = (float*)(p.ws + O_HGB);
    else if (type == T_IB) dst = (float*)(p.ws + O_HI);
    else dst = (float*)(p.ws + O_HSG);
    float lbv[4] = {0.f, 0.f, 0.f, 0.f};
    if ((type == T_FF || type == T_FB) && li == 1) {
      const float* lg = (type == T_FF) ? p.in[19] : p.in[20];
#pragma unroll
      for (int j = 0; j < 4; ++j) {
        int c = cbase + j * 16 + l16;
        lbv[j] = 1.f / (1.f + expf(lg[c] - lg[256 + c]));
      }
    }
#pragma unroll
    for (int i = 0; i < 4; ++i)
#pragma unroll
      for (int r = 0; r < 4; ++r) {
        size_t base = (size_t)(R0 + i * 16 + q4 * 4 + r) * 256 + cbase;
#pragma unroll
        for (int j = 0; j < 4; ++j) {
          float v = acc[i][j][r];
          float o;
          if (type == T_QB || type == T_GB) o = v * __frcp_rn(1.f + __expf(-v));
          else if (type == T_IB) o = v;
          else {
            float sg = __frcp_rn(1.f + __expf(-v));
            float f = lbv[j] + (1.f - lbv[j]) * sg;
            o = __logf(fmaxf(f, 1e-6f));
          }
          dst[base + j * 16 + l16] = o;
        }
      }
  }
}

template <int EPI, int MI = 4>
DI void gemm_phase(const P& p, const GA& g, int li, char* smem) {
  constexpr int BMT = MI * 32;
  constexpr int MPX = NTOK / BMT / 8;
  const int NT = g.N >> 7;
  const int xcd = blockIdx.x & 7, lb = blockIdx.x >> 3, nlb = gridDim.x >> 3;
  if (lb >= nlb) return;
  u32x4 ra0[4], rb0[4], ra1[4], rb1[4];
  bool primed = false;
  for (int t = lb; t < MPX * NT; t += nlb) {
    int mt = xcd * MPX + t % MPX, nt = t / MPX;
    const int tn = (t + nlb < MPX * NT) ? t + nlb : t;
    const int nmt = xcd * MPX + tn % MPX, nnt = tn / MPX;
    gemm_tile<EPI, MI>(p, g, li, mt * BMT, nt * 128, smem, ra0, rb0, ra1, rb1, primed, nmt * BMT, nnt * 128);
    primed = true;
  }
}


template <int KW, int DV>
DI void attn_gload(const u16* Kb, int kstride, const u16* VT, int L, int kb, int tid, u32x4 (&kr)[KW / 32], u32x4 (&vr)[DV / 32]) {
  constexpr int KPR = 256 / (KW / 8);
  const unsigned koff = (unsigned)(tid / (KW / 8)) * (unsigned)kstride + (unsigned)(tid % (KW / 8)) * 8u;
  const unsigned voff = (unsigned)(tid >> 3) * (unsigned)L + (unsigned)(tid & 7) * 8u;
#pragma unroll
  for (int i = 0; i < KW / 32; ++i) {
    const u16* kbp = Kb + (size_t)(kb * 64 + KPR * i) * kstride;
    kr[i] = *(const u32x4*)(kbp + koff);
  }
#pragma unroll
  for (int i = 0; i < DV / 32; ++i) {
    const u16* vbp = VT + (size_t)(32 * i) * L + kb * 64;
    vr[i] = *(const u32x4*)(vbp + voff);
  }
}
template <int KW, int DV>
DI void attn_lstore(u16* sK, u16* sV, int tid, const u32x4 (&kr)[KW / 32], const u32x4 (&vr)[DV / 32]) {
  constexpr int KS = KW + 8;
#pragma unroll
  for (int i = 0; i < KW / 32; ++i) {
    int idx = tid + 256 * i;
    int key = idx / (KW / 8), cc = idx % (KW / 8);
    *(u32x4*)(sK + key * KS + cc * 8) = kr[i];
  }
#pragma unroll
  for (int i = 0; i < DV / 32; ++i) {
    int idx = tid + 256 * i;
    int row = idx >> 3, cc = idx & 7;
    *(u32x4*)(sV + row * 72 + cc * 8) = vr[i];
  }
}

template <int KW, int DV, int NQ>
DI void attn_compute(const u16* sK, const u16* sV, int kfo, int l16, int q4, const bf16x8 (&qf)[NQ][2],
                     f32x4 (&o)[NQ][DV / 16], float (&m)[NQ], float (&l)[NQ]) {
  constexpr int KS = KW + 8, NDT = DV / 16;
  const float c = 0.125f * LOG2E;
  f32x4 st[NQ][4];
#pragma unroll
  for (int kt = 0; kt < 4; ++kt) {
    const u16* kp = sK + (kt * 16 + l16) * KS + kfo + q4 * 8;
    bf16x8 k0 = *(const bf16x8*)kp;
    bf16x8 k1 = *(const bf16x8*)(kp + 32);
#pragma unroll
    for (int q = 0; q < NQ; ++q) {
      f32x4 z = {0.f, 0.f, 0.f, 0.f};
      z = MFMA16(k0, qf[q][0], z);
      st[q][kt] = MFMA16(k1, qf[q][1], z);
    }
  }
#pragma unroll
  for (int q = 0; q < NQ; ++q) {
    float bm = st[q][0][0];
#pragma unroll
    for (int kt = 0; kt < 4; ++kt)
#pragma unroll
      for (int r = 0; r < 4; ++r) bm = fmaxf(bm, st[q][kt][r]);
    bm = fmaxf(bm, shx(bm, 16));
    bm = fmaxf(bm, shx(bm, 32));
    const float mn = fmaxf(m[q], bm);
    const float alpha = ex2((m[q] - mn) * c);
    m[q] = mn;
    float ps = 0.f;
#pragma unroll
    for (int kt = 0; kt < 4; ++kt)
#pragma unroll
      for (int r = 0; r < 4; ++r) {
        float pv = ex2((st[q][kt][r] - mn) * c);
        st[q][kt][r] = pv;
        ps += pv;
      }
    l[q] = l[q] * alpha + ps;
#pragma unroll
    for (int d = 0; d < NDT; ++d) {
      o[q][d][0] *= alpha; o[q][d][1] *= alpha; o[q][d][2] *= alpha; o[q][d][3] *= alpha;
    }
  }
#pragma unroll
  for (int ks = 0; ks < 2; ++ks) {
    bf16x8 pf[NQ];
#pragma unroll
    for (int q = 0; q < NQ; ++q) {
      u32x4 pu;
      pu.x = pack2(st[q][2 * ks][0], st[q][2 * ks][1]);
      pu.y = pack2(st[q][2 * ks][2], st[q][2 * ks][3]);
      pu.z = pack2(st[q][2 * ks + 1][0], st[q][2 * ks + 1][1]);
      pu.w = pack2(st[q][2 * ks + 1][2], st[q][2 * ks + 1][3]);
      pf[q] = __builtin_bit_cast(bf16x8, pu);
    }
#pragma unroll
    for (int d = 0; d < NDT; ++d) {
      const u16* vp = sV + (d * 16 + l16) * 72 + ks * 32 + q4 * 4;
      u32x2 v0 = *(const u32x2*)vp;
      u32x2 v1 = *(const u32x2*)(vp + 16);
      u32x4 vu = {v0.x, v0.y, v1.x, v1.y};
      bf16x8 vf = __builtin_bit_cast(bf16x8, vu);
#pragma unroll
      for (int q = 0; q < NQ; ++q) o[q][d] = MFMA16(vf, pf[q], o[q][d]);
    }
  }
}

template <int KW, int DV, bool DIFF>
DI void attn_item(const u16* Q, int qstride, int qcol, int qrow0, const u16* Kb, int kstride, const u16* VT, int L,
                          int nkeys, u16* mixed, int mixcol, float lam, float postscale, const float* subg, char* smem) {
  constexpr int NQ = 2;
  const int tid = ltid(), lane = tid & 63, wid = tid >> 6, l16 = lane & 15, q4 = lane >> 4;
  const int qsub = wid & 1, var = wid >> 1;
  constexpr int KS = KW + 8;
  constexpr int STAGE = 64 * KS + DV * 72;
  u16* sK0 = (u16*)smem;
  u16* sV0 = sK0 + 64 * KS;
  u16* sK1 = sK0 + STAGE;
  u16* sV1 = sV0 + STAGE;
  constexpr int KPT = KW / 32, VPT = DV / 32, NDT = DV / 16;
  const int kfo = DIFF ? var * 64 : 0;

  bf16x8 qf[NQ][2];
#pragma unroll
  for (int q = 0; q < NQ; ++q) {
    const u16* qp = Q + (size_t)(qrow0 + qsub * 32 + q * 16 + l16) * qstride + qcol + var * 64 + q4 * 8;
    qf[q][0] = *(const bf16x8*)qp;
    qf[q][1] = *(const bf16x8*)(qp + 32);
  }

  u32x4 kr0[KPT], vr0[VPT];
  f32x4 o[NQ][NDT];
  float m[NQ], l[NQ];
#pragma unroll
  for (int q = 0; q < NQ; ++q) {
    m[q] = -INFINITY;
    l[q] = 0.f;
#pragma unroll
    for (int d = 0; d < NDT; ++d) o[q][d] = f32x4{0.f, 0.f, 0.f, 0.f};
  }
  const int nkb = nkeys >> 6;
#define SB0 __builtin_amdgcn_sched_barrier(0)
#define ACOMP(SK, SV) attn_compute<KW, DV, NQ>(SK, SV, kfo, l16, q4, qf, o, m, l)
  attn_gload<KW, DV>(Kb, kstride, VT, L, 0, tid, kr0, vr0);
  SB0;
  __syncthreads();
  attn_lstore<KW, DV>(sK0, sV0, tid, kr0, vr0);
  SB0;
  attn_gload<KW, DV>(Kb, kstride, VT, L, 1, tid, kr0, vr0);
  SB0;
  __syncthreads();
#pragma unroll 1
  for (int kb = 0; kb < nkb - 2; kb += 2) {
    SB0;
    attn_lstore<KW, DV>(sK1, sV1, tid, kr0, vr0);
    SB0;
    attn_gload<KW, DV>(Kb, kstride, VT, L, kb + 2, tid, kr0, vr0);
    SB0;
    ACOMP(sK0, sV0);
    __syncthreads();
    SB0;
    attn_lstore<KW, DV>(sK0, sV0, tid, kr0, vr0);
    SB0;
    attn_gload<KW, DV>(Kb, kstride, VT, L, kb + 3, tid, kr0, vr0);
    SB0;
    ACOMP(sK1, sV1);
    __syncthreads();
  }
  SB0;
  attn_lstore<KW, DV>(sK1, sV1, tid, kr0, vr0);
  SB0;
  ACOMP(sK0, sV0);
  __syncthreads();
  SB0;
  ACOMP(sK1, sV1);
  __syncthreads();
#undef SB0
#undef ACOMP
  float inv[NQ];
#pragma unroll
  for (int q = 0; q < NQ; ++q) {
    float lt = l[q];
    lt += shx(lt, 16);
    lt += shx(lt, 32);
    inv[q] = 1.f / lt;
  }
  if constexpr (DIFF) {
    float* sO = (float*)smem;
    if (var == 1) {
#pragma unroll
      for (int q = 0; q < NQ; ++q)
#pragma unroll
        for (int d = 0; d < NDT; ++d)
          *(f32x4*)(sO + (qsub * 32 + q * 16 + l16) * 132 + d * 16 + q4 * 4) = o[q][d] * inv[q];
    }
    __syncthreads();
    if (var == 0) {
      f32x4 ggv[NDT];
#pragma unroll
      for (int d = 0; d < NDT; ++d) ggv[d] = *(const f32x4*)(subg + d * 16 + q4 * 4);
#pragma unroll
      for (int q = 0; q < NQ; ++q) {
        const int row = qrow0 + qsub * 32 + q * 16 + l16;
        float ss = 0.f;
#pragma unroll
        for (int d = 0; d < NDT; ++d) {
          f32x4 o1 = *(const f32x4*)(sO + (qsub * 32 + q * 16 + l16) * 132 + d * 16 + q4 * 4);
          o[q][d] = o[q][d] * inv[q] - lam * o1;
          ss += o[q][d][0] * o[q][d][0] + o[q][d][1] * o[q][d][1] + o[q][d][2] * o[q][d][2] + o[q][d][3] * o[q][d][3];
        }
        ss += shx(ss, 16);
        ss += shx(ss, 32);
        const float rs = rsqrtf(ss * (1.f / 128.f) + 1e-6f) * postscale;
#pragma unroll
        for (int d = 0; d < NDT; ++d) {
          f32x4 v = o[q][d] * rs * ggv[d];
          u32x2 ov;
          ov.x = pack2(v.x, v.y);
          ov.y = pack2(v.z, v.w);
          *(u32x2*)(mixed + (size_t)row * 1024 + mixcol + d * 16 + q4 * 4) = ov;
        }
      }
    }
  } else {
#pragma unroll
    for (int q = 0; q < NQ; ++q) {
      const int row = qrow0 + qsub * 32 + q * 16 + l16;
#pragma unroll
      for (int d = 0; d < NDT; ++d) {
        f32x4 v = o[q][d] * inv[q];
        u32x2 ov;
        ov.x = pack2(v.x, v.y);
        ov.y = pack2(v.z, v.w);
        *(u32x2*)(mixed + (size_t)row * 1024 + mixcol + var * 64 + d * 16 + q4 * 4) = ov;
      }
    }
  }
}

DI void attnA_item(const P& p, int li, int it, char* smem) {
  const int lane = ltid() & 63;
  float d1 = p.in[14][li * 64 + lane] * p.in[15][li * 64 + lane];
  float d2 = p.in[16][li * 64 + lane] * p.in[17][li * 64 + lane];
#pragma unroll
  for (int s = 1; s < 64; s <<= 1) { d1 += shx(d1, s); d2 += shx(d2, s); }
  const float lam_init = 0.8f - 0.6f * expf(-0.3f * (float)li);
  const float lam = expf(d1) - expf(d2) + lam_init;
  const u16* QA = (const u16*)(p.ws + O_QA);
  u16* mixed = (u16*)(p.ws + O_MIXED);
  const float* subg = p.in[18] + li * 128;
  int qrow0, L;
  const u16 *Kb, *VT;
  int h;
  if (it < 128) {
    int b = it >> 6, qb = it & 15;
    h = (it >> 4) & 3;
    Kb = (const u16*)(p.ws + O_KALAT) + (size_t)(li * 2 + b) * 1536 * 512 + h * 128;
    VT = (const u16*)(p.ws + O_VTALAT) + (size_t)((li * 2 + b) * 4 + h) * 128 * 1536;
    qrow0 = NCTX + b * 1024 + qb * 64;
    L = 1536;
  } else {
    it -= 128;
    int b = it >> 4, qb = it & 3;
    h = (it >> 2) & 3;
    Kb = (const u16*)(p.ws + O_KACTX) + (size_t)b * 256 * 512 + h * 128;
    VT = (const u16*)(p.ws + O_VTACTX) + (size_t)(b * 4 + h) * 128 * 256;
    qrow0 = b * 256 + qb * 64;
    L = 256;
  }
  attn_item<128, 128, true>(QA, 512, h * 128, qrow0, Kb, 512, VT, L, L, mixed, h * 128, lam, 1.f - lam_init, subg, smem);
}
DI void attnC_item(const P& p, int li, int it, char* smem) {
  const u16* QC = (const u16*)(p.ws + O_QC);
  u16* mixed = (u16*)(p.ws + O_MIXED);
  int qrow0, L, n;
  const u16 *Kb, *VT;
  if (it < 64) {
    int b = it >> 5, qb = it & 15;
    n = (it >> 4) & 1;
    Kb = (const u16*)(p.ws + O_KCLAT) + (size_t)(li * 2 + b) * 1536 * 128 + n * 64;
    VT = (const u16*)(p.ws + O_VTCLAT) + (size_t)((li * 2 + b) * 2 + n) * 64 * 1536;
    qrow0 = NCTX + b * 1024 + qb * 64;
    L = 1536;
  } else {
    it -= 64;
    int b = it >> 3, qb = it & 3;
    n = (it >> 2) & 1;
    Kb = (const u16*)(p.ws + O_KCCTX) + (size_t)b * 256 * 128 + n * 64;
    VT = (const u16*)(p.ws + O_VTCCTX) + (size_t)(b * 2 + n) * 64 * 256;
    qrow0 = b * 256 + qb * 64;
    L = 256;
  }
  attn_item<64, 64, false>(QC, 256, n * 128, qrow0, Kb, 128, VT, L, L, mixed, 768 + n * 128, 0.f, 1.f, nullptr, smem);
}

DI void h1_item(const P& p, int item, char* smem) {
  const int tid = ltid(), lane = tid & 63, w = tid >> 6, l16 = lane & 15, q4 = lane >> 4;
  const int dir = item & 1, h = (item >> 1) & 3, tc = item >> 3;
  const int row0 = tc * 64;
  float* sQ = (float*)smem;
  float* sB = sQ + 64 * 68;
  float* sK = sB + 64 * 68;
  u16* sVT = (u16*)(sK + 64 * 68);
  float* sTot = (float*)(sVT + 64 * 72);
  const float* HQ = (const float*)(p.ws + O_HQ);
  const float* HG = (const float*)(p.ws + (dir ? O_HGB : O_HGF));
  const float* HI = (const float*)(p.ws + O_HI);
  float* OI = (float*)(p.ws + O_OI) + (size_t)dir * NTOK * 256;
  u16* QE = (u16*)(p.ws + O_QE) + (size_t)dir * NTOK * 256;
  float* KV = (float*)(p.ws + O_KV) + (size_t)item * 4096;
  float* DEC = (float*)(p.ws + O_DEC) + (size_t)item * 64;

  __syncthreads();
#pragma unroll
  for (int i = 0; i < 4; ++i) {
    int idx = tid + 256 * i;
    int lo = idx >> 4, c4 = idx & 15;
    int row = dir ? row0 + 63 - lo : row0 + lo;
    size_t off = (size_t)row * 256 + h * 64 + c4 * 4;
    *(float4*)(sQ + lo * 68 + c4 * 4) = *(const float4*)(HQ + off);
    *(float4*)(sB + lo * 68 + c4 * 4) = *(const float4*)(HG + off);
    float4 v = *(const float4*)(HI + off);
    sVT[(c4 * 4 + 0) * 72 + lo] = f2bf(v.x);
    sVT[(c4 * 4 + 1) * 72 + lo] = f2bf(v.y);
    sVT[(c4 * 4 + 2) * 72 + lo] = f2bf(v.z);
    sVT[(c4 * 4 + 3) * 72 + lo] = f2bf(v.w);
  }
  __syncthreads();
  {
    const int k = tid & 63, part = tid >> 6;
    float run = 0.f;
#pragma unroll 4
    for (int e = 0; e < 16; ++e) {
      int i = part * 16 + e;
      float g = sB[i * 68 + k];
      sK[i * 68 + k] = 1.f - ex2(g * LOG2E);
      run += g * LOG2E;
      sB[i * 68 + k] = run;
    }
    sTot[part * 64 + k] = run;
    __syncthreads();
    float add = 0.f;
    for (int pp = 0; pp < part; ++pp) add += sTot[pp * 64 + k];
    if (part > 0)
      for (int e = 0; e < 16; ++e) sB[(part * 16 + e) * 68 + k] += add;
  }
  __syncthreads();
#pragma unroll
  for (int i = 0; i < 4; ++i) {
    int idx = tid + 256 * i;
    int lo = idx >> 4, c4 = idx & 15;
    int row = dir ? row0 + 63 - lo : row0 + lo;
    f32x4 q = *(const f32x4*)(sQ + lo * 68 + c4 * 4);
    f32x4 bb = *(const f32x4*)(sB + lo * 68 + c4 * 4);
    u32x2 o;
    o.x = pack2(q.x * ex2(bb.x), q.y * ex2(bb.y));
    o.y = pack2(q.z * ex2(bb.z), q.w * ex2(bb.w));
    *(u32x2*)(QE + (size_t)row * 256 + h * 64 + c4 * 4) = o;
  }
  {
    const int I = w;
    bf16x8 qs[2];
    f32x4 rr[2][2];
#pragma unroll
    for (int s = 0; s < 2; ++s) {
      const int kk0 = s * 32 + q4 * 8;
      if (I > 0) {
        rr[s][0] = *(const f32x4*)(sB + (16 * I - 1) * 68 + kk0);
        rr[s][1] = *(const f32x4*)(sB + (16 * I - 1) * 68 + kk0 + 4);
      } else {
        rr[s][0] = f32x4{0.f, 0.f, 0.f, 0.f};
        rr[s][1] = rr[s][0];
      }
      const float* qr = sQ + (16 * I + l16) * 68 + kk0;
      const float* br = sB + (16 * I + l16) * 68 + kk0;
      f32x4 q0 = *(const f32x4*)qr, q1 = *(const f32x4*)(qr + 4);
      f32x4 b0 = *(const f32x4*)br, b1 = *(const f32x4*)(br + 4);
      u32x4 pu;
      pu.x = pack2(q0.x * ex2(b0.x - rr[s][0].x), q0.y * ex2(b0.y - rr[s][0].y));
      pu.y = pack2(q0.z * ex2(b0.z - rr[s][0].z), q0.w * ex2(b0.w - rr[s][0].w));
      pu.z = pack2(q1.x * ex2(b1.x - rr[s][1].x), q1.y * ex2(b1.y - rr[s][1].y));
      pu.w = pack2(q1.z * ex2(b1.z - rr[s][1].z), q1.w * ex2(b1.w - rr[s][1].w));
      qs[s] = __builtin_bit_cast(bf16x8, pu);
    }
    f32x4 at[4];
#pragma unroll
    for (int J = 0; J < 4; ++J) {
      at[J] = f32x4{0.f, 0.f, 0.f, 0.f};
      if (J <= I) {
#pragma unroll
        for (int s = 0; s < 2; ++s) {
          const int kk0 = s * 32 + q4 * 8;
          const float* kr = sK + (16 * J + l16) * 68 + kk0;
          const float* br = sB + (16 * J + l16) * 68 + kk0;
          f32x4 k0 = *(const f32x4*)kr, k1 = *(const f32x4*)(kr + 4);
          f32x4 b0 = *(const f32x4*)br, b1 = *(const f32x4*)(br + 4);
          u32x4 pu;
          pu.x = pack2(k0.x * ex2(fminf(rr[s][0].x - b0.x, 100.f)), k0.y * ex2(fminf(rr[s][0].y - b0.y, 100.f)));
          pu.y = pack2(k0.z * ex2(fminf(rr[s][0].z - b0.z, 100.f)), k0.w * ex2(fminf(rr[s][0].w - b0.w, 100.f)));
          pu.z = pack2(k1.x * ex2(fminf(rr[s][1].x - b1.x, 100.f)), k1.y * ex2(fminf(rr[s][1].y - b1.y, 100.f)));
          pu.w = pack2(k1.z * ex2(fminf(rr[s][1].z - b1.z, 100.f)), k1.w * ex2(fminf(rr[s][1].w - b1.w, 100.f)));
          bf16x8 kf = __builtin_bit_cast(bf16x8, pu);
          at[J] = MFMA16(kf, qs[s], at[J]);
        }
        if (J == I) {
#pragma unroll
          for (int r = 0; r < 4; ++r)
            if (q4 * 4 + r > l16) at[J][r] = 0.f;
        }
      }
    }
    f32x4 oc[4];
#pragma unroll
    for (int vt = 0; vt < 4; ++vt) oc[vt] = f32x4{0.f, 0.f, 0.f, 0.f};
#pragma unroll
    for (int ks = 0; ks < 2; ++ks) {
      if (2 * ks <= I) {
        u32x4 pu;
        pu.x = pack2(at[2 * ks][0], at[2 * ks][1]);
        pu.y = pack2(at[2 * ks][2], at[2 * ks][3]);
        pu.z = pack2(at[2 * ks + 1][0], at[2 * ks + 1][1]);
        pu.w = pack2(at[2 * ks + 1][2], at[2 * ks + 1][3]);
        bf16x8 pf = __builtin_bit_cast(bf16x8, pu);
#pragma unroll
        for (int vt = 0; vt < 4; ++vt) {
          const u16* vp = sVT + (vt * 16 + l16) * 72 + ks * 32 + q4 * 4;
          u32x2 v0 = *(const u32x2*)vp;
          u32x2 v1 = *(const u32x2*)(vp + 16);
          u32x4 vu = {v0.x, v0.y, v1.x, v1.y};
          oc[vt] = MFMA16(__builtin_bit_cast(bf16x8, vu), pf, oc[vt]);
        }
      }
    }
    {
      const int t = 16 * I + l16;
      const int row = dir ? row0 + 63 - t : row0 + t;
#pragma unroll
      for (int vt = 0; vt < 4; ++vt) *(f32x4*)(OI + (size_t)row * 256 + h * 64 + vt * 16 + q4 * 4) = oc[vt];
    }
  }
  {
    const int k = 16 * w + l16;
    const float bend = sB[63 * 68 + k];
    f32x4 kc[4];
#pragma unroll
    for (int vt = 0; vt < 4; ++vt) kc[vt] = f32x4{0.f, 0.f, 0.f, 0.f};
#pragma unroll
    for (int ks = 0; ks < 2; ++ks) {
      float kd[8];
#pragma unroll
      for (int j = 0; j < 8; ++j) {
        const int s = ks * 32 + q4 * 8 + j;
        kd[j] = sK[s * 68 + k] * ex2(bend - sB[s * 68 + k]);
      }
      u32x4 pu;
      pu.x = pack2(kd[0], kd[1]);
      pu.y = pack2(kd[2], kd[3]);
      pu.z = pack2(kd[4], kd[5]);
      pu.w = pack2(kd[6], kd[7]);
      bf16x8 af = __builtin_bit_cast(bf16x8, pu);
#pragma unroll
      for (int vt = 0; vt < 4; ++vt) {
        bf16x8 vf = *(const bf16x8*)(sVT + (vt * 16 + l16) * 72 + ks * 32 + q4 * 8);
        kc[vt] = MFMA16(af, vf, kc[vt]);
      }
    }
#pragma unroll
    for (int vt = 0; vt < 4; ++vt)
#pragma unroll
      for (int r = 0; r < 4; ++r) KV[(16 * w + q4 * 4 + r) * 64 + vt * 16 + l16] = kc[vt][r];
    if (q4 == 0) DEC[k] = ex2(bend);
  }
}

DI void h2_item(const P& p, int li, int item, char* smem) {
  const int tid = ltid(), ty = tid >> 4, tx = tid & 15;
  const int lane = tid & 63, w = tid >> 6, l16 = lane & 15, q4 = lane >> 4;
  const int h = item & 3, tc = item >> 2, row0 = tc * 64;
  const bool lat = tc >= 64;
  int seq, cl, nc;
  if (!lat) { seq = tc >> 2; cl = tc & 3; nc = 4; } else { seq = (tc - 64) >> 4; cl = (tc - 64) & 15; nc = 16; }
  const int tcbase = tc - cl;
  u16* sST = (u16*)smem;
  const float* KVb = (const float*)(p.ws + O_KV);
  const float* DECb = (const float*)(p.ws + O_DEC);
  __syncthreads();
#pragma unroll 1
  for (int dir = 0; dir < 2; ++dir) {
    float4 S[4];
#pragma unroll
    for (int a = 0; a < 4; ++a) {
      if (lat) S[a] = *(const float4*)(p.in[6 + dir] + ((size_t)((seq * 2 + li) * 4 + h) * 64 + ty + 16 * a) * 64 + tx * 4);
      else S[a] = make_float4(0.f, 0.f, 0.f, 0.f);
    }
    const int nprev = dir == 0 ? cl : nc - 1 - cl;
#pragma unroll 1
    for (int j = 0; j < nprev; ++j) {
      int tcj = tcbase + (dir == 0 ? j : nc - 1 - j);
      size_t itj = (size_t)((tcj * 4 + h) * 2 + dir);
#pragma unroll
      for (int a = 0; a < 4; ++a) {
        int k = ty + 16 * a;
        float dcy = DECb[itj * 64 + k];
        float4 kv = *(const float4*)(KVb + itj * 4096 + k * 64 + tx * 4);
        S[a].x = dcy * S[a].x + kv.x; S[a].y = dcy * S[a].y + kv.y; S[a].z = dcy * S[a].z + kv.z; S[a].w = dcy * S[a].w + kv.w;
      }
    }
    if (!lat && nprev == nc - 1) {
      size_t itj = (size_t)((tc * 4 + h) * 2 + dir);
      float* so = p.out + (dir == 0 ? OUT_SF : OUT_SB) + (size_t)((seq * 2 + li) * 4 + h) * 4096;
#pragma unroll
      for (int a = 0; a < 4; ++a) {
        int k = ty + 16 * a;
        float dcy = DECb[itj * 64 + k];
        float4 kv = *(const float4*)(KVb + itj * 4096 + k * 64 + tx * 4);
        *(float4*)(so + k * 64 + tx * 4) = make_float4(dcy * S[a].x + kv.x, dcy * S[a].y + kv.y, dcy * S[a].z + kv.z, dcy * S[a].w + kv.w);
      }
    }
    u16* st = sST + dir * 64 * 72;
#pragma unroll
    for (int a = 0; a < 4; ++a) {
      int k = ty + 16 * a;
      st[(tx * 4 + 0) * 72 + k] = f2bf(S[a].x);
      st[(tx * 4 + 1) * 72 + k] = f2bf(S[a].y);
      st[(tx * 4 + 2) * 72 + k] = f2bf(S[a].z);
      st[(tx * 4 + 3) * 72 + k] = f2bf(S[a].w);
    }
  }
  __syncthreads();
  f32x4 oc[4];
#pragma unroll
  for (int vt = 0; vt < 4; ++vt) oc[vt] = f32x4{0.f, 0.f, 0.f, 0.f};
#pragma unroll
  for (int dir = 0; dir < 2; ++dir) {
    const u16* QE = (const u16*)(p.ws + O_QE) + (size_t)dir * NTOK * 256 + (size_t)(row0 + 16 * w + l16) * 256 + h * 64 + q4 * 8;
    const u16* st = sST + dir * 64 * 72;
#pragma unroll
    for (int ks = 0; ks < 2; ++ks) {
      bf16x8 af = *(const bf16x8*)(QE + ks * 32);
#pragma unroll
      for (int vt = 0; vt < 4; ++vt) {
        bf16x8 bf = *(const bf16x8*)(st + (vt * 16 + l16) * 72 + ks * 32 + q4 * 8);
        oc[vt] = MFMA16(af, bf, oc[vt]);
      }
    }
  }
  const float* OI0 = (const float*)(p.ws + O_OI);
  const float* OI1 = OI0 + (size_t)NTOK * 256;
  const float* HSG = (const float*)(p.ws + O_HSG);
  u16* mixed = (u16*)(p.ws + O_MIXED);
  float gn[4];
#pragma unroll
  for (int vt = 0; vt < 4; ++vt) gn[vt] = p.in[21][li * 64 + vt * 16 + l16];
  float oi[4][4], sgv[4][4];
#pragma unroll
  for (int r = 0; r < 4; ++r) {
    const size_t off = (size_t)(row0 + 16 * w + q4 * 4 + r) * 256 + h * 64 + l16;
#pragma unroll
    for (int vt = 0; vt < 4; ++vt) {
      oi[r][vt] = OI0[off + vt * 16] + OI1[off + vt * 16];
      sgv[r][vt] = HSG[off + vt * 16];
    }
  }
#pragma unroll
  for (int r = 0; r < 4; ++r) {
    const int row = row0 + 16 * w + q4 * 4 + r;
    float val[4];
    float ss = 0.f;
#pragma unroll
    for (int vt = 0; vt < 4; ++vt) {
      val[vt] = oc[vt][r] + oi[r][vt];
      ss += val[vt] * val[vt];
    }
    ss = red16(ss);
    const float rs = rsqrtf(ss * (1.f / 64.f) + 1e-6f);
#pragma unroll
    for (int vt = 0; vt < 4; ++vt)
      mixed[(size_t)row * 1024 + 512 + h * 64 + vt * 16 + l16] = f2bf(val[vt] * rs * gn[vt] * sgv[r][vt]);
  }
}

DI void ln_apply(const P& p, const float* lo, const float* hi, const float* stats, const float* lng, const float* lnb,
                 const float* mods, int sc_off, int sh_off) {
  const int lane = ltid() & 63, wid = ltid() >> 6;
  u16* dst = (u16*)(p.ws + O_ABF);
  for (int it = blockIdx.x; it < NTOK / 4; it += gridDim.x) {
    const int row = it * 4 + wid;
    float mu = 0.f, rs = 1.f;
    if (stats != nullptr) {
      float s1 = 0.f, s2 = 0.f;
      if (lane < 16) {
        float2 v = *(const float2*)(stats + (size_t)row * 32 + lane * 2);
        s1 = v.x;
        s2 = v.y;
      }
#pragma unroll
      for (int s = 1; s < 16; s <<= 1) { s1 += shx(s1, s); s2 += shx(s2, s); }
      s1 = __shfl(s1, 0, 64);
      s2 = __shfl(s2, 0, 64);
      mu = s1 * (1.f / 1024.f);
      rs = rsqrtf(fmaxf(s2 * (1.f / 1024.f) - mu * mu, 0.f) + 1e-6f);
    }
    const float* x = row < NCTX ? lo + (size_t)row * 1024 : hi + (size_t)(row - NCTX) * 1024;
    const int rtype = row < NCTX ? 0 : 1 + ((row - NCTX) >> 10);
    const float* mv = mods + rtype * 6144;
    f32x4 xv[4], scv[4], shv[4], ggv[4], bbv[4];
#pragma unroll
    for (int i = 0; i < 4; ++i) {
      const int c = (lane + 64 * i) * 4;
      xv[i] = *(const f32x4*)(x + c);
      scv[i] = *(const f32x4*)(mv + sc_off + c);
      shv[i] = *(const f32x4*)(mv + sh_off + c);
      if (stats != nullptr) {
        ggv[i] = *(const f32x4*)(lng + c);
        bbv[i] = *(const f32x4*)(lnb + c);
      }
    }
#pragma unroll
    for (int i = 0; i < 4; ++i) {
      const int c = (lane + 64 * i) * 4;
      f32x4 v = xv[i];
      f32x4 sc = scv[i] + 1.f;
      f32x4 sh = shv[i];
      if (stats != nullptr) v = (v - mu) * rs * ggv[i] + bbv[i];
      v = v * sc + sh;
      u32x2 o;
      o.x = pack2(v.x, v.y);
      o.y = pack2(v.z, v.w);
      *(u32x2*)(dst + (size_t)row * 1024 + c) = o;
    }
  }
}

DI void final_ln(const P& p) {
  const int lane = ltid() & 63, wid = ltid() >> 6;
  const float* X = (const float*)(p.ws + O_XPRE2);
  const float* ST = (const float*)(p.ws + O_ST2);
  const float* g = p.in[26] + 1024;
  const float* bb = p.in[27] + 1024;
  for (int it = blockIdx.x; it < NTOK / 4; it += gridDim.x) {
    int row = it * 4 + wid;
    float s1 = 0.f, s2 = 0.f;
    if (lane < 16) {
      float2 v = *(const float2*)(ST + (size_t)row * 32 + lane * 2);
      s1 = v.x;
      s2 = v.y;
    }
#pragma unroll
    for (int s = 1; s < 16; s <<= 1) { s1 += shx(s1, s); s2 += shx(s2, s); }
    s1 = __shfl(s1, 0, 64);
    s2 = __shfl(s2, 0, 64);
    float mu = s1 * (1.f / 1024.f);
    float rs = rsqrtf(fmaxf(s2 * (1.f / 1024.f) - mu * mu, 0.f) + 1e-6f);
    float* out = p.out + (row < NCTX ? OUT_YP + (size_t)row * 1024 : OUT_YS + (size_t)(row - NCTX) * 1024);
    float4 xv[4], gv[4], bv[4];
#pragma unroll
    for (int i = 0; i < 4; ++i) {
      int c = (lane + 64 * i) * 4;
      xv[i] = *(const float4*)(X + (size_t)row * 1024 + c);
      gv[i] = *(const float4*)(g + c);
      bv[i] = *(const float4*)(bb + c);
    }
#pragma unroll
    for (int i = 0; i < 4; ++i) {
      int c = (lane + 64 * i) * 4;
      float4 x = xv[i];
      float4 gg = gv[i];
      float4 b4 = bv[i];
      *(float4*)(out + c) = make_float4((x.x - mu) * rs * gg.x + b4.x, (x.y - mu) * rs * gg.y + b4.y,
                                         (x.z - mu) * rs * gg.z + b4.z, (x.w - mu) * rs * gg.w + b4.w);
    }
  }
}

DI void run_phase(const P& p, int ph, char* smem, int sub = 0) {
  if (ph == 0) { phase0(p, smem); return; }
  if (ph == NPHASE - 1) { final_ln(p); return; }
  const int li = (ph - 1) >> 3, s = (ph - 1) & 7;
  float* XPRE1 = (float*)(p.ws + O_XPRE1);
  float* XPRE2 = (float*)(p.ws + O_XPRE2);
  float* ST1 = (float*)(p.ws + O_ST1);
  float* ST2 = (float*)(p.ws + O_ST2);
  GA g;
  g.mods = (const float*)(p.ws + O_MODS) + li * 3 * 6144;
  g.a16 = (const u16*)(p.ws + O_ABF); g.xout = nullptr; g.sout = nullptr; g.hid = nullptr;
  g.alo = nullptr; g.ahi = nullptr; g.stats = nullptr; g.lng = nullptr; g.lnb = nullptr; g.sc_off = 0; g.sh_off = 0;
  const float* xin_lo = li == 0 ? p.in[0] : XPRE2;
  const float* xin_hi = li == 0 ? p.in[1] : XPRE2 + (size_t)NCTX * 1024;
  const float* xin_st = li == 0 ? nullptr : ST2;
  const float* xin_g = p.in[26] + (li == 0 ? 0 : (li - 1) * 1024);
  const float* xin_b = p.in[27] + (li == 0 ? 0 : (li - 1) * 1024);
  if (s == 0) {
    ln_apply(p, xin_lo, xin_hi, xin_st, xin_g, xin_b, g.mods, 1024, 0);
  } else if (s == 1) {
    g.bt = (const u16*)(p.ws + O_WTIN) + (size_t)li * NIN * D; g.K = D; g.N = NIN;
    gemm_phase<0>(p, g, li, smem);
    if (li == 0) {
      const int xcd = blockIdx.x & 7, lb = blockIdx.x >> 3, nlb = gridDim.x >> 3;
      const int busy = 6 * (NIN >> 7) - 2 * nlb;
      if (nlb == 64 && lb >= busy) run_transposes(p, smem, (lb - busy) * 8 + xcd, (nlb - busy) * 8, 1);
      else if (nlb != 64) run_transposes(p, smem, blockIdx.x, gridDim.x, 1);
    }
  } else if (s == 2) {
    if (gridDim.x == 512 && sub == 0) {
      const int b = blockIdx.x;
      if (b < 128) {
        attnA_item(p, li, b, smem);
      } else if (b < 192) {
        attnC_item(p, li, b - 128, smem);
        h1_item(p, b - 128, smem);
      } else {
        const int j = b - 192;
        h1_item(p, 64 + j, smem);
        h1_item(p, 64 + 320 + j, smem);
        if (j < 64) h1_item(p, 64 + 640 + j, smem);
        else attnA_item(p, li, 128 + (j - 64), smem);
        run_transposes(p, smem, j, 320, 2 + li);
      }
    } else {
      if (sub == 0) run_transposes(p, smem, blockIdx.x, gridDim.x, 2 + li);
      const int it_lo = sub == 2 ? 128 : (sub == 3 ? 192 : (sub == 4 ? 960 : 0)), it_hi = sub == 1 ? 128 : (sub == 2 ? 192 : (sub == 3 ? 960 : 1216));
      for (int it = it_lo + blockIdx.x; it < it_hi; it += gridDim.x) {
        if (it >= 192 && it < 960) h1_item(p, it - 192, smem);
        else if (it >= 128 && it < 192) attnC_item(p, li, it - 128, smem);
        else attnA_item(p, li, it < 128 ? it : it - 832, smem);
      }
    }
  } else if (s == 3) {
    for (int it = blockIdx.x; it < 512; it += gridDim.x) {
      if (it < 384) h2_item(p, li, it, smem);
      else attnC_item(p, li, it - 384 + 64, smem);
    }
  } else if (s == 4) {
    g.alo = xin_lo; g.ahi = xin_hi; g.stats = xin_st; g.lng = xin_g; g.lnb = xin_b;
    g.sc_off = 2048;
    g.a16 = (const u16*)(p.ws + O_MIXED);
    g.bt = (const u16*)(p.ws + O_WTOUT) + (size_t)li * D * D; g.K = D; g.N = D;
    g.xout = XPRE1; g.sout = ST1;
    gemm_phase<1, 3>(p, g, li, smem);
  } else if (s == 5) {
    ln_apply(p, XPRE1, XPRE1 + (size_t)NCTX * 1024, ST1, p.in[24] + li * 1024, p.in[25] + li * 1024, g.mods, 4096, 3072);
  } else if (s == 6) {
    g.bt = (const u16*)(p.ws + O_WTFF1) + (size_t)li * DFF * D; g.K = D; g.N = DFF;
    g.hid = (u16*)(p.ws + O_HID);
    gemm_phase<2>(p, g, li, smem);
  } else {
    g.alo = XPRE1; g.ahi = XPRE1 + (size_t)NCTX * 1024; g.stats = ST1; g.lng = p.in[24] + li * 1024; g.lnb = p.in[25] + li * 1024;
    g.sc_off = 5120;
    g.a16 = (const u16*)(p.ws + O_HID);
    g.bt = (const u16*)(p.ws + O_WTFF2) + (size_t)li * D * DFF; g.K = DFF; g.N = D;
    g.xout = XPRE2; g.sout = ST2;
    gemm_phase<1, 3>(p, g, li, smem);
  }
}

#define XB_TMO      128
#define XB_XCNT(j)  (256  + 64 * (j))
#define XB_XSUB(j)  (1280 + 64 * (j))
#define XB_XGEN(j)  (2304 + 64 * (j))
#define XB_TOP      3328
#define XB_TOPGEN   3392
#define XCD_BAR_WORDS 3456
#define XB_SPIN_CAP (1u << 20)
#define LAS __attribute__((address_space(3)))
DI unsigned xb_ld(unsigned* p) { return __hip_atomic_load(p, __ATOMIC_RELAXED, __HIP_MEMORY_SCOPE_AGENT); }
DI unsigned xb_add(unsigned* p, unsigned v) { return __hip_atomic_fetch_add(p, v, __ATOMIC_RELAXED, __HIP_MEMORY_SCOPE_AGENT); }
DI unsigned xb_xcc_id() { return (unsigned)__builtin_amdgcn_s_getreg((3 << 11) | 20) & 0xFu; }
#define XB_SPIN(cond, bar) do { unsigned _sp = 0; while (cond) { __builtin_amdgcn_s_sleep(1); \
    if ((++_sp & 255u) == 0u) { if (xb_ld(&(bar)[XB_TMO])) break; if (_sp > XB_SPIN_CAP) { atomicAdd(&(bar)[XB_TMO], 1u); break; } } } } while (0)
struct XcdBarrier { unsigned* bar; unsigned x; volatile LAS unsigned* st; };
DI XcdBarrier xcd_barrier_post(unsigned* bar, volatile LAS unsigned* st) {
  XcdBarrier b; b.bar = bar; b.x = xb_xcc_id(); b.st = st;
  if (threadIdx.x == 0) (void)xb_add(&bar[XB_XCNT(b.x)], 1u);
  return b;
}
DI void xcd_barrier_complete(unsigned* bar, unsigned x, unsigned& nloc, unsigned& nx) {
  const unsigned G = gridDim.x * gridDim.y * gridDim.z;
  unsigned sum, cnt, mine, sp = 0u;
  for (;;) {
    sum = 0u; cnt = 0u; mine = 0u;
#pragma unroll
    for (unsigned j = 0; j < 16; ++j) { const unsigned c = xb_ld(&bar[XB_XCNT(j)]); sum += c; cnt += (c > 0u) ? 1u : 0u; mine = (j == x) ? c : mine; }
    if (sum == G) break;
    __builtin_amdgcn_s_sleep(1);
    if ((++sp & 255u) == 0u) { if (xb_ld(&bar[XB_TMO])) break; if (sp > XB_SPIN_CAP) { atomicAdd(&bar[XB_TMO], 1u); break; } }
  }
  nloc = mine > 0u ? mine : 1u; nx = cnt > 0u ? cnt : 1u;
}
DI void xcd_barrier(const XcdBarrier& b) {
  asm volatile("s_waitcnt vmcnt(0)" ::: "memory");
  __syncthreads();
  if (threadIdx.x == 0) {
    unsigned* bar = b.bar;
    __builtin_amdgcn_s_waitcnt(0);
    unsigned nloc = b.st[0], nx = b.st[1];
    if (nloc == 0u) { xcd_barrier_complete(bar, b.x, nloc, nx); b.st[0] = nloc; b.st[1] = nx; }
    const unsigned old = xb_add(&bar[XB_XSUB(b.x)], 1u);
    const unsigned gen = old / nloc;
    if (old + 1u == (gen + 1u) * nloc) {
      __builtin_amdgcn_fence(__ATOMIC_RELEASE, "agent");
      asm volatile("s_waitcnt vmcnt(0)" ::: "memory");
      const unsigned og = xb_add(&bar[XB_TOP], 1u);
      const unsigned tg = og / nx;
      if (og + 1u == (tg + 1u) * nx) xb_add(&bar[XB_TOPGEN], 1u);
      else XB_SPIN(xb_ld(&bar[XB_TOPGEN]) == tg, bar);
      __builtin_amdgcn_fence(__ATOMIC_ACQUIRE, "agent");
      xb_add(&bar[XB_XGEN(b.x)], 1u);
      asm volatile("s_waitcnt vmcnt(0)" ::: "memory");
    } else {
      XB_SPIN(xb_ld(&bar[XB_XGEN(b.x)]) == gen, bar);
      __builtin_amdgcn_fence(__ATOMIC_ACQUIRE, "agent");
      asm volatile("s_waitcnt vmcnt(0)" ::: "memory");
    }
  }
  __syncthreads();
}
constexpr size_t O_BAR = O_END1;
static_assert(O_BAR + XCD_BAR_WORDS * 4 <= (size_t)256 * 1024 * 1024, "barrier words must fit");

#if !MULTI_LAUNCH
__global__ void __launch_bounds__(256, 2) mega_kernel(P p) {
  extern __shared__ __attribute__((aligned(16))) char smem[];
  cg::grid_group grid = cg::this_grid();
  if (p.ws == nullptr) grid.sync();
  if (threadIdx.x == 0) *(uint4*)(smem + LDS_BYTES - 16) = make_uint4(0u, 0u, 0u, 0u);
  __syncthreads();
  XcdBarrier xb = xcd_barrier_post((unsigned*)(p.ws + O_BAR), (volatile LAS unsigned*)(smem + LDS_BYTES - 16));
  run_phase(p, 0, smem); xcd_barrier(xb);
  run_phase(p, 1, smem); xcd_barrier(xb);
  run_phase(p, 2, smem); xcd_barrier(xb);
  run_phase(p, 3, smem); xcd_barrier(xb);
  run_phase(p, 4, smem); xcd_barrier(xb);
  run_phase(p, 5, smem); xcd_barrier(xb);
  run_phase(p, 6, smem); xcd_barrier(xb);
  run_phase(p, 7, smem); xcd_barrier(xb);
  run_phase(p, 8, smem); xcd_barrier(xb);
  run_phase(p, 9, smem); xcd_barrier(xb);
  run_phase(p, 10, smem); xcd_barrier(xb);
  run_phase(p, 11, smem); xcd_barrier(xb);
  run_phase(p, 12, smem); xcd_barrier(xb);
  run_phase(p, 13, smem); xcd_barrier(xb);
  run_phase(p, 14, smem); xcd_barrier(xb);
  run_phase(p, 15, smem); xcd_barrier(xb);
  run_phase(p, 16, smem); xcd_barrier(xb);
  run_phase(p, 17, smem);
}
#define MAIN_KERNEL mega_kernel
#else
template <int PH>
__global__ void __launch_bounds__(256, 2) phase_kernel(P p, int sub) {
  extern __shared__ __attribute__((aligned(16))) char smem[];
  run_phase(p, PH, smem, sub);
}
typedef void (*phase_fn)(P, int);
static phase_fn phase_table[NPHASE] = {phase_kernel<0>, phase_kernel<1>, phase_kernel<2>, phase_kernel<3>, phase_kernel<4>, phase_kernel<5>,
                                       phase_kernel<6>, phase_kernel<7>, phase_kernel<8>, phase_kernel<9>, phase_kernel<10>, phase_kernel<11>,
                                       phase_kernel<12>, phase_kernel<13>, phase_kernel<14>, phase_kernel<15>, phase_kernel<16>, phase_kernel<17>};
#define MAIN_KERNEL phase_kernel<2>
#endif

extern "C" void kernel_launch(void* const* d_in, const int* in_sizes, int n_in, void* d_out, int out_size, void* d_ws,
                              size_t ws_size, hipStream_t stream) {
  static int grid_blocks = 0;
  if (!grid_blocks) {
    int dev = 0, cus = 0, per_cu = 0;
    (void)hipGetDevice(&dev);
    (void)hipDeviceGetAttribute(&cus, hipDeviceAttributeMultiprocessorCount, dev);
    (void)hipFuncSetAttribute((const void*)MAIN_KERNEL, hipFuncAttributeMaxDynamicSharedMemorySize, LDS_BYTES);
    (void)hipOccupancyMaxActiveBlocksPerMultiprocessor(&per_cu, MAIN_KERNEL, 256, LDS_BYTES);
    if (per_cu > 2) per_cu = 2;
    if (per_cu < 1) per_cu = 1;
    grid_blocks = cus * per_cu;
  }
  P p{};
  for (int i = 0; i < 30; ++i) p.in[i] = (const float*)d_in[i];
  p.out = (float*)d_out;
  p.ws = (char*)d_ws;
#if MULTI_LAUNCH
  for (int ph = 0; ph < NPHASE; ++ph) {
    (void)hipFuncSetAttribute((const void*)phase_table[ph], hipFuncAttributeMaxDynamicSharedMemorySize, LDS_BYTES);
    phase_table[ph]<<<dim3(grid_blocks), dim3(256), LDS_BYTES, stream>>>(p, 0);
#ifdef DUP_MASK
    int bit = (ph == 0) ? 8 : (ph == NPHASE - 1 ? 9 : (ph - 1) & 7);
    if ((DUP_MASK >> bit) & 1) phase_table[ph]<<<dim3(grid_blocks), dim3(256), LDS_BYTES, stream>>>(p, DUP_SUB);
#endif
  }
#else
  (void)hipMemsetAsync((char*)d_ws + O_BAR, 0, XCD_BAR_WORDS * 4, stream);
  void* args[] = {&p};
  hipError_t e = hipLaunchCooperativeKernel((void*)mega_kernel, dim3(grid_blocks), dim3(256), args, LDS_BYTES, stream);
  if (e != hipSuccess) fprintf(stderr, "cooperative launch failed: %s (grid %d)\n", hipGetErrorString(e), grid_blocks);
#endif
}
```

```cpp
#include <hip/hip_runtime.h>
#include <hip/hip_cooperative_groups.h>
#include <stdint.h>
#include <stdio.h>
namespace cg = cooperative_groups;

#ifndef MULTI_LAUNCH
#define MULTI_LAUNCH 0
#endif

#define DI __device__ __forceinline__
typedef unsigned short u16;
using bf16x8 = __attribute__((ext_vector_type(8))) short;
using f32x4 = __attribute__((ext_vector_type(4))) float;
typedef __bf16 bf2_t __attribute__((ext_vector_type(2)));
typedef float f2_t __attribute__((ext_vector_type(2)));
typedef unsigned u32x4 __attribute__((ext_vector_type(4)));
typedef unsigned u32x2 __attribute__((ext_vector_type(2)));

constexpr int D = 1024, NTOK = 6144, NCTX = 4096, NIN = 3328, DFF = 4096;
constexpr float ALPHA = 1.41421356237309515f;
constexpr float LOG2E = 1.44269504088896341f;
constexpr int LDS_BYTES = 75776;
constexpr int NPHASE = 18;

constexpr size_t O_WTIN = 0;
constexpr size_t O_WTOUT = O_WTIN + (size_t)2 * NIN * D * 2;
constexpr size_t O_WTFF1 = O_WTOUT + (size_t)2 * D * D * 2;
constexpr size_t O_WTFF2 = O_WTFF1 + (size_t)2 * DFF * D * 2;
constexpr size_t O_MODS = O_WTFF2 + (size_t)2 * D * DFF * 2;
constexpr size_t O_ROPE = O_MODS + (size_t)2 * 3 * 6144 * 4;
constexpr size_t O_QA = O_ROPE + (size_t)1024 * 32 * 2 * 4;
constexpr size_t O_KACTX = O_QA + (size_t)NTOK * 512 * 2;
constexpr size_t O_KALAT = O_KACTX + (size_t)NCTX * 512 * 2;
constexpr size_t O_VTACTX = O_KALAT + (size_t)2 * 2 * 1536 * 512 * 2;
constexpr size_t O_VTALAT = O_VTACTX + (size_t)16 * 4 * 128 * 256 * 2;
constexpr size_t O_QC = O_VTALAT + (size_t)2 * 2 * 4 * 128 * 1536 * 2;
constexpr size_t O_KCCTX = O_QC + (size_t)NTOK * 256 * 2;
constexpr size_t O_KCLAT = O_KCCTX + (size_t)NCTX * 128 * 2;
constexpr size_t O_VTCCTX = O_KCLAT + (size_t)2 * 2 * 1536 * 128 * 2;
constexpr size_t O_VTCLAT = O_VTCCTX + (size_t)16 * 2 * 64 * 256 * 2;
constexpr size_t O_KV = O_VTCLAT + (size_t)2 * 2 * 2 * 64 * 1536 * 2;
constexpr size_t O_DEC = O_KV + (size_t)768 * 4096 * 4;
constexpr size_t O_MIXED = O_DEC + (size_t)768 * 64 * 4;
constexpr size_t O_XPRE1 = O_MIXED + (size_t)NTOK * 1024 * 2;
constexpr size_t O_ST1 = O_XPRE1 + (size_t)NTOK * 1024 * 4;
constexpr size_t O_XPRE2 = O_ST1 + (size_t)NTOK * 32 * 4;
constexpr size_t O_ST2 = O_XPRE2 + (size_t)NTOK * 1024 * 4;
constexpr size_t O_ABF = O_ST2 + (size_t)NTOK * 32 * 4;
constexpr size_t O_HQ = O_ABF + (size_t)NTOK * 1024 * 2;
constexpr size_t O_HGF = O_HQ + (size_t)NTOK * 256 * 4;
constexpr size_t O_HGB = O_HGF + (size_t)NTOK * 256 * 4;
constexpr size_t O_HI = O_HGB + (size_t)NTOK * 256 * 4;
constexpr size_t O_HSG = O_HI + (size_t)NTOK * 256 * 4;
constexpr size_t O_OI = O_HSG + (size_t)NTOK * 256 * 4;
constexpr size_t O_QE = O_OI + (size_t)2 * NTOK * 256 * 4;
constexpr size_t O_END1 = O_QE + (size_t)2 * NTOK * 256 * 4;
constexpr size_t O_HID = O_HQ;
constexpr size_t O_END2 = O_HID + (size_t)NTOK * 4096 * 2;
static_assert(O_END2 <= O_END1, "HID alias must fit");
static_assert(O_END1 <= (size_t)256 * 1024 * 1024, "workspace too big");

constexpr size_t OUT_YP = 0, OUT_YS = 4194304, OUT_AK = 6291456, OUT_AV = 10485760, OUT_CK = 14680064,
                 OUT_CV = 15728640, OUT_SF = 16777216, OUT_SB = 17301504;

struct P {
  const float* in[30];
  float* out;
  char* ws;
};

DI unsigned pack2(float a, float b) {
  f2_t v = {a, b};
  bf2_t r = __builtin_convertvector(v, bf2_t);
  return __builtin_bit_cast(unsigned, r);
}
DI u16 f2bf(float x) { return (u16)(pack2(x, 0.f) & 0xffffu); }
DI float ex2(float x) { return __builtin_amdgcn_exp2f(x); }
DI float siluf(float x) { return x / (1.f + expf(-x)); }
DI float shx(float v, int m) { return __shfl_xor(v, m, 64); }
DI float red16(float x) {
  x += __builtin_bit_cast(float, __builtin_amdgcn_update_dpp(0, __builtin_bit_cast(int, x), 0xB1, 0xF, 0xF, true));
  x += __builtin_bit_cast(float, __builtin_amdgcn_update_dpp(0, __builtin_bit_cast(int, x), 0x4E, 0xF, 0xF, true));
  x += __builtin_bit_cast(float, __builtin_amdgcn_update_dpp(0, __builtin_bit_cast(int, x), 0x141, 0xF, 0xF, true));
  x += __builtin_bit_cast(float, __builtin_amdgcn_update_dpp(0, __builtin_bit_cast(int, x), 0x140, 0xF, 0xF, true));
  return x;
}
DI float xor1(float x) { return __builtin_bit_cast(float, __builtin_amdgcn_update_dpp(0, __builtin_bit_cast(int, x), 0xB1, 0xF, 0xF, true)); }
DI int ltid() { int t = threadIdx.x; asm volatile("" : "+v"(t)); return t; }
#define MFMA16(a, b, c) __builtin_amdgcn_mfma_f32_16x16x32_bf16((a), (b), (c), 0, 0, 0)

DI void p0_mod(const P& p, int item, char* smem) {
  float* ssilu = (float*)smem;
  float* red = ssilu + 3072;
  const int tid = ltid();
  __syncthreads();
  for (int i = tid; i < 3072; i += 256) {
    int w = i >> 10, k = i & 1023;
    float v = (w == 0) ? p.in[9][k] : p.in[8][(w - 1) * 1024 + k];
    ssilu[i] = siluf(v);
  }
  __syncthreads();
  const int li = item / 96, j0 = (item % 96) * 64;
  const int c4 = tid & 15, kp = tid >> 4;
  const float* W = p.in[10] + (size_t)li * 1024 * 6144 + j0 + c4 * 4;
  float4 a0 = {0, 0, 0, 0}, a1 = a0, a2 = a0;
#pragma unroll 16
  for (int kk = 0; kk < 64; ++kk) {
    int k = kp * 64 + kk;
    float4 w4 = *(const float4*)(W + (size_t)k * 6144);
    float s0 = ssilu[k], s1 = ssilu[1024 + k], s2 = ssilu[2048 + k];
    a0.x += s0 * w4.x; a0.y += s0 * w4.y; a0.z += s0 * w4.z; a0.w += s0 * w4.w;
    a1.x += s1 * w4.x; a1.y += s1 * w4.y; a1.z += s1 * w4.z; a1.w += s1 * w4.w;
    a2.x += s2 * w4.x; a2.y += s2 * w4.y; a2.z += s2 * w4.z; a2.w += s2 * w4.w;
  }
  *(float4*)(red + (kp * 3 + 0) * 64 + c4 * 4) = a0;
  *(float4*)(red + (kp * 3 + 1) * 64 + c4 * 4) = a1;
  *(float4*)(red + (kp * 3 + 2) * 64 + c4 * 4) = a2;
  __syncthreads();
  if (tid < 192) {
    int w = tid >> 6, c = tid & 63;
    float s = p.in[11][li * 6144 + j0 + c];
    for (int q = 0; q < 16; ++q) s += red[(q * 3 + w) * 64 + c];
    ((float*)(p.ws + O_MODS))[(li * 3 + w) * 6144 + j0 + c] = s;
  }
}

DI void p0_rope(const P& p, int item) {
  float* R = (float*)(p.ws + O_ROPE);
  for (int i = ltid(); i < 4096; i += 256) {
    int idx = item * 4096 + i;
    int t = idx >> 5, pp = idx & 31;
    float inv = powf(10000.f, -(float)(pp & 15) / 16.f);
    float pos = (pp < 16) ? (float)(t >> 6) : (float)(t & 63);
    float ang = pos * inv;
    R[idx * 2] = cosf(ang);
    R[idx * 2 + 1] = sinf(ang);
  }
}

DI void p0_copyk(const P& p, int item, bool isA) {
  const int W = isA ? 512 : 128;
  const float* src = isA ? p.in[2] : p.in[4];
  u16* dst = (u16*)(p.ws + (isA ? O_KALAT : O_KCLAT));
  float4 vv[4];
#pragma unroll
  for (int i = 0; i < 4; ++i) vv[i] = *(const float4*)(src + (size_t)item * 4096 + (size_t)(ltid() + 256 * i) * 4);
#pragma unroll
  for (int i = 0; i < 4; ++i) {
    size_t e = (size_t)item * 4096 + (size_t)(ltid() + 256 * i) * 4;
    float4 v = vv[i];
    int c = (int)(e % W);
    size_t r = e / W;
    int pp = (int)(r % 512);
    int bl = (int)(r / 512);
    int b = bl >> 1, li = bl & 1;
    uint2 o;
    o.x = pack2(v.x, v.y);
    o.y = pack2(v.z, v.w);
    *(uint2*)(dst + ((size_t)((li * 2 + b) * 1536 + 1024 + pp)) * W + c) = o;
  }
}

struct TDesc { const float* src; int sstride; u16* dst; int dstride; };

DI TDesc tdesc(const P& p, int t) {
  constexpr int T_IN = 1664, T_OUT = 512, T_FF1 = 2048, T_FF2 = 2048, T_AV = 256;
  TDesc d;
  if (t < T_IN) {
    int li = t / 832, r = t % 832, kt = r / 52, nt = r % 52;
    d.src = p.in[12] + (size_t)li * 1024 * NIN + (size_t)(kt * 64) * NIN + nt * 64; d.sstride = NIN;
    d.dst = (u16*)(p.ws + O_WTIN) + (size_t)li * NIN * 1024 + (size_t)(nt * 64) * 1024 + kt * 64; d.dstride = 1024;
  } else if ((t -= T_IN) < T_OUT) {
    int li = t / 256, r = t % 256, kt = r / 16, nt = r % 16;
    d.src = p.in[13] + (size_t)li * 1024 * 1024 + (size_t)(kt * 64) * 1024 + nt * 64; d.sstride = 1024;
    d.dst = (u16*)(p.ws + O_WTOUT) + (size_t)li * 1024 * 1024 + (size_t)(nt * 64) * 1024 + kt * 64; d.dstride = 1024;
  } else if ((t -= T_OUT) < T_FF1) {
    int li = t / 1024, r = t % 1024, kt = r / 64, nt = r % 64;
    d.src = p.in[28] + (size_t)li * 1024 * DFF + (size_t)(kt * 64) * DFF + nt * 64; d.sstride = DFF;
    d.dst = (u16*)(p.ws + O_WTFF1) + (size_t)li * DFF * 1024 + (size_t)(nt * 64) * 1024 + kt * 64; d.dstride = 1024;
  } else if ((t -= T_FF1) < T_FF2) {
    int li = t / 1024, r = t % 1024, kt = r / 16, nt = r % 16;
    d.src = p.in[29] + (size_t)li * DFF * 1024 + (size_t)(kt * 64) * 1024 + nt * 64; d.sstride = 1024;
    d.dst = (u16*)(p.ws + O_WTFF2) + (size_t)li * 1024 * DFF + (size_t)(nt * 64) * DFF + kt * 64; d.dstride = DFF;
  } else if ((t -= T_FF2) < T_AV) {
    int bl = t / 64, r = t % 64, pt = r / 8, ct = r % 8;
    int b = bl >> 1, li = bl & 1;
    d.src = p.in[3] + ((size_t)bl * 512 + pt * 64) * 512 + ct * 64; d.sstride = 512;
    d.dst = (u16*)(p.ws + O_VTALAT) + ((size_t)(li * 2 + b) * 512 + ct * 64) * 1536 + 1024 + pt * 64; d.dstride = 1536;
  } else {
    t -= T_AV;
    int bl = t / 16, r = t % 16, pt = r / 2, ct = r % 2;
    int b = bl >> 1, li = bl & 1;
    d.src = p.in[5] + ((size_t)bl * 512 + pt * 64) * 128 + ct * 64; d.sstride = 128;
    d.dst = (u16*)(p.ws + O_VTCLAT) + ((size_t)(li * 2 + b) * 128 + ct * 64) * 1536 + 1024 + pt * 64; d.dstride = 1536;
  }
  return d;
}

DI int tcount(int mode) { return mode == 0 ? 832 + 256 + 320 : (mode == 1 ? 832 + 256 : 2048); }
DI int tmap(int k, int mode) {
  if (mode == 0) {
    if (k < 832) return k;
    if (k < 1088) return 1664 + (k - 832);
    return 6272 + (k - 1088);
  }
  if (mode == 1) {
    if (k < 832) return 832 + k;
    return 1920 + (k - 832);
  }
  const int li = mode - 2;
  if (k < 1024) return 2176 + li * 1024 + k;
  return 4224 + li * 1024 + (k - 1024);
}
DI void run_transposes(const P& p, char* smem, int first, int step, int deferred, int count_override = -1) {
  const int count = count_override >= 0 ? count_override : tcount(deferred);
  float* tl = (float*)smem;
  const int tid = ltid();
  const int lr = tid >> 4, lc4 = tid & 15;
  const int c = tid >> 2, rs = tid & 3;
  int t = first;
  f32x4 v[4];
  TDesc cur;
  if (t < count) {
    cur = tdesc(p, tmap(t, deferred));
#pragma unroll
    for (int i = 0; i < 4; ++i) v[i] = *(const f32x4*)(cur.src + (size_t)(lr + 16 * i) * cur.sstride + lc4 * 4);
  }
  while (t < count) {
    __syncthreads();
#pragma unroll
    for (int i = 0; i < 4; ++i) {
      float* q = tl + (lr + 16 * i) * 65 + lc4 * 4;
      q[0] = v[i].x; q[1] = v[i].y; q[2] = v[i].z; q[3] = v[i].w;
    }
    const int tn = t + step;
    TDesc nxt = cur;
    if (tn < count) {
      nxt = tdesc(p, tmap(tn, deferred));
#pragma unroll
      for (int i = 0; i < 4; ++i) v[i] = *(const f32x4*)(nxt.src + (size_t)(lr + 16 * i) * nxt.sstride + lc4 * 4);
    }
    __syncthreads();
    u32x4 o0, o1;
    {
      const float* q = tl + (rs * 16) * 65 + c;
      o0.x = pack2(q[0 * 65], q[1 * 65]);   o0.y = pack2(q[2 * 65], q[3 * 65]);
      o0.z = pack2(q[4 * 65], q[5 * 65]);   o0.w = pack2(q[6 * 65], q[7 * 65]);
      o1.x = pack2(q[8 * 65], q[9 * 65]);   o1.y = pack2(q[10 * 65], q[11 * 65]);
      o1.z = pack2(q[12 * 65], q[13 * 65]); o1.w = pack2(q[14 * 65], q[15 * 65]);
    }
    u32x4* dp = (u32x4*)(cur.dst + (size_t)c * cur.dstride + rs * 16);
    dp[0] = o0;
    dp[1] = o1;
    cur = nxt;
    t = tn;
  }
}

DI void phase0(const P& p, char* smem) {
  constexpr int N_MOD = 192, N_ROPE = 8, N_AK = 256, N_CK = 64;
  constexpr int B_ROPE = N_MOD, B_AK = B_ROPE + N_ROPE, B_CK = B_AK + N_AK, B_T = B_CK + N_CK;
  constexpr int NTILES = 1664 + 512 + 2048 + 2048 + 256 + 64;
  for (int it = blockIdx.x; it < B_T; it += gridDim.x) {
    if (it < B_ROPE) p0_mod(p, it, smem);
    else if (it < B_AK) p0_rope(p, it - B_ROPE);
    else if (it < B_CK) p0_copyk(p, it - B_AK, true);
    else p0_copyk(p, it - B_CK, false);
  }
  run_transposes(p, smem, blockIdx.x, gridDim.x, 0);
}

struct GA {
  const float* alo;
  const float* ahi;
  const float* stats;
  const float* lng;
  const float* lnb;
  const float* mods;
  int sc_off, sh_off;
  const u16* a16;
  const u16* bt;
  int K, N;
  float* xout;
  float* sout;
  u16* hid;
};

DI void epi_inproj(const P& p, int li, f32x4 (&acc)[4][4], int R0, int C0);


template <int EPI, int MI = 4>
DI void gemm_tile(const P& p, const GA& g, int li, int m0, int n0, char* smem, u32x4 (&ra0)[4], u32x4 (&rb0)[4],
                  u32x4 (&ra1)[4], u32x4 (&rb1)[4], bool primed, int nm0, int nn0) {
  static_assert(MI == 4 || EPI == 1, "only the residual epilogue supports 96-row tiles");
  constexpr int WM = MI * 16;
  const int tid = ltid(), lane = tid & 63, wid = tid >> 6, wr = wid >> 1, wc = wid & 1;
  const int l16 = lane & 15, q4 = lane >> 4;
  u16* sA0 = (u16*)smem;
  u16* sB0 = sA0 + 128 * 72;
  u16* sA1 = sB0 + 128 * 72;
  u16* sB1 = sA1 + 128 * 72;
  float2* sStat = (float2*)(smem + 73728);
  const int K = g.K;
  const int rtype = (m0 < NCTX) ? 0 : 1 + ((m0 - NCTX) >> 10);
  const float* modv = g.mods + rtype * 6144;
  const float* fsrc = (m0 < NCTX) ? g.alo + (size_t)m0 * 1024 : g.ahi + (size_t)(m0 - NCTX) * 1024;

  if (!primed) {
    const unsigned goff_ = (unsigned)(tid >> 3) * (unsigned)g.K + (unsigned)(tid & 7) * 8u;
    const u16* ab_ = g.a16 + (size_t)m0 * g.K;
    const u16* bb_ = g.bt + (size_t)n0 * g.K;
#pragma unroll
    for (int i = 0; i < 4; ++i) {
      if (i < MI) ra0[i] = *(const u32x4*)(ab_ + (size_t)(32 * i) * g.K + goff_);
      rb0[i] = *(const u32x4*)(bb_ + (size_t)(32 * i) * g.K + goff_);
    }
    __builtin_amdgcn_sched_barrier(0);
#pragma unroll
    for (int i = 0; i < 4; ++i) {
      if (i < MI) ra1[i] = *(const u32x4*)(ab_ + (size_t)(32 * i) * g.K + 64 + goff_);
      rb1[i] = *(const u32x4*)(bb_ + (size_t)(32 * i) * g.K + 64 + goff_);
    }
    __builtin_amdgcn_sched_barrier(0);
  }
  __syncthreads();
  if constexpr (EPI == 1 || EPI == 3) {
    if (g.stats != nullptr && tid < 2 * WM) {
      const float4* sp = (const float4*)(g.stats + (size_t)(m0 + tid) * 32);
      float s1 = 0.f, s2 = 0.f;
#pragma unroll
      for (int i = 0; i < 8; ++i) {
        float4 v = sp[i];
        s1 += v.x + v.z;
        s2 += v.y + v.w;
      }
      float mu = s1 * (1.f / 1024.f);
      float var = s2 * (1.f / 1024.f) - mu * mu;
      sStat[tid] = make_float2(mu, rsqrtf(fmaxf(var, 0.f) + 1e-6f));
    }
  }

  f32x4 acc[MI][4];
#pragma unroll
  for (int i = 0; i < MI; ++i)
#pragma unroll
    for (int j = 0; j < 4; ++j) acc[i][j] = f32x4{0.f, 0.f, 0.f, 0.f};

  const unsigned goff = (unsigned)(tid >> 3) * (unsigned)K + (unsigned)(tid & 7) * 8u;
  const unsigned loff = (unsigned)(tid >> 3) * 72u + (unsigned)(tid & 7) * 8u;
  const u16* abase = g.a16 + (size_t)m0 * K;
  const u16* bbase = g.bt + (size_t)n0 * K;
#define GLOAD(RA, RB, KT)                                                        \
  _Pragma("unroll") for (int i = 0; i < 4; ++i) {                                \
    if (i < MI) RA[i] = *(const u32x4*)(abase + (size_t)(32 * i) * K + (KT) * 64 + goff); \
    RB[i] = *(const u32x4*)(bbase + (size_t)(32 * i) * K + (KT) * 64 + goff);    \
  }
#define LSTORE(SA, SB, RA, RB)                                                   \
  _Pragma("unroll") for (int i = 0; i < 4; ++i) {                                \
    if (i < MI) *(u32x4*)(SA + 32 * i * 72 + loff) = RA[i];                      \
    *(u32x4*)(SB + 32 * i * 72 + loff) = RB[i];                                  \
  }
#define COMPUTE(SA, SB)                                                          \
  _Pragma("unroll") for (int s = 0; s < 2; ++s) {                                \
    bf16x8 af[MI], bfr[4];                                                       \
    _Pragma("unroll") for (int i = 0; i < 4; ++i) {                              \
      if (i < MI) af[i] = *(const bf16x8*)(SA + (wr * WM + i * 16 + l16) * 72 + s * 32 + q4 * 8);  \
      bfr[i] = *(const bf16x8*)(SB + (wc * 64 + i * 16 + l16) * 72 + s * 32 + q4 * 8); \
    }                                                                            \
    __builtin_amdgcn_s_setprio(1);                                               \
    _Pragma("unroll") for (int i = 0; i < MI; ++i)                               \
      _Pragma("unroll") for (int j = 0; j < 4; ++j) acc[i][j] = MFMA16(af[i], bfr[j], acc[i][j]); \
    __builtin_amdgcn_s_setprio(0);                                               \
    __builtin_amdgcn_sched_barrier(0);                                           \
  }

  const int nk = K >> 6;
#define SB0 __builtin_amdgcn_sched_barrier(0)
  LSTORE(sA0, sB0, ra0, rb0);
  SB0;
  GLOAD(ra0, rb0, 2);
  SB0;
  __syncthreads();
#pragma unroll 1
  for (int kt = 0; kt < nk - 4; kt += 2) {
    SB0;
    LSTORE(sA1, sB1, ra1, rb1);
    SB0;
    GLOAD(ra1, rb1, kt + 3);
    SB0;
    COMPUTE(sA0, sB0);
    __syncthreads();
    SB0;
    LSTORE(sA0, sB0, ra0, rb0);
    SB0;
    GLOAD(ra0, rb0, kt + 4);
    SB0;
    COMPUTE(sA1, sB1);
    __syncthreads();
  }
  SB0;
  LSTORE(sA1, sB1, ra1, rb1);
  SB0;
  GLOAD(ra1, rb1, nk - 1);
  SB0;
  COMPUTE(sA0, sB0);
  __syncthreads();
  const u16* nabase = g.a16 + (size_t)nm0 * K;
  const u16* nbbase = g.bt + (size_t)nn0 * K;
  SB0;
  LSTORE(sA0, sB0, ra0, rb0);
  SB0;
  _Pragma("unroll") for (int i = 0; i < 4; ++i) {
    if (i < MI) ra0[i] = *(const u32x4*)(nabase + (size_t)(32 * i) * K + goff);
    rb0[i] = *(const u32x4*)(nbbase + (size_t)(32 * i) * K + goff);
  }
  SB0;
  COMPUTE(sA1, sB1);
  __syncthreads();
  SB0;
  LSTORE(sA1, sB1, ra1, rb1);
  SB0;
  _Pragma("unroll") for (int i = 0; i < 4; ++i) {
    if (i < MI) ra1[i] = *(const u32x4*)(nabase + (size_t)(32 * i) * K + 64 + goff);
    rb1[i] = *(const u32x4*)(nbbase + (size_t)(32 * i) * K + 64 + goff);
  }
  SB0;
  COMPUTE(sA0, sB0);
  __syncthreads();
  SB0;
  COMPUTE(sA1, sB1);
#undef GLOAD
#undef LSTORE
#undef COMPUTE
#undef SB0
  asm volatile("" ::: "memory");

  const int R0 = m0 + wr * WM, C0 = n0 + wc * 64;
  if constexpr (EPI == 0) {
    if constexpr (MI == 4) epi_inproj(p, li, acc, R0, C0);
  } else if constexpr (EPI == 1) {
    const int rtA = rtype;
    const int mlast = m0 + 2 * WM - 1;
    const int rtB = (mlast < NCTX) ? 0 : 1 + ((mlast - NCTX) >> 10);
    const float* modvB = g.mods + rtB * 6144;
    float gateA[4], gateB[4], lg[4], lb[4];
#pragma unroll
    for (int j = 0; j < 4; ++j) {
      int col = C0 + j * 16 + l16;
      gateA[j] = modv[g.sc_off + col];
      gateB[j] = modvB[g.sc_off + col];
      lg[j] = g.stats ? g.lng[col] : 1.f;
      lb[j] = g.stats ? g.lnb[col] : 0.f;
    }
    float xr[MI][4][4];
#pragma unroll
    for (int i = 0; i < MI; ++i)
#pragma unroll
      for (int r = 0; r < 4; ++r) {
        const int grow = m0 + wr * WM + i * 16 + q4 * 4 + r;
        const float* rp = (grow < NCTX) ? g.alo + (size_t)grow * 1024 : g.ahi + (size_t)(grow - NCTX) * 1024;
#pragma unroll
        for (int j = 0; j < 4; ++j) xr[i][r][j] = rp[C0 + j * 16 + l16];
      }
#pragma unroll
    for (int i = 0; i < MI; ++i) {
#pragma unroll
      for (int r = 0; r < 4; ++r) {
        int lrow = wr * WM + i * 16 + q4 * 4 + r;
        const int grow = m0 + lrow;
        const int rt = (grow < NCTX) ? 0 : 1 + ((grow - NCTX) >> 10);
        const bool useA = (rt == rtA);
        float mu = 0.f, rs = 1.f;
        if (g.stats != nullptr) {
          float2 st = sStat[lrow];
          mu = st.x;
          rs = st.y;
        }
        float s1 = 0.f, s2 = 0.f;
#pragma unroll
        for (int j = 0; j < 4; ++j) {
          int col = C0 + j * 16 + l16;
          float x = xr[i][r][j];
          x = (x - mu) * rs * lg[j] + lb[j];
          float v = ALPHA * x + (useA ? gateA[j] : gateB[j]) * acc[i][j][r];
          g.xout[(size_t)grow * 1024 + col] = v;
          s1 += v;
          s2 += v * v;
        }
        s1 = red16(s1);
        s2 = red16(s2);
        if (l16 == 0) *(float2*)(g.sout + (size_t)grow * 32 + (C0 >> 6) * 2) = make_float2(s1, s2);
      }
    }
  } else {
    float* sC = (float*)smem;
    __syncthreads();
#pragma unroll
    for (int i = 0; i < 4; ++i)
#pragma unroll
      for (int j = 0; j < 4; ++j)
#pragma unroll
        for (int r = 0; r < 4; ++r) if constexpr (MI == 4) sC[(wr * 64 + i * 16 + q4 * 4 + r) * 132 + wc * 64 + j * 16 + l16] = acc[i][j][r];
    __syncthreads();
    if constexpr (EPI == 3) {
      const int hl = lane & 31, rsel = lane >> 5;
      const int col = n0 + hl * 4;
      const f32x4 gate4 = *(const f32x4*)(modv + g.sc_off + col);
      f32x4 lg4 = {1.f, 1.f, 1.f, 1.f}, lb4 = {0.f, 0.f, 0.f, 0.f};
      if (g.stats != nullptr) {
        lg4 = *(const f32x4*)(g.lng + col);
        lb4 = *(const f32x4*)(g.lnb + col);
      }
#pragma unroll 4
      for (int pp = 0; pp < 16; ++pp) {
        const int lrow = pp * 8 + wid * 2 + rsel;
        f32x4 a = *(const f32x4*)(sC + lrow * 132 + hl * 4);
        f32x4 x = *(const f32x4*)(fsrc + (size_t)lrow * 1024 + col);
        float mu = 0.f, rs = 1.f;
        if (g.stats != nullptr) {
          float2 st = sStat[lrow];
          mu = st.x;
          rs = st.y;
        }
        x = (x - mu) * rs * lg4 + lb4;
        f32x4 v = ALPHA * x + gate4 * a;
        *(f32x4*)(g.xout + (size_t)(m0 + lrow) * 1024 + col) = v;
        float s1 = (v.x + v.y) + (v.z + v.w);
        float s2 = (v.x * v.x + v.y * v.y) + (v.z * v.z + v.w * v.w);
        s1 = red16(s1);
        s2 = red16(s2);
        if ((lane & 15) == 0) *(float2*)(g.sout + (size_t)(m0 + lrow) * 32 + ((n0 >> 6) + (hl >> 4)) * 2) = make_float2(s1, s2);
      }
    } else {
#pragma unroll
      for (int pp = 0; pp < 8; ++pp) {
        const int idx = tid + 256 * pp;
        const int lrow = idx >> 4, c8 = idx & 15;
        f32x4 a0 = *(const f32x4*)(sC + lrow * 132 + c8 * 8);
        f32x4 a1 = *(const f32x4*)(sC + lrow * 132 + c8 * 8 + 4);
        a0.x = fmaxf(a0.x, 0.f); a0.y = fmaxf(a0.y, 0.f); a0.z = fmaxf(a0.z, 0.f); a0.w = fmaxf(a0.w, 0.f);
        a1.x = fmaxf(a1.x, 0.f); a1.y = fmaxf(a1.y, 0.f); a1.z = fmaxf(a1.z, 0.f); a1.w = fmaxf(a1.w, 0.f);
        u32x4 o;
        o.x = pack2(a0.x * a0.x, a0.y * a0.y);
        o.y = pack2(a0.z * a0.z, a0.w * a0.w);
        o.z = pack2(a1.x * a1.x, a1.y * a1.y);
        o.w = pack2(a1.z * a1.z, a1.w * a1.w);
        *(u32x4*)(g.hid + (size_t)(m0 + lrow) * DFF + n0 + c8 * 8) = o;
      }
    }
  }
}

DI void epi_inproj(const P& p, int li, f32x4 (&acc)[4][4], int R0, int C0) {
  const int lane = ltid() & 63, l16 = lane & 15, q4 = lane >> 4;
  const int seg = C0 >> 6;
  const bool lat = R0 >= NCTX;
  const float2* rope = (const float2*)(p.ws + O_ROPE);
  int b, tb;
  if (!lat) { b = R0 >> 8; tb = R0 & 255; } else { b = (R0 - NCTX) >> 10; tb = (R0 - NCTX) & 1023; }

  enum { T_QA, T_KA, T_VA, T_QB, T_FF, T_FB, T_IB, T_GB, T_QC, T_KC, T_VC };
  int type, cbase;
  if (seg < 8) { type = T_QA; cbase = seg * 64; }
  else if (seg < 16) { type = T_KA; cbase = (seg - 8) * 64; }
  else if (seg < 24) { type = T_VA; cbase = (seg - 16) * 64; }
  else if (seg < 28) { type = T_QB; cbase = (seg - 24) * 64; }
  else if (seg < 32) { type = T_FF; cbase = (seg - 28) * 64; }
  else if (seg < 36) { type = T_FB; cbase = (seg - 32) * 64; }
  else if (seg < 40) { type = T_IB; cbase = (seg - 36) * 64; }
  else if (seg < 44) { type = T_GB; cbase = (seg - 40) * 64; }
  else if (seg < 48) { type = T_QC; cbase = (seg - 44) * 64; }
  else if (seg < 50) { type = T_KC; cbase = (seg - 48) * 64; }
  else { type = T_VC; cbase = (seg - 50) * 64; }

  if (type == T_QC || type == T_KC) {
    const float* gv = (type == T_QC ? p.in[22] : p.in[23]) + li * 64;
    float gj[4];
#pragma unroll
    for (int j = 0; j < 4; ++j) gj[j] = gv[j * 16 + l16];
#pragma unroll
    for (int i = 0; i < 4; ++i)
#pragma unroll
      for (int r = 0; r < 4; ++r) {
        float ss = 0.f;
#pragma unroll
        for (int j = 0; j < 4; ++j) ss += acc[i][j][r] * acc[i][j][r];
        ss = red16(ss);
        float rs = rsqrtf(ss * (1.f / 64.f) + 1e-6f);
#pragma unroll
        for (int j = 0; j < 4; ++j) acc[i][j][r] = acc[i][j][r] * rs * gj[j];
      }
  }
  if (!lat && (type == T_KA || type == T_VA || type == T_KC || type == T_VC)) {
    float* o;
    int W;
    if (type == T_KA) { o = p.out + OUT_AK; W = 512; }
    else if (type == T_VA) { o = p.out + OUT_AV; W = 512; }
    else if (type == T_KC) { o = p.out + OUT_CK; W = 128; }
    else { o = p.out + OUT_CV; W = 128; }
#pragma unroll
    for (int i = 0; i < 4; ++i)
#pragma unroll
      for (int r = 0; r < 4; ++r) {
        int t = tb + i * 16 + q4 * 4 + r;
        size_t base = ((size_t)(b * 2 + li) * 256 + t) * W + cbase;
#pragma unroll
        for (int j = 0; j < 4; ++j) o[base + j * 16 + l16] = acc[i][j][r];
      }
  }
  if (lat && (type == T_QA || type == T_KA || type == T_QC || type == T_KC)) {
#pragma unroll
    for (int i = 0; i < 4; ++i)
#pragma unroll
      for (int r = 0; r < 4; ++r) {
        int t = tb + i * 16 + q4 * 4 + r;
#pragma unroll
        for (int j = 0; j < 4; ++j) {
          float v = acc[i][j][r];
          float pv = xor1(v);
          float2 cs = rope[t * 32 + j * 8 + (l16 >> 1)];
          acc[i][j][r] = (l16 & 1) ? (pv * cs.y + v * cs.x) : (v * cs.x - pv * cs.y);
        }
      }
  }

  if (type == T_QA || type == T_KA || type == T_QC || type == T_KC) {
    u16* dst;
    int W;
    size_t rowbase;
    if (type == T_QA) { dst = (u16*)(p.ws + O_QA); W = 512; rowbase = (size_t)R0 * 512; }
    else if (type == T_QC) { dst = (u16*)(p.ws + O_QC); W = 256; rowbase = (size_t)R0 * 256; }
    else if (type == T_KA) {
      W = 512;
      if (!lat) { dst = (u16*)(p.ws + O_KACTX); rowbase = (size_t)R0 * 512; }
      else { dst = (u16*)(p.ws + O_KALAT); rowbase = ((size_t)(li * 2 + b) * 1536 + tb) * 512; }
    } else {
      W = 128;
      if (!lat) { dst = (u16*)(p.ws + O_KCCTX); rowbase = (size_t)R0 * 128; }
      else { dst = (u16*)(p.ws + O_KCLAT); rowbase = ((size_t)(li * 2 + b) * 1536 + tb) * 128; }
    }
#pragma unroll
    for (int i = 0; i < 4; ++i)
#pragma unroll
      for (int r = 0; r < 4; ++r) {
        size_t base = rowbase + (size_t)(i * 16 + q4 * 4 + r) * W + cbase;
#pragma unroll
        for (int j = 0; j < 4; ++j) dst[base + j * 16 + l16] = f2bf(acc[i][j][r]);
      }
  } else if (type == T_VA || type == T_VC) {
    u16* dst;
    int L;
    size_t hb;
    if (type == T_VA) {
      int h = cbase >> 7, dv0 = cbase & 127;
      if (!lat) { dst = (u16*)(p.ws + O_VTACTX); L = 256; hb = ((size_t)(b * 4 + h) * 128 + dv0) * 256; }
      else { dst = (u16*)(p.ws + O_VTALAT); L = 1536; hb = ((size_t)((li * 2 + b) * 4 + h) * 128 + dv0) * 1536; }
    } else {
      int n = cbase >> 6;
      if (!lat) { dst = (u16*)(p.ws + O_VTCCTX); L = 256; hb = ((size_t)(b * 2 + n) * 64) * 256; }
      else { dst = (u16*)(p.ws + O_VTCLAT); L = 1536; hb = ((size_t)((li * 2 + b) * 2 + n) * 64) * 1536; }
    }
#pragma unroll
    for (int i = 0; i < 4; ++i)
#pragma unroll
      for (int j = 0; j < 4; ++j) {
        uint2 o;
        o.x = pack2(acc[i][j][0], acc[i][j][1]);
        o.y = pack2(acc[i][j][2], acc[i][j][3]);
        *(uint2*)(dst + hb + (size_t)(j * 16 + l16) * L + tb + i * 16 + q4 * 4) = o;
      }
  } else {
    float* dst;
    if (type == T_QB) dst = (float*)(p.ws + O_HQ);
    else if (type == T_FF) dst = (float*)(p.ws + O_HGF);
    else if (type == T_FB) dst = (float*)(p.ws + O_HGB);
    else if (type == T_IB) dst = (float*)(p.ws + O_HI);
    else dst = (float*)(p.ws + O_HSG);
    float lbv[4] = {0.f, 0.f, 0.f, 0.f};
    if ((type == T_FF || type == T_FB) && li == 1) {
      const float* lg = (type == T_FF) ? p.in[19] : p.in[20];
#pragma unroll
      for (int j = 0; j < 4; ++j) {
        int c = cbase + j * 16 + l16;
        lbv[j] = 1.f / (1.f + expf(lg[c] - lg[256 + c]));
      }
    }
#pragma unroll
    for (int i = 0; i < 4; ++i)
#pragma unroll
      for (int r = 0; r < 4; ++r) {
        size_t base = (size_t)(R0 + i * 16 + q4 * 4 + r) * 256 + cbase;
#pragma unroll
        for (int j = 0; j < 4; ++j) {
          float v = acc[i][j][r];
          float o;
          if (type == T_QB || type == T_GB) o = v * __frcp_rn(1.f + __expf(-v));
          else if (type == T_IB) o = v;
          else {
            float sg = __frcp_rn(1.f + __expf(-v));
            float f = lbv[j] + (1.f - lbv[j]) * sg;
            o = __logf(fmaxf(f, 1e-6f));
          }
          dst[base + j * 16 + l16] = o;
        }
      }
  }
}

template <int EPI, int MI = 4>
DI void gemm_phase(const P& p, const GA& g, int li, char* smem) {
  constexpr int BMT = MI * 32;
  constexpr int MPX = NTOK / BMT / 8;
  const int NT = g.N >> 7;
  const int xcd = blockIdx.x & 7, lb = blockIdx.x >> 3, nlb = gridDim.x >> 3;
  if (lb >= nlb) return;
  u32x4 ra0[4], rb0[4], ra1[4], rb1[4];
  bool primed = false;
  for (int t = lb; t < MPX * NT; t += nlb) {
    int mt = xcd * MPX + t % MPX, nt = t / MPX;
    const int tn = (t + nlb < MPX * NT) ? t + nlb : t;
    const int nmt = xcd * MPX + tn % MPX, nnt = tn / MPX;
    gemm_tile<EPI, MI>(p, g, li, mt * BMT, nt * 128, smem, ra0, rb0, ra1, rb1, primed, nmt * BMT, nnt * 128);
    primed = true;
  }
}


template <int KW, int DV>
DI void attn_gload(const u16* Kb, int kstride, const u16* VT, int L, int kb, int tid, u32x4 (&kr)[KW / 32], u32x4 (&vr)[DV / 32]) {
  constexpr int KPR = 256 / (KW / 8);
  const unsigned koff = (unsigned)(tid / (KW / 8)) * (unsigned)kstride + (unsigned)(tid % (KW / 8)) * 8u;
  const unsigned voff = (unsigned)(tid >> 3) * (unsigned)L + (unsigned)(tid & 7) * 8u;
#pragma unroll
  for (int i = 0; i < KW / 32; ++i) {
    const u16* kbp = Kb + (size_t)(kb * 64 + KPR * i) * kstride;
    kr[i] = *(const u32x4*)(kbp + koff);
  }
#pragma unroll
  for (int i = 0; i < DV / 32; ++i) {
    const u16* vbp = VT + (size_t)(32 * i) * L + kb * 64;
    vr[i] = *(const u32x4*)(vbp + voff);
  }
}
template <int KW, int DV>
DI void attn_lstore(u16* sK, u16* sV, int tid, const u32x4 (&kr)[KW / 32], const u32x4 (&vr)[DV / 32]) {
  constexpr int KS = KW + 8;
#pragma unroll
  for (int i = 0; i < KW / 32; ++i) {
    int idx = tid + 256 * i;
    int key = idx / (KW / 8), cc = idx % (KW / 8);
    *(u32x4*)(sK + key * KS + cc * 8) = kr[i];
  }
#pragma unroll
  for (int i = 0; i < DV / 32; ++i) {
    int idx = tid + 256 * i;
    int row = idx >> 3, cc = idx & 7;
    *(u32x4*)(sV + row * 72 + cc * 8) = vr[i];
  }
}

template <int KW, int DV, int NQ>
DI void attn_compute(const u16* sK, const u16* sV, int kfo, int l16, int q4, const bf16x8 (&qf)[NQ][2],
                     f32x4 (&o)[NQ][DV / 16], float (&m)[NQ], float (&l)[NQ]) {
  constexpr int KS = KW + 8, NDT = DV / 16;
  const float c = 0.125f * LOG2E;
  f32x4 st[NQ][4];
#pragma unroll
  for (int kt = 0; kt < 4; ++kt) {
    const u16* kp = sK + (kt * 16 + l16) * KS + kfo + q4 * 8;
    bf16x8 k0 = *(const bf16x8*)kp;
    bf16x8 k1 = *(const bf16x8*)(kp + 32);
#pragma unroll
    for (int q = 0; q < NQ; ++q) {
      f32x4 z = {0.f, 0.f, 0.f, 0.f};
      z = MFMA16(k0, qf[q][0], z);
      st[q][kt] = MFMA16(k1, qf[q][1], z);
    }
  }
#pragma unroll
  for (int q = 0; q < NQ; ++q) {
    float bm = st[q][0][0];
#pragma unroll
    for (int kt = 0; kt < 4; ++kt)
#pragma unroll
      for (int r = 0; r < 4; ++r) bm = fmaxf(bm, st[q][kt][r]);
    bm = fmaxf(bm, shx(bm, 16));
    bm = fmaxf(bm, shx(bm, 32));
    const float mn = fmaxf(m[q], bm);
    const float alpha = ex2((m[q] - mn) * c);
    m[q] = mn;
    float ps = 0.f;
#pragma unroll
    for (int kt = 0; kt < 4; ++kt)
#pragma unroll
      for (int r = 0; r < 4; ++r) {
        float pv = ex2((st[q][kt][r] - mn) * c);
        st[q][kt][r] = pv;
        ps += pv;
      }
    l[q] = l[q] * alpha + ps;
#pragma unroll
    for (int d = 0; d < NDT; ++d) {
      o[q][d][0] *= alpha; o[q][d][1] *= alpha; o[q][d][2] *= alpha; o[q][d][3] *= alpha;
    }
  }
#pragma unroll
  for (int ks = 0; ks < 2; ++ks) {
    bf16x8 pf[NQ];
#pragma unroll
    for (int q = 0; q < NQ; ++q) {
      u32x4 pu;
      pu.x = pack2(st[q][2 * ks][0], st[q][2 * ks][1]);
      pu.y = pack2(st[q][2 * ks][2], st[q][2 * ks][3]);
      pu.z = pack2(st[q][2 * ks + 1][0], st[q][2 * ks + 1][1]);
      pu.w = pack2(st[q][2 * ks + 1][2], st[q][2 * ks + 1][3]);
      pf[q] = __builtin_bit_cast(bf16x8, pu);
    }
#pragma unroll
    for (int d = 0; d < NDT; ++d) {
      const u16* vp = sV + (d * 16 + l16) * 72 + ks * 32 + q4 * 4;
      u32x2 v0 = *(const u32x2*)vp;
      u32x2 v1 = *(const u32x2*)(vp + 16);
      u32x4 vu = {v0.x, v0.y, v1.x, v1.y};
      bf16x8 vf = __builtin_bit_cast(bf16x8, vu);
#pragma unroll
      for (int q = 0; q < NQ; ++q) o[q][d] = MFMA16(vf, pf[q], o[q][d]);
    }
  }
}

template <int KW, int DV, bool DIFF>
DI void attn_item(const u16* Q, int qstride, int qcol, int qrow0, const u16* Kb, int kstride, const u16* VT, int L,
                          int nkeys, u16* mixed, int mixcol, float lam, float postscale, const float* subg, char* smem) {
  constexpr int NQ = 2;
  const int tid = ltid(), lane = tid & 63, wid = tid >> 6, l16 = lane & 15, q4 = lane >> 4;
  const int qsub = wid & 1, var = wid >> 1;
  constexpr int KS = KW + 8;
  constexpr int STAGE = 64 * KS + DV * 72;
  u16* sK0 = (u16*)smem;
  u16* sV0 = sK0 + 64 * KS;
  u16* sK1 = sK0 + STAGE;
  u16* sV1 = sV0 + STAGE;
  constexpr int KPT = KW / 32, VPT = DV / 32, NDT = DV / 16;
  const int kfo = DIFF ? var * 64 : 0;

  bf16x8 qf[NQ][2];
#pragma unroll
  for (int q = 0; q < NQ; ++q) {
    const u16* qp = Q + (size_t)(qrow0 + qsub * 32 + q * 16 + l16) * qstride + qcol + var * 64 + q4 * 8;
    qf[q][0] = *(const bf16x8*)qp;
    qf[q][1] = *(const bf16x8*)(qp + 32);
  }

  u32x4 kr0[KPT], vr0[VPT];
  f32x4 o[NQ][NDT];
  float m[NQ], l[NQ];
#pragma unroll
  for (int q = 0; q < NQ; ++q) {
    m[q] = -INFINITY;
    l[q] = 0.f;
#pragma unroll
    for (int d = 0; d < NDT; ++d) o[q][d] = f32x4{0.f, 0.f, 0.f, 0.f};
  }
  const int nkb = nkeys >> 6;
#define SB0 __builtin_amdgcn_sched_barrier(0)
#define ACOMP(SK, SV) attn_compute<KW, DV, NQ>(SK, SV, kfo, l16, q4, qf, o, m, l)
  attn_gload<KW, DV>(Kb, kstride, VT, L, 0, tid, kr0, vr0);
  SB0;
  __syncthreads();
  attn_lstore<KW, DV>(sK0, sV0, tid, kr0, vr0);
  SB0;
  attn_gload<KW, DV>(Kb, kstride, VT, L, 1, tid, kr0, vr0);
  SB0;
  __syncthreads();
#pragma unroll 1
  for (int kb = 0; kb < nkb - 2; kb += 2) {
    SB0;
    attn_lstore<KW, DV>(sK1, sV1, tid, kr0, vr0);
    SB0;
    attn_gload<KW, DV>(Kb, kstride, VT, L, kb + 2, tid, kr0, vr0);
    SB0;
    ACOMP(sK0, sV0);
    __syncthreads();
    SB0;
    attn_lstore<KW, DV>(sK0, sV0, tid, kr0, vr0);
    SB0;
    attn_gload<KW, DV>(Kb, kstride, VT, L, kb + 3, tid, kr0, vr0);
    SB0;
    ACOMP(sK1, sV1);
    __syncthreads();
  }
  SB0;
  attn_lstore<KW, DV>(sK1, sV1, tid, kr0, vr0);
  SB0;
  ACOMP(sK0, sV0);
  __syncthreads();
  SB0;
  ACOMP(sK1, sV1);
  __syncthreads();
#undef SB0
#undef ACOMP
  float inv[NQ];
#pragma unroll
  for (int q = 0; q < NQ; ++q) {
    float lt = l[q];
    lt += shx(lt, 16);
    lt += shx(lt, 32);
    inv[q] = 1.f / lt;
  }
  if constexpr (DIFF) {
    float* sO = (float*)smem;
    if (var == 1) {
#pragma unroll
      for (int q = 0; q < NQ; ++q)
#pragma unroll
        for (int d = 0; d < NDT; ++d)
          *(f32x4*)(sO + (qsub * 32 + q * 16 + l16) * 132 + d * 16 + q4 * 4) = o[q][d] * inv[q];
    }
    __syncthreads();
    if (var == 0) {
      f32x4 ggv[NDT];
#pragma unroll
      for (int d = 0; d < NDT; ++d) ggv[d] = *(const f32x4*)(subg + d * 16 + q4 * 4);
#pragma unroll
      for (int q = 0; q < NQ; ++q) {
        const int row = qrow0 + qsub * 32 + q * 16 + l16;
        float ss = 0.f;
#pragma unroll
        for (int d = 0; d < NDT; ++d) {
          f32x4 o1 = *(const f32x4*)(sO + (qsub * 32 + q * 16 + l16) * 132 + d * 16 + q4 * 4);
          o[q][d] = o[q][d] * inv[q] - lam * o1;
          ss += o[q][d][0] * o[q][d][0] + o[q][d][1] * o[q][d][1] + o[q][d][2] * o[q][d][2] + o[q][d][3] * o[q][d][3];
        }
        ss += shx(ss, 16);
        ss += shx(ss, 32);
        const float rs = rsqrtf(ss * (1.f / 128.f) + 1e-6f) * postscale;
#pragma unroll
        for (int d = 0; d < NDT; ++d) {
          f32x4 v = o[q][d] * rs * ggv[d];
          u32x2 ov;
          ov.x = pack2(v.x, v.y);
          ov.y = pack2(v.z, v.w);
          *(u32x2*)(mixed + (size_t)row * 1024 + mixcol + d * 16 + q4 * 4) = ov;
        }
      }
    }
  } else {
#pragma unroll
    for (int q = 0; q < NQ; ++q) {
      const int row = qrow0 + qsub * 32 + q * 16 + l16;
#pragma unroll
      for (int d = 0; d < NDT; ++d) {
        f32x4 v = o[q][d] * inv[q];
        u32x2 ov;
        ov.x = pack2(v.x, v.y);
        ov.y = pack2(v.z, v.w);
        *(u32x2*)(mixed + (size_t)row * 1024 + mixcol + var * 64 + d * 16 + q4 * 4) = ov;
      }
    }
  }
}

DI void attnA_item(const P& p, int li, int it, char* smem) {
  const int lane = ltid() & 63;
  float d1 = p.in[14][li * 64 + lane] * p.in[15][li * 64 + lane];
  float d2 = p.in[16][li * 64 + lane] * p.in[17][li * 64 + lane];
#pragma unroll
  for (int s = 1; s < 64; s <<= 1) { d1 += shx(d1, s); d2 += shx(d2, s); }
  const float lam_init = 0.8f - 0.6f * expf(-0.3f * (float)li);
  const float lam = expf(d1) - expf(d2) + lam_init;
  const u16* QA = (const u16*)(p.ws + O_QA);
  u16* mixed = (u16*)(p.ws + O_MIXED);
  const float* subg = p.in[18] + li * 128;
  int qrow0, L;
  const u16 *Kb, *VT;
  int h;
  if (it < 128) {
    int b = it >> 6, qb = it & 15;
    h = (it >> 4) & 3;
    Kb = (const u16*)(p.ws + O_KALAT) + (size_t)(li * 2 + b) * 1536 * 512 + h * 128;
    VT = (const u16*)(p.ws + O_VTALAT) + (size_t)((li * 2 + b) * 4 + h) * 128 * 1536;
    qrow0 = NCTX + b * 1024 + qb * 64;
    L = 1536;
  } else {
    it -= 128;
    int b = it >> 4, qb = it & 3;
    h = (it >> 2) & 3;
    Kb = (const u16*)(p.ws + O_KACTX) + (size_t)b * 256 * 512 + h * 128;
    VT = (const u16*)(p.ws + O_VTACTX) + (size_t)(b * 4 + h) * 128 * 256;
    qrow0 = b * 256 + qb * 64;
    L = 256;
  }
  attn_item<128, 128, true>(QA, 512, h * 128, qrow0, Kb, 512, VT, L, L, mixed, h * 128, lam, 1.f - lam_init, subg, smem);
}
DI void attnC_item(const P& p, int li, int it, char* smem) {
  const u16* QC = (const u16*)(p.ws + O_QC);
  u16* mixed = (u16*)(p.ws + O_MIXED);
  int qrow0, L, n;
  const u16 *Kb, *VT;
  if (it < 64) {
    int b = it >> 5, qb = it & 15;
    n = (it >> 4) & 1;
    Kb = (const u16*)(p.ws + O_KCLAT) + (size_t)(li * 2 + b) * 1536 * 128 + n * 64;
    VT = (const u16*)(p.ws + O_VTCLAT) + (size_t)((li * 2 + b) * 2 + n) * 64 * 1536;
    qrow0 = NCTX + b * 1024 + qb * 64;
    L = 1536;
  } else {
    it -= 64;
    int b = it >> 3, qb = it & 3;
    n = (it >> 2) & 1;
    Kb = (const u16*)(p.ws + O_KCCTX) + (size_t)b * 256 * 128 + n * 64;
    VT = (const u16*)(p.ws + O_VTCCTX) + (size_t)(b * 2 + n) * 64 * 256;
    qrow0 = b * 256 + qb * 64;
    L = 256;
  }
  attn_item<64, 64, false>(QC, 256, n * 128, qrow0, Kb, 128, VT, L, L, mixed, 768 + n * 128, 0.f, 1.f, nullptr, smem);
}

DI void h1_item(const P& p, int item, char* smem) {
  const int tid = ltid(), lane = tid & 63, w = tid >> 6, l16 = lane & 15, q4 = lane >> 4;
  const int dir = item & 1, h = (item >> 1) & 3, tc = item >> 3;
  const int row0 = tc * 64;
  float* sQ = (float*)smem;
  float* sB = sQ + 64 * 68;
  float* sK = sB + 64 * 68;
  u16* sVT = (u16*)(sK + 64 * 68);
  float* sTot = (float*)(sVT + 64 * 72);
  const float* HQ = (const float*)(p.ws + O_HQ);
  const float* HG = (const float*)(p.ws + (dir ? O_HGB : O_HGF));
  const float* HI = (const float*)(p.ws + O_HI);
  float* OI = (float*)(p.ws + O_OI) + (size_t)dir * NTOK * 256;
  u16* QE = (u16*)(p.ws + O_QE) + (size_t)dir * NTOK * 256;
  float* KV = (float*)(p.ws + O_KV) + (size_t)item * 4096;
  float* DEC = (float*)(p.ws + O_DEC) + (size_t)item * 64;

  __syncthreads();
#pragma unroll
  for (int i = 0; i < 4; ++i) {
    int idx = tid + 256 * i;
    int lo = idx >> 4, c4 = idx & 15;
    int row = dir ? row0 + 63 - lo : row0 + lo;
    size_t off = (size_t)row * 256 + h * 64 + c4 * 4;
    *(float4*)(sQ + lo * 68 + c4 * 4) = *(const float4*)(HQ + off);
    *(float4*)(sB + lo * 68 + c4 * 4) = *(const float4*)(HG + off);
    float4 v = *(const float4*)(HI + off);
    sVT[(c4 * 4 + 0) * 72 + lo] = f2bf(v.x);
    sVT[(c4 * 4 + 1) * 72 + lo] = f2bf(v.y);
    sVT[(c4 * 4 + 2) * 72 + lo] = f2bf(v.z);
    sVT[(c4 * 4 + 3) * 72 + lo] = f2bf(v.w);
  }
  __syncthreads();
  {
    const int k = tid & 63, part = tid >> 6;
    float run = 0.f;
#pragma unroll 4
    for (int e = 0; e < 16; ++e) {
      int i = part * 16 + e;
      float g = sB[i * 68 + k];
      sK[i * 68 + k] = 1.f - ex2(g * LOG2E);
      run += g * LOG2E;
      sB[i * 68 + k] = run;
    }
    sTot[part * 64 + k] = run;
    __syncthreads();
    float add = 0.f;
    for (int pp = 0; pp < part; ++pp) add += sTot[pp * 64 + k];
    if (part > 0)
      for (int e = 0; e < 16; ++e) sB[(part * 16 + e) * 68 + k] += add;
  }
  __syncthreads();
#pragma unroll
  for (int i = 0; i < 4; ++i) {
    int idx = tid + 256 * i;
    int lo = idx >> 4, c4 = idx & 15;
    int row = dir ? row0 + 63 - lo : row0 + lo;
    f32x4 q = *(const f32x4*)(sQ + lo * 68 + c4 * 4);
    f32x4 bb = *(const f32x4*)(sB + lo * 68 + c4 * 4);
    u32x2 o;
    o.x = pack2(q.x * ex2(bb.x), q.y * ex2(bb.y));
    o.y = pack2(q.z * ex2(bb.z), q.w * ex2(bb.w));
    *(u32x2*)(QE + (size_t)row * 256 + h * 64 + c4 * 4) = o;
  }
  {
    const int I = w;
    bf16x8 qs[2];
    f32x4 rr[2][2];
#pragma unroll
    for (int s = 0; s < 2; ++s) {
      const int kk0 = s * 32 + q4 * 8;
      if (I > 0) {
        rr[s][0] = *(const f32x4*)(sB + (16 * I - 1) * 68 + kk0);
        rr[s][1] = *(const f32x4*)(sB + (16 * I - 1) * 68 + kk0 + 4);
      } else {
        rr[s][0] = f32x4{0.f, 0.f, 0.f, 0.f};
        rr[s][1] = rr[s][0];
      }
      const float* qr = sQ + (16 * I + l16) * 68 + kk0;
      const float* br = sB + (16 * I + l16) * 68 + kk0;
      f32x4 q0 = *(const f32x4*)qr, q1 = *(const f32x4*)(qr + 4);
      f32x4 b0 = *(const f32x4*)br, b1 = *(const f32x4*)(br + 4);
      u32x4 pu;
      pu.x = pack2(q0.x * ex2(b0.x - rr[s][0].x), q0.y * ex2(b0.y - rr[s][0].y));
      pu.y = pack2(q0.z * ex2(b0.z - rr[s][0].z), q0.w * ex2(b0.w - rr[s][0].w));
      pu.z = pack2(q1.x * ex2(b1.x - rr[s][1].x), q1.y * ex2(b1.y - rr[s][1].y));
      pu.w = pack2(q1.z * ex2(b1.z - rr[s][1].z), q1.w * ex2(b1.w - rr[s][1].w));
      qs[s] = __builtin_bit_cast(bf16x8, pu);
    }
    f32x4 at[4];
#pragma unroll
    for (int J = 0; J < 4; ++J) {
      at[J] = f32x4{0.f, 0.f, 0.f, 0.f};
      if (J <= I) {
#pragma unroll
        for (int s = 0; s < 2; ++s) {
          const int kk0 = s * 32 + q4 * 8;
          const float* kr = sK + (16 * J + l16) * 68 + kk0;
          const float* br = sB + (16 * J + l16) * 68 + kk0;
          f32x4 k0 = *(const f32x4*)kr, k1 = *(const f32x4*)(kr + 4);
          f32x4 b0 = *(const f32x4*)br, b1 = *(const f32x4*)(br + 4);
          u32x4 pu;
          pu.x = pack2(k0.x * ex2(fminf(rr[s][0].x - b0.x, 100.f)), k0.y * ex2(fminf(rr[s][0].y - b0.y, 100.f)));
          pu.y = pack2(k0.z * ex2(fminf(rr[s][0].z - b0.z, 100.f)), k0.w * ex2(fminf(rr[s][0].w - b0.w, 100.f)));
          pu.z = pack2(k1.x * ex2(fminf(rr[s][1].x - b1.x, 100.f)), k1.y * ex2(fminf(rr[s][1].y - b1.y, 100.f)));
          pu.w = pack2(k1.z * ex2(fminf(rr[s][1].z - b1.z, 100.f)), k1.w * ex2(fminf(rr[s][1].w - b1.w, 100.f)));
          bf16x8 kf = __builtin_bit_cast(bf16x8, pu);
          at[J] = MFMA16(kf, qs[s], at[J]);
        }
        if (J == I) {
#pragma unroll
          for (int r = 0; r < 4; ++r)
            if (q4 * 4 + r > l16) at[J][r] = 0.f;
        }
      }
    }
    f32x4 oc[4];
#pragma unroll
    for (int vt = 0; vt < 4; ++vt) oc[vt] = f32x4{0.f, 0.f, 0.f, 0.f};
#pragma unroll
    for (int ks = 0; ks < 2; ++ks) {
      if (2 * ks <= I) {
        u32x4 pu;
        pu.x = pack2(at[2 * ks][0], at[2 * ks][1]);
        pu.y = pack2(at[2 * ks][2], at[2 * ks][3]);
        pu.z = pack2(at[2 * ks + 1][0], at[2 * ks + 1][1]);
        pu.w = pack2(at[2 * ks + 1][2], at[2 * ks + 1][3]);
        bf16x8 pf = __builtin_bit_cast(bf16x8, pu);
#pragma unroll
        for (int vt = 0; vt < 4; ++vt) {
          const u16* vp = sVT + (vt * 16 + l16) * 72 + ks * 32 + q4 * 4;
          u32x2 v0 = *(const u32x2*)vp;
          u32x2 v1 = *(const u32x2*)(vp + 16);
          u32x4 vu = {v0.x, v0.y, v1.x, v1.y};
          oc[vt] = MFMA16(__builtin_bit_cast(bf16x8, vu), pf, oc[vt]);
        }
      }
    }
    {
      const int t = 16 * I + l16;
      const int row = dir ? row0 + 63 - t : row0 + t;
#pragma unroll
      for (int vt = 0; vt < 4; ++vt) *(f32x4*)(OI + (size_t)row * 256 + h * 64 + vt * 16 + q4 * 4) = oc[vt];
    }
  }
  {
    const int k = 16 * w + l16;
    const float bend = sB[63 * 68 + k];
    f32x4 kc[4];
#pragma unroll
    for (int vt = 0; vt < 4; ++vt) kc[vt] = f32x4{0.f, 0.f, 0.f, 0.f};
#pragma unroll
    for (int ks = 0; ks < 2; ++ks) {
      float kd[8];
#pragma unroll
      for (int j = 0; j < 8; ++j) {
        const int s = ks * 32 + q4 * 8 + j;
        kd[j] = sK[s * 68 + k] * ex2(bend - sB[s * 68 + k]);
      }
      u32x4 pu;
      pu.x = pack2(kd[0], kd[1]);
      pu.y = pack2(kd[2], kd[3]);
      pu.z = pack2(kd[4], kd[5]);
      pu.w = pack2(kd[6], kd[7]);
      bf16x8 af = __builtin_bit_cast(bf16x8, pu);
#pragma unroll
      for (int vt = 0; vt < 4; ++vt) {
        bf16x8 vf = *(const bf16x8*)(sVT + (vt * 16 + l16) * 72 + ks * 32 + q4 * 8);
        kc[vt] = MFMA16(af, vf, kc[vt]);
      }
    }
#pragma unroll
    for (int vt = 0; vt < 4; ++vt)
#pragma unroll
      for (int r = 0; r < 4; ++r) KV[(16 * w + q4 * 4 + r) * 64 + vt * 16 + l16] = kc[vt][r];
    if (q4 == 0) DEC[k] = ex2(bend);
  }
}

DI void h2_item(const P& p, int li, int item, char* smem) {
  const int tid = ltid(), ty = tid >> 4, tx = tid & 15;
  const int lane = tid & 63, w = tid >> 6, l16 = lane & 15, q4 = lane >> 4;
  const int h = item & 3, tc = item >> 2, row0 = tc * 64;
  const bool lat = tc >= 64;
  int seq, cl, nc;
  if (!lat) { seq = tc >> 2; cl = tc & 3; nc = 4; } else { seq = (tc - 64) >> 4; cl = (tc - 64) & 15; nc = 16; }
  const int tcbase = tc - cl;
  u16* sST = (u16*)smem;
  const float* KVb = (const float*)(p.ws + O_KV);
  const float* DECb = (const float*)(p.ws + O_DEC);
  __syncthreads();
#pragma unroll 1
  for (int dir = 0; dir < 2; ++dir) {
    float4 S[4];
#pragma unroll
    for (int a = 0; a < 4; ++a) {
      if (lat) S[a] = *(const float4*)(p.in[6 + dir] + ((size_t)((seq * 2 + li) * 4 + h) * 64 + ty + 16 * a) * 64 + tx * 4);
      else S[a] = make_float4(0.f, 0.f, 0.f, 0.f);
    }
    const int nprev = dir == 0 ? cl : nc - 1 - cl;
#pragma unroll 4
    for (int j = 0; j < nprev; ++j) {
      int tcj = tcbase + (dir == 0 ? j : nc - 1 - j);
      size_t itj = (size_t)((tcj * 4 + h) * 2 + dir);
#pragma unroll
      for (int a = 0; a < 4; ++a) {
        int k = ty + 16 * a;
        float dcy = DECb[itj * 64 + k];
        float4 kv = *(const float4*)(KVb + itj * 4096 + k * 64 + tx * 4);
        S[a].x = dcy * S[a].x + kv.x; S[a].y = dcy * S[a].y + kv.y; S[a].z = dcy * S[a].z + kv.z; S[a].w = dcy * S[a].w + kv.w;
      }
    }
    if (!lat && nprev == nc - 1) {
      size_t itj = (size_t)((tc * 4 + h) * 2 + dir);
      float* so = p.out + (dir == 0 ? OUT_SF : OUT_SB) + (size_t)((seq * 2 + li) * 4 + h) * 4096;
#pragma unroll
      for (int a = 0; a < 4; ++a) {
        int k = ty + 16 * a;
        float dcy = DECb[itj * 64 + k];
        float4 kv = *(const float4*)(KVb + itj * 4096 + k * 64 + tx * 4);
        *(float4*)(so + k * 64 + tx * 4) = make_float4(dcy * S[a].x + kv.x, dcy * S[a].y + kv.y, dcy * S[a].z + kv.z, dcy * S[a].w + kv.w);
      }
    }
    u16* st = sST + dir * 64 * 72;
#pragma unroll
    for (int a = 0; a < 4; ++a) {
      int k = ty + 16 * a;
      st[(tx * 4 + 0) * 72 + k] = f2bf(S[a].x);
      st[(tx * 4 + 1) * 72 + k] = f2bf(S[a].y);
      st[(tx * 4 + 2) * 72 + k] = f2bf(S[a].z);
      st[(tx * 4 + 3) * 72 + k] = f2bf(S[a].w);
    }
  }
  __syncthreads();
  f32x4 oc[4];
#pragma unroll
  for (int vt = 0; vt < 4; ++vt) oc[vt] = f32x4{0.f, 0.f, 0.f, 0.f};
#pragma unroll
  for (int dir = 0; dir < 2; ++dir) {
    const u16* QE = (const u16*)(p.ws + O_QE) + (size_t)dir * NTOK * 256 + (size_t)(row0 + 16 * w + l16) * 256 + h * 64 + q4 * 8;
    const u16* st = sST + dir * 64 * 72;
#pragma unroll
    for (int ks = 0; ks < 2; ++ks) {
      bf16x8 af = *(const bf16x8*)(QE + ks * 32);
#pragma unroll
      for (int vt = 0; vt < 4; ++vt) {
        bf16x8 bf = *(const bf16x8*)(st + (vt * 16 + l16) * 72 + ks * 32 + q4 * 8);
        oc[vt] = MFMA16(af, bf, oc[vt]);
      }
    }
  }
  const float* OI0 = (const float*)(p.ws + O_OI);
  const float* OI1 = OI0 + (size_t)NTOK * 256;
  const float* HSG = (const float*)(p.ws + O_HSG);
  u16* mixed = (u16*)(p.ws + O_MIXED);
  float gn[4];
#pragma unroll
  for (int vt = 0; vt < 4; ++vt) gn[vt] = p.in[21][li * 64 + vt * 16 + l16];
  float oi[4][4], sgv[4][4];
#pragma unroll
  for (int r = 0; r < 4; ++r) {
    const size_t off = (size_t)(row0 + 16 * w + q4 * 4 + r) * 256 + h * 64 + l16;
#pragma unroll
    for (int vt = 0; vt < 4; ++vt) {
      oi[r][vt] = OI0[off + vt * 16] + OI1[off + vt * 16];
      sgv[r][vt] = HSG[off + vt * 16];
    }
  }
#pragma unroll
  for (int r = 0; r < 4; ++r) {
    const int row = row0 + 16 * w + q4 * 4 + r;
    float val[4];
    float ss = 0.f;
#pragma unroll
    for (int vt = 0; vt < 4; ++vt) {
      val[vt] = oc[vt][r] + oi[r][vt];
      ss += val[vt] * val[vt];
    }
    ss = red16(ss);
    const float rs = rsqrtf(ss * (1.f / 64.f) + 1e-6f);
#pragma unroll
    for (int vt = 0; vt < 4; ++vt)
      mixed[(size_t)row * 1024 + 512 + h * 64 + vt * 16 + l16] = f2bf(val[vt] * rs * gn[vt] * sgv[r][vt]);
  }
}

DI void row_stats(float2 slot, float& mu, float& rs) {
  float s1 = red16(slot.x), s2 = red16(slot.y);
  s1 = __builtin_bit_cast(float, __builtin_amdgcn_readfirstlane(__builtin_bit_cast(int, s1)));
  s2 = __builtin_bit_cast(float, __builtin_amdgcn_readfirstlane(__builtin_bit_cast(int, s2)));
  mu = s1 * (1.f / 1024.f);
  rs = rsqrtf(fmaxf(s2 * (1.f / 1024.f) - mu * mu, 0.f) + 1e-6f);
}

DI void ln_apply(const P& p, const float* lo, const float* hi, const float* stats, const float* lng, const float* lnb,
                 const float* mods, int sc_off, int sh_off) {
  const int lane = ltid() & 63, wid = ltid() >> 6;
  u16* dst = (u16*)(p.ws + O_ABF);
  f32x4 ggv[4], bbv[4];
#pragma unroll
  for (int i = 0; i < 4; ++i) {
    ggv[i] = f32x4{1.f, 1.f, 1.f, 1.f};
    bbv[i] = f32x4{0.f, 0.f, 0.f, 0.f};
    if (stats != nullptr) {
      ggv[i] = *(const f32x4*)(lng + (lane + 64 * i) * 4);
      bbv[i] = *(const f32x4*)(lnb + (lane + 64 * i) * 4);
    }
  }
  int it = blockIdx.x;
  f32x4 xn[4];
  float2 stn = make_float2(0.f, 0.f);
  if (it < NTOK / 4) {
    const int row = it * 4 + wid;
    const float* x = row < NCTX ? lo + (size_t)row * 1024 : hi + (size_t)(row - NCTX) * 1024;
#pragma unroll
    for (int i = 0; i < 4; ++i) xn[i] = *(const f32x4*)(x + (lane + 64 * i) * 4);
    if (stats != nullptr && lane < 16) stn = *(const float2*)(stats + (size_t)row * 32 + lane * 2);
  }
  while (it < NTOK / 4) {
    const int row = it * 4 + wid;
    f32x4 xv[4];
#pragma unroll
    for (int i = 0; i < 4; ++i) xv[i] = xn[i];
    const float2 stc = stn;
    const int itn = it + gridDim.x;
    if (itn < NTOK / 4) {
      const int rown = itn * 4 + wid;
      const float* x = rown < NCTX ? lo + (size_t)rown * 1024 : hi + (size_t)(rown - NCTX) * 1024;
#pragma unroll
      for (int i = 0; i < 4; ++i) xn[i] = *(const f32x4*)(x + (lane + 64 * i) * 4);
      stn = make_float2(0.f, 0.f);
      if (stats != nullptr && lane < 16) stn = *(const float2*)(stats + (size_t)rown * 32 + lane * 2);
    }
    float mu = 0.f, rs = 1.f;
    if (stats != nullptr) row_stats(stc, mu, rs);
    const int rtype = row < NCTX ? 0 : 1 + ((row - NCTX) >> 10);
    const float* mv = mods + rtype * 6144;
    f32x4 scv[4], shv[4];
#pragma unroll
    for (int i = 0; i < 4; ++i) {
      scv[i] = *(const f32x4*)(mv + sc_off + (lane + 64 * i) * 4);
      shv[i] = *(const f32x4*)(mv + sh_off + (lane + 64 * i) * 4);
    }
#pragma unroll
    for (int i = 0; i < 4; ++i) {
      const int c = (lane + 64 * i) * 4;
      f32x4 v = (xv[i] - mu) * rs * ggv[i] + bbv[i];
      v = v * (scv[i] + 1.f) + shv[i];
      u32x2 o;
      o.x = pack2(v.x, v.y);
      o.y = pack2(v.z, v.w);
      *(u32x2*)(dst + (size_t)row * 1024 + c) = o;
    }
    it = itn;
  }
}

DI void final_ln(const P& p) {
  const int lane = ltid() & 63, wid = ltid() >> 6;
  const float* X = (const float*)(p.ws + O_XPRE2);
  const float* ST = (const float*)(p.ws + O_ST2);
  f32x4 gv[4], bv[4];
#pragma unroll
  for (int i = 0; i < 4; ++i) {
    gv[i] = *(const f32x4*)(p.in[26] + 1024 + (lane + 64 * i) * 4);
    bv[i] = *(const f32x4*)(p.in[27] + 1024 + (lane + 64 * i) * 4);
  }
  int it = blockIdx.x;
  f32x4 xn[4];
  float2 stn = make_float2(0.f, 0.f);
  if (it < NTOK / 4) {
    const int row = it * 4 + wid;
#pragma unroll
    for (int i = 0; i < 4; ++i) xn[i] = *(const f32x4*)(X + (size_t)row * 1024 + (lane + 64 * i) * 4);
    if (lane < 16) stn = *(const float2*)(ST + (size_t)row * 32 + lane * 2);
  }
  while (it < NTOK / 4) {
    const int row = it * 4 + wid;
    f32x4 xv[4];
#pragma unroll
    for (int i = 0; i < 4; ++i) xv[i] = xn[i];
    const float2 stc = stn;
    const int itn = it + gridDim.x;
    if (itn < NTOK / 4) {
      const int rown = itn * 4 + wid;
#pragma unroll
      for (int i = 0; i < 4; ++i) xn[i] = *(const f32x4*)(X + (size_t)rown * 1024 + (lane + 64 * i) * 4);
      stn = make_float2(0.f, 0.f);
      if (lane < 16) stn = *(const float2*)(ST + (size_t)rown * 32 + lane * 2);
    }
    float mu, rs;
    row_stats(stc, mu, rs);
    float* out = p.out + (row < NCTX ? OUT_YP + (size_t)row * 1024 : OUT_YS + (size_t)(row - NCTX) * 1024);
#pragma unroll
    for (int i = 0; i < 4; ++i) *(f32x4*)(out + (lane + 64 * i) * 4) = (xv[i] - mu) * rs * gv[i] + bv[i];
    it = itn;
  }
}

DI void run_phase(const P& p, int ph, char* smem, int sub = 0) {
  if (ph == 0) { phase0(p, smem); return; }
  if (ph == NPHASE - 1) { final_ln(p); return; }
  const int li = (ph - 1) >> 3, s = (ph - 1) & 7;
  float* XPRE1 = (float*)(p.ws + O_XPRE1);
  float* XPRE2 = (float*)(p.ws + O_XPRE2);
  float* ST1 = (float*)(p.ws + O_ST1);
  float* ST2 = (float*)(p.ws + O_ST2);
  GA g;
  g.mods = (const float*)(p.ws + O_MODS) + li * 3 * 6144;
  g.a16 = (const u16*)(p.ws + O_ABF); g.xout = nullptr; g.sout = nullptr; g.hid = nullptr;
  g.alo = nullptr; g.ahi = nullptr; g.stats = nullptr; g.lng = nullptr; g.lnb = nullptr; g.sc_off = 0; g.sh_off = 0;
  const float* xin_lo = li == 0 ? p.in[0] : XPRE2;
  const float* xin_hi = li == 0 ? p.in[1] : XPRE2 + (size_t)NCTX * 1024;
  const float* xin_st = li == 0 ? nullptr : ST2;
  const float* xin_g = p.in[26] + (li == 0 ? 0 : (li - 1) * 1024);
  const float* xin_b = p.in[27] + (li == 0 ? 0 : (li - 1) * 1024);
  if (s == 0) {
    ln_apply(p, xin_lo, xin_hi, xin_st, xin_g, xin_b, g.mods, 1024, 0);
  } else if (s == 1) {
    g.bt = (const u16*)(p.ws + O_WTIN) + (size_t)li * NIN * D; g.K = D; g.N = NIN;
    gemm_phase<0>(p, g, li, smem);
    if (li == 0) {
      const int xcd = blockIdx.x & 7, lb = blockIdx.x >> 3, nlb = gridDim.x >> 3;
      const int busy = 6 * (NIN >> 7) - 2 * nlb;
      if (nlb == 64 && lb >= busy) run_transposes(p, smem, (lb - busy) * 8 + xcd, (nlb - busy) * 8, 1);
      else if (nlb != 64) run_transposes(p, smem, blockIdx.x, gridDim.x, 1);
    }
  } else if (s == 2) {
    if (gridDim.x == 512 && sub == 0) {
      const int b = blockIdx.x;
      if (b < 128) {
        attnA_item(p, li, b, smem);
      } else if (b < 192) {
        attnC_item(p, li, b - 128, smem);
        h1_item(p, b - 128, smem);
      } else {
        const int j = b - 192;
        h1_item(p, 64 + j, smem);
        h1_item(p, 64 + 320 + j, smem);
        if (j < 64) h1_item(p, 64 + 640 + j, smem);
        else attnA_item(p, li, 128 + (j - 64), smem);
        run_transposes(p, smem, j, 320, 2 + li);
      }
    } else {
      if (sub == 0) run_transposes(p, smem, blockIdx.x, gridDim.x, 2 + li);
      const int it_lo = sub == 2 ? 128 : (sub == 3 ? 192 : (sub == 4 ? 960 : 0)), it_hi = sub == 1 ? 128 : (sub == 2 ? 192 : (sub == 3 ? 960 : 1216));
      for (int it = it_lo + blockIdx.x; it < it_hi; it += gridDim.x) {
        if (it >= 192 && it < 960) h1_item(p, it - 192, smem);
        else if (it >= 128 && it < 192) attnC_item(p, li, it - 128, smem);
        else attnA_item(p, li, it < 128 ? it : it - 832, smem);
      }
    }
  } else if (s == 3) {
    for (int it = blockIdx.x; it < 512; it += gridDim.x) {
      if (it < 384) h2_item(p, li, it, smem);
      else attnC_item(p, li, it - 384 + 64, smem);
    }
  } else if (s == 4) {
    g.alo = xin_lo; g.ahi = xin_hi; g.stats = xin_st; g.lng = xin_g; g.lnb = xin_b;
    g.sc_off = 2048;
    g.a16 = (const u16*)(p.ws + O_MIXED);
    g.bt = (const u16*)(p.ws + O_WTOUT) + (size_t)li * D * D; g.K = D; g.N = D;
    g.xout = XPRE1; g.sout = ST1;
    gemm_phase<1, 3>(p, g, li, smem);
  } else if (s == 5) {
    ln_apply(p, XPRE1, XPRE1 + (size_t)NCTX * 1024, ST1, p.in[24] + li * 1024, p.in[25] + li * 1024, g.mods, 4096, 3072);
  } else if (s == 6) {
    g.bt = (const u16*)(p.ws + O_WTFF1) + (size_t)li * DFF * D; g.K = D; g.N = DFF;
    g.hid = (u16*)(p.ws + O_HID);
    gemm_phase<2>(p, g, li, smem);
  } else {
    g.alo = XPRE1; g.ahi = XPRE1 + (size_t)NCTX * 1024; g.stats = ST1; g.lng = p.in[24] + li * 1024; g.lnb = p.in[25] + li * 1024;
    g.sc_off = 5120;
    g.a16 = (const u16*)(p.ws + O_HID);
    g.bt = (const u16*)(p.ws + O_WTFF2) + (size_t)li * D * DFF; g.K = DFF; g.N = D;
    g.xout = XPRE2; g.sout = ST2;
    gemm_phase<1, 3>(p, g, li, smem);
  }
}

#define XB_TMO      128
#define XB_XCNT(j)  (256  + 64 * (j))
#define XB_XSUB(j)  (1280 + 64 * (j))
#define XB_XGEN(j)  (2304 + 64 * (j))
#define XB_TOP      3328
#define XB_TOPGEN   3392
#define XCD_BAR_WORDS 3456
#define XB_SPIN_CAP (1u << 20)
#define LAS __attribute__((address_space(3)))
DI unsigned xb_ld(unsigned* p) { return __hip_atomic_load(p, __ATOMIC_RELAXED, __HIP_MEMORY_SCOPE_AGENT); }
DI unsigned xb_add(unsigned* p, unsigned v) { return __hip_atomic_fetch_add(p, v, __ATOMIC_RELAXED, __HIP_MEMORY_SCOPE_AGENT); }
DI unsigned xb_xcc_id() { return (unsigned)__builtin_amdgcn_s_getreg((3 << 11) | 20) & 0xFu; }
#define XB_SPIN(cond, bar) do { unsigned _sp = 0; while (cond) { __builtin_amdgcn_s_sleep(1); \
    if ((++_sp & 255u) == 0u) { if (xb_ld(&(bar)[XB_TMO])) break; if (_sp > XB_SPIN_CAP) { atomicAdd(&(bar)[XB_TMO], 1u); break; } } } } while (0)
struct XcdBarrier { unsigned* bar; unsigned x; volatile LAS unsigned* st; };
DI XcdBarrier xcd_barrier_post(unsigned* bar, volatile LAS unsigned* st) {
  XcdBarrier b; b.bar = bar; b.x = xb_xcc_id(); b.st = st;
  if (threadIdx.x == 0) (void)xb_add(&bar[XB_XCNT(b.x)], 1u);
  return b;
}
DI void xcd_barrier_complete(unsigned* bar, unsigned x, unsigned& nloc, unsigned& nx) {
  const unsigned G = gridDim.x * gridDim.y * gridDim.z;
  unsigned sum, cnt, mine, sp = 0u;
  for (;;) {
    sum = 0u; cnt = 0u; mine = 0u;
#pragma unroll
    for (unsigned j = 0; j < 16; ++j) { const unsigned c = xb_ld(&bar[XB_XCNT(j)]); sum += c; cnt += (c > 0u) ? 1u : 0u; mine = (j == x) ? c : mine; }
    if (sum == G) break;
    __builtin_amdgcn_s_sleep(1);
    if ((++sp & 255u) == 0u) { if (xb_ld(&bar[XB_TMO])) break; if (sp > XB_SPIN_CAP) { atomicAdd(&bar[XB_TMO], 1u); break; } }
  }
  nloc = mine > 0u ? mine : 1u; nx = cnt > 0u ? cnt : 1u;
}
DI void xcd_barrier(const XcdBarrier& b) {
  asm volatile("s_waitcnt vmcnt(0)" ::: "memory");
  __syncthreads();
  if (threadIdx.x == 0) {
    unsigned* bar = b.bar;
    __builtin_amdgcn_s_waitcnt(0);
    unsigned nloc = b.st[0], nx = b.st[1];
    if (nloc == 0u) { xcd_barrier_complete(bar, b.x, nloc, nx); b.st[0] = nloc; b.st[1] = nx; }
    const unsigned old = xb_add(&bar[XB_XSUB(b.x)], 1u);
    const unsigned gen = old / nloc;
    if (old + 1u == (gen + 1u) * nloc) {
      __builtin_amdgcn_fence(__ATOMIC_RELEASE, "agent");
      asm volatile("s_waitcnt vmcnt(0)" ::: "memory");
      const unsigned og = xb_add(&bar[XB_TOP], 1u);
      const unsigned tg = og / nx;
      if (og + 1u == (tg + 1u) * nx) xb_add(&bar[XB_TOPGEN], 1u);
      else XB_SPIN(xb_ld(&bar[XB_TOPGEN]) == tg, bar);
      __builtin_amdgcn_fence(__ATOMIC_ACQUIRE, "agent");
      xb_add(&bar[XB_XGEN(b.x)], 1u);
      asm volatile("s_waitcnt vmcnt(0)" ::: "memory");
    } else {
      XB_SPIN(xb_ld(&bar[XB_XGEN(b.x)]) == gen, bar);
      __builtin_amdgcn_fence(__ATOMIC_ACQUIRE, "agent");
      asm volatile("s_waitcnt vmcnt(0)" ::: "memory");
    }
  }
  __syncthreads();
}
constexpr size_t O_BAR = O_END1;
static_assert(O_BAR + XCD_BAR_WORDS * 4 <= (size_t)256 * 1024 * 1024, "barrier words must fit");

#if !MULTI_LAUNCH
__global__ void __launch_bounds__(256, 2) mega_kernel(P p) {
  extern __shared__ __attribute__((aligned(16))) char smem[];
  cg::grid_group grid = cg::this_grid();
  if (p.ws == nullptr) grid.sync();
  if (threadIdx.x == 0) *(uint4*)(smem + LDS_BYTES - 16) = make_uint4(0u, 0u, 0u, 0u);
  __syncthreads();
  XcdBarrier xb = xcd_barrier_post((unsigned*)(p.ws + O_BAR), (volatile LAS unsigned*)(smem + LDS_BYTES - 16));
  run_phase(p, 0, smem); xcd_barrier(xb);
  run_phase(p, 1, smem); xcd_barrier(xb);
  run_phase(p, 2, smem); xcd_barrier(xb);
  run_phase(p, 3, smem); xcd_barrier(xb);
  run_phase(p, 4, smem); xcd_barrier(xb);
  run_phase(p, 5, smem); xcd_barrier(xb);
  run_phase(p, 6, smem); xcd_barrier(xb);
  run_phase(p, 7, smem); xcd_barrier(xb);
  run_phase(p, 8, smem); xcd_barrier(xb);
  run_phase(p, 9, smem); xcd_barrier(xb);
  run_phase(p, 10, smem); xcd_barrier(xb);
  run_phase(p, 11, smem); xcd_barrier(xb);
  run_phase(p, 12, smem); xcd_barrier(xb);
  run_phase(p, 13, smem); xcd_barrier(xb);
  run_phase(p, 14, smem); xcd_barrier(xb);
  run_phase(p, 15, smem); xcd_barrier(xb);
  run_phase(p, 16, smem); xcd_barrier(xb);
  run_phase(p, 17, smem);
}
#define MAIN_KERNEL mega_kernel
#else
template <int PH>
__global__ void __launch_bounds__(256, 2) phase_kernel(P p, int sub) {
  extern __shared__ __attribute__((aligned(16))) char smem[];
  run_phase(p, PH, smem, sub);
}
typedef void (*phase_fn)(P, int);
static phase_fn phase_table[NPHASE] = {phase_kernel<0>, phase_kernel<1>, phase_kernel<2>, phase_kernel<3>, phase_kernel<4>, phase_kernel<5>,
                                       phase_kernel<6>, phase_kernel<7>, phase_kernel<8>, phase_kernel<9>, phase_kernel<10>, phase_kernel<11>,
                                       phase_kernel<12>, phase_kernel<13>, phase_kernel<14>, phase_kernel<15>, phase_kernel<16>, phase_kernel<17>};
#define MAIN_KERNEL phase_kernel<2>
#endif

extern "C" void kernel_launch(void* const* d_in, const int* in_sizes, int n_in, void* d_out, int out_size, void* d_ws,
                              size_t ws_size, hipStream_t stream) {
  static int grid_blocks = 0;
  if (!grid_blocks) {
    int dev = 0, cus = 0, per_cu = 0;
    (void)hipGetDevice(&dev);
    (void)hipDeviceGetAttribute(&cus, hipDeviceAttributeMultiprocessorCount, dev);
    (void)hipFuncSetAttribute((const void*)MAIN_KERNEL, hipFuncAttributeMaxDynamicSharedMemorySize, LDS_BYTES);
    (void)hipOccupancyMaxActiveBlocksPerMultiprocessor(&per_cu, MAIN_KERNEL, 256, LDS_BYTES);
    if (per_cu > 2) per_cu = 2;
    if (per_cu < 1) per_cu = 1;
    grid_blocks = cus * per_cu;
  }
  P p{};
  for (int i = 0; i < 30; ++i) p.in[i] = (const float*)d_in[i];
  p.out = (float*)d_out;
  p.ws = (char*)d_ws;
#if MULTI_LAUNCH
  for (int ph = 0; ph < NPHASE; ++ph) {
    (void)hipFuncSetAttribute((const void*)phase_table[ph], hipFuncAttributeMaxDynamicSharedMemorySize, LDS_BYTES);
    phase_table[ph]<<<dim3(grid_blocks), dim3(256), LDS_BYTES, stream>>>(p, 0);
#ifdef DUP_MASK
    int bit = (ph == 0) ? 8 : (ph == NPHASE - 1 ? 9 : (ph - 1) & 7);
    if ((DUP_MASK >> bit) & 1) phase_table[ph]<<<dim3(grid_blocks), dim3(256), LDS_BYTES, stream>>>(p, DUP_SUB);
#endif
  }
#else
  (void)hipMemsetAsync((char*)d_ws + O_BAR, 0, XCD_BAR_WORDS * 4, stream);
  void* args[] = {&p};
  hipError_t e = hipLaunchCooperativeKernel((void*)mega_kernel, dim3(grid_blocks), dim3(256), args, LDS_BYTES, stream);
  if (e != hipSuccess) fprintf(stderr, "cooperative launch failed: %s (grid %d)\n", hipGetErrorString(e), grid_blocks);
#endif
}
```

```cpp
#include <hip/hip_runtime.h>
#include <hip/hip_cooperative_groups.h>
#include <stdint.h>
#include <stdio.h>
namespace cg = cooperative_groups;

#ifndef MULTI_LAUNCH
#define MULTI_LAUNCH 0
#endif

#define DI __device__ __forceinline__
typedef unsigned short u16;
using bf16x8 = __attribute__((ext_vector_type(8))) short;
using f32x4 = __attribute__((ext_vector_type(4))) float;
typedef __bf16 bf2_t __attribute__((ext_vector_type(2)));
typedef float f2_t __attribute__((ext_vector_type(2)));
typedef unsigned u32x4 __attribute__((ext_vector_type(4)));
typedef unsigned u32x2 __attribute__((ext_vector_type(2)));

constexpr int D = 1024, NTOK = 6144, NCTX = 4096, NIN = 3328, DFF = 4096;
constexpr float ALPHA = 1.41421356237309515f;
constexpr float LOG2E = 1.44269504088896341f;
constexpr int LDS_BYTES = 75776;
constexpr int NPHASE = 18;

constexpr size_t O_WTIN = 0;
constexpr size_t O_WTOUT = O_WTIN + (size_t)2 * NIN * D * 2;
constexpr size_t O_WTFF1 = O_WTOUT + (size_t)2 * D * D * 2;
constexpr size_t O_WTFF2 = O_WTFF1 + (size_t)2 * DFF * D * 2;
constexpr size_t O_MODS = O_WTFF2 + (size_t)2 * D * DFF * 2;
constexpr size_t O_ROPE = O_MODS + (size_t)2 * 3 * 6144 * 4;
constexpr size_t O_QA = O_ROPE + (size_t)1024 * 32 * 2 * 4;
constexpr size_t O_KACTX = O_QA + (size_t)NTOK * 512 * 2;
constexpr size_t O_KALAT = O_KACTX + (size_t)NCTX * 512 * 2;
constexpr size_t O_VTACTX = O_KALAT + (size_t)2 * 2 * 1536 * 512 * 2;
constexpr size_t O_VTALAT = O_VTACTX + (size_t)16 * 4 * 128 * 256 * 2;
constexpr size_t O_QC = O_VTALAT + (size_t)2 * 2 * 4 * 128 * 1536 * 2;
constexpr size_t O_KCCTX = O_QC + (size_t)NTOK * 256 * 2;
constexpr size_t O_KCLAT = O_KCCTX + (size_t)NCTX * 128 * 2;
constexpr size_t O_VTCCTX = O_KCLAT + (size_t)2 * 2 * 1536 * 128 * 2;
constexpr size_t O_VTCLAT = O_VTCCTX + (size_t)16 * 2 * 64 * 256 * 2;
constexpr size_t O_KV = O_VTCLAT + (size_t)2 * 2 * 2 * 64 * 1536 * 2;
constexpr size_t O_DEC = O_KV + (size_t)768 * 4096 * 4;
constexpr size_t O_MIXED = O_DEC + (size_t)768 * 64 * 4;
constexpr size_t O_XPRE1 = O_MIXED + (size_t)NTOK * 1024 * 2;
constexpr size_t O_ST1 = O_XPRE1 + (size_t)NTOK * 1024 * 4;
constexpr size_t O_XPRE2 = O_ST1 + (size_t)NTOK * 32 * 4;
constexpr size_t O_ST2 = O_XPRE2 + (size_t)NTOK * 1024 * 4;
constexpr size_t O_ABF = O_ST2 + (size_t)NTOK * 32 * 4;
constexpr size_t O_HQ = O_ABF + (size_t)NTOK * 1024 * 2;
constexpr size_t O_HGF = O_HQ + (size_t)NTOK * 256 * 4;
constexpr size_t O_HGB = O_HGF + (size_t)NTOK * 256 * 4;
constexpr size_t O_HI = O_HGB + (size_t)NTOK * 256 * 4;
constexpr size_t O_HSG = O_HI + (size_t)NTOK * 256 * 4;
constexpr size_t O_OI = O_HSG + (size_t)NTOK * 256 * 4;
constexpr size_t O_QE = O_OI + (size_t)2 * NTOK * 256 * 4;
constexpr size_t O_END1 = O_QE + (size_t)2 * NTOK * 256 * 4;
constexpr size_t O_CNT = O_END1 + 16384;
constexpr size_t CNT_BYTES = 2048;
static_assert(O_CNT + CNT_BYTES <= (size_t)256 * 1024 * 1024, "counters must fit");
constexpr size_t O_HID = O_HQ;
constexpr size_t O_END2 = O_HID + (size_t)NTOK * 4096 * 2;
static_assert(O_END2 <= O_END1, "HID alias must fit");
static_assert(O_END1 <= (size_t)256 * 1024 * 1024, "workspace too big");

constexpr size_t OUT_YP = 0, OUT_YS = 4194304, OUT_AK = 6291456, OUT_AV = 10485760, OUT_CK = 14680064,
                 OUT_CV = 15728640, OUT_SF = 16777216, OUT_SB = 17301504;

struct P {
  const float* in[30];
  float* out;
  char* ws;
};

DI unsigned pack2(float a, float b) {
  f2_t v = {a, b};
  bf2_t r = __builtin_convertvector(v, bf2_t);
  return __builtin_bit_cast(unsigned, r);
}
DI u16 f2bf(float x) { return (u16)(pack2(x, 0.f) & 0xffffu); }
DI float ex2(float x) { return __builtin_amdgcn_exp2f(x); }
DI float siluf(float x) { return x / (1.f + expf(-x)); }
DI float shx(float v, int m) { return __shfl_xor(v, m, 64); }
DI float red16(float x) {
  x += __builtin_bit_cast(float, __builtin_amdgcn_update_dpp(0, __builtin_bit_cast(int, x), 0xB1, 0xF, 0xF, true));
  x += __builtin_bit_cast(float, __builtin_amdgcn_update_dpp(0, __builtin_bit_cast(int, x), 0x4E, 0xF, 0xF, true));
  x += __builtin_bit_cast(float, __builtin_amdgcn_update_dpp(0, __builtin_bit_cast(int, x), 0x141, 0xF, 0xF, true));
  x += __builtin_bit_cast(float, __builtin_amdgcn_update_dpp(0, __builtin_bit_cast(int, x), 0x140, 0xF, 0xF, true));
  return x;
}
DI float xor1(float x) { return __builtin_bit_cast(float, __builtin_amdgcn_update_dpp(0, __builtin_bit_cast(int, x), 0xB1, 0xF, 0xF, true)); }
DI int ltid() { int t = threadIdx.x; asm volatile("" : "+v"(t)); return t; }
#define MFMA16(a, b, c) __builtin_amdgcn_mfma_f32_16x16x32_bf16((a), (b), (c), 0, 0, 0)

DI void p0_mod(const P& p, int item, char* smem) {
  float* ssilu = (float*)smem;
  float* red = ssilu + 3072;
  const int tid = ltid();
  __syncthreads();
  for (int i = tid; i < 3072; i += 256) {
    int w = i >> 10, k = i & 1023;
    float v = (w == 0) ? p.in[9][k] : p.in[8][(w - 1) * 1024 + k];
    ssilu[i] = siluf(v);
  }
  __syncthreads();
  const int li = item / 96, j0 = (item % 96) * 64;
  const int c4 = tid & 15, kp = tid >> 4;
  const float* W = p.in[10] + (size_t)li * 1024 * 6144 + j0 + c4 * 4;
  float4 a0 = {0, 0, 0, 0}, a1 = a0, a2 = a0;
#pragma unroll 16
  for (int kk = 0; kk < 64; ++kk) {
    int k = kp * 64 + kk;
    float4 w4 = *(const float4*)(W + (size_t)k * 6144);
    float s0 = ssilu[k], s1 = ssilu[1024 + k], s2 = ssilu[2048 + k];
    a0.x += s0 * w4.x; a0.y += s0 * w4.y; a0.z += s0 * w4.z; a0.w += s0 * w4.w;
    a1.x += s1 * w4.x; a1.y += s1 * w4.y; a1.z += s1 * w4.z; a1.w += s1 * w4.w;
    a2.x += s2 * w4.x; a2.y += s2 * w4.y; a2.z += s2 * w4.z; a2.w += s2 * w4.w;
  }
  *(float4*)(red + (kp * 3 + 0) * 64 + c4 * 4) = a0;
  *(float4*)(red + (kp * 3 + 1) * 64 + c4 * 4) = a1;
  *(float4*)(red + (kp * 3 + 2) * 64 + c4 * 4) = a2;
  __syncthreads();
  if (tid < 192) {
    int w = tid >> 6, c = tid & 63;
    float s = p.in[11][li * 6144 + j0 + c];
    for (int q = 0; q < 16; ++q) s += red[(q * 3 + w) * 64 + c];
    ((float*)(p.ws + O_MODS))[(li * 3 + w) * 6144 + j0 + c] = s;
  }
#if !MULTI_LAUNCH
  if (li == 0 && j0 < 2048) {
    asm volatile("s_waitcnt vmcnt(0)" ::: "memory");
    __syncthreads();
    if (tid == 0) {
      __builtin_amdgcn_fence(__ATOMIC_RELEASE, "agent");
      asm volatile("s_waitcnt vmcnt(0)" ::: "memory");
      (void)__hip_atomic_fetch_add((unsigned*)(p.ws + O_CNT), 1u, __ATOMIC_RELAXED, __HIP_MEMORY_SCOPE_AGENT);
    }
  }
#endif
}

DI void p0_rope(const P& p, int item) {
  float* R = (float*)(p.ws + O_ROPE);
  for (int i = ltid(); i < 4096; i += 256) {
    int idx = item * 4096 + i;
    int t = idx >> 5, pp = idx & 31;
    float inv = powf(10000.f, -(float)(pp & 15) / 16.f);
    float pos = (pp < 16) ? (float)(t >> 6) : (float)(t & 63);
    float ang = pos * inv;
    R[idx * 2] = cosf(ang);
    R[idx * 2 + 1] = sinf(ang);
  }
}

DI void p0_copyk(const P& p, int item, bool isA) {
  const int W = isA ? 512 : 128;
  const float* src = isA ? p.in[2] : p.in[4];
  u16* dst = (u16*)(p.ws + (isA ? O_KALAT : O_KCLAT));
  float4 vv[4];
#pragma unroll
  for (int i = 0; i < 4; ++i) vv[i] = *(const float4*)(src + (size_t)item * 4096 + (size_t)(ltid() + 256 * i) * 4);
#pragma unroll
  for (int i = 0; i < 4; ++i) {
    size_t e = (size_t)item * 4096 + (size_t)(ltid() + 256 * i) * 4;
    float4 v = vv[i];
    int c = (int)(e % W);
    size_t r = e / W;
    int pp = (int)(r % 512);
    int bl = (int)(r / 512);
    int b = bl >> 1, li = bl & 1;
    uint2 o;
    o.x = pack2(v.x, v.y);
    o.y = pack2(v.z, v.w);
    *(uint2*)(dst + ((size_t)((li * 2 + b) * 1536 + 1024 + pp)) * W + c) = o;
  }
}

struct TDesc { const float* src; int sstride; u16* dst; int dstride; };

DI TDesc tdesc(const P& p, int t) {
  constexpr int T_IN = 1664, T_OUT = 512, T_FF1 = 2048, T_FF2 = 2048, T_AV = 256;
  TDesc d;
  if (t < T_IN) {
    int li = t / 832, r = t % 832, kt = r / 52, nt = r % 52;
    d.src = p.in[12] + (size_t)li * 1024 * NIN + (size_t)(kt * 64) * NIN + nt * 64; d.sstride = NIN;
    d.dst = (u16*)(p.ws + O_WTIN) + (size_t)li * NIN * 1024 + (size_t)(nt * 64) * 1024 + kt * 64; d.dstride = 1024;
  } else if ((t -= T_IN) < T_OUT) {
    int li = t / 256, r = t % 256, kt = r / 16, nt = r % 16;
    d.src = p.in[13] + (size_t)li * 1024 * 1024 + (size_t)(kt * 64) * 1024 + nt * 64; d.sstride = 1024;
    d.dst = (u16*)(p.ws + O_WTOUT) + (size_t)li * 1024 * 1024 + (size_t)(nt * 64) * 1024 + kt * 64; d.dstride = 1024;
  } else if ((t -= T_OUT) < T_FF1) {
    int li = t / 1024, r = t % 1024, kt = r / 64, nt = r % 64;
    d.src = p.in[28] + (size_t)li * 1024 * DFF + (size_t)(kt * 64) * DFF + nt * 64; d.sstride = DFF;
    d.dst = (u16*)(p.ws + O_WTFF1) + (size_t)li * DFF * 1024 + (size_t)(nt * 64) * 1024 + kt * 64; d.dstride = 1024;
  } else if ((t -= T_FF1) < T_FF2) {
    int li = t / 1024, r = t % 1024, kt = r / 16, nt = r % 16;
    d.src = p.in[29] + (size_t)li * DFF * 1024 + (size_t)(kt * 64) * 1024 + nt * 64; d.sstride = 1024;
    d.dst = (u16*)(p.ws + O_WTFF2) + (size_t)li * 1024 * DFF + (size_t)(nt * 64) * DFF + kt * 64; d.dstride = DFF;
  } else if ((t -= T_FF2) < T_AV) {
    int bl = t / 64, r = t % 64, pt = r / 8, ct = r % 8;
    int b = bl >> 1, li = bl & 1;
    d.src = p.in[3] + ((size_t)bl * 512 + pt * 64) * 512 + ct * 64; d.sstride = 512;
    d.dst = (u16*)(p.ws + O_VTALAT) + ((size_t)(li * 2 + b) * 512 + ct * 64) * 1536 + 1024 + pt * 64; d.dstride = 1536;
  } else {
    t -= T_AV;
    int bl = t / 16, r = t % 16, pt = r / 2, ct = r % 2;
    int b = bl >> 1, li = bl & 1;
    d.src = p.in[5] + ((size_t)bl * 512 + pt * 64) * 128 + ct * 64; d.sstride = 128;
    d.dst = (u16*)(p.ws + O_VTCLAT) + ((size_t)(li * 2 + b) * 128 + ct * 64) * 1536 + 1024 + pt * 64; d.dstride = 1536;
  }
  return d;
}

DI int tcount(int mode) { return mode == 0 ? 832 + 256 + 320 : (mode == 1 ? 832 + 256 : 2048); }
DI int tmap(int k, int mode) {
  if (mode == 0) {
    if (k < 832) return k;
    if (k < 1088) return 1664 + (k - 832);
    return 6272 + (k - 1088);
  }
  if (mode == 1) {
    if (k < 832) return 832 + k;
    return 1920 + (k - 832);
  }
  const int li = mode - 2;
  if (k < 1024) return 2176 + li * 1024 + k;
  return 4224 + li * 1024 + (k - 1024);
}
DI void run_transposes(const P& p, char* smem, int first, int step, int deferred, int count_override = -1) {
  const int count = count_override >= 0 ? count_override : tcount(deferred);
  float* tl = (float*)smem;
  const int tid = ltid();
  const int lr = tid >> 4, lc4 = tid & 15;
  const int c = tid >> 2, rs = tid & 3;
  int t = first;
  f32x4 v[4];
  TDesc cur;
  if (t < count) {
    cur = tdesc(p, tmap(t, deferred));
#pragma unroll
    for (int i = 0; i < 4; ++i) v[i] = *(const f32x4*)(cur.src + (size_t)(lr + 16 * i) * cur.sstride + lc4 * 4);
  }
  while (t < count) {
    __syncthreads();
#pragma unroll
    for (int i = 0; i < 4; ++i) {
      float* q = tl + (lr + 16 * i) * 65 + lc4 * 4;
      q[0] = v[i].x; q[1] = v[i].y; q[2] = v[i].z; q[3] = v[i].w;
    }
    const int tn = t + step;
    TDesc nxt = cur;
    if (tn < count) {
      nxt = tdesc(p, tmap(tn, deferred));
#pragma unroll
      for (int i = 0; i < 4; ++i) v[i] = *(const f32x4*)(nxt.src + (size_t)(lr + 16 * i) * nxt.sstride + lc4 * 4);
    }
    __syncthreads();
    u32x4 o0, o1;
    {
      const float* q = tl + (rs * 16) * 65 + c;
      o0.x = pack2(q[0 * 65], q[1 * 65]);   o0.y = pack2(q[2 * 65], q[3 * 65]);
      o0.z = pack2(q[4 * 65], q[5 * 65]);   o0.w = pack2(q[6 * 65], q[7 * 65]);
      o1.x = pack2(q[8 * 65], q[9 * 65]);   o1.y = pack2(q[10 * 65], q[11 * 65]);
      o1.z = pack2(q[12 * 65], q[13 * 65]); o1.w = pack2(q[14 * 65], q[15 * 65]);
    }
    u32x4* dp = (u32x4*)(cur.dst + (size_t)c * cur.dstride + rs * 16);
    dp[0] = o0;
    dp[1] = o1;
    cur = nxt;
    t = tn;
  }
}

DI void ln_apply(const P& p, const float* lo, const float* hi, const float* stats, const float* lng, const float* lnb,
                 const float* mods, int sc_off, int sh_off);

DI void phase0(const P& p, char* smem) {
  constexpr int N_MOD = 192, N_ROPE = 8, N_AK = 256, N_CK = 64;
  constexpr int B_ROPE = N_MOD, B_AK = B_ROPE + N_ROPE, B_CK = B_AK + N_AK, B_T = B_CK + N_CK;
  constexpr int NTILES = 1664 + 512 + 2048 + 2048 + 256 + 64;
  for (int it = blockIdx.x; it < B_T; it += gridDim.x) {
    if (it < B_ROPE) p0_mod(p, it, smem);
    else if (it < B_AK) p0_rope(p, it - B_ROPE);
    else if (it < B_CK) p0_copyk(p, it - B_AK, true);
    else p0_copyk(p, it - B_CK, false);
  }
  run_transposes(p, smem, blockIdx.x, gridDim.x, 0);
#if !MULTI_LAUNCH
  if (ltid() == 0) {
    unsigned sp = 0;
    while (__hip_atomic_load((unsigned*)(p.ws + O_CNT), __ATOMIC_RELAXED, __HIP_MEMORY_SCOPE_AGENT) < 32u) {
      __builtin_amdgcn_s_sleep(2);
      if (++sp > (1u << 22)) break;
    }
    __builtin_amdgcn_fence(__ATOMIC_ACQUIRE, "agent");
    asm volatile("s_waitcnt vmcnt(0)" ::: "memory");
  }
  __syncthreads();
  ln_apply(p, p.in[0], p.in[1], nullptr, p.in[26], p.in[27], (const float*)(p.ws + O_MODS), 1024, 0);
#endif
}

struct GA {
  const float* alo;
  const float* ahi;
  const float* stats;
  const float* lng;
  const float* lnb;
  const float* mods;
  int sc_off, sh_off;
  const u16* a16;
  const u16* bt;
  int K, N;
  float* xout;
  float* sout;
  u16* hid;
};

DI void epi_inproj(const P& p, int li, f32x4 (&acc)[4][4], int R0, int C0);


template <int EPI, int MI = 4>
DI void gemm_tile(const P& p, const GA& g, int li, int m0, int n0, char* smem, u32x4 (&ra0)[4], u32x4 (&rb0)[4],
                  u32x4 (&ra1)[4], u32x4 (&rb1)[4], bool primed, int nm0, int nn0) {
  static_assert(MI == 4 || EPI == 1, "only the residual epilogue supports 96-row tiles");
  constexpr int WM = MI * 16;
  const int tid = ltid(), lane = tid & 63, wid = tid >> 6, wr = wid >> 1, wc = wid & 1;
  const int l16 = lane & 15, q4 = lane >> 4;
  u16* sA0 = (u16*)smem;
  u16* sB0 = sA0 + 128 * 72;
  u16* sA1 = sB0 + 128 * 72;
  u16* sB1 = sA1 + 128 * 72;
  float2* sStat = (float2*)(smem + 73728);
  const int K = g.K;
  const int rtype = (m0 < NCTX) ? 0 : 1 + ((m0 - NCTX) >> 10);
  const float* modv = g.mods + rtype * 6144;
  const float* fsrc = (m0 < NCTX) ? g.alo + (size_t)m0 * 1024 : g.ahi + (size_t)(m0 - NCTX) * 1024;

  if (!primed) {
    const unsigned goff_ = (unsigned)(tid >> 3) * (unsigned)g.K + (unsigned)(tid & 7) * 8u;
    const u16* ab_ = g.a16 + (size_t)m0 * g.K;
    const u16* bb_ = g.bt + (size_t)n0 * g.K;
#pragma unroll
    for (int i = 0; i < 4; ++i) {
      if (i < MI) ra0[i] = *(const u32x4*)(ab_ + (size_t)(32 * i) * g.K + goff_);
      rb0[i] = *(const u32x4*)(bb_ + (size_t)(32 * i) * g.K + goff_);
    }
    __builtin_amdgcn_sched_barrier(0);
#pragma unroll
    for (int i = 0; i < 4; ++i) {
      if (i < MI) ra1[i] = *(const u32x4*)(ab_ + (size_t)(32 * i) * g.K + 64 + goff_);
      rb1[i] = *(const u32x4*)(bb_ + (size_t)(32 * i) * g.K + 64 + goff_);
    }
    __builtin_amdgcn_sched_barrier(0);
  }
  __syncthreads();
  if constexpr (EPI == 1 || EPI == 3) {
    if (g.stats != nullptr && tid < 2 * WM) {
      const float4* sp = (const float4*)(g.stats + (size_t)(m0 + tid) * 32);
      float s1 = 0.f, s2 = 0.f;
#pragma unroll
      for (int i = 0; i < 8; ++i) {
        float4 v = sp[i];
        s1 += v.x + v.z;
        s2 += v.y + v.w;
      }
      float mu = s1 * (1.f / 1024.f);
      float var = s2 * (1.f / 1024.f) - mu * mu;
      sStat[tid] = make_float2(mu, rsqrtf(fmaxf(var, 0.f) + 1e-6f));
    }
  }

  f32x4 acc[MI][4];
#pragma unroll
  for (int i = 0; i < MI; ++i)
#pragma unroll
    for (int j = 0; j < 4; ++j) acc[i][j] = f32x4{0.f, 0.f, 0.f, 0.f};

  const unsigned goff = (unsigned)(tid >> 3) * (unsigned)K + (unsigned)(tid & 7) * 8u;
  const unsigned loff = (unsigned)(tid >> 3) * 72u + (unsigned)(tid & 7) * 8u;
  const u16* abase = g.a16 + (size_t)m0 * K;
  const u16* bbase = g.bt + (size_t)n0 * K;
#define GLOAD(RA, RB, KT)                                                        \
  _Pragma("unroll") for (int i = 0; i < 4; ++i) {                                \
    if (i < MI) RA[i] = *(const u32x4*)(abase + (size_t)(32 * i) * K + (KT) * 64 + goff); \
    RB[i] = *(const u32x4*)(bbase + (size_t)(32 * i) * K + (KT) * 64 + goff);    \
  }
#define LSTORE(SA, SB, RA, RB)                                                   \
  _Pragma("unroll") for (int i = 0; i < 4; ++i) {                                \
    if (i < MI) *(u32x4*)(SA + 32 * i * 72 + loff) = RA[i];                      \
    *(u32x4*)(SB + 32 * i * 72 + loff) = RB[i];                                  \
  }
#define COMPUTE(SA, SB)                                                          \
  _Pragma("unroll") for (int s = 0; s < 2; ++s) {                                \
    bf16x8 af[MI], bfr[4];                                                       \
    _Pragma("unroll") for (int i = 0; i < 4; ++i) {                              \
      if (i < MI) af[i] = *(const bf16x8*)(SA + (wr * WM + i * 16 + l16) * 72 + s * 32 + q4 * 8);  \
      bfr[i] = *(const bf16x8*)(SB + (wc * 64 + i * 16 + l16) * 72 + s * 32 + q4 * 8); \
    }                                                                            \
    __builtin_amdgcn_s_setprio(1);                                               \
    _Pragma("unroll") for (int i = 0; i < MI; ++i)                               \
      _Pragma("unroll") for (int j = 0; j < 4; ++j) acc[i][j] = MFMA16(af[i], bfr[j], acc[i][j]); \
    __builtin_amdgcn_s_setprio(0);                                               \
    __builtin_amdgcn_sched_barrier(0);                                           \
  }

  const int nk = K >> 6;
#define SB0 __builtin_amdgcn_sched_barrier(0)
  LSTORE(sA0, sB0, ra0, rb0);
  SB0;
  GLOAD(ra0, rb0, 2);
  SB0;
  __syncthreads();
#pragma unroll 1
  for (int kt = 0; kt < nk - 4; kt += 2) {
    SB0;
    LSTORE(sA1, sB1, ra1, rb1);
    SB0;
    GLOAD(ra1, rb1, kt + 3);
    SB0;
    COMPUTE(sA0, sB0);
    __syncthreads();
    SB0;
    LSTORE(sA0, sB0, ra0, rb0);
    SB0;
    GLOAD(ra0, rb0, kt + 4);
    SB0;
    COMPUTE(sA1, sB1);
    __syncthreads();
  }
  SB0;
  LSTORE(sA1, sB1, ra1, rb1);
  SB0;
  GLOAD(ra1, rb1, nk - 1);
  SB0;
  COMPUTE(sA0, sB0);
  __syncthreads();
  const u16* nabase = g.a16 + (size_t)nm0 * K;
  const u16* nbbase = g.bt + (size_t)nn0 * K;
  SB0;
  LSTORE(sA0, sB0, ra0, rb0);
  SB0;
  _Pragma("unroll") for (int i = 0; i < 4; ++i) {
    if (i < MI) ra0[i] = *(const u32x4*)(nabase + (size_t)(32 * i) * K + goff);
    rb0[i] = *(const u32x4*)(nbbase + (size_t)(32 * i) * K + goff);
  }
  SB0;
  COMPUTE(sA1, sB1);
  __syncthreads();
  SB0;
  LSTORE(sA1, sB1, ra1, rb1);
  SB0;
  _Pragma("unroll") for (int i = 0; i < 4; ++i) {
    if (i < MI) ra1[i] = *(const u32x4*)(nabase + (size_t)(32 * i) * K + 64 + goff);
    rb1[i] = *(const u32x4*)(nbbase + (size_t)(32 * i) * K + 64 + goff);
  }
  SB0;
  COMPUTE(sA0, sB0);
  __syncthreads();
  SB0;
  COMPUTE(sA1, sB1);
#undef GLOAD
#undef LSTORE
#undef COMPUTE
#undef SB0
  asm volatile("" ::: "memory");

  const int R0 = m0 + wr * WM, C0 = n0 + wc * 64;
  if constexpr (EPI == 0) {
    if constexpr (MI == 4) epi_inproj(p, li, acc, R0, C0);
  } else if constexpr (EPI == 1) {
    const int rtA = rtype;
    const int mlast = m0 + 2 * WM - 1;
    const int rtB = (mlast < NCTX) ? 0 : 1 + ((mlast - NCTX) >> 10);
    const float* modvB = g.mods + rtB * 6144;
    float gateA[4], gateB[4], lg[4], lb[4];
#pragma unroll
    for (int j = 0; j < 4; ++j) {
      int col = C0 + j * 16 + l16;
      gateA[j] = modv[g.sc_off + col];
      gateB[j] = modvB[g.sc_off + col];
      lg[j] = g.stats ? g.lng[col] : 1.f;
      lb[j] = g.stats ? g.lnb[col] : 0.f;
    }
    float xr[MI][4][4];
#pragma unroll
    for (int i = 0; i < MI; ++i)
#pragma unroll
      for (int r = 0; r < 4; ++r) {
        const int grow = m0 + wr * WM + i * 16 + q4 * 4 + r;
        const float* rp = (grow < NCTX) ? g.alo + (size_t)grow * 1024 : g.ahi + (size_t)(grow - NCTX) * 1024;
#pragma unroll
        for (int j = 0; j < 4; ++j) xr[i][r][j] = rp[C0 + j * 16 + l16];
      }
#pragma unroll
    for (int i = 0; i < MI; ++i) {
#pragma unroll
      for (int r = 0; r < 4; ++r) {
        int lrow = wr * WM + i * 16 + q4 * 4 + r;
        const int grow = m0 + lrow;
        const int rt = (grow < NCTX) ? 0 : 1 + ((grow - NCTX) >> 10);
        const bool useA = (rt == rtA);
        float mu = 0.f, rs = 1.f;
        if (g.stats != nullptr) {
          float2 st = sStat[lrow];
          mu = st.x;
          rs = st.y;
        }
        float s1 = 0.f, s2 = 0.f;
#pragma unroll
        for (int j = 0; j < 4; ++j) {
          int col = C0 + j * 16 + l16;
          float x = xr[i][r][j];
          x = (x - mu) * rs * lg[j] + lb[j];
          float v = ALPHA * x + (useA ? gateA[j] : gateB[j]) * acc[i][j][r];
          g.xout[(size_t)grow * 1024 + col] = v;
          s1 += v;
          s2 += v * v;
        }
        s1 = red16(s1);
        s2 = red16(s2);
        if (l16 == 0) *(float2*)(g.sout + (size_t)grow * 32 + (C0 >> 6) * 2) = make_float2(s1, s2);
      }
    }
  } else {
    float* sC = (float*)smem;
    __syncthreads();
#pragma unroll
    for (int i = 0; i < 4; ++i)
#pragma unroll
      for (int j = 0; j < 4; ++j)
#pragma unroll
        for (int r = 0; r < 4; ++r) if constexpr (MI == 4) sC[(wr * 64 + i * 16 + q4 * 4 + r) * 132 + wc * 64 + j * 16 + l16] = acc[i][j][r];
    __syncthreads();
    if constexpr (EPI == 3) {
      const int hl = lane & 31, rsel = lane >> 5;
      const int col = n0 + hl * 4;
      const f32x4 gate4 = *(const f32x4*)(modv + g.sc_off + col);
      f32x4 lg4 = {1.f, 1.f, 1.f, 1.f}, lb4 = {0.f, 0.f, 0.f, 0.f};
      if (g.stats != nullptr) {
        lg4 = *(const f32x4*)(g.lng + col);
        lb4 = *(const f32x4*)(g.lnb + col);
      }
#pragma unroll 4
      for (int pp = 0; pp < 16; ++pp) {
        const int lrow = pp * 8 + wid * 2 + rsel;
        f32x4 a = *(const f32x4*)(sC + lrow * 132 + hl * 4);
        f32x4 x = *(const f32x4*)(fsrc + (size_t)lrow * 1024 + col);
        float mu = 0.f, rs = 1.f;
        if (g.stats != nullptr) {
          float2 st = sStat[lrow];
          mu = st.x;
          rs = st.y;
        }
        x = (x - mu) * rs * lg4 + lb4;
        f32x4 v = ALPHA * x + gate4 * a;
        *(f32x4*)(g.xout + (size_t)(m0 + lrow) * 1024 + col) = v;
        float s1 = (v.x + v.y) + (v.z + v.w);
        float s2 = (v.x * v.x + v.y * v.y) + (v.z * v.z + v.w * v.w);
        s1 = red16(s1);
        s2 = red16(s2);
        if ((lane & 15) == 0) *(float2*)(g.sout + (size_t)(m0 + lrow) * 32 + ((n0 >> 6) + (hl >> 4)) * 2) = make_float2(s1, s2);
      }
    } else {
#pragma unroll
      for (int pp = 0; pp < 8; ++pp) {
        const int idx = tid + 256 * pp;
        const int lrow = idx >> 4, c8 = idx & 15;
        f32x4 a0 = *(const f32x4*)(sC + lrow * 132 + c8 * 8);
        f32x4 a1 = *(const f32x4*)(sC + lrow * 132 + c8 * 8 + 4);
        a0.x = fmaxf(a0.x, 0.f); a0.y = fmaxf(a0.y, 0.f); a0.z = fmaxf(a0.z, 0.f); a0.w = fmaxf(a0.w, 0.f);
        a1.x = fmaxf(a1.x, 0.f); a1.y = fmaxf(a1.y, 0.f); a1.z = fmaxf(a1.z, 0.f); a1.w = fmaxf(a1.w, 0.f);
        u32x4 o;
        o.x = pack2(a0.x * a0.x, a0.y * a0.y);
        o.y = pack2(a0.z * a0.z, a0.w * a0.w);
        o.z = pack2(a1.x * a1.x, a1.y * a1.y);
        o.w = pack2(a1.z * a1.z, a1.w * a1.w);
        *(u32x4*)(g.hid + (size_t)(m0 + lrow) * DFF + n0 + c8 * 8) = o;
      }
    }
  }
}

DI void epi_inproj(const P& p, int li, f32x4 (&acc)[4][4], int R0, int C0) {
  const int lane = ltid() & 63, l16 = lane & 15, q4 = lane >> 4;
  const int seg = C0 >> 6;
  const bool lat = R0 >= NCTX;
  const float2* rope = (const float2*)(p.ws + O_ROPE);
  int b, tb;
  if (!lat) { b = R0 >> 8; tb = R0 & 255; } else { b = (R0 - NCTX) >> 10; tb = (R0 - NCTX) & 1023; }

  enum { T_QA, T_KA, T_VA, T_QB, T_FF, T_FB, T_IB, T_GB, T_QC, T_KC, T_VC };
  int type, cbase;
  if (seg < 8) { type = T_QA; cbase = seg * 64; }
  else if (seg < 16) { type = T_KA; cbase = (seg - 8) * 64; }
  else if (seg < 24) { type = T_VA; cbase = (seg - 16) * 64; }
  else if (seg < 28) { type = T_QB; cbase = (seg - 24) * 64; }
  else if (seg < 32) { type = T_FF; cbase = (seg - 28) * 64; }
  else if (seg < 36) { type = T_FB; cbase = (seg - 32) * 64; }
  else if (seg < 40) { type = T_IB; cbase = (seg - 36) * 64; }
  else if (seg < 44) { type = T_GB; cbase = (seg - 40) * 64; }
  else if (seg < 48) { type = T_QC; cbase = (seg - 44) * 64; }
  else if (seg < 50) { type = T_KC; cbase = (seg - 48) * 64; }
  else { type = T_VC; cbase = (seg - 50) * 64; }

  if (type == T_QC || type == T_KC) {
    const float* gv = (type == T_QC ? p.in[22] : p.in[23]) + li * 64;
    float gj[4];
#pragma unroll
    for (int j = 0; j < 4; ++j) gj[j] = gv[j * 16 + l16];
#pragma unroll
    for (int i = 0; i < 4; ++i)
#pragma unroll
      for (int r = 0; r < 4; ++r) {
        float ss = 0.f;
#pragma unroll
        for (int j = 0; j < 4; ++j) ss += acc[i][j][r] * acc[i][j][r];
        ss = red16(ss);
        float rs = rsqrtf(ss * (1.f / 64.f) + 1e-6f);
#pragma unroll
        for (int j = 0; j < 4; ++j) acc[i][j][r] = acc[i][j][r] * rs * gj[j];
      }
  }
  if (!lat && (type == T_KA || type == T_VA || type == T_KC || type == T_VC)) {
    float* o;
    int W;
    if (type == T_KA) { o = p.out + OUT_AK; W = 512; }
    else if (type == T_VA) { o = p.out + OUT_AV; W = 512; }
    else if (type == T_KC) { o = p.out + OUT_CK; W = 128; }
    else { o = p.out + OUT_CV; W = 128; }
#pragma unroll
    for (int i = 0; i < 4; ++i)
#pragma unroll
      for (int r = 0; r < 4; ++r) {
        int t = tb + i * 16 + q4 * 4 + r;
        size_t base = ((size_t)(b * 2 + li) * 256 + t) * W + cbase;
#pragma unroll
        for (int j = 0; j < 4; ++j) o[base + j * 16 + l16] = acc[i][j][r];
      }
  }
  if (lat && (type == T_QA || type == T_KA || type == T_QC || type == T_KC)) {
#pragma unroll
    for (int i = 0; i < 4; ++i)
#pragma unroll
      for (int r = 0; r < 4; ++r) {
        int t = tb + i * 16 + q4 * 4 + r;
#pragma unroll
        for (int j = 0; j < 4; ++j) {
          float v = acc[i][j][r];
          float pv = xor1(v);
          float2 cs = rope[t * 32 + j * 8 + (l16 >> 1)];
          acc[i][j][r] = (l16 & 1) ? (pv * cs.y + v * cs.x) : (v * cs.x - pv * cs.y);
        }
      }
  }

  if (type == T_QA || type == T_KA || type == T_QC || type == T_KC) {
    u16* dst;
    int W;
    size_t rowbase;
    if (type == T_QA) { dst = (u16*)(p.ws + O_QA); W = 512; rowbase = (size_t)R0 * 512; }
    else if (type == T_QC) { dst = (u16*)(p.ws + O_QC); W = 256; rowbase = (size_t)R0 * 256; }
    else if (type == T_KA) {
      W = 512;
      if (!lat) { dst = (u16*)(p.ws + O_KACTX); rowbase = (size_t)R0 * 512; }
      else { dst = (u16*)(p.ws + O_KALAT); rowbase = ((size_t)(li * 2 + b) * 1536 + tb) * 512; }
    } else {
      W = 128;
      if (!lat) { dst = (u16*)(p.ws + O_KCCTX); rowbase = (size_t)R0 * 128; }
      else { dst = (u16*)(p.ws + O_KCLAT); rowbase = ((size_t)(li * 2 + b) * 1536 + tb) * 128; }
    }
#pragma unroll
    for (int i = 0; i < 4; ++i)
#pragma unroll
      for (int r = 0; r < 4; ++r) {
        size_t base = rowbase + (size_t)(i * 16 + q4 * 4 + r) * W + cbase;
#pragma unroll
        for (int j = 0; j < 4; ++j) dst[base + j * 16 + l16] = f2bf(acc[i][j][r]);
      }
  } else if (type == T_VA || type == T_VC) {
    u16* dst;
    int L;
    size_t hb;
    if (type == T_VA) {
      int h = cbase >> 7, dv0 = cbase & 127;
      if (!lat) { dst = (u16*)(p.ws + O_VTACTX); L = 256; hb = ((size_t)(b * 4 + h) * 128 + dv0) * 256; }
      else { dst = (u16*)(p.ws + O_VTALAT); L = 1536; hb = ((size_t)((li * 2 + b) * 4 + h) * 128 + dv0) * 1536; }
    } else {
      int n = cbase >> 6;
      if (!lat) { dst = (u16*)(p.ws + O_VTCCTX); L = 256; hb = ((size_t)(b * 2 + n) * 64) * 256; }
      else { dst = (u16*)(p.ws + O_VTCLAT); L = 1536; hb = ((size_t)((li * 2 + b) * 2 + n) * 64) * 1536; }
    }
#pragma unroll
    for (int i = 0; i < 4; ++i)
#pragma unroll
      for (int j = 0; j < 4; ++j) {
        uint2 o;
        o.x = pack2(acc[i][j][0], acc[i][j][1]);
        o.y = pack2(acc[i][j][2], acc[i][j][3]);
        *(uint2*)(dst + hb + (size_t)(j * 16 + l16) * L + tb + i * 16 + q4 * 4) = o;
      }
  } else {
    float* dst;
    if (type == T_QB) dst = (float*)(p.ws + O_HQ);
    else if (type == T_FF) dst = (float*)(p.ws + O_HGF);
    else if (type == T_FB) dst = (float*)(p.ws + O_HGB);
    else if (type == T_IB) dst = (float*)(p.ws + O_HI);
    else dst = (float*)(p.ws + O_HSG);
    float lbv[4] = {0.f, 0.f, 0.f, 0.f};
    if ((type == T_FF || type == T_FB) && li == 1) {
      const float* lg = (type == T_FF) ? p.in[19] : p.in[20];
#pragma unroll
      for (int j = 0; j < 4; ++j) {
        int c = cbase + j * 16 + l16;
        lbv[j] = 1.f / (1.f + expf(lg[c] - lg[256 + c]));
      }
    }
#pragma unroll
    for (int i = 0; i < 4; ++i)
#pragma unroll
      for (int r = 0; r < 4; ++r) {
        size_t base = (size_t)(R0 + i * 16 + q4 * 4 + r) * 256 + cbase;
#pragma unroll
        for (int j = 0; j < 4; ++j) {
          float v = acc[i][j][r];
          float o;
          if (type == T_QB || type == T_GB) o = v * __frcp_rn(1.f + __expf(-v));
          else if (type == T_IB) o = v;
          else {
            float sg = __frcp_rn(1.f + __expf(-v));
            float f = lbv[j] + (1.f - lbv[j]) * sg;
            o = __logf(fmaxf(f, 1e-6f));
          }
          dst[base + j * 16 + l16] = o;
        }
      }
  }
}

template <int EPI, int MI = 4>
DI void gemm_phase(const P& p, const GA& g, int li, char* smem) {
  constexpr int BMT = MI * 32;
  constexpr int MPX = NTOK / BMT / 8;
  const int NT = g.N >> 7;
  const int xcd = blockIdx.x & 7, lb = blockIdx.x >> 3, nlb = gridDim.x >> 3;
  if (lb >= nlb) return;
  u32x4 ra0[4], rb0[4], ra1[4], rb1[4];
  bool primed = false;
  for (int t = lb; t < MPX * NT; t += nlb) {
    int mt = xcd * MPX + t % MPX, nt = t / MPX;
    const int tn = (t + nlb < MPX * NT) ? t + nlb : t;
    const int nmt = xcd * MPX + tn % MPX, nnt = tn / MPX;
    gemm_tile<EPI, MI>(p, g, li, mt * BMT, nt * 128, smem, ra0, rb0, ra1, rb1, primed, nmt * BMT, nnt * 128);
    primed = true;
  }
}


template <int KW, int DV>
DI void attn_gload(const u16* Kb, int kstride, const u16* VT, int L, int kb, int tid, u32x4 (&kr)[KW / 32], u32x4 (&vr)[DV / 32]) {
  constexpr int KPR = 256 / (KW / 8);
  const unsigned koff = (unsigned)(tid / (KW / 8)) * (unsigned)kstride + (unsigned)(tid % (KW / 8)) * 8u;
  const unsigned voff = (unsigned)(tid >> 3) * (unsigned)L + (unsigned)(tid & 7) * 8u;
#pragma unroll
  for (int i = 0; i < KW / 32; ++i) {
    const u16* kbp = Kb + (size_t)(kb * 64 + KPR * i) * kstride;
    kr[i] = *(const u32x4*)(kbp + koff);
  }
#pragma unroll
  for (int i = 0; i < DV / 32; ++i) {
    const u16* vbp = VT + (size_t)(32 * i) * L + kb * 64;
    vr[i] = *(const u32x4*)(vbp + voff);
  }
}
template <int KW, int DV>
DI void attn_lstore(u16* sK, u16* sV, int tid, const u32x4 (&kr)[KW / 32], const u32x4 (&vr)[DV / 32]) {
  constexpr int KS = KW + 8;
#pragma unroll
  for (int i = 0; i < KW / 32; ++i) {
    int idx = tid + 256 * i;
    int key = idx / (KW / 8), cc = idx % (KW / 8);
    *(u32x4*)(sK + key * KS + cc * 8) = kr[i];
  }
#pragma unroll
  for (int i = 0; i < DV / 32; ++i) {
    int idx = tid + 256 * i;
    int row = idx >> 3, cc = idx & 7;
    *(u32x4*)(sV + row * 72 + cc * 8) = vr[i];
  }
}

template <int KW, int DV, int NQ>
DI void attn_compute(const u16* sK, const u16* sV, int kfo, int l16, int q4, const bf16x8 (&qf)[NQ][2],
                     f32x4 (&o)[NQ][DV / 16], float (&m)[NQ], float (&l)[NQ]) {
  constexpr int KS = KW + 8, NDT = DV / 16;
  const float c = 0.125f * LOG2E;
  f32x4 st[NQ][4];
#pragma unroll
  for (int kt = 0; kt < 4; ++kt) {
    const u16* kp = sK + (kt * 16 + l16) * KS + kfo + q4 * 8;
    bf16x8 k0 = *(const bf16x8*)kp;
    bf16x8 k1 = *(const bf16x8*)(kp + 32);
#pragma unroll
    for (int q = 0; q < NQ; ++q) {
      f32x4 z = {0.f, 0.f, 0.f, 0.f};
      z = MFMA16(k0, qf[q][0], z);
      st[q][kt] = MFMA16(k1, qf[q][1], z);
    }
  }
#pragma unroll
  for (int q = 0; q < NQ; ++q) {
    float bm = st[q][0][0];
#pragma unroll
    for (int kt = 0; kt < 4; ++kt)
#pragma unroll
      for (int r = 0; r < 4; ++r) bm = fmaxf(bm, st[q][kt][r]);
    bm = fmaxf(bm, shx(bm, 16));
    bm = fmaxf(bm, shx(bm, 32));
    const float mn = fmaxf(m[q], bm);
    const float alpha = ex2((m[q] - mn) * c);
    m[q] = mn;
    float ps = 0.f;
#pragma unroll
    for (int kt = 0; kt < 4; ++kt)
#pragma unroll
      for (int r = 0; r < 4; ++r) {
        float pv = ex2((st[q][kt][r] - mn) * c);
        st[q][kt][r] = pv;
        ps += pv;
      }
    l[q] = l[q] * alpha + ps;
#pragma unroll
    for (int d = 0; d < NDT; ++d) {
      o[q][d][0] *= alpha; o[q][d][1] *= alpha; o[q][d][2] *= alpha; o[q][d][3] *= alpha;
    }
  }
#pragma unroll
  for (int ks = 0; ks < 2; ++ks) {
    bf16x8 pf[NQ];
#pragma unroll
    for (int q = 0; q < NQ; ++q) {
      u32x4 pu;
      pu.x = pack2(st[q][2 * ks][0], st[q][2 * ks][1]);
      pu.y = pack2(st[q][2 * ks][2], st[q][2 * ks][3]);
      pu.z = pack2(st[q][2 * ks + 1][0], st[q][2 * ks + 1][1]);
      pu.w = pack2(st[q][2 * ks + 1][2], st[q][2 * ks + 1][3]);
      pf[q] = __builtin_bit_cast(bf16x8, pu);
    }
#pragma unroll
    for (int d = 0; d < NDT; ++d) {
      const u16* vp = sV + (d * 16 + l16) * 72 + ks * 32 + q4 * 4;
      u32x2 v0 = *(const u32x2*)vp;
      u32x2 v1 = *(const u32x2*)(vp + 16);
      u32x4 vu = {v0.x, v0.y, v1.x, v1.y};
      bf16x8 vf = __builtin_bit_cast(bf16x8, vu);
#pragma unroll
      for (int q = 0; q < NQ; ++q) o[q][d] = MFMA16(vf, pf[q], o[q][d]);
    }
  }
}

template <int KW, int DV, bool DIFF>
DI void attn_item(const u16* Q, int qstride, int qcol, int qrow0, const u16* Kb, int kstride, const u16* VT, int L,
                          int nkeys, u16* mixed, int mixcol, float lam, float postscale, const float* subg, char* smem) {
  constexpr int NQ = 2;
  const int tid = ltid(), lane = tid & 63, wid = tid >> 6, l16 = lane & 15, q4 = lane >> 4;
  const int qsub = wid & 1, var = wid >> 1;
  constexpr int KS = KW + 8;
  constexpr int STAGE = 64 * KS + DV * 72;
  u16* sK0 = (u16*)smem;
  u16* sV0 = sK0 + 64 * KS;
  u16* sK1 = sK0 + STAGE;
  u16* sV1 = sV0 + STAGE;
  constexpr int KPT = KW / 32, VPT = DV / 32, NDT = DV / 16;
  const int kfo = DIFF ? var * 64 : 0;

  bf16x8 qf[NQ][2];
#pragma unroll
  for (int q = 0; q < NQ; ++q) {
    const u16* qp = Q + (size_t)(qrow0 + qsub * 32 + q * 16 + l16) * qstride + qcol + var * 64 + q4 * 8;
    qf[q][0] = *(const bf16x8*)qp;
    qf[q][1] = *(const bf16x8*)(qp + 32);
  }

  u32x4 kr0[KPT], vr0[VPT];
  f32x4 o[NQ][NDT];
  float m[NQ], l[NQ];
#pragma unroll
  for (int q = 0; q < NQ; ++q) {
    m[q] = -INFINITY;
    l[q] = 0.f;
#pragma unroll
    for (int d = 0; d < NDT; ++d) o[q][d] = f32x4{0.f, 0.f, 0.f, 0.f};
  }
  const int nkb = nkeys >> 6;
#define SB0 __builtin_amdgcn_sched_barrier(0)
#define ACOMP(SK, SV) attn_compute<KW, DV, NQ>(SK, SV, kfo, l16, q4, qf, o, m, l)
  attn_gload<KW, DV>(Kb, kstride, VT, L, 0, tid, kr0, vr0);
  SB0;
  __syncthreads();
  attn_lstore<KW, DV>(sK0, sV0, tid, kr0, vr0);
  SB0;
  attn_gload<KW, DV>(Kb, kstride, VT, L, 1, tid, kr0, vr0);
  SB0;
  __syncthreads();
#pragma unroll 1
  for (int kb = 0; kb < nkb - 2; kb += 2) {
    SB0;
    attn_lstore<KW, DV>(sK1, sV1, tid, kr0, vr0);
    SB0;
    attn_gload<KW, DV>(Kb, kstride, VT, L, kb + 2, tid, kr0, vr0);
    SB0;
    ACOMP(sK0, sV0);
    __syncthreads();
    SB0;
    attn_lstore<KW, DV>(sK0, sV0, tid, kr0, vr0);
    SB0;
    attn_gload<KW, DV>(Kb, kstride, VT, L, kb + 3, tid, kr0, vr0);
    SB0;
    ACOMP(sK1, sV1);
    __syncthreads();
  }
  SB0;
  attn_lstore<KW, DV>(sK1, sV1, tid, kr0, vr0);
  SB0;
  ACOMP(sK0, sV0);
  __syncthreads();
  SB0;
  ACOMP(sK1, sV1);
  __syncthreads();
#undef SB0
#undef ACOMP
  float inv[NQ];
#pragma unroll
  for (int q = 0; q < NQ; ++q) {
    float lt = l[q];
    lt += shx(lt, 16);
    lt += shx(lt, 32);
    inv[q] = 1.f / lt;
  }
  if constexpr (DIFF) {
    float* sO = (float*)smem;
    if (var == 1) {
#pragma unroll
      for (int q = 0; q < NQ; ++q)
#pragma unroll
        for (int d = 0; d < NDT; ++d)
          *(f32x4*)(sO + (qsub * 32 + q * 16 + l16) * 132 + d * 16 + q4 * 4) = o[q][d] * inv[q];
    }
    __syncthreads();
    if (var == 0) {
      f32x4 ggv[NDT];
#pragma unroll
      for (int d = 0; d < NDT; ++d) ggv[d] = *(const f32x4*)(subg + d * 16 + q4 * 4);
#pragma unroll
      for (int q = 0; q < NQ; ++q) {
        const int row = qrow0 + qsub * 32 + q * 16 + l16;
        float ss = 0.f;
#pragma unroll
        for (int d = 0; d < NDT; ++d) {
          f32x4 o1 = *(const f32x4*)(sO + (qsub * 32 + q * 16 + l16) * 132 + d * 16 + q4 * 4);
          o[q][d] = o[q][d] * inv[q] - lam * o1;
          ss += o[q][d][0] * o[q][d][0] + o[q][d][1] * o[q][d][1] + o[q][d][2] * o[q][d][2] + o[q][d][3] * o[q][d][3];
        }
        ss += shx(ss, 16);
        ss += shx(ss, 32);
        const float rs = rsqrtf(ss * (1.f / 128.f) + 1e-6f) * postscale;
#pragma unroll
        for (int d = 0; d < NDT; ++d) {
          f32x4 v = o[q][d] * rs * ggv[d];
          u32x2 ov;
          ov.x = pack2(v.x, v.y);
          ov.y = pack2(v.z, v.w);
          *(u32x2*)(mixed + (size_t)row * 1024 + mixcol + d * 16 + q4 * 4) = ov;
        }
      }
    }
  } else {
#pragma unroll
    for (int q = 0; q < NQ; ++q) {
      const int row = qrow0 + qsub * 32 + q * 16 + l16;
#pragma unroll
      for (int d = 0; d < NDT; ++d) {
        f32x4 v = o[q][d] * inv[q];
        u32x2 ov;
        ov.x = pack2(v.x, v.y);
        ov.y = pack2(v.z, v.w);
        *(u32x2*)(mixed + (size_t)row * 1024 + mixcol + var * 64 + d * 16 + q4 * 4) = ov;
      }
    }
  }
}

DI void attnA_item(const P& p, int li, int it, char* smem) {
  const int lane = ltid() & 63;
  float d1 = p.in[14][li * 64 + lane] * p.in[15][li * 64 + lane];
  float d2 = p.in[16][li * 64 + lane] * p.in[17][li * 64 + lane];
#pragma unroll
  for (int s = 1; s < 64; s <<= 1) { d1 += shx(d1, s); d2 += shx(d2, s); }
  const float lam_init = 0.8f - 0.6f * expf(-0.3f * (float)li);
  const float lam = expf(d1) - expf(d2) + lam_init;
  const u16* QA = (const u16*)(p.ws + O_QA);
  u16* mixed = (u16*)(p.ws + O_MIXED);
  const float* subg = p.in[18] + li * 128;
  int qrow0, L;
  const u16 *Kb, *VT;
  int h;
  if (it < 128) {
    int b = it >> 6, qb = it & 15;
    h = (it >> 4) & 3;
    Kb = (const u16*)(p.ws + O_KALAT) + (size_t)(li * 2 + b) * 1536 * 512 + h * 128;
    VT = (const u16*)(p.ws + O_VTALAT) + (size_t)((li * 2 + b) * 4 + h) * 128 * 1536;
    qrow0 = NCTX + b * 1024 + qb * 64;
    L = 1536;
  } else {
    it -= 128;
    int b = it >> 4, qb = it & 3;
    h = (it >> 2) & 3;
    Kb = (const u16*)(p.ws + O_KACTX) + (size_t)b * 256 * 512 + h * 128;
    VT = (const u16*)(p.ws + O_VTACTX) + (size_t)(b * 4 + h) * 128 * 256;
    qrow0 = b * 256 + qb * 64;
    L = 256;
  }
  attn_item<128, 128, true>(QA, 512, h * 128, qrow0, Kb, 512, VT, L, L, mixed, h * 128, lam, 1.f - lam_init, subg, smem);
}
DI void attnC_item(const P& p, int li, int it, char* smem) {
  const u16* QC = (const u16*)(p.ws + O_QC);
  u16* mixed = (u16*)(p.ws + O_MIXED);
  int qrow0, L, n;
  const u16 *Kb, *VT;
  if (it < 64) {
    int b = it >> 5, qb = it & 15;
    n = (it >> 4) & 1;
    Kb = (const u16*)(p.ws + O_KCLAT) + (size_t)(li * 2 + b) * 1536 * 128 + n * 64;
    VT = (const u16*)(p.ws + O_VTCLAT) + (size_t)((li * 2 + b) * 2 + n) * 64 * 1536;
    qrow0 = NCTX + b * 1024 + qb * 64;
    L = 1536;
  } else {
    it -= 64;
    int b = it >> 3, qb = it & 3;
    n = (it >> 2) & 1;
    Kb = (const u16*)(p.ws + O_KCCTX) + (size_t)b * 256 * 128 + n * 64;
    VT = (const u16*)(p.ws + O_VTCCTX) + (size_t)(b * 2 + n) * 64 * 256;
    qrow0 = b * 256 + qb * 64;
    L = 256;
  }
  attn_item<64, 64, false>(QC, 256, n * 128, qrow0, Kb, 128, VT, L, L, mixed, 768 + n * 128, 0.f, 1.f, nullptr, smem);
}

DI void h1_item(const P& p, int item, char* smem) {
  const int tid = ltid(), lane = tid & 63, w = tid >> 6, l16 = lane & 15, q4 = lane >> 4;
  const int dir = item & 1, h = (item >> 1) & 3, tc = item >> 3;
  const int row0 = tc * 64;
  float* sQ = (float*)smem;
  float* sB = sQ + 64 * 68;
  float* sK = sB + 64 * 68;
  u16* sVT = (u16*)(sK + 64 * 68);
  float* sTot = (float*)(sVT + 64 * 72);
  const float* HQ = (const float*)(p.ws + O_HQ);
  const float* HG = (const float*)(p.ws + (dir ? O_HGB : O_HGF));
  const float* HI = (const float*)(p.ws + O_HI);
  float* OI = (float*)(p.ws + O_OI) + (size_t)dir * NTOK * 256;
  u16* QE = (u16*)(p.ws + O_QE) + (size_t)dir * NTOK * 256;
  float* KV = (float*)(p.ws + O_KV) + (size_t)item * 4096;
  float* DEC = (float*)(p.ws + O_DEC) + (size_t)item * 64;

  __syncthreads();
#pragma unroll
  for (int i = 0; i < 4; ++i) {
    int idx = tid + 256 * i;
    int lo = idx >> 4, c4 = idx & 15;
    int row = dir ? row0 + 63 - lo : row0 + lo;
    size_t off = (size_t)row * 256 + h * 64 + c4 * 4;
    *(float4*)(sQ + lo * 68 + c4 * 4) = *(const float4*)(HQ + off);
    *(float4*)(sB + lo * 68 + c4 * 4) = *(const float4*)(HG + off);
    float4 v = *(const float4*)(HI + off);
    sVT[(c4 * 4 + 0) * 72 + lo] = f2bf(v.x);
    sVT[(c4 * 4 + 1) * 72 + lo] = f2bf(v.y);
    sVT[(c4 * 4 + 2) * 72 + lo] = f2bf(v.z);
    sVT[(c4 * 4 + 3) * 72 + lo] = f2bf(v.w);
  }
  __syncthreads();
  {
    const int k = tid & 63, part = tid >> 6;
    float run = 0.f;
#pragma unroll 4
    for (int e = 0; e < 16; ++e) {
      int i = part * 16 + e;
      float g = sB[i * 68 + k];
      sK[i * 68 + k] = 1.f - ex2(g * LOG2E);
      run += g * LOG2E;
      sB[i * 68 + k] = run;
    }
    sTot[part * 64 + k] = run;
    __syncthreads();
    float add = 0.f;
    for (int pp = 0; pp < part; ++pp) add += sTot[pp * 64 + k];
    if (part > 0)
      for (int e = 0; e < 16; ++e) sB[(part * 16 + e) * 68 + k] += add;
  }
  __syncthreads();
#pragma unroll
  for (int i = 0; i < 4; ++i) {
    int idx = tid + 256 * i;
    int lo = idx >> 4, c4 = idx & 15;
    int row = dir ? row0 + 63 - lo : row0 + lo;
    f32x4 q = *(const f32x4*)(sQ + lo * 68 + c4 * 4);
    f32x4 bb = *(const f32x4*)(sB + lo * 68 + c4 * 4);
    u32x2 o;
    o.x = pack2(q.x * ex2(bb.x), q.y * ex2(bb.y));
    o.y = pack2(q.z * ex2(bb.z), q.w * ex2(bb.w));
    *(u32x2*)(QE + (size_t)row * 256 + h * 64 + c4 * 4) = o;
  }
  {
    const int I = w;
    bf16x8 qs[2];
    f32x4 rr[2][2];
#pragma unroll
    for (int s = 0; s < 2; ++s) {
      const int kk0 = s * 32 + q4 * 8;
      if (I > 0) {
        rr[s][0] = *(const f32x4*)(sB + (16 * I - 1) * 68 + kk0);
        rr[s][1] = *(const f32x4*)(sB + (16 * I - 1) * 68 + kk0 + 4);
      } else {
        rr[s][0] = f32x4{0.f, 0.f, 0.f, 0.f};
        rr[s][1] = rr[s][0];
      }
      const float* qr = sQ + (16 * I + l16) * 68 + kk0;
      const float* br = sB + (16 * I + l16) * 68 + kk0;
      f32x4 q0 = *(const f32x4*)qr, q1 = *(const f32x4*)(qr + 4);
      f32x4 b0 = *(const f32x4*)br, b1 = *(const f32x4*)(br + 4);
      u32x4 pu;
      pu.x = pack2(q0.x * ex2(b0.x - rr[s][0].x), q0.y * ex2(b0.y - rr[s][0].y));
      pu.y = pack2(q0.z * ex2(b0.z - rr[s][0].z), q0.w * ex2(b0.w - rr[s][0].w));
      pu.z = pack2(q1.x * ex2(b1.x - rr[s][1].x), q1.y * ex2(b1.y - rr[s][1].y));
      pu.w = pack2(q1.z * ex2(b1.z - rr[s][1].z), q1.w * ex2(b1.w - rr[s][1].w));
      qs[s] = __builtin_bit_cast(bf16x8, pu);
    }
    f32x4 at[4];
#pragma unroll
    for (int J = 0; J < 4; ++J) {
      at[J] = f32x4{0.f, 0.f, 0.f, 0.f};
      if (J <= I) {
#pragma unroll
        for (int s = 0; s < 2; ++s) {
          const int kk0 = s * 32 + q4 * 8;
          const float* kr = sK + (16 * J + l16) * 68 + kk0;
          const float* br = sB + (16 * J + l16) * 68 + kk0;
          f32x4 k0 = *(const f32x4*)kr, k1 = *(const f32x4*)(kr + 4);
          f32x4 b0 = *(const f32x4*)br, b1 = *(const f32x4*)(br + 4);
          u32x4 pu;
          pu.x = pack2(k0.x * ex2(fminf(rr[s][0].x - b0.x, 100.f)), k0.y * ex2(fminf(rr[s][0].y - b0.y, 100.f)));
          pu.y = pack2(k0.z * ex2(fminf(rr[s][0].z - b0.z, 100.f)), k0.w * ex2(fminf(rr[s][0].w - b0.w, 100.f)));
          pu.z = pack2(k1.x * ex2(fminf(rr[s][1].x - b1.x, 100.f)), k1.y * ex2(fminf(rr[s][1].y - b1.y, 100.f)));
          pu.w = pack2(k1.z * ex2(fminf(rr[s][1].z - b1.z, 100.f)), k1.w * ex2(fminf(rr[s][1].w - b1.w, 100.f)));
          bf16x8 kf = __builtin_bit_cast(bf16x8, pu);
          at[J] = MFMA16(kf, qs[s], at[J]);
        }
        if (J == I) {
#pragma unroll
          for (int r = 0; r < 4; ++r)
            if (q4 * 4 + r > l16) at[J][r] = 0.f;
        }
      }
    }
    f32x4 oc[4];
#pragma unroll
    for (int vt = 0; vt < 4; ++vt) oc[vt] = f32x4{0.f, 0.f, 0.f, 0.f};
#pragma unroll
    for (int ks = 0; ks < 2; ++ks) {
      if (2 * ks <= I) {
        u32x4 pu;
        pu.x = pack2(at[2 * ks][0], at[2 * ks][1]);
        pu.y = pack2(at[2 * ks][2], at[2 * ks][3]);
        pu.z = pack2(at[2 * ks + 1][0], at[2 * ks + 1][1]);
        pu.w = pack2(at[2 * ks + 1][2], at[2 * ks + 1][3]);
        bf16x8 pf = __builtin_bit_cast(bf16x8, pu);
#pragma unroll
        for (int vt = 0; vt < 4; ++vt) {
          const u16* vp = sVT + (vt * 16 + l16) * 72 + ks * 32 + q4 * 4;
          u32x2 v0 = *(const u32x2*)vp;
          u32x2 v1 = *(const u32x2*)(vp + 16);
          u32x4 vu = {v0.x, v0.y, v1.x, v1.y};
          oc[vt] = MFMA16(__builtin_bit_cast(bf16x8, vu), pf, oc[vt]);
        }
      }
    }
    {
      const int t = 16 * I + l16;
      const int row = dir ? row0 + 63 - t : row0 + t;
#pragma unroll
      for (int vt = 0; vt < 4; ++vt) *(f32x4*)(OI + (size_t)row * 256 + h * 64 + vt * 16 + q4 * 4) = oc[vt];
    }
  }
  {
    const int k = 16 * w + l16;
    const float bend = sB[63 * 68 + k];
    f32x4 kc[4];
#pragma unroll
    for (int vt = 0; vt < 4; ++vt) kc[vt] = f32x4{0.f, 0.f, 0.f, 0.f};
#pragma unroll
    for (int ks = 0; ks < 2; ++ks) {
      float kd[8];
#pragma unroll
      for (int j = 0; j < 8; ++j) {
        const int s = ks * 32 + q4 * 8 + j;
        kd[j] = sK[s * 68 + k] * ex2(bend - sB[s * 68 + k]);
      }
      u32x4 pu;
      pu.x = pack2(kd[0], kd[1]);
      pu.y = pack2(kd[2], kd[3]);
      pu.z = pack2(kd[4], kd[5]);
      pu.w = pack2(kd[6], kd[7]);
      bf16x8 af = __builtin_bit_cast(bf16x8, pu);
#pragma unroll
      for (int vt = 0; vt < 4; ++vt) {
        bf16x8 vf = *(const bf16x8*)(sVT + (vt * 16 + l16) * 72 + ks * 32 + q4 * 8);
        kc[vt] = MFMA16(af, vf, kc[vt]);
      }
    }
#pragma unroll
    for (int vt = 0; vt < 4; ++vt)
#pragma unroll
      for (int r = 0; r < 4; ++r) KV[(16 * w + q4 * 4 + r) * 64 + vt * 16 + l16] = kc[vt][r];
    if (q4 == 0) DEC[k] = ex2(bend);
  }
}

DI void h2_item(const P& p, int li, int item, char* smem) {
  const int tid = ltid(), ty = tid >> 4, tx = tid & 15;
  const int lane = tid & 63, w = tid >> 6, l16 = lane & 15, q4 = lane >> 4;
  const int h = item & 3, tc = item >> 2, row0 = tc * 64;
  const bool lat = tc >= 64;
  int seq, cl, nc;
  if (!lat) { seq = tc >> 2; cl = tc & 3; nc = 4; } else { seq = (tc - 64) >> 4; cl = (tc - 64) & 15; nc = 16; }
  const int tcbase = tc - cl;
  u16* sST = (u16*)smem;
  const float* KVb = (const float*)(p.ws + O_KV);
  const float* DECb = (const float*)(p.ws + O_DEC);
  __syncthreads();
#pragma unroll 1
  for (int dir = 0; dir < 2; ++dir) {
    float4 S[4];
#pragma unroll
    for (int a = 0; a < 4; ++a) {
      if (lat) S[a] = *(const float4*)(p.in[6 + dir] + ((size_t)((seq * 2 + li) * 4 + h) * 64 + ty + 16 * a) * 64 + tx * 4);
      else S[a] = make_float4(0.f, 0.f, 0.f, 0.f);
    }
    const int nprev = dir == 0 ? cl : nc - 1 - cl;
#pragma unroll 4
    for (int j = 0; j < nprev; ++j) {
      int tcj = tcbase + (dir == 0 ? j : nc - 1 - j);
      size_t itj = (size_t)((tcj * 4 + h) * 2 + dir);
#pragma unroll
      for (int a = 0; a < 4; ++a) {
        int k = ty + 16 * a;
        float dcy = DECb[itj * 64 + k];
        float4 kv = *(const float4*)(KVb + itj * 4096 + k * 64 + tx * 4);
        S[a].x = dcy * S[a].x + kv.x; S[a].y = dcy * S[a].y + kv.y; S[a].z = dcy * S[a].z + kv.z; S[a].w = dcy * S[a].w + kv.w;
      }
    }
    if (!lat && nprev == nc - 1) {
      size_t itj = (size_t)((tc * 4 + h) * 2 + dir);
      float* so = p.out + (dir == 0 ? OUT_SF : OUT_SB) + (size_t)((seq * 2 + li) * 4 + h) * 4096;
#pragma unroll
      for (int a = 0; a < 4; ++a) {
        int k = ty + 16 * a;
        float dcy = DECb[itj * 64 + k];
        float4 kv = *(const float4*)(KVb + itj * 4096 + k * 64 + tx * 4);
        *(float4*)(so + k * 64 + tx * 4) = make_float4(dcy * S[a].x + kv.x, dcy * S[a].y + kv.y, dcy * S[a].z + kv.z, dcy * S[a].w + kv.w);
      }
    }
    u16* st = sST + dir * 64 * 72;
#pragma unroll
    for (int a = 0; a < 4; ++a) {
      int k = ty + 16 * a;
      st[(tx * 4 + 0) * 72 + k] = f2bf(S[a].x);
      st[(tx * 4 + 1) * 72 + k] = f2bf(S[a].y);
      st[(tx * 4 + 2) * 72 + k] = f2bf(S[a].z);
      st[(tx * 4 + 3) * 72 + k] = f2bf(S[a].w);
    }
  }
  __syncthreads();
  f32x4 oc[4];
#pragma unroll
  for (int vt = 0; vt < 4; ++vt) oc[vt] = f32x4{0.f, 0.f, 0.f, 0.f};
#pragma unroll
  for (int dir = 0; dir < 2; ++dir) {
    const u16* QE = (const u16*)(p.ws + O_QE) + (size_t)dir * NTOK * 256 + (size_t)(row0 + 16 * w + l16) * 256 + h * 64 + q4 * 8;
    const u16* st = sST + dir * 64 * 72;
#pragma unroll
    for (int ks = 0; ks < 2; ++ks) {
      bf16x8 af = *(const bf16x8*)(QE + ks * 32);
#pragma unroll
      for (int vt = 0; vt < 4; ++vt) {
        bf16x8 bf = *(const bf16x8*)(st + (vt * 16 + l16) * 72 + ks * 32 + q4 * 8);
        oc[vt] = MFMA16(af, bf, oc[vt]);
      }
    }
  }
  const float* OI0 = (const float*)(p.ws + O_OI);
  const float* OI1 = OI0 + (size_t)NTOK * 256;
  const float* HSG = (const float*)(p.ws + O_HSG);
  u16* mixed = (u16*)(p.ws + O_MIXED);
  float gn[4];
#pragma unroll
  for (int vt = 0; vt < 4; ++vt) gn[vt] = p.in[21][li * 64 + vt * 16 + l16];
  float oi[4][4], sgv[4][4];
#pragma unroll
  for (int r = 0; r < 4; ++r) {
    const size_t off = (size_t)(row0 + 16 * w + q4 * 4 + r) * 256 + h * 64 + l16;
#pragma unroll
    for (int vt = 0; vt < 4; ++vt) {
      oi[r][vt] = OI0[off + vt * 16] + OI1[off + vt * 16];
      sgv[r][vt] = HSG[off + vt * 16];
    }
  }
#pragma unroll
  for (int r = 0; r < 4; ++r) {
    const int row = row0 + 16 * w + q4 * 4 + r;
    float val[4];
    float ss = 0.f;
#pragma unroll
    for (int vt = 0; vt < 4; ++vt) {
      val[vt] = oc[vt][r] + oi[r][vt];
      ss += val[vt] * val[vt];
    }
    ss = red16(ss);
    const float rs = rsqrtf(ss * (1.f / 64.f) + 1e-6f);
#pragma unroll
    for (int vt = 0; vt < 4; ++vt)
      mixed[(size_t)row * 1024 + 512 + h * 64 + vt * 16 + l16] = f2bf(val[vt] * rs * gn[vt] * sgv[r][vt]);
  }
}

DI void row_stats(float2 slot, float& mu, float& rs) {
  float s1 = red16(slot.x), s2 = red16(slot.y);
  s1 = __builtin_bit_cast(float, __builtin_amdgcn_readfirstlane(__builtin_bit_cast(int, s1)));
  s2 = __builtin_bit_cast(float, __builtin_amdgcn_readfirstlane(__builtin_bit_cast(int, s2)));
  mu = s1 * (1.f / 1024.f);
  rs = rsqrtf(fmaxf(s2 * (1.f / 1024.f) - mu * mu, 0.f) + 1e-6f);
}

DI void ln_apply(const P& p, const float* lo, const float* hi, const float* stats, const float* lng, const float* lnb,
                 const float* mods, int sc_off, int sh_off) {
  const int lane = ltid() & 63, wid = ltid() >> 6;
  u16* dst = (u16*)(p.ws + O_ABF);
  f32x4 ggv[4], bbv[4];
#pragma unroll
  for (int i = 0; i < 4; ++i) {
    ggv[i] = f32x4{1.f, 1.f, 1.f, 1.f};
    bbv[i] = f32x4{0.f, 0.f, 0.f, 0.f};
    if (stats != nullptr) {
      ggv[i] = *(const f32x4*)(lng + (lane + 64 * i) * 4);
      bbv[i] = *(const f32x4*)(lnb + (lane + 64 * i) * 4);
    }
  }
  int it = blockIdx.x;
  f32x4 xn[4];
  float2 stn = make_float2(0.f, 0.f);
  if (it < NTOK / 4) {
    const int row = it * 4 + wid;
    const float* x = row < NCTX ? lo + (size_t)row * 1024 : hi + (size_t)(row - NCTX) * 1024;
#pragma unroll
    for (int i = 0; i < 4; ++i) xn[i] = *(const f32x4*)(x + (lane + 64 * i) * 4);
    if (stats != nullptr && lane < 16) stn = *(const float2*)(stats + (size_t)row * 32 + lane * 2);
  }
  while (it < NTOK / 4) {
    const int row = it * 4 + wid;
    f32x4 xv[4];
#pragma unroll
    for (int i = 0; i < 4; ++i) xv[i] = xn[i];
    const float2 stc = stn;
    const int itn = it + gridDim.x;
    if (itn < NTOK / 4) {
      const int rown = itn * 4 + wid;
      const float* x = rown < NCTX ? lo + (size_t)rown * 1024 : hi + (size_t)(rown - NCTX) * 1024;
#pragma unroll
      for (int i = 0; i < 4; ++i) xn[i] = *(const f32x4*)(x + (lane + 64 * i) * 4);
      stn = make_float2(0.f, 0.f);
      if (stats != nullptr && lane < 16) stn = *(const float2*)(stats + (size_t)rown * 32 + lane * 2);
    }
    float mu = 0.f, rs = 1.f;
    if (stats != nullptr) row_stats(stc, mu, rs);
    const int rtype = row < NCTX ? 0 : 1 + ((row - NCTX) >> 10);
    const float* mv = mods + rtype * 6144;
    f32x4 scv[4], shv[4];
#pragma unroll
    for (int i = 0; i < 4; ++i) {
      scv[i] = *(const f32x4*)(mv + sc_off + (lane + 64 * i) * 4);
      shv[i] = *(const f32x4*)(mv + sh_off + (lane + 64 * i) * 4);
    }
#pragma unroll
    for (int i = 0; i < 4; ++i) {
      const int c = (lane + 64 * i) * 4;
      f32x4 v = (xv[i] - mu) * rs * ggv[i] + bbv[i];
      v = v * (scv[i] + 1.f) + shv[i];
      u32x2 o;
      o.x = pack2(v.x, v.y);
      o.y = pack2(v.z, v.w);
      *(u32x2*)(dst + (size_t)row * 1024 + c) = o;
    }
    it = itn;
  }
}

DI void final_ln(const P& p) {
  const int lane = ltid() & 63, wid = ltid() >> 6;
  const float* X = (const float*)(p.ws + O_XPRE2);
  const float* ST = (const float*)(p.ws + O_ST2);
  f32x4 gv[4], bv[4];
#pragma unroll
  for (int i = 0; i < 4; ++i) {
    gv[i] = *(const f32x4*)(p.in[26] + 1024 + (lane + 64 * i) * 4);
    bv[i] = *(const f32x4*)(p.in[27] + 1024 + (lane + 64 * i) * 4);
  }
  int it = blockIdx.x;
  f32x4 xn[4];
  float2 stn = make_float2(0.f, 0.f);
  if (it < NTOK / 4) {
    const int row = it * 4 + wid;
#pragma unroll
    for (int i = 0; i < 4; ++i) xn[i] = *(const f32x4*)(X + (size_t)row * 1024 + (lane + 64 * i) * 4);
    if (lane < 16) stn = *(const float2*)(ST + (size_t)row * 32 + lane * 2);
  }
  while (it < NTOK / 4) {
    const int row = it * 4 + wid;
    f32x4 xv[4];
#pragma unroll
    for (int i = 0; i < 4; ++i) xv[i] = xn[i];
    const float2 stc = stn;
    const int itn = it + gridDim.x;
    if (itn < NTOK / 4) {
      const int rown = itn * 4 + wid;
#pragma unroll
      for (int i = 0; i < 4; ++i) xn[i] = *(const f32x4*)(X + (size_t)rown * 1024 + (lane + 64 * i) * 4);
      stn = make_float2(0.f, 0.f);
      if (lane < 16) stn = *(const float2*)(ST + (size_t)rown * 32 + lane * 2);
    }
    float mu, rs;
    row_stats(stc, mu, rs);
    float* out = p.out + (row < NCTX ? OUT_YP + (size_t)row * 1024 : OUT_YS + (size_t)(row - NCTX) * 1024);
#pragma unroll
    for (int i = 0; i < 4; ++i) *(f32x4*)(out + (lane + 64 * i) * 4) = (xv[i] - mu) * rs * gv[i] + bv[i];
    it = itn;
  }
}

DI void run_phase(const P& p, int ph, char* smem, int sub = 0) {
  if (ph == 0) { phase0(p, smem); return; }
  if (ph == NPHASE - 1) { final_ln(p); return; }
  const int li = (ph - 1) >> 3, s = (ph - 1) & 7;
  float* XPRE1 = (float*)(p.ws + O_XPRE1);
  float* XPRE2 = (float*)(p.ws + O_XPRE2);
  float* ST1 = (float*)(p.ws + O_ST1);
  float* ST2 = (float*)(p.ws + O_ST2);
  GA g;
  g.mods = (const float*)(p.ws + O_MODS) + li * 3 * 6144;
  g.a16 = (const u16*)(p.ws + O_ABF); g.xout = nullptr; g.sout = nullptr; g.hid = nullptr;
  g.alo = nullptr; g.ahi = nullptr; g.stats = nullptr; g.lng = nullptr; g.lnb = nullptr; g.sc_off = 0; g.sh_off = 0;
  const float* xin_lo = li == 0 ? p.in[0] : XPRE2;
  const float* xin_hi = li == 0 ? p.in[1] : XPRE2 + (size_t)NCTX * 1024;
  const float* xin_st = li == 0 ? nullptr : ST2;
  const float* xin_g = p.in[26] + (li == 0 ? 0 : (li - 1) * 1024);
  const float* xin_b = p.in[27] + (li == 0 ? 0 : (li - 1) * 1024);
  if (s == 0) {
#if !MULTI_LAUNCH
    if (li == 0) return;
#endif
    ln_apply(p, xin_lo, xin_hi, xin_st, xin_g, xin_b, g.mods, 1024, 0);
  } else if (s == 1) {
    g.bt = (const u16*)(p.ws + O_WTIN) + (size_t)li * NIN * D; g.K = D; g.N = NIN;
    gemm_phase<0>(p, g, li, smem);
    if (li == 0) {
      const int xcd = blockIdx.x & 7, lb = blockIdx.x >> 3, nlb = gridDim.x >> 3;
      const int busy = 6 * (NIN >> 7) - 2 * nlb;
      if (nlb == 64 && lb >= busy) run_transposes(p, smem, (lb - busy) * 8 + xcd, (nlb - busy) * 8, 1);
      else if (nlb != 64) run_transposes(p, smem, blockIdx.x, gridDim.x, 1);
    }
  } else if (s == 2) {
    if (gridDim.x == 512 && sub == 0) {
      const int b = blockIdx.x;
      if (b < 128) {
        attnA_item(p, li, b, smem);
      } else if (b < 192) {
        attnC_item(p, li, b - 128, smem);
        h1_item(p, b - 128, smem);
      } else {
        const int j = b - 192;
        h1_item(p, 64 + j, smem);
        h1_item(p, 64 + 320 + j, smem);
        if (j < 64) h1_item(p, 64 + 640 + j, smem);
        else attnA_item(p, li, 128 + (j - 64), smem);
        run_transposes(p, smem, j, 320, 2 + li);
      }
    } else {
      if (sub == 0) run_transposes(p, smem, blockIdx.x, gridDim.x, 2 + li);
      const int it_lo = sub == 2 ? 128 : (sub == 3 ? 192 : (sub == 4 ? 960 : 0)), it_hi = sub == 1 ? 128 : (sub == 2 ? 192 : (sub == 3 ? 960 : 1216));
      for (int it = it_lo + blockIdx.x; it < it_hi; it += gridDim.x) {
        if (it >= 192 && it < 960) h1_item(p, it - 192, smem);
        else if (it >= 128 && it < 192) attnC_item(p, li, it - 128, smem);
        else attnA_item(p, li, it < 128 ? it : it - 832, smem);
      }
    }
  } else if (s == 3) {
    for (int it = blockIdx.x; it < 512; it += gridDim.x) {
      if (it < 384) h2_item(p, li, it, smem);
      else attnC_item(p, li, it - 384 + 64, smem);
    }
  } else if (s == 4) {
    g.alo = xin_lo; g.ahi = xin_hi; g.stats = xin_st; g.lng = xin_g; g.lnb = xin_b;
    g.sc_off = 2048;
    g.a16 = (const u16*)(p.ws + O_MIXED);
    g.bt = (const u16*)(p.ws + O_WTOUT) + (size_t)li * D * D; g.K = D; g.N = D;
    g.xout = XPRE1; g.sout = ST1;
    gemm_phase<1, 3>(p, g, li, smem);
  } else if (s == 5) {
    ln_apply(p, XPRE1, XPRE1 + (size_t)NCTX * 1024, ST1, p.in[24] + li * 1024, p.in[25] + li * 1024, g.mods, 4096, 3072);
  } else if (s == 6) {
    g.bt = (const u16*)(p.ws + O_WTFF1) + (size_t)li * DFF * D; g.K = D; g.N = DFF;
    g.hid = (u16*)(p.ws + O_HID);
    gemm_phase<2>(p, g, li, smem);
  } else {
    g.alo = XPRE1; g.ahi = XPRE1 + (size_t)NCTX * 1024; g.stats = ST1; g.lng = p.in[24] + li * 1024; g.lnb = p.in[25] + li * 1024;
    g.sc_off = 5120;
    g.a16 = (const u16*)(p.ws + O_HID);
    g.bt = (const u16*)(p.ws + O_WTFF2) + (size_t)li * D * DFF; g.K = DFF; g.N = D;
    g.xout = XPRE2; g.sout = ST2;
    gemm_phase<1, 3>(p, g, li, smem);
  }
}

#define XB_TMO      128
#define XB_XCNT(j)  (256  + 64 * (j))
#define XB_XSUB(j)  (1280 + 64 * (j))
#define XB_XGEN(j)  (2304 + 64 * (j))
#define XB_TOP      3328
#define XB_TOPGEN   3392
#define XCD_BAR_WORDS 3456
#define XB_SPIN_CAP (1u << 20)
#define LAS __attribute__((address_space(3)))
DI unsigned xb_ld(unsigned* p) { return __hip_atomic_load(p, __ATOMIC_RELAXED, __HIP_MEMORY_SCOPE_AGENT); }
DI unsigned xb_add(unsigned* p, unsigned v) { return __hip_atomic_fetch_add(p, v, __ATOMIC_RELAXED, __HIP_MEMORY_SCOPE_AGENT); }
DI unsigned xb_xcc_id() { return (unsigned)__builtin_amdgcn_s_getreg((3 << 11) | 20) & 0xFu; }
#define XB_SPIN(cond, bar) do { unsigned _sp = 0; while (cond) { __builtin_amdgcn_s_sleep(1); \
    if ((++_sp & 255u) == 0u) { if (xb_ld(&(bar)[XB_TMO])) break; if (_sp > XB_SPIN_CAP) { atomicAdd(&(bar)[XB_TMO], 1u); break; } } } } while (0)
struct XcdBarrier { unsigned* bar; unsigned x; volatile LAS unsigned* st; };
DI XcdBarrier xcd_barrier_post(unsigned* bar, volatile LAS unsigned* st) {
  XcdBarrier b; b.bar = bar; b.x = xb_xcc_id(); b.st = st;
  if (threadIdx.x == 0) (void)xb_add(&bar[XB_XCNT(b.x)], 1u);
  return b;
}
DI void xcd_barrier_complete(unsigned* bar, unsigned x, unsigned& nloc, unsigned& nx) {
  const unsigned G = gridDim.x * gridDim.y * gridDim.z;
  unsigned sum, cnt, mine, sp = 0u;
  for (;;) {
    sum = 0u; cnt = 0u; mine = 0u;
#pragma unroll
    for (unsigned j = 0; j < 16; ++j) { const unsigned c = xb_ld(&bar[XB_XCNT(j)]); sum += c; cnt += (c > 0u) ? 1u : 0u; mine = (j == x) ? c : mine; }
    if (sum == G) break;
    __builtin_amdgcn_s_sleep(1);
    if ((++sp & 255u) == 0u) { if (xb_ld(&bar[XB_TMO])) break; if (sp > XB_SPIN_CAP) { atomicAdd(&bar[XB_TMO], 1u); break; } }
  }
  nloc = mine > 0u ? mine : 1u; nx = cnt > 0u ? cnt : 1u;
}
DI void xcd_barrier(const XcdBarrier& b) {
  asm volatile("s_waitcnt vmcnt(0)" ::: "memory");
  __syncthreads();
  if (threadIdx.x == 0) {
    unsigned* bar = b.bar;
    __builtin_amdgcn_s_waitcnt(0);
    unsigned nloc = b.st[0], nx = b.st[1];
    if (nloc == 0u) { xcd_barrier_complete(bar, b.x, nloc, nx); b.st[0] = nloc; b.st[1] = nx; }
    const unsigned old = xb_add(&bar[XB_XSUB(b.x)], 1u);
    const unsigned gen = old / nloc;
    if (old + 1u == (gen + 1u) * nloc) {
      __builtin_amdgcn_fence(__ATOMIC_RELEASE, "agent");
      asm volatile("s_waitcnt vmcnt(0)" ::: "memory");
      const unsigned og = xb_add(&bar[XB_TOP], 1u);
      const unsigned tg = og / nx;
      if (og + 1u == (tg + 1u) * nx) xb_add(&bar[XB_TOPGEN], 1u);
      else XB_SPIN(xb_ld(&bar[XB_TOPGEN]) == tg, bar);
      __builtin_amdgcn_fence(__ATOMIC_ACQUIRE, "agent");
      xb_add(&bar[XB_XGEN(b.x)], 1u);
      asm volatile("s_waitcnt vmcnt(0)" ::: "memory");
    } else {
      XB_SPIN(xb_ld(&bar[XB_XGEN(b.x)]) == gen, bar);
      __builtin_amdgcn_fence(__ATOMIC_ACQUIRE, "agent");
      asm volatile("s_waitcnt vmcnt(0)" ::: "memory");
    }
  }
  __syncthreads();
}
constexpr size_t O_BAR = O_END1;
static_assert(O_BAR + XCD_BAR_WORDS * 4 <= (size_t)256 * 1024 * 1024, "barrier words must fit");

#if !MULTI_LAUNCH
__global__ void __launch_bounds__(256, 2) mega_kernel(P p) {
  extern __shared__ __attribute__((aligned(16))) char smem[];
  cg::grid_group grid = cg::this_grid();
  if (p.ws == nullptr) grid.sync();
  if (threadIdx.x == 0) *(uint4*)(smem + LDS_BYTES - 16) = make_uint4(0u, 0u, 0u, 0u);
  __syncthreads();
  XcdBarrier xb = xcd_barrier_post((unsigned*)(p.ws + O_BAR), (volatile LAS unsigned*)(smem + LDS_BYTES - 16));
  run_phase(p, 0, smem); xcd_barrier(xb);
  run_phase(p, 2, smem); xcd_barrier(xb);
  run_phase(p, 3, smem); xcd_barrier(xb);
  run_phase(p, 4, smem); xcd_barrier(xb);
  run_phase(p, 5, smem); xcd_barrier(xb);
  run_phase(p, 6, smem); xcd_barrier(xb);
  run_phase(p, 7, smem); xcd_barrier(xb);
  run_phase(p, 8, smem); xcd_barrier(xb);
  run_phase(p, 9, smem); xcd_barrier(xb);
  run_phase(p, 10, smem); xcd_barrier(xb);
  run_phase(p, 11, smem); xcd_barrier(xb);
  run_phase(p, 12, smem); xcd_barrier(xb);
  run_phase(p, 13, smem); xcd_barrier(xb);
  run_phase(p, 14, smem); xcd_barrier(xb);
  run_phase(p, 15, smem); xcd_barrier(xb);
  run_phase(p, 16, smem); xcd_barrier(xb);
  run_phase(p, 17, smem);
}
#define MAIN_KERNEL mega_kernel
#else
template <int PH>
__global__ void __launch_bounds__(256, 2) phase_kernel(P p, int sub) {
  extern __shared__ __attribute__((aligned(16))) char smem[];
  run_phase(p, PH, smem, sub);
}
typedef void (*phase_fn)(P, int);
static phase_fn phase_table[NPHASE] = {phase_kernel<0>, phase_kernel<1>, phase_kernel<2>, phase_kernel<3>, phase_kernel<4>, phase_kernel<5>,
                                       phase_kernel<6>, phase_kernel<7>, phase_kernel<8>, phase_kernel<9>, phase_kernel<10>, phase_kernel<11>,
                                       phase_kernel<12>, phase_kernel<13>, phase_kernel<14>, phase_kernel<15>, phase_kernel<16>, phase_kernel<17>};
#define MAIN_KERNEL phase_kernel<2>
#endif

extern "C" void kernel_launch(void* const* d_in, const int* in_sizes, int n_in, void* d_out, int out_size, void* d_ws,
                              size_t ws_size, hipStream_t stream) {
  static int grid_blocks = 0;
  if (!grid_blocks) {
    int dev = 0, cus = 0, per_cu = 0;
    (void)hipGetDevice(&dev);
    (void)hipDeviceGetAttribute(&cus, hipDeviceAttributeMultiprocessorCount, dev);
    (void)hipFuncSetAttribute((const void*)MAIN_KERNEL, hipFuncAttributeMaxDynamicSharedMemorySize, LDS_BYTES);
    (void)hipOccupancyMaxActiveBlocksPerMultiprocessor(&per_cu, MAIN_KERNEL, 256, LDS_BYTES);
    if (per_cu > 2) per_cu = 2;
    if (per_cu < 1) per_cu = 1;
    grid_blocks = cus * per_cu;
  }
  P p{};
  for (int i = 0; i < 30; ++i) p.in[i] = (const float*)d_in[i];
  p.out = (float*)d_out;
  p.ws = (char*)d_ws;
#if MULTI_LAUNCH
  for (int ph = 0; ph < NPHASE; ++ph) {
    (void)hipFuncSetAttribute((const void*)phase_table[ph], hipFuncAttributeMaxDynamicSharedMemorySize, LDS_BYTES);
    phase_table[ph]<<<dim3(grid_blocks), dim3(256), LDS_BYTES, stream>>>(p, 0);
#ifdef DUP_MASK
    int bit = (ph == 0) ? 8 : (ph == NPHASE - 1 ? 9 : (ph - 1) & 7);
    if ((DUP_MASK >> bit) & 1) phase_table[ph]<<<dim3(grid_blocks), dim3(256), LDS_BYTES, stream>>>(p, DUP_SUB);
#endif
  }
#else
  (void)hipMemsetAsync((char*)d_ws + O_BAR, 0, 16384 + CNT_BYTES, stream);
  void* args[] = {&p};
  hipError_t e = hipLaunchCooperativeKernel((void*)mega_kernel, dim3(grid_blocks), dim3(256), args, LDS_BYTES, stream);
  if (e != hipSuccess) fprintf(stderr, "cooperative launch failed: %s (grid %d)\n", hipGetErrorString(e), grid_blocks);
#endif
}
```

```cpp
#include <hip/hip_runtime.h>
#include <hip/hip_cooperative_groups.h>
#include <stdint.h>
#include <stdio.h>
namespace cg = cooperative_groups;

#ifndef MULTI_LAUNCH
#define MULTI_LAUNCH 0
#endif

#define DI __device__ __forceinline__
typedef unsigned short u16;
using bf16x8 = __attribute__((ext_vector_type(8))) short;
using f32x4 = __attribute__((ext_vector_type(4))) float;
typedef __bf16 bf2_t __attribute__((ext_vector_type(2)));
typedef float f2_t __attribute__((ext_vector_type(2)));
typedef unsigned u32x4 __attribute__((ext_vector_type(4)));
typedef unsigned u32x2 __attribute__((ext_vector_type(2)));

constexpr int D = 1024, NTOK = 6144, NCTX = 4096, NIN = 3328, DFF = 4096;
constexpr float ALPHA = 1.41421356237309515f;
constexpr float LOG2E = 1.44269504088896341f;
constexpr int LDS_BYTES = 75776;
constexpr int NPHASE = 18;

constexpr size_t O_WTIN = 0;
constexpr size_t O_WTOUT = O_WTIN + (size_t)2 * NIN * D * 2;
constexpr size_t O_WTFF1 = O_WTOUT + (size_t)2 * D * D * 2;
constexpr size_t O_WTFF2 = O_WTFF1 + (size_t)2 * DFF * D * 2;
constexpr size_t O_MODS = O_WTFF2 + (size_t)2 * D * DFF * 2;
constexpr size_t O_ROPE = O_MODS + (size_t)2 * 3 * 6144 * 4;
constexpr size_t O_QA = O_ROPE + (size_t)1024 * 32 * 2 * 4;
constexpr size_t O_KACTX = O_QA + (size_t)NTOK * 512 * 2;
constexpr size_t O_KALAT = O_KACTX + (size_t)NCTX * 512 * 2;
constexpr size_t O_VTACTX = O_KALAT + (size_t)2 * 2 * 1536 * 512 * 2;
constexpr size_t O_VTALAT = O_VTACTX + (size_t)16 * 4 * 128 * 256 * 2;
constexpr size_t O_QC = O_VTALAT + (size_t)2 * 2 * 4 * 128 * 1536 * 2;
constexpr size_t O_KCCTX = O_QC + (size_t)NTOK * 256 * 2;
constexpr size_t O_KCLAT = O_KCCTX + (size_t)NCTX * 128 * 2;
constexpr size_t O_VTCCTX = O_KCLAT + (size_t)2 * 2 * 1536 * 128 * 2;
constexpr size_t O_VTCLAT = O_VTCCTX + (size_t)16 * 2 * 64 * 256 * 2;
constexpr size_t O_KV = O_VTCLAT + (size_t)2 * 2 * 2 * 64 * 1536 * 2;
constexpr size_t O_DEC = O_KV + (size_t)768 * 4096 * 4;
constexpr size_t O_MIXED = O_DEC + (size_t)768 * 64 * 4;
constexpr size_t O_XPRE1 = O_MIXED + (size_t)NTOK * 1024 * 2;
constexpr size_t O_ST1 = O_XPRE1 + (size_t)NTOK * 1024 * 4;
constexpr size_t O_XPRE2 = O_ST1 + (size_t)NTOK * 32 * 4;
constexpr size_t O_ST2 = O_XPRE2 + (size_t)NTOK * 1024 * 4;
constexpr size_t O_ABF = O_ST2 + (size_t)NTOK * 32 * 4;
constexpr size_t O_HQ = O_ABF + (size_t)NTOK * 1024 * 2;
constexpr size_t O_HGF = O_HQ + (size_t)NTOK * 256 * 4;
constexpr size_t O_HGB = O_HGF + (size_t)NTOK * 256 * 4;
constexpr size_t O_HI = O_HGB + (size_t)NTOK * 256 * 4;
constexpr size_t O_HSG = O_HI + (size_t)NTOK * 256 * 4;
constexpr size_t O_OI = O_HSG + (size_t)NTOK * 256 * 4;
constexpr size_t O_QE = O_OI + (size_t)2 * NTOK * 256 * 4;
constexpr size_t O_END1 = O_QE + (size_t)2 * NTOK * 256 * 4;
constexpr size_t O_CNT = O_END1 + 16384;
constexpr size_t CNT_BYTES = 2048;
static_assert(O_CNT + CNT_BYTES <= (size_t)256 * 1024 * 1024, "counters must fit");
constexpr size_t O_HID = O_HQ;
constexpr size_t O_END2 = O_HID + (size_t)NTOK * 4096 * 2;
static_assert(O_END2 <= O_END1, "HID alias must fit");
static_assert(O_END1 <= (size_t)256 * 1024 * 1024, "workspace too big");

constexpr size_t OUT_YP = 0, OUT_YS = 4194304, OUT_AK = 6291456, OUT_AV = 10485760, OUT_CK = 14680064,
                 OUT_CV = 15728640, OUT_SF = 16777216, OUT_SB = 17301504;

struct P {
  const float* in[30];
  float* out;
  char* ws;
};

DI unsigned pack2(float a, float b) {
  f2_t v = {a, b};
  bf2_t r = __builtin_convertvector(v, bf2_t);
  return __builtin_bit_cast(unsigned, r);
}
DI u16 f2bf(float x) { return (u16)(pack2(x, 0.f) & 0xffffu); }
DI float ex2(float x) { return __builtin_amdgcn_exp2f(x); }
DI float siluf(float x) { return x / (1.f + expf(-x)); }
DI float shx(float v, int m) { return __shfl_xor(v, m, 64); }
DI float red16(float x) {
  x += __builtin_bit_cast(float, __builtin_amdgcn_update_dpp(0, __builtin_bit_cast(int, x), 0xB1, 0xF, 0xF, true));
  x += __builtin_bit_cast(float, __builtin_amdgcn_update_dpp(0, __builtin_bit_cast(int, x), 0x4E, 0xF, 0xF, true));
  x += __builtin_bit_cast(float, __builtin_amdgcn_update_dpp(0, __builtin_bit_cast(int, x), 0x141, 0xF, 0xF, true));
  x += __builtin_bit_cast(float, __builtin_amdgcn_update_dpp(0, __builtin_bit_cast(int, x), 0x140, 0xF, 0xF, true));
  return x;
}
DI float xor1(float x) { return __builtin_bit_cast(float, __builtin_amdgcn_update_dpp(0, __builtin_bit_cast(int, x), 0xB1, 0xF, 0xF, true)); }
DI int ltid() { int t = threadIdx.x; asm volatile("" : "+v"(t)); return t; }
#define MFMA16(a, b, c) __builtin_amdgcn_mfma_f32_16x16x32_bf16((a), (b), (c), 0, 0, 0)

DI void p0_mod(const P& p, int item, char* smem) {
  float* ssilu = (float*)smem;
  float* red = ssilu + 3072;
  const int tid = ltid();
  __syncthreads();
  for (int i = tid; i < 3072; i += 256) {
    int w = i >> 10, k = i & 1023;
    float v = (w == 0) ? p.in[9][k] : p.in[8][(w - 1) * 1024 + k];
    ssilu[i] = siluf(v);
  }
  __syncthreads();
  const int li = item / 96, j0 = (item % 96) * 64;
  const int c4 = tid & 15, kp = tid >> 4;
  const float* W = p.in[10] + (size_t)li * 1024 * 6144 + j0 + c4 * 4;
  float4 a0 = {0, 0, 0, 0}, a1 = a0, a2 = a0;
#pragma unroll 16
  for (int kk = 0; kk < 64; ++kk) {
    int k = kp * 64 + kk;
    float4 w4 = *(const float4*)(W + (size_t)k * 6144);
    float s0 = ssilu[k], s1 = ssilu[1024 + k], s2 = ssilu[2048 + k];
    a0.x += s0 * w4.x; a0.y += s0 * w4.y; a0.z += s0 * w4.z; a0.w += s0 * w4.w;
    a1.x += s1 * w4.x; a1.y += s1 * w4.y; a1.z += s1 * w4.z; a1.w += s1 * w4.w;
    a2.x += s2 * w4.x; a2.y += s2 * w4.y; a2.z += s2 * w4.z; a2.w += s2 * w4.w;
  }
  *(float4*)(red + (kp * 3 + 0) * 64 + c4 * 4) = a0;
  *(float4*)(red + (kp * 3 + 1) * 64 + c4 * 4) = a1;
  *(float4*)(red + (kp * 3 + 2) * 64 + c4 * 4) = a2;
  __syncthreads();
  if (tid < 192) {
    int w = tid >> 6, c = tid & 63;
    float s = p.in[11][li * 6144 + j0 + c];
    for (int q = 0; q < 16; ++q) s += red[(q * 3 + w) * 64 + c];
    ((float*)(p.ws + O_MODS))[(li * 3 + w) * 6144 + j0 + c] = s;
  }
#if !MULTI_LAUNCH
  if (li == 0 && j0 < 2048) {
    asm volatile("s_waitcnt vmcnt(0)" ::: "memory");
    __syncthreads();
    if (tid == 0) {
      __builtin_amdgcn_fence(__ATOMIC_RELEASE, "agent");
      asm volatile("s_waitcnt vmcnt(0)" ::: "memory");
      (void)__hip_atomic_fetch_add((unsigned*)(p.ws + O_CNT), 1u, __ATOMIC_RELAXED, __HIP_MEMORY_SCOPE_AGENT);
    }
  }
#endif
}

DI void p0_rope(const P& p, int item) {
  float* R = (float*)(p.ws + O_ROPE);
  for (int i = ltid(); i < 4096; i += 256) {
    int idx = item * 4096 + i;
    int t = idx >> 5, pp = idx & 31;
    float inv = powf(10000.f, -(float)(pp & 15) / 16.f);
    float pos = (pp < 16) ? (float)(t >> 6) : (float)(t & 63);
    float ang = pos * inv;
    R[idx * 2] = cosf(ang);
    R[idx * 2 + 1] = sinf(ang);
  }
}

DI void p0_copyk(const P& p, int item, bool isA) {
  const int W = isA ? 512 : 128;
  const float* src = isA ? p.in[2] : p.in[4];
  u16* dst = (u16*)(p.ws + (isA ? O_KALAT : O_KCLAT));
  float4 vv[4];
#pragma unroll
  for (int i = 0; i < 4; ++i) vv[i] = *(const float4*)(src + (size_t)item * 4096 + (size_t)(ltid() + 256 * i) * 4);
#pragma unroll
  for (int i = 0; i < 4; ++i) {
    size_t e = (size_t)item * 4096 + (size_t)(ltid() + 256 * i) * 4;
    float4 v = vv[i];
    int c = (int)(e % W);
    size_t r = e / W;
    int pp = (int)(r % 512);
    int bl = (int)(r / 512);
    int b = bl >> 1, li = bl & 1;
    uint2 o;
    o.x = pack2(v.x, v.y);
    o.y = pack2(v.z, v.w);
    *(uint2*)(dst + ((size_t)((li * 2 + b) * 1536 + 1024 + pp)) * W + c) = o;
  }
}

struct TDesc { const float* src; int sstride; u16* dst; int dstride; };

DI TDesc tdesc(const P& p, int t) {
  constexpr int T_IN = 1664, T_OUT = 512, T_FF1 = 2048, T_FF2 = 2048, T_AV = 256;
  TDesc d;
  if (t < T_IN) {
    int li = t / 832, r = t % 832, kt = r / 52, nt = r % 52;
    d.src = p.in[12] + (size_t)li * 1024 * NIN + (size_t)(kt * 64) * NIN + nt * 64; d.sstride = NIN;
    d.dst = (u16*)(p.ws + O_WTIN) + (size_t)li * NIN * 1024 + (size_t)(nt * 64) * 1024 + kt * 64; d.dstride = 1024;
  } else if ((t -= T_IN) < T_OUT) {
    int li = t / 256, r = t % 256, kt = r / 16, nt = r % 16;
    d.src = p.in[13] + (size_t)li * 1024 * 1024 + (size_t)(kt * 64) * 1024 + nt * 64; d.sstride = 1024;
    d.dst = (u16*)(p.ws + O_WTOUT) + (size_t)li * 1024 * 1024 + (size_t)(nt * 64) * 1024 + kt * 64; d.dstride = 1024;
  } else if ((t -= T_OUT) < T_FF1) {
    int li = t / 1024, r = t % 1024, kt = r / 64, nt = r % 64;
    d.src = p.in[28] + (size_t)li * 1024 * DFF + (size_t)(kt * 64) * DFF + nt * 64; d.sstride = DFF;
    d.dst = (u16*)(p.ws + O_WTFF1) + (size_t)li * DFF * 1024 + (size_t)(nt * 64) * 1024 + kt * 64; d.dstride = 1024;
  } else if ((t -= T_FF1) < T_FF2) {
    int li = t / 1024, r = t % 1024, kt = r / 16, nt = r % 16;
    d.src = p.in[29] + (size_t)li * DFF * 1024 + (size_t)(kt * 64) * 1024 + nt * 64; d.sstride = 1024;
    d.dst = (u16*)(p.ws + O_WTFF2) + (size_t)li * 1024 * DFF + (size_t)(nt * 64) * DFF + kt * 64; d.dstride = DFF;
  } else if ((t -= T_FF2) < T_AV) {
    int bl = t / 64, r = t % 64, pt = r / 8, ct = r % 8;
    int b = bl >> 1, li = bl & 1;
    d.src = p.in[3] + ((size_t)bl * 512 + pt * 64) * 512 + ct * 64; d.sstride = 512;
    d.dst = (u16*)(p.ws + O_VTALAT) + ((size_t)(li * 2 + b) * 512 + ct * 64) * 1536 + 1024 + pt * 64; d.dstride = 1536;
  } else {
    t -= T_AV;
    int bl = t / 16, r = t % 16, pt = r / 2, ct = r % 2;
    int b = bl >> 1, li = bl & 1;
    d.src = p.in[5] + ((size_t)bl * 512 + pt * 64) * 128 + ct * 64; d.sstride = 128;
    d.dst = (u16*)(p.ws + O_VTCLAT) + ((size_t)(li * 2 + b) * 128 + ct * 64) * 1536 + 1024 + pt * 64; d.dstride = 1536;
  }
  return d;
}

DI int tcount(int mode) { return mode == 0 ? 832 + 256 + 320 : (mode == 1 ? 832 + 256 : 2048); }
DI int tmap(int k, int mode) {
  if (mode == 0) {
    if (k < 832) return k;
    if (k < 1088) return 1664 + (k - 832);
    return 6272 + (k - 1088);
  }
  if (mode == 1) {
    if (k < 832) return 832 + k;
    return 1920 + (k - 832);
  }
  const int li = mode - 2;
  if (k < 1024) return 2176 + li * 1024 + k;
  return 4224 + li * 1024 + (k - 1024);
}
DI void run_transposes(const P& p, char* smem, int first, int step, int deferred, int count_override = -1) {
  const int count = count_override >= 0 ? count_override : tcount(deferred);
  float* tl = (float*)smem;
  const int tid = ltid();
  const int lr = tid >> 4, lc4 = tid & 15;
  const int c = tid >> 2, rs = tid & 3;
  int t = first;
  f32x4 v[4];
  TDesc cur;
  if (t < count) {
    cur = tdesc(p, tmap(t, deferred));
#pragma unroll
    for (int i = 0; i < 4; ++i) v[i] = *(const f32x4*)(cur.src + (size_t)(lr + 16 * i) * cur.sstride + lc4 * 4);
  }
  while (t < count) {
    __syncthreads();
#pragma unroll
    for (int i = 0; i < 4; ++i) {
      float* q = tl + (lr + 16 * i) * 65 + lc4 * 4;
      q[0] = v[i].x; q[1] = v[i].y; q[2] = v[i].z; q[3] = v[i].w;
    }
    const int tn = t + step;
    TDesc nxt = cur;
    if (tn < count) {
      nxt = tdesc(p, tmap(tn, deferred));
#pragma unroll
      for (int i = 0; i < 4; ++i) v[i] = *(const f32x4*)(nxt.src + (size_t)(lr + 16 * i) * nxt.sstride + lc4 * 4);
    }
    __syncthreads();
    u32x4 o0, o1;
    {
      const float* q = tl + (rs * 16) * 65 + c;
      o0.x = pack2(q[0 * 65], q[1 * 65]);   o0.y = pack2(q[2 * 65], q[3 * 65]);
      o0.z = pack2(q[4 * 65], q[5 * 65]);   o0.w = pack2(q[6 * 65], q[7 * 65]);
      o1.x = pack2(q[8 * 65], q[9 * 65]);   o1.y = pack2(q[10 * 65], q[11 * 65]);
      o1.z = pack2(q[12 * 65], q[13 * 65]); o1.w = pack2(q[14 * 65], q[15 * 65]);
    }
    u32x4* dp = (u32x4*)(cur.dst + (size_t)c * cur.dstride + rs * 16);
    dp[0] = o0;
    dp[1] = o1;
    cur = nxt;
    t = tn;
  }
}

DI void ln_apply(const P& p, const float* lo, const float* hi, const float* stats, const float* lng, const float* lnb,
                 const float* mods, int sc_off, int sh_off);

DI void phase0(const P& p, char* smem) {
  constexpr int N_MOD = 192, N_ROPE = 8, N_AK = 256, N_CK = 64;
  constexpr int B_ROPE = N_MOD, B_AK = B_ROPE + N_ROPE, B_CK = B_AK + N_AK, B_T = B_CK + N_CK;
  constexpr int NTILES = 1664 + 512 + 2048 + 2048 + 256 + 64;
  for (int it = blockIdx.x; it < B_T; it += gridDim.x) {
    if (it < B_ROPE) p0_mod(p, it, smem);
    else if (it < B_AK) p0_rope(p, it - B_ROPE);
    else if (it < B_CK) p0_copyk(p, it - B_AK, true);
    else p0_copyk(p, it - B_CK, false);
  }
  run_transposes(p, smem, blockIdx.x, gridDim.x, 0);
#if !MULTI_LAUNCH
  if (ltid() == 0) {
    unsigned sp = 0;
    while (__hip_atomic_load((unsigned*)(p.ws + O_CNT), __ATOMIC_RELAXED, __HIP_MEMORY_SCOPE_AGENT) < 32u) {
      __builtin_amdgcn_s_sleep(2);
      if (++sp > (1u << 22)) break;
    }
    __builtin_amdgcn_fence(__ATOMIC_ACQUIRE, "agent");
    asm volatile("s_waitcnt vmcnt(0)" ::: "memory");
  }
  __syncthreads();
  ln_apply(p, p.in[0], p.in[1], nullptr, p.in[26], p.in[27], (const float*)(p.ws + O_MODS), 1024, 0);
#endif
}

struct GA {
  const float* alo;
  const float* ahi;
  const float* stats;
  const float* lng;
  const float* lnb;
  const float* mods;
  int sc_off, sh_off;
  const u16* a16;
  const u16* bt;
  int K, N;
  float* xout;
  float* sout;
  u16* hid;
};

DI void epi_inproj(const P& p, int li, f32x4 (&acc)[4][4], int R0, int C0);


template <int EPI, int MI = 4>
DI void gemm_tile(const P& p, const GA& g, int li, int m0, int n0, char* smem, u32x4 (&ra0)[4], u32x4 (&rb0)[4],
                  u32x4 (&ra1)[4], u32x4 (&rb1)[4], bool primed, int nm0, int nn0) {
  static_assert(MI == 4 || EPI == 1, "only the residual epilogue supports 96-row tiles");
  constexpr int WM = MI * 16;
  const int tid = ltid(), lane = tid & 63, wid = tid >> 6, wr = wid >> 1, wc = wid & 1;
  const int l16 = lane & 15, q4 = lane >> 4;
  u16* sA0 = (u16*)smem;
  u16* sB0 = sA0 + 128 * 72;
  u16* sA1 = sB0 + 128 * 72;
  u16* sB1 = sA1 + 128 * 72;
  float2* sStat = (float2*)(smem + 73728);
  const int K = g.K;
  const int rtype = (m0 < NCTX) ? 0 : 1 + ((m0 - NCTX) >> 10);
  const float* modv = g.mods + rtype * 6144;
  const float* fsrc = (m0 < NCTX) ? g.alo + (size_t)m0 * 1024 : g.ahi + (size_t)(m0 - NCTX) * 1024;

  if (!primed) {
    const unsigned goff_ = (unsigned)(tid >> 3) * (unsigned)g.K + (unsigned)(tid & 7) * 8u;
    const u16* ab_ = g.a16 + (size_t)m0 * g.K;
    const u16* bb_ = g.bt + (size_t)n0 * g.K;
#pragma unroll
    for (int i = 0; i < 4; ++i) {
      if (i < MI) ra0[i] = *(const u32x4*)(ab_ + (size_t)(32 * i) * g.K + goff_);
      rb0[i] = *(const u32x4*)(bb_ + (size_t)(32 * i) * g.K + goff_);
    }
    __builtin_amdgcn_sched_barrier(0);
#pragma unroll
    for (int i = 0; i < 4; ++i) {
      if (i < MI) ra1[i] = *(const u32x4*)(ab_ + (size_t)(32 * i) * g.K + 64 + goff_);
      rb1[i] = *(const u32x4*)(bb_ + (size_t)(32 * i) * g.K + 64 + goff_);
    }
    __builtin_amdgcn_sched_barrier(0);
  }
  __syncthreads();
  if constexpr (EPI == 1 || EPI == 3) {
    if (g.stats != nullptr && tid < 2 * WM) {
      const float4* sp = (const float4*)(g.stats + (size_t)(m0 + tid) * 32);
      float s1 = 0.f, s2 = 0.f;
#pragma unroll
      for (int i = 0; i < 8; ++i) {
        float4 v = sp[i];
        s1 += v.x + v.z;
        s2 += v.y + v.w;
      }
      float mu = s1 * (1.f / 1024.f);
      float var = s2 * (1.f / 1024.f) - mu * mu;
      sStat[tid] = make_float2(mu, rsqrtf(fmaxf(var, 0.f) + 1e-6f));
    }
  }

  f32x4 acc[MI][4];
#pragma unroll
  for (int i = 0; i < MI; ++i)
#pragma unroll
    for (int j = 0; j < 4; ++j) acc[i][j] = f32x4{0.f, 0.f, 0.f, 0.f};

  const unsigned goff = (unsigned)(tid >> 3) * (unsigned)K + (unsigned)(tid & 7) * 8u;
  const unsigned loff = (unsigned)(tid >> 3) * 72u + (unsigned)(tid & 7) * 8u;
  const u16* abase = g.a16 + (size_t)m0 * K;
  const u16* bbase = g.bt + (size_t)n0 * K;
#define GLOAD(RA, RB, KT)                                                        \
  _Pragma("unroll") for (int i = 0; i < 4; ++i) {                                \
    if (i < MI) RA[i] = *(const u32x4*)(abase + (size_t)(32 * i) * K + (KT) * 64 + goff); \
    RB[i] = *(const u32x4*)(bbase + (size_t)(32 * i) * K + (KT) * 64 + goff);    \
  }
#define LSTORE(SA, SB, RA, RB)                                                   \
  _Pragma("unroll") for (int i = 0; i < 4; ++i) {                                \
    if (i < MI) *(u32x4*)(SA + 32 * i * 72 + loff) = RA[i];                      \
    *(u32x4*)(SB + 32 * i * 72 + loff) = RB[i];                                  \
  }
#define COMPUTE(SA, SB)                                                          \
  _Pragma("unroll") for (int s = 0; s < 2; ++s) {                                \
    bf16x8 af[MI], bfr[4];                                                       \
    _Pragma("unroll") for (int i = 0; i < 4; ++i) {                              \
      if (i < MI) af[i] = *(const bf16x8*)(SA + (wr * WM + i * 16 + l16) * 72 + s * 32 + q4 * 8);  \
      bfr[i] = *(const bf16x8*)(SB + (wc * 64 + i * 16 + l16) * 72 + s * 32 + q4 * 8); \
    }                                                                            \
    __builtin_amdgcn_s_setprio(1);                                               \
    _Pragma("unroll") for (int i = 0; i < MI; ++i)                               \
      _Pragma("unroll") for (int j = 0; j < 4; ++j) acc[i][j] = MFMA16(af[i], bfr[j], acc[i][j]); \
    __builtin_amdgcn_s_setprio(0);                                               \
    __builtin_amdgcn_sched_barrier(0);                                           \
  }

  const int nk = K >> 6;
#define SB0 __builtin_amdgcn_sched_barrier(0)
  LSTORE(sA0, sB0, ra0, rb0);
  SB0;
  GLOAD(ra0, rb0, 2);
  SB0;
  __syncthreads();
#pragma unroll 1
  for (int kt = 0; kt < nk - 4; kt += 2) {
    SB0;
    LSTORE(sA1, sB1, ra1, rb1);
    SB0;
    GLOAD(ra1, rb1, kt + 3);
    SB0;
    COMPUTE(sA0, sB0);
    __syncthreads();
    SB0;
    LSTORE(sA0, sB0, ra0, rb0);
    SB0;
    GLOAD(ra0, rb0, kt + 4);
    SB0;
    COMPUTE(sA1, sB1);
    __syncthreads();
  }
  SB0;
  LSTORE(sA1, sB1, ra1, rb1);
  SB0;
  GLOAD(ra1, rb1, nk - 1);
  SB0;
  COMPUTE(sA0, sB0);
  __syncthreads();
  const u16* nabase = g.a16 + (size_t)nm0 * K;
  const u16* nbbase = g.bt + (size_t)nn0 * K;
  SB0;
  LSTORE(sA0, sB0, ra0, rb0);
  SB0;
  _Pragma("unroll") for (int i = 0; i < 4; ++i) {
    if (i < MI) ra0[i] = *(const u32x4*)(nabase + (size_t)(32 * i) * K + goff);
    rb0[i] = *(const u32x4*)(nbbase + (size_t)(32 * i) * K + goff);
  }
  SB0;
  COMPUTE(sA1, sB1);
  __syncthreads();
  SB0;
  LSTORE(sA1, sB1, ra1, rb1);
  SB0;
  _Pragma("unroll") for (int i = 0; i < 4; ++i) {
    if (i < MI) ra1[i] = *(const u32x4*)(nabase + (size_t)(32 * i) * K + 64 + goff);
    rb1[i] = *(const u32x4*)(nbbase + (size_t)(32 * i) * K + 64 + goff);
  }
  SB0;
  COMPUTE(sA0, sB0);
  __syncthreads();
  SB0;
  COMPUTE(sA1, sB1);
#undef GLOAD
#undef LSTORE
#undef COMPUTE
#undef SB0
  asm volatile("" ::: "memory");

  const int R0 = m0 + wr * WM, C0 = n0 + wc * 64;
  if constexpr (EPI == 0) {
    if constexpr (MI == 4) epi_inproj(p, li, acc, R0, C0);
  } else if constexpr (EPI == 1) {
    const int rtA = rtype;
    const int mlast = m0 + 2 * WM - 1;
    const int rtB = (mlast < NCTX) ? 0 : 1 + ((mlast - NCTX) >> 10);
    const float* modvB = g.mods + rtB * 6144;
    float gateA[4], gateB[4], lg[4], lb[4];
#pragma unroll
    for (int j = 0; j < 4; ++j) {
      int col = C0 + j * 16 + l16;
      gateA[j] = modv[g.sc_off + col];
      gateB[j] = modvB[g.sc_off + col];
      lg[j] = g.stats ? g.lng[col] : 1.f;
      lb[j] = g.stats ? g.lnb[col] : 0.f;
    }
    float xr[MI][4][4];
#pragma unroll
    for (int i = 0; i < MI; ++i)
#pragma unroll
      for (int r = 0; r < 4; ++r) {
        const int grow = m0 + wr * WM + i * 16 + q4 * 4 + r;
        const float* rp = (grow < NCTX) ? g.alo + (size_t)grow * 1024 : g.ahi + (size_t)(grow - NCTX) * 1024;
#pragma unroll
        for (int j = 0; j < 4; ++j) xr[i][r][j] = rp[C0 + j * 16 + l16];
      }
#pragma unroll
    for (int i = 0; i < MI; ++i) {
#pragma unroll
      for (int r = 0; r < 4; ++r) {
        int lrow = wr * WM + i * 16 + q4 * 4 + r;
        const int grow = m0 + lrow;
        const int rt = (grow < NCTX) ? 0 : 1 + ((grow - NCTX) >> 10);
        const bool useA = (rt == rtA);
        float mu = 0.f, rs = 1.f;
        if (g.stats != nullptr) {
          float2 st = sStat[lrow];
          mu = st.x;
          rs = st.y;
        }
        float s1 = 0.f, s2 = 0.f;
#pragma unroll
        for (int j = 0; j < 4; ++j) {
          int col = C0 + j * 16 + l16;
          float x = xr[i][r][j];
          x = (x - mu) * rs * lg[j] + lb[j];
          float v = ALPHA * x + (useA ? gateA[j] : gateB[j]) * acc[i][j][r];
          g.xout[(size_t)grow * 1024 + col] = v;
          s1 += v;
          s2 += v * v;
        }
        s1 = red16(s1);
        s2 = red16(s2);
        if (l16 == 0) *(float2*)(g.sout + (size_t)grow * 32 + (C0 >> 6) * 2) = make_float2(s1, s2);
      }
    }
  } else {
    float* sC = (float*)smem;
    __syncthreads();
#pragma unroll
    for (int i = 0; i < 4; ++i)
#pragma unroll
      for (int j = 0; j < 4; ++j)
#pragma unroll
        for (int r = 0; r < 4; ++r) if constexpr (MI == 4) sC[(wr * 64 + i * 16 + q4 * 4 + r) * 132 + wc * 64 + j * 16 + l16] = acc[i][j][r];
    __syncthreads();
    if constexpr (EPI == 3) {
      const int hl = lane & 31, rsel = lane >> 5;
      const int col = n0 + hl * 4;
      const f32x4 gate4 = *(const f32x4*)(modv + g.sc_off + col);
      f32x4 lg4 = {1.f, 1.f, 1.f, 1.f}, lb4 = {0.f, 0.f, 0.f, 0.f};
      if (g.stats != nullptr) {
        lg4 = *(const f32x4*)(g.lng + col);
        lb4 = *(const f32x4*)(g.lnb + col);
      }
#pragma unroll 4
      for (int pp = 0; pp < 16; ++pp) {
        const int lrow = pp * 8 + wid * 2 + rsel;
        f32x4 a = *(const f32x4*)(sC + lrow * 132 + hl * 4);
        f32x4 x = *(const f32x4*)(fsrc + (size_t)lrow * 1024 + col);
        float mu = 0.f, rs = 1.f;
        if (g.stats != nullptr) {
          float2 st = sStat[lrow];
          mu = st.x;
          rs = st.y;
        }
        x = (x - mu) * rs * lg4 + lb4;
        f32x4 v = ALPHA * x + gate4 * a;
        *(f32x4*)(g.xout + (size_t)(m0 + lrow) * 1024 + col) = v;
        float s1 = (v.x + v.y) + (v.z + v.w);
        float s2 = (v.x * v.x + v.y * v.y) + (v.z * v.z + v.w * v.w);
        s1 = red16(s1);
        s2 = red16(s2);
        if ((lane & 15) == 0) *(float2*)(g.sout + (size_t)(m0 + lrow) * 32 + ((n0 >> 6) + (hl >> 4)) * 2) = make_float2(s1, s2);
      }
    } else {
#pragma unroll
      for (int pp = 0; pp < 8; ++pp) {
        const int idx = tid + 256 * pp;
        const int lrow = idx >> 4, c8 = idx & 15;
        f32x4 a0 = *(const f32x4*)(sC + lrow * 132 + c8 * 8);
        f32x4 a1 = *(const f32x4*)(sC + lrow * 132 + c8 * 8 + 4);
        a0.x = fmaxf(a0.x, 0.f); a0.y = fmaxf(a0.y, 0.f); a0.z = fmaxf(a0.z, 0.f); a0.w = fmaxf(a0.w, 0.f);
        a1.x = fmaxf(a1.x, 0.f); a1.y = fmaxf(a1.y, 0.f); a1.z = fmaxf(a1.z, 0.f); a1.w = fmaxf(a1.w, 0.f);
        u32x4 o;
        o.x = pack2(a0.x * a0.x, a0.y * a0.y);
        o.y = pack2(a0.z * a0.z, a0.w * a0.w);
        o.z = pack2(a1.x * a1.x, a1.y * a1.y);
        o.w = pack2(a1.z * a1.z, a1.w * a1.w);
        *(u32x4*)(g.hid + (size_t)(m0 + lrow) * DFF + n0 + c8 * 8) = o;
      }
    }
  }
}

DI void epi_inproj(const P& p, int li, f32x4 (&acc)[4][4], int R0, int C0) {
  const int lane = ltid() & 63, l16 = lane & 15, q4 = lane >> 4;
  const int seg = C0 >> 6;
  const bool lat = R0 >= NCTX;
  const float2* rope = (const float2*)(p.ws + O_ROPE);
  int b, tb;
  if (!lat) { b = R0 >> 8; tb = R0 & 255; } else { b = (R0 - NCTX) >> 10; tb = (R0 - NCTX) & 1023; }

  enum { T_QA, T_KA, T_VA, T_QB, T_FF, T_FB, T_IB, T_GB, T_QC, T_KC, T_VC };
  int type, cbase;
  if (seg < 8) { type = T_QA; cbase = seg * 64; }
  else if (seg < 16) { type = T_KA; cbase = (seg - 8) * 64; }
  else if (seg < 24) { type = T_VA; cbase = (seg - 16) * 64; }
  else if (seg < 28) { type = T_QB; cbase = (seg - 24) * 64; }
  else if (seg < 32) { type = T_FF; cbase = (seg - 28) * 64; }
  else if (seg < 36) { type = T_FB; cbase = (seg - 32) * 64; }
  else if (seg < 40) { type = T_IB; cbase = (seg - 36) * 64; }
  else if (seg < 44) { type = T_GB; cbase = (seg - 40) * 64; }
  else if (seg < 48) { type = T_QC; cbase = (seg - 44) * 64; }
  else if (seg < 50) { type = T_KC; cbase = (seg - 48) * 64; }
  else { type = T_VC; cbase = (seg - 50) * 64; }

  if (type == T_QC || type == T_KC) {
    const float* gv = (type == T_QC ? p.in[22] : p.in[23]) + li * 64;
    float gj[4];
#pragma unroll
    for (int j = 0; j < 4; ++j) gj[j] = gv[j * 16 + l16];
#pragma unroll
    for (int i = 0; i < 4; ++i)
#pragma unroll
      for (int r = 0; r < 4; ++r) {
        float ss = 0.f;
#pragma unroll
        for (int j = 0; j < 4; ++j) ss += acc[i][j][r] * acc[i][j][r];
        ss = red16(ss);
        float rs = rsqrtf(ss * (1.f / 64.f) + 1e-6f);
#pragma unroll
        for (int j = 0; j < 4; ++j) acc[i][j][r] = acc[i][j][r] * rs * gj[j];
      }
  }
  if (!lat && (type == T_KA || type == T_VA || type == T_KC || type == T_VC)) {
    float* o;
    int W;
    if (type == T_KA) { o = p.out + OUT_AK; W = 512; }
    else if (type == T_VA) { o = p.out + OUT_AV; W = 512; }
    else if (type == T_KC) { o = p.out + OUT_CK; W = 128; }
    else { o = p.out + OUT_CV; W = 128; }
#pragma unroll
    for (int i = 0; i < 4; ++i)
#pragma unroll
      for (int r = 0; r < 4; ++r) {
        int t = tb + i * 16 + q4 * 4 + r;
        size_t base = ((size_t)(b * 2 + li) * 256 + t) * W + cbase;
#pragma unroll
        for (int j = 0; j < 4; ++j) o[base + j * 16 + l16] = acc[i][j][r];
      }
  }
  if (lat && (type == T_QA || type == T_KA || type == T_QC || type == T_KC)) {
#pragma unroll
    for (int i = 0; i < 4; ++i)
#pragma unroll
      for (int r = 0; r < 4; ++r) {
        int t = tb + i * 16 + q4 * 4 + r;
#pragma unroll
        for (int j = 0; j < 4; ++j) {
          float v = acc[i][j][r];
          float pv = xor1(v);
          float2 cs = rope[t * 32 + j * 8 + (l16 >> 1)];
          acc[i][j][r] = (l16 & 1) ? (pv * cs.y + v * cs.x) : (v * cs.x - pv * cs.y);
        }
      }
  }

  if (type == T_QA || type == T_KA || type == T_QC || type == T_KC) {
    u16* dst;
    int W;
    size_t rowbase;
    if (type == T_QA) { dst = (u16*)(p.ws + O_QA); W = 512; rowbase = (size_t)R0 * 512; }
    else if (type == T_QC) { dst = (u16*)(p.ws + O_QC); W = 256; rowbase = (size_t)R0 * 256; }
    else if (type == T_KA) {
      W = 512;
      if (!lat) { dst = (u16*)(p.ws + O_KACTX); rowbase = (size_t)R0 * 512; }
      else { dst = (u16*)(p.ws + O_KALAT); rowbase = ((size_t)(li * 2 + b) * 1536 + tb) * 512; }
    } else {
      W = 128;
      if (!lat) { dst = (u16*)(p.ws + O_KCCTX); rowbase = (size_t)R0 * 128; }
      else { dst = (u16*)(p.ws + O_KCLAT); rowbase = ((size_t)(li * 2 + b) * 1536 + tb) * 128; }
    }
#pragma unroll
    for (int i = 0; i < 4; ++i)
#pragma unroll
      for (int r = 0; r < 4; ++r) {
        size_t base = rowbase + (size_t)(i * 16 + q4 * 4 + r) * W + cbase;
#pragma unroll
        for (int j = 0; j < 4; ++j) dst[base + j * 16 + l16] = f2bf(acc[i][j][r]);
      }
  } else if (type == T_VA || type == T_VC) {
    u16* dst;
    int L;
    size_t hb;
    if (type == T_VA) {
      int h = cbase >> 7, dv0 = cbase & 127;
      if (!lat) { dst = (u16*)(p.ws + O_VTACTX); L = 256; hb = ((size_t)(b * 4 + h) * 128 + dv0) * 256; }
      else { dst = (u16*)(p.ws + O_VTALAT); L = 1536; hb = ((size_t)((li * 2 + b) * 4 + h) * 128 + dv0) * 1536; }
    } else {
      int n = cbase >> 6;
      if (!lat) { dst = (u16*)(p.ws + O_VTCCTX); L = 256; hb = ((size_t)(b * 2 + n) * 64) * 256; }
      else { dst = (u16*)(p.ws + O_VTCLAT); L = 1536; hb = ((size_t)((li * 2 + b) * 2 + n) * 64) * 1536; }
    }
#pragma unroll
    for (int i = 0; i < 4; ++i)
#pragma unroll
      for (int j = 0; j < 4; ++j) {
        uint2 o;
        o.x = pack2(acc[i][j][0], acc[i][j][1]);
        o.y = pack2(acc[i][j][2], acc[i][j][3]);
        *(uint2*)(dst + hb + (size_t)(j * 16 + l16) * L + tb + i * 16 + q4 * 4) = o;
      }
  } else {
    float* dst;
    if (type == T_QB) dst = (float*)(p.ws + O_HQ);
    else if (type == T_FF) dst = (float*)(p.ws + O_HGF);
    else if (type == T_FB) dst = (float*)(p.ws + O_HGB);
    else if (type == T_IB) dst = (float*)(p.ws + O_HI);
    else dst = (float*)(p.ws + O_HSG);
    float lbv[4] = {0.f, 0.f, 0.f, 0.f};
    if ((type == T_FF || type == T_FB) && li == 1) {
      const float* lg = (type == T_FF) ? p.in[19] : p.in[20];
#pragma unroll
      for (int j = 0; j < 4; ++j) {
        int c = cbase + j * 16 + l16;
        lbv[j] = 1.f / (1.f + expf(lg[c] - lg[256 + c]));
      }
    }
#pragma unroll
    for (int i = 0; i < 4; ++i)
#pragma unroll
      for (int r = 0; r < 4; ++r) {
        size_t base = (size_t)(R0 + i * 16 + q4 * 4 + r) * 256 + cbase;
#pragma unroll
        for (int j = 0; j < 4; ++j) {
          float v = acc[i][j][r];
          float o;
          if (type == T_QB || type == T_GB) o = v * __frcp_rn(1.f + __expf(-v));
          else if (type == T_IB) o = v;
          else {
            float sg = __frcp_rn(1.f + __expf(-v));
            float f = lbv[j] + (1.f - lbv[j]) * sg;
            o = __logf(fmaxf(f, 1e-6f));
          }
          dst[base + j * 16 + l16] = o;
        }
      }
  }
}

template <int EPI, int MI = 4>
DI void gemm_phase(const P& p, const GA& g, int li, char* smem) {
  constexpr int BMT = MI * 32;
  constexpr int MPX = NTOK / BMT / 8;
  const int NT = g.N >> 7;
  const int xcd = blockIdx.x & 7, lb = blockIdx.x >> 3, nlb = gridDim.x >> 3;
  if (lb >= nlb) return;
  u32x4 ra0[4], rb0[4], ra1[4], rb1[4];
  bool primed = false;
  for (int t = lb; t < MPX * NT; t += nlb) {
    int mt = xcd * MPX + t % MPX, nt = t / MPX;
    const int tn = (t + nlb < MPX * NT) ? t + nlb : t;
    const int nmt = xcd * MPX + tn % MPX, nnt = tn / MPX;
    gemm_tile<EPI, MI>(p, g, li, mt * BMT, nt * 128, smem, ra0, rb0, ra1, rb1, primed, nmt * BMT, nnt * 128);
    primed = true;
  }
}


template <int KW, int DV>
DI void attn_gload(const u16* Kb, int kstride, const u16* VT, int L, int kb, int tid, u32x4 (&kr)[KW / 32], u32x4 (&vr)[DV / 32]) {
  constexpr int KPR = 256 / (KW / 8);
  const unsigned koff = (unsigned)(tid / (KW / 8)) * (unsigned)kstride + (unsigned)(tid % (KW / 8)) * 8u;
  const unsigned voff = (unsigned)(tid >> 3) * (unsigned)L + (unsigned)(tid & 7) * 8u;
#pragma unroll
  for (int i = 0; i < KW / 32; ++i) {
    const u16* kbp = Kb + (size_t)(kb * 64 + KPR * i) * kstride;
    kr[i] = *(const u32x4*)(kbp + koff);
  }
#pragma unroll
  for (int i = 0; i < DV / 32; ++i) {
    const u16* vbp = VT + (size_t)(32 * i) * L + kb * 64;
    vr[i] = *(const u32x4*)(vbp + voff);
  }
}
template <int KW, int DV>
DI void attn_lstore(u16* sK, u16* sV, int tid, const u32x4 (&kr)[KW / 32], const u32x4 (&vr)[DV / 32]) {
  constexpr int KS = KW + 8;
#pragma unroll
  for (int i = 0; i < KW / 32; ++i) {
    int idx = tid + 256 * i;
    int key = idx / (KW / 8), cc = idx % (KW / 8);
    *(u32x4*)(sK + key * KS + cc * 8) = kr[i];
  }
#pragma unroll
  for (int i = 0; i < DV / 32; ++i) {
    int idx = tid + 256 * i;
    int row = idx >> 3, cc = idx & 7;
    *(u32x4*)(sV + row * 72 + cc * 8) = vr[i];
  }
}

template <int KW, int DV, int NQ>
DI void attn_compute(const u16* sK, const u16* sV, int kfo, int l16, int q4, const bf16x8 (&qf)[NQ][2],
                     f32x4 (&o)[NQ][DV / 16], float (&m)[NQ], float (&l)[NQ]) {
  constexpr int KS = KW + 8, NDT = DV / 16;
  const float c = 0.125f * LOG2E;
  f32x4 st[NQ][4];
#pragma unroll
  for (int kt = 0; kt < 4; ++kt) {
    const u16* kp = sK + (kt * 16 + l16) * KS + kfo + q4 * 8;
    bf16x8 k0 = *(const bf16x8*)kp;
    bf16x8 k1 = *(const bf16x8*)(kp + 32);
#pragma unroll
    for (int q = 0; q < NQ; ++q) {
      f32x4 z = {0.f, 0.f, 0.f, 0.f};
      z = MFMA16(k0, qf[q][0], z);
      st[q][kt] = MFMA16(k1, qf[q][1], z);
    }
  }
#pragma unroll
  for (int q = 0; q < NQ; ++q) {
    float bm = st[q][0][0];
#pragma unroll
    for (int kt = 0; kt < 4; ++kt)
#pragma unroll
      for (int r = 0; r < 4; ++r) bm = fmaxf(bm, st[q][kt][r]);
    bm = fmaxf(bm, shx(bm, 16));
    bm = fmaxf(bm, shx(bm, 32));
    const float mn = fmaxf(m[q], bm);
    const float alpha = ex2((m[q] - mn) * c);
    m[q] = mn;
    float ps = 0.f;
#pragma unroll
    for (int kt = 0; kt < 4; ++kt)
#pragma unroll
      for (int r = 0; r < 4; ++r) {
        float pv = ex2((st[q][kt][r] - mn) * c);
        st[q][kt][r] = pv;
        ps += pv;
      }
    l[q] = l[q] * alpha + ps;
#pragma unroll
    for (int d = 0; d < NDT; ++d) {
      o[q][d][0] *= alpha; o[q][d][1] *= alpha; o[q][d][2] *= alpha; o[q][d][3] *= alpha;
    }
  }
#pragma unroll
  for (int ks = 0; ks < 2; ++ks) {
    bf16x8 pf[NQ];
#pragma unroll
    for (int q = 0; q < NQ; ++q) {
      u32x4 pu;
      pu.x = pack2(st[q][2 * ks][0], st[q][2 * ks][1]);
      pu.y = pack2(st[q][2 * ks][2], st[q][2 * ks][3]);
      pu.z = pack2(st[q][2 * ks + 1][0], st[q][2 * ks + 1][1]);
      pu.w = pack2(st[q][2 * ks + 1][2], st[q][2 * ks + 1][3]);
      pf[q] = __builtin_bit_cast(bf16x8, pu);
    }
#pragma unroll
    for (int d = 0; d < NDT; ++d) {
      const u16* vp = sV + (d * 16 + l16) * 72 + ks * 32 + q4 * 4;
      u32x2 v0 = *(const u32x2*)vp;
      u32x2 v1 = *(const u32x2*)(vp + 16);
      u32x4 vu = {v0.x, v0.y, v1.x, v1.y};
      bf16x8 vf = __builtin_bit_cast(bf16x8, vu);
#pragma unroll
      for (int q = 0; q < NQ; ++q) o[q][d] = MFMA16(vf, pf[q], o[q][d]);
    }
  }
}

template <int KW, int DV, bool DIFF>
DI void attn_item(const u16* Q, int qstride, int qcol, int qrow0, const u16* Kb, int kstride, const u16* VT, int L,
                          int nkeys, u16* mixed, int mixcol, float lam, float postscale, const float* subg, char* smem) {
  constexpr int NQ = 2;
  const int tid = ltid(), lane = tid & 63, wid = tid >> 6, l16 = lane & 15, q4 = lane >> 4;
  const int qsub = wid & 1, var = wid >> 1;
  constexpr int KS = KW + 8;
  constexpr int STAGE = 64 * KS + DV * 72;
  u16* sK0 = (u16*)smem;
  u16* sV0 = sK0 + 64 * KS;
  u16* sK1 = sK0 + STAGE;
  u16* sV1 = sV0 + STAGE;
  constexpr int KPT = KW / 32, VPT = DV / 32, NDT = DV / 16;
  const int kfo = DIFF ? var * 64 : 0;

  bf16x8 qf[NQ][2];
#pragma unroll
  for (int q = 0; q < NQ; ++q) {
    const u16* qp = Q + (size_t)(qrow0 + qsub * 32 + q * 16 + l16) * qstride + qcol + var * 64 + q4 * 8;
    qf[q][0] = *(const bf16x8*)qp;
    qf[q][1] = *(const bf16x8*)(qp + 32);
  }

  u32x4 kr0[KPT], vr0[VPT];
  f32x4 o[NQ][NDT];
  float m[NQ], l[NQ];
#pragma unroll
  for (int q = 0; q < NQ; ++q) {
    m[q] = -INFINITY;
    l[q] = 0.f;
#pragma unroll
    for (int d = 0; d < NDT; ++d) o[q][d] = f32x4{0.f, 0.f, 0.f, 0.f};
  }
  const int nkb = nkeys >> 6;
#define SB0 __builtin_amdgcn_sched_barrier(0)
#define ACOMP(SK, SV) attn_compute<KW, DV, NQ>(SK, SV, kfo, l16, q4, qf, o, m, l)
  attn_gload<KW, DV>(Kb, kstride, VT, L, 0, tid, kr0, vr0);
  SB0;
  __syncthreads();
  attn_lstore<KW, DV>(sK0, sV0, tid, kr0, vr0);
  SB0;
  attn_gload<KW, DV>(Kb, kstride, VT, L, 1, tid, kr0, vr0);
  SB0;
  __syncthreads();
#pragma unroll 1
  for (int kb = 0; kb < nkb - 2; kb += 2) {
    SB0;
    attn_lstore<KW, DV>(sK1, sV1, tid, kr0, vr0);
    SB0;
    attn_gload<KW, DV>(Kb, kstride, VT, L, kb + 2, tid, kr0, vr0);
    SB0;
    ACOMP(sK0, sV0);
    __syncthreads();
    SB0;
    attn_lstore<KW, DV>(sK0, sV0, tid, kr0, vr0);
    SB0;
    attn_gload<KW, DV>(Kb, kstride, VT, L, kb + 3, tid, kr0, vr0);
    SB0;
    ACOMP(sK1, sV1);
    __syncthreads();
  }
  SB0;
  attn_lstore<KW, DV>(sK1, sV1, tid, kr0, vr0);
  SB0;
  ACOMP(sK0, sV0);
  __syncthreads();
  SB0;
  ACOMP(sK1, sV1);
  __syncthreads();
#undef SB0
#undef ACOMP
  float inv[NQ];
#pragma unroll
  for (int q = 0; q < NQ; ++q) {
    float lt = l[q];
    lt += shx(lt, 16);
    lt += shx(lt, 32);
    inv[q] = 1.f / lt;
  }
  if constexpr (DIFF) {
    float* sO = (float*)smem;
    if (var == 1) {
#pragma unroll
      for (int q = 0; q < NQ; ++q)
#pragma unroll
        for (int d = 0; d < NDT; ++d)
          *(f32x4*)(sO + (qsub * 32 + q * 16 + l16) * 132 + d * 16 + q4 * 4) = o[q][d] * inv[q];
    }
    __syncthreads();
    if (var == 0) {
      f32x4 ggv[NDT];
#pragma unroll
      for (int d = 0; d < NDT; ++d) ggv[d] = *(const f32x4*)(subg + d * 16 + q4 * 4);
#pragma unroll
      for (int q = 0; q < NQ; ++q) {
        const int row = qrow0 + qsub * 32 + q * 16 + l16;
        float ss = 0.f;
#pragma unroll
        for (int d = 0; d < NDT; ++d) {
          f32x4 o1 = *(const f32x4*)(sO + (qsub * 32 + q * 16 + l16) * 132 + d * 16 + q4 * 4);
          o[q][d] = o[q][d] * inv[q] - lam * o1;
          ss += o[q][d][0] * o[q][d][0] + o[q][d][1] * o[q][d][1] + o[q][d][2] * o[q][d][2] + o[q][d][3] * o[q][d][3];
        }
        ss += shx(ss, 16);
        ss += shx(ss, 32);
        const float rs = rsqrtf(ss * (1.f / 128.f) + 1e-6f) * postscale;
#pragma unroll
        for (int d = 0; d < NDT; ++d) {
          f32x4 v = o[q][d] * rs * ggv[d];
          u32x2 ov;
          ov.x = pack2(v.x, v.y);
          ov.y = pack2(v.z, v.w);
          *(u32x2*)(mixed + (size_t)row * 1024 + mixcol + d * 16 + q4 * 4) = ov;
        }
      }
    }
  } else {
#pragma unroll
    for (int q = 0; q < NQ; ++q) {
      const int row = qrow0 + qsub * 32 + q * 16 + l16;
#pragma unroll
      for (int d = 0; d < NDT; ++d) {
        f32x4 v = o[q][d] * inv[q];
        u32x2 ov;
        ov.x = pack2(v.x, v.y);
        ov.y = pack2(v.z, v.w);
        *(u32x2*)(mixed + (size_t)row * 1024 + mixcol + var * 64 + d * 16 + q4 * 4) = ov;
      }
    }
  }
}

DI void attnA_item(const P& p, int li, int it, char* smem) {
  const int lane = ltid() & 63;
  float d1 = p.in[14][li * 64 + lane] * p.in[15][li * 64 + lane];
  float d2 = p.in[16][li * 64 + lane] * p.in[17][li * 64 + lane];
#pragma unroll
  for (int s = 1; s < 64; s <<= 1) { d1 += shx(d1, s); d2 += shx(d2, s); }
  const float lam_init = 0.8f - 0.6f * expf(-0.3f * (float)li);
  const float lam = expf(d1) - expf(d2) + lam_init;
  const u16* QA = (const u16*)(p.ws + O_QA);
  u16* mixed = (u16*)(p.ws + O_MIXED);
  const float* subg = p.in[18] + li * 128;
  int qrow0, L;
  const u16 *Kb, *VT;
  int h;
  if (it < 128) {
    int b = it >> 6, qb = it & 15;
    h = (it >> 4) & 3;
    Kb = (const u16*)(p.ws + O_KALAT) + (size_t)(li * 2 + b) * 1536 * 512 + h * 128;
    VT = (const u16*)(p.ws + O_VTALAT) + (size_t)((li * 2 + b) * 4 + h) * 128 * 1536;
    qrow0 = NCTX + b * 1024 + qb * 64;
    L = 1536;
  } else {
    it -= 128;
    int b = it >> 4, qb = it & 3;
    h = (it >> 2) & 3;
    Kb = (const u16*)(p.ws + O_KACTX) + (size_t)b * 256 * 512 + h * 128;
    VT = (const u16*)(p.ws + O_VTACTX) + (size_t)(b * 4 + h) * 128 * 256;
    qrow0 = b * 256 + qb * 64;
    L = 256;
  }
  attn_item<128, 128, true>(QA, 512, h * 128, qrow0, Kb, 512, VT, L, L, mixed, h * 128, lam, 1.f - lam_init, subg, smem);
}
DI void attnC_item(const P& p, int li, int it, char* smem) {
  const u16* QC = (const u16*)(p.ws + O_QC);
  u16* mixed = (u16*)(p.ws + O_MIXED);
  int qrow0, L, n;
  const u16 *Kb, *VT;
  if (it < 64) {
    int b = it >> 5, qb = it & 15;
    n = (it >> 4) & 1;
    Kb = (const u16*)(p.ws + O_KCLAT) + (size_t)(li * 2 + b) * 1536 * 128 + n * 64;
    VT = (const u16*)(p.ws + O_VTCLAT) + (size_t)((li * 2 + b) * 2 + n) * 64 * 1536;
    qrow0 = NCTX + b * 1024 + qb * 64;
    L = 1536;
  } else {
    it -= 64;
    int b = it >> 3, qb = it & 3;
    n = (it >> 2) & 1;
    Kb = (const u16*)(p.ws + O_KCCTX) + (size_t)b * 256 * 128 + n * 64;
    VT = (const u16*)(p.ws + O_VTCCTX) + (size_t)(b * 2 + n) * 64 * 256;
    qrow0 = b * 256 + qb * 64;
    L = 256;
  }
  attn_item<64, 64, false>(QC, 256, n * 128, qrow0, Kb, 128, VT, L, L, mixed, 768 + n * 128, 0.f, 1.f, nullptr, smem);
}

DI void h1_item(const P& p, int item, char* smem) {
  const int tid = ltid(), lane = tid & 63, w = tid >> 6, l16 = lane & 15, q4 = lane >> 4;
  const int dir = item & 1, h = (item >> 1) & 3, tc = item >> 3;
  const int row0 = tc * 64;
  float* sQ = (float*)smem;
  float* sB = sQ + 64 * 68;
  float* sK = sB + 64 * 68;
  u16* sVT = (u16*)(sK + 64 * 68);
  float* sTot = (float*)(sVT + 64 * 72);
  const float* HQ = (const float*)(p.ws + O_HQ);
  const float* HG = (const float*)(p.ws + (dir ? O_HGB : O_HGF));
  const float* HI = (const float*)(p.ws + O_HI);
  float* OI = (float*)(p.ws + O_OI) + (size_t)dir * NTOK * 256;
  u16* QE = (u16*)(p.ws + O_QE) + (size_t)dir * NTOK * 256;
  float* KV = (float*)(p.ws + O_KV) + (size_t)item * 4096;
  float* DEC = (float*)(p.ws + O_DEC) + (size_t)item * 64;

  __syncthreads();
#pragma unroll
  for (int i = 0; i < 4; ++i) {
    int idx = tid + 256 * i;
    int lo = idx >> 4, c4 = idx & 15;
    int row = dir ? row0 + 63 - lo : row0 + lo;
    size_t off = (size_t)row * 256 + h * 64 + c4 * 4;
    *(float4*)(sQ + lo * 68 + c4 * 4) = *(const float4*)(HQ + off);
    *(float4*)(sB + lo * 68 + c4 * 4) = *(const float4*)(HG + off);
    float4 v = *(const float4*)(HI + off);
    sVT[(c4 * 4 + 0) * 72 + lo] = f2bf(v.x);
    sVT[(c4 * 4 + 1) * 72 + lo] = f2bf(v.y);
    sVT[(c4 * 4 + 2) * 72 + lo] = f2bf(v.z);
    sVT[(c4 * 4 + 3) * 72 + lo] = f2bf(v.w);
  }
  __syncthreads();
  {
    const int k = tid & 63, part = tid >> 6;
    float run = 0.f;
#pragma unroll 4
    for (int e = 0; e < 16; ++e) {
      int i = part * 16 + e;
      float g = sB[i * 68 + k];
      sK[i * 68 + k] = 1.f - ex2(g * LOG2E);
      run += g * LOG2E;
      sB[i * 68 + k] = run;
    }
    sTot[part * 64 + k] = run;
    __syncthreads();
    float add = 0.f;
    for (int pp = 0; pp < part; ++pp) add += sTot[pp * 64 + k];
    if (part > 0)
      for (int e = 0; e < 16; ++e) sB[(part * 16 + e) * 68 + k] += add;
  }
  __syncthreads();
#pragma unroll
  for (int i = 0; i < 4; ++i) {
    int idx = tid + 256 * i;
    int lo = idx >> 4, c4 = idx & 15;
    int row = dir ? row0 + 63 - lo : row0 + lo;
    f32x4 q = *(const f32x4*)(sQ + lo * 68 + c4 * 4);
    f32x4 bb = *(const f32x4*)(sB + lo * 68 + c4 * 4);
    u32x2 o;
    o.x = pack2(q.x * ex2(bb.x), q.y * ex2(bb.y));
    o.y = pack2(q.z * ex2(bb.z), q.w * ex2(bb.w));
    *(u32x2*)(QE + (size_t)row * 256 + h * 64 + c4 * 4) = o;
  }
  {
    const int I = w;
    bf16x8 qs[2];
    f32x4 rr[2][2];
#pragma unroll
    for (int s = 0; s < 2; ++s) {
      const int kk0 = s * 32 + q4 * 8;
      if (I > 0) {
        rr[s][0] = *(const f32x4*)(sB + (16 * I - 1) * 68 + kk0);
        rr[s][1] = *(const f32x4*)(sB + (16 * I - 1) * 68 + kk0 + 4);
      } else {
        rr[s][0] = f32x4{0.f, 0.f, 0.f, 0.f};
        rr[s][1] = rr[s][0];
      }
      const float* qr = sQ + (16 * I + l16) * 68 + kk0;
      const float* br = sB + (16 * I + l16) * 68 + kk0;
      f32x4 q0 = *(const f32x4*)qr, q1 = *(const f32x4*)(qr + 4);
      f32x4 b0 = *(const f32x4*)br, b1 = *(const f32x4*)(br + 4);
      u32x4 pu;
      pu.x = pack2(q0.x * ex2(b0.x - rr[s][0].x), q0.y * ex2(b0.y - rr[s][0].y));
      pu.y = pack2(q0.z * ex2(b0.z - rr[s][0].z), q0.w * ex2(b0.w - rr[s][0].w));
      pu.z = pack2(q1.x * ex2(b1.x - rr[s][1].x), q1.y * ex2(b1.y - rr[s][1].y));
      pu.w = pack2(q1.z * ex2(b1.z - rr[s][1].z), q1.w * ex2(b1.w - rr[s][1].w));
      qs[s] = __builtin_bit_cast(bf16x8, pu);
    }
    f32x4 at[4];
#pragma unroll
    for (int J = 0; J < 4; ++J) {
      at[J] = f32x4{0.f, 0.f, 0.f, 0.f};
      if (J <= I) {
#pragma unroll
        for (int s = 0; s < 2; ++s) {
          const int kk0 = s * 32 + q4 * 8;
          const float* kr = sK + (16 * J + l16) * 68 + kk0;
          const float* br = sB + (16 * J + l16) * 68 + kk0;
          f32x4 k0 = *(const f32x4*)kr, k1 = *(const f32x4*)(kr + 4);
          f32x4 b0 = *(const f32x4*)br, b1 = *(const f32x4*)(br + 4);
          u32x4 pu;
          pu.x = pack2(k0.x * ex2(fminf(rr[s][0].x - b0.x, 100.f)), k0.y * ex2(fminf(rr[s][0].y - b0.y, 100.f)));
          pu.y = pack2(k0.z * ex2(fminf(rr[s][0].z - b0.z, 100.f)), k0.w * ex2(fminf(rr[s][0].w - b0.w, 100.f)));
          pu.z = pack2(k1.x * ex2(fminf(rr[s][1].x - b1.x, 100.f)), k1.y * ex2(fminf(rr[s][1].y - b1.y, 100.f)));
          pu.w = pack2(k1.z * ex2(fminf(rr[s][1].z - b1.z, 100.f)), k1.w * ex2(fminf(rr[s][1].w - b1.w, 100.f)));
          bf16x8 kf = __builtin_bit_cast(bf16x8, pu);
          at[J] = MFMA16(kf, qs[s], at[J]);
        }
        if (J == I) {
#pragma unroll
          for (int r = 0; r < 4; ++r)
            if (q4 * 4 + r > l16) at[J][r] = 0.f;
        }
      }
    }
    f32x4 oc[4];
#pragma unroll
    for (int vt = 0; vt < 4; ++vt) oc[vt] = f32x4{0.f, 0.f, 0.f, 0.f};
#pragma unroll
    for (int ks = 0; ks < 2; ++ks) {
      if (2 * ks <= I) {
        u32x4 pu;
        pu.x = pack2(at[2 * ks][0], at[2 * ks][1]);
        pu.y = pack2(at[2 * ks][2], at[2 * ks][3]);
        pu.z = pack2(at[2 * ks + 1][0], at[2 * ks + 1][1]);
        pu.w = pack2(at[2 * ks + 1][2], at[2 * ks + 1][3]);
        bf16x8 pf = __builtin_bit_cast(bf16x8, pu);
#pragma unroll
        for (int vt = 0; vt < 4; ++vt) {
          const u16* vp = sVT + (vt * 16 + l16) * 72 + ks * 32 + q4 * 4;
          u32x2 v0 = *(const u32x2*)vp;
          u32x2 v1 = *(const u32x2*)(vp + 16);
          u32x4 vu = {v0.x, v0.y, v1.x, v1.y};
          oc[vt] = MFMA16(__builtin_bit_cast(bf16x8, vu), pf, oc[vt]);
        }
      }
    }
    {
      const int t = 16 * I + l16;
      const int row = dir ? row0 + 63 - t : row0 + t;
#pragma unroll
      for (int vt = 0; vt < 4; ++vt) *(f32x4*)(OI + (size_t)row * 256 + h * 64 + vt * 16 + q4 * 4) = oc[vt];
    }
  }
  {
    const int k = 16 * w + l16;
    const float bend = sB[63 * 68 + k];
    f32x4 kc[4];
#pragma unroll
    for (int vt = 0; vt < 4; ++vt) kc[vt] = f32x4{0.f, 0.f, 0.f, 0.f};
#pragma unroll
    for (int ks = 0; ks < 2; ++ks) {
      float kd[8];
#pragma unroll
      for (int j = 0; j < 8; ++j) {
        const int s = ks * 32 + q4 * 8 + j;
        kd[j] = sK[s * 68 + k] * ex2(bend - sB[s * 68 + k]);
      }
      u32x4 pu;
      pu.x = pack2(kd[0], kd[1]);
      pu.y = pack2(kd[2], kd[3]);
      pu.z = pack2(kd[4], kd[5]);
      pu.w = pack2(kd[6], kd[7]);
      bf16x8 af = __builtin_bit_cast(bf16x8, pu);
#pragma unroll
      for (int vt = 0; vt < 4; ++vt) {
        bf16x8 vf = *(const bf16x8*)(sVT + (vt * 16 + l16) * 72 + ks * 32 + q4 * 8);
        kc[vt] = MFMA16(af, vf, kc[vt]);
      }
    }
#pragma unroll
    for (int vt = 0; vt < 4; ++vt)
#pragma unroll
      for (int r = 0; r < 4; ++r) KV[(16 * w + q4 * 4 + r) * 64 + vt * 16 + l16] = kc[vt][r];
    if (q4 == 0) DEC[k] = ex2(bend);
  }
}

DI void h2_item(const P& p, int li, int item, char* smem) {
  const int tid = ltid(), ty = tid >> 4, tx = tid & 15;
  const int lane = tid & 63, w = tid >> 6, l16 = lane & 15, q4 = lane >> 4;
  const int h = item & 3, tc = item >> 2, row0 = tc * 64;
  const bool lat = tc >= 64;
  int seq, cl, nc;
  if (!lat) { seq = tc >> 2; cl = tc & 3; nc = 4; } else { seq = (tc - 64) >> 4; cl = (tc - 64) & 15; nc = 16; }
  const int tcbase = tc - cl;
  u16* sST = (u16*)smem;
  const float* KVb = (const float*)(p.ws + O_KV);
  const float* DECb = (const float*)(p.ws + O_DEC);
  __syncthreads();
#pragma unroll 1
  for (int dir = 0; dir < 2; ++dir) {
    float4 S[4];
#pragma unroll
    for (int a = 0; a < 4; ++a) {
      if (lat) S[a] = *(const float4*)(p.in[6 + dir] + ((size_t)((seq * 2 + li) * 4 + h) * 64 + ty + 16 * a) * 64 + tx * 4);
      else S[a] = make_float4(0.f, 0.f, 0.f, 0.f);
    }
    const int nprev = dir == 0 ? cl : nc - 1 - cl;
#pragma unroll 4
    for (int j = 0; j < nprev; ++j) {
      int tcj = tcbase + (dir == 0 ? j : nc - 1 - j);
      size_t itj = (size_t)((tcj * 4 + h) * 2 + dir);
#pragma unroll
      for (int a = 0; a < 4; ++a) {
        int k = ty + 16 * a;
        float dcy = DECb[itj * 64 + k];
        float4 kv = *(const float4*)(KVb + itj * 4096 + k * 64 + tx * 4);
        S[a].x = dcy * S[a].x + kv.x; S[a].y = dcy * S[a].y + kv.y; S[a].z = dcy * S[a].z + kv.z; S[a].w = dcy * S[a].w + kv.w;
      }
    }
    if (!lat && nprev == nc - 1) {
      size_t itj = (size_t)((tc * 4 + h) * 2 + dir);
      float* so = p.out + (dir == 0 ? OUT_SF : OUT_SB) + (size_t)((seq * 2 + li) * 4 + h) * 4096;
#pragma unroll
      for (int a = 0; a < 4; ++a) {
        int k = ty + 16 * a;
        float dcy = DECb[itj * 64 + k];
        float4 kv = *(const float4*)(KVb + itj * 4096 + k * 64 + tx * 4);
        *(float4*)(so + k * 64 + tx * 4) = make_float4(dcy * S[a].x + kv.x, dcy * S[a].y + kv.y, dcy * S[a].z + kv.z, dcy * S[a].w + kv.w);
      }
    }
    u16* st = sST + dir * 64 * 72;
#pragma unroll
    for (int a = 0; a < 4; ++a) {
      int k = ty + 16 * a;
      st[(tx * 4 + 0) * 72 + k] = f2bf(S[a].x);
      st[(tx * 4 + 1) * 72 + k] = f2bf(S[a].y);
      st[(tx * 4 + 2) * 72 + k] = f2bf(S[a].z);
      st[(tx * 4 + 3) * 72 + k] = f2bf(S[a].w);
    }
  }
  __syncthreads();
  f32x4 oc[4];
#pragma unroll
  for (int vt = 0; vt < 4; ++vt) oc[vt] = f32x4{0.f, 0.f, 0.f, 0.f};
#pragma unroll
  for (int dir = 0; dir < 2; ++dir) {
    const u16* QE = (const u16*)(p.ws + O_QE) + (size_t)dir * NTOK * 256 + (size_t)(row0 + 16 * w + l16) * 256 + h * 64 + q4 * 8;
    const u16* st = sST + dir * 64 * 72;
#pragma unroll
    for (int ks = 0; ks < 2; ++ks) {
      bf16x8 af = *(const bf16x8*)(QE + ks * 32);
#pragma unroll
      for (int vt = 0; vt < 4; ++vt) {
        bf16x8 bf = *(const bf16x8*)(st + (vt * 16 + l16) * 72 + ks * 32 + q4 * 8);
        oc[vt] = MFMA16(af, bf, oc[vt]);
      }
    }
  }
  const float* OI0 = (const float*)(p.ws + O_OI);
  const float* OI1 = OI0 + (size_t)NTOK * 256;
  const float* HSG = (const float*)(p.ws + O_HSG);
  u16* mixed = (u16*)(p.ws + O_MIXED);
  float gn[4];
#pragma unroll
  for (int vt = 0; vt < 4; ++vt) gn[vt] = p.in[21][li * 64 + vt * 16 + l16];
  float oi[4][4], sgv[4][4];
#pragma unroll
  for (int r = 0; r < 4; ++r) {
    const size_t off = (size_t)(row0 + 16 * w + q4 * 4 + r) * 256 + h * 64 + l16;
#pragma unroll
    for (int vt = 0; vt < 4; ++vt) {
      oi[r][vt] = OI0[off + vt * 16] + OI1[off + vt * 16];
      sgv[r][vt] = HSG[off + vt * 16];
    }
  }
#pragma unroll
  for (int r = 0; r < 4; ++r) {
    const int row = row0 + 16 * w + q4 * 4 + r;
    float val[4];
    float ss = 0.f;
#pragma unroll
    for (int vt = 0; vt < 4; ++vt) {
      val[vt] = oc[vt][r] + oi[r][vt];
      ss += val[vt] * val[vt];
    }
    ss = red16(ss);
    const float rs = rsqrtf(ss * (1.f / 64.f) + 1e-6f);
#pragma unroll
    for (int vt = 0; vt < 4; ++vt)
      mixed[(size_t)row * 1024 + 512 + h * 64 + vt * 16 + l16] = f2bf(val[vt] * rs * gn[vt] * sgv[r][vt]);
  }
}

DI void row_stats(float2 slot, float& mu, float& rs) {
  float s1 = red16(slot.x), s2 = red16(slot.y);
  s1 = __builtin_bit_cast(float, __builtin_amdgcn_readfirstlane(__builtin_bit_cast(int, s1)));
  s2 = __builtin_bit_cast(float, __builtin_amdgcn_readfirstlane(__builtin_bit_cast(int, s2)));
  mu = s1 * (1.f / 1024.f);
  rs = rsqrtf(fmaxf(s2 * (1.f / 1024.f) - mu * mu, 0.f) + 1e-6f);
}

DI void ln_apply(const P& p, const float* lo, const float* hi, const float* stats, const float* lng, const float* lnb,
                 const float* mods, int sc_off, int sh_off) {
  const int lane = ltid() & 63, wid = ltid() >> 6;
  u16* dst = (u16*)(p.ws + O_ABF);
  f32x4 ggv[4], bbv[4];
#pragma unroll
  for (int i = 0; i < 4; ++i) {
    ggv[i] = f32x4{1.f, 1.f, 1.f, 1.f};
    bbv[i] = f32x4{0.f, 0.f, 0.f, 0.f};
    if (stats != nullptr) {
      ggv[i] = *(const f32x4*)(lng + (lane + 64 * i) * 4);
      bbv[i] = *(const f32x4*)(lnb + (lane + 64 * i) * 4);
    }
  }
  int it = blockIdx.x;
  f32x4 xn[4];
  float2 stn = make_float2(0.f, 0.f);
  if (it < NTOK / 4) {
    const int row = it * 4 + wid;
    const float* x = row < NCTX ? lo + (size_t)row * 1024 : hi + (size_t)(row - NCTX) * 1024;
#pragma unroll
    for (int i = 0; i < 4; ++i) xn[i] = *(const f32x4*)(x + (lane + 64 * i) * 4);
    if (stats != nullptr && lane < 16) stn = *(const float2*)(stats + (size_t)row * 32 + lane * 2);
  }
  while (it < NTOK / 4) {
    const int row = it * 4 + wid;
    f32x4 xv[4];
#pragma unroll
    for (int i = 0; i < 4; ++i) xv[i] = xn[i];
    const float2 stc = stn;
    const int itn = it + gridDim.x;
    if (itn < NTOK / 4) {
      const int rown = itn * 4 + wid;
      const float* x = rown < NCTX ? lo + (size_t)rown * 1024 : hi + (size_t)(rown - NCTX) * 1024;
#pragma unroll
      for (int i = 0; i < 4; ++i) xn[i] = *(const f32x4*)(x + (lane + 64 * i) * 4);
      stn = make_float2(0.f, 0.f);
      if (stats != nullptr && lane < 16) stn = *(const float2*)(stats + (size_t)rown * 32 + lane * 2);
    }
    float mu = 0.f, rs = 1.f;
    if (stats != nullptr) row_stats(stc, mu, rs);
    const int rtype = row < NCTX ? 0 : 1 + ((row - NCTX) >> 10);
    const float* mv = mods + rtype * 6144;
    f32x4 scv[4], shv[4];
#pragma unroll
    for (int i = 0; i < 4; ++i) {
      scv[i] = *(const f32x4*)(mv + sc_off + (lane + 64 * i) * 4);
      shv[i] = *(const f32x4*)(mv + sh_off + (lane + 64 * i) * 4);
    }
#pragma unroll
    for (int i = 0; i < 4; ++i) {
      const int c = (lane + 64 * i) * 4;
      f32x4 v = (xv[i] - mu) * rs * ggv[i] + bbv[i];
      v = v * (scv[i] + 1.f) + shv[i];
      u32x2 o;
      o.x = pack2(v.x, v.y);
      o.y = pack2(v.z, v.w);
      *(u32x2*)(dst + (size_t)row * 1024 + c) = o;
    }
    it = itn;
  }
}

DI void final_ln(const P& p) {
  const int lane = ltid() & 63, wid = ltid() >> 6;
  const float* X = (const float*)(p.ws + O_XPRE2);
  const float* ST = (const float*)(p.ws + O_ST2);
  f32x4 gv[4], bv[4];
#pragma unroll
  for (int i = 0; i < 4; ++i) {
    gv[i] = *(const f32x4*)(p.in[26] + 1024 + (lane + 64 * i) * 4);
    bv[i] = *(const f32x4*)(p.in[27] + 1024 + (lane + 64 * i) * 4);
  }
  int it = blockIdx.x;
  f32x4 xn[4];
  float2 stn = make_float2(0.f, 0.f);
  if (it < NTOK / 4) {
    const int row = it * 4 + wid;
#pragma unroll
    for (int i = 0; i < 4; ++i) xn[i] = *(const f32x4*)(X + (size_t)row * 1024 + (lane + 64 * i) * 4);
    if (lane < 16) stn = *(const float2*)(ST + (size_t)row * 32 + lane * 2);
  }
  while (it < NTOK / 4) {
    const int row = it * 4 + wid;
    f32x4 xv[4];
#pragma unroll
    for (int i = 0; i < 4; ++i) xv[i] = xn[i];
    const float2 stc = stn;
    const int itn = it + gridDim.x;
    if (itn < NTOK / 4) {
      const int rown = itn * 4 + wid;
#pragma unroll
      for (int i = 0; i < 4; ++i) xn[i] = *(const f32x4*)(X + (size_t)rown * 1024 + (lane + 64 * i) * 4);
      stn = make_float2(0.f, 0.f);
      if (lane < 16) stn = *(const float2*)(ST + (size_t)rown * 32 + lane * 2);
    }
    float mu, rs;
    row_stats(stc, mu, rs);
    float* out = p.out + (row < NCTX ? OUT_YP + (size_t)row * 1024 : OUT_YS + (size_t)(row - NCTX) * 1024);
#pragma unroll
    for (int i = 0; i < 4; ++i) *(f32x4*)(out + (lane + 64 * i) * 4) = (xv[i] - mu) * rs * gv[i] + bv[i];
    it = itn;
  }
}

DI void run_phase(const P& p, int ph, char* smem, int sub = 0) {
  if (ph == 0) { phase0(p, smem); return; }
  if (ph == NPHASE - 1) { final_ln(p); return; }
  const int li = (ph - 1) >> 3, s = (ph - 1) & 7;
  float* XPRE1 = (float*)(p.ws + O_XPRE1);
  float* XPRE2 = (float*)(p.ws + O_XPRE2);
  float* ST1 = (float*)(p.ws + O_ST1);
  float* ST2 = (float*)(p.ws + O_ST2);
  GA g;
  g.mods = (const float*)(p.ws + O_MODS) + li * 3 * 6144;
  g.a16 = (const u16*)(p.ws + O_ABF); g.xout = nullptr; g.sout = nullptr; g.hid = nullptr;
  g.alo = nullptr; g.ahi = nullptr; g.stats = nullptr; g.lng = nullptr; g.lnb = nullptr; g.sc_off = 0; g.sh_off = 0;
  const float* xin_lo = li == 0 ? p.in[0] : XPRE2;
  const float* xin_hi = li == 0 ? p.in[1] : XPRE2 + (size_t)NCTX * 1024;
  const float* xin_st = li == 0 ? nullptr : ST2;
  const float* xin_g = p.in[26] + (li == 0 ? 0 : (li - 1) * 1024);
  const float* xin_b = p.in[27] + (li == 0 ? 0 : (li - 1) * 1024);
  if (s == 0) {
#if !MULTI_LAUNCH
    if (li == 0) return;
#endif
    ln_apply(p, xin_lo, xin_hi, xin_st, xin_g, xin_b, g.mods, 1024, 0);
  } else if (s == 1) {
    g.bt = (const u16*)(p.ws + O_WTIN) + (size_t)li * NIN * D; g.K = D; g.N = NIN;
    gemm_phase<0>(p, g, li, smem);
    if (li == 0) {
      const int xcd = blockIdx.x & 7, lb = blockIdx.x >> 3, nlb = gridDim.x >> 3;
      const int busy = 6 * (NIN >> 7) - 2 * nlb;
      if (nlb == 64 && lb >= busy) run_transposes(p, smem, (lb - busy) * 8 + xcd, (nlb - busy) * 8, 1);
      else if (nlb != 64) run_transposes(p, smem, blockIdx.x, gridDim.x, 1);
    }
  } else if (s == 2) {
    if (gridDim.x == 512 && sub == 0) {
      const int b = blockIdx.x;
      if (b < 128) {
        attnA_item(p, li, b, smem);
      } else if (b < 192) {
        attnC_item(p, li, b - 128, smem);
        h1_item(p, b - 128, smem);
      } else {
        const int j = b - 192;
        h1_item(p, 64 + j, smem);
        h1_item(p, 64 + 320 + j, smem);
        if (j < 64) h1_item(p, 64 + 640 + j, smem);
        else attnA_item(p, li, 128 + (j - 64), smem);
        run_transposes(p, smem, j, 320, 2 + li);
      }
    } else {
      if (sub == 0) run_transposes(p, smem, blockIdx.x, gridDim.x, 2 + li);
      const int it_lo = sub == 2 ? 128 : (sub == 3 ? 192 : (sub == 4 ? 960 : 0)), it_hi = sub == 1 ? 128 : (sub == 2 ? 192 : (sub == 3 ? 960 : 1216));
      for (int it = it_lo + blockIdx.x; it < it_hi; it += gridDim.x) {
        if (it >= 192 && it < 960) h1_item(p, it - 192, smem);
        else if (it >= 128 && it < 192) attnC_item(p, li, it - 128, smem);
        else attnA_item(p, li, it < 128 ? it : it - 832, smem);
      }
    }
  } else if (s == 3) {
    for (int it = blockIdx.x; it < 512; it += gridDim.x) {
      if (it < 384) h2_item(p, li, it, smem);
      else attnC_item(p, li, it - 384 + 64, smem);
    }
  } else if (s == 4) {
    g.alo = xin_lo; g.ahi = xin_hi; g.stats = xin_st; g.lng = xin_g; g.lnb = xin_b;
    g.sc_off = 2048;
    g.a16 = (const u16*)(p.ws + O_MIXED);
    g.bt = (const u16*)(p.ws + O_WTOUT) + (size_t)li * D * D; g.K = D; g.N = D;
    g.xout = XPRE1; g.sout = ST1;
    gemm_phase<1, 3>(p, g, li, smem);
  } else if (s == 5) {
    ln_apply(p, XPRE1, XPRE1 + (size_t)NCTX * 1024, ST1, p.in[24] + li * 1024, p.in[25] + li * 1024, g.mods, 4096, 3072);
  } else if (s == 6) {
    g.bt = (const u16*)(p.ws + O_WTFF1) + (size_t)li * DFF * D; g.K = D; g.N = DFF;
    g.hid = (u16*)(p.ws + O_HID);
    gemm_phase<2>(p, g, li, smem);
  } else {
    g.alo = XPRE1; g.ahi = XPRE1 + (size_t)NCTX * 1024; g.stats = ST1; g.lng = p.in[24] + li * 1024; g.lnb = p.in[25] + li * 1024;
    g.sc_off = 5120;
    g.a16 = (const u16*)(p.ws + O_HID);
    g.bt = (const u16*)(p.ws + O_WTFF2) + (size_t)li * D * DFF; g.K = DFF; g.N = D;
    g.xout = XPRE2; g.sout = ST2;
    gemm_phase<1, 3>(p, g, li, smem);
  }
}

#define XB_TMO      128
#define XB_XCNT(j)  (256  + 64 * (j))
#define XB_XSUB(j)  (1280 + 64 * (j))
#define XB_XGEN(j)  (2304 + 64 * (j))
#define XB_TOP      3328
#define XB_TOPGEN   3392
#define XCD_BAR_WORDS 3456
#define XB_SPIN_CAP (1u << 20)
#define LAS __attribute__((address_space(3)))
DI unsigned xb_ld(unsigned* p) { return __hip_atomic_load(p, __ATOMIC_RELAXED, __HIP_MEMORY_SCOPE_AGENT); }
DI unsigned xb_add(unsigned* p, unsigned v) { return __hip_atomic_fetch_add(p, v, __ATOMIC_RELAXED, __HIP_MEMORY_SCOPE_AGENT); }
DI unsigned xb_xcc_id() { return (unsigned)__builtin_amdgcn_s_getreg((3 << 11) | 20) & 0xFu; }
#define XB_SPIN(cond, bar) do { unsigned _sp = 0; while (cond) { __builtin_amdgcn_s_sleep(1); \
    if ((++_sp & 255u) == 0u) { if (xb_ld(&(bar)[XB_TMO])) break; if (_sp > XB_SPIN_CAP) { atomicAdd(&(bar)[XB_TMO], 1u); break; } } } } while (0)
struct XcdBarrier { unsigned* bar; unsigned x; volatile LAS unsigned* st; };
DI XcdBarrier xcd_barrier_post(unsigned* bar, volatile LAS unsigned* st) {
  XcdBarrier b; b.bar = bar; b.x = xb_xcc_id(); b.st = st;
  if (threadIdx.x == 0) (void)xb_add(&bar[XB_XCNT(b.x)], 1u);
  return b;
}
DI void xcd_barrier_complete(unsigned* bar, unsigned x, unsigned& nloc, unsigned& nx) {
  const unsigned G = gridDim.x * gridDim.y * gridDim.z;
  unsigned sum, cnt, mine, sp = 0u;
  for (;;) {
    sum = 0u; cnt = 0u; mine = 0u;
#pragma unroll
    for (unsigned j = 0; j < 16; ++j) { const unsigned c = xb_ld(&bar[XB_XCNT(j)]); sum += c; cnt += (c > 0u) ? 1u : 0u; mine = (j == x) ? c : mine; }
    if (sum == G) break;
    __builtin_amdgcn_s_sleep(1);
    if ((++sp & 255u) == 0u) { if (xb_ld(&bar[XB_TMO])) break; if (sp > XB_SPIN_CAP) { atomicAdd(&bar[XB_TMO], 1u); break; } }
  }
  nloc = mine > 0u ? mine : 1u; nx = cnt > 0u ? cnt : 1u;
}
DI void xcd_barrier(const XcdBarrier& b) {
  asm volatile("s_waitcnt vmcnt(0)" ::: "memory");
  __syncthreads();
  if (threadIdx.x == 0) {
    unsigned* bar = b.bar;
    __builtin_amdgcn_s_waitcnt(0);
    unsigned nloc = b.st[0], nx = b.st[1];
    if (nloc == 0u) { xcd_barrier_complete(bar, b.x, nloc, nx); b.st[0] = nloc; b.st[1] = nx; }
    const unsigned old = xb_add(&bar[XB_XSUB(b.x)], 1u);
    const unsigned gen = old / nloc;
    if (old + 1u == (gen + 1u) * nloc) {
      __builtin_amdgcn_fence(__ATOMIC_RELEASE, "agent");
      asm volatile("s_waitcnt vmcnt(0)" ::: "memory");
      const unsigned og = xb_add(&bar[XB_TOP], 1u);
      const unsigned tg = og / nx;
      if (og + 1u == (tg + 1u) * nx) xb_add(&bar[XB_TOPGEN], 1u);
      else XB_SPIN(xb_ld(&bar[XB_TOPGEN]) == tg, bar);
      __builtin_amdgcn_fence(__ATOMIC_ACQUIRE, "agent");
      asm volatile("s_waitcnt vmcnt(0)" ::: "memory");
    } else {
      XB_SPIN(xb_ld(&bar[XB_TOPGEN]) <= gen, bar);
      __builtin_amdgcn_fence(__ATOMIC_ACQUIRE, "agent");
      asm volatile("s_waitcnt vmcnt(0)" ::: "memory");
    }
  }
  __syncthreads();
}
constexpr size_t O_BAR = O_END1;
static_assert(O_BAR + XCD_BAR_WORDS * 4 <= (size_t)256 * 1024 * 1024, "barrier words must fit");

#if !MULTI_LAUNCH
__global__ void __launch_bounds__(256, 2) mega_kernel(P p) {
  extern __shared__ __attribute__((aligned(16))) char smem[];
  cg::grid_group grid = cg::this_grid();
  if (p.ws == nullptr) grid.sync();
  if (threadIdx.x == 0) *(uint4*)(smem + LDS_BYTES - 16) = make_uint4(0u, 0u, 0u, 0u);
  __syncthreads();
  XcdBarrier xb = xcd_barrier_post((unsigned*)(p.ws + O_BAR), (volatile LAS unsigned*)(smem + LDS_BYTES - 16));
  run_phase(p, 0, smem); xcd_barrier(xb);
  run_phase(p, 2, smem); xcd_barrier(xb);
  run_phase(p, 3, smem); xcd_barrier(xb);
  run_phase(p, 4, smem); xcd_barrier(xb);
  run_phase(p, 5, smem); xcd_barrier(xb);
  run_phase(p, 6, smem); xcd_barrier(xb);
  run_phase(p, 7, smem); xcd_barrier(xb);
  run_phase(p, 8, smem); xcd_barrier(xb);
  run_phase(p, 9, smem); xcd_barrier(xb);
  run_phase(p, 10, smem); xcd_barrier(xb);
  run_phase(p, 11, smem); xcd_barrier(xb);
  run_phase(p, 12, smem); xcd_barrier(xb);
  run_phase(p, 13, smem); xcd_barrier(xb);
  run_phase(p, 14, smem); xcd_barrier(xb);
  run_phase(p, 15, smem); xcd_barrier(xb);
  run_phase(p, 16, smem); xcd_barrier(xb);
  run_phase(p, 17, smem);
}
#define MAIN_KERNEL mega_kernel
#else
template <int PH>
__global__ void __launch_bounds__(256, 2) phase_kernel(P p, int sub) {
  extern __shared__ __attribute__((aligned(16))) char smem[];
  run_phase(p, PH, smem, sub);
}
typedef void (*phase_fn)(P, int);
static phase_fn phase_table[NPHASE] = {phase_kernel<0>, phase_kernel<1>, phase_kernel<2>, phase_kernel<3>, phase_kernel<4>, phase_kernel<5>,
                                       phase_kernel<6>, phase_kernel<7>, phase_kernel<8>, phase_kernel<9>, phase_kernel<10>, phase_kernel<11>,
                                       phase_kernel<12>, phase_kernel<13>, phase_kernel<14>, phase_kernel<15>, phase_kernel<16>, phase_kernel<17>};
#define MAIN_KERNEL phase_kernel<2>
#endif

extern "C" void kernel_launch(void* const* d_in, const int* in_sizes, int n_in, void* d_out, int out_size, void* d_ws,
                              size_t ws_size, hipStream_t stream) {
  static int grid_blocks = 0;
  if (!grid_blocks) {
    int dev = 0, cus = 0, per_cu = 0;
    (void)hipGetDevice(&dev);
    (void)hipDeviceGetAttribute(&cus, hipDeviceAttributeMultiprocessorCount, dev);
    (void)hipFuncSetAttribute((const void*)MAIN_KERNEL, hipFuncAttributeMaxDynamicSharedMemorySize, LDS_BYTES);
    (void)hipOccupancyMaxActiveBlocksPerMultiprocessor(&per_cu, MAIN_KERNEL, 256, LDS_BYTES);
    if (per_cu > 2) per_cu = 2;
    if (per_cu < 1) per_cu = 1;
    grid_blocks = cus * per_cu;
  }
  P p{};
  for (int i = 0; i < 30; ++i) p.in[i] = (const float*)d_in[i];
  p.out = (float*)d_out;
  p.ws = (char*)d_ws;
#if MULTI_LAUNCH
  for (int ph = 0; ph < NPHASE; ++ph) {
    (void)hipFuncSetAttribute((const void*)phase_table[ph], hipFuncAttributeMaxDynamicSharedMemorySize, LDS_BYTES);
    phase_table[ph]<<<dim3(grid_blocks), dim3(256), LDS_BYTES, stream>>>(p, 0);
#ifdef DUP_MASK
    int bit = (ph == 0) ? 8 : (ph == NPHASE - 1 ? 9 : (ph - 1) & 7);
    if ((DUP_MASK >> bit) & 1) phase_table[ph]<<<dim3(grid_blocks), dim3(256), LDS_BYTES, stream>>>(p, DUP_SUB);
#endif
  }
#else
  (void)hipMemsetAsync((char*)d_ws + O_BAR, 0, 16384 + CNT_BYTES, stream);
  void* args[] = {&p};
  hipError_t e = hipLaunchCooperativeKernel((void*)mega_kernel, dim3(grid_blocks), dim3(256), args, LDS_BYTES, stream);
  if (e != hipSuccess) fprintf(stderr, "cooperative launch failed: %s (grid %d)\n", hipGetErrorString(e), grid_blocks);
#endif
}
```
